# Optimizing an MI355X kernel written in HIP

```python
import jax, jax.numpy as jnp
from jax import lax
import numpy as np

D_MODEL = 2048
BATCH = 1
SEQ = 16384
DEPTH = 4
DEC_BATCH = 16
DEC_SEQ = 32
PAST_LEN = 1024

CHUNK = 64
D_MIX = D_MODEL
RW_WIDTH = D_MIX // 2
RW_HEAD = 64
RW_HEADS = RW_WIDTH // RW_HEAD
GM_WIDTH = D_MIX - RW_WIDTH
GM_HEADS = 8
GM_HEAD = GM_WIDTH // GM_HEADS
GM_CHUNK = 128
DECAY_RANK = 64
ICL_RANK = 64
GATE_RANK = 160
FFN_DIM = 5632
ALPHA = (2 * DEPTH) ** 0.25
BETA = (8 * DEPTH) ** -0.25
LN_EPS = 1e-5
GN_EPS = 64e-5

C_R = 0
C_K = RW_WIDTH
C_V = 2 * RW_WIDTH
C_W = 3 * RW_WIDTH
C_A = C_W + DECAY_RANK
C_G = C_A + ICL_RANK
SHIFT_COLS = C_G + GATE_RANK
IN_COLS = SHIFT_COLS + 2 * GM_WIDTH

kernel_name = "rwkv7_gmlp_macaron_deepnorm_stream_step"


def _layernorm(x, g, b, eps=LN_EPS):
    xf = x.astype(jnp.float32)
    mu = jnp.mean(xf, -1, keepdims=True)
    var = jnp.mean(jnp.square(xf - mu), -1, keepdims=True)
    return ((xf - mu) * lax.rsqrt(var + eps) * g + b).astype(x.dtype)


def _swiglu(x, wg, wu, wd):
    return (jax.nn.silu(x @ wg) * (x @ wu)) @ wd


def _rwkv7_scan(S0, r, w, k, v, kk, a):
    def step(S, inp):
        r_t, w_t, k_t, v_t, kk_t, a_t = inp
        sa = jnp.einsum('bhvk,bhk->bhv', S, -kk_t)
        S = (S * w_t[:, :, None, :]
             + sa[..., None] * (kk_t * a_t)[:, :, None, :]
             + v_t[..., None] * k_t[:, :, None, :])
        y = jnp.einsum('bhvk,bhk->bhv', S, r_t)
        return S, y
    xs = tuple(jnp.moveaxis(t, 1, 0) for t in (r, w, k, v, kk, a))
    S, ys = lax.scan(step, S0, xs)
    return jnp.moveaxis(ys, 0, 1), S


def _rwkv7_mix(p, S0, prev_row, mu, w0, w_up, a0, a_up, g_up, k_k, k_a, r_k, gn_g, gn_b):
    B, T, _ = p.shape
    prev = jnp.concatenate([prev_row[:, None, :].astype(p.dtype), p[:, :-1]], axis=1)
    xs = p + (prev - p) * mu
    r, k, v = xs[..., C_R:C_K], xs[..., C_K:C_V], xs[..., C_V:C_W]
    wd, ad, gd = xs[..., C_W:C_A], xs[..., C_A:C_G], xs[..., C_G:SHIFT_COLS]
    w = -jax.nn.softplus(-(w0 + jnp.tanh(wd) @ w_up)) - 0.5
    decay = jnp.exp(-jnp.exp(w.astype(jnp.float32)))
    a = jax.nn.sigmoid(a0 + ad @ a_up)
    g = jax.nn.sigmoid(gd) @ g_up
    heads = lambda t: t.reshape(B, T, RW_HEADS, RW_HEAD).astype(jnp.float32)
    kk = heads(k * k_k)
    kk = kk / jnp.maximum(jnp.sqrt(jnp.sum(kk * kk, -1, keepdims=True)), 1e-12)
    k = heads(k * (1 + (a - 1) * k_a))
    r, v, a, decay = heads(r), heads(v), heads(a), heads(decay)
    y, S = _rwkv7_scan(S0.astype(jnp.float32), r, decay, k, v, kk, a)
    ym = jnp.mean(y, -1, keepdims=True)
    yv = jnp.mean(jnp.square(y - ym), -1, keepdims=True)
    y = ((y - ym) * lax.rsqrt(yv + GN_EPS)).reshape(B, T, RW_WIDTH) * gn_g + gn_b
    y = y + (jnp.sum(r * k * r_k, -1, keepdims=True) * v).reshape(B, T, RW_WIDTH)
    return (y * g).astype(p.dtype), S.astype(S0.dtype), p[:, -1]


def _gmlp_mix(p, ln_g, ln_b, ws, bs):
    B, T, _ = p.shape
    h = jax.nn.gelu(p, approximate=False)
    u, v = h[..., :GM_WIDTH], h[..., GM_WIDTH:]
    v = _layernorm(v, ln_g, ln_b)
    n_chunks = -(-T // GM_CHUNK)
    pad = n_chunks * GM_CHUNK - T
    vc = jnp.pad(v, ((0, 0), (0, pad), (0, 0))).reshape(B, n_chunks, GM_CHUNK, GM_HEADS, GM_HEAD)
    causal = jnp.tril(jnp.ones((GM_CHUNK, GM_CHUNK), dtype=bool))
    ws_c = jnp.where(causal[None], ws, jnp.zeros_like(ws))
    s = jnp.einsum('hij,bnjhc->bnihc', ws_c, vc) + jnp.transpose(bs)[None, None, :, :, None]
    s = s.reshape(B, n_chunks * GM_CHUNK, GM_WIDTH)[:, :T]
    return u * s, v


def _layer(x, S0, shift0, ffn1_wg, ffn1_wu, ffn1_wd, w_in, rw_mu, rw_w0, rw_w_up, rw_a0, rw_a_up,
           rw_g_up, rw_k_k, rw_k_a, rw_r_k, rw_gn_g, rw_gn_b, gm_ln_g, gm_ln_b, gm_ws, gm_bs,
           w_out, ffn2_wg, ffn2_wu, ffn2_wd, ln_g, ln_b):
    x = _layernorm(ALPHA * x + 0.5 * _swiglu(x, ffn1_wg, ffn1_wu, ffn1_wd), ln_g[0], ln_b[0])
    p = x @ w_in
    rw_out, S, shift = _rwkv7_mix(p[..., :SHIFT_COLS], S0, shift0, rw_mu, rw_w0, rw_w_up,
                                  rw_a0, rw_a_up, rw_g_up, rw_k_k, rw_k_a, rw_r_k, rw_gn_g, rw_gn_b)
    gm_out, gm_v = _gmlp_mix(p[..., SHIFT_COLS:], gm_ln_g, gm_ln_b, gm_ws, gm_bs)
    mix = jnp.concatenate([rw_out, gm_out], axis=-1) @ w_out
    x = _layernorm(ALPHA * x + mix, ln_g[1], ln_b[1])
    x = _layernorm(ALPHA * x + 0.5 * _swiglu(x, ffn2_wg, ffn2_wu, ffn2_wd), ln_g[2], ln_b[2])
    return x, S, shift, gm_v


def setup_inputs(seed: int = 0) -> dict:
    key = jax.random.key(seed)
    ks = iter(jax.random.split(key, 40))
    nrm = lambda shape, scale: jax.random.normal(next(ks), shape, jnp.float32) * scale
    col_scale = jnp.ones((IN_COLS,), jnp.float32).at[C_V:C_W].set(BETA)
    return {
        "x_prompt": nrm((BATCH, SEQ, D_MODEL), 1.0),
        "x_sample": nrm((DEC_BATCH, DEC_SEQ, D_MODEL), 1.0),
        "state_rwkv": nrm((DEPTH, DEC_BATCH, RW_HEADS, RW_HEAD, RW_HEAD), 0.1),
        "state_shift": nrm((DEPTH, DEC_BATCH, SHIFT_COLS), 1.0),
        "ffn1_wg": nrm((DEPTH, D_MODEL, FFN_DIM), D_MODEL ** -0.5),
        "ffn1_wu": nrm((DEPTH, D_MODEL, FFN_DIM), D_MODEL ** -0.5 * BETA),
        "ffn1_wd": nrm((DEPTH, FFN_DIM, D_MODEL), FFN_DIM ** -0.5 * BETA),
        "w_in": nrm((DEPTH, D_MODEL, IN_COLS), D_MODEL ** -0.5) * col_scale,
        "rw_mu": jax.random.uniform(next(ks), (DEPTH, SHIFT_COLS), jnp.float32),
        "rw_w0": jax.random.uniform(next(ks), (DEPTH, RW_WIDTH), jnp.float32, -4.0, 0.0),
        "rw_w_up": nrm((DEPTH, DECAY_RANK, RW_WIDTH), 0.5 * DECAY_RANK ** -0.5),
        "rw_a0": nrm((DEPTH, RW_WIDTH), 0.1),
        "rw_a_up": nrm((DEPTH, ICL_RANK, RW_WIDTH), 0.5 * ICL_RANK ** -0.5),
        "rw_g_up": nrm((DEPTH, GATE_RANK, RW_WIDTH), GATE_RANK ** -0.5),
        "rw_k_k": 0.85 + nrm((DEPTH, RW_WIDTH), 0.05),
        "rw_k_a": 1.0 + nrm((DEPTH, RW_WIDTH), 0.05),
        "rw_r_k": nrm((DEPTH, RW_HEADS, RW_HEAD), 0.1),
        "rw_gn_g": 1.0 + nrm((DEPTH, RW_WIDTH), 0.02),
        "rw_gn_b": nrm((DEPTH, RW_WIDTH), 0.02),
        "gm_ln_g": 1.0 + nrm((DEPTH, GM_WIDTH), 0.02),
        "gm_ln_b": nrm((DEPTH, GM_WIDTH), 0.02),
        "gm_ws": nrm((DEPTH, GM_HEADS, GM_CHUNK, GM_CHUNK), GM_CHUNK ** -0.5),
        "gm_bs": 1.0 + nrm((DEPTH, GM_HEADS, GM_CHUNK), 0.02),
        "w_out": nrm((DEPTH, D_MIX, D_MODEL), D_MIX ** -0.5 * BETA),
        "ffn2_wg": nrm((DEPTH, D_MODEL, FFN_DIM), D_MODEL ** -0.5),
        "ffn2_wu": nrm((DEPTH, D_MODEL, FFN_DIM), D_MODEL ** -0.5 * BETA),
        "ffn2_wd": nrm((DEPTH, FFN_DIM, D_MODEL), FFN_DIM ** -0.5 * BETA),
        "ln_g": 1.0 + nrm((DEPTH, 3, D_MODEL), 0.02),
        "ln_b": nrm((DEPTH, 3, D_MODEL), 0.02),
    }


def reference(x_prompt, x_sample, state_rwkv, state_shift, ffn1_wg, ffn1_wu, ffn1_wd, w_in,
              rw_mu, rw_w0, rw_w_up, rw_a0, rw_a_up, rw_g_up, rw_k_k, rw_k_a, rw_r_k,
              rw_gn_g, rw_gn_b, gm_ln_g, gm_ln_b, gm_ws, gm_bs, w_out, ffn2_wg, ffn2_wu,
              ffn2_wd, ln_g, ln_b):
    layer_params = (ffn1_wg, ffn1_wu, ffn1_wd, w_in, rw_mu, rw_w0, rw_w_up, rw_a0, rw_a_up,
                    rw_g_up, rw_k_k, rw_k_a, rw_r_k, rw_gn_g, rw_gn_b, gm_ln_g, gm_ln_b,
                    gm_ws, gm_bs, w_out, ffn2_wg, ffn2_wu, ffn2_wd, ln_g, ln_b)
    b_p = x_prompt.shape[0]
    S_p0 = jnp.zeros((b_p, RW_HEADS, RW_HEAD, RW_HEAD), state_rwkv.dtype)
    sh_p0 = jnp.zeros((b_p, SHIFT_COLS), state_shift.dtype)
    x_p, x_s = x_prompt, x_sample
    S_ps, sh_ps, S_ss, sh_ss, gv_ss = [], [], [], [], []
    for l in range(DEPTH):
        lp = tuple(t[l] for t in layer_params)
        x_p, S_p, sh_p, _ = _layer(x_p, S_p0, sh_p0, *lp)
        x_s, S_s, sh_s, gv_s = _layer(x_s, state_rwkv[l], state_shift[l], *lp)
        S_ps.append(S_p); sh_ps.append(sh_p.astype(state_shift.dtype))
        S_ss.append(S_s); sh_ss.append(sh_s.astype(state_shift.dtype)); gv_ss.append(gv_s)
    new_rwkv_prompt = jnp.stack(S_ps)
    new_shift_prompt = jnp.stack(sh_ps)
    new_rwkv_sample = jnp.stack(S_ss)
    new_shift_sample = jnp.stack(sh_ss)
    gm_v_sample = jnp.stack(gv_ss)
    return (x_p, x_s, new_rwkv_prompt, new_shift_prompt, new_rwkv_sample, new_shift_sample, gm_v_sample)
```

```cpp
#include <hip/hip_runtime.h>
#include <cstdio>
#include <cstdint>
#define MK_ONE_LAUNCH 1
namespace pg8 {
#define PG8_LAS __attribute__((address_space(3)))
typedef unsigned short bf16_t;
typedef short bf16x8 __attribute__((ext_vector_type(8)));
typedef float f32x4 __attribute__((ext_vector_type(4)));
typedef unsigned u32x4 __attribute__((ext_vector_type(4)));
constexpr int BM = 256, BK = 64, HALF = 128, HTB = HALF * BK * 2  , STAGE_BYTES = 8 * HTB, NXCD = 8, WGM = 8;

__host__ __device__ __forceinline__ int lds_byte(int r, int c) { const int st = (r >> 4) * 2 + (c >> 5), rr = r & 15, cc = c & 31, ob = rr * 64 + cc * 2; return st * 1024 + (ob ^ (((ob >> 9) & 1) << 5)); }
__host__ __device__ __forceinline__ void stage_rc(int b, int& R, int& C) { const int st = b / 1024, sb = b % 1024, swz = sb ^ (((sb >> 9) & 1) << 5); R = (st >> 1) * 16 + swz / 64; C = (st & 1) * 32 + (swz % 64) / 2; }
__host__ __device__ __forceinline__ int perm32(int rho) { const int n = rho >> 4, i = rho & 15; return 8 * (i >> 2) + 4 * n + (i & 3); }

struct Unit { int pm, pn; };
struct Gemm { const bf16_t* A; const bf16_t* Bt; int M, N, K; };

struct StaticOrder {
    int nM, nN, nwg, G, c;
    __host__ __device__ void init(int M, int N, int G_, int c_) { nM = M / BM; nN = N / BM; nwg = nM * nN; G = G_; c = c_; }
    __host__ __device__ bool next(int i, Unit& u) const {
        const long L = (long)i * G + c; if (L >= nwg) return false;
        int wgid = (int)L; { const int q = nwg / NXCD, r = nwg % NXCD, xcd = wgid % NXCD, off = wgid / NXCD; wgid = (xcd < r ? xcd * (q + 1) : r * (q + 1) + (xcd - r) * q) + off; }
        const int nig = WGM * nN, gid = wgid / nig, fm = gid * WGM, gsz = (nM - fm) < WGM ? (nM - fm) : WGM;
        u.pm = fm + ((wgid % nig) % gsz); u.pn = (wgid % nig) / gsz; return true;
    }
    __device__ __forceinline__ void a_ready(const Unit&) const {}
    __device__ __forceinline__ void done(const Unit&) const {}
};
__device__ __forceinline__ unsigned cvt_pk_bf16(float lo, float hi) { unsigned r; asm volatile("v_cvt_pk_bf16_f32 %0, %1, %2" : "=v"(r) : "v"(lo), "v"(hi)); return r; }
typedef float f32x2 __attribute__((ext_vector_type(2)));
__device__ __forceinline__ f32x2 gelu_pk(f32x2 v) {
    const f32x2 av = __builtin_elementwise_abs(v), d = av * 0.2316418882f + 1.0f;
    f32x2 t; t.x = __builtin_amdgcn_rcpf(d.x); t.y = __builtin_amdgcn_rcpf(d.y);
    f32x2 q = t * 0.5307027145f + (-0.7265760135f); q = q * t + 0.7107068705f; q = q * t + (-0.142248368f); q = q * t + 0.127414796f; q = q * t;
    const f32x2 s = (v * v) * (-0.72134752044f);
    f32x2 e; e.x = __builtin_amdgcn_exp2f(s.x); e.y = __builtin_amdgcn_exp2f(s.y);
    const f32x2 m = v * (q * e), r = v - m;
    f32x2 o; o.x = v.x < 0.f ? m.x : r.x; o.y = v.y < 0.f ? m.y : r.y; return o;
}

typedef unsigned u32x2 __attribute__((ext_vector_type(2)));
__device__ __forceinline__ float silu_f(float g) { return g * __builtin_amdgcn_rcpf(1.0f + __expf(-g)); }
struct EpiSwiGLU {
    static constexpr bool PERM = true, AFTER_DRAIN = false;
    bf16_t* O; int ldc;
    __device__ __forceinline__ void operator()(const f32x4 (&acc)[2][2][4][2], const Unit& u, int wr, int wc, int fr, int fq) const {
        const int row0 = u.pm * BM + wr * 64 + fr, col0 = u.pn * HALF + wc * 32 + 8 * fq;
#pragma unroll
        for (int ai = 0; ai < 2; ++ai)
#pragma unroll
            for (int m = 0; m < 4; ++m) { bf16_t* rowp = O + (size_t)(row0 + ai * HALF + m * 16) * ldc + col0;
                const f32x4 g0 = acc[ai][0][m][0], g1 = acc[ai][0][m][1], u0 = acc[ai][1][m][0], u1 = acc[ai][1][m][1];
                u32x4 w; w.x = cvt_pk_bf16(silu_f(g0[0]) * u0[0], silu_f(g0[1]) * u0[1]); w.y = cvt_pk_bf16(silu_f(g0[2]) * u0[2], silu_f(g0[3]) * u0[3]);
                w.z = cvt_pk_bf16(silu_f(g1[0]) * u1[0], silu_f(g1[1]) * u1[1]); w.w = cvt_pk_bf16(silu_f(g1[2]) * u1[2], silu_f(g1[3]) * u1[3]);
                *(u32x4*)rowp = w; }
    }
};
struct EpiResid {
    static constexpr bool PERM = false, AFTER_DRAIN = false;
    const float* base; float* out; int ldc; float sa, sb;
    __device__ __forceinline__ void operator()(const f32x4 (&acc)[2][2][4][2], const Unit& u, int wr, int wc, int fr, int fq) const {
        const int row0 = u.pm * BM + wr * 64 + fr, col0 = u.pn * BM + wc * 32 + 4 * fq;
#pragma unroll
        for (int ai = 0; ai < 2; ++ai)
#pragma unroll
            for (int m = 0; m < 4; ++m) { const size_t off = (size_t)(row0 + ai * HALF + m * 16) * ldc + col0;
#pragma unroll
                for (int bj = 0; bj < 2; ++bj)
#pragma unroll
                    for (int n = 0; n < 2; ++n) { const f32x4 b = *(const f32x4*)(base + off + bj * HALF + n * 16); *(f32x4*)(out + off + bj * HALF + n * 16) = b * sa + acc[ai][bj][m][n] * sb; } }
    }
};
struct EpiP {
    static constexpr bool PERM = false, AFTER_DRAIN = false;
    float* P; bf16_t* U; float* GV;
    __device__ __forceinline__ void operator()(const f32x4 (&acc)[2][2][4][2], const Unit& u, int wr, int wc, int fr, int fq) const {
        const int row0 = u.pm * BM + wr * 64 + fr, cw = wc * 32 + 4 * fq;
        const int kind = u.pn < 14 ? 0 : (u.pn < 18 ? 1 : 2);
        float* F = kind == 0 ? P + u.pn * BM + cw : GV + (u.pn - 18) * BM + cw; const int ldf = kind == 0 ? 3584 : 1024;
        bf16_t* Ub = U + (u.pn - 14) * BM + cw;
#pragma unroll
        for (int ai = 0; ai < 2; ++ai)
#pragma unroll
            for (int m = 0; m < 4; ++m) { const size_t row = (size_t)(row0 + ai * HALF + m * 16);
#pragma unroll
                for (int bj = 0; bj < 2; ++bj)
#pragma unroll
                    for (int n = 0; n < 2; ++n) { f32x4 v = acc[ai][bj][m][n];
                        if (kind != 0) { const f32x2 a = gelu_pk((f32x2){v[0], v[1]}), b = gelu_pk((f32x2){v[2], v[3]}); v = (f32x4){a.x, a.y, b.x, b.y}; }
                        if (kind == 1) { u32x2 w; w.x = cvt_pk_bf16(v[0], v[1]); w.y = cvt_pk_bf16(v[2], v[3]); *(u32x2*)(Ub + row * 1024 + bj * HALF + n * 16) = w; }
                        else *(f32x4*)(F + row * ldf + bj * HALF + n * 16) = v; }
                asm volatile("" ::: "memory"); }
    }
};
struct EpiLora {
    static constexpr bool PERM = false, AFTER_DRAIN = false;
    float* base;
    __device__ __forceinline__ void operator()(const f32x4 (&acc)[2][2][4][2], const Unit& u, int wr, int wc, int fr, int fq) const {
        const int row0 = u.pm * BM + wr * 64 + fr, kind = u.pn >> 2, cb = (u.pn & 3) * BM + wc * 32 + 4 * fq;
        float* O = base + (size_t)kind * ((size_t)66 << 18) + cb;
#pragma unroll
        for (int ai = 0; ai < 2; ++ai)
#pragma unroll
            for (int m = 0; m < 4; ++m) { float* rowp = O + (size_t)(row0 + ai * HALF + m * 16) * 1024;
#pragma unroll
                for (int bj = 0; bj < 2; ++bj)
#pragma unroll
                    for (int n = 0; n < 2; ++n) *(f32x4*)(rowp + bj * HALF + n * 16) = acc[ai][bj][m][n]; }
    }
};
template <class Epi, class Sched, bool ALIGN_EPI = false, bool SP2 = false>
__device__ __forceinline__ void gemm_phase(PG8_LAS unsigned char* lds, const Gemm g, const Sched& S, const Epi& E, int tid_in) {
    int tid_ = tid_in; asm volatile("" : "+v"(tid_));
    const int tid = tid_, wid = __builtin_amdgcn_readfirstlane(tid >> 6), lane = tid & 63, wr = wid >> 2, wc = wid & 3, fr = lane & 15, fq = lane >> 4;
    const int K = g.K, nt = K / BK;
    unsigned voffA[2], voffB[2];
#pragma unroll
    for (int i = 0; i < 2; ++i) { int R, C; stage_rc(tid * 16 + i * 8192, R, C); const int Rb = Epi::PERM ? ((R & ~31) + perm32(R & 31)) : R;
        voffA[i] = (unsigned)(R * K + C) * 2u; voffB[i] = (unsigned)(Rb * K + C) * 2u; }
    const size_t kstep = (size_t)(BK * 2);
    const size_t hstep = (size_t)HALF * K * 2;
    const size_t tstep = 2 * hstep;
    const unsigned ldsw = (unsigned)wid * 1024u;
    const int aoff = lds_byte(wr * 64 + fr, fq * 8), boff = lds_byte(wc * 32 + fr, fq * 8);
#define PG8_SA(b, h) (((b) * 2 + (h)) * HTB)
#define PG8_SB(b, h) ((4 + (b) * 2 + (h)) * HTB)
#define PG8_STAGE(bufoff, gbase, voff) do { _Pragma("unroll") for (int _i = 0; _i < 2; ++_i) \
        __builtin_amdgcn_global_load_lds((const unsigned*)((const char*)(gbase) + (voff)[_i]), (PG8_LAS unsigned*)(lds + (bufoff) + ldsw + _i * 8192), 16, 0, 0); } while (0)
#define PG8_LDA(dst, b, h) do { _Pragma("unroll") for (int m = 0; m < 4; ++m) _Pragma("unroll") for (int k = 0; k < 2; ++k) dst[m][k] = *(const PG8_LAS bf16x8*)(lds + PG8_SA(b, h) + aoff + m * 2048 + k * 1024); } while (0)
#define PG8_LDB(dst, b, h) do { _Pragma("unroll") for (int n = 0; n < 2; ++n) _Pragma("unroll") for (int k = 0; k < 2; ++k) dst[n][k] = *(const PG8_LAS bf16x8*)(lds + PG8_SB(b, h) + boff + n * 2048 + k * 1024); } while (0)
#define PG8_MMA(ai, bj, At, Bt) do { __builtin_amdgcn_s_setprio(1); _Pragma("unroll") for (int m = 0; m < 4; ++m) _Pragma("unroll") for (int n = 0; n < 2; ++n) _Pragma("unroll") for (int k = 0; k < 2; ++k) \
        acc[ai][bj][m][n] = __builtin_amdgcn_mfma_f32_16x16x32_bf16(Bt[n][k], At[m][k], acc[ai][bj][m][n], 0, 0, 0); __builtin_amdgcn_s_setprio(0); } while (0)
#define PG8_WAIT_V(n) asm volatile("s_waitcnt vmcnt(" #n ")" ::: "memory")
#define PG8_WAIT_L(n) asm volatile("s_waitcnt lgkmcnt(" #n ")" ::: "memory")
#define PG8_BAR __builtin_amdgcn_s_barrier()
#define PG8_SCHED __builtin_amdgcn_sched_barrier(0)
    Unit cur, nxt; int ui = 0;
    if (!S.next(0, cur)) return;
    f32x4 acc[2][2][4][2];
    float zz0; asm volatile("v_mov_b32 %0, 0" : "=v"(zz0));
#pragma unroll
    for (int a = 0; a < 2; ++a)
#pragma unroll
        for (int b = 0; b < 2; ++b)
#pragma unroll
            for (int m = 0; m < 4; ++m)
#pragma unroll
                for (int n = 0; n < 2; ++n) acc[a][b][m][n] = (f32x4){zz0, zz0, zz0, zz0};
    bf16x8 At[4][2], B0[2][2], B1[2][2];
    const char* cA = (const char*)g.A + (size_t)cur.pm * tstep; const char* cB = (const char*)g.Bt + (size_t)cur.pn * tstep;
    S.a_ready(cur);
    if constexpr (SP2) {
        PG8_STAGE(PG8_SB(0, 0), cB, voffB); PG8_STAGE(PG8_SB(0, 1), cB + hstep, voffB); PG8_STAGE(PG8_SA(0, 0), cA, voffA); PG8_STAGE(PG8_SA(0, 1), cA + hstep, voffA);
        if (wr == 1) PG8_BAR;
        PG8_WAIT_V(2); PG8_BAR;
        PG8_STAGE(PG8_SB(1, 0), cB + kstep, voffB); PG8_STAGE(PG8_SA(1, 0), cA + kstep, voffA); PG8_STAGE(PG8_SB(1, 1), cB + hstep + kstep, voffB);
        PG8_WAIT_V(6); PG8_BAR;
    } else {
        PG8_STAGE(PG8_SB(0, 0), cB, voffB); PG8_STAGE(PG8_SA(0, 0), cA, voffA); PG8_STAGE(PG8_SB(0, 1), cB + hstep, voffB); PG8_STAGE(PG8_SA(0, 1), cA + hstep, voffA);
        if (wr == 1) PG8_BAR;
        PG8_WAIT_V(4); PG8_BAR;
        PG8_STAGE(PG8_SB(1, 0), cB + kstep, voffB); PG8_STAGE(PG8_SA(1, 0), cA + kstep, voffA); PG8_STAGE(PG8_SB(1, 1), cB + hstep + kstep, voffB);
        PG8_WAIT_V(6); PG8_BAR;
    }
    for (;;) {
        const bool has_next = S.next(ui + 1, nxt);
        const char* nA = has_next ? (const char*)g.A + (size_t)nxt.pm * tstep : cA; const char* nB = has_next ? (const char*)g.Bt + (size_t)nxt.pn * tstep : cB;
        for (int t = 0; t < nt; t += 2) {
            const bool last = (t == nt - 2);
            const char* a1 = cA + (size_t)(t + 1) * kstep;
            const char* a2 = last ? nA : cA + (size_t)(t + 2) * kstep; const char* b2 = last ? nB : cB + (size_t)(t + 2) * kstep;
            const char* a3 = a2 + kstep; const char* b3 = b2 + kstep;
            if (last && has_next) S.a_ready(nxt);
            if constexpr (SP2) {
            PG8_LDB(B0, 0, 0); PG8_LDB(B1, 0, 1); PG8_SCHED; PG8_LDA(At, 0, 0); PG8_STAGE(PG8_SA(1, 1), a1 + hstep, voffA);
            PG8_WAIT_V(8); PG8_WAIT_L(0); PG8_BAR; PG8_MMA(0, 0, At, B0); PG8_MMA(0, 1, At, B1); PG8_BAR; PG8_SCHED;
            PG8_LDA(At, 0, 1); PG8_STAGE(PG8_SB(0, 0), b2, voffB); PG8_STAGE(PG8_SB(0, 1), b2 + hstep, voffB); PG8_STAGE(PG8_SA(0, 0), a2, voffA);
            PG8_WAIT_V(8); PG8_WAIT_L(0); PG8_BAR; PG8_MMA(1, 0, At, B0); PG8_MMA(1, 1, At, B1); PG8_BAR; PG8_SCHED;
            PG8_LDB(B0, 1, 0); PG8_LDB(B1, 1, 1); PG8_SCHED; PG8_LDA(At, 1, 0); PG8_STAGE(PG8_SA(0, 1), a2 + hstep, voffA);
            PG8_WAIT_V(8); PG8_WAIT_L(0); PG8_BAR; PG8_MMA(0, 0, At, B0); PG8_MMA(0, 1, At, B1); PG8_BAR; PG8_SCHED;
            PG8_LDA(At, 1, 1); PG8_STAGE(PG8_SB(1, 0), b3, voffB); PG8_STAGE(PG8_SB(1, 1), b3 + hstep, voffB); PG8_STAGE(PG8_SA(1, 0), a3, voffA);
            PG8_WAIT_V(8); PG8_WAIT_L(0); PG8_BAR; PG8_MMA(1, 0, At, B0); PG8_MMA(1, 1, At, B1); PG8_BAR; PG8_SCHED;
            } else {
            PG8_LDB(B0, 0, 0); PG8_SCHED; PG8_LDA(At, 0, 0); PG8_STAGE(PG8_SA(1, 1), a1 + hstep, voffA);
            PG8_WAIT_L(8); PG8_BAR; PG8_WAIT_L(0); PG8_MMA(0, 0, At, B0); PG8_BAR; PG8_SCHED;
            PG8_LDB(B1, 0, 1); PG8_STAGE(PG8_SB(0, 0), b2, voffB);
            PG8_BAR; PG8_WAIT_L(0); PG8_MMA(0, 1, At, B1); PG8_BAR;
            PG8_LDA(At, 0, 1); PG8_STAGE(PG8_SA(0, 0), a2, voffA);
            PG8_BAR; PG8_WAIT_L(0); PG8_MMA(1, 0, At, B0); PG8_BAR; PG8_SCHED;
            PG8_STAGE(PG8_SB(0, 1), b2 + hstep, voffB);
            PG8_WAIT_V(6); PG8_BAR; PG8_MMA(1, 1, At, B1); PG8_BAR;
            PG8_LDB(B0, 1, 0); PG8_SCHED; PG8_LDA(At, 1, 0); PG8_STAGE(PG8_SA(0, 1), a2 + hstep, voffA);
            PG8_WAIT_L(8); PG8_BAR; PG8_WAIT_L(0); PG8_MMA(0, 0, At, B0); PG8_BAR; PG8_SCHED;
            PG8_LDB(B1, 1, 1); PG8_STAGE(PG8_SB(1, 0), b3, voffB);
            PG8_BAR; PG8_WAIT_L(0); PG8_MMA(0, 1, At, B1); PG8_BAR;
            PG8_LDA(At, 1, 1); PG8_STAGE(PG8_SA(1, 0), a3, voffA);
            PG8_BAR; PG8_WAIT_L(0); PG8_MMA(1, 0, At, B0); PG8_BAR; PG8_SCHED;
            PG8_STAGE(PG8_SB(1, 1), b3 + hstep, voffB);
            PG8_WAIT_V(6); PG8_BAR; PG8_MMA(1, 1, At, B1); PG8_BAR;
            }
        }
        if constexpr (ALIGN_EPI) { if (wr == 0) PG8_BAR; }
        if constexpr (!Epi::AFTER_DRAIN) { E(acc, cur, wr, wc, fr, fq); S.done(cur); }
        if (!has_next) break;
{ float zz1; asm volatile("v_mov_b32 %0, 0" : "=v"(zz1));
#pragma unroll
        for (int a = 0; a < 2; ++a)
#pragma unroll
            for (int b = 0; b < 2; ++b)
#pragma unroll
                for (int m = 0; m < 4; ++m)
#pragma unroll
                    for (int n = 0; n < 2; ++n) acc[a][b][m][n] = (f32x4){zz1, zz1, zz1, zz1}; }
        cur = nxt; cA = nA; cB = nB; ++ui;
        if constexpr (ALIGN_EPI) { if (wr == 1) PG8_BAR; }
    }
    PG8_WAIT_V(0);
    if constexpr (!ALIGN_EPI) { if (wr == 0) PG8_BAR; }
    PG8_BAR;
    if constexpr (Epi::AFTER_DRAIN) { E.fused(acc, cur, wr, wc, fr, fq, lds, wid, lane); S.done(cur); }
#undef PG8_SA
#undef PG8_SB
#undef PG8_STAGE
#undef PG8_LDA
#undef PG8_LDB
#undef PG8_MMA
#undef PG8_WAIT_V
#undef PG8_WAIT_L
#undef PG8_BAR
#undef PG8_SCHED
}
}
#define GAS __attribute__((address_space(1)))
#define LAS __attribute__((address_space(3)))
typedef unsigned short bf16;
typedef unsigned v4u __attribute__((ext_vector_type(4)));
typedef float f32x4 __attribute__((ext_vector_type(4)));
typedef short bf16x8 __attribute__((ext_vector_type(8)));
typedef GAS unsigned gu32;
typedef GAS unsigned long long gu64;
#define RLX_AGENT __ATOMIC_RELAXED, __HIP_MEMORY_SCOPE_AGENT
#define LDS_WAIT() asm volatile("s_waitcnt lgkmcnt(0)" ::: "memory")
#define VM_WAIT() asm volatile("s_waitcnt vmcnt(0)" ::: "memory")
__device__ __forceinline__ unsigned long long rt() { return __builtin_amdgcn_s_memrealtime(); }
__device__ __forceinline__ unsigned f2bf(float f) { unsigned u = __builtin_bit_cast(unsigned, f); return (u + 0x7fffu + ((u >> 16) & 1u)) >> 16; }
__device__ __forceinline__ unsigned pk2(float lo, float hi) { return f2bf(lo) | (f2bf(hi) << 16); }
#define XB_TMO      128
#define XB_XCNT(j)  (256  + 64 * (j))
#define XB_XSUB(j)  (1280 + 64 * (j))
#define XB_XGEN(j)  (2304 + 64 * (j))
#define XB_TOP      3328
#define XB_TOPGEN   3392
#define XCD_BAR_WORDS 3456
#define XB_SPIN_CAP (1u << 18)

__device__ __forceinline__ unsigned xb_ld(unsigned* p)              { return __hip_atomic_load(p, __ATOMIC_RELAXED, __HIP_MEMORY_SCOPE_AGENT); }
__device__ __forceinline__ unsigned xb_add(unsigned* p, unsigned v) { return __hip_atomic_fetch_add(p, v, __ATOMIC_RELAXED, __HIP_MEMORY_SCOPE_AGENT); }
__device__ __forceinline__ unsigned xb_xcc_id() { return (unsigned)__builtin_amdgcn_s_getreg((3 << 11) | 20) & 0xFu; }
#define XB_SPIN(cond, bar) do { unsigned _sp = 0; while (cond) { __builtin_amdgcn_s_sleep(1); \
    if ((++_sp & 255u) == 0u) { if (xb_ld(&(bar)[XB_TMO])) break; if (_sp > XB_SPIN_CAP) { atomicAdd(&(bar)[XB_TMO], 1u); break; } } } } while (0)

struct XcdBarrier {
    unsigned* bar; unsigned x;
    volatile LAS unsigned* st;
};

__device__ __forceinline__ XcdBarrier xcd_barrier_post(unsigned* bar, volatile LAS unsigned* st, int tid) {
    XcdBarrier b; b.bar = bar; b.x = xb_xcc_id(); b.st = st;
    if (tid == 0) (void)xb_add(&bar[XB_XCNT(b.x)], 1u);
    return b;
}
__device__ __forceinline__ void xcd_barrier_complete(unsigned* bar, unsigned x, unsigned& nloc, unsigned& nx) {
    const unsigned G = gridDim.x * gridDim.y * gridDim.z;
    unsigned sum, cnt, mine, sp = 0u;
    for (;;) {
        sum = 0u; cnt = 0u; mine = 0u;
#pragma unroll
        for (unsigned j = 0; j < 16; ++j) { const unsigned c = xb_ld(&bar[XB_XCNT(j)]); sum += c; cnt += (c > 0u) ? 1u : 0u; mine = (j == x) ? c : mine; }
        if (sum == G) break;
        __builtin_amdgcn_s_sleep(1);
        if ((++sp & 255u) == 0u) { if (xb_ld(&bar[XB_TMO])) break; if (sp > XB_SPIN_CAP) { atomicAdd(&bar[XB_TMO], 1u); break; } }
    }
    nloc = mine > 0u ? mine : 1u; nx = cnt > 0u ? cnt : 1u;
}

__device__ __forceinline__ void xcd_barrier(const XcdBarrier& b, int tid) {
    asm volatile("s_waitcnt vmcnt(0)" ::: "memory");
    __syncthreads();
    if (tid == 0) {
        unsigned* bar = b.bar;
        __builtin_amdgcn_s_waitcnt(0);
        unsigned nloc = b.st[0], nx = b.st[1];
        if (nloc == 0u) { xcd_barrier_complete(bar, b.x, nloc, nx); b.st[0] = nloc; b.st[1] = nx; }
        const unsigned old = xb_add(&bar[XB_XSUB(b.x)], 1u);
        const unsigned gen = old / nloc;
        if (old + 1u == (gen + 1u) * nloc) {
            __builtin_amdgcn_fence(__ATOMIC_RELEASE, "agent");
            asm volatile("s_waitcnt vmcnt(0)" ::: "memory");
            const unsigned og = xb_add(&bar[XB_TOP], 1u);
            const unsigned tg = og / nx;
            if (og + 1u == (tg + 1u) * nx) xb_add(&bar[XB_TOPGEN], 1u);
            else XB_SPIN(xb_ld(&bar[XB_TOPGEN]) == tg, bar);
            __builtin_amdgcn_fence(__ATOMIC_ACQUIRE, "agent");
            xb_add(&bar[XB_XGEN(b.x)], 1u);
            asm volatile("s_waitcnt vmcnt(0)" ::: "memory");
        } else {
            XB_SPIN(xb_ld(&bar[XB_XGEN(b.x)]) == gen, bar);
            __builtin_amdgcn_fence(__ATOMIC_ACQUIRE, "agent");
            asm volatile("s_waitcnt vmcnt(0)" ::: "memory");
        }
    }
    __syncthreads();
}

constexpr int NWAVES = 8, NTHR = 512;
constexpr int DM = 2048, FF = 5632, DEPTH = 4;
constexpr int TP = 16384, NSB = 16, TS = 32, M = TP + NSB * TS;
constexpr int RW = 1024, NH = 16, HN = 64, GMW = 1024, GH = 8, GHD = 128;
constexpr int C_W = 3072, C_A = 3136, C_G = 3200, SHIFT = 3360, INC = 5408;
constexpr int PLD = 3584;
constexpr int N3 = 5632;
constexpr int LK = 384;
constexpr int NL = 3072;
constexpr float ALPHA = 1.6817928305074292f;
constexpr float LN_EPS = 1e-5f, GN_EPS = 64e-5f;
constexpr int NPHASE = 15;

constexpr size_t O_YP = 0, O_SP = 34603008, O_SHP = 34865152, O_SS = 34878592, O_SHS = 39072896, O_GV = 39287936, O_END = 41385088;

constexpr size_t MiB = 1u << 20;
constexpr size_t WS_CTL = 0, CTL_ZERO_BYTES = 1 * MiB;
constexpr size_t WS_X = 1 * MiB;
constexpr size_t WS_Z = 133 * MiB;
constexpr size_t WS_XB = 265 * MiB;
constexpr size_t WS_W = 331 * MiB;
constexpr size_t W_1 = WS_W, W_2 = W_1 + 44 * MiB, W_3 = W_2 + 22 * MiB, W_4 = W_3 + 22 * MiB, W_5 = W_4 + 8 * MiB, W_6 = W_5 + 44 * MiB, W_3B = W_6 + 22 * MiB;
constexpr size_t WS_BIG = 496 * MiB;
constexpr size_t B_H = WS_BIG, B_P = WS_BIG, B_U = WS_BIG + 231 * MiB, B_GV = B_U + 33 * MiB, B_A3B = B_GV + 66 * MiB;
constexpr size_t B_Y = WS_BIG, B_MIX = WS_BIG + 66 * MiB;
constexpr size_t WS_RW = 839 * MiB;
constexpr size_t RWSZ = 66 * MiB;
constexpr size_t WS_END = WS_RW + 8 * RWSZ;
static_assert(W_3B + (size_t)NL * LK * 2 <= WS_BIG && B_A3B + (size_t)M * LK * 2 <= WS_RW, "ws map");
static_assert((size_t)M * DM * 4 == 132 * MiB && (size_t)M * PLD * 4 == 231 * MiB && (size_t)M * 1024 * 4 == 66 * MiB, "ws sizes");
constexpr int CW_TMO = 0, CW_CODE = 1, CW_BAR = 4096;

constexpr int RING_OFF = 0, RING_BYTES = 131072;
constexpr int LDSCTL_OFF = RING_BYTES, MISC_OFF = LDSCTL_OFF + 320;
constexpr int LDS_BYTES = 147456;

struct Args { const float* in[29]; float* out; unsigned char* ws; int l_lo, l_hi; };
#define KOUT() ((float*)karg_ptr<232>())
#define KWS() ((unsigned char*)karg_ptr<240>())
enum InIdx { I_XP = 0, I_XS, I_SRW, I_SSH, I_F1G, I_F1U, I_F1D, I_WIN, I_MU, I_W0, I_WUP, I_A0, I_AUP, I_GUP, I_KK, I_KA, I_RK, I_GNG, I_GNB, I_GLG, I_GLB, I_GWS, I_GBS, I_WOUT, I_F2G, I_F2U, I_F2D, I_LNG, I_LNB };


template <int OFF> __device__ __forceinline__ const float* karg_ptr() {
    const unsigned long long kp = (unsigned long long)__builtin_amdgcn_kernarg_segment_ptr(); unsigned long long v;
    asm volatile("s_load_dwordx2 %0, %1, %2\n\ts_waitcnt lgkmcnt(0)" : "=s"(v) : "s"(kp), "i"(OFF) : "memory");
    return (const float*)v;
}
#define KIN(i) karg_ptr<8 * (i)>()
template <int CTRL> __device__ __forceinline__ float dpp_mov(float x) { return __builtin_bit_cast(float, __builtin_amdgcn_mov_dpp(__builtin_bit_cast(int, x), CTRL, 0xf, 0xf, true)); }
__device__ __forceinline__ float row16_sum(float x) { x += dpp_mov<0x128>(x); x += dpp_mov<0x124>(x); x += dpp_mov<0x122>(x); x += dpp_mov<0x121>(x); return x; }
__device__ __forceinline__ float wave_sum(float v) {
    v = row16_sum(v); const int i = __builtin_bit_cast(int, v);
    const float a = __builtin_bit_cast(float, __builtin_amdgcn_readlane(i, 0)), b = __builtin_bit_cast(float, __builtin_amdgcn_readlane(i, 16)), c = __builtin_bit_cast(float, __builtin_amdgcn_readlane(i, 32)), d = __builtin_bit_cast(float, __builtin_amdgcn_readlane(i, 48));
    return (a + b) + (c + d);
}

__device__ __forceinline__ void transpose_item(const float* W, int K, int N, bf16* WT, int dst_row0, int k0, int n0, LAS float* scr, int lane) {
#pragma unroll 8
    for (int i = 0; i < 32; ++i) { const int kk = 2 * i + (lane >> 5); scr[kk * 33 + (lane & 31)] = W[(size_t)(k0 + kk) * N + n0 + (lane & 31)]; }
    LDS_WAIT(); asm volatile("" ::: "memory");
    const int c = lane & 7;
#pragma unroll
    for (int j = 0; j < 4; ++j) { const int n = (lane >> 3) + 8 * j; const LAS float* s = scr + (8 * c) * 33 + n;
        v4u o; o.x = pk2(s[0 * 33], s[1 * 33]); o.y = pk2(s[2 * 33], s[3 * 33]); o.z = pk2(s[4 * 33], s[5 * 33]); o.w = pk2(s[6 * 33], s[7 * 33]);
        *(v4u*)(WT + (size_t)(dst_row0 + n) * K + k0 + 8 * c) = o; }
    LDS_WAIT(); asm volatile("" ::: "memory");
}

__device__ __forceinline__ void phase_convert(int l, LAS unsigned char* lds, int wave, int lane, int gw, int NGW) {
    unsigned char* ws = KWS();
    LAS float* scr = (LAS float*)(lds + RING_OFF + wave * 16384);
    const size_t so = (size_t)l * DM * FF;
    const float *f1g = KIN(I_F1G) + so, *f1u = KIN(I_F1U) + so, *f1d = KIN(I_F1D) + so, *f2g = KIN(I_F2G) + so, *f2u = KIN(I_F2U) + so, *f2d = KIN(I_F2D) + so;
    const float* win = KIN(I_WIN) + (size_t)l * DM * INC; const float* wout = KIN(I_WOUT) + (size_t)l * DM * DM;
    constexpr int I_GU = (DM / 64) * (FF / 32);
    constexpr int I_D = (FF / 64) * (DM / 32);
    constexpr int I_IN = (DM / 64) * (INC / 32);
    constexpr int I_O = (DM / 64) * (DM / 32);
    constexpr int NITEMS = 4 * I_GU + 2 * I_D + I_IN + I_O;
    for (int it = gw; it < NITEMS; it += NGW) {
        int r = it;
        if (r < 4 * I_GU) { const int which = r / I_GU; r -= which * I_GU; const int nblk = FF / 32, kb = r / nblk, nb = r % nblk, n0 = 32 * nb;
            const float* W = which == 0 ? f1g : (which == 1 ? f1u : (which == 2 ? f2g : f2u));
            bf16* WT = (bf16*)(ws + (which < 2 ? W_1 : W_5));
            transpose_item(W, DM, FF, WT, 256 * (n0 / 128) + (n0 % 128) + ((which & 1) ? 128 : 0), 64 * kb, n0, scr, lane); continue; }
        r -= 4 * I_GU;
        if (r < 2 * I_D) { const int which = r / I_D; r -= which * I_D; const int nblk = DM / 32, kb = r / nblk, nb = r % nblk;
            transpose_item(which == 0 ? f1d : f2d, FF, DM, (bf16*)(ws + (which == 0 ? W_2 : W_6)), 32 * nb, 64 * kb, 32 * nb, scr, lane); continue; }
        r -= 2 * I_D;
        if (r < I_IN) { const int nblk = INC / 32, kb = r / nblk, nb = r % nblk, n0 = 32 * nb;
            transpose_item(win, DM, INC, (bf16*)(ws + W_3), n0 < SHIFT ? n0 : n0 + (PLD - SHIFT), 64 * kb, n0, scr, lane); continue; }
        r -= I_IN;
        { const int nblk = DM / 32, kb = r / nblk, nb = r % nblk; transpose_item(wout, DM, DM, (bf16*)(ws + W_4), 32 * nb, 64 * kb, 32 * nb, scr, lane); }
    }
    { v4u* z = (v4u*)(ws + W_3 + (size_t)SHIFT * DM * 2); const int nz = (PLD - SHIFT) * DM * 2 / 16;
      unsigned z0; asm volatile("v_mov_b32 %0, 0" : "=v"(z0));
      for (int i = gw * 64 + lane; i < nz; i += NGW * 64) z[i] = (v4u){z0, z0, z0, z0}; }
    { bf16* WT = (bf16*)(ws + W_3B); const float* wup = KIN(I_WUP) + (size_t)l * 64 * RW; const float* aup = KIN(I_AUP) + (size_t)l * 64 * RW; const float* gup = KIN(I_GUP) + (size_t)l * 160 * RW;
      for (int i = gw * 64 + lane; i < NL * LK; i += NGW * 64) { const int n = i / LK, k = i % LK, kind = n >> 10, c = n & 1023; float v = 0.f;
          if (kind == 0) { if (k < 64) v = wup[(size_t)k * RW + c]; } else if (kind == 1) { if (k >= 64 && k < 128) v = aup[(size_t)(k - 64) * RW + c]; } else { if (k >= 128 && k < 288) v = gup[(size_t)(k - 128) * RW + c]; }
          WT[i] = (bf16)f2bf(v); } }
    if (l == 0) {
        float* X = (float*)(ws + WS_X); bf16* XB = (bf16*)(ws + WS_XB); const float* xp = KIN(I_XP); const float* xs = KIN(I_XS);
        for (int m = gw; m < M; m += NGW) { const float* src = m < TP ? xp + (size_t)m * DM : xs + (size_t)(m - TP) * DM;
            const f32x4* s4 = (const f32x4*)src + lane; f32x4* d4 = (f32x4*)(X + (size_t)m * DM) + lane; unsigned long long* o8 = (unsigned long long*)(XB + (size_t)m * DM) + lane;
#pragma unroll
            for (int j = 0; j < 8; ++j) { const f32x4 v = s4[64 * j]; d4[64 * j] = v; o8[64 * j] = (unsigned long long)pk2(v.x, v.y) | ((unsigned long long)pk2(v.z, v.w) << 32); } }
    }
}

__device__ __forceinline__ void phase_ln(const float* Z, const float* g, const float* b, float* Xo, bf16* XBo, int lane, int gw, int NGW) {
    for (int m = gw; m < M; m += NGW) {
        const f32x4* zr = (const f32x4*)(Z + (size_t)m * DM) + lane; f32x4 v[8]; float s = 0.f;
#pragma unroll
        for (int j = 0; j < 8; ++j) { v[j] = zr[64 * j]; s += (v[j].x + v[j].y) + (v[j].z + v[j].w); }
        const float mean = wave_sum(s) * (1.f / DM); float s2 = 0.f;
#pragma unroll
        for (int j = 0; j < 8; ++j) { v[j] = v[j] - mean; s2 += (v[j].x * v[j].x + v[j].y * v[j].y) + (v[j].z * v[j].z + v[j].w * v[j].w); }
        const float rstd = 1.f / sqrtf(wave_sum(s2) * (1.f / DM) + LN_EPS);
        f32x4* xo = (f32x4*)(Xo + (size_t)m * DM) + lane;
#pragma unroll
        for (int j = 0; j < 8; ++j) { const f32x4 gg = ((const f32x4*)g)[lane + 64 * j], bb = ((const f32x4*)b)[lane + 64 * j]; const f32x4 o = v[j] * rstd * gg + bb; xo[64 * j] = o;
            if (XBo) ((unsigned long long*)(XBo + (size_t)m * DM) + lane)[64 * j] = (unsigned long long)pk2(o.x, o.y) | ((unsigned long long)pk2(o.z, o.w) << 32); }
    }
}

__device__ __forceinline__ const float* prev_row(const float* ssh, int l, const float* P, int m) {
    if (m < TP) return m == 0 ? nullptr : P + (size_t)(m - 1) * PLD;
    const int b = (m - TP) >> 5, t = (m - TP) & 31;
    return t == 0 ? ssh + (size_t)(l * NSB + b) * SHIFT : P + (size_t)(m - 1) * PLD;
}

__device__ __forceinline__ void phase_prep1(int l, int lane, int gw, int NGW) {
    unsigned char* ws = KWS(); float* outp = KOUT(); const float* P = (const float*)(ws + B_P); float* GV = (float*)(ws + B_GV); bf16* A3B = (bf16*)(ws + B_A3B);
    const float* mu = KIN(I_MU) + (size_t)l * SHIFT; const float* lg = KIN(I_GLG) + (size_t)l * GMW; const float* lb = KIN(I_GLB) + (size_t)l * GMW;
    const float* ssh = KIN(I_SSH);
    for (int m = gw; m < M; m += NGW) {
        const float* pr = P + (size_t)m * PLD; const float* pp = prev_row(ssh, l, P, m);
#pragma unroll
        for (int jj = 0; jj < 6; ++jj) { const int j = jj * 64 + lane; float v = 0.f;
            if (j < 288) { const int c = C_W + j; const float p = pr[c], q = pp ? pp[c] : 0.f; const float xs = p + (q - p) * mu[c];
                if (j < 64) { const float t = __expf(-2.f * fabsf(xs)); const float r = (1.f - t) / (1.f + t); v = xs < 0.f ? -r : r; }
                else if (j < 128) v = xs;
                else v = 1.f / (1.f + __expf(-xs)); }
            A3B[(size_t)m * LK + j] = (bf16)f2bf(v); }
        { f32x4* vr = (f32x4*)(GV + (size_t)m * GMW) + lane; f32x4 v[4]; float s = 0.f;
#pragma unroll
          for (int j = 0; j < 4; ++j) { v[j] = vr[64 * j]; s += (v[j].x + v[j].y) + (v[j].z + v[j].w); }
          const float mean = wave_sum(s) * (1.f / GMW); float s2 = 0.f;
#pragma unroll
          for (int j = 0; j < 4; ++j) { v[j] = v[j] - mean; s2 += (v[j].x * v[j].x + v[j].y * v[j].y) + (v[j].z * v[j].z + v[j].w * v[j].w); }
          const float rstd = 1.f / sqrtf(wave_sum(s2) * (1.f / GMW) + LN_EPS);
          f32x4* go = nullptr; if (m >= TP) go = (f32x4*)(outp + O_GV + ((size_t)l * NSB * TS + (m - TP)) * GMW) + lane;
#pragma unroll
          for (int j = 0; j < 4; ++j) { const f32x4 o = v[j] * rstd * ((const f32x4*)lg)[lane + 64 * j] + ((const f32x4*)lb)[lane + 64 * j]; vr[64 * j] = o; if (go) go[64 * j] = o; } }
        if (m == TP - 1) { float* o = outp + O_SHP + (size_t)l * SHIFT; for (int c = lane; c < SHIFT; c += 64) o[c] = pr[c]; }
        if (m >= TP && ((m - TP) & 31) == 31) { float* o = outp + O_SHS + (size_t)(l * NSB + ((m - TP) >> 5)) * SHIFT; for (int c = lane; c < SHIFT; c += 64) o[c] = pr[c]; }
    }
}

__device__ __forceinline__ void phase_prep2(int l, int lane, int gw, int NGW) {
    unsigned char* ws = KWS(); const float* P = (const float*)(ws + B_P);
    float* Wd = (float*)(ws + WS_RW); const float* Aa = (const float*)(ws + WS_RW + 1 * RWSZ);
    float *R = (float*)(ws + WS_RW + 3 * RWSZ), *Kp = (float*)(ws + WS_RW + 4 * RWSZ), *V = (float*)(ws + WS_RW + 5 * RWSZ), *KK = (float*)(ws + WS_RW + 6 * RWSZ), *Bb = (float*)(ws + WS_RW + 7 * RWSZ);
    const float* mu = KIN(I_MU) + (size_t)l * SHIFT; const float* kkw = KIN(I_KK) + (size_t)l * RW; const float* kaw = KIN(I_KA) + (size_t)l * RW;
    const float* w0 = KIN(I_W0) + (size_t)l * RW; const float* a0 = KIN(I_A0) + (size_t)l * RW;
    const float* ssh = KIN(I_SSH);
    for (int m = gw; m < M; m += NGW) {
        const float* pr = P + (size_t)m * PLD; const float* pp = prev_row(ssh, l, P, m); const size_t ro = (size_t)m * RW;
#pragma unroll 4
        for (int h = 0; h < NH; ++h) { const int c = h * HN + lane;
            const float p_r = pr[c], p_k = pr[RW + c], p_v = pr[2 * RW + c];
            const float q_r = pp ? pp[c] : 0.f, q_k = pp ? pp[RW + c] : 0.f, q_v = pp ? pp[2 * RW + c] : 0.f;
            const float r = p_r + (q_r - p_r) * mu[c], k = p_k + (q_k - p_k) * mu[RW + c], v = p_v + (q_v - p_v) * mu[2 * RW + c];
            const float av = 1.f / (1.f + __expf(-(a0[c] + Aa[ro + c])));
            { const float y = -(w0[c] + Wd[ro + c]); const float sp = fmaxf(y, 0.f) + __logf(1.0f + __expf(-fabsf(y))); Wd[ro + c] = __expf(-__expf(-sp - 0.5f)); }
            const float kkv = k * kkw[c]; const float n2 = wave_sum(kkv * kkv); const float kk = kkv / fmaxf(sqrtf(n2), 1e-12f);
            R[ro + c] = r; Kp[ro + c] = k * (1.f + (av - 1.f) * kaw[c]); V[ro + c] = v; KK[ro + c] = kk; Bb[ro + c] = kk * av; }
    }
}

__device__ __forceinline__ void scan_unit(int l, LAS unsigned char* lds, int unit, int tid) {
    unsigned char* ws = KWS();
    const float *Wd = (const float*)(ws + WS_RW), *R = (const float*)(ws + WS_RW + 3 * RWSZ), *Kp = (const float*)(ws + WS_RW + 4 * RWSZ), *V = (const float*)(ws + WS_RW + 5 * RWSZ), *KK = (const float*)(ws + WS_RW + 6 * RWSZ), *Bb = (const float*)(ws + WS_RW + 7 * RWSZ);
    float* Y = (float*)(ws + B_Y); float* outp = KOUT(); const float* srw = KIN(I_SRW);
    int m0, T, h, half; const float* s0; float* sout;
    if (unit < 32) { h = unit >> 1; half = unit & 1; m0 = 0; T = TP; s0 = nullptr; sout = outp + O_SP + ((size_t)l * NH + h) * 4096; }
    else { const int u2 = unit - 32, b = u2 >> 5; h = (u2 >> 1) & 15; half = u2 & 1; m0 = TP + b * TS; T = TS;
        s0 = srw + (((size_t)l * NSB + b) * NH + h) * 4096; sout = outp + O_SS + (((size_t)l * NSB + b) * NH + h) * 4096; }
    const int i = tid >> 4, q = tid & 15, vi = half * 32 + i;
    float zs; asm volatile("v_mov_b32 %0, 0" : "=v"(zs));
    f32x4 S = (f32x4){zs, zs, zs, zs}; if (s0) S = *(const f32x4*)(s0 + vi * 64 + 4 * q);
    LAS f32x4* Lw = (LAS f32x4*)(lds); LAS f32x4* Lkk = Lw + 1024; LAS f32x4* Lb = Lw + 2048; LAS f32x4* Lk = Lw + 3072; LAS f32x4* Lr = Lw + 4096; LAS float* Lv = (LAS float*)(Lw + 5120);
    for (int t0 = 0; t0 < T; t0 += 64) {
        const int nb = (T - t0) < 64 ? (T - t0) : 64;
        __syncthreads();
        for (int idx = tid; idx < nb * 16; idx += NTHR) { const int tok = idx >> 4, c4 = idx & 15; const size_t go = (size_t)(m0 + t0 + tok) * RW + h * HN + 4 * c4;
            Lw[idx] = *(const f32x4*)(Wd + go); Lkk[idx] = *(const f32x4*)(KK + go); Lb[idx] = *(const f32x4*)(Bb + go); Lk[idx] = *(const f32x4*)(Kp + go); Lr[idx] = *(const f32x4*)(R + go); }
        for (int idx = tid; idx < nb * 32; idx += NTHR) { const int tok = idx >> 5, i2 = idx & 31; Lv[idx] = V[(size_t)(m0 + t0 + tok) * RW + h * HN + half * 32 + i2]; }
        __syncthreads();
        for (int tt = 0; tt < nb; ++tt) {
            const f32x4 w4 = Lw[tt * 16 + q], kk4 = Lkk[tt * 16 + q], b4 = Lb[tt * 16 + q], k4 = Lk[tt * 16 + q], r4 = Lr[tt * 16 + q]; const float vv = Lv[tt * 32 + i];
            const float sa = -row16_sum((S.x * kk4.x + S.y * kk4.y) + (S.z * kk4.z + S.w * kk4.w));
            S = S * w4 + b4 * sa + k4 * vv;
            const float y = row16_sum((S.x * r4.x + S.y * r4.y) + (S.z * r4.z + S.w * r4.w));
            if (q == 0) Y[(size_t)(m0 + t0 + tt) * RW + h * HN + vi] = y;
        }
    }
    *(f32x4*)(sout + vi * 64 + 4 * q) = S;
}

__device__ __forceinline__ void gmlp_unit(int l, LAS unsigned char* lds, int unit, int tid) {
    unsigned char* ws = KWS(); const float* VN = (const float*)(ws + B_GV); const bf16* U = (const bf16*)(ws + B_U); bf16* MIXB = (bf16*)(ws + B_MIX);
    const int ci = unit >> 3, h = unit & 7; int row0, nr; if (ci < 128) { row0 = 128 * ci; nr = 128; } else { row0 = TP + 32 * (ci - 128); nr = 32; }
    const float* wsm = KIN(I_GWS) + ((size_t)l * GH + h) * 128 * 128; const float* bs = KIN(I_GBS) + ((size_t)l * GH + h) * 128;
    LAS f32x4* Lws = (LAS f32x4*)lds; LAS f32x4* Lv = Lws + 4096;
    __syncthreads();
    for (int idx = tid; idx < nr * 32; idx += NTHR) { const int r = idx >> 5, c4 = idx & 31; Lws[idx] = *(const f32x4*)(wsm + r * 128 + 4 * c4); Lv[idx] = *(const f32x4*)(VN + (size_t)(row0 + r) * GMW + h * GHD + 4 * c4); }
    __syncthreads();
    const int rg = tid >> 4, cg = tid & 15;
    if (4 * rg < nr) {
        f32x4 acc[4][2];
#pragma unroll
        for (int r = 0; r < 4; ++r) { const float b0 = bs[4 * rg + r]; acc[r][0] = (f32x4){b0, b0, b0, b0}; acc[r][1] = acc[r][0]; }
        const LAS float* Lwf = (const LAS float*)Lws;
        for (int j = 0; j < 4 * rg + 4; ++j) { const f32x4 v0 = Lv[j * 32 + 2 * cg], v1 = Lv[j * 32 + 2 * cg + 1];
#pragma unroll
            for (int r = 0; r < 4; ++r) { const float w = (j <= 4 * rg + r) ? Lwf[(4 * rg + r) * 128 + j] : 0.f; acc[r][0] += v0 * w; acc[r][1] += v1 * w; } }
#pragma unroll
        for (int r = 0; r < 4; ++r) { const size_t row = (size_t)(row0 + 4 * rg + r); const v4u uu = *(const v4u*)(U + row * GMW + h * GHD + 8 * cg);
            const float u0 = __builtin_bit_cast(float, uu.x << 16), u1 = __builtin_bit_cast(float, uu.x & 0xffff0000u), u2 = __builtin_bit_cast(float, uu.y << 16), u3 = __builtin_bit_cast(float, uu.y & 0xffff0000u);
            const float u4 = __builtin_bit_cast(float, uu.z << 16), u5 = __builtin_bit_cast(float, uu.z & 0xffff0000u), u6 = __builtin_bit_cast(float, uu.w << 16), u7 = __builtin_bit_cast(float, uu.w & 0xffff0000u);
            v4u o; o.x = pk2(u0 * acc[r][0].x, u1 * acc[r][0].y); o.y = pk2(u2 * acc[r][0].z, u3 * acc[r][0].w); o.z = pk2(u4 * acc[r][1].x, u5 * acc[r][1].y); o.w = pk2(u6 * acc[r][1].z, u7 * acc[r][1].w);
            *(v4u*)(MIXB + row * DM + RW + h * GHD + 8 * cg) = o; }
    }
}

__device__ __forceinline__ void phase_post(int l, int lane, int gw, int NGW) {
    unsigned char* ws = KWS(); const float* Y = (const float*)(ws + B_Y); bf16* MIXB = (bf16*)(ws + B_MIX);
    const float *Gg = (const float*)(ws + WS_RW + 2 * RWSZ), *R = (const float*)(ws + WS_RW + 3 * RWSZ), *Kp = (const float*)(ws + WS_RW + 4 * RWSZ), *V = (const float*)(ws + WS_RW + 5 * RWSZ);
    const float* rk = KIN(I_RK) + (size_t)l * RW; const float* gg = KIN(I_GNG) + (size_t)l * RW; const float* gb = KIN(I_GNB) + (size_t)l * RW;
    for (int m = gw; m < M; m += NGW) { const size_t ro = (size_t)m * RW;
#pragma unroll 4
        for (int h = 0; h < NH; ++h) { const int c = h * HN + lane;
            const float y = Y[ro + c]; const float ym = wave_sum(y) * (1.f / HN); const float d = y - ym; const float yv = wave_sum(d * d) * (1.f / HN);
            const float yn = d * (1.f / sqrtf(yv + GN_EPS)) * gg[c] + gb[c];
            const float s = wave_sum(R[ro + c] * Kp[ro + c] * rk[c]);
            MIXB[(size_t)m * DM + c] = (bf16)f2bf((yn + s * V[ro + c]) * Gg[ro + c]); }
    }
}

template <int PH> __global__ void __launch_bounds__(NTHR, 2) mk_fwd(Args a) {
    extern __shared__ __attribute__((aligned(16))) unsigned char lds_raw[];
    LAS unsigned char* lds = (LAS unsigned char*)lds_raw;
    const int wave_s = __builtin_amdgcn_readfirstlane((int)threadIdx.x >> 6);
    for (int u = threadIdx.x; u < (LDS_BYTES - LDSCTL_OFF) / 4; u += NTHR) ((LAS unsigned*)(lds + LDSCTL_OFF))[u] = 0u;
    __syncthreads();
    if (PH < 0) (void)xcd_barrier_post((unsigned*)KWS() + CW_BAR, (volatile LAS unsigned*)(lds + MISC_OFF) + 8, (int)threadIdx.x);
#define IN(k) (PH < 0 || PH == (k))
#define PHASE_IDS() int tid_; asm volatile("v_mbcnt_lo_u32_b32 %0, -1, 0\n\tv_mbcnt_hi_u32_b32 %0, -1, %0\n\tv_lshl_add_u32 %0, %1, 6, %0" : "=&v"(tid_) : "s"(wave_s)); const int tid = tid_, lane = tid & 63, wave = wave_s; \
    const int G = gridDim.x, bx = blockIdx.x, vcu = (G % 8 == 0) ? (bx % 8) * (G / 8) + bx / 8 : bx, gw = vcu * NWAVES + wave, NGW = G * NWAVES; unsigned char* ws = KWS(); (void)tid; (void)lane; (void)gw; (void)NGW; (void)ws
#define SEAM() do { if (PH < 0) { XcdBarrier bar_; bar_.bar = (unsigned*)KWS() + CW_BAR; bar_.x = xb_xcc_id(); bar_.st = (volatile LAS unsigned*)(lds + MISC_OFF) + 8; xcd_barrier(bar_, tid); } } while (0)

    for (int l = a.l_lo; l < a.l_hi; ++l) {
        if (IN(0)) { PHASE_IDS(); phase_convert(l, lds, wave, lane, gw, NGW); SEAM(); }
        if (IN(1)) { PHASE_IDS(); pg8::Gemm g{(const bf16*)(ws + WS_XB), (const bf16*)(ws + W_1), M, 2 * FF, DM}; pg8::StaticOrder S; S.init(M, 2 * FF, G, bx); pg8::EpiSwiGLU E{(bf16*)(ws + B_H), FF};
            pg8::gemm_phase<pg8::EpiSwiGLU, pg8::StaticOrder, true, true>(lds + RING_OFF, g, S, E, tid); SEAM(); }
        if (IN(2)) { PHASE_IDS(); pg8::Gemm g{(const bf16*)(ws + B_H), (const bf16*)(ws + W_2), M, DM, FF}; pg8::StaticOrder S; S.init(M, DM, G, bx); pg8::EpiResid E{(const float*)(ws + WS_X), (float*)(ws + WS_Z), DM, ALPHA, 0.5f};
            pg8::gemm_phase<pg8::EpiResid, pg8::StaticOrder, true, true>(lds + RING_OFF, g, S, E, tid); SEAM(); }
        if (IN(3)) { PHASE_IDS(); phase_ln((const float*)(ws + WS_Z), KIN(I_LNG) + (size_t)l * 3 * DM, KIN(I_LNB) + (size_t)l * 3 * DM, (float*)(ws + WS_X), (bf16*)(ws + WS_XB), lane, gw, NGW); SEAM(); }
        if (IN(4)) { PHASE_IDS(); pg8::Gemm g{(const bf16*)(ws + WS_XB), (const bf16*)(ws + W_3), M, N3, DM}; pg8::StaticOrder S; S.init(M, N3, G, bx); pg8::EpiP E{(float*)(ws + B_P), (bf16*)(ws + B_U), (float*)(ws + B_GV)};
            pg8::gemm_phase<pg8::EpiP, pg8::StaticOrder, true, true>(lds + RING_OFF, g, S, E, tid); SEAM(); }
        if (IN(5)) { PHASE_IDS(); phase_prep1(l, lane, gw, NGW); SEAM(); }
        if (IN(6)) { PHASE_IDS(); pg8::Gemm g{(const bf16*)(ws + B_A3B), (const bf16*)(ws + W_3B), M, NL, LK}; pg8::StaticOrder S; S.init(M, NL, G, bx);
            pg8::EpiLora E{(float*)(ws + WS_RW)};
            pg8::gemm_phase<pg8::EpiLora, pg8::StaticOrder, false, false>(lds + RING_OFF, g, S, E, tid); SEAM(); }
        if (IN(7)) { PHASE_IDS(); phase_prep2(l, lane, gw, NGW); SEAM(); }
        if (IN(8)) { PHASE_IDS();
            { const int step = bx < 32 ? (1 << 20) : (G - 32); for (int u = bx; u < 32 + 512; u += step) scan_unit(l, lds, u, tid); }
            if (bx >= 32) for (int u = bx - 32; u < 144 * 8; u += G - 32) gmlp_unit(l, lds, u, tid);
            SEAM(); }
        if (IN(9)) { PHASE_IDS(); phase_post(l, lane, gw, NGW); SEAM(); }
        if (IN(10)) { PHASE_IDS(); pg8::Gemm g{(const bf16*)(ws + B_MIX), (const bf16*)(ws + W_4), M, DM, DM}; pg8::StaticOrder S; S.init(M, DM, G, bx); pg8::EpiResid E{(const float*)(ws + WS_X), (float*)(ws + WS_Z), DM, ALPHA, 1.0f};
            pg8::gemm_phase<pg8::EpiResid, pg8::StaticOrder, true, true>(lds + RING_OFF, g, S, E, tid); SEAM(); }
        if (IN(11)) { PHASE_IDS(); phase_ln((const float*)(ws + WS_Z), KIN(I_LNG) + (size_t)(l * 3 + 1) * DM, KIN(I_LNB) + (size_t)(l * 3 + 1) * DM, (float*)(ws + WS_X), (bf16*)(ws + WS_XB), lane, gw, NGW); SEAM(); }
        if (IN(12)) { PHASE_IDS(); pg8::Gemm g{(const bf16*)(ws + WS_XB), (const bf16*)(ws + W_5), M, 2 * FF, DM}; pg8::StaticOrder S; S.init(M, 2 * FF, G, bx); pg8::EpiSwiGLU E{(bf16*)(ws + B_H), FF};
            pg8::gemm_phase<pg8::EpiSwiGLU, pg8::StaticOrder, true, true>(lds + RING_OFF, g, S, E, tid); SEAM(); }
        if (IN(13)) { PHASE_IDS(); pg8::Gemm g{(const bf16*)(ws + B_H), (const bf16*)(ws + W_6), M, DM, FF}; pg8::StaticOrder S; S.init(M, DM, G, bx); pg8::EpiResid E{(const float*)(ws + WS_X), (float*)(ws + WS_Z), DM, ALPHA, 0.5f};
            pg8::gemm_phase<pg8::EpiResid, pg8::StaticOrder, true, true>(lds + RING_OFF, g, S, E, tid); SEAM(); }
        if (IN(14)) { PHASE_IDS(); const bool last = (l == DEPTH - 1);
            phase_ln((const float*)(ws + WS_Z), KIN(I_LNG) + (size_t)(l * 3 + 2) * DM, KIN(I_LNB) + (size_t)(l * 3 + 2) * DM, last ? KOUT() + O_YP : (float*)(ws + WS_X), last ? (bf16*)nullptr : (bf16*)(ws + WS_XB), lane, gw, NGW);
            if (!last) SEAM(); }
    }
#undef IN
#undef SEAM
#undef PHASE_IDS
}

template <int PH> static bool prep_kernel() { return hipFuncSetAttribute((const void*)mk_fwd<PH>, hipFuncAttributeMaxDynamicSharedMemorySize, LDS_BYTES) == hipSuccess; }
template <int PH> static void launch_phase(int grid, hipStream_t stream, Args a) { hipLaunchKernelGGL(mk_fwd<PH>, dim3(grid), dim3(NTHR), LDS_BYTES, stream, a); }
extern "C" void kernel_launch(void* const* d_in, const int* in_sizes, int n_in, void* d_out, int out_size, void* d_ws, size_t ws_size, hipStream_t stream) {
    static int grid = 0;
    if (grid == 0) {
        if (n_in != 29 || (size_t)out_size != O_END || ws_size < WS_END) { fprintf(stderr, "kernel_launch: unexpected shapes: n_in %d out %d ws %zu (need %zu)\n", n_in, out_size, ws_size, (size_t)WS_END); grid = -1; return; }
        int dev = 0, cus = 0, per_cu = 0;
        if (hipGetDevice(&dev) != hipSuccess || hipDeviceGetAttribute(&cus, hipDeviceAttributeMultiprocessorCount, dev) != hipSuccess) { grid = -1; return; }
        bool ok = true;
#if MK_ONE_LAUNCH
        ok = prep_kernel<-1>();
        if (hipOccupancyMaxActiveBlocksPerMultiprocessor(&per_cu, (const void*)mk_fwd<-1>, NTHR, LDS_BYTES) != hipSuccess || per_cu < 1) fprintf(stderr, "kernel_launch: occupancy query says %d\n", per_cu);
#else
        ok = prep_kernel<0>() && prep_kernel<1>() && prep_kernel<2>() && prep_kernel<3>() && prep_kernel<4>() && prep_kernel<5>() && prep_kernel<6>() && prep_kernel<7>() && prep_kernel<8>() && prep_kernel<9>() && prep_kernel<10>() && prep_kernel<11>() && prep_kernel<12>() && prep_kernel<13>() && prep_kernel<14>();
#endif
        if (!ok) { fprintf(stderr, "kernel_launch: hipFuncSetAttribute failed\n"); grid = -1; return; }
        (void)hipGetLastError();
        grid = cus;
        if (grid < 64) { grid = -1; return; }
    }
    if (grid < 0) return;
    (void)hipMemsetAsync((char*)d_ws + WS_CTL, 0, CTL_ZERO_BYTES, stream);
    Args a{};
    for (int i = 0; i < 29; ++i) a.in[i] = (const float*)d_in[i];
    a.out = (float*)d_out; a.ws = (unsigned char*)d_ws;
#if MK_ONE_LAUNCH
    a.l_lo = 0; a.l_hi = DEPTH;
    launch_phase<-1>(grid, stream, a);
#else
    for (int l = 0; l < DEPTH; ++l) { a.l_lo = l; a.l_hi = l + 1;
        launch_phase<0>(grid, stream, a); launch_phase<1>(grid, stream, a); launch_phase<2>(grid, stream, a); launch_phase<3>(grid, stream, a); launch_phase<4>(grid, stream, a);
        launch_phase<5>(grid, stream, a); launch_phase<6>(grid, stream, a); launch_phase<7>(grid, stream, a); launch_phase<8>(grid, stream, a); launch_phase<9>(grid, stream, a);
        launch_phase<10>(grid, stream, a); launch_phase<11>(grid, stream, a); launch_phase<12>(grid, stream, a); launch_phase<13>(grid, stream, a); launch_phase<14>(grid, stream, a); }
#endif
}
```

```cpp
#include <hip/hip_runtime.h>
#include <cstdio>
#include <cstdint>
#define MK_ONE_LAUNCH 1
namespace pg8 {
#define PG8_LAS __attribute__((address_space(3)))
typedef unsigned short bf16_t;
typedef short bf16x8 __attribute__((ext_vector_type(8)));
typedef float f32x4 __attribute__((ext_vector_type(4)));
typedef unsigned u32x4 __attribute__((ext_vector_type(4)));
constexpr int BM = 256, BK = 64, HALF = 128, HTB = HALF * BK * 2  , STAGE_BYTES = 8 * HTB, NXCD = 8, WGM = 8;

__host__ __device__ __forceinline__ int lds_byte(int r, int c) { const int st = (r >> 4) * 2 + (c >> 5), rr = r & 15, cc = c & 31, ob = rr * 64 + cc * 2; return st * 1024 + (ob ^ (((ob >> 9) & 1) << 5)); }
__host__ __device__ __forceinline__ void stage_rc(int b, int& R, int& C) { const int st = b / 1024, sb = b % 1024, swz = sb ^ (((sb >> 9) & 1) << 5); R = (st >> 1) * 16 + swz / 64; C = (st & 1) * 32 + (swz % 64) / 2; }
__host__ __device__ __forceinline__ int perm32(int rho) { const int n = rho >> 4, i = rho & 15; return 8 * (i >> 2) + 4 * n + (i & 3); }

struct Unit { int pm, pn; };
struct Gemm { const bf16_t* A; const bf16_t* Bt; int M, N, K; };

struct StaticOrder {
    int nM, nN, nwg, G, c;
    __host__ __device__ void init(int M, int N, int G_, int c_) { nM = M / BM; nN = N / BM; nwg = nM * nN; G = G_; c = c_; }
    __host__ __device__ bool next(int i, Unit& u) const {
        const long L = (long)i * G + c; if (L >= nwg) return false;
        int wgid = (int)L; { const int q = nwg / NXCD, r = nwg % NXCD, xcd = wgid % NXCD, off = wgid / NXCD; wgid = (xcd < r ? xcd * (q + 1) : r * (q + 1) + (xcd - r) * q) + off; }
        const int nig = WGM * nN, gid = wgid / nig, fm = gid * WGM, gsz = (nM - fm) < WGM ? (nM - fm) : WGM;
        u.pm = fm + ((wgid % nig) % gsz); u.pn = (wgid % nig) / gsz; return true;
    }
    __device__ __forceinline__ void a_ready(const Unit&) const {}
    __device__ __forceinline__ void done(const Unit&) const {}
};
__device__ __forceinline__ unsigned cvt_pk_bf16(float lo, float hi) { unsigned r; asm volatile("v_cvt_pk_bf16_f32 %0, %1, %2" : "=v"(r) : "v"(lo), "v"(hi)); return r; }
typedef float f32x2 __attribute__((ext_vector_type(2)));
__device__ __forceinline__ f32x2 gelu_pk(f32x2 v) {
    const f32x2 av = __builtin_elementwise_abs(v), d = av * 0.2316418882f + 1.0f;
    f32x2 t; t.x = __builtin_amdgcn_rcpf(d.x); t.y = __builtin_amdgcn_rcpf(d.y);
    f32x2 q = t * 0.5307027145f + (-0.7265760135f); q = q * t + 0.7107068705f; q = q * t + (-0.142248368f); q = q * t + 0.127414796f; q = q * t;
    const f32x2 s = (v * v) * (-0.72134752044f);
    f32x2 e; e.x = __builtin_amdgcn_exp2f(s.x); e.y = __builtin_amdgcn_exp2f(s.y);
    const f32x2 m = v * (q * e), r = v - m;
    f32x2 o; o.x = v.x < 0.f ? m.x : r.x; o.y = v.y < 0.f ? m.y : r.y; return o;
}

typedef unsigned u32x2 __attribute__((ext_vector_type(2)));
__device__ __forceinline__ float silu_f(float g) { return g * __builtin_amdgcn_rcpf(1.0f + __expf(-g)); }
struct EpiSwiGLU {
    static constexpr bool PERM = true, AFTER_DRAIN = false;
    bf16_t* O; int ldc;
    __device__ __forceinline__ void operator()(const f32x4 (&acc)[2][2][4][2], const Unit& u, int wr, int wc, int fr, int fq) const {
        const int row0 = u.pm * BM + wr * 64 + fr, col0 = u.pn * HALF + wc * 32 + 8 * fq;
#pragma unroll
        for (int ai = 0; ai < 2; ++ai)
#pragma unroll
            for (int m = 0; m < 4; ++m) { bf16_t* rowp = O + (size_t)(row0 + ai * HALF + m * 16) * ldc + col0;
                const f32x4 g0 = acc[ai][0][m][0], g1 = acc[ai][0][m][1], u0 = acc[ai][1][m][0], u1 = acc[ai][1][m][1];
                u32x4 w; w.x = cvt_pk_bf16(silu_f(g0[0]) * u0[0], silu_f(g0[1]) * u0[1]); w.y = cvt_pk_bf16(silu_f(g0[2]) * u0[2], silu_f(g0[3]) * u0[3]);
                w.z = cvt_pk_bf16(silu_f(g1[0]) * u1[0], silu_f(g1[1]) * u1[1]); w.w = cvt_pk_bf16(silu_f(g1[2]) * u1[2], silu_f(g1[3]) * u1[3]);
                *(u32x4*)rowp = w; }
    }
};
struct EpiResid {
    static constexpr bool PERM = false, AFTER_DRAIN = false;
    const float* base; float* out; int ldc; float sa, sb;
    __device__ __forceinline__ void operator()(const f32x4 (&acc)[2][2][4][2], const Unit& u, int wr, int wc, int fr, int fq) const {
        const int row0 = u.pm * BM + wr * 64 + fr, col0 = u.pn * BM + wc * 32 + 4 * fq;
#pragma unroll
        for (int ai = 0; ai < 2; ++ai)
#pragma unroll
            for (int m = 0; m < 4; ++m) { const size_t off = (size_t)(row0 + ai * HALF + m * 16) * ldc + col0;
#pragma unroll
                for (int bj = 0; bj < 2; ++bj)
#pragma unroll
                    for (int n = 0; n < 2; ++n) { const f32x4 b = *(const f32x4*)(base + off + bj * HALF + n * 16); *(f32x4*)(out + off + bj * HALF + n * 16) = b * sa + acc[ai][bj][m][n] * sb; } }
    }
};
struct EpiP {
    static constexpr bool PERM = false, AFTER_DRAIN = false;
    float* P; bf16_t* U; float* GV;
    __device__ __forceinline__ void operator()(const f32x4 (&acc)[2][2][4][2], const Unit& u, int wr, int wc, int fr, int fq) const {
        const int row0 = u.pm * BM + wr * 64 + fr, cw = wc * 32 + 4 * fq;
        const int kind = u.pn < 14 ? 0 : (u.pn < 18 ? 1 : 2);
        float* F = kind == 0 ? P + u.pn * BM + cw : GV + (u.pn - 18) * BM + cw; const int ldf = kind == 0 ? 3584 : 1024;
        bf16_t* Ub = U + (u.pn - 14) * BM + cw;
#pragma unroll
        for (int ai = 0; ai < 2; ++ai)
#pragma unroll
            for (int m = 0; m < 4; ++m) { const size_t row = (size_t)(row0 + ai * HALF + m * 16);
#pragma unroll
                for (int bj = 0; bj < 2; ++bj)
#pragma unroll
                    for (int n = 0; n < 2; ++n) { f32x4 v = acc[ai][bj][m][n];
                        if (kind != 0) { const f32x2 a = gelu_pk((f32x2){v[0], v[1]}), b = gelu_pk((f32x2){v[2], v[3]}); v = (f32x4){a.x, a.y, b.x, b.y}; }
                        if (kind == 1) { u32x2 w; w.x = cvt_pk_bf16(v[0], v[1]); w.y = cvt_pk_bf16(v[2], v[3]); *(u32x2*)(Ub + row * 1024 + bj * HALF + n * 16) = w; }
                        else *(f32x4*)(F + row * ldf + bj * HALF + n * 16) = v; }
                asm volatile("" ::: "memory"); }
    }
};
struct EpiLora {
    static constexpr bool PERM = false, AFTER_DRAIN = false;
    float* base;
    __device__ __forceinline__ void operator()(const f32x4 (&acc)[2][2][4][2], const Unit& u, int wr, int wc, int fr, int fq) const {
        const int row0 = u.pm * BM + wr * 64 + fr, kind = u.pn >> 2, cb = (u.pn & 3) * BM + wc * 32 + 4 * fq;
        float* O = base + (size_t)kind * ((size_t)66 << 18) + cb;
#pragma unroll
        for (int ai = 0; ai < 2; ++ai)
#pragma unroll
            for (int m = 0; m < 4; ++m) { float* rowp = O + (size_t)(row0 + ai * HALF + m * 16) * 1024;
#pragma unroll
                for (int bj = 0; bj < 2; ++bj)
#pragma unroll
                    for (int n = 0; n < 2; ++n) *(f32x4*)(rowp + bj * HALF + n * 16) = acc[ai][bj][m][n]; }
    }
};
template <class Epi, class Sched, bool ALIGN_EPI = false, bool SP2 = false>
__device__ __forceinline__ void gemm_phase(PG8_LAS unsigned char* lds, const Gemm g, const Sched& S, const Epi& E, int tid_in) {
    int tid_ = tid_in; asm volatile("" : "+v"(tid_));
    const int tid = tid_, wid = __builtin_amdgcn_readfirstlane(tid >> 6), lane = tid & 63, wr = wid >> 2, wc = wid & 3, fr = lane & 15, fq = lane >> 4;
    const int K = g.K, nt = K / BK;
    unsigned voffA[2], voffB[2];
#pragma unroll
    for (int i = 0; i < 2; ++i) { int R, C; stage_rc(tid * 16 + i * 8192, R, C); const int Rb = Epi::PERM ? ((R & ~31) + perm32(R & 31)) : R;
        voffA[i] = (unsigned)(R * K + C) * 2u; voffB[i] = (unsigned)(Rb * K + C) * 2u; }
    const size_t kstep = (size_t)(BK * 2);
    const size_t hstep = (size_t)HALF * K * 2;
    const size_t tstep = 2 * hstep;
    const unsigned ldsw = (unsigned)wid * 1024u;
    const int aoff = lds_byte(wr * 64 + fr, fq * 8), boff = lds_byte(wc * 32 + fr, fq * 8);
#define PG8_SA(b, h) (((b) * 2 + (h)) * HTB)
#define PG8_SB(b, h) ((4 + (b) * 2 + (h)) * HTB)
#define PG8_STAGE(bufoff, gbase, voff) do { _Pragma("unroll") for (int _i = 0; _i < 2; ++_i) \
        __builtin_amdgcn_global_load_lds((const unsigned*)((const char*)(gbase) + (voff)[_i]), (PG8_LAS unsigned*)(lds + (bufoff) + ldsw + _i * 8192), 16, 0, 0); } while (0)
#define PG8_LDA(dst, b, h) do { _Pragma("unroll") for (int m = 0; m < 4; ++m) _Pragma("unroll") for (int k = 0; k < 2; ++k) dst[m][k] = *(const PG8_LAS bf16x8*)(lds + PG8_SA(b, h) + aoff + m * 2048 + k * 1024); } while (0)
#define PG8_LDB(dst, b, h) do { _Pragma("unroll") for (int n = 0; n < 2; ++n) _Pragma("unroll") for (int k = 0; k < 2; ++k) dst[n][k] = *(const PG8_LAS bf16x8*)(lds + PG8_SB(b, h) + boff + n * 2048 + k * 1024); } while (0)
#define PG8_MMA(ai, bj, At, Bt) do { __builtin_amdgcn_s_setprio(1); _Pragma("unroll") for (int m = 0; m < 4; ++m) _Pragma("unroll") for (int n = 0; n < 2; ++n) _Pragma("unroll") for (int k = 0; k < 2; ++k) \
        acc[ai][bj][m][n] = __builtin_amdgcn_mfma_f32_16x16x32_bf16(Bt[n][k], At[m][k], acc[ai][bj][m][n], 0, 0, 0); __builtin_amdgcn_s_setprio(0); } while (0)
#define PG8_WAIT_V(n) asm volatile("s_waitcnt vmcnt(" #n ")" ::: "memory")
#define PG8_WAIT_L(n) asm volatile("s_waitcnt lgkmcnt(" #n ")" ::: "memory")
#define PG8_BAR __builtin_amdgcn_s_barrier()
#define PG8_SCHED __builtin_amdgcn_sched_barrier(0)
    Unit cur, nxt; int ui = 0;
    if (!S.next(0, cur)) return;
    f32x4 acc[2][2][4][2];
    float zz0; asm volatile("v_mov_b32 %0, 0" : "=v"(zz0));
#pragma unroll
    for (int a = 0; a < 2; ++a)
#pragma unroll
        for (int b = 0; b < 2; ++b)
#pragma unroll
            for (int m = 0; m < 4; ++m)
#pragma unroll
                for (int n = 0; n < 2; ++n) acc[a][b][m][n] = (f32x4){zz0, zz0, zz0, zz0};
    bf16x8 At[4][2], B0[2][2], B1[2][2];
    const char* cA = (const char*)g.A + (size_t)cur.pm * tstep; const char* cB = (const char*)g.Bt + (size_t)cur.pn * tstep;
    S.a_ready(cur);
    if constexpr (SP2) {
        PG8_STAGE(PG8_SB(0, 0), cB, voffB); PG8_STAGE(PG8_SB(0, 1), cB + hstep, voffB); PG8_STAGE(PG8_SA(0, 0), cA, voffA); PG8_STAGE(PG8_SA(0, 1), cA + hstep, voffA);
        if (wr == 1) PG8_BAR;
        PG8_WAIT_V(2); PG8_BAR;
        PG8_STAGE(PG8_SB(1, 0), cB + kstep, voffB); PG8_STAGE(PG8_SA(1, 0), cA + kstep, voffA); PG8_STAGE(PG8_SB(1, 1), cB + hstep + kstep, voffB);
        PG8_WAIT_V(6); PG8_BAR;
    } else {
        PG8_STAGE(PG8_SB(0, 0), cB, voffB); PG8_STAGE(PG8_SA(0, 0), cA, voffA); PG8_STAGE(PG8_SB(0, 1), cB + hstep, voffB); PG8_STAGE(PG8_SA(0, 1), cA + hstep, voffA);
        if (wr == 1) PG8_BAR;
        PG8_WAIT_V(4); PG8_BAR;
        PG8_STAGE(PG8_SB(1, 0), cB + kstep, voffB); PG8_STAGE(PG8_SA(1, 0), cA + kstep, voffA); PG8_STAGE(PG8_SB(1, 1), cB + hstep + kstep, voffB);
        PG8_WAIT_V(6); PG8_BAR;
    }
    for (;;) {
        const bool has_next = S.next(ui + 1, nxt);
        const char* nA = has_next ? (const char*)g.A + (size_t)nxt.pm * tstep : cA; const char* nB = has_next ? (const char*)g.Bt + (size_t)nxt.pn * tstep : cB;
        for (int t = 0; t < nt; t += 2) {
            const bool last = (t == nt - 2);
            const char* a1 = cA + (size_t)(t + 1) * kstep;
            const char* a2 = last ? nA : cA + (size_t)(t + 2) * kstep; const char* b2 = last ? nB : cB + (size_t)(t + 2) * kstep;
            const char* a3 = a2 + kstep; const char* b3 = b2 + kstep;
            if (last && has_next) S.a_ready(nxt);
            if constexpr (SP2) {
            PG8_LDB(B0, 0, 0); PG8_LDB(B1, 0, 1); PG8_SCHED; PG8_LDA(At, 0, 0); PG8_STAGE(PG8_SA(1, 1), a1 + hstep, voffA);
            PG8_WAIT_V(8); PG8_WAIT_L(0); PG8_BAR; PG8_MMA(0, 0, At, B0); PG8_MMA(0, 1, At, B1); PG8_BAR; PG8_SCHED;
            PG8_LDA(At, 0, 1); PG8_STAGE(PG8_SB(0, 0), b2, voffB); PG8_STAGE(PG8_SB(0, 1), b2 + hstep, voffB); PG8_STAGE(PG8_SA(0, 0), a2, voffA);
            PG8_WAIT_V(8); PG8_WAIT_L(0); PG8_BAR; PG8_MMA(1, 0, At, B0); PG8_MMA(1, 1, At, B1); PG8_BAR; PG8_SCHED;
            PG8_LDB(B0, 1, 0); PG8_LDB(B1, 1, 1); PG8_SCHED; PG8_LDA(At, 1, 0); PG8_STAGE(PG8_SA(0, 1), a2 + hstep, voffA);
            PG8_WAIT_V(8); PG8_WAIT_L(0); PG8_BAR; PG8_MMA(0, 0, At, B0); PG8_MMA(0, 1, At, B1); PG8_BAR; PG8_SCHED;
            PG8_LDA(At, 1, 1); PG8_STAGE(PG8_SB(1, 0), b3, voffB); PG8_STAGE(PG8_SB(1, 1), b3 + hstep, voffB); PG8_STAGE(PG8_SA(1, 0), a3, voffA);
            PG8_WAIT_V(8); PG8_WAIT_L(0); PG8_BAR; PG8_MMA(1, 0, At, B0); PG8_MMA(1, 1, At, B1); PG8_BAR; PG8_SCHED;
            } else {
            PG8_LDB(B0, 0, 0); PG8_SCHED; PG8_LDA(At, 0, 0); PG8_STAGE(PG8_SA(1, 1), a1 + hstep, voffA);
            PG8_WAIT_L(8); PG8_BAR; PG8_WAIT_L(0); PG8_MMA(0, 0, At, B0); PG8_BAR; PG8_SCHED;
            PG8_LDB(B1, 0, 1); PG8_STAGE(PG8_SB(0, 0), b2, voffB);
            PG8_BAR; PG8_WAIT_L(0); PG8_MMA(0, 1, At, B1); PG8_BAR;
            PG8_LDA(At, 0, 1); PG8_STAGE(PG8_SA(0, 0), a2, voffA);
            PG8_BAR; PG8_WAIT_L(0); PG8_MMA(1, 0, At, B0); PG8_BAR; PG8_SCHED;
            PG8_STAGE(PG8_SB(0, 1), b2 + hstep, voffB);
            PG8_WAIT_V(6); PG8_BAR; PG8_MMA(1, 1, At, B1); PG8_BAR;
            PG8_LDB(B0, 1, 0); PG8_SCHED; PG8_LDA(At, 1, 0); PG8_STAGE(PG8_SA(0, 1), a2 + hstep, voffA);
            PG8_WAIT_L(8); PG8_BAR; PG8_WAIT_L(0); PG8_MMA(0, 0, At, B0); PG8_BAR; PG8_SCHED;
            PG8_LDB(B1, 1, 1); PG8_STAGE(PG8_SB(1, 0), b3, voffB);
            PG8_BAR; PG8_WAIT_L(0); PG8_MMA(0, 1, At, B1); PG8_BAR;
            PG8_LDA(At, 1, 1); PG8_STAGE(PG8_SA(1, 0), a3, voffA);
            PG8_BAR; PG8_WAIT_L(0); PG8_MMA(1, 0, At, B0); PG8_BAR; PG8_SCHED;
            PG8_STAGE(PG8_SB(1, 1), b3 + hstep, voffB);
            PG8_WAIT_V(6); PG8_BAR; PG8_MMA(1, 1, At, B1); PG8_BAR;
            }
        }
        if constexpr (ALIGN_EPI) { if (wr == 0) PG8_BAR; }
        if constexpr (!Epi::AFTER_DRAIN) { E(acc, cur, wr, wc, fr, fq); S.done(cur); }
        if (!has_next) break;
{ float zz1; asm volatile("v_mov_b32 %0, 0" : "=v"(zz1));
#pragma unroll
        for (int a = 0; a < 2; ++a)
#pragma unroll
            for (int b = 0; b < 2; ++b)
#pragma unroll
                for (int m = 0; m < 4; ++m)
#pragma unroll
                    for (int n = 0; n < 2; ++n) acc[a][b][m][n] = (f32x4){zz1, zz1, zz1, zz1}; }
        cur = nxt; cA = nA; cB = nB; ++ui;
        if constexpr (ALIGN_EPI) { if (wr == 1) PG8_BAR; }
    }
    PG8_WAIT_V(0);
    if constexpr (!ALIGN_EPI) { if (wr == 0) PG8_BAR; }
    PG8_BAR;
    if constexpr (Epi::AFTER_DRAIN) { E.fused(acc, cur, wr, wc, fr, fq, lds, wid, lane); S.done(cur); }
#undef PG8_SA
#undef PG8_SB
#undef PG8_STAGE
#undef PG8_LDA
#undef PG8_LDB
#undef PG8_MMA
#undef PG8_WAIT_V
#undef PG8_WAIT_L
#undef PG8_BAR
#undef PG8_SCHED
}
}
#define GAS __attribute__((address_space(1)))
#define LAS __attribute__((address_space(3)))
typedef unsigned short bf16;
typedef unsigned v4u __attribute__((ext_vector_type(4)));
typedef float f32x4 __attribute__((ext_vector_type(4)));
typedef short bf16x8 __attribute__((ext_vector_type(8)));
typedef GAS unsigned gu32;
typedef GAS unsigned long long gu64;
#define RLX_AGENT __ATOMIC_RELAXED, __HIP_MEMORY_SCOPE_AGENT
#define LDS_WAIT() asm volatile("s_waitcnt lgkmcnt(0)" ::: "memory")
#define VM_WAIT() asm volatile("s_waitcnt vmcnt(0)" ::: "memory")
__device__ __forceinline__ unsigned long long rt() { return __builtin_amdgcn_s_memrealtime(); }
__device__ __forceinline__ unsigned f2bf(float f) { unsigned u = __builtin_bit_cast(unsigned, f); return (u + 0x7fffu + ((u >> 16) & 1u)) >> 16; }
__device__ __forceinline__ unsigned pk2(float lo, float hi) { return f2bf(lo) | (f2bf(hi) << 16); }
#define XB_TMO      128
#define XB_XCNT(j)  (256  + 64 * (j))
#define XB_XSUB(j)  (1280 + 64 * (j))
#define XB_XGEN(j)  (2304 + 64 * (j))
#define XB_TOP      3328
#define XB_TOPGEN   3392
#define XCD_BAR_WORDS 3456
#define XB_SPIN_CAP (1u << 18)

__device__ __forceinline__ unsigned xb_ld(unsigned* p)              { return __hip_atomic_load(p, __ATOMIC_RELAXED, __HIP_MEMORY_SCOPE_AGENT); }
__device__ __forceinline__ unsigned xb_add(unsigned* p, unsigned v) { return __hip_atomic_fetch_add(p, v, __ATOMIC_RELAXED, __HIP_MEMORY_SCOPE_AGENT); }
__device__ __forceinline__ unsigned xb_xcc_id() { return (unsigned)__builtin_amdgcn_s_getreg((3 << 11) | 20) & 0xFu; }
#define XB_SPIN(cond, bar) do { unsigned _sp = 0; while (cond) { __builtin_amdgcn_s_sleep(1); \
    if ((++_sp & 255u) == 0u) { if (xb_ld(&(bar)[XB_TMO])) break; if (_sp > XB_SPIN_CAP) { atomicAdd(&(bar)[XB_TMO], 1u); break; } } } } while (0)

struct XcdBarrier {
    unsigned* bar; unsigned x;
    volatile LAS unsigned* st;
};

__device__ __forceinline__ XcdBarrier xcd_barrier_post(unsigned* bar, volatile LAS unsigned* st, int tid) {
    XcdBarrier b; b.bar = bar; b.x = xb_xcc_id(); b.st = st;
    if (tid == 0) (void)xb_add(&bar[XB_XCNT(b.x)], 1u);
    return b;
}
__device__ __forceinline__ void xcd_barrier_complete(unsigned* bar, unsigned x, unsigned& nloc, unsigned& nx) {
    const unsigned G = gridDim.x * gridDim.y * gridDim.z;
    unsigned sum, cnt, mine, sp = 0u;
    for (;;) {
        sum = 0u; cnt = 0u; mine = 0u;
#pragma unroll
        for (unsigned j = 0; j < 16; ++j) { const unsigned c = xb_ld(&bar[XB_XCNT(j)]); sum += c; cnt += (c > 0u) ? 1u : 0u; mine = (j == x) ? c : mine; }
        if (sum == G) break;
        __builtin_amdgcn_s_sleep(1);
        if ((++sp & 255u) == 0u) { if (xb_ld(&bar[XB_TMO])) break; if (sp > XB_SPIN_CAP) { atomicAdd(&bar[XB_TMO], 1u); break; } }
    }
    nloc = mine > 0u ? mine : 1u; nx = cnt > 0u ? cnt : 1u;
}

__device__ __forceinline__ void xcd_barrier(const XcdBarrier& b, int tid) {
    asm volatile("s_waitcnt vmcnt(0)" ::: "memory");
    __syncthreads();
    if (tid == 0) {
        unsigned* bar = b.bar;
        __builtin_amdgcn_s_waitcnt(0);
        unsigned nloc = b.st[0], nx = b.st[1];
        if (nloc == 0u) { xcd_barrier_complete(bar, b.x, nloc, nx); b.st[0] = nloc; b.st[1] = nx; }
        const unsigned old = xb_add(&bar[XB_XSUB(b.x)], 1u);
        const unsigned gen = old / nloc;
        if (old + 1u == (gen + 1u) * nloc) {
            __builtin_amdgcn_fence(__ATOMIC_RELEASE, "agent");
            asm volatile("s_waitcnt vmcnt(0)" ::: "memory");
            const unsigned og = xb_add(&bar[XB_TOP], 1u);
            const unsigned tg = og / nx;
            if (og + 1u == (tg + 1u) * nx) xb_add(&bar[XB_TOPGEN], 1u);
            else XB_SPIN(xb_ld(&bar[XB_TOPGEN]) == tg, bar);
            __builtin_amdgcn_fence(__ATOMIC_ACQUIRE, "agent");
            xb_add(&bar[XB_XGEN(b.x)], 1u);
            asm volatile("s_waitcnt vmcnt(0)" ::: "memory");
        } else {
            XB_SPIN(xb_ld(&bar[XB_XGEN(b.x)]) == gen, bar);
            __builtin_amdgcn_fence(__ATOMIC_ACQUIRE, "agent");
            asm volatile("s_waitcnt vmcnt(0)" ::: "memory");
        }
    }
    __syncthreads();
}

constexpr int NWAVES = 8, NTHR = 512;
constexpr int DM = 2048, FF = 5632, DEPTH = 4;
constexpr int TP = 16384, NSB = 16, TS = 32, M = TP + NSB * TS;
constexpr int RW = 1024, NH = 16, HN = 64, GMW = 1024, GH = 8, GHD = 128;
constexpr int C_W = 3072, C_A = 3136, C_G = 3200, SHIFT = 3360, INC = 5408;
constexpr int PLD = 3584;
constexpr int N3 = 5632;
constexpr int LK = 384;
constexpr int NL = 3072;
constexpr float ALPHA = 1.6817928305074292f;
constexpr float LN_EPS = 1e-5f, GN_EPS = 64e-5f;
constexpr int NPHASE = 15;

constexpr size_t O_YP = 0, O_SP = 34603008, O_SHP = 34865152, O_SS = 34878592, O_SHS = 39072896, O_GV = 39287936, O_END = 41385088;

constexpr size_t MiB = 1u << 20;
constexpr size_t WS_CTL = 0, CTL_ZERO_BYTES = 1 * MiB;
constexpr size_t WS_X = 1 * MiB;
constexpr size_t WS_Z = 133 * MiB;
constexpr size_t WS_XB = 265 * MiB;
constexpr size_t WS_W = 331 * MiB;
constexpr size_t W_1 = WS_W, W_2 = W_1 + 44 * MiB, W_3 = W_2 + 22 * MiB, W_4 = W_3 + 22 * MiB, W_5 = W_4 + 8 * MiB, W_6 = W_5 + 44 * MiB, W_3B = W_6 + 22 * MiB;
constexpr size_t WS_BIG = 496 * MiB;
constexpr size_t B_H = WS_BIG, B_P = WS_BIG, B_U = WS_BIG + 231 * MiB, B_GV = B_U + 33 * MiB, B_A3B = B_GV + 66 * MiB;
constexpr size_t B_MIX = WS_XB;
constexpr size_t WS_RW = 839 * MiB;
constexpr size_t RWSZ = 66 * MiB;
constexpr size_t WS_END = WS_RW + 8 * RWSZ;
static_assert(W_3B + (size_t)NL * LK * 2 <= WS_BIG && B_A3B + (size_t)M * LK * 2 <= WS_RW, "ws map");
static_assert((size_t)M * DM * 4 == 132 * MiB && (size_t)M * PLD * 4 == 231 * MiB && (size_t)M * 1024 * 4 == 66 * MiB, "ws sizes");
constexpr int CW_TMO = 0, CW_CODE = 1, CW_BAR = 4096;

constexpr int RING_OFF = 0, RING_BYTES = 135168;
constexpr int LDSCTL_OFF = RING_BYTES, MISC_OFF = LDSCTL_OFF + 320;
constexpr int LDS_BYTES = 147456;

struct Args { const float* in[29]; float* out; unsigned char* ws; int l_lo, l_hi; };
#define KOUT() ((float*)karg_ptr<232>())
#define KWS() ((unsigned char*)karg_ptr<240>())
enum InIdx { I_XP = 0, I_XS, I_SRW, I_SSH, I_F1G, I_F1U, I_F1D, I_WIN, I_MU, I_W0, I_WUP, I_A0, I_AUP, I_GUP, I_KK, I_KA, I_RK, I_GNG, I_GNB, I_GLG, I_GLB, I_GWS, I_GBS, I_WOUT, I_F2G, I_F2U, I_F2D, I_LNG, I_LNB };


template <int OFF> __device__ __forceinline__ const float* karg_ptr() {
    const unsigned long long kp = (unsigned long long)__builtin_amdgcn_kernarg_segment_ptr(); unsigned long long v;
    asm volatile("s_load_dwordx2 %0, %1, %2\n\ts_waitcnt lgkmcnt(0)" : "=s"(v) : "s"(kp), "i"(OFF) : "memory");
    return (const float*)v;
}
#define KIN(i) karg_ptr<8 * (i)>()
template <int CTRL> __device__ __forceinline__ float dpp_mov(float x) { return __builtin_bit_cast(float, __builtin_amdgcn_mov_dpp(__builtin_bit_cast(int, x), CTRL, 0xf, 0xf, true)); }
__device__ __forceinline__ float row16_sum(float x) { x += dpp_mov<0x128>(x); x += dpp_mov<0x124>(x); x += dpp_mov<0x122>(x); x += dpp_mov<0x121>(x); return x; }
__device__ __forceinline__ float wave_sum(float v) {
    v = row16_sum(v); const int i = __builtin_bit_cast(int, v);
    const float a = __builtin_bit_cast(float, __builtin_amdgcn_readlane(i, 0)), b = __builtin_bit_cast(float, __builtin_amdgcn_readlane(i, 16)), c = __builtin_bit_cast(float, __builtin_amdgcn_readlane(i, 32)), d = __builtin_bit_cast(float, __builtin_amdgcn_readlane(i, 48));
    return (a + b) + (c + d);
}

__device__ __forceinline__ void transpose_item(const float* W, int K, int N, bf16* WT, int dst_row0, int k0, int n0, LAS float* scr, int lane) {
#pragma unroll 8
    for (int i = 0; i < 32; ++i) { const int kk = 2 * i + (lane >> 5); scr[kk * 33 + (lane & 31)] = W[(size_t)(k0 + kk) * N + n0 + (lane & 31)]; }
    LDS_WAIT(); asm volatile("" ::: "memory");
    const int c = lane & 7;
#pragma unroll
    for (int j = 0; j < 4; ++j) { const int n = (lane >> 3) + 8 * j; const LAS float* s = scr + (8 * c) * 33 + n;
        v4u o; o.x = pk2(s[0 * 33], s[1 * 33]); o.y = pk2(s[2 * 33], s[3 * 33]); o.z = pk2(s[4 * 33], s[5 * 33]); o.w = pk2(s[6 * 33], s[7 * 33]);
        *(v4u*)(WT + (size_t)(dst_row0 + n) * K + k0 + 8 * c) = o; }
    LDS_WAIT(); asm volatile("" ::: "memory");
}

__device__ __forceinline__ void phase_convert(int l, LAS unsigned char* lds, int wave, int lane, int gw, int NGW) {
    unsigned char* ws = KWS();
    LAS float* scr = (LAS float*)(lds + RING_OFF + wave * 16384);
    const size_t so = (size_t)l * DM * FF;
    const float *f1g = KIN(I_F1G) + so, *f1u = KIN(I_F1U) + so, *f1d = KIN(I_F1D) + so, *f2g = KIN(I_F2G) + so, *f2u = KIN(I_F2U) + so, *f2d = KIN(I_F2D) + so;
    const float* win = KIN(I_WIN) + (size_t)l * DM * INC; const float* wout = KIN(I_WOUT) + (size_t)l * DM * DM;
    constexpr int I_GU = (DM / 64) * (FF / 32);
    constexpr int I_D = (FF / 64) * (DM / 32);
    constexpr int I_IN = (DM / 64) * (INC / 32);
    constexpr int I_O = (DM / 64) * (DM / 32);
    constexpr int NITEMS = 4 * I_GU + 2 * I_D + I_IN + I_O;
    for (int it = gw; it < NITEMS; it += NGW) {
        int r = it;
        if (r < 4 * I_GU) { const int which = r / I_GU; r -= which * I_GU; const int nblk = FF / 32, kb = r / nblk, nb = r % nblk, n0 = 32 * nb;
            const float* W = which == 0 ? f1g : (which == 1 ? f1u : (which == 2 ? f2g : f2u));
            bf16* WT = (bf16*)(ws + (which < 2 ? W_1 : W_5));
            transpose_item(W, DM, FF, WT, 256 * (n0 / 128) + (n0 % 128) + ((which & 1) ? 128 : 0), 64 * kb, n0, scr, lane); continue; }
        r -= 4 * I_GU;
        if (r < 2 * I_D) { const int which = r / I_D; r -= which * I_D; const int nblk = DM / 32, kb = r / nblk, nb = r % nblk;
            transpose_item(which == 0 ? f1d : f2d, FF, DM, (bf16*)(ws + (which == 0 ? W_2 : W_6)), 32 * nb, 64 * kb, 32 * nb, scr, lane); continue; }
        r -= 2 * I_D;
        if (r < I_IN) { const int nblk = INC / 32, kb = r / nblk, nb = r % nblk, n0 = 32 * nb;
            transpose_item(win, DM, INC, (bf16*)(ws + W_3), n0 < SHIFT ? n0 : n0 + (PLD - SHIFT), 64 * kb, n0, scr, lane); continue; }
        r -= I_IN;
        { const int nblk = DM / 32, kb = r / nblk, nb = r % nblk; transpose_item(wout, DM, DM, (bf16*)(ws + W_4), 32 * nb, 64 * kb, 32 * nb, scr, lane); }
    }
    { v4u* z = (v4u*)(ws + W_3 + (size_t)SHIFT * DM * 2); const int nz = (PLD - SHIFT) * DM * 2 / 16;
      unsigned z0; asm volatile("v_mov_b32 %0, 0" : "=v"(z0));
      for (int i = gw * 64 + lane; i < nz; i += NGW * 64) z[i] = (v4u){z0, z0, z0, z0}; }
    { bf16* WT = (bf16*)(ws + W_3B); const float* wup = KIN(I_WUP) + (size_t)l * 64 * RW; const float* aup = KIN(I_AUP) + (size_t)l * 64 * RW; const float* gup = KIN(I_GUP) + (size_t)l * 160 * RW;
      for (int i = gw * 64 + lane; i < NL * LK; i += NGW * 64) { const int n = i / LK, k = i % LK, kind = n >> 10, c = n & 1023; float v = 0.f;
          if (kind == 0) { if (k < 64) v = wup[(size_t)k * RW + c]; } else if (kind == 1) { if (k >= 64 && k < 128) v = aup[(size_t)(k - 64) * RW + c]; } else { if (k >= 128 && k < 288) v = gup[(size_t)(k - 128) * RW + c]; }
          WT[i] = (bf16)f2bf(v); } }
    if (l == 0) {
        float* X = (float*)(ws + WS_X); bf16* XB = (bf16*)(ws + WS_XB); const float* xp = KIN(I_XP); const float* xs = KIN(I_XS);
        for (int m = gw; m < M; m += NGW) { const float* src = m < TP ? xp + (size_t)m * DM : xs + (size_t)(m - TP) * DM;
            const f32x4* s4 = (const f32x4*)src + lane; f32x4* d4 = (f32x4*)(X + (size_t)m * DM) + lane; unsigned long long* o8 = (unsigned long long*)(XB + (size_t)m * DM) + lane;
#pragma unroll
            for (int j = 0; j < 8; ++j) { const f32x4 v = s4[64 * j]; d4[64 * j] = v; o8[64 * j] = (unsigned long long)pk2(v.x, v.y) | ((unsigned long long)pk2(v.z, v.w) << 32); } }
    }
}

__device__ __forceinline__ void phase_ln(const float* Z, const float* g, const float* b, float* Xo, bf16* XBo, int lane, int gw, int NGW) {
    for (int m = gw; m < M; m += NGW) {
        const f32x4* zr = (const f32x4*)(Z + (size_t)m * DM) + lane; f32x4 v[8]; float s = 0.f;
#pragma unroll
        for (int j = 0; j < 8; ++j) { v[j] = zr[64 * j]; s += (v[j].x + v[j].y) + (v[j].z + v[j].w); }
        const float mean = wave_sum(s) * (1.f / DM); float s2 = 0.f;
#pragma unroll
        for (int j = 0; j < 8; ++j) { v[j] = v[j] - mean; s2 += (v[j].x * v[j].x + v[j].y * v[j].y) + (v[j].z * v[j].z + v[j].w * v[j].w); }
        const float rstd = 1.f / sqrtf(wave_sum(s2) * (1.f / DM) + LN_EPS);
        f32x4* xo = (f32x4*)(Xo + (size_t)m * DM) + lane;
#pragma unroll
        for (int j = 0; j < 8; ++j) { const f32x4 gg = ((const f32x4*)g)[lane + 64 * j], bb = ((const f32x4*)b)[lane + 64 * j]; const f32x4 o = v[j] * rstd * gg + bb; xo[64 * j] = o;
            if (XBo) ((unsigned long long*)(XBo + (size_t)m * DM) + lane)[64 * j] = (unsigned long long)pk2(o.x, o.y) | ((unsigned long long)pk2(o.z, o.w) << 32); }
    }
}

__device__ __forceinline__ const float* prev_row(const float* ssh, int l, const float* P, int m) {
    if (m < TP) return m == 0 ? nullptr : P + (size_t)(m - 1) * PLD;
    const int b = (m - TP) >> 5, t = (m - TP) & 31;
    return t == 0 ? ssh + (size_t)(l * NSB + b) * SHIFT : P + (size_t)(m - 1) * PLD;
}

__device__ __forceinline__ void phase_prep1(int l, int lane, int gw, int NGW) {
    unsigned char* ws = KWS(); float* outp = KOUT(); const float* P = (const float*)(ws + B_P); float* GV = (float*)(ws + B_GV); bf16* A3B = (bf16*)(ws + B_A3B);
    const float* mu = KIN(I_MU) + (size_t)l * SHIFT; const float* lg = KIN(I_GLG) + (size_t)l * GMW; const float* lb = KIN(I_GLB) + (size_t)l * GMW;
    const float* ssh = KIN(I_SSH);
    for (int m = gw; m < M; m += NGW) {
        const float* pr = P + (size_t)m * PLD; const float* pp = prev_row(ssh, l, P, m);
#pragma unroll
        for (int jj = 0; jj < 6; ++jj) { const int j = jj * 64 + lane; float v = 0.f;
            if (j < 288) { const int c = C_W + j; const float p = pr[c], q = pp ? pp[c] : 0.f; const float xs = p + (q - p) * mu[c];
                if (j < 64) { const float t = __expf(-2.f * fabsf(xs)); const float r = (1.f - t) / (1.f + t); v = xs < 0.f ? -r : r; }
                else if (j < 128) v = xs;
                else v = 1.f / (1.f + __expf(-xs)); }
            A3B[(size_t)m * LK + j] = (bf16)f2bf(v); }
        { f32x4* vr = (f32x4*)(GV + (size_t)m * GMW) + lane; f32x4 v[4]; float s = 0.f;
#pragma unroll
          for (int j = 0; j < 4; ++j) { v[j] = vr[64 * j]; s += (v[j].x + v[j].y) + (v[j].z + v[j].w); }
          const float mean = wave_sum(s) * (1.f / GMW); float s2 = 0.f;
#pragma unroll
          for (int j = 0; j < 4; ++j) { v[j] = v[j] - mean; s2 += (v[j].x * v[j].x + v[j].y * v[j].y) + (v[j].z * v[j].z + v[j].w * v[j].w); }
          const float rstd = 1.f / sqrtf(wave_sum(s2) * (1.f / GMW) + LN_EPS);
          f32x4* go = nullptr; if (m >= TP) go = (f32x4*)(outp + O_GV + ((size_t)l * NSB * TS + (m - TP)) * GMW) + lane;
#pragma unroll
          for (int j = 0; j < 4; ++j) { const f32x4 o = v[j] * rstd * ((const f32x4*)lg)[lane + 64 * j] + ((const f32x4*)lb)[lane + 64 * j]; vr[64 * j] = o; if (go) go[64 * j] = o; } }
        if (m == TP - 1) { float* o = outp + O_SHP + (size_t)l * SHIFT; for (int c = lane; c < SHIFT; c += 64) o[c] = pr[c]; }
        if (m >= TP && ((m - TP) & 31) == 31) { float* o = outp + O_SHS + (size_t)(l * NSB + ((m - TP) >> 5)) * SHIFT; for (int c = lane; c < SHIFT; c += 64) o[c] = pr[c]; }
    }
}

__device__ __forceinline__ void gmlp_unit(int l, LAS unsigned char* lds, int unit, int tid) {
    unsigned char* ws = KWS(); const float* VN = (const float*)(ws + B_GV); const bf16* U = (const bf16*)(ws + B_U); bf16* MIXB = (bf16*)(ws + B_MIX);
    const int ci = unit >> 3, h = unit & 7; int row0, nr; if (ci < 128) { row0 = 128 * ci; nr = 128; } else { row0 = TP + 32 * (ci - 128); nr = 32; }
    const float* wsm = KIN(I_GWS) + ((size_t)l * GH + h) * 128 * 128; const float* bs = KIN(I_GBS) + ((size_t)l * GH + h) * 128;
    LAS f32x4* Lws = (LAS f32x4*)lds; LAS f32x4* Lv = Lws + 4096;
    __syncthreads();
    for (int idx = tid; idx < nr * 32; idx += NTHR) { const int r = idx >> 5, c4 = idx & 31; Lws[idx] = *(const f32x4*)(wsm + r * 128 + 4 * c4); Lv[idx] = *(const f32x4*)(VN + (size_t)(row0 + r) * GMW + h * GHD + 4 * c4); }
    __syncthreads();
    const int rg = tid >> 4, cg = tid & 15;
    if (4 * rg < nr) {
        f32x4 acc[4][2];
#pragma unroll
        for (int r = 0; r < 4; ++r) { const float b0 = bs[4 * rg + r]; acc[r][0] = (f32x4){b0, b0, b0, b0}; acc[r][1] = acc[r][0]; }
        const LAS float* Lwf = (const LAS float*)Lws;
        for (int j = 0; j < 4 * rg + 4; ++j) { const f32x4 v0 = Lv[j * 32 + 2 * cg], v1 = Lv[j * 32 + 2 * cg + 1];
#pragma unroll
            for (int r = 0; r < 4; ++r) { const float w = (j <= 4 * rg + r) ? Lwf[(4 * rg + r) * 128 + j] : 0.f; acc[r][0] += v0 * w; acc[r][1] += v1 * w; } }
#pragma unroll
        for (int r = 0; r < 4; ++r) { const size_t row = (size_t)(row0 + 4 * rg + r); const v4u uu = *(const v4u*)(U + row * GMW + h * GHD + 8 * cg);
            const float u0 = __builtin_bit_cast(float, uu.x << 16), u1 = __builtin_bit_cast(float, uu.x & 0xffff0000u), u2 = __builtin_bit_cast(float, uu.y << 16), u3 = __builtin_bit_cast(float, uu.y & 0xffff0000u);
            const float u4 = __builtin_bit_cast(float, uu.z << 16), u5 = __builtin_bit_cast(float, uu.z & 0xffff0000u), u6 = __builtin_bit_cast(float, uu.w << 16), u7 = __builtin_bit_cast(float, uu.w & 0xffff0000u);
            v4u o; o.x = pk2(u0 * acc[r][0].x, u1 * acc[r][0].y); o.y = pk2(u2 * acc[r][0].z, u3 * acc[r][0].w); o.z = pk2(u4 * acc[r][1].x, u5 * acc[r][1].y); o.w = pk2(u6 * acc[r][1].z, u7 * acc[r][1].w);
            *(v4u*)(MIXB + row * DM + RW + h * GHD + 8 * cg) = o; }
    }
}


constexpr int NCI = 272, NUNIT = NCI * NH;
constexpr size_t SC_G = WS_RW + 3 * RWSZ;
constexpr size_t SC_HL = SC_G + (size_t)NUNIT * 8192;
constexpr size_t SC_RP = SC_HL + (size_t)NUNIT * 16384;
constexpr size_t SC_YL = SC_RP + (size_t)NUNIT * 8192;
constexpr size_t SC_S0 = SC_YL + (size_t)NUNIT * 16384;
constexpr size_t SC_BON = SC_S0 + (size_t)NUNIT * 8192;
constexpr size_t SC_END = SC_BON + (size_t)NUNIT * 256;
static_assert(SC_END <= WS_END, "scan scratch");
typedef unsigned u32x2 __attribute__((ext_vector_type(2)));
constexpr int BLD = 144;
constexpr int LBUF = 9216;
constexpr int LF0 = 7 * LBUF, F0P = 129;
constexpr int LF1 = LF0 + 64 * F0P * 4, F1P = 68;
constexpr int LF2 = LF1 + 64 * F1P * 4;
constexpr int LTOT = LF2 + 16384;
constexpr int LGC = LTOT + 2048;
constexpr int SCAN_LDS = LGC + 256;
static_assert(SCAN_LDS <= RING_BYTES, "scan LDS");

__device__ __forceinline__ bf16x8 ldfrag(const LAS unsigned char* mat, int blk, int ks, int lane) { return *(const LAS bf16x8*)(mat + (16 * blk + (lane & 15)) * BLD + (32 * ks + 8 * (lane >> 4)) * 2); }
#define MFMA16(a, b, c) __builtin_amdgcn_mfma_f32_16x16x32_bf16((a), (b), (c), 0, 0, 0)

__device__ __forceinline__ void scanA_unit(int l, LAS unsigned char* lds, int unit, int tid, int wave) {
    unsigned char* ws = KWS();
    const int lane = tid & 63, ci = unit >> 4, h = unit & 15, cc = 64 * h + lane;
    int m0, n; if (ci < 256) { m0 = 64 * ci; n = 64; } else { m0 = TP + 32 * (ci - 256); n = 32; }
    const float* P = (const float*)(ws + B_P); const float* Wl = (const float*)(ws + WS_RW); const float* Al = (const float*)(ws + WS_RW + RWSZ);
    LAS unsigned char* B0 = lds; LAS unsigned char* B1 = lds + LBUF; LAS unsigned char* B2 = lds + 2 * LBUF; LAS unsigned char* B3 = lds + 3 * LBUF;
    LAS unsigned char* B4 = lds + 4 * LBUF; LAS unsigned char* B5 = lds + 5 * LBUF; LAS unsigned char* B6 = lds + 6 * LBUF;
    LAS float* F0 = (LAS float*)(lds + LF0); LAS float* F1 = (LAS float*)(lds + LF1); LAS float* F2 = (LAS float*)(lds + LF2); LAS float* TOT = (LAS float*)(lds + LTOT); LAS float* GC = (LAS float*)(lds + LGC);
    __syncthreads();
    {
        const float* mu = KIN(I_MU) + (size_t)l * SHIFT;
        const float mu_r = mu[cc], mu_k = mu[RW + cc], mu_v = mu[2 * RW + cc];
        const float w0c = (KIN(I_W0) + (size_t)l * RW)[cc], a0c = (KIN(I_A0) + (size_t)l * RW)[cc], kkc = (KIN(I_KK) + (size_t)l * RW)[cc], kac = (KIN(I_KA) + (size_t)l * RW)[cc], rkc = (KIN(I_RK) + (size_t)l * RW)[cc];
        const int t0 = 8 * wave; const bool live = t0 < n;
        float r[8], kp[8], v[8], kk[8], b[8], lw[8];
        float q_r = 0.f, q_k = 0.f, q_v = 0.f;
        if (live) { const float* pp = prev_row(KIN(I_SSH), l, P, m0 + t0); if (pp) { q_r = pp[cc]; q_k = pp[RW + cc]; q_v = pp[2 * RW + cc]; } }
        float* bon = (float*)(ws + SC_BON) + (size_t)unit * 64;
#pragma unroll
        for (int i = 0; i < 8; ++i) {
            r[i] = 0.f; kp[i] = 0.f; v[i] = 0.f; kk[i] = 0.f; b[i] = 0.f; lw[i] = 0.f;
            if (live) { const size_t m = (size_t)(m0 + t0 + i); const float* pr = P + m * PLD;
                const float p_r = pr[cc], p_k = pr[RW + cc], p_v = pr[2 * RW + cc];
                const float rr = p_r + (q_r - p_r) * mu_r, kx = p_k + (q_k - p_k) * mu_k, vx = p_v + (q_v - p_v) * mu_v; q_r = p_r; q_k = p_k; q_v = p_v;
                const float av = 1.f / (1.f + __expf(-(a0c + Al[m * RW + cc])));
                const float y = -(w0c + Wl[m * RW + cc]); const float sp = fmaxf(y, 0.f) + __logf(1.0f + __expf(-fabsf(y)));
                const float kkv = kx * kkc; const float n2 = wave_sum(kkv * kkv); const float kn = kkv / fmaxf(sqrtf(n2), 1e-12f);
                const float kpv = kx * (1.f + (av - 1.f) * kac);
                const float bs = wave_sum(rr * kpv * rkc); if (lane == 0) bon[t0 + i] = bs;
                r[i] = rr; kp[i] = kpv; v[i] = vx; kk[i] = kn; b[i] = kn * av; lw[i] = -__expf(-sp - 0.5f); }
        }
        float pl[8]; pl[0] = lw[0];
#pragma unroll
        for (int i = 1; i < 8; ++i) pl[i] = pl[i - 1] + lw[i];
        TOT[wave * 64 + lane] = pl[7];
        __syncthreads();
        float off = 0.f, lamC = 0.f;
#pragma unroll
        for (int s = 0; s < 8; ++s) { const float tv = TOT[s * 64 + lane]; lamC += tv; if (s < wave) off += tv; }
        if (wave == 0) GC[lane] = __expf(lamC);
        unsigned vt[4], kb[4], bb[4];
#pragma unroll
        for (int i = 0; i < 8; ++i) { const int t = t0 + i; const float lam = off + pl[i];
            const float g_t = __expf(lam), g_p = __expf(lam - lw[i]), g_i = __expf(-lam), g_c = __expf(lamC - lam);
            const float kkt = kk[i] * g_p, rt = r[i] * g_t;
            *(LAS unsigned short*)(B0 + t * BLD + lane * 2) = (unsigned short)f2bf(kkt); F0[t * F0P + lane] = kkt;
            *(LAS unsigned short*)(B1 + t * BLD + lane * 2) = (unsigned short)f2bf(rt); F2[t * 64 + lane] = rt;
            *(LAS unsigned short*)(B2 + t * BLD + lane * 2) = (unsigned short)f2bf(kp[i] * g_i);
            *(LAS unsigned short*)(B3 + t * BLD + lane * 2) = (unsigned short)f2bf(b[i] * g_i);
            const unsigned hv = f2bf(v[i]), hk = f2bf(kp[i] * g_c), hb = f2bf(b[i] * g_c);
            if (i & 1) { vt[i >> 1] |= hv << 16; kb[i >> 1] |= hk << 16; bb[i >> 1] |= hb << 16; } else { vt[i >> 1] = hv; kb[i >> 1] = hk; bb[i >> 1] = hb; } }
        *(LAS v4u*)(B4 + lane * BLD + 16 * wave) = (v4u){vt[0], vt[1], vt[2], vt[3]};
        *(LAS v4u*)(B5 + lane * BLD + 16 * wave) = (v4u){kb[0], kb[1], kb[2], kb[3]};
        *(LAS v4u*)(B6 + lane * BLD + 16 * wave) = (v4u){bb[0], bb[1], bb[2], bb[3]};
    }
    __syncthreads();
    const int rb = wave >> 1, cb0 = (wave & 1) * 2, g = lane >> 4, lc = lane & 15;
    float zf; asm volatile("v_mov_b32 %0, 0" : "=v"(zf));
    const f32x4 z4 = (f32x4){zf, zf, zf, zf};
    {
        f32x4 aab[2] = {z4, z4}, aak[2] = {z4, z4}, arb[2] = {z4, z4}, ark[2] = {z4, z4};
#pragma unroll
        for (int ks = 0; ks < 2; ++ks) { const bf16x8 fk = ldfrag(B0, rb, ks, lane), fr = ldfrag(B1, rb, ks, lane);
#pragma unroll
            for (int c = 0; c < 2; ++c) { const bf16x8 fkh = ldfrag(B2, cb0 + c, ks, lane), fb = ldfrag(B3, cb0 + c, ks, lane);
                aab[c] = MFMA16(fk, fb, aab[c]); aak[c] = MFMA16(fk, fkh, aak[c]); arb[c] = MFMA16(fr, fb, arb[c]); ark[c] = MFMA16(fr, fkh, ark[c]); } }
        __syncthreads();
#pragma unroll
        for (int c = 0; c < 2; ++c)
#pragma unroll
            for (int rg = 0; rg < 4; ++rg) { const int t = 16 * rb + 4 * g + rg, s = 16 * (cb0 + c) + lc;
                F1[t * F1P + (s & 3) * 16 + (s >> 2)] = s < t ? aab[c][rg] : 0.f;
                *(LAS unsigned short*)(B0 + t * BLD + s * 2) = (unsigned short)f2bf(s < t ? aak[c][rg] : 0.f);
                *(LAS unsigned short*)(B1 + t * BLD + s * 2) = (unsigned short)f2bf(s <= t ? arb[c][rg] : 0.f);
                *(LAS unsigned short*)(B2 + t * BLD + s * 2) = (unsigned short)f2bf(s <= t ? ark[c][rg] : 0.f); }
    }
    __syncthreads();
    {
        f32x4 av[2] = {z4, z4};
#pragma unroll
        for (int ks = 0; ks < 2; ++ks) { const bf16x8 fa = ldfrag(B0, rb, ks, lane);
#pragma unroll
            for (int c = 0; c < 2; ++c) av[c] = MFMA16(fa, ldfrag(B4, cb0 + c, ks, lane), av[c]); }
#pragma unroll
        for (int c = 0; c < 2; ++c)
#pragma unroll
            for (int rg = 0; rg < 4; ++rg) F0[(16 * rb + 4 * g + rg) * F0P + 64 + 16 * (cb0 + c) + lc] = av[c][rg];
    }
    __syncthreads();
    {
        const int j = tid >> 2, p = tid & 3; const LAS float* f1p = F1 + p * 16; const LAS float* f0p = F0 + j;
        float x0 = zf, x1 = zf, x2 = zf, x3 = zf, x4 = zf, x5 = zf, x6 = zf, x7 = zf, x8 = zf, x9 = zf, x10 = zf, x11 = zf, x12 = zf, x13 = zf, x14 = zf, x15 = zf;
        { float part = zf; const float xt = f0p[0*F0P] - part; x0 = (p == 0) ? xt : x0; }
        { const f32x4 a0 = *(const LAS f32x4*)(f1p + 1*F1P + 0); float part = a0.x * x0; part += dpp_mov<0xB1>(part); part += dpp_mov<0x4E>(part); const float xt = f0p[1*F0P] - part; x0 = (p == 1) ? xt : x0; }
        { const f32x4 a0 = *(const LAS f32x4*)(f1p + 2*F1P + 0); float part = a0.x * x0; part += dpp_mov<0xB1>(part); part += dpp_mov<0x4E>(part); const float xt = f0p[2*F0P] - part; x0 = (p == 2) ? xt : x0; }
        { const f32x4 a0 = *(const LAS f32x4*)(f1p + 3*F1P + 0); float part = a0.x * x0; part += dpp_mov<0xB1>(part); part += dpp_mov<0x4E>(part); const float xt = f0p[3*F0P] - part; x0 = (p == 3) ? xt : x0; }
        { const f32x4 a0 = *(const LAS f32x4*)(f1p + 4*F1P + 0); float part = a0.x * x0; part += dpp_mov<0xB1>(part); part += dpp_mov<0x4E>(part); const float xt = f0p[4*F0P] - part; x1 = (p == 0) ? xt : x1; }
        { const f32x4 a0 = *(const LAS f32x4*)(f1p + 5*F1P + 0); float part = (a0.x * x0) + (a0.y * x1); part += dpp_mov<0xB1>(part); part += dpp_mov<0x4E>(part); const float xt = f0p[5*F0P] - part; x1 = (p == 1) ? xt : x1; }
        { const f32x4 a0 = *(const LAS f32x4*)(f1p + 6*F1P + 0); float part = (a0.x * x0) + (a0.y * x1); part += dpp_mov<0xB1>(part); part += dpp_mov<0x4E>(part); const float xt = f0p[6*F0P] - part; x1 = (p == 2) ? xt : x1; }
        { const f32x4 a0 = *(const LAS f32x4*)(f1p + 7*F1P + 0); float part = (a0.x * x0) + (a0.y * x1); part += dpp_mov<0xB1>(part); part += dpp_mov<0x4E>(part); const float xt = f0p[7*F0P] - part; x1 = (p == 3) ? xt : x1; }
        { const f32x4 a0 = *(const LAS f32x4*)(f1p + 8*F1P + 0); float part = (a0.x * x0) + (a0.y * x1); part += dpp_mov<0xB1>(part); part += dpp_mov<0x4E>(part); const float xt = f0p[8*F0P] - part; x2 = (p == 0) ? xt : x2; }
        { const f32x4 a0 = *(const LAS f32x4*)(f1p + 9*F1P + 0); float part = (a0.x * x0 + a0.z * x2) + (a0.y * x1); part += dpp_mov<0xB1>(part); part += dpp_mov<0x4E>(part); const float xt = f0p[9*F0P] - part; x2 = (p == 1) ? xt : x2; }
        { const f32x4 a0 = *(const LAS f32x4*)(f1p + 10*F1P + 0); float part = (a0.x * x0 + a0.z * x2) + (a0.y * x1); part += dpp_mov<0xB1>(part); part += dpp_mov<0x4E>(part); const float xt = f0p[10*F0P] - part; x2 = (p == 2) ? xt : x2; }
        { const f32x4 a0 = *(const LAS f32x4*)(f1p + 11*F1P + 0); float part = (a0.x * x0 + a0.z * x2) + (a0.y * x1); part += dpp_mov<0xB1>(part); part += dpp_mov<0x4E>(part); const float xt = f0p[11*F0P] - part; x2 = (p == 3) ? xt : x2; }
        { const f32x4 a0 = *(const LAS f32x4*)(f1p + 12*F1P + 0); float part = (a0.x * x0 + a0.z * x2) + (a0.y * x1); part += dpp_mov<0xB1>(part); part += dpp_mov<0x4E>(part); const float xt = f0p[12*F0P] - part; x3 = (p == 0) ? xt : x3; }
        { const f32x4 a0 = *(const LAS f32x4*)(f1p + 13*F1P + 0); float part = (a0.x * x0 + a0.z * x2) + (a0.y * x1 + a0.w * x3); part += dpp_mov<0xB1>(part); part += dpp_mov<0x4E>(part); const float xt = f0p[13*F0P] - part; x3 = (p == 1) ? xt : x3; }
        { const f32x4 a0 = *(const LAS f32x4*)(f1p + 14*F1P + 0); float part = (a0.x * x0 + a0.z * x2) + (a0.y * x1 + a0.w * x3); part += dpp_mov<0xB1>(part); part += dpp_mov<0x4E>(part); const float xt = f0p[14*F0P] - part; x3 = (p == 2) ? xt : x3; }
        { const f32x4 a0 = *(const LAS f32x4*)(f1p + 15*F1P + 0); float part = (a0.x * x0 + a0.z * x2) + (a0.y * x1 + a0.w * x3); part += dpp_mov<0xB1>(part); part += dpp_mov<0x4E>(part); const float xt = f0p[15*F0P] - part; x3 = (p == 3) ? xt : x3; }
        { const f32x4 a0 = *(const LAS f32x4*)(f1p + 16*F1P + 0); float part = (a0.x * x0 + a0.z * x2) + (a0.y * x1 + a0.w * x3); part += dpp_mov<0xB1>(part); part += dpp_mov<0x4E>(part); const float xt = f0p[16*F0P] - part; x4 = (p == 0) ? xt : x4; }
        { const f32x4 a0 = *(const LAS f32x4*)(f1p + 17*F1P + 0); const f32x4 a1 = *(const LAS f32x4*)(f1p + 17*F1P + 4); float part = (a0.x * x0 + a0.z * x2 + a1.x * x4) + (a0.y * x1 + a0.w * x3); part += dpp_mov<0xB1>(part); part += dpp_mov<0x4E>(part); const float xt = f0p[17*F0P] - part; x4 = (p == 1) ? xt : x4; }
        { const f32x4 a0 = *(const LAS f32x4*)(f1p + 18*F1P + 0); const f32x4 a1 = *(const LAS f32x4*)(f1p + 18*F1P + 4); float part = (a0.x * x0 + a0.z * x2 + a1.x * x4) + (a0.y * x1 + a0.w * x3); part += dpp_mov<0xB1>(part); part += dpp_mov<0x4E>(part); const float xt = f0p[18*F0P] - part; x4 = (p == 2) ? xt : x4; }
        { const f32x4 a0 = *(const LAS f32x4*)(f1p + 19*F1P + 0); const f32x4 a1 = *(const LAS f32x4*)(f1p + 19*F1P + 4); float part = (a0.x * x0 + a0.z * x2 + a1.x * x4) + (a0.y * x1 + a0.w * x3); part += dpp_mov<0xB1>(part); part += dpp_mov<0x4E>(part); const float xt = f0p[19*F0P] - part; x4 = (p == 3) ? xt : x4; }
        { const f32x4 a0 = *(const LAS f32x4*)(f1p + 20*F1P + 0); const f32x4 a1 = *(const LAS f32x4*)(f1p + 20*F1P + 4); float part = (a0.x * x0 + a0.z * x2 + a1.x * x4) + (a0.y * x1 + a0.w * x3); part += dpp_mov<0xB1>(part); part += dpp_mov<0x4E>(part); const float xt = f0p[20*F0P] - part; x5 = (p == 0) ? xt : x5; }
        { const f32x4 a0 = *(const LAS f32x4*)(f1p + 21*F1P + 0); const f32x4 a1 = *(const LAS f32x4*)(f1p + 21*F1P + 4); float part = (a0.x * x0 + a0.z * x2 + a1.x * x4) + (a0.y * x1 + a0.w * x3 + a1.y * x5); part += dpp_mov<0xB1>(part); part += dpp_mov<0x4E>(part); const float xt = f0p[21*F0P] - part; x5 = (p == 1) ? xt : x5; }
        { const f32x4 a0 = *(const LAS f32x4*)(f1p + 22*F1P + 0); const f32x4 a1 = *(const LAS f32x4*)(f1p + 22*F1P + 4); float part = (a0.x * x0 + a0.z * x2 + a1.x * x4) + (a0.y * x1 + a0.w * x3 + a1.y * x5); part += dpp_mov<0xB1>(part); part += dpp_mov<0x4E>(part); const float xt = f0p[22*F0P] - part; x5 = (p == 2) ? xt : x5; }
        { const f32x4 a0 = *(const LAS f32x4*)(f1p + 23*F1P + 0); const f32x4 a1 = *(const LAS f32x4*)(f1p + 23*F1P + 4); float part = (a0.x * x0 + a0.z * x2 + a1.x * x4) + (a0.y * x1 + a0.w * x3 + a1.y * x5); part += dpp_mov<0xB1>(part); part += dpp_mov<0x4E>(part); const float xt = f0p[23*F0P] - part; x5 = (p == 3) ? xt : x5; }
        { const f32x4 a0 = *(const LAS f32x4*)(f1p + 24*F1P + 0); const f32x4 a1 = *(const LAS f32x4*)(f1p + 24*F1P + 4); float part = (a0.x * x0 + a0.z * x2 + a1.x * x4) + (a0.y * x1 + a0.w * x3 + a1.y * x5); part += dpp_mov<0xB1>(part); part += dpp_mov<0x4E>(part); const float xt = f0p[24*F0P] - part; x6 = (p == 0) ? xt : x6; }
        { const f32x4 a0 = *(const LAS f32x4*)(f1p + 25*F1P + 0); const f32x4 a1 = *(const LAS f32x4*)(f1p + 25*F1P + 4); float part = (a0.x * x0 + a0.z * x2 + a1.x * x4 + a1.z * x6) + (a0.y * x1 + a0.w * x3 + a1.y * x5); part += dpp_mov<0xB1>(part); part += dpp_mov<0x4E>(part); const float xt = f0p[25*F0P] - part; x6 = (p == 1) ? xt : x6; }
        { const f32x4 a0 = *(const LAS f32x4*)(f1p + 26*F1P + 0); const f32x4 a1 = *(const LAS f32x4*)(f1p + 26*F1P + 4); float part = (a0.x * x0 + a0.z * x2 + a1.x * x4 + a1.z * x6) + (a0.y * x1 + a0.w * x3 + a1.y * x5); part += dpp_mov<0xB1>(part); part += dpp_mov<0x4E>(part); const float xt = f0p[26*F0P] - part; x6 = (p == 2) ? xt : x6; }
        { const f32x4 a0 = *(const LAS f32x4*)(f1p + 27*F1P + 0); const f32x4 a1 = *(const LAS f32x4*)(f1p + 27*F1P + 4); float part = (a0.x * x0 + a0.z * x2 + a1.x * x4 + a1.z * x6) + (a0.y * x1 + a0.w * x3 + a1.y * x5); part += dpp_mov<0xB1>(part); part += dpp_mov<0x4E>(part); const float xt = f0p[27*F0P] - part; x6 = (p == 3) ? xt : x6; }
        { const f32x4 a0 = *(const LAS f32x4*)(f1p + 28*F1P + 0); const f32x4 a1 = *(const LAS f32x4*)(f1p + 28*F1P + 4); float part = (a0.x * x0 + a0.z * x2 + a1.x * x4 + a1.z * x6) + (a0.y * x1 + a0.w * x3 + a1.y * x5); part += dpp_mov<0xB1>(part); part += dpp_mov<0x4E>(part); const float xt = f0p[28*F0P] - part; x7 = (p == 0) ? xt : x7; }
        { const f32x4 a0 = *(const LAS f32x4*)(f1p + 29*F1P + 0); const f32x4 a1 = *(const LAS f32x4*)(f1p + 29*F1P + 4); float part = (a0.x * x0 + a0.z * x2 + a1.x * x4 + a1.z * x6) + (a0.y * x1 + a0.w * x3 + a1.y * x5 + a1.w * x7); part += dpp_mov<0xB1>(part); part += dpp_mov<0x4E>(part); const float xt = f0p[29*F0P] - part; x7 = (p == 1) ? xt : x7; }
        { const f32x4 a0 = *(const LAS f32x4*)(f1p + 30*F1P + 0); const f32x4 a1 = *(const LAS f32x4*)(f1p + 30*F1P + 4); float part = (a0.x * x0 + a0.z * x2 + a1.x * x4 + a1.z * x6) + (a0.y * x1 + a0.w * x3 + a1.y * x5 + a1.w * x7); part += dpp_mov<0xB1>(part); part += dpp_mov<0x4E>(part); const float xt = f0p[30*F0P] - part; x7 = (p == 2) ? xt : x7; }
        { const f32x4 a0 = *(const LAS f32x4*)(f1p + 31*F1P + 0); const f32x4 a1 = *(const LAS f32x4*)(f1p + 31*F1P + 4); float part = (a0.x * x0 + a0.z * x2 + a1.x * x4 + a1.z * x6) + (a0.y * x1 + a0.w * x3 + a1.y * x5 + a1.w * x7); part += dpp_mov<0xB1>(part); part += dpp_mov<0x4E>(part); const float xt = f0p[31*F0P] - part; x7 = (p == 3) ? xt : x7; }
        { const f32x4 a0 = *(const LAS f32x4*)(f1p + 32*F1P + 0); const f32x4 a1 = *(const LAS f32x4*)(f1p + 32*F1P + 4); float part = (a0.x * x0 + a0.z * x2 + a1.x * x4 + a1.z * x6) + (a0.y * x1 + a0.w * x3 + a1.y * x5 + a1.w * x7); part += dpp_mov<0xB1>(part); part += dpp_mov<0x4E>(part); const float xt = f0p[32*F0P] - part; x8 = (p == 0) ? xt : x8; }
        { const f32x4 a0 = *(const LAS f32x4*)(f1p + 33*F1P + 0); const f32x4 a1 = *(const LAS f32x4*)(f1p + 33*F1P + 4); const f32x4 a2 = *(const LAS f32x4*)(f1p + 33*F1P + 8); float part = (a0.x * x0 + a0.z * x2 + a1.x * x4 + a1.z * x6 + a2.x * x8) + (a0.y * x1 + a0.w * x3 + a1.y * x5 + a1.w * x7); part += dpp_mov<0xB1>(part); part += dpp_mov<0x4E>(part); const float xt = f0p[33*F0P] - part; x8 = (p == 1) ? xt : x8; }
        { const f32x4 a0 = *(const LAS f32x4*)(f1p + 34*F1P + 0); const f32x4 a1 = *(const LAS f32x4*)(f1p + 34*F1P + 4); const f32x4 a2 = *(const LAS f32x4*)(f1p + 34*F1P + 8); float part = (a0.x * x0 + a0.z * x2 + a1.x * x4 + a1.z * x6 + a2.x * x8) + (a0.y * x1 + a0.w * x3 + a1.y * x5 + a1.w * x7); part += dpp_mov<0xB1>(part); part += dpp_mov<0x4E>(part); const float xt = f0p[34*F0P] - part; x8 = (p == 2) ? xt : x8; }
        { const f32x4 a0 = *(const LAS f32x4*)(f1p + 35*F1P + 0); const f32x4 a1 = *(const LAS f32x4*)(f1p + 35*F1P + 4); const f32x4 a2 = *(const LAS f32x4*)(f1p + 35*F1P + 8); float part = (a0.x * x0 + a0.z * x2 + a1.x * x4 + a1.z * x6 + a2.x * x8) + (a0.y * x1 + a0.w * x3 + a1.y * x5 + a1.w * x7); part += dpp_mov<0xB1>(part); part += dpp_mov<0x4E>(part); const float xt = f0p[35*F0P] - part; x8 = (p == 3) ? xt : x8; }
        { const f32x4 a0 = *(const LAS f32x4*)(f1p + 36*F1P + 0); const f32x4 a1 = *(const LAS f32x4*)(f1p + 36*F1P + 4); const f32x4 a2 = *(const LAS f32x4*)(f1p + 36*F1P + 8); float part = (a0.x * x0 + a0.z * x2 + a1.x * x4 + a1.z * x6 + a2.x * x8) + (a0.y * x1 + a0.w * x3 + a1.y * x5 + a1.w * x7); part += dpp_mov<0xB1>(part); part += dpp_mov<0x4E>(part); const float xt = f0p[36*F0P] - part; x9 = (p == 0) ? xt : x9; }
        { const f32x4 a0 = *(const LAS f32x4*)(f1p + 37*F1P + 0); const f32x4 a1 = *(const LAS f32x4*)(f1p + 37*F1P + 4); const f32x4 a2 = *(const LAS f32x4*)(f1p + 37*F1P + 8); float part = (a0.x * x0 + a0.z * x2 + a1.x * x4 + a1.z * x6 + a2.x * x8) + (a0.y * x1 + a0.w * x3 + a1.y * x5 + a1.w * x7 + a2.y * x9); part += dpp_mov<0xB1>(part); part += dpp_mov<0x4E>(part); const float xt = f0p[37*F0P] - part; x9 = (p == 1) ? xt : x9; }
        { const f32x4 a0 = *(const LAS f32x4*)(f1p + 38*F1P + 0); const f32x4 a1 = *(const LAS f32x4*)(f1p + 38*F1P + 4); const f32x4 a2 = *(const LAS f32x4*)(f1p + 38*F1P + 8); float part = (a0.x * x0 + a0.z * x2 + a1.x * x4 + a1.z * x6 + a2.x * x8) + (a0.y * x1 + a0.w * x3 + a1.y * x5 + a1.w * x7 + a2.y * x9); part += dpp_mov<0xB1>(part); part += dpp_mov<0x4E>(part); const float xt = f0p[38*F0P] - part; x9 = (p == 2) ? xt : x9; }
        { const f32x4 a0 = *(const LAS f32x4*)(f1p + 39*F1P + 0); const f32x4 a1 = *(const LAS f32x4*)(f1p + 39*F1P + 4); const f32x4 a2 = *(const LAS f32x4*)(f1p + 39*F1P + 8); float part = (a0.x * x0 + a0.z * x2 + a1.x * x4 + a1.z * x6 + a2.x * x8) + (a0.y * x1 + a0.w * x3 + a1.y * x5 + a1.w * x7 + a2.y * x9); part += dpp_mov<0xB1>(part); part += dpp_mov<0x4E>(part); const float xt = f0p[39*F0P] - part; x9 = (p == 3) ? xt : x9; }
        { const f32x4 a0 = *(const LAS f32x4*)(f1p + 40*F1P + 0); const f32x4 a1 = *(const LAS f32x4*)(f1p + 40*F1P + 4); const f32x4 a2 = *(const LAS f32x4*)(f1p + 40*F1P + 8); float part = (a0.x * x0 + a0.z * x2 + a1.x * x4 + a1.z * x6 + a2.x * x8) + (a0.y * x1 + a0.w * x3 + a1.y * x5 + a1.w * x7 + a2.y * x9); part += dpp_mov<0xB1>(part); part += dpp_mov<0x4E>(part); const float xt = f0p[40*F0P] - part; x10 = (p == 0) ? xt : x10; }
        { const f32x4 a0 = *(const LAS f32x4*)(f1p + 41*F1P + 0); const f32x4 a1 = *(const LAS f32x4*)(f1p + 41*F1P + 4); const f32x4 a2 = *(const LAS f32x4*)(f1p + 41*F1P + 8); float part = (a0.x * x0 + a0.z * x2 + a1.x * x4 + a1.z * x6 + a2.x * x8 + a2.z * x10) + (a0.y * x1 + a0.w * x3 + a1.y * x5 + a1.w * x7 + a2.y * x9); part += dpp_mov<0xB1>(part); part += dpp_mov<0x4E>(part); const float xt = f0p[41*F0P] - part; x10 = (p == 1) ? xt : x10; }
        { const f32x4 a0 = *(const LAS f32x4*)(f1p + 42*F1P + 0); const f32x4 a1 = *(const LAS f32x4*)(f1p + 42*F1P + 4); const f32x4 a2 = *(const LAS f32x4*)(f1p + 42*F1P + 8); float part = (a0.x * x0 + a0.z * x2 + a1.x * x4 + a1.z * x6 + a2.x * x8 + a2.z * x10) + (a0.y * x1 + a0.w * x3 + a1.y * x5 + a1.w * x7 + a2.y * x9); part += dpp_mov<0xB1>(part); part += dpp_mov<0x4E>(part); const float xt = f0p[42*F0P] - part; x10 = (p == 2) ? xt : x10; }
        { const f32x4 a0 = *(const LAS f32x4*)(f1p + 43*F1P + 0); const f32x4 a1 = *(const LAS f32x4*)(f1p + 43*F1P + 4); const f32x4 a2 = *(const LAS f32x4*)(f1p + 43*F1P + 8); float part = (a0.x * x0 + a0.z * x2 + a1.x * x4 + a1.z * x6 + a2.x * x8 + a2.z * x10) + (a0.y * x1 + a0.w * x3 + a1.y * x5 + a1.w * x7 + a2.y * x9); part += dpp_mov<0xB1>(part); part += dpp_mov<0x4E>(part); const float xt = f0p[43*F0P] - part; x10 = (p == 3) ? xt : x10; }
        { const f32x4 a0 = *(const LAS f32x4*)(f1p + 44*F1P + 0); const f32x4 a1 = *(const LAS f32x4*)(f1p + 44*F1P + 4); const f32x4 a2 = *(const LAS f32x4*)(f1p + 44*F1P + 8); float part = (a0.x * x0 + a0.z * x2 + a1.x * x4 + a1.z * x6 + a2.x * x8 + a2.z * x10) + (a0.y * x1 + a0.w * x3 + a1.y * x5 + a1.w * x7 + a2.y * x9); part += dpp_mov<0xB1>(part); part += dpp_mov<0x4E>(part); const float xt = f0p[44*F0P] - part; x11 = (p == 0) ? xt : x11; }
        { const f32x4 a0 = *(const LAS f32x4*)(f1p + 45*F1P + 0); const f32x4 a1 = *(const LAS f32x4*)(f1p + 45*F1P + 4); const f32x4 a2 = *(const LAS f32x4*)(f1p + 45*F1P + 8); float part = (a0.x * x0 + a0.z * x2 + a1.x * x4 + a1.z * x6 + a2.x * x8 + a2.z * x10) + (a0.y * x1 + a0.w * x3 + a1.y * x5 + a1.w * x7 + a2.y * x9 + a2.w * x11); part += dpp_mov<0xB1>(part); part += dpp_mov<0x4E>(part); const float xt = f0p[45*F0P] - part; x11 = (p == 1) ? xt : x11; }
        { const f32x4 a0 = *(const LAS f32x4*)(f1p + 46*F1P + 0); const f32x4 a1 = *(const LAS f32x4*)(f1p + 46*F1P + 4); const f32x4 a2 = *(const LAS f32x4*)(f1p + 46*F1P + 8); float part = (a0.x * x0 + a0.z * x2 + a1.x * x4 + a1.z * x6 + a2.x * x8 + a2.z * x10) + (a0.y * x1 + a0.w * x3 + a1.y * x5 + a1.w * x7 + a2.y * x9 + a2.w * x11); part += dpp_mov<0xB1>(part); part += dpp_mov<0x4E>(part); const float xt = f0p[46*F0P] - part; x11 = (p == 2) ? xt : x11; }
        { const f32x4 a0 = *(const LAS f32x4*)(f1p + 47*F1P + 0); const f32x4 a1 = *(const LAS f32x4*)(f1p + 47*F1P + 4); const f32x4 a2 = *(const LAS f32x4*)(f1p + 47*F1P + 8); float part = (a0.x * x0 + a0.z * x2 + a1.x * x4 + a1.z * x6 + a2.x * x8 + a2.z * x10) + (a0.y * x1 + a0.w * x3 + a1.y * x5 + a1.w * x7 + a2.y * x9 + a2.w * x11); part += dpp_mov<0xB1>(part); part += dpp_mov<0x4E>(part); const float xt = f0p[47*F0P] - part; x11 = (p == 3) ? xt : x11; }
        { const f32x4 a0 = *(const LAS f32x4*)(f1p + 48*F1P + 0); const f32x4 a1 = *(const LAS f32x4*)(f1p + 48*F1P + 4); const f32x4 a2 = *(const LAS f32x4*)(f1p + 48*F1P + 8); float part = (a0.x * x0 + a0.z * x2 + a1.x * x4 + a1.z * x6 + a2.x * x8 + a2.z * x10) + (a0.y * x1 + a0.w * x3 + a1.y * x5 + a1.w * x7 + a2.y * x9 + a2.w * x11); part += dpp_mov<0xB1>(part); part += dpp_mov<0x4E>(part); const float xt = f0p[48*F0P] - part; x12 = (p == 0) ? xt : x12; }
        { const f32x4 a0 = *(const LAS f32x4*)(f1p + 49*F1P + 0); const f32x4 a1 = *(const LAS f32x4*)(f1p + 49*F1P + 4); const f32x4 a2 = *(const LAS f32x4*)(f1p + 49*F1P + 8); const f32x4 a3 = *(const LAS f32x4*)(f1p + 49*F1P + 12); float part = (a0.x * x0 + a0.z * x2 + a1.x * x4 + a1.z * x6 + a2.x * x8 + a2.z * x10 + a3.x * x12) + (a0.y * x1 + a0.w * x3 + a1.y * x5 + a1.w * x7 + a2.y * x9 + a2.w * x11); part += dpp_mov<0xB1>(part); part += dpp_mov<0x4E>(part); const float xt = f0p[49*F0P] - part; x12 = (p == 1) ? xt : x12; }
        { const f32x4 a0 = *(const LAS f32x4*)(f1p + 50*F1P + 0); const f32x4 a1 = *(const LAS f32x4*)(f1p + 50*F1P + 4); const f32x4 a2 = *(const LAS f32x4*)(f1p + 50*F1P + 8); const f32x4 a3 = *(const LAS f32x4*)(f1p + 50*F1P + 12); float part = (a0.x * x0 + a0.z * x2 + a1.x * x4 + a1.z * x6 + a2.x * x8 + a2.z * x10 + a3.x * x12) + (a0.y * x1 + a0.w * x3 + a1.y * x5 + a1.w * x7 + a2.y * x9 + a2.w * x11); part += dpp_mov<0xB1>(part); part += dpp_mov<0x4E>(part); const float xt = f0p[50*F0P] - part; x12 = (p == 2) ? xt : x12; }
        { const f32x4 a0 = *(const LAS f32x4*)(f1p + 51*F1P + 0); const f32x4 a1 = *(const LAS f32x4*)(f1p + 51*F1P + 4); const f32x4 a2 = *(const LAS f32x4*)(f1p + 51*F1P + 8); const f32x4 a3 = *(const LAS f32x4*)(f1p + 51*F1P + 12); float part = (a0.x * x0 + a0.z * x2 + a1.x * x4 + a1.z * x6 + a2.x * x8 + a2.z * x10 + a3.x * x12) + (a0.y * x1 + a0.w * x3 + a1.y * x5 + a1.w * x7 + a2.y * x9 + a2.w * x11); part += dpp_mov<0xB1>(part); part += dpp_mov<0x4E>(part); const float xt = f0p[51*F0P] - part; x12 = (p == 3) ? xt : x12; }
        { const f32x4 a0 = *(const LAS f32x4*)(f1p + 52*F1P + 0); const f32x4 a1 = *(const LAS f32x4*)(f1p + 52*F1P + 4); const f32x4 a2 = *(const LAS f32x4*)(f1p + 52*F1P + 8); const f32x4 a3 = *(const LAS f32x4*)(f1p + 52*F1P + 12); float part = (a0.x * x0 + a0.z * x2 + a1.x * x4 + a1.z * x6 + a2.x * x8 + a2.z * x10 + a3.x * x12) + (a0.y * x1 + a0.w * x3 + a1.y * x5 + a1.w * x7 + a2.y * x9 + a2.w * x11); part += dpp_mov<0xB1>(part); part += dpp_mov<0x4E>(part); const float xt = f0p[52*F0P] - part; x13 = (p == 0) ? xt : x13; }
        { const f32x4 a0 = *(const LAS f32x4*)(f1p + 53*F1P + 0); const f32x4 a1 = *(const LAS f32x4*)(f1p + 53*F1P + 4); const f32x4 a2 = *(const LAS f32x4*)(f1p + 53*F1P + 8); const f32x4 a3 = *(const LAS f32x4*)(f1p + 53*F1P + 12); float part = (a0.x * x0 + a0.z * x2 + a1.x * x4 + a1.z * x6 + a2.x * x8 + a2.z * x10 + a3.x * x12) + (a0.y * x1 + a0.w * x3 + a1.y * x5 + a1.w * x7 + a2.y * x9 + a2.w * x11 + a3.y * x13); part += dpp_mov<0xB1>(part); part += dpp_mov<0x4E>(part); const float xt = f0p[53*F0P] - part; x13 = (p == 1) ? xt : x13; }
        { const f32x4 a0 = *(const LAS f32x4*)(f1p + 54*F1P + 0); const f32x4 a1 = *(const LAS f32x4*)(f1p + 54*F1P + 4); const f32x4 a2 = *(const LAS f32x4*)(f1p + 54*F1P + 8); const f32x4 a3 = *(const LAS f32x4*)(f1p + 54*F1P + 12); float part = (a0.x * x0 + a0.z * x2 + a1.x * x4 + a1.z * x6 + a2.x * x8 + a2.z * x10 + a3.x * x12) + (a0.y * x1 + a0.w * x3 + a1.y * x5 + a1.w * x7 + a2.y * x9 + a2.w * x11 + a3.y * x13); part += dpp_mov<0xB1>(part); part += dpp_mov<0x4E>(part); const float xt = f0p[54*F0P] - part; x13 = (p == 2) ? xt : x13; }
        { const f32x4 a0 = *(const LAS f32x4*)(f1p + 55*F1P + 0); const f32x4 a1 = *(const LAS f32x4*)(f1p + 55*F1P + 4); const f32x4 a2 = *(const LAS f32x4*)(f1p + 55*F1P + 8); const f32x4 a3 = *(const LAS f32x4*)(f1p + 55*F1P + 12); float part = (a0.x * x0 + a0.z * x2 + a1.x * x4 + a1.z * x6 + a2.x * x8 + a2.z * x10 + a3.x * x12) + (a0.y * x1 + a0.w * x3 + a1.y * x5 + a1.w * x7 + a2.y * x9 + a2.w * x11 + a3.y * x13); part += dpp_mov<0xB1>(part); part += dpp_mov<0x4E>(part); const float xt = f0p[55*F0P] - part; x13 = (p == 3) ? xt : x13; }
        { const f32x4 a0 = *(const LAS f32x4*)(f1p + 56*F1P + 0); const f32x4 a1 = *(const LAS f32x4*)(f1p + 56*F1P + 4); const f32x4 a2 = *(const LAS f32x4*)(f1p + 56*F1P + 8); const f32x4 a3 = *(const LAS f32x4*)(f1p + 56*F1P + 12); float part = (a0.x * x0 + a0.z * x2 + a1.x * x4 + a1.z * x6 + a2.x * x8 + a2.z * x10 + a3.x * x12) + (a0.y * x1 + a0.w * x3 + a1.y * x5 + a1.w * x7 + a2.y * x9 + a2.w * x11 + a3.y * x13); part += dpp_mov<0xB1>(part); part += dpp_mov<0x4E>(part); const float xt = f0p[56*F0P] - part; x14 = (p == 0) ? xt : x14; }
        { const f32x4 a0 = *(const LAS f32x4*)(f1p + 57*F1P + 0); const f32x4 a1 = *(const LAS f32x4*)(f1p + 57*F1P + 4); const f32x4 a2 = *(const LAS f32x4*)(f1p + 57*F1P + 8); const f32x4 a3 = *(const LAS f32x4*)(f1p + 57*F1P + 12); float part = (a0.x * x0 + a0.z * x2 + a1.x * x4 + a1.z * x6 + a2.x * x8 + a2.z * x10 + a3.x * x12 + a3.z * x14) + (a0.y * x1 + a0.w * x3 + a1.y * x5 + a1.w * x7 + a2.y * x9 + a2.w * x11 + a3.y * x13); part += dpp_mov<0xB1>(part); part += dpp_mov<0x4E>(part); const float xt = f0p[57*F0P] - part; x14 = (p == 1) ? xt : x14; }
        { const f32x4 a0 = *(const LAS f32x4*)(f1p + 58*F1P + 0); const f32x4 a1 = *(const LAS f32x4*)(f1p + 58*F1P + 4); const f32x4 a2 = *(const LAS f32x4*)(f1p + 58*F1P + 8); const f32x4 a3 = *(const LAS f32x4*)(f1p + 58*F1P + 12); float part = (a0.x * x0 + a0.z * x2 + a1.x * x4 + a1.z * x6 + a2.x * x8 + a2.z * x10 + a3.x * x12 + a3.z * x14) + (a0.y * x1 + a0.w * x3 + a1.y * x5 + a1.w * x7 + a2.y * x9 + a2.w * x11 + a3.y * x13); part += dpp_mov<0xB1>(part); part += dpp_mov<0x4E>(part); const float xt = f0p[58*F0P] - part; x14 = (p == 2) ? xt : x14; }
        { const f32x4 a0 = *(const LAS f32x4*)(f1p + 59*F1P + 0); const f32x4 a1 = *(const LAS f32x4*)(f1p + 59*F1P + 4); const f32x4 a2 = *(const LAS f32x4*)(f1p + 59*F1P + 8); const f32x4 a3 = *(const LAS f32x4*)(f1p + 59*F1P + 12); float part = (a0.x * x0 + a0.z * x2 + a1.x * x4 + a1.z * x6 + a2.x * x8 + a2.z * x10 + a3.x * x12 + a3.z * x14) + (a0.y * x1 + a0.w * x3 + a1.y * x5 + a1.w * x7 + a2.y * x9 + a2.w * x11 + a3.y * x13); part += dpp_mov<0xB1>(part); part += dpp_mov<0x4E>(part); const float xt = f0p[59*F0P] - part; x14 = (p == 3) ? xt : x14; }
        { const f32x4 a0 = *(const LAS f32x4*)(f1p + 60*F1P + 0); const f32x4 a1 = *(const LAS f32x4*)(f1p + 60*F1P + 4); const f32x4 a2 = *(const LAS f32x4*)(f1p + 60*F1P + 8); const f32x4 a3 = *(const LAS f32x4*)(f1p + 60*F1P + 12); float part = (a0.x * x0 + a0.z * x2 + a1.x * x4 + a1.z * x6 + a2.x * x8 + a2.z * x10 + a3.x * x12 + a3.z * x14) + (a0.y * x1 + a0.w * x3 + a1.y * x5 + a1.w * x7 + a2.y * x9 + a2.w * x11 + a3.y * x13); part += dpp_mov<0xB1>(part); part += dpp_mov<0x4E>(part); const float xt = f0p[60*F0P] - part; x15 = (p == 0) ? xt : x15; }
        { const f32x4 a0 = *(const LAS f32x4*)(f1p + 61*F1P + 0); const f32x4 a1 = *(const LAS f32x4*)(f1p + 61*F1P + 4); const f32x4 a2 = *(const LAS f32x4*)(f1p + 61*F1P + 8); const f32x4 a3 = *(const LAS f32x4*)(f1p + 61*F1P + 12); float part = (a0.x * x0 + a0.z * x2 + a1.x * x4 + a1.z * x6 + a2.x * x8 + a2.z * x10 + a3.x * x12 + a3.z * x14) + (a0.y * x1 + a0.w * x3 + a1.y * x5 + a1.w * x7 + a2.y * x9 + a2.w * x11 + a3.y * x13 + a3.w * x15); part += dpp_mov<0xB1>(part); part += dpp_mov<0x4E>(part); const float xt = f0p[61*F0P] - part; x15 = (p == 1) ? xt : x15; }
        { const f32x4 a0 = *(const LAS f32x4*)(f1p + 62*F1P + 0); const f32x4 a1 = *(const LAS f32x4*)(f1p + 62*F1P + 4); const f32x4 a2 = *(const LAS f32x4*)(f1p + 62*F1P + 8); const f32x4 a3 = *(const LAS f32x4*)(f1p + 62*F1P + 12); float part = (a0.x * x0 + a0.z * x2 + a1.x * x4 + a1.z * x6 + a2.x * x8 + a2.z * x10 + a3.x * x12 + a3.z * x14) + (a0.y * x1 + a0.w * x3 + a1.y * x5 + a1.w * x7 + a2.y * x9 + a2.w * x11 + a3.y * x13 + a3.w * x15); part += dpp_mov<0xB1>(part); part += dpp_mov<0x4E>(part); const float xt = f0p[62*F0P] - part; x15 = (p == 2) ? xt : x15; }
        { const f32x4 a0 = *(const LAS f32x4*)(f1p + 63*F1P + 0); const f32x4 a1 = *(const LAS f32x4*)(f1p + 63*F1P + 4); const f32x4 a2 = *(const LAS f32x4*)(f1p + 63*F1P + 8); const f32x4 a3 = *(const LAS f32x4*)(f1p + 63*F1P + 12); float part = (a0.x * x0 + a0.z * x2 + a1.x * x4 + a1.z * x6 + a2.x * x8 + a2.z * x10 + a3.x * x12 + a3.z * x14) + (a0.y * x1 + a0.w * x3 + a1.y * x5 + a1.w * x7 + a2.y * x9 + a2.w * x11 + a3.y * x13 + a3.w * x15); part += dpp_mov<0xB1>(part); part += dpp_mov<0x4E>(part); const float xt = f0p[63*F0P] - part; x15 = (p == 3) ? xt : x15; }
        LAS unsigned char* dst = (wave < 4 ? B3 : B0) + (j & 63) * BLD + p * 2;
        *(LAS unsigned short*)(dst + 0) = (unsigned short)f2bf(-x0);
        *(LAS unsigned short*)(dst + 8) = (unsigned short)f2bf(-x1);
        *(LAS unsigned short*)(dst + 16) = (unsigned short)f2bf(-x2);
        *(LAS unsigned short*)(dst + 24) = (unsigned short)f2bf(-x3);
        *(LAS unsigned short*)(dst + 32) = (unsigned short)f2bf(-x4);
        *(LAS unsigned short*)(dst + 40) = (unsigned short)f2bf(-x5);
        *(LAS unsigned short*)(dst + 48) = (unsigned short)f2bf(-x6);
        *(LAS unsigned short*)(dst + 56) = (unsigned short)f2bf(-x7);
        *(LAS unsigned short*)(dst + 64) = (unsigned short)f2bf(-x8);
        *(LAS unsigned short*)(dst + 72) = (unsigned short)f2bf(-x9);
        *(LAS unsigned short*)(dst + 80) = (unsigned short)f2bf(-x10);
        *(LAS unsigned short*)(dst + 88) = (unsigned short)f2bf(-x11);
        *(LAS unsigned short*)(dst + 96) = (unsigned short)f2bf(-x12);
        *(LAS unsigned short*)(dst + 104) = (unsigned short)f2bf(-x13);
        *(LAS unsigned short*)(dst + 112) = (unsigned short)f2bf(-x14);
        *(LAS unsigned short*)(dst + 120) = (unsigned short)f2bf(-x15);
    }
    __syncthreads();
    {
        f32x4 rp[2], yl[2] = {z4, z4}, gg[2], hl[2] = {z4, z4};
#pragma unroll
        for (int c = 0; c < 2; ++c)
#pragma unroll
            for (int rg = 0; rg < 4; ++rg) { const int row = 16 * rb + 4 * g + rg, col = 16 * (cb0 + c) + lc; rp[c][rg] = F2[row * 64 + col]; gg[c][rg] = row == col ? GC[row] : 0.f; }
#pragma unroll
        for (int ks = 0; ks < 2; ++ks) { const bf16x8 farb = ldfrag(B1, rb, ks, lane), fark = ldfrag(B2, rb, ks, lane), fbb = ldfrag(B6, rb, ks, lane), fkb = ldfrag(B5, rb, ks, lane);
#pragma unroll
            for (int c = 0; c < 2; ++c) { const bf16x8 fp = ldfrag(B3, cb0 + c, ks, lane), fq = ldfrag(B0, cb0 + c, ks, lane), fv = ldfrag(B4, cb0 + c, ks, lane);
                rp[c] = MFMA16(farb, fp, rp[c]); yl[c] = MFMA16(fark, fv, yl[c]); yl[c] = MFMA16(farb, fq, yl[c]);
                gg[c] = MFMA16(fbb, fp, gg[c]); hl[c] = MFMA16(fkb, fv, hl[c]); hl[c] = MFMA16(fbb, fq, hl[c]); } }
        bf16* RPg = (bf16*)(ws + SC_RP) + (size_t)unit * 4096; float* YLg = (float*)(ws + SC_YL) + (size_t)unit * 4096; bf16* Gg_ = (bf16*)(ws + SC_G) + (size_t)unit * 4096; float* HLg = (float*)(ws + SC_HL) + (size_t)unit * 4096;
#pragma unroll
        for (int c = 0; c < 2; ++c)
#pragma unroll
            for (int rg = 0; rg < 4; ++rg) { const int o = (16 * rb + 4 * g + rg) * 64 + 16 * (cb0 + c) + lc;
                RPg[o] = (bf16)f2bf(rp[c][rg]); YLg[o] = yl[c][rg]; Gg_[o] = (bf16)f2bf(gg[c][rg]); HLg[o] = hl[c][rg]; }
    }
}

template <int NSTEP, int PF> __device__ __forceinline__ void scanB_chain(int l, LAS unsigned char* lds, int ci0, int h, int vs, const float* init, float* outp_state, int tid, int wave) {
    unsigned char* ws = KWS();
    const int lane = tid & 63, half = wave >> 2, jr = wave & 3, g = lane >> 4, lc = lane & 15;
    LAS unsigned char* XH = lds + half * 16384;
    const bf16* Gall = (const bf16*)(ws + SC_G); const float* HLall = (const float*)(ws + SC_HL); bf16* S0all = (bf16*)(ws + SC_S0);
    float zf; asm volatile("v_mov_b32 %0, 0" : "=v"(zf));
    f32x4 acc = (f32x4){zf, zf, zf, zf};
    __syncthreads();
    if (init) acc = *(const f32x4*)(init + (16 * vs + lc) * 64 + 16 * jr + 4 * g);
    bf16x8 Gf[PF][2]; f32x4 Lf[PF];
#define SB_ISSUE(slot, c) do { const size_t unit_ = (size_t)(ci0 + (c)) * 16 + h; const bf16* Gp = Gall + unit_ * 4096 + (16 * jr + lc) * 64 + 8 * g; const float* Lp = HLall + unit_ * 4096 + (16 * jr + 4 * g) * 64 + 16 * vs + lc; \
        Gf[slot][0] = *(const bf16x8*)Gp; Gf[slot][1] = *(const bf16x8*)(Gp + 32); Lf[slot] = (f32x4){Lp[0], Lp[64], Lp[128], Lp[192]}; } while (0)
#pragma unroll
    for (int s = 0; s < PF; ++s) if (s < NSTEP) SB_ISSUE(s, s);
    for (int c0 = 0; c0 < NSTEP; c0 += PF) {
#pragma unroll
        for (int s = 0; s < PF; ++s) { const int c = c0 + s; if (NSTEP % PF == 0 || c < NSTEP) {
            const size_t unit = (size_t)(ci0 + c) * 16 + h;
            const unsigned h0 = pk2(acc.x, acc.y), h1 = pk2(acc.z, acc.w);
            const float l0 = acc.x - __builtin_bit_cast(float, h0 << 16), l1 = acc.y - __builtin_bit_cast(float, h0 & 0xffff0000u), l2 = acc.z - __builtin_bit_cast(float, h1 << 16), l3 = acc.w - __builtin_bit_cast(float, h1 & 0xffff0000u);
            LAS unsigned char* xb = XH + (c & 1) * 8192;
            *(LAS u32x2*)(xb + lc * BLD + (16 * jr + 4 * g) * 2) = (u32x2){h0, h1};
            *(LAS u32x2*)(xb + 4096 + lc * BLD + (16 * jr + 4 * g) * 2) = (u32x2){pk2(l0, l1), pk2(l2, l3)};
            *(u32x2*)(S0all + unit * 4096 + (16 * vs + lc) * 64 + 16 * jr + 4 * g) = (u32x2){h0, h1};
            __syncthreads();
            f32x4 a2 = Lf[s];
#pragma unroll
            for (int ks = 0; ks < 2; ++ks) { const bf16x8 bh = *(const LAS bf16x8*)(xb + lc * BLD + (32 * ks + 8 * g) * 2), bl = *(const LAS bf16x8*)(xb + 4096 + lc * BLD + (32 * ks + 8 * g) * 2);
                a2 = MFMA16(Gf[s][ks], bh, a2); a2 = MFMA16(Gf[s][ks], bl, a2); }
            acc = a2;
            if (c + PF < NSTEP) SB_ISSUE(s, c + PF);
        } }
    }
    *(f32x4*)(outp_state + (16 * vs + lc) * 64 + 16 * jr + 4 * g) = acc;
#undef SB_ISSUE
}

__device__ __forceinline__ void scanC_unit(int l, LAS unsigned char* lds, int unit, int tid, int wave) {
    unsigned char* ws = KWS();
    const int lane = tid & 63, ci = unit >> 4, h = unit & 15, cc = 64 * h + lane;
    int m0, n; if (ci < 256) { m0 = 64 * ci; n = 64; } else { m0 = TP + 32 * (ci - 256); n = 32; }
    const int rb = wave >> 1, cb0 = (wave & 1) * 2, g = lane >> 4, lc = lane & 15;
    const bf16* RPg = (const bf16*)(ws + SC_RP) + (size_t)unit * 4096; const float* YLg = (const float*)(ws + SC_YL) + (size_t)unit * 4096; const bf16* S0g = (const bf16*)(ws + SC_S0) + (size_t)unit * 4096;
    LAS float* Yl = (LAS float*)lds;
    f32x4 acc[2];
#pragma unroll
    for (int c = 0; c < 2; ++c)
#pragma unroll
        for (int rg = 0; rg < 4; ++rg) acc[c][rg] = YLg[(16 * rb + 4 * g + rg) * 64 + 16 * (cb0 + c) + lc];
#pragma unroll
    for (int ks = 0; ks < 2; ++ks) { const bf16x8 fa = *(const bf16x8*)(RPg + (16 * rb + lc) * 64 + 32 * ks + 8 * g);
#pragma unroll
        for (int c = 0; c < 2; ++c) acc[c] = MFMA16(fa, *(const bf16x8*)(S0g + (16 * (cb0 + c) + lc) * 64 + 32 * ks + 8 * g), acc[c]); }
    __syncthreads();
#pragma unroll
    for (int c = 0; c < 2; ++c)
#pragma unroll
        for (int rg = 0; rg < 4; ++rg) Yl[(16 * rb + 4 * g + rg) * 65 + 16 * (cb0 + c) + lc] = acc[c][rg];
    __syncthreads();
    const int t0 = 8 * wave;
    if (t0 < n) {
        const float* P = (const float*)(ws + B_P); const float* Gg = (const float*)(ws + WS_RW + 2 * RWSZ); bf16* MIXB = (bf16*)(ws + B_MIX); const float* bon = (const float*)(ws + SC_BON) + (size_t)unit * 64;
        const float mu_v = (KIN(I_MU) + (size_t)l * SHIFT)[2 * RW + cc], gng = (KIN(I_GNG) + (size_t)l * RW)[cc], gnb = (KIN(I_GNB) + (size_t)l * RW)[cc];
        const float* pp = prev_row(KIN(I_SSH), l, P, m0 + t0); float q_v = pp ? pp[2 * RW + cc] : 0.f;
#pragma unroll
        for (int i = 0; i < 8; ++i) { const int t = t0 + i; const size_t m = (size_t)(m0 + t);
            const float y = Yl[t * 65 + lane]; const float ym = wave_sum(y) * (1.f / HN); const float d = y - ym; const float yv = wave_sum(d * d) * (1.f / HN);
            const float yn = d * (1.f / sqrtf(yv + GN_EPS)) * gng + gnb;
            const float p_v = P[m * PLD + 2 * RW + cc]; const float vx = p_v + (q_v - p_v) * mu_v; q_v = p_v;
            MIXB[m * DM + cc] = (bf16)f2bf((yn + bon[t] * vx) * Gg[m * RW + cc]); }
    }
}

template <int PH> __global__ void __launch_bounds__(NTHR, 2) mk_fwd(Args a) {
    extern __shared__ __attribute__((aligned(16))) unsigned char lds_raw[];
    LAS unsigned char* lds = (LAS unsigned char*)lds_raw;
    const int wave_s = __builtin_amdgcn_readfirstlane((int)threadIdx.x >> 6);
    for (int u = threadIdx.x; u < (LDS_BYTES - LDSCTL_OFF) / 4; u += NTHR) ((LAS unsigned*)(lds + LDSCTL_OFF))[u] = 0u;
    __syncthreads();
    if (PH < 0) (void)xcd_barrier_post((unsigned*)KWS() + CW_BAR, (volatile LAS unsigned*)(lds + MISC_OFF) + 8, (int)threadIdx.x);
#define IN(k) (PH < 0 || PH == (k))
#define PHASE_IDS() int tid_; asm volatile("v_mbcnt_lo_u32_b32 %0, -1, 0\n\tv_mbcnt_hi_u32_b32 %0, -1, %0\n\tv_lshl_add_u32 %0, %1, 6, %0" : "=&v"(tid_) : "s"(wave_s)); const int tid = tid_, lane = tid & 63, wave = wave_s; \
    const int G = gridDim.x, bx = blockIdx.x, vcu = (G % 8 == 0) ? (bx % 8) * (G / 8) + bx / 8 : bx, gw = vcu * NWAVES + wave, NGW = G * NWAVES; unsigned char* ws = KWS(); (void)tid; (void)lane; (void)gw; (void)NGW; (void)ws
#define SEAM() do { if (PH < 0) { XcdBarrier bar_; bar_.bar = (unsigned*)KWS() + CW_BAR; bar_.x = xb_xcc_id(); bar_.st = (volatile LAS unsigned*)(lds + MISC_OFF) + 8; xcd_barrier(bar_, tid); } } while (0)

    for (int l = a.l_lo; l < a.l_hi; ++l) {
        if (IN(0)) { PHASE_IDS(); phase_convert(l, lds, wave, lane, gw, NGW); SEAM(); }
        if (IN(1)) { PHASE_IDS(); pg8::Gemm g{(const bf16*)(ws + WS_XB), (const bf16*)(ws + W_1), M, 2 * FF, DM}; pg8::StaticOrder S; S.init(M, 2 * FF, G, bx); pg8::EpiSwiGLU E{(bf16*)(ws + B_H), FF};
            pg8::gemm_phase<pg8::EpiSwiGLU, pg8::StaticOrder, true, true>(lds + RING_OFF, g, S, E, tid); SEAM(); }
        if (IN(2)) { PHASE_IDS(); pg8::Gemm g{(const bf16*)(ws + B_H), (const bf16*)(ws + W_2), M, DM, FF}; pg8::StaticOrder S; S.init(M, DM, G, bx); pg8::EpiResid E{(const float*)(ws + WS_X), (float*)(ws + WS_Z), DM, ALPHA, 0.5f};
            pg8::gemm_phase<pg8::EpiResid, pg8::StaticOrder, true, true>(lds + RING_OFF, g, S, E, tid); SEAM(); }
        if (IN(3)) { PHASE_IDS(); phase_ln((const float*)(ws + WS_Z), KIN(I_LNG) + (size_t)l * 3 * DM, KIN(I_LNB) + (size_t)l * 3 * DM, (float*)(ws + WS_X), (bf16*)(ws + WS_XB), lane, gw, NGW); SEAM(); }
        if (IN(4)) { PHASE_IDS(); pg8::Gemm g{(const bf16*)(ws + WS_XB), (const bf16*)(ws + W_3), M, N3, DM}; pg8::StaticOrder S; S.init(M, N3, G, bx); pg8::EpiP E{(float*)(ws + B_P), (bf16*)(ws + B_U), (float*)(ws + B_GV)};
            pg8::gemm_phase<pg8::EpiP, pg8::StaticOrder, true, true>(lds + RING_OFF, g, S, E, tid); SEAM(); }
        if (IN(5)) { PHASE_IDS(); phase_prep1(l, lane, gw, NGW); SEAM(); }
        if (IN(6)) { PHASE_IDS(); pg8::Gemm g{(const bf16*)(ws + B_A3B), (const bf16*)(ws + W_3B), M, NL, LK}; pg8::StaticOrder S; S.init(M, NL, G, bx);
            pg8::EpiLora E{(float*)(ws + WS_RW)};
            pg8::gemm_phase<pg8::EpiLora, pg8::StaticOrder, false, false>(lds + RING_OFF, g, S, E, tid); SEAM(); }
        if (IN(7)) { PHASE_IDS(); for (int u = bx; u < NUNIT; u += G) scanA_unit(l, lds, u, tid, wave); SEAM(); }
        if (IN(8)) { PHASE_IDS();
            if (bx < 32) { const int task = 2 * bx + (wave >> 2), hh = task >> 2; scanB_chain<256, 8>(l, lds, 0, hh, task & 3, nullptr, KOUT() + O_SP + ((size_t)l * NH + hh) * 4096, tid, wave); }
            else { const float* srw = KIN(I_SRW); float* outp = KOUT();
                for (int p = bx - 32; p < 512; p += G - 32) { const int task = 2 * p + (wave >> 2), b = task >> 6, hh = (task >> 2) & 15; const size_t so = (((size_t)l * NSB + b) * NH + hh) * 4096;
                    scanB_chain<1, 1>(l, lds, 256 + b, hh, task & 3, srw + so, outp + O_SS + so, tid, wave); }
                for (int u = bx - 32; u < 144 * 8; u += G - 32) gmlp_unit(l, lds, u, tid); }
            SEAM(); }
        if (IN(9)) { PHASE_IDS(); for (int u = bx; u < NUNIT; u += G) scanC_unit(l, lds, u, tid, wave); SEAM(); }
        if (IN(10)) { PHASE_IDS(); pg8::Gemm g{(const bf16*)(ws + B_MIX), (const bf16*)(ws + W_4), M, DM, DM}; pg8::StaticOrder S; S.init(M, DM, G, bx); pg8::EpiResid E{(const float*)(ws + WS_X), (float*)(ws + WS_Z), DM, ALPHA, 1.0f};
            pg8::gemm_phase<pg8::EpiResid, pg8::StaticOrder, true, true>(lds + RING_OFF, g, S, E, tid); SEAM(); }
        if (IN(11)) { PHASE_IDS(); phase_ln((const float*)(ws + WS_Z), KIN(I_LNG) + (size_t)(l * 3 + 1) * DM, KIN(I_LNB) + (size_t)(l * 3 + 1) * DM, (float*)(ws + WS_X), (bf16*)(ws + WS_XB), lane, gw, NGW); SEAM(); }
        if (IN(12)) { PHASE_IDS(); pg8::Gemm g{(const bf16*)(ws + WS_XB), (const bf16*)(ws + W_5), M, 2 * FF, DM}; pg8::StaticOrder S; S.init(M, 2 * FF, G, bx); pg8::EpiSwiGLU E{(bf16*)(ws + B_H), FF};
            pg8::gemm_phase<pg8::EpiSwiGLU, pg8::StaticOrder, true, true>(lds + RING_OFF, g, S, E, tid); SEAM(); }
        if (IN(13)) { PHASE_IDS(); pg8::Gemm g{(const bf16*)(ws + B_H), (const bf16*)(ws + W_6), M, DM, FF}; pg8::StaticOrder S; S.init(M, DM, G, bx); pg8::EpiResid E{(const float*)(ws + WS_X), (float*)(ws + WS_Z), DM, ALPHA, 0.5f};
            pg8::gemm_phase<pg8::EpiResid, pg8::StaticOrder, true, true>(lds + RING_OFF, g, S, E, tid); SEAM(); }
        if (IN(14)) { PHASE_IDS(); const bool last = (l == DEPTH - 1);
            phase_ln((const float*)(ws + WS_Z), KIN(I_LNG) + (size_t)(l * 3 + 2) * DM, KIN(I_LNB) + (size_t)(l * 3 + 2) * DM, last ? KOUT() + O_YP : (float*)(ws + WS_X), last ? (bf16*)nullptr : (bf16*)(ws + WS_XB), lane, gw, NGW);
            if (!last) SEAM(); }
    }
#undef IN
#undef SEAM
#undef PHASE_IDS
}

template <int PH> static bool prep_kernel() { return hipFuncSetAttribute((const void*)mk_fwd<PH>, hipFuncAttributeMaxDynamicSharedMemorySize, LDS_BYTES) == hipSuccess; }
template <int PH> static void launch_phase(int grid, hipStream_t stream, Args a) { hipLaunchKernelGGL(mk_fwd<PH>, dim3(grid), dim3(NTHR), LDS_BYTES, stream, a); }
extern "C" void kernel_launch(void* const* d_in, const int* in_sizes, int n_in, void* d_out, int out_size, void* d_ws, size_t ws_size, hipStream_t stream) {
    static int grid = 0;
    if (grid == 0) {
        if (n_in != 29 || (size_t)out_size != O_END || ws_size < WS_END) { fprintf(stderr, "kernel_launch: unexpected shapes: n_in %d out %d ws %zu (need %zu)\n", n_in, out_size, ws_size, (size_t)WS_END); grid = -1; return; }
        int dev = 0, cus = 0, per_cu = 0;
        if (hipGetDevice(&dev) != hipSuccess || hipDeviceGetAttribute(&cus, hipDeviceAttributeMultiprocessorCount, dev) != hipSuccess) { grid = -1; return; }
        bool ok = true;
#if MK_ONE_LAUNCH
        ok = prep_kernel<-1>();
        if (hipOccupancyMaxActiveBlocksPerMultiprocessor(&per_cu, (const void*)mk_fwd<-1>, NTHR, LDS_BYTES) != hipSuccess || per_cu < 1) fprintf(stderr, "kernel_launch: occupancy query says %d\n", per_cu);
#else
        ok = prep_kernel<0>() && prep_kernel<1>() && prep_kernel<2>() && prep_kernel<3>() && prep_kernel<4>() && prep_kernel<5>() && prep_kernel<6>() && prep_kernel<7>() && prep_kernel<8>() && prep_kernel<9>() && prep_kernel<10>() && prep_kernel<11>() && prep_kernel<12>() && prep_kernel<13>() && prep_kernel<14>();
#endif
        if (!ok) { fprintf(stderr, "kernel_launch: hipFuncSetAttribute failed\n"); grid = -1; return; }
        (void)hipGetLastError();
        grid = cus;
        if (grid < 64) { grid = -1; return; }
    }
    if (grid < 0) return;
    (void)hipMemsetAsync((char*)d_ws + WS_CTL, 0, CTL_ZERO_BYTES, stream);
    Args a{};
    for (int i = 0; i < 29; ++i) a.in[i] = (const float*)d_in[i];
    a.out = (float*)d_out; a.ws = (unsigned char*)d_ws;
#if MK_ONE_LAUNCH
    a.l_lo = 0; a.l_hi = DEPTH;
    launch_phase<-1>(grid, stream, a);
#else
    for (int l = 0; l < DEPTH; ++l) { a.l_lo = l; a.l_hi = l + 1;
        launch_phase<0>(grid, stream, a); launch_phase<1>(grid, stream, a); launch_phase<2>(grid, stream, a); launch_phase<3>(grid, stream, a); launch_phase<4>(grid, stream, a);
        launch_phase<5>(grid, stream, a); launch_phase<6>(grid, stream, a); launch_phase<7>(grid, stream, a); launch_phase<8>(grid, stream, a); launch_phase<9>(grid, stream, a);
        launch_phase<10>(grid, stream, a); launch_phase<11>(grid, stream, a); launch_phase<12>(grid, stream, a); launch_phase<13>(grid, stream, a); launch_phase<14>(grid, stream, a); }
#endif
}
```

```cpp
#include <hip/hip_runtime.h>
#include <cstdio>
#include <cstdint>
#define MK_ONE_LAUNCH 1
namespace pg8 {
#define PG8_LAS __attribute__((address_space(3)))
typedef unsigned short bf16_t;
typedef short bf16x8 __attribute__((ext_vector_type(8)));
typedef float f32x4 __attribute__((ext_vector_type(4)));
typedef unsigned u32x4 __attribute__((ext_vector_type(4)));
constexpr int BM = 256, BK = 64, HALF = 128, HTB = HALF * BK * 2  , STAGE_BYTES = 8 * HTB, NXCD = 8, WGM = 8;

__host__ __device__ __forceinline__ int lds_byte(int r, int c) { const int st = (r >> 4) * 2 + (c >> 5), rr = r & 15, cc = c & 31, ob = rr * 64 + cc * 2; return st * 1024 + (ob ^ (((ob >> 9) & 1) << 5)); }
__host__ __device__ __forceinline__ void stage_rc(int b, int& R, int& C) { const int st = b / 1024, sb = b % 1024, swz = sb ^ (((sb >> 9) & 1) << 5); R = (st >> 1) * 16 + swz / 64; C = (st & 1) * 32 + (swz % 64) / 2; }
__host__ __device__ __forceinline__ int perm32(int rho) { const int n = rho >> 4, i = rho & 15; return 8 * (i >> 2) + 4 * n + (i & 3); }

struct Unit { int pm, pn; };
struct Gemm { const bf16_t* A; const bf16_t* Bt; int M, N, K; };

struct StaticOrder {
    int nM, nN, nwg, G, c;
    __host__ __device__ void init(int M, int N, int G_, int c_) { nM = M / BM; nN = N / BM; nwg = nM * nN; G = G_; c = c_; }
    __host__ __device__ bool next(int i, Unit& u) const {
        const long L = (long)i * G + c; if (L >= nwg) return false;
        int wgid = (int)L; { const int q = nwg / NXCD, r = nwg % NXCD, xcd = wgid % NXCD, off = wgid / NXCD; wgid = (xcd < r ? xcd * (q + 1) : r * (q + 1) + (xcd - r) * q) + off; }
        const int nig = WGM * nN, gid = wgid / nig, fm = gid * WGM, gsz = (nM - fm) < WGM ? (nM - fm) : WGM;
        u.pm = fm + ((wgid % nig) % gsz); u.pn = (wgid % nig) / gsz; return true;
    }
    __device__ __forceinline__ void a_ready(const Unit&) const {}
    __device__ __forceinline__ void done(const Unit&) const {}
};
__device__ __forceinline__ unsigned cvt_pk_bf16(float lo, float hi) { unsigned r; asm volatile("v_cvt_pk_bf16_f32 %0, %1, %2" : "=v"(r) : "v"(lo), "v"(hi)); return r; }
typedef float f32x2 __attribute__((ext_vector_type(2)));
__device__ __forceinline__ f32x2 gelu_pk(f32x2 v) {
    const f32x2 av = __builtin_elementwise_abs(v), d = av * 0.2316418882f + 1.0f;
    f32x2 t; t.x = __builtin_amdgcn_rcpf(d.x); t.y = __builtin_amdgcn_rcpf(d.y);
    f32x2 q = t * 0.5307027145f + (-0.7265760135f); q = q * t + 0.7107068705f; q = q * t + (-0.142248368f); q = q * t + 0.127414796f; q = q * t;
    const f32x2 s = (v * v) * (-0.72134752044f);
    f32x2 e; e.x = __builtin_amdgcn_exp2f(s.x); e.y = __builtin_amdgcn_exp2f(s.y);
    const f32x2 m = v * (q * e), r = v - m;
    f32x2 o; o.x = v.x < 0.f ? m.x : r.x; o.y = v.y < 0.f ? m.y : r.y; return o;
}

typedef unsigned u32x2 __attribute__((ext_vector_type(2)));
__device__ __forceinline__ float silu_f(float g) { return g * __builtin_amdgcn_rcpf(1.0f + __expf(-g)); }
struct EpiSwiGLU {
    static constexpr bool PERM = true, AFTER_DRAIN = false;
    bf16_t* O; int ldc;
    __device__ __forceinline__ void operator()(const f32x4 (&acc)[2][2][4][2], const Unit& u, int wr, int wc, int fr, int fq) const {
        const int row0 = u.pm * BM + wr * 64 + fr, col0 = u.pn * HALF + wc * 32 + 8 * fq;
#pragma unroll
        for (int ai = 0; ai < 2; ++ai)
#pragma unroll
            for (int m = 0; m < 4; ++m) { bf16_t* rowp = O + (size_t)(row0 + ai * HALF + m * 16) * ldc + col0;
                const f32x4 g0 = acc[ai][0][m][0], g1 = acc[ai][0][m][1], u0 = acc[ai][1][m][0], u1 = acc[ai][1][m][1];
                u32x4 w; w.x = cvt_pk_bf16(silu_f(g0[0]) * u0[0], silu_f(g0[1]) * u0[1]); w.y = cvt_pk_bf16(silu_f(g0[2]) * u0[2], silu_f(g0[3]) * u0[3]);
                w.z = cvt_pk_bf16(silu_f(g1[0]) * u1[0], silu_f(g1[1]) * u1[1]); w.w = cvt_pk_bf16(silu_f(g1[2]) * u1[2], silu_f(g1[3]) * u1[3]);
                *(u32x4*)rowp = w; }
    }
};
struct EpiResid {
    static constexpr bool PERM = false, AFTER_DRAIN = false;
    const float* base; float* out; int ldc; float sa, sb;
    __device__ __forceinline__ void operator()(const f32x4 (&acc)[2][2][4][2], const Unit& u, int wr, int wc, int fr, int fq) const {
        const int row0 = u.pm * BM + wr * 64 + fr, col0 = u.pn * BM + wc * 32 + 4 * fq;
#pragma unroll
        for (int ai = 0; ai < 2; ++ai)
#pragma unroll
            for (int m = 0; m < 4; ++m) { const size_t off = (size_t)(row0 + ai * HALF + m * 16) * ldc + col0;
#pragma unroll
                for (int bj = 0; bj < 2; ++bj)
#pragma unroll
                    for (int n = 0; n < 2; ++n) { const f32x4 b = *(const f32x4*)(base + off + bj * HALF + n * 16); *(f32x4*)(out + off + bj * HALF + n * 16) = b * sa + acc[ai][bj][m][n] * sb; } }
    }
};
struct EpiP {
    static constexpr bool PERM = false, AFTER_DRAIN = false;
    float* P; bf16_t* U; float* GV;
    __device__ __forceinline__ void operator()(const f32x4 (&acc)[2][2][4][2], const Unit& u, int wr, int wc, int fr, int fq) const {
        const int row0 = u.pm * BM + wr * 64 + fr, cw = wc * 32 + 4 * fq;
        const int kind = u.pn < 14 ? 0 : (u.pn < 18 ? 1 : 2);
        float* F = kind == 0 ? P + u.pn * BM + cw : GV + (u.pn - 18) * BM + cw; const int ldf = kind == 0 ? 3584 : 1024;
        bf16_t* Ub = U + (u.pn - 14) * BM + cw;
#pragma unroll
        for (int ai = 0; ai < 2; ++ai)
#pragma unroll
            for (int m = 0; m < 4; ++m) { const size_t row = (size_t)(row0 + ai * HALF + m * 16);
#pragma unroll
                for (int bj = 0; bj < 2; ++bj)
#pragma unroll
                    for (int n = 0; n < 2; ++n) { f32x4 v = acc[ai][bj][m][n];
                        if (kind != 0) { const f32x2 a = gelu_pk((f32x2){v[0], v[1]}), b = gelu_pk((f32x2){v[2], v[3]}); v = (f32x4){a.x, a.y, b.x, b.y}; }
                        if (kind == 1) { u32x2 w; w.x = cvt_pk_bf16(v[0], v[1]); w.y = cvt_pk_bf16(v[2], v[3]); *(u32x2*)(Ub + row * 1024 + bj * HALF + n * 16) = w; }
                        else *(f32x4*)(F + row * ldf + bj * HALF + n * 16) = v; }
                asm volatile("" ::: "memory"); }
    }
};
struct EpiLora {
    static constexpr bool PERM = false, AFTER_DRAIN = false;
    float* base;
    __device__ __forceinline__ void operator()(const f32x4 (&acc)[2][2][4][2], const Unit& u, int wr, int wc, int fr, int fq) const {
        const int row0 = u.pm * BM + wr * 64 + fr, kind = u.pn >> 2, cb = (u.pn & 3) * BM + wc * 32 + 4 * fq;
        float* O = base + (size_t)kind * ((size_t)66 << 18) + cb;
#pragma unroll
        for (int ai = 0; ai < 2; ++ai)
#pragma unroll
            for (int m = 0; m < 4; ++m) { float* rowp = O + (size_t)(row0 + ai * HALF + m * 16) * 1024;
#pragma unroll
                for (int bj = 0; bj < 2; ++bj)
#pragma unroll
                    for (int n = 0; n < 2; ++n) *(f32x4*)(rowp + bj * HALF + n * 16) = acc[ai][bj][m][n]; }
    }
};
template <class Epi, class Sched, bool ALIGN_EPI = false, bool SP2 = false>
__device__ __forceinline__ void gemm_phase(PG8_LAS unsigned char* lds, const Gemm g, const Sched& S, const Epi& E, int tid_in) {
    int tid_ = tid_in; asm volatile("" : "+v"(tid_));
    const int tid = tid_, wid = __builtin_amdgcn_readfirstlane(tid >> 6), lane = tid & 63, wr = wid >> 2, wc = wid & 3, fr = lane & 15, fq = lane >> 4;
    const int K = g.K, nt = K / BK;
    unsigned voffA[2], voffB[2];
#pragma unroll
    for (int i = 0; i < 2; ++i) { int R, C; stage_rc(tid * 16 + i * 8192, R, C); const int Rb = Epi::PERM ? ((R & ~31) + perm32(R & 31)) : R;
        voffA[i] = (unsigned)(R * K + C) * 2u; voffB[i] = (unsigned)(Rb * K + C) * 2u; }
    const size_t kstep = (size_t)(BK * 2);
    const size_t hstep = (size_t)HALF * K * 2;
    const size_t tstep = 2 * hstep;
    const unsigned ldsw = (unsigned)wid * 1024u;
    const int aoff = lds_byte(wr * 64 + fr, fq * 8), boff = lds_byte(wc * 32 + fr, fq * 8);
#define PG8_SA(b, h) (((b) * 2 + (h)) * HTB)
#define PG8_SB(b, h) ((4 + (b) * 2 + (h)) * HTB)
#define PG8_STAGE(bufoff, gbase, voff) do { _Pragma("unroll") for (int _i = 0; _i < 2; ++_i) \
        __builtin_amdgcn_global_load_lds((const unsigned*)((const char*)(gbase) + (voff)[_i]), (PG8_LAS unsigned*)(lds + (bufoff) + ldsw + _i * 8192), 16, 0, 0); } while (0)
#define PG8_LDA(dst, b, h) do { _Pragma("unroll") for (int m = 0; m < 4; ++m) _Pragma("unroll") for (int k = 0; k < 2; ++k) dst[m][k] = *(const PG8_LAS bf16x8*)(lds + PG8_SA(b, h) + aoff + m * 2048 + k * 1024); } while (0)
#define PG8_LDB(dst, b, h) do { _Pragma("unroll") for (int n = 0; n < 2; ++n) _Pragma("unroll") for (int k = 0; k < 2; ++k) dst[n][k] = *(const PG8_LAS bf16x8*)(lds + PG8_SB(b, h) + boff + n * 2048 + k * 1024); } while (0)
#define PG8_MMA(ai, bj, At, Bt) do { __builtin_amdgcn_s_setprio(1); _Pragma("unroll") for (int m = 0; m < 4; ++m) _Pragma("unroll") for (int n = 0; n < 2; ++n) _Pragma("unroll") for (int k = 0; k < 2; ++k) \
        acc[ai][bj][m][n] = __builtin_amdgcn_mfma_f32_16x16x32_bf16(Bt[n][k], At[m][k], acc[ai][bj][m][n], 0, 0, 0); __builtin_amdgcn_s_setprio(0); } while (0)
#define PG8_WAIT_V(n) asm volatile("s_waitcnt vmcnt(" #n ")" ::: "memory")
#define PG8_WAIT_L(n) asm volatile("s_waitcnt lgkmcnt(" #n ")" ::: "memory")
#define PG8_BAR __builtin_amdgcn_s_barrier()
#define PG8_SCHED __builtin_amdgcn_sched_barrier(0)
    Unit cur, nxt; int ui = 0;
    if (!S.next(0, cur)) return;
    f32x4 acc[2][2][4][2];
    float zz0; asm volatile("v_mov_b32 %0, 0" : "=v"(zz0));
#pragma unroll
    for (int a = 0; a < 2; ++a)
#pragma unroll
        for (int b = 0; b < 2; ++b)
#pragma unroll
            for (int m = 0; m < 4; ++m)
#pragma unroll
                for (int n = 0; n < 2; ++n) acc[a][b][m][n] = (f32x4){zz0, zz0, zz0, zz0};
    bf16x8 At[4][2], B0[2][2], B1[2][2];
    const char* cA = (const char*)g.A + (size_t)cur.pm * tstep; const char* cB = (const char*)g.Bt + (size_t)cur.pn * tstep;
    S.a_ready(cur);
    if constexpr (SP2) {
        PG8_STAGE(PG8_SB(0, 0), cB, voffB); PG8_STAGE(PG8_SB(0, 1), cB + hstep, voffB); PG8_STAGE(PG8_SA(0, 0), cA, voffA); PG8_STAGE(PG8_SA(0, 1), cA + hstep, voffA);
        if (wr == 1) PG8_BAR;
        PG8_WAIT_V(2); PG8_BAR;
        PG8_STAGE(PG8_SB(1, 0), cB + kstep, voffB); PG8_STAGE(PG8_SA(1, 0), cA + kstep, voffA); PG8_STAGE(PG8_SB(1, 1), cB + hstep + kstep, voffB);
        PG8_WAIT_V(6); PG8_BAR;
    } else {
        PG8_STAGE(PG8_SB(0, 0), cB, voffB); PG8_STAGE(PG8_SA(0, 0), cA, voffA); PG8_STAGE(PG8_SB(0, 1), cB + hstep, voffB); PG8_STAGE(PG8_SA(0, 1), cA + hstep, voffA);
        if (wr == 1) PG8_BAR;
        PG8_WAIT_V(4); PG8_BAR;
        PG8_STAGE(PG8_SB(1, 0), cB + kstep, voffB); PG8_STAGE(PG8_SA(1, 0), cA + kstep, voffA); PG8_STAGE(PG8_SB(1, 1), cB + hstep + kstep, voffB);
        PG8_WAIT_V(6); PG8_BAR;
    }
    for (;;) {
        const bool has_next = S.next(ui + 1, nxt);
        const char* nA = has_next ? (const char*)g.A + (size_t)nxt.pm * tstep : cA; const char* nB = has_next ? (const char*)g.Bt + (size_t)nxt.pn * tstep : cB;
        for (int t = 0; t < nt; t += 2) {
            const bool last = (t == nt - 2);
            const char* a1 = cA + (size_t)(t + 1) * kstep;
            const char* a2 = last ? nA : cA + (size_t)(t + 2) * kstep; const char* b2 = last ? nB : cB + (size_t)(t + 2) * kstep;
            const char* a3 = a2 + kstep; const char* b3 = b2 + kstep;
            if (last && has_next) S.a_ready(nxt);
            if constexpr (SP2) {
            PG8_LDB(B0, 0, 0); PG8_LDB(B1, 0, 1); PG8_SCHED; PG8_LDA(At, 0, 0); PG8_STAGE(PG8_SA(1, 1), a1 + hstep, voffA);
            PG8_WAIT_V(8); PG8_WAIT_L(0); PG8_BAR; PG8_MMA(0, 0, At, B0); PG8_MMA(0, 1, At, B1); PG8_BAR; PG8_SCHED;
            PG8_LDA(At, 0, 1); PG8_STAGE(PG8_SB(0, 0), b2, voffB); PG8_STAGE(PG8_SB(0, 1), b2 + hstep, voffB); PG8_STAGE(PG8_SA(0, 0), a2, voffA);
            PG8_WAIT_V(8); PG8_WAIT_L(0); PG8_BAR; PG8_MMA(1, 0, At, B0); PG8_MMA(1, 1, At, B1); PG8_BAR; PG8_SCHED;
            PG8_LDB(B0, 1, 0); PG8_LDB(B1, 1, 1); PG8_SCHED; PG8_LDA(At, 1, 0); PG8_STAGE(PG8_SA(0, 1), a2 + hstep, voffA);
            PG8_WAIT_V(8); PG8_WAIT_L(0); PG8_BAR; PG8_MMA(0, 0, At, B0); PG8_MMA(0, 1, At, B1); PG8_BAR; PG8_SCHED;
            PG8_LDA(At, 1, 1); PG8_STAGE(PG8_SB(1, 0), b3, voffB); PG8_STAGE(PG8_SB(1, 1), b3 + hstep, voffB); PG8_STAGE(PG8_SA(1, 0), a3, voffA);
            PG8_WAIT_V(8); PG8_WAIT_L(0); PG8_BAR; PG8_MMA(1, 0, At, B0); PG8_MMA(1, 1, At, B1); PG8_BAR; PG8_SCHED;
            } else {
            PG8_LDB(B0, 0, 0); PG8_SCHED; PG8_LDA(At, 0, 0); PG8_STAGE(PG8_SA(1, 1), a1 + hstep, voffA);
            PG8_WAIT_L(8); PG8_BAR; PG8_WAIT_L(0); PG8_MMA(0, 0, At, B0); PG8_BAR; PG8_SCHED;
            PG8_LDB(B1, 0, 1); PG8_STAGE(PG8_SB(0, 0), b2, voffB);
            PG8_BAR; PG8_WAIT_L(0); PG8_MMA(0, 1, At, B1); PG8_BAR;
            PG8_LDA(At, 0, 1); PG8_STAGE(PG8_SA(0, 0), a2, voffA);
            PG8_BAR; PG8_WAIT_L(0); PG8_MMA(1, 0, At, B0); PG8_BAR; PG8_SCHED;
            PG8_STAGE(PG8_SB(0, 1), b2 + hstep, voffB);
            PG8_WAIT_V(6); PG8_BAR; PG8_MMA(1, 1, At, B1); PG8_BAR;
            PG8_LDB(B0, 1, 0); PG8_SCHED; PG8_LDA(At, 1, 0); PG8_STAGE(PG8_SA(0, 1), a2 + hstep, voffA);
            PG8_WAIT_L(8); PG8_BAR; PG8_WAIT_L(0); PG8_MMA(0, 0, At, B0); PG8_BAR; PG8_SCHED;
            PG8_LDB(B1, 1, 1); PG8_STAGE(PG8_SB(1, 0), b3, voffB);
            PG8_BAR; PG8_WAIT_L(0); PG8_MMA(0, 1, At, B1); PG8_BAR;
            PG8_LDA(At, 1, 1); PG8_STAGE(PG8_SA(1, 0), a3, voffA);
            PG8_BAR; PG8_WAIT_L(0); PG8_MMA(1, 0, At, B0); PG8_BAR; PG8_SCHED;
            PG8_STAGE(PG8_SB(1, 1), b3 + hstep, voffB);
            PG8_WAIT_V(6); PG8_BAR; PG8_MMA(1, 1, At, B1); PG8_BAR;
            }
        }
        if constexpr (ALIGN_EPI) { if (wr == 0) PG8_BAR; }
        if constexpr (!Epi::AFTER_DRAIN) { E(acc, cur, wr, wc, fr, fq); S.done(cur); }
        if (!has_next) break;
{ float zz1; asm volatile("v_mov_b32 %0, 0" : "=v"(zz1));
#pragma unroll
        for (int a = 0; a < 2; ++a)
#pragma unroll
            for (int b = 0; b < 2; ++b)
#pragma unroll
                for (int m = 0; m < 4; ++m)
#pragma unroll
                    for (int n = 0; n < 2; ++n) acc[a][b][m][n] = (f32x4){zz1, zz1, zz1, zz1}; }
        cur = nxt; cA = nA; cB = nB; ++ui;
        if constexpr (ALIGN_EPI) { if (wr == 1) PG8_BAR; }
    }
    PG8_WAIT_V(0);
    if constexpr (!ALIGN_EPI) { if (wr == 0) PG8_BAR; }
    PG8_BAR;
    if constexpr (Epi::AFTER_DRAIN) { E.fused(acc, cur, wr, wc, fr, fq, lds, wid, lane); S.done(cur); }
#undef PG8_SA
#undef PG8_SB
#undef PG8_STAGE
#undef PG8_LDA
#undef PG8_LDB
#undef PG8_MMA
#undef PG8_WAIT_V
#undef PG8_WAIT_L
#undef PG8_BAR
#undef PG8_SCHED
}
}
#define GAS __attribute__((address_space(1)))
#define LAS __attribute__((address_space(3)))
typedef unsigned short bf16;
typedef unsigned v4u __attribute__((ext_vector_type(4)));
typedef float f32x4 __attribute__((ext_vector_type(4)));
typedef short bf16x8 __attribute__((ext_vector_type(8)));
typedef GAS unsigned gu32;
typedef GAS unsigned long long gu64;
#define RLX_AGENT __ATOMIC_RELAXED, __HIP_MEMORY_SCOPE_AGENT
#define LDS_WAIT() asm volatile("s_waitcnt lgkmcnt(0)" ::: "memory")
#define VM_WAIT() asm volatile("s_waitcnt vmcnt(0)" ::: "memory")
__device__ __forceinline__ unsigned long long rt() { return __builtin_amdgcn_s_memrealtime(); }
__device__ __forceinline__ unsigned f2bf(float f) { unsigned u = __builtin_bit_cast(unsigned, f); return (u + 0x7fffu + ((u >> 16) & 1u)) >> 16; }
__device__ __forceinline__ unsigned pk2(float lo, float hi) { return f2bf(lo) | (f2bf(hi) << 16); }
#define XB_TMO      128
#define XB_XCNT(j)  (256  + 64 * (j))
#define XB_XSUB(j)  (1280 + 64 * (j))
#define XB_XGEN(j)  (2304 + 64 * (j))
#define XB_TOP      3328
#define XB_TOPGEN   3392
#define XCD_BAR_WORDS 3456
#define XB_SPIN_CAP (1u << 18)

__device__ __forceinline__ unsigned xb_ld(unsigned* p)              { return __hip_atomic_load(p, __ATOMIC_RELAXED, __HIP_MEMORY_SCOPE_AGENT); }
__device__ __forceinline__ unsigned xb_add(unsigned* p, unsigned v) { return __hip_atomic_fetch_add(p, v, __ATOMIC_RELAXED, __HIP_MEMORY_SCOPE_AGENT); }
__device__ __forceinline__ unsigned xb_xcc_id() { return (unsigned)__builtin_amdgcn_s_getreg((3 << 11) | 20) & 0xFu; }
#define XB_SPIN(cond, bar) do { unsigned _sp = 0; while (cond) { __builtin_amdgcn_s_sleep(1); \
    if ((++_sp & 255u) == 0u) { if (xb_ld(&(bar)[XB_TMO])) break; if (_sp > XB_SPIN_CAP) { atomicAdd(&(bar)[XB_TMO], 1u); break; } } } } while (0)

struct XcdBarrier {
    unsigned* bar; unsigned x;
    volatile LAS unsigned* st;
};

__device__ __forceinline__ XcdBarrier xcd_barrier_post(unsigned* bar, volatile LAS unsigned* st, int tid) {
    XcdBarrier b; b.bar = bar; b.x = xb_xcc_id(); b.st = st;
    if (tid == 0) (void)xb_add(&bar[XB_XCNT(b.x)], 1u);
    return b;
}
__device__ __forceinline__ void xcd_barrier_complete(unsigned* bar, unsigned x, unsigned& nloc, unsigned& nx) {
    const unsigned G = gridDim.x * gridDim.y * gridDim.z;
    unsigned sum, cnt, mine, sp = 0u;
    for (;;) {
        sum = 0u; cnt = 0u; mine = 0u;
#pragma unroll
        for (unsigned j = 0; j < 16; ++j) { const unsigned c = xb_ld(&bar[XB_XCNT(j)]); sum += c; cnt += (c > 0u) ? 1u : 0u; mine = (j == x) ? c : mine; }
        if (sum == G) break;
        __builtin_amdgcn_s_sleep(1);
        if ((++sp & 255u) == 0u) { if (xb_ld(&bar[XB_TMO])) break; if (sp > XB_SPIN_CAP) { atomicAdd(&bar[XB_TMO], 1u); break; } }
    }
    nloc = mine > 0u ? mine : 1u; nx = cnt > 0u ? cnt : 1u;
}

__device__ __forceinline__ void xcd_barrier(const XcdBarrier& b, int tid) {
    asm volatile("s_waitcnt vmcnt(0)" ::: "memory");
    __syncthreads();
    if (tid == 0) {
        unsigned* bar = b.bar;
        __builtin_amdgcn_s_waitcnt(0);
        unsigned nloc = b.st[0], nx = b.st[1];
        if (nloc == 0u) { xcd_barrier_complete(bar, b.x, nloc, nx); b.st[0] = nloc; b.st[1] = nx; }
        const unsigned old = xb_add(&bar[XB_XSUB(b.x)], 1u);
        const unsigned gen = old / nloc;
        if (old + 1u == (gen + 1u) * nloc) {
            __builtin_amdgcn_fence(__ATOMIC_RELEASE, "agent");
            asm volatile("s_waitcnt vmcnt(0)" ::: "memory");
            const unsigned og = xb_add(&bar[XB_TOP], 1u);
            const unsigned tg = og / nx;
            if (og + 1u == (tg + 1u) * nx) xb_add(&bar[XB_TOPGEN], 1u);
            else XB_SPIN(xb_ld(&bar[XB_TOPGEN]) == tg, bar);
            __builtin_amdgcn_fence(__ATOMIC_ACQUIRE, "agent");
            xb_add(&bar[XB_XGEN(b.x)], 1u);
            asm volatile("s_waitcnt vmcnt(0)" ::: "memory");
        } else {
            XB_SPIN(xb_ld(&bar[XB_XGEN(b.x)]) == gen, bar);
            __builtin_amdgcn_fence(__ATOMIC_ACQUIRE, "agent");
            asm volatile("s_waitcnt vmcnt(0)" ::: "memory");
        }
    }
    __syncthreads();
}

constexpr int NWAVES = 8, NTHR = 512;
constexpr int DM = 2048, FF = 5632, DEPTH = 4;
constexpr int TP = 16384, NSB = 16, TS = 32, M = TP + NSB * TS;
constexpr int RW = 1024, NH = 16, HN = 64, GMW = 1024, GH = 8, GHD = 128;
constexpr int C_W = 3072, C_A = 3136, C_G = 3200, SHIFT = 3360, INC = 5408;
constexpr int PLD = 3584;
constexpr int N3 = 5632;
constexpr int LK = 384;
constexpr int NL = 3072;
constexpr float ALPHA = 1.6817928305074292f;
constexpr float LN_EPS = 1e-5f, GN_EPS = 64e-5f;
constexpr int NPHASE = 15;

constexpr size_t O_YP = 0, O_SP = 34603008, O_SHP = 34865152, O_SS = 34878592, O_SHS = 39072896, O_GV = 39287936, O_END = 41385088;

constexpr size_t MiB = 1u << 20;
constexpr size_t WS_CTL = 0, CTL_ZERO_BYTES = 1 * MiB;
constexpr size_t WS_X = 1 * MiB;
constexpr size_t WS_Z = 133 * MiB;
constexpr size_t WS_XB = 265 * MiB;
constexpr size_t WS_W = 331 * MiB;
constexpr size_t W_1 = WS_W, W_2 = W_1 + 44 * MiB, W_3 = W_2 + 22 * MiB, W_4 = W_3 + 22 * MiB, W_5 = W_4 + 8 * MiB, W_6 = W_5 + 44 * MiB, W_3B = W_6 + 22 * MiB;
constexpr size_t WS_BIG = 496 * MiB;
constexpr size_t B_H = WS_BIG, B_P = WS_BIG, B_U = WS_BIG + 231 * MiB, B_GV = B_U + 33 * MiB, B_A3B = B_GV + 66 * MiB;
constexpr size_t B_MIX = WS_XB;
constexpr size_t WS_RW = 839 * MiB;
constexpr size_t RWSZ = 66 * MiB;
constexpr size_t WS_END = WS_RW + 8 * RWSZ;
static_assert(W_3B + (size_t)NL * LK * 2 <= WS_BIG && B_A3B + (size_t)M * LK * 2 <= WS_RW, "ws map");
static_assert((size_t)M * DM * 4 == 132 * MiB && (size_t)M * PLD * 4 == 231 * MiB && (size_t)M * 1024 * 4 == 66 * MiB, "ws sizes");
constexpr int CW_TMO = 0, CW_CODE = 1, CW_BAR = 4096;

constexpr int RING_OFF = 0, RING_BYTES = 135168;
constexpr int LDSCTL_OFF = RING_BYTES, MISC_OFF = LDSCTL_OFF + 320;
constexpr int LDS_BYTES = 147456;

struct Args { const float* in[29]; float* out; unsigned char* ws; int l_lo, l_hi; };
#define KOUT() ((float*)karg_ptr<232>())
#define KWS() ((unsigned char*)karg_ptr<240>())
enum InIdx { I_XP = 0, I_XS, I_SRW, I_SSH, I_F1G, I_F1U, I_F1D, I_WIN, I_MU, I_W0, I_WUP, I_A0, I_AUP, I_GUP, I_KK, I_KA, I_RK, I_GNG, I_GNB, I_GLG, I_GLB, I_GWS, I_GBS, I_WOUT, I_F2G, I_F2U, I_F2D, I_LNG, I_LNB };


template <int OFF> __device__ __forceinline__ const float* karg_ptr() {
    const unsigned long long kp = (unsigned long long)__builtin_amdgcn_kernarg_segment_ptr(); unsigned long long v;
    asm volatile("s_load_dwordx2 %0, %1, %2\n\ts_waitcnt lgkmcnt(0)" : "=s"(v) : "s"(kp), "i"(OFF) : "memory");
    return (const float*)v;
}
#define KIN(i) karg_ptr<8 * (i)>()
template <int CTRL> __device__ __forceinline__ float dpp_mov(float x) { return __builtin_bit_cast(float, __builtin_amdgcn_mov_dpp(__builtin_bit_cast(int, x), CTRL, 0xf, 0xf, true)); }
__device__ __forceinline__ float row16_sum(float x) { x += dpp_mov<0x128>(x); x += dpp_mov<0x124>(x); x += dpp_mov<0x122>(x); x += dpp_mov<0x121>(x); return x; }
__device__ __forceinline__ float wave_sum(float v) {
    v = row16_sum(v); const int i = __builtin_bit_cast(int, v);
    const float a = __builtin_bit_cast(float, __builtin_amdgcn_readlane(i, 0)), b = __builtin_bit_cast(float, __builtin_amdgcn_readlane(i, 16)), c = __builtin_bit_cast(float, __builtin_amdgcn_readlane(i, 32)), d = __builtin_bit_cast(float, __builtin_amdgcn_readlane(i, 48));
    return (a + b) + (c + d);
}

template <int MAP> __device__ __forceinline__ void cvt_task(const float* __restrict__ W, int K, int N, bf16* __restrict__ WT, int nb, int k0, int lane) {
    const int n = nb * 256 + 4 * lane; if (n >= N) return;
    const int drow = MAP == 0 ? n : (MAP == 3 ? (n < SHIFT ? n : n + (PLD - SHIFT)) : 256 * (n >> 7) + (n & 127) + (MAP == 2 ? 128 : 0));
    const float* src = W + (size_t)k0 * N + n; bf16* dst = WT + (size_t)drow * K + k0;
#pragma unroll
    for (int kk = 0; kk < 32; kk += 16) { f32x4 v[16];
#pragma unroll
        for (int j = 0; j < 16; ++j) v[j] = *(const f32x4*)(src + (size_t)(kk + j) * N);
#pragma unroll
        for (int i = 0; i < 4; ++i)
#pragma unroll
            for (int hh = 0; hh < 2; ++hh) { v4u o; o.x = pk2(v[8 * hh + 0][i], v[8 * hh + 1][i]); o.y = pk2(v[8 * hh + 2][i], v[8 * hh + 3][i]); o.z = pk2(v[8 * hh + 4][i], v[8 * hh + 5][i]); o.w = pk2(v[8 * hh + 6][i], v[8 * hh + 7][i]);
                *(v4u*)(dst + (size_t)i * K + kk + 8 * hh) = o; } }
}

__device__ __forceinline__ void phase_convert(int l, LAS unsigned char* lds, int wave, int lane, int gw, int NGW) {
    unsigned char* ws = KWS();
    const size_t so = (size_t)l * DM * FF;
    const float *f1g = KIN(I_F1G) + so, *f1u = KIN(I_F1U) + so, *f1d = KIN(I_F1D) + so, *f2g = KIN(I_F2G) + so, *f2u = KIN(I_F2U) + so, *f2d = KIN(I_F2D) + so;
    const float* win = KIN(I_WIN) + (size_t)l * DM * INC; const float* wout = KIN(I_WOUT) + (size_t)l * DM * DM;
    constexpr int T_GU = (FF / 256) * (DM / 32);
    constexpr int T_D = (DM / 256) * (FF / 32);
    constexpr int T_IN = ((INC + 255) / 256) * (DM / 32);
    constexpr int T_O = (DM / 256) * (DM / 32);
    constexpr int NTASK = 4 * T_GU + 2 * T_D + T_IN + T_O;
    for (int it = gw; it < NTASK; it += NGW) {
        int r = it;
        if (r < 4 * T_GU) { const int which = r / T_GU; r -= which * T_GU; const int nb = r % (FF / 256), kb = r / (FF / 256);
            const float* W = which == 0 ? f1g : (which == 1 ? f1u : (which == 2 ? f2g : f2u)); bf16* WT = (bf16*)(ws + (which < 2 ? W_1 : W_5));
            if (which & 1) cvt_task<2>(W, DM, FF, WT, nb, 32 * kb, lane); else cvt_task<1>(W, DM, FF, WT, nb, 32 * kb, lane); continue; }
        r -= 4 * T_GU;
        if (r < 2 * T_D) { const int which = r / T_D; r -= which * T_D; const int nb = r % (DM / 256), kb = r / (DM / 256);
            cvt_task<0>(which == 0 ? f1d : f2d, FF, DM, (bf16*)(ws + (which == 0 ? W_2 : W_6)), nb, 32 * kb, lane); continue; }
        r -= 2 * T_D;
        if (r < T_IN) { const int nb = r % ((INC + 255) / 256), kb = r / ((INC + 255) / 256); cvt_task<3>(win, DM, INC, (bf16*)(ws + W_3), nb, 32 * kb, lane); continue; }
        r -= T_IN;
        { const int nb = r % (DM / 256), kb = r / (DM / 256); cvt_task<0>(wout, DM, DM, (bf16*)(ws + W_4), nb, 32 * kb, lane); }
    }
    { v4u* z = (v4u*)(ws + W_3 + (size_t)SHIFT * DM * 2); const int nz = (PLD - SHIFT) * DM * 2 / 16;
      unsigned z0; asm volatile("v_mov_b32 %0, 0" : "=v"(z0));
      for (int i = gw * 64 + lane; i < nz; i += NGW * 64) z[i] = (v4u){z0, z0, z0, z0}; }
    { bf16* WT = (bf16*)(ws + W_3B); const float* wup = KIN(I_WUP) + (size_t)l * 64 * RW; const float* aup = KIN(I_AUP) + (size_t)l * 64 * RW; const float* gup = KIN(I_GUP) + (size_t)l * 160 * RW;
      for (int i = gw * 64 + lane; i < NL * LK; i += NGW * 64) { const int n = i / LK, k = i % LK, kind = n >> 10, c = n & 1023; float v = 0.f;
          if (kind == 0) { if (k < 64) v = wup[(size_t)k * RW + c]; } else if (kind == 1) { if (k >= 64 && k < 128) v = aup[(size_t)(k - 64) * RW + c]; } else { if (k >= 128 && k < 288) v = gup[(size_t)(k - 128) * RW + c]; }
          WT[i] = (bf16)f2bf(v); } }
    if (l == 0) {
        float* X = (float*)(ws + WS_X); bf16* XB = (bf16*)(ws + WS_XB); const float* xp = KIN(I_XP); const float* xs = KIN(I_XS);
        for (int m = gw; m < M; m += NGW) { const float* src = m < TP ? xp + (size_t)m * DM : xs + (size_t)(m - TP) * DM;
            const f32x4* s4 = (const f32x4*)src + lane; f32x4* d4 = (f32x4*)(X + (size_t)m * DM) + lane; unsigned long long* o8 = (unsigned long long*)(XB + (size_t)m * DM) + lane;
#pragma unroll
            for (int j = 0; j < 8; ++j) { const f32x4 v = s4[64 * j]; d4[64 * j] = v; o8[64 * j] = (unsigned long long)pk2(v.x, v.y) | ((unsigned long long)pk2(v.z, v.w) << 32); } }
    }
}

__device__ __forceinline__ void phase_ln(const float* Z, const float* g, const float* b, float* Xo, bf16* XBo, int lane, int gw, int NGW) {
    for (int m = gw; m < M; m += NGW) {
        const f32x4* zr = (const f32x4*)(Z + (size_t)m * DM) + lane; f32x4 v[8]; float s = 0.f;
#pragma unroll
        for (int j = 0; j < 8; ++j) { v[j] = zr[64 * j]; s += (v[j].x + v[j].y) + (v[j].z + v[j].w); }
        const float mean = wave_sum(s) * (1.f / DM); float s2 = 0.f;
#pragma unroll
        for (int j = 0; j < 8; ++j) { v[j] = v[j] - mean; s2 += (v[j].x * v[j].x + v[j].y * v[j].y) + (v[j].z * v[j].z + v[j].w * v[j].w); }
        const float rstd = 1.f / sqrtf(wave_sum(s2) * (1.f / DM) + LN_EPS);
        f32x4* xo = (f32x4*)(Xo + (size_t)m * DM) + lane;
#pragma unroll
        for (int j = 0; j < 8; ++j) { const f32x4 gg = ((const f32x4*)g)[lane + 64 * j], bb = ((const f32x4*)b)[lane + 64 * j]; const f32x4 o = v[j] * rstd * gg + bb; xo[64 * j] = o;
            if (XBo) ((unsigned long long*)(XBo + (size_t)m * DM) + lane)[64 * j] = (unsigned long long)pk2(o.x, o.y) | ((unsigned long long)pk2(o.z, o.w) << 32); }
    }
}

__device__ __forceinline__ const float* prev_row(const float* ssh, int l, const float* P, int m) {
    if (m < TP) return m == 0 ? nullptr : P + (size_t)(m - 1) * PLD;
    const int b = (m - TP) >> 5, t = (m - TP) & 31;
    return t == 0 ? ssh + (size_t)(l * NSB + b) * SHIFT : P + (size_t)(m - 1) * PLD;
}

__device__ __forceinline__ void phase_prep1(int l, int lane, int gw, int NGW) {
    unsigned char* ws = KWS(); float* outp = KOUT(); const float* P = (const float*)(ws + B_P); float* GV = (float*)(ws + B_GV); bf16* A3B = (bf16*)(ws + B_A3B);
    const float* mu = KIN(I_MU) + (size_t)l * SHIFT; const float* lg = KIN(I_GLG) + (size_t)l * GMW; const float* lb = KIN(I_GLB) + (size_t)l * GMW;
    const float* ssh = KIN(I_SSH);
    for (int m = gw; m < M; m += NGW) {
        const float* pr = P + (size_t)m * PLD; const float* pp = prev_row(ssh, l, P, m);
#pragma unroll
        for (int jj = 0; jj < 6; ++jj) { const int j = jj * 64 + lane; float v = 0.f;
            if (j < 288) { const int c = C_W + j; const float p = pr[c], q = pp ? pp[c] : 0.f; const float xs = p + (q - p) * mu[c];
                if (j < 64) { const float t = __expf(-2.f * fabsf(xs)); const float r = (1.f - t) / (1.f + t); v = xs < 0.f ? -r : r; }
                else if (j < 128) v = xs;
                else v = 1.f / (1.f + __expf(-xs)); }
            A3B[(size_t)m * LK + j] = (bf16)f2bf(v); }
        { f32x4* vr = (f32x4*)(GV + (size_t)m * GMW) + lane; f32x4 v[4]; float s = 0.f;
#pragma unroll
          for (int j = 0; j < 4; ++j) { v[j] = vr[64 * j]; s += (v[j].x + v[j].y) + (v[j].z + v[j].w); }
          const float mean = wave_sum(s) * (1.f / GMW); float s2 = 0.f;
#pragma unroll
          for (int j = 0; j < 4; ++j) { v[j] = v[j] - mean; s2 += (v[j].x * v[j].x + v[j].y * v[j].y) + (v[j].z * v[j].z + v[j].w * v[j].w); }
          const float rstd = 1.f / sqrtf(wave_sum(s2) * (1.f / GMW) + LN_EPS);
          f32x4* go = nullptr; if (m >= TP) go = (f32x4*)(outp + O_GV + ((size_t)l * NSB * TS + (m - TP)) * GMW) + lane;
#pragma unroll
          for (int j = 0; j < 4; ++j) { const f32x4 o = v[j] * rstd * ((const f32x4*)lg)[lane + 64 * j] + ((const f32x4*)lb)[lane + 64 * j]; vr[64 * j] = o; if (go) go[64 * j] = o; } }
        if (m == TP - 1) { float* o = outp + O_SHP + (size_t)l * SHIFT; for (int c = lane; c < SHIFT; c += 64) o[c] = pr[c]; }
        if (m >= TP && ((m - TP) & 31) == 31) { float* o = outp + O_SHS + (size_t)(l * NSB + ((m - TP) >> 5)) * SHIFT; for (int c = lane; c < SHIFT; c += 64) o[c] = pr[c]; }
    }
}

__device__ __forceinline__ void gmlp_unit(int l, LAS unsigned char* lds, int unit, int tid) {
    unsigned char* ws = KWS(); const float* VN = (const float*)(ws + B_GV); const bf16* U = (const bf16*)(ws + B_U); bf16* MIXB = (bf16*)(ws + B_MIX);
    const int ci = unit >> 3, h = unit & 7; int row0, nr; if (ci < 128) { row0 = 128 * ci; nr = 128; } else { row0 = TP + 32 * (ci - 128); nr = 32; }
    const float* wsm = KIN(I_GWS) + ((size_t)l * GH + h) * 128 * 128; const float* bs = KIN(I_GBS) + ((size_t)l * GH + h) * 128;
    LAS f32x4* Lws = (LAS f32x4*)lds; LAS f32x4* Lv = Lws + 4096;
    __syncthreads();
    for (int idx = tid; idx < nr * 32; idx += NTHR) { const int r = idx >> 5, c4 = idx & 31; Lws[idx] = *(const f32x4*)(wsm + r * 128 + 4 * c4); Lv[idx] = *(const f32x4*)(VN + (size_t)(row0 + r) * GMW + h * GHD + 4 * c4); }
    __syncthreads();
    const int rg = tid >> 4, cg = tid & 15;
    if (4 * rg < nr) {
        f32x4 acc[4][2];
#pragma unroll
        for (int r = 0; r < 4; ++r) { const float b0 = bs[4 * rg + r]; acc[r][0] = (f32x4){b0, b0, b0, b0}; acc[r][1] = acc[r][0]; }
        const LAS float* Lwf = (const LAS float*)Lws;
        for (int j = 0; j < 4 * rg + 4; ++j) { const f32x4 v0 = Lv[j * 32 + 2 * cg], v1 = Lv[j * 32 + 2 * cg + 1];
#pragma unroll
            for (int r = 0; r < 4; ++r) { const float w = (j <= 4 * rg + r) ? Lwf[(4 * rg + r) * 128 + j] : 0.f; acc[r][0] += v0 * w; acc[r][1] += v1 * w; } }
#pragma unroll
        for (int r = 0; r < 4; ++r) { const size_t row = (size_t)(row0 + 4 * rg + r); const v4u uu = *(const v4u*)(U + row * GMW + h * GHD + 8 * cg);
            const float u0 = __builtin_bit_cast(float, uu.x << 16), u1 = __builtin_bit_cast(float, uu.x & 0xffff0000u), u2 = __builtin_bit_cast(float, uu.y << 16), u3 = __builtin_bit_cast(float, uu.y & 0xffff0000u);
            const float u4 = __builtin_bit_cast(float, uu.z << 16), u5 = __builtin_bit_cast(float, uu.z & 0xffff0000u), u6 = __builtin_bit_cast(float, uu.w << 16), u7 = __builtin_bit_cast(float, uu.w & 0xffff0000u);
            v4u o; o.x = pk2(u0 * acc[r][0].x, u1 * acc[r][0].y); o.y = pk2(u2 * acc[r][0].z, u3 * acc[r][0].w); o.z = pk2(u4 * acc[r][1].x, u5 * acc[r][1].y); o.w = pk2(u6 * acc[r][1].z, u7 * acc[r][1].w);
            *(v4u*)(MIXB + row * DM + RW + h * GHD + 8 * cg) = o; }
    }
}


constexpr int NCI = 272, NUNIT = NCI * NH;
constexpr size_t SC_G = WS_RW + 3 * RWSZ;
constexpr size_t SC_HL = SC_G + (size_t)NUNIT * 8192;
constexpr size_t SC_RP = SC_HL + (size_t)NUNIT * 16384;
constexpr size_t SC_YL = SC_RP + (size_t)NUNIT * 8192;
constexpr size_t SC_S0 = SC_YL + (size_t)NUNIT * 16384;
constexpr size_t SC_BON = SC_S0 + (size_t)NUNIT * 8192;
constexpr size_t SC_END = SC_BON + (size_t)NUNIT * 256;
static_assert(SC_END <= WS_END, "scan scratch");
typedef unsigned u32x2 __attribute__((ext_vector_type(2)));
constexpr int BLD = 144;
constexpr int LBUF = 9216;
constexpr int LF0 = 7 * LBUF, F0P = 129;
constexpr int LF1 = LF0 + 64 * F0P * 4, F1P = 68;
constexpr int LF2 = LF1 + 64 * F1P * 4;
constexpr int LTOT = LF2 + 16384;
constexpr int LGC = LTOT + 2048;
constexpr int SCAN_LDS = LGC + 256;
static_assert(SCAN_LDS <= RING_BYTES, "scan LDS");

__device__ __forceinline__ bf16x8 ldfrag(const LAS unsigned char* mat, int blk, int ks, int lane) { return *(const LAS bf16x8*)(mat + (16 * blk + (lane & 15)) * BLD + (32 * ks + 8 * (lane >> 4)) * 2); }
#define MFMA16(a, b, c) __builtin_amdgcn_mfma_f32_16x16x32_bf16((a), (b), (c), 0, 0, 0)

__device__ __forceinline__ void scanA_unit(int l, LAS unsigned char* lds, int unit, int tid, int wave) {
    unsigned char* ws = KWS();
    const int lane = tid & 63, ci = unit >> 4, h = unit & 15, cc = 64 * h + lane;
    int m0, n; if (ci < 256) { m0 = 64 * ci; n = 64; } else { m0 = TP + 32 * (ci - 256); n = 32; }
    const float* P = (const float*)(ws + B_P); const float* Wl = (const float*)(ws + WS_RW); const float* Al = (const float*)(ws + WS_RW + RWSZ);
    LAS unsigned char* B0 = lds; LAS unsigned char* B1 = lds + LBUF; LAS unsigned char* B2 = lds + 2 * LBUF; LAS unsigned char* B3 = lds + 3 * LBUF;
    LAS unsigned char* B4 = lds + 4 * LBUF; LAS unsigned char* B5 = lds + 5 * LBUF; LAS unsigned char* B6 = lds + 6 * LBUF;
    LAS float* F0 = (LAS float*)(lds + LF0); LAS float* F1 = (LAS float*)(lds + LF1); LAS float* F2 = (LAS float*)(lds + LF2); LAS float* TOT = (LAS float*)(lds + LTOT); LAS float* GC = (LAS float*)(lds + LGC);
    __syncthreads();
    {
        const float* mu = KIN(I_MU) + (size_t)l * SHIFT;
        const float mu_r = mu[cc], mu_k = mu[RW + cc], mu_v = mu[2 * RW + cc];
        const float w0c = (KIN(I_W0) + (size_t)l * RW)[cc], a0c = (KIN(I_A0) + (size_t)l * RW)[cc], kkc = (KIN(I_KK) + (size_t)l * RW)[cc], kac = (KIN(I_KA) + (size_t)l * RW)[cc], rkc = (KIN(I_RK) + (size_t)l * RW)[cc];
        const int t0 = 8 * wave; const bool live = t0 < n;
        float r[8], kp[8], v[8], kk[8], b[8], lw[8];
        float q_r = 0.f, q_k = 0.f, q_v = 0.f;
        if (live) { const float* pp = prev_row(KIN(I_SSH), l, P, m0 + t0); if (pp) { q_r = pp[cc]; q_k = pp[RW + cc]; q_v = pp[2 * RW + cc]; } }
        float* bon = (float*)(ws + SC_BON) + (size_t)unit * 64;
        float pr_[8], pk_[8], pv_[8], al_[8], wl_[8], bsv[8];
#pragma unroll
        for (int i = 0; i < 8; ++i) { pr_[i] = 0.f; pk_[i] = 0.f; pv_[i] = 0.f; al_[i] = 0.f; wl_[i] = 0.f;
            if (live) { const size_t m = (size_t)(m0 + t0 + i); const float* pr = P + m * PLD; pr_[i] = pr[cc]; pk_[i] = pr[RW + cc]; pv_[i] = pr[2 * RW + cc]; al_[i] = Al[m * RW + cc]; wl_[i] = Wl[m * RW + cc]; } }
#pragma unroll
        for (int i = 0; i < 8; ++i) {
            r[i] = 0.f; kp[i] = 0.f; v[i] = 0.f; kk[i] = 0.f; b[i] = 0.f; lw[i] = 0.f; bsv[i] = 0.f;
            if (live) {
                const float p_r = pr_[i], p_k = pk_[i], p_v = pv_[i];
                const float rr = p_r + (q_r - p_r) * mu_r, kx = p_k + (q_k - p_k) * mu_k, vx = p_v + (q_v - p_v) * mu_v; q_r = p_r; q_k = p_k; q_v = p_v;
                const float av = 1.f / (1.f + __expf(-(a0c + al_[i])));
                const float y = -(w0c + wl_[i]); const float sp = fmaxf(y, 0.f) + __logf(1.0f + __expf(-fabsf(y)));
                const float kkv = kx * kkc; const float n2 = wave_sum(kkv * kkv); const float kn = kkv / fmaxf(sqrtf(n2), 1e-12f);
                const float kpv = kx * (1.f + (av - 1.f) * kac);
                bsv[i] = wave_sum(rr * kpv * rkc);
                r[i] = rr; kp[i] = kpv; v[i] = vx; kk[i] = kn; b[i] = kn * av; lw[i] = -__expf(-sp - 0.5f); }
        }
        if (live && lane < 8) { float bv = bsv[0];
#pragma unroll
            for (int i = 1; i < 8; ++i) bv = lane == i ? bsv[i] : bv;
            bon[t0 + lane] = bv; }
        float pl[8]; pl[0] = lw[0];
#pragma unroll
        for (int i = 1; i < 8; ++i) pl[i] = pl[i - 1] + lw[i];
        TOT[wave * 64 + lane] = pl[7];
        __syncthreads();
        float off = 0.f, lamC = 0.f;
#pragma unroll
        for (int s = 0; s < 8; ++s) { const float tv = TOT[s * 64 + lane]; lamC += tv; if (s < wave) off += tv; }
        if (wave == 0) GC[lane] = __expf(lamC);
        unsigned vt[4], kb[4], bb[4];
#pragma unroll
        for (int i = 0; i < 8; ++i) { const int t = t0 + i; const float lam = off + pl[i];
            const float g_t = __expf(lam), g_p = __expf(lam - lw[i]), g_i = __expf(-lam), g_c = __expf(lamC - lam);
            const float kkt = kk[i] * g_p, rt = r[i] * g_t;
            *(LAS unsigned short*)(B0 + t * BLD + lane * 2) = (unsigned short)f2bf(kkt); F0[t * F0P + lane] = kkt;
            *(LAS unsigned short*)(B1 + t * BLD + lane * 2) = (unsigned short)f2bf(rt); F2[t * 64 + lane] = rt;
            *(LAS unsigned short*)(B2 + t * BLD + lane * 2) = (unsigned short)f2bf(kp[i] * g_i);
            *(LAS unsigned short*)(B3 + t * BLD + lane * 2) = (unsigned short)f2bf(b[i] * g_i);
            const unsigned hv = f2bf(v[i]), hk = f2bf(kp[i] * g_c), hb = f2bf(b[i] * g_c);
            if (i & 1) { vt[i >> 1] |= hv << 16; kb[i >> 1] |= hk << 16; bb[i >> 1] |= hb << 16; } else { vt[i >> 1] = hv; kb[i >> 1] = hk; bb[i >> 1] = hb; } }
        *(LAS v4u*)(B4 + lane * BLD + 16 * wave) = (v4u){vt[0], vt[1], vt[2], vt[3]};
        *(LAS v4u*)(B5 + lane * BLD + 16 * wave) = (v4u){kb[0], kb[1], kb[2], kb[3]};
        *(LAS v4u*)(B6 + lane * BLD + 16 * wave) = (v4u){bb[0], bb[1], bb[2], bb[3]};
    }
    __syncthreads();
    const int rb = wave >> 1, cb0 = (wave & 1) * 2, g = lane >> 4, lc = lane & 15;
    float zf; asm volatile("v_mov_b32 %0, 0" : "=v"(zf));
    const f32x4 z4 = (f32x4){zf, zf, zf, zf};
    {
        f32x4 aab[2] = {z4, z4}, aak[2] = {z4, z4}, arb[2] = {z4, z4}, ark[2] = {z4, z4};
#pragma unroll
        for (int ks = 0; ks < 2; ++ks) { const bf16x8 fk = ldfrag(B0, rb, ks, lane), fr = ldfrag(B1, rb, ks, lane);
#pragma unroll
            for (int c = 0; c < 2; ++c) { const bf16x8 fkh = ldfrag(B2, cb0 + c, ks, lane), fb = ldfrag(B3, cb0 + c, ks, lane);
                aab[c] = MFMA16(fk, fb, aab[c]); aak[c] = MFMA16(fk, fkh, aak[c]); arb[c] = MFMA16(fr, fb, arb[c]); ark[c] = MFMA16(fr, fkh, ark[c]); } }
        __syncthreads();
#pragma unroll
        for (int c = 0; c < 2; ++c)
#pragma unroll
            for (int rg = 0; rg < 4; ++rg) { const int t = 16 * rb + 4 * g + rg, s = 16 * (cb0 + c) + lc;
                F1[t * F1P + (s & 3) * 16 + (s >> 2)] = s < t ? aab[c][rg] : 0.f;
                *(LAS unsigned short*)(B0 + t * BLD + s * 2) = (unsigned short)f2bf(s < t ? aak[c][rg] : 0.f);
                *(LAS unsigned short*)(B1 + t * BLD + s * 2) = (unsigned short)f2bf(s <= t ? arb[c][rg] : 0.f);
                *(LAS unsigned short*)(B2 + t * BLD + s * 2) = (unsigned short)f2bf(s <= t ? ark[c][rg] : 0.f); }
    }
    __syncthreads();
    {
        f32x4 av[2] = {z4, z4};
#pragma unroll
        for (int ks = 0; ks < 2; ++ks) { const bf16x8 fa = ldfrag(B0, rb, ks, lane);
#pragma unroll
            for (int c = 0; c < 2; ++c) av[c] = MFMA16(fa, ldfrag(B4, cb0 + c, ks, lane), av[c]); }
#pragma unroll
        for (int c = 0; c < 2; ++c)
#pragma unroll
            for (int rg = 0; rg < 4; ++rg) F0[(16 * rb + 4 * g + rg) * F0P + 64 + 16 * (cb0 + c) + lc] = av[c][rg];
    }
    __syncthreads();
    {
        const int j = tid >> 2, p = tid & 3; const LAS float* f1p = F1 + p * 16; const LAS float* f0p = F0 + j;
        float x0 = zf, x1 = zf, x2 = zf, x3 = zf, x4 = zf, x5 = zf, x6 = zf, x7 = zf, x8 = zf, x9 = zf, x10 = zf, x11 = zf, x12 = zf, x13 = zf, x14 = zf, x15 = zf;
        { float part = zf; const float xt = f0p[0*F0P] - part; x0 = (p == 0) ? xt : x0; }
        { const f32x4 a0 = *(const LAS f32x4*)(f1p + 1*F1P + 0); float part = a0.x * x0; part += dpp_mov<0xB1>(part); part += dpp_mov<0x4E>(part); const float xt = f0p[1*F0P] - part; x0 = (p == 1) ? xt : x0; }
        { const f32x4 a0 = *(const LAS f32x4*)(f1p + 2*F1P + 0); float part = a0.x * x0; part += dpp_mov<0xB1>(part); part += dpp_mov<0x4E>(part); const float xt = f0p[2*F0P] - part; x0 = (p == 2) ? xt : x0; }
        { const f32x4 a0 = *(const LAS f32x4*)(f1p + 3*F1P + 0); float part = a0.x * x0; part += dpp_mov<0xB1>(part); part += dpp_mov<0x4E>(part); const float xt = f0p[3*F0P] - part; x0 = (p == 3) ? xt : x0; }
        { const f32x4 a0 = *(const LAS f32x4*)(f1p + 4*F1P + 0); float part = a0.x * x0; part += dpp_mov<0xB1>(part); part += dpp_mov<0x4E>(part); const float xt = f0p[4*F0P] - part; x1 = (p == 0) ? xt : x1; }
        { const f32x4 a0 = *(const LAS f32x4*)(f1p + 5*F1P + 0); float part = (a0.x * x0) + (a0.y * x1); part += dpp_mov<0xB1>(part); part += dpp_mov<0x4E>(part); const float xt = f0p[5*F0P] - part; x1 = (p == 1) ? xt : x1; }
        { const f32x4 a0 = *(const LAS f32x4*)(f1p + 6*F1P + 0); float part = (a0.x * x0) + (a0.y * x1); part += dpp_mov<0xB1>(part); part += dpp_mov<0x4E>(part); const float xt = f0p[6*F0P] - part; x1 = (p == 2) ? xt : x1; }
        { const f32x4 a0 = *(const LAS f32x4*)(f1p + 7*F1P + 0); float part = (a0.x * x0) + (a0.y * x1); part += dpp_mov<0xB1>(part); part += dpp_mov<0x4E>(part); const float xt = f0p[7*F0P] - part; x1 = (p == 3) ? xt : x1; }
        { const f32x4 a0 = *(const LAS f32x4*)(f1p + 8*F1P + 0); float part = (a0.x * x0) + (a0.y * x1); part += dpp_mov<0xB1>(part); part += dpp_mov<0x4E>(part); const float xt = f0p[8*F0P] - part; x2 = (p == 0) ? xt : x2; }
        { const f32x4 a0 = *(const LAS f32x4*)(f1p + 9*F1P + 0); float part = (a0.x * x0 + a0.z * x2) + (a0.y * x1); part += dpp_mov<0xB1>(part); part += dpp_mov<0x4E>(part); const float xt = f0p[9*F0P] - part; x2 = (p == 1) ? xt : x2; }
        { const f32x4 a0 = *(const LAS f32x4*)(f1p + 10*F1P + 0); float part = (a0.x * x0 + a0.z * x2) + (a0.y * x1); part += dpp_mov<0xB1>(part); part += dpp_mov<0x4E>(part); const float xt = f0p[10*F0P] - part; x2 = (p == 2) ? xt : x2; }
        { const f32x4 a0 = *(const LAS f32x4*)(f1p + 11*F1P + 0); float part = (a0.x * x0 + a0.z * x2) + (a0.y * x1); part += dpp_mov<0xB1>(part); part += dpp_mov<0x4E>(part); const float xt = f0p[11*F0P] - part; x2 = (p == 3) ? xt : x2; }
        { const f32x4 a0 = *(const LAS f32x4*)(f1p + 12*F1P + 0); float part = (a0.x * x0 + a0.z * x2) + (a0.y * x1); part += dpp_mov<0xB1>(part); part += dpp_mov<0x4E>(part); const float xt = f0p[12*F0P] - part; x3 = (p == 0) ? xt : x3; }
        { const f32x4 a0 = *(const LAS f32x4*)(f1p + 13*F1P + 0); float part = (a0.x * x0 + a0.z * x2) + (a0.y * x1 + a0.w * x3); part += dpp_mov<0xB1>(part); part += dpp_mov<0x4E>(part); const float xt = f0p[13*F0P] - part; x3 = (p == 1) ? xt : x3; }
        { const f32x4 a0 = *(const LAS f32x4*)(f1p + 14*F1P + 0); float part = (a0.x * x0 + a0.z * x2) + (a0.y * x1 + a0.w * x3); part += dpp_mov<0xB1>(part); part += dpp_mov<0x4E>(part); const float xt = f0p[14*F0P] - part; x3 = (p == 2) ? xt : x3; }
        { const f32x4 a0 = *(const LAS f32x4*)(f1p + 15*F1P + 0); float part = (a0.x * x0 + a0.z * x2) + (a0.y * x1 + a0.w * x3); part += dpp_mov<0xB1>(part); part += dpp_mov<0x4E>(part); const float xt = f0p[15*F0P] - part; x3 = (p == 3) ? xt : x3; }
        { const f32x4 a0 = *(const LAS f32x4*)(f1p + 16*F1P + 0); float part = (a0.x * x0 + a0.z * x2) + (a0.y * x1 + a0.w * x3); part += dpp_mov<0xB1>(part); part += dpp_mov<0x4E>(part); const float xt = f0p[16*F0P] - part; x4 = (p == 0) ? xt : x4; }
        { const f32x4 a0 = *(const LAS f32x4*)(f1p + 17*F1P + 0); const f32x4 a1 = *(const LAS f32x4*)(f1p + 17*F1P + 4); float part = (a0.x * x0 + a0.z * x2 + a1.x * x4) + (a0.y * x1 + a0.w * x3); part += dpp_mov<0xB1>(part); part += dpp_mov<0x4E>(part); const float xt = f0p[17*F0P] - part; x4 = (p == 1) ? xt : x4; }
        { const f32x4 a0 = *(const LAS f32x4*)(f1p + 18*F1P + 0); const f32x4 a1 = *(const LAS f32x4*)(f1p + 18*F1P + 4); float part = (a0.x * x0 + a0.z * x2 + a1.x * x4) + (a0.y * x1 + a0.w * x3); part += dpp_mov<0xB1>(part); part += dpp_mov<0x4E>(part); const float xt = f0p[18*F0P] - part; x4 = (p == 2) ? xt : x4; }
        { const f32x4 a0 = *(const LAS f32x4*)(f1p + 19*F1P + 0); const f32x4 a1 = *(const LAS f32x4*)(f1p + 19*F1P + 4); float part = (a0.x * x0 + a0.z * x2 + a1.x * x4) + (a0.y * x1 + a0.w * x3); part += dpp_mov<0xB1>(part); part += dpp_mov<0x4E>(part); const float xt = f0p[19*F0P] - part; x4 = (p == 3) ? xt : x4; }
        { const f32x4 a0 = *(const LAS f32x4*)(f1p + 20*F1P + 0); const f32x4 a1 = *(const LAS f32x4*)(f1p + 20*F1P + 4); float part = (a0.x * x0 + a0.z * x2 + a1.x * x4) + (a0.y * x1 + a0.w * x3); part += dpp_mov<0xB1>(part); part += dpp_mov<0x4E>(part); const float xt = f0p[20*F0P] - part; x5 = (p == 0) ? xt : x5; }
        { const f32x4 a0 = *(const LAS f32x4*)(f1p + 21*F1P + 0); const f32x4 a1 = *(const LAS f32x4*)(f1p + 21*F1P + 4); float part = (a0.x * x0 + a0.z * x2 + a1.x * x4) + (a0.y * x1 + a0.w * x3 + a1.y * x5); part += dpp_mov<0xB1>(part); part += dpp_mov<0x4E>(part); const float xt = f0p[21*F0P] - part; x5 = (p == 1) ? xt : x5; }
        { const f32x4 a0 = *(const LAS f32x4*)(f1p + 22*F1P + 0); const f32x4 a1 = *(const LAS f32x4*)(f1p + 22*F1P + 4); float part = (a0.x * x0 + a0.z * x2 + a1.x * x4) + (a0.y * x1 + a0.w * x3 + a1.y * x5); part += dpp_mov<0xB1>(part); part += dpp_mov<0x4E>(part); const float xt = f0p[22*F0P] - part; x5 = (p == 2) ? xt : x5; }
        { const f32x4 a0 = *(const LAS f32x4*)(f1p + 23*F1P + 0); const f32x4 a1 = *(const LAS f32x4*)(f1p + 23*F1P + 4); float part = (a0.x * x0 + a0.z * x2 + a1.x * x4) + (a0.y * x1 + a0.w * x3 + a1.y * x5); part += dpp_mov<0xB1>(part); part += dpp_mov<0x4E>(part); const float xt = f0p[23*F0P] - part; x5 = (p == 3) ? xt : x5; }
        { const f32x4 a0 = *(const LAS f32x4*)(f1p + 24*F1P + 0); const f32x4 a1 = *(const LAS f32x4*)(f1p + 24*F1P + 4); float part = (a0.x * x0 + a0.z * x2 + a1.x * x4) + (a0.y * x1 + a0.w * x3 + a1.y * x5); part += dpp_mov<0xB1>(part); part += dpp_mov<0x4E>(part); const float xt = f0p[24*F0P] - part; x6 = (p == 0) ? xt : x6; }
        { const f32x4 a0 = *(const LAS f32x4*)(f1p + 25*F1P + 0); const f32x4 a1 = *(const LAS f32x4*)(f1p + 25*F1P + 4); float part = (a0.x * x0 + a0.z * x2 + a1.x * x4 + a1.z * x6) + (a0.y * x1 + a0.w * x3 + a1.y * x5); part += dpp_mov<0xB1>(part); part += dpp_mov<0x4E>(part); const float xt = f0p[25*F0P] - part; x6 = (p == 1) ? xt : x6; }
        { const f32x4 a0 = *(const LAS f32x4*)(f1p + 26*F1P + 0); const f32x4 a1 = *(const LAS f32x4*)(f1p + 26*F1P + 4); float part = (a0.x * x0 + a0.z * x2 + a1.x * x4 + a1.z * x6) + (a0.y * x1 + a0.w * x3 + a1.y * x5); part += dpp_mov<0xB1>(part); part += dpp_mov<0x4E>(part); const float xt = f0p[26*F0P] - part; x6 = (p == 2) ? xt : x6; }
        { const f32x4 a0 = *(const LAS f32x4*)(f1p + 27*F1P + 0); const f32x4 a1 = *(const LAS f32x4*)(f1p + 27*F1P + 4); float part = (a0.x * x0 + a0.z * x2 + a1.x * x4 + a1.z * x6) + (a0.y * x1 + a0.w * x3 + a1.y * x5); part += dpp_mov<0xB1>(part); part += dpp_mov<0x4E>(part); const float xt = f0p[27*F0P] - part; x6 = (p == 3) ? xt : x6; }
        { const f32x4 a0 = *(const LAS f32x4*)(f1p + 28*F1P + 0); const f32x4 a1 = *(const LAS f32x4*)(f1p + 28*F1P + 4); float part = (a0.x * x0 + a0.z * x2 + a1.x * x4 + a1.z * x6) + (a0.y * x1 + a0.w * x3 + a1.y * x5); part += dpp_mov<0xB1>(part); part += dpp_mov<0x4E>(part); const float xt = f0p[28*F0P] - part; x7 = (p == 0) ? xt : x7; }
        { const f32x4 a0 = *(const LAS f32x4*)(f1p + 29*F1P + 0); const f32x4 a1 = *(const LAS f32x4*)(f1p + 29*F1P + 4); float part = (a0.x * x0 + a0.z * x2 + a1.x * x4 + a1.z * x6) + (a0.y * x1 + a0.w * x3 + a1.y * x5 + a1.w * x7); part += dpp_mov<0xB1>(part); part += dpp_mov<0x4E>(part); const float xt = f0p[29*F0P] - part; x7 = (p == 1) ? xt : x7; }
        { const f32x4 a0 = *(const LAS f32x4*)(f1p + 30*F1P + 0); const f32x4 a1 = *(const LAS f32x4*)(f1p + 30*F1P + 4); float part = (a0.x * x0 + a0.z * x2 + a1.x * x4 + a1.z * x6) + (a0.y * x1 + a0.w * x3 + a1.y * x5 + a1.w * x7); part += dpp_mov<0xB1>(part); part += dpp_mov<0x4E>(part); const float xt = f0p[30*F0P] - part; x7 = (p == 2) ? xt : x7; }
        { const f32x4 a0 = *(const LAS f32x4*)(f1p + 31*F1P + 0); const f32x4 a1 = *(const LAS f32x4*)(f1p + 31*F1P + 4); float part = (a0.x * x0 + a0.z * x2 + a1.x * x4 + a1.z * x6) + (a0.y * x1 + a0.w * x3 + a1.y * x5 + a1.w * x7); part += dpp_mov<0xB1>(part); part += dpp_mov<0x4E>(part); const float xt = f0p[31*F0P] - part; x7 = (p == 3) ? xt : x7; }
        { const f32x4 a0 = *(const LAS f32x4*)(f1p + 32*F1P + 0); const f32x4 a1 = *(const LAS f32x4*)(f1p + 32*F1P + 4); float part = (a0.x * x0 + a0.z * x2 + a1.x * x4 + a1.z * x6) + (a0.y * x1 + a0.w * x3 + a1.y * x5 + a1.w * x7); part += dpp_mov<0xB1>(part); part += dpp_mov<0x4E>(part); const float xt = f0p[32*F0P] - part; x8 = (p == 0) ? xt : x8; }
        { const f32x4 a0 = *(const LAS f32x4*)(f1p + 33*F1P + 0); const f32x4 a1 = *(const LAS f32x4*)(f1p + 33*F1P + 4); const f32x4 a2 = *(const LAS f32x4*)(f1p + 33*F1P + 8); float part = (a0.x * x0 + a0.z * x2 + a1.x * x4 + a1.z * x6 + a2.x * x8) + (a0.y * x1 + a0.w * x3 + a1.y * x5 + a1.w * x7); part += dpp_mov<0xB1>(part); part += dpp_mov<0x4E>(part); const float xt = f0p[33*F0P] - part; x8 = (p == 1) ? xt : x8; }
        { const f32x4 a0 = *(const LAS f32x4*)(f1p + 34*F1P + 0); const f32x4 a1 = *(const LAS f32x4*)(f1p + 34*F1P + 4); const f32x4 a2 = *(const LAS f32x4*)(f1p + 34*F1P + 8); float part = (a0.x * x0 + a0.z * x2 + a1.x * x4 + a1.z * x6 + a2.x * x8) + (a0.y * x1 + a0.w * x3 + a1.y * x5 + a1.w * x7); part += dpp_mov<0xB1>(part); part += dpp_mov<0x4E>(part); const float xt = f0p[34*F0P] - part; x8 = (p == 2) ? xt : x8; }
        { const f32x4 a0 = *(const LAS f32x4*)(f1p + 35*F1P + 0); const f32x4 a1 = *(const LAS f32x4*)(f1p + 35*F1P + 4); const f32x4 a2 = *(const LAS f32x4*)(f1p + 35*F1P + 8); float part = (a0.x * x0 + a0.z * x2 + a1.x * x4 + a1.z * x6 + a2.x * x8) + (a0.y * x1 + a0.w * x3 + a1.y * x5 + a1.w * x7); part += dpp_mov<0xB1>(part); part += dpp_mov<0x4E>(part); const float xt = f0p[35*F0P] - part; x8 = (p == 3) ? xt : x8; }
        { const f32x4 a0 = *(const LAS f32x4*)(f1p + 36*F1P + 0); const f32x4 a1 = *(const LAS f32x4*)(f1p + 36*F1P + 4); const f32x4 a2 = *(const LAS f32x4*)(f1p + 36*F1P + 8); float part = (a0.x * x0 + a0.z * x2 + a1.x * x4 + a1.z * x6 + a2.x * x8) + (a0.y * x1 + a0.w * x3 + a1.y * x5 + a1.w * x7); part += dpp_mov<0xB1>(part); part += dpp_mov<0x4E>(part); const float xt = f0p[36*F0P] - part; x9 = (p == 0) ? xt : x9; }
        { const f32x4 a0 = *(const LAS f32x4*)(f1p + 37*F1P + 0); const f32x4 a1 = *(const LAS f32x4*)(f1p + 37*F1P + 4); const f32x4 a2 = *(const LAS f32x4*)(f1p + 37*F1P + 8); float part = (a0.x * x0 + a0.z * x2 + a1.x * x4 + a1.z * x6 + a2.x * x8) + (a0.y * x1 + a0.w * x3 + a1.y * x5 + a1.w * x7 + a2.y * x9); part += dpp_mov<0xB1>(part); part += dpp_mov<0x4E>(part); const float xt = f0p[37*F0P] - part; x9 = (p == 1) ? xt : x9; }
        { const f32x4 a0 = *(const LAS f32x4*)(f1p + 38*F1P + 0); const f32x4 a1 = *(const LAS f32x4*)(f1p + 38*F1P + 4); const f32x4 a2 = *(const LAS f32x4*)(f1p + 38*F1P + 8); float part = (a0.x * x0 + a0.z * x2 + a1.x * x4 + a1.z * x6 + a2.x * x8) + (a0.y * x1 + a0.w * x3 + a1.y * x5 + a1.w * x7 + a2.y * x9); part += dpp_mov<0xB1>(part); part += dpp_mov<0x4E>(part); const float xt = f0p[38*F0P] - part; x9 = (p == 2) ? xt : x9; }
        { const f32x4 a0 = *(const LAS f32x4*)(f1p + 39*F1P + 0); const f32x4 a1 = *(const LAS f32x4*)(f1p + 39*F1P + 4); const f32x4 a2 = *(const LAS f32x4*)(f1p + 39*F1P + 8); float part = (a0.x * x0 + a0.z * x2 + a1.x * x4 + a1.z * x6 + a2.x * x8) + (a0.y * x1 + a0.w * x3 + a1.y * x5 + a1.w * x7 + a2.y * x9); part += dpp_mov<0xB1>(part); part += dpp_mov<0x4E>(part); const float xt = f0p[39*F0P] - part; x9 = (p == 3) ? xt : x9; }
        { const f32x4 a0 = *(const LAS f32x4*)(f1p + 40*F1P + 0); const f32x4 a1 = *(const LAS f32x4*)(f1p + 40*F1P + 4); const f32x4 a2 = *(const LAS f32x4*)(f1p + 40*F1P + 8); float part = (a0.x * x0 + a0.z * x2 + a1.x * x4 + a1.z * x6 + a2.x * x8) + (a0.y * x1 + a0.w * x3 + a1.y * x5 + a1.w * x7 + a2.y * x9); part += dpp_mov<0xB1>(part); part += dpp_mov<0x4E>(part); const float xt = f0p[40*F0P] - part; x10 = (p == 0) ? xt : x10; }
        { const f32x4 a0 = *(const LAS f32x4*)(f1p + 41*F1P + 0); const f32x4 a1 = *(const LAS f32x4*)(f1p + 41*F1P + 4); const f32x4 a2 = *(const LAS f32x4*)(f1p + 41*F1P + 8); float part = (a0.x * x0 + a0.z * x2 + a1.x * x4 + a1.z * x6 + a2.x * x8 + a2.z * x10) + (a0.y * x1 + a0.w * x3 + a1.y * x5 + a1.w * x7 + a2.y * x9); part += dpp_mov<0xB1>(part); part += dpp_mov<0x4E>(part); const float xt = f0p[41*F0P] - part; x10 = (p == 1) ? xt : x10; }
        { const f32x4 a0 = *(const LAS f32x4*)(f1p + 42*F1P + 0); const f32x4 a1 = *(const LAS f32x4*)(f1p + 42*F1P + 4); const f32x4 a2 = *(const LAS f32x4*)(f1p + 42*F1P + 8); float part = (a0.x * x0 + a0.z * x2 + a1.x * x4 + a1.z * x6 + a2.x * x8 + a2.z * x10) + (a0.y * x1 + a0.w * x3 + a1.y * x5 + a1.w * x7 + a2.y * x9); part += dpp_mov<0xB1>(part); part += dpp_mov<0x4E>(part); const float xt = f0p[42*F0P] - part; x10 = (p == 2) ? xt : x10; }
        { const f32x4 a0 = *(const LAS f32x4*)(f1p + 43*F1P + 0); const f32x4 a1 = *(const LAS f32x4*)(f1p + 43*F1P + 4); const f32x4 a2 = *(const LAS f32x4*)(f1p + 43*F1P + 8); float part = (a0.x * x0 + a0.z * x2 + a1.x * x4 + a1.z * x6 + a2.x * x8 + a2.z * x10) + (a0.y * x1 + a0.w * x3 + a1.y * x5 + a1.w * x7 + a2.y * x9); part += dpp_mov<0xB1>(part); part += dpp_mov<0x4E>(part); const float xt = f0p[43*F0P] - part; x10 = (p == 3) ? xt : x10; }
        { const f32x4 a0 = *(const LAS f32x4*)(f1p + 44*F1P + 0); const f32x4 a1 = *(const LAS f32x4*)(f1p + 44*F1P + 4); const f32x4 a2 = *(const LAS f32x4*)(f1p + 44*F1P + 8); float part = (a0.x * x0 + a0.z * x2 + a1.x * x4 + a1.z * x6 + a2.x * x8 + a2.z * x10) + (a0.y * x1 + a0.w * x3 + a1.y * x5 + a1.w * x7 + a2.y * x9); part += dpp_mov<0xB1>(part); part += dpp_mov<0x4E>(part); const float xt = f0p[44*F0P] - part; x11 = (p == 0) ? xt : x11; }
        { const f32x4 a0 = *(const LAS f32x4*)(f1p + 45*F1P + 0); const f32x4 a1 = *(const LAS f32x4*)(f1p + 45*F1P + 4); const f32x4 a2 = *(const LAS f32x4*)(f1p + 45*F1P + 8); float part = (a0.x * x0 + a0.z * x2 + a1.x * x4 + a1.z * x6 + a2.x * x8 + a2.z * x10) + (a0.y * x1 + a0.w * x3 + a1.y * x5 + a1.w * x7 + a2.y * x9 + a2.w * x11); part += dpp_mov<0xB1>(part); part += dpp_mov<0x4E>(part); const float xt = f0p[45*F0P] - part; x11 = (p == 1) ? xt : x11; }
        { const f32x4 a0 = *(const LAS f32x4*)(f1p + 46*F1P + 0); const f32x4 a1 = *(const LAS f32x4*)(f1p + 46*F1P + 4); const f32x4 a2 = *(const LAS f32x4*)(f1p + 46*F1P + 8); float part = (a0.x * x0 + a0.z * x2 + a1.x * x4 + a1.z * x6 + a2.x * x8 + a2.z * x10) + (a0.y * x1 + a0.w * x3 + a1.y * x5 + a1.w * x7 + a2.y * x9 + a2.w * x11); part += dpp_mov<0xB1>(part); part += dpp_mov<0x4E>(part); const float xt = f0p[46*F0P] - part; x11 = (p == 2) ? xt : x11; }
        { const f32x4 a0 = *(const LAS f32x4*)(f1p + 47*F1P + 0); const f32x4 a1 = *(const LAS f32x4*)(f1p + 47*F1P + 4); const f32x4 a2 = *(const LAS f32x4*)(f1p + 47*F1P + 8); float part = (a0.x * x0 + a0.z * x2 + a1.x * x4 + a1.z * x6 + a2.x * x8 + a2.z * x10) + (a0.y * x1 + a0.w * x3 + a1.y * x5 + a1.w * x7 + a2.y * x9 + a2.w * x11); part += dpp_mov<0xB1>(part); part += dpp_mov<0x4E>(part); const float xt = f0p[47*F0P] - part; x11 = (p == 3) ? xt : x11; }
        { const f32x4 a0 = *(const LAS f32x4*)(f1p + 48*F1P + 0); const f32x4 a1 = *(const LAS f32x4*)(f1p + 48*F1P + 4); const f32x4 a2 = *(const LAS f32x4*)(f1p + 48*F1P + 8); float part = (a0.x * x0 + a0.z * x2 + a1.x * x4 + a1.z * x6 + a2.x * x8 + a2.z * x10) + (a0.y * x1 + a0.w * x3 + a1.y * x5 + a1.w * x7 + a2.y * x9 + a2.w * x11); part += dpp_mov<0xB1>(part); part += dpp_mov<0x4E>(part); const float xt = f0p[48*F0P] - part; x12 = (p == 0) ? xt : x12; }
        { const f32x4 a0 = *(const LAS f32x4*)(f1p + 49*F1P + 0); const f32x4 a1 = *(const LAS f32x4*)(f1p + 49*F1P + 4); const f32x4 a2 = *(const LAS f32x4*)(f1p + 49*F1P + 8); const f32x4 a3 = *(const LAS f32x4*)(f1p + 49*F1P + 12); float part = (a0.x * x0 + a0.z * x2 + a1.x * x4 + a1.z * x6 + a2.x * x8 + a2.z * x10 + a3.x * x12) + (a0.y * x1 + a0.w * x3 + a1.y * x5 + a1.w * x7 + a2.y * x9 + a2.w * x11); part += dpp_mov<0xB1>(part); part += dpp_mov<0x4E>(part); const float xt = f0p[49*F0P] - part; x12 = (p == 1) ? xt : x12; }
        { const f32x4 a0 = *(const LAS f32x4*)(f1p + 50*F1P + 0); const f32x4 a1 = *(const LAS f32x4*)(f1p + 50*F1P + 4); const f32x4 a2 = *(const LAS f32x4*)(f1p + 50*F1P + 8); const f32x4 a3 = *(const LAS f32x4*)(f1p + 50*F1P + 12); float part = (a0.x * x0 + a0.z * x2 + a1.x * x4 + a1.z * x6 + a2.x * x8 + a2.z * x10 + a3.x * x12) + (a0.y * x1 + a0.w * x3 + a1.y * x5 + a1.w * x7 + a2.y * x9 + a2.w * x11); part += dpp_mov<0xB1>(part); part += dpp_mov<0x4E>(part); const float xt = f0p[50*F0P] - part; x12 = (p == 2) ? xt : x12; }
        { const f32x4 a0 = *(const LAS f32x4*)(f1p + 51*F1P + 0); const f32x4 a1 = *(const LAS f32x4*)(f1p + 51*F1P + 4); const f32x4 a2 = *(const LAS f32x4*)(f1p + 51*F1P + 8); const f32x4 a3 = *(const LAS f32x4*)(f1p + 51*F1P + 12); float part = (a0.x * x0 + a0.z * x2 + a1.x * x4 + a1.z * x6 + a2.x * x8 + a2.z * x10 + a3.x * x12) + (a0.y * x1 + a0.w * x3 + a1.y * x5 + a1.w * x7 + a2.y * x9 + a2.w * x11); part += dpp_mov<0xB1>(part); part += dpp_mov<0x4E>(part); const float xt = f0p[51*F0P] - part; x12 = (p == 3) ? xt : x12; }
        { const f32x4 a0 = *(const LAS f32x4*)(f1p + 52*F1P + 0); const f32x4 a1 = *(const LAS f32x4*)(f1p + 52*F1P + 4); const f32x4 a2 = *(const LAS f32x4*)(f1p + 52*F1P + 8); const f32x4 a3 = *(const LAS f32x4*)(f1p + 52*F1P + 12); float part = (a0.x * x0 + a0.z * x2 + a1.x * x4 + a1.z * x6 + a2.x * x8 + a2.z * x10 + a3.x * x12) + (a0.y * x1 + a0.w * x3 + a1.y * x5 + a1.w * x7 + a2.y * x9 + a2.w * x11); part += dpp_mov<0xB1>(part); part += dpp_mov<0x4E>(part); const float xt = f0p[52*F0P] - part; x13 = (p == 0) ? xt : x13; }
        { const f32x4 a0 = *(const LAS f32x4*)(f1p + 53*F1P + 0); const f32x4 a1 = *(const LAS f32x4*)(f1p + 53*F1P + 4); const f32x4 a2 = *(const LAS f32x4*)(f1p + 53*F1P + 8); const f32x4 a3 = *(const LAS f32x4*)(f1p + 53*F1P + 12); float part = (a0.x * x0 + a0.z * x2 + a1.x * x4 + a1.z * x6 + a2.x * x8 + a2.z * x10 + a3.x * x12) + (a0.y * x1 + a0.w * x3 + a1.y * x5 + a1.w * x7 + a2.y * x9 + a2.w * x11 + a3.y * x13); part += dpp_mov<0xB1>(part); part += dpp_mov<0x4E>(part); const float xt = f0p[53*F0P] - part; x13 = (p == 1) ? xt : x13; }
        { const f32x4 a0 = *(const LAS f32x4*)(f1p + 54*F1P + 0); const f32x4 a1 = *(const LAS f32x4*)(f1p + 54*F1P + 4); const f32x4 a2 = *(const LAS f32x4*)(f1p + 54*F1P + 8); const f32x4 a3 = *(const LAS f32x4*)(f1p + 54*F1P + 12); float part = (a0.x * x0 + a0.z * x2 + a1.x * x4 + a1.z * x6 + a2.x * x8 + a2.z * x10 + a3.x * x12) + (a0.y * x1 + a0.w * x3 + a1.y * x5 + a1.w * x7 + a2.y * x9 + a2.w * x11 + a3.y * x13); part += dpp_mov<0xB1>(part); part += dpp_mov<0x4E>(part); const float xt = f0p[54*F0P] - part; x13 = (p == 2) ? xt : x13; }
        { const f32x4 a0 = *(const LAS f32x4*)(f1p + 55*F1P + 0); const f32x4 a1 = *(const LAS f32x4*)(f1p + 55*F1P + 4); const f32x4 a2 = *(const LAS f32x4*)(f1p + 55*F1P + 8); const f32x4 a3 = *(const LAS f32x4*)(f1p + 55*F1P + 12); float part = (a0.x * x0 + a0.z * x2 + a1.x * x4 + a1.z * x6 + a2.x * x8 + a2.z * x10 + a3.x * x12) + (a0.y * x1 + a0.w * x3 + a1.y * x5 + a1.w * x7 + a2.y * x9 + a2.w * x11 + a3.y * x13); part += dpp_mov<0xB1>(part); part += dpp_mov<0x4E>(part); const float xt = f0p[55*F0P] - part; x13 = (p == 3) ? xt : x13; }
        { const f32x4 a0 = *(const LAS f32x4*)(f1p + 56*F1P + 0); const f32x4 a1 = *(const LAS f32x4*)(f1p + 56*F1P + 4); const f32x4 a2 = *(const LAS f32x4*)(f1p + 56*F1P + 8); const f32x4 a3 = *(const LAS f32x4*)(f1p + 56*F1P + 12); float part = (a0.x * x0 + a0.z * x2 + a1.x * x4 + a1.z * x6 + a2.x * x8 + a2.z * x10 + a3.x * x12) + (a0.y * x1 + a0.w * x3 + a1.y * x5 + a1.w * x7 + a2.y * x9 + a2.w * x11 + a3.y * x13); part += dpp_mov<0xB1>(part); part += dpp_mov<0x4E>(part); const float xt = f0p[56*F0P] - part; x14 = (p == 0) ? xt : x14; }
        { const f32x4 a0 = *(const LAS f32x4*)(f1p + 57*F1P + 0); const f32x4 a1 = *(const LAS f32x4*)(f1p + 57*F1P + 4); const f32x4 a2 = *(const LAS f32x4*)(f1p + 57*F1P + 8); const f32x4 a3 = *(const LAS f32x4*)(f1p + 57*F1P + 12); float part = (a0.x * x0 + a0.z * x2 + a1.x * x4 + a1.z * x6 + a2.x * x8 + a2.z * x10 + a3.x * x12 + a3.z * x14) + (a0.y * x1 + a0.w * x3 + a1.y * x5 + a1.w * x7 + a2.y * x9 + a2.w * x11 + a3.y * x13); part += dpp_mov<0xB1>(part); part += dpp_mov<0x4E>(part); const float xt = f0p[57*F0P] - part; x14 = (p == 1) ? xt : x14; }
        { const f32x4 a0 = *(const LAS f32x4*)(f1p + 58*F1P + 0); const f32x4 a1 = *(const LAS f32x4*)(f1p + 58*F1P + 4); const f32x4 a2 = *(const LAS f32x4*)(f1p + 58*F1P + 8); const f32x4 a3 = *(const LAS f32x4*)(f1p + 58*F1P + 12); float part = (a0.x * x0 + a0.z * x2 + a1.x * x4 + a1.z * x6 + a2.x * x8 + a2.z * x10 + a3.x * x12 + a3.z * x14) + (a0.y * x1 + a0.w * x3 + a1.y * x5 + a1.w * x7 + a2.y * x9 + a2.w * x11 + a3.y * x13); part += dpp_mov<0xB1>(part); part += dpp_mov<0x4E>(part); const float xt = f0p[58*F0P] - part; x14 = (p == 2) ? xt : x14; }
        { const f32x4 a0 = *(const LAS f32x4*)(f1p + 59*F1P + 0); const f32x4 a1 = *(const LAS f32x4*)(f1p + 59*F1P + 4); const f32x4 a2 = *(const LAS f32x4*)(f1p + 59*F1P + 8); const f32x4 a3 = *(const LAS f32x4*)(f1p + 59*F1P + 12); float part = (a0.x * x0 + a0.z * x2 + a1.x * x4 + a1.z * x6 + a2.x * x8 + a2.z * x10 + a3.x * x12 + a3.z * x14) + (a0.y * x1 + a0.w * x3 + a1.y * x5 + a1.w * x7 + a2.y * x9 + a2.w * x11 + a3.y * x13); part += dpp_mov<0xB1>(part); part += dpp_mov<0x4E>(part); const float xt = f0p[59*F0P] - part; x14 = (p == 3) ? xt : x14; }
        { const f32x4 a0 = *(const LAS f32x4*)(f1p + 60*F1P + 0); const f32x4 a1 = *(const LAS f32x4*)(f1p + 60*F1P + 4); const f32x4 a2 = *(const LAS f32x4*)(f1p + 60*F1P + 8); const f32x4 a3 = *(const LAS f32x4*)(f1p + 60*F1P + 12); float part = (a0.x * x0 + a0.z * x2 + a1.x * x4 + a1.z * x6 + a2.x * x8 + a2.z * x10 + a3.x * x12 + a3.z * x14) + (a0.y * x1 + a0.w * x3 + a1.y * x5 + a1.w * x7 + a2.y * x9 + a2.w * x11 + a3.y * x13); part += dpp_mov<0xB1>(part); part += dpp_mov<0x4E>(part); const float xt = f0p[60*F0P] - part; x15 = (p == 0) ? xt : x15; }
        { const f32x4 a0 = *(const LAS f32x4*)(f1p + 61*F1P + 0); const f32x4 a1 = *(const LAS f32x4*)(f1p + 61*F1P + 4); const f32x4 a2 = *(const LAS f32x4*)(f1p + 61*F1P + 8); const f32x4 a3 = *(const LAS f32x4*)(f1p + 61*F1P + 12); float part = (a0.x * x0 + a0.z * x2 + a1.x * x4 + a1.z * x6 + a2.x * x8 + a2.z * x10 + a3.x * x12 + a3.z * x14) + (a0.y * x1 + a0.w * x3 + a1.y * x5 + a1.w * x7 + a2.y * x9 + a2.w * x11 + a3.y * x13 + a3.w * x15); part += dpp_mov<0xB1>(part); part += dpp_mov<0x4E>(part); const float xt = f0p[61*F0P] - part; x15 = (p == 1) ? xt : x15; }
        { const f32x4 a0 = *(const LAS f32x4*)(f1p + 62*F1P + 0); const f32x4 a1 = *(const LAS f32x4*)(f1p + 62*F1P + 4); const f32x4 a2 = *(const LAS f32x4*)(f1p + 62*F1P + 8); const f32x4 a3 = *(const LAS f32x4*)(f1p + 62*F1P + 12); float part = (a0.x * x0 + a0.z * x2 + a1.x * x4 + a1.z * x6 + a2.x * x8 + a2.z * x10 + a3.x * x12 + a3.z * x14) + (a0.y * x1 + a0.w * x3 + a1.y * x5 + a1.w * x7 + a2.y * x9 + a2.w * x11 + a3.y * x13 + a3.w * x15); part += dpp_mov<0xB1>(part); part += dpp_mov<0x4E>(part); const float xt = f0p[62*F0P] - part; x15 = (p == 2) ? xt : x15; }
        { const f32x4 a0 = *(const LAS f32x4*)(f1p + 63*F1P + 0); const f32x4 a1 = *(const LAS f32x4*)(f1p + 63*F1P + 4); const f32x4 a2 = *(const LAS f32x4*)(f1p + 63*F1P + 8); const f32x4 a3 = *(const LAS f32x4*)(f1p + 63*F1P + 12); float part = (a0.x * x0 + a0.z * x2 + a1.x * x4 + a1.z * x6 + a2.x * x8 + a2.z * x10 + a3.x * x12 + a3.z * x14) + (a0.y * x1 + a0.w * x3 + a1.y * x5 + a1.w * x7 + a2.y * x9 + a2.w * x11 + a3.y * x13 + a3.w * x15); part += dpp_mov<0xB1>(part); part += dpp_mov<0x4E>(part); const float xt = f0p[63*F0P] - part; x15 = (p == 3) ? xt : x15; }
        LAS unsigned char* dst = (wave < 4 ? B3 : B0) + (j & 63) * BLD + p * 2;
        *(LAS unsigned short*)(dst + 0) = (unsigned short)f2bf(-x0);
        *(LAS unsigned short*)(dst + 8) = (unsigned short)f2bf(-x1);
        *(LAS unsigned short*)(dst + 16) = (unsigned short)f2bf(-x2);
        *(LAS unsigned short*)(dst + 24) = (unsigned short)f2bf(-x3);
        *(LAS unsigned short*)(dst + 32) = (unsigned short)f2bf(-x4);
        *(LAS unsigned short*)(dst + 40) = (unsigned short)f2bf(-x5);
        *(LAS unsigned short*)(dst + 48) = (unsigned short)f2bf(-x6);
        *(LAS unsigned short*)(dst + 56) = (unsigned short)f2bf(-x7);
        *(LAS unsigned short*)(dst + 64) = (unsigned short)f2bf(-x8);
        *(LAS unsigned short*)(dst + 72) = (unsigned short)f2bf(-x9);
        *(LAS unsigned short*)(dst + 80) = (unsigned short)f2bf(-x10);
        *(LAS unsigned short*)(dst + 88) = (unsigned short)f2bf(-x11);
        *(LAS unsigned short*)(dst + 96) = (unsigned short)f2bf(-x12);
        *(LAS unsigned short*)(dst + 104) = (unsigned short)f2bf(-x13);
        *(LAS unsigned short*)(dst + 112) = (unsigned short)f2bf(-x14);
        *(LAS unsigned short*)(dst + 120) = (unsigned short)f2bf(-x15);
    }
    __syncthreads();
    {
        f32x4 rp[2], yl[2] = {z4, z4}, gg[2], hl[2] = {z4, z4};
#pragma unroll
        for (int c = 0; c < 2; ++c)
#pragma unroll
            for (int rg = 0; rg < 4; ++rg) { const int row = 16 * rb + 4 * g + rg, col = 16 * (cb0 + c) + lc; rp[c][rg] = F2[row * 64 + col]; gg[c][rg] = row == col ? GC[row] : 0.f; }
#pragma unroll
        for (int ks = 0; ks < 2; ++ks) { const bf16x8 farb = ldfrag(B1, rb, ks, lane), fark = ldfrag(B2, rb, ks, lane), fbb = ldfrag(B6, rb, ks, lane), fkb = ldfrag(B5, rb, ks, lane);
#pragma unroll
            for (int c = 0; c < 2; ++c) { const bf16x8 fp = ldfrag(B3, cb0 + c, ks, lane), fq = ldfrag(B0, cb0 + c, ks, lane), fv = ldfrag(B4, cb0 + c, ks, lane);
                rp[c] = MFMA16(farb, fp, rp[c]); yl[c] = MFMA16(fark, fv, yl[c]); yl[c] = MFMA16(farb, fq, yl[c]);
                gg[c] = MFMA16(fbb, fp, gg[c]); hl[c] = MFMA16(fkb, fv, hl[c]); hl[c] = MFMA16(fbb, fq, hl[c]); } }
        bf16* RPg = (bf16*)(ws + SC_RP) + (size_t)unit * 4096; float* YLg = (float*)(ws + SC_YL) + (size_t)unit * 4096; bf16* Gg_ = (bf16*)(ws + SC_G) + (size_t)unit * 4096; float* HLg = (float*)(ws + SC_HL) + (size_t)unit * 4096;
#pragma unroll
        for (int c = 0; c < 2; ++c)
#pragma unroll
            for (int rg = 0; rg < 4; ++rg) { const int o = (16 * rb + 4 * g + rg) * 64 + 16 * (cb0 + c) + lc;
                RPg[o] = (bf16)f2bf(rp[c][rg]); YLg[o] = yl[c][rg]; Gg_[o] = (bf16)f2bf(gg[c][rg]); HLg[o] = hl[c][rg]; }
    }
}

template <int NSTEP, int PF> __device__ __forceinline__ void scanB_chain(int l, LAS unsigned char* lds, int ci0, int h, int vs, const float* init, float* outp_state, int tid, int wave) {
    unsigned char* ws = KWS();
    const int lane = tid & 63, half = wave >> 2, jr = wave & 3, g = lane >> 4, lc = lane & 15;
    LAS unsigned char* XH = lds + half * 16384;
    const bf16* Gall = (const bf16*)(ws + SC_G); const float* HLall = (const float*)(ws + SC_HL); bf16* S0all = (bf16*)(ws + SC_S0);
    float zf; asm volatile("v_mov_b32 %0, 0" : "=v"(zf));
    f32x4 acc = (f32x4){zf, zf, zf, zf};
    __syncthreads();
    if (init) acc = *(const f32x4*)(init + (16 * vs + lc) * 64 + 16 * jr + 4 * g);
    bf16x8 Gf[PF][2]; f32x4 Lf[PF];
#define SB_ISSUE(slot, c) do { const size_t unit_ = (size_t)(ci0 + (c)) * 16 + h; const bf16* Gp = Gall + unit_ * 4096 + (16 * jr + lc) * 64 + 8 * g; const float* Lp = HLall + unit_ * 4096 + (16 * jr + 4 * g) * 64 + 16 * vs + lc; \
        Gf[slot][0] = *(const bf16x8*)Gp; Gf[slot][1] = *(const bf16x8*)(Gp + 32); Lf[slot] = (f32x4){Lp[0], Lp[64], Lp[128], Lp[192]}; } while (0)
#pragma unroll
    for (int s = 0; s < PF; ++s) if (s < NSTEP) SB_ISSUE(s, s);
    for (int c0 = 0; c0 < NSTEP; c0 += PF) {
#pragma unroll
        for (int s = 0; s < PF; ++s) { const int c = c0 + s; if (NSTEP % PF == 0 || c < NSTEP) {
            const size_t unit = (size_t)(ci0 + c) * 16 + h;
            const unsigned h0 = pk2(acc.x, acc.y), h1 = pk2(acc.z, acc.w);
            const float l0 = acc.x - __builtin_bit_cast(float, h0 << 16), l1 = acc.y - __builtin_bit_cast(float, h0 & 0xffff0000u), l2 = acc.z - __builtin_bit_cast(float, h1 << 16), l3 = acc.w - __builtin_bit_cast(float, h1 & 0xffff0000u);
            LAS unsigned char* xb = XH + (c & 1) * 8192;
            *(LAS u32x2*)(xb + lc * BLD + (16 * jr + 4 * g) * 2) = (u32x2){h0, h1};
            *(LAS u32x2*)(xb + 4096 + lc * BLD + (16 * jr + 4 * g) * 2) = (u32x2){pk2(l0, l1), pk2(l2, l3)};
            *(u32x2*)(S0all + unit * 4096 + (16 * vs + lc) * 64 + 16 * jr + 4 * g) = (u32x2){h0, h1};
            __syncthreads();
            f32x4 a2 = Lf[s];
#pragma unroll
            for (int ks = 0; ks < 2; ++ks) { const bf16x8 bh = *(const LAS bf16x8*)(xb + lc * BLD + (32 * ks + 8 * g) * 2), bl = *(const LAS bf16x8*)(xb + 4096 + lc * BLD + (32 * ks + 8 * g) * 2);
                a2 = MFMA16(Gf[s][ks], bh, a2); a2 = MFMA16(Gf[s][ks], bl, a2); }
            acc = a2;
            if (c + PF < NSTEP) SB_ISSUE(s, c + PF);
        } }
    }
    *(f32x4*)(outp_state + (16 * vs + lc) * 64 + 16 * jr + 4 * g) = acc;
#undef SB_ISSUE
}

__device__ __forceinline__ void scanC_unit(int l, LAS unsigned char* lds, int unit, int tid, int wave) {
    unsigned char* ws = KWS();
    const int lane = tid & 63, ci = unit >> 4, h = unit & 15, cc = 64 * h + lane;
    int m0, n; if (ci < 256) { m0 = 64 * ci; n = 64; } else { m0 = TP + 32 * (ci - 256); n = 32; }
    const int rb = wave >> 1, cb0 = (wave & 1) * 2, g = lane >> 4, lc = lane & 15;
    const bf16* RPg = (const bf16*)(ws + SC_RP) + (size_t)unit * 4096; const float* YLg = (const float*)(ws + SC_YL) + (size_t)unit * 4096; const bf16* S0g = (const bf16*)(ws + SC_S0) + (size_t)unit * 4096;
    LAS float* Yl = (LAS float*)lds;
    f32x4 acc[2];
#pragma unroll
    for (int c = 0; c < 2; ++c)
#pragma unroll
        for (int rg = 0; rg < 4; ++rg) acc[c][rg] = YLg[(16 * rb + 4 * g + rg) * 64 + 16 * (cb0 + c) + lc];
#pragma unroll
    for (int ks = 0; ks < 2; ++ks) { const bf16x8 fa = *(const bf16x8*)(RPg + (16 * rb + lc) * 64 + 32 * ks + 8 * g);
#pragma unroll
        for (int c = 0; c < 2; ++c) acc[c] = MFMA16(fa, *(const bf16x8*)(S0g + (16 * (cb0 + c) + lc) * 64 + 32 * ks + 8 * g), acc[c]); }
    __syncthreads();
#pragma unroll
    for (int c = 0; c < 2; ++c)
#pragma unroll
        for (int rg = 0; rg < 4; ++rg) Yl[(16 * rb + 4 * g + rg) * 65 + 16 * (cb0 + c) + lc] = acc[c][rg];
    __syncthreads();
    const int t0 = 8 * wave;
    if (t0 < n) {
        const float* P = (const float*)(ws + B_P); const float* Gg = (const float*)(ws + WS_RW + 2 * RWSZ); bf16* MIXB = (bf16*)(ws + B_MIX); const float* bon = (const float*)(ws + SC_BON) + (size_t)unit * 64;
        const float mu_v = (KIN(I_MU) + (size_t)l * SHIFT)[2 * RW + cc], gng = (KIN(I_GNG) + (size_t)l * RW)[cc], gnb = (KIN(I_GNB) + (size_t)l * RW)[cc];
        const float* pp = prev_row(KIN(I_SSH), l, P, m0 + t0); float q_v = pp ? pp[2 * RW + cc] : 0.f;
        float pv_[8], gt_[8], bn_[8];
#pragma unroll
        for (int i = 0; i < 8; ++i) { const size_t m = (size_t)(m0 + t0 + i); pv_[i] = P[m * PLD + 2 * RW + cc]; gt_[i] = Gg[m * RW + cc]; bn_[i] = bon[t0 + i]; }
        unsigned short ov[8];
#pragma unroll
        for (int i = 0; i < 8; ++i) { const int t = t0 + i;
            const float y = Yl[t * 65 + lane]; const float ym = wave_sum(y) * (1.f / HN); const float d = y - ym; const float yv = wave_sum(d * d) * (1.f / HN);
            const float yn = d * (1.f / sqrtf(yv + GN_EPS)) * gng + gnb;
            const float p_v = pv_[i]; const float vx = p_v + (q_v - p_v) * mu_v; q_v = p_v;
            ov[i] = (unsigned short)f2bf((yn + bn_[i] * vx) * gt_[i]); }
#pragma unroll
        for (int i = 0; i < 8; ++i) MIXB[(size_t)(m0 + t0 + i) * DM + cc] = (bf16)ov[i];
    }
}

template <int PH> __global__ void __launch_bounds__(NTHR, 2) mk_fwd(Args a) {
    extern __shared__ __attribute__((aligned(16))) unsigned char lds_raw[];
    LAS unsigned char* lds = (LAS unsigned char*)lds_raw;
    const int wave_s = __builtin_amdgcn_readfirstlane((int)threadIdx.x >> 6);
    for (int u = threadIdx.x; u < (LDS_BYTES - LDSCTL_OFF) / 4; u += NTHR) ((LAS unsigned*)(lds + LDSCTL_OFF))[u] = 0u;
    __syncthreads();
    if (PH < 0) (void)xcd_barrier_post((unsigned*)KWS() + CW_BAR, (volatile LAS unsigned*)(lds + MISC_OFF) + 8, (int)threadIdx.x);
#define IN(k) (PH < 0 || PH == (k))
#define PHASE_IDS() int tid_; asm volatile("v_mbcnt_lo_u32_b32 %0, -1, 0\n\tv_mbcnt_hi_u32_b32 %0, -1, %0\n\tv_lshl_add_u32 %0, %1, 6, %0" : "=&v"(tid_) : "s"(wave_s)); const int tid = tid_, lane = tid & 63, wave = wave_s; \
    const int G = gridDim.x, bx = blockIdx.x, vcu = (G % 8 == 0) ? (bx % 8) * (G / 8) + bx / 8 : bx, gw = vcu * NWAVES + wave, NGW = G * NWAVES; unsigned char* ws = KWS(); (void)tid; (void)lane; (void)gw; (void)NGW; (void)ws
#define SEAM() do { if (PH < 0) { XcdBarrier bar_; bar_.bar = (unsigned*)KWS() + CW_BAR; bar_.x = xb_xcc_id(); bar_.st = (volatile LAS unsigned*)(lds + MISC_OFF) + 8; xcd_barrier(bar_, tid); } } while (0)

    for (int l = a.l_lo; l < a.l_hi; ++l) {
        if (IN(0)) { PHASE_IDS(); phase_convert(l, lds, wave, lane, gw, NGW); SEAM(); }
        if (IN(1)) { PHASE_IDS(); pg8::Gemm g{(const bf16*)(ws + WS_XB), (const bf16*)(ws + W_1), M, 2 * FF, DM}; pg8::StaticOrder S; S.init(M, 2 * FF, G, bx); pg8::EpiSwiGLU E{(bf16*)(ws + B_H), FF};
            pg8::gemm_phase<pg8::EpiSwiGLU, pg8::StaticOrder, true, true>(lds + RING_OFF, g, S, E, tid); SEAM(); }
        if (IN(2)) { PHASE_IDS(); pg8::Gemm g{(const bf16*)(ws + B_H), (const bf16*)(ws + W_2), M, DM, FF}; pg8::StaticOrder S; S.init(M, DM, G, bx); pg8::EpiResid E{(const float*)(ws + WS_X), (float*)(ws + WS_Z), DM, ALPHA, 0.5f};
            pg8::gemm_phase<pg8::EpiResid, pg8::StaticOrder, true, true>(lds + RING_OFF, g, S, E, tid); SEAM(); }
        if (IN(3)) { PHASE_IDS(); phase_ln((const float*)(ws + WS_Z), KIN(I_LNG) + (size_t)l * 3 * DM, KIN(I_LNB) + (size_t)l * 3 * DM, (float*)(ws + WS_X), (bf16*)(ws + WS_XB), lane, gw, NGW); SEAM(); }
        if (IN(4)) { PHASE_IDS(); pg8::Gemm g{(const bf16*)(ws + WS_XB), (const bf16*)(ws + W_3), M, N3, DM}; pg8::StaticOrder S; S.init(M, N3, G, bx); pg8::EpiP E{(float*)(ws + B_P), (bf16*)(ws + B_U), (float*)(ws + B_GV)};
            pg8::gemm_phase<pg8::EpiP, pg8::StaticOrder, true, true>(lds + RING_OFF, g, S, E, tid); SEAM(); }
        if (IN(5)) { PHASE_IDS(); phase_prep1(l, lane, gw, NGW); SEAM(); }
        if (IN(6)) { PHASE_IDS(); pg8::Gemm g{(const bf16*)(ws + B_A3B), (const bf16*)(ws + W_3B), M, NL, LK}; pg8::StaticOrder S; S.init(M, NL, G, bx);
            pg8::EpiLora E{(float*)(ws + WS_RW)};
            pg8::gemm_phase<pg8::EpiLora, pg8::StaticOrder, false, false>(lds + RING_OFF, g, S, E, tid); SEAM(); }
        if (IN(7)) { PHASE_IDS(); for (int u = bx; u < NUNIT; u += G) scanA_unit(l, lds, u, tid, wave); SEAM(); }
        if (IN(8)) { PHASE_IDS();
            if (bx < 32) { const int task = 2 * bx + (wave >> 2), hh = task >> 2; scanB_chain<256, 8>(l, lds, 0, hh, task & 3, nullptr, KOUT() + O_SP + ((size_t)l * NH + hh) * 4096, tid, wave); }
            else { const float* srw = KIN(I_SRW); float* outp = KOUT();
                for (int p = bx - 32; p < 512; p += G - 32) { const int task = 2 * p + (wave >> 2), b = task >> 6, hh = (task >> 2) & 15; const size_t so = (((size_t)l * NSB + b) * NH + hh) * 4096;
                    scanB_chain<1, 1>(l, lds, 256 + b, hh, task & 3, srw + so, outp + O_SS + so, tid, wave); }
                for (int u = bx - 32; u < 144 * 8; u += G - 32) gmlp_unit(l, lds, u, tid); }
            SEAM(); }
        if (IN(9)) { PHASE_IDS(); for (int u = bx; u < NUNIT; u += G) scanC_unit(l, lds, u, tid, wave); SEAM(); }
        if (IN(10)) { PHASE_IDS(); pg8::Gemm g{(const bf16*)(ws + B_MIX), (const bf16*)(ws + W_4), M, DM, DM}; pg8::StaticOrder S; S.init(M, DM, G, bx); pg8::EpiResid E{(const float*)(ws + WS_X), (float*)(ws + WS_Z), DM, ALPHA, 1.0f};
            pg8::gemm_phase<pg8::EpiResid, pg8::StaticOrder, true, true>(lds + RING_OFF, g, S, E, tid); SEAM(); }
        if (IN(11)) { PHASE_IDS(); phase_ln((const float*)(ws + WS_Z), KIN(I_LNG) + (size_t)(l * 3 + 1) * DM, KIN(I_LNB) + (size_t)(l * 3 + 1) * DM, (float*)(ws + WS_X), (bf16*)(ws + WS_XB), lane, gw, NGW); SEAM(); }
        if (IN(12)) { PHASE_IDS(); pg8::Gemm g{(const bf16*)(ws + WS_XB), (const bf16*)(ws + W_5), M, 2 * FF, DM}; pg8::StaticOrder S; S.init(M, 2 * FF, G, bx); pg8::EpiSwiGLU E{(bf16*)(ws + B_H), FF};
            pg8::gemm_phase<pg8::EpiSwiGLU, pg8::StaticOrder, true, true>(lds + RING_OFF, g, S, E, tid); SEAM(); }
        if (IN(13)) { PHASE_IDS(); pg8::Gemm g{(const bf16*)(ws + B_H), (const bf16*)(ws + W_6), M, DM, FF}; pg8::StaticOrder S; S.init(M, DM, G, bx); pg8::EpiResid E{(const float*)(ws + WS_X), (float*)(ws + WS_Z), DM, ALPHA, 0.5f};
            pg8::gemm_phase<pg8::EpiResid, pg8::StaticOrder, true, true>(lds + RING_OFF, g, S, E, tid); SEAM(); }
        if (IN(14)) { PHASE_IDS(); const bool last = (l == DEPTH - 1);
            phase_ln((const float*)(ws + WS_Z), KIN(I_LNG) + (size_t)(l * 3 + 2) * DM, KIN(I_LNB) + (size_t)(l * 3 + 2) * DM, last ? KOUT() + O_YP : (float*)(ws + WS_X), last ? (bf16*)nullptr : (bf16*)(ws + WS_XB), lane, gw, NGW);
            if (!last) SEAM(); }
    }
#undef IN
#undef SEAM
#undef PHASE_IDS
}

template <int PH> static bool prep_kernel() { return hipFuncSetAttribute((const void*)mk_fwd<PH>, hipFuncAttributeMaxDynamicSharedMemorySize, LDS_BYTES) == hipSuccess; }
template <int PH> static void launch_phase(int grid, hipStream_t stream, Args a) { hipLaunchKernelGGL(mk_fwd<PH>, dim3(grid), dim3(NTHR), LDS_BYTES, stream, a); }
extern "C" void kernel_launch(void* const* d_in, const int* in_sizes, int n_in, void* d_out, int out_size, void* d_ws, size_t ws_size, hipStream_t stream) {
    static int grid = 0;
    if (grid == 0) {
        if (n_in != 29 || (size_t)out_size != O_END || ws_size < WS_END) { fprintf(stderr, "kernel_launch: unexpected shapes: n_in %d out %d ws %zu (need %zu)\n", n_in, out_size, ws_size, (size_t)WS_END); grid = -1; return; }
        int dev = 0, cus = 0, per_cu = 0;
        if (hipGetDevice(&dev) != hipSuccess || hipDeviceGetAttribute(&cus, hipDeviceAttributeMultiprocessorCount, dev) != hipSuccess) { grid = -1; return; }
        bool ok = true;
#if MK_ONE_LAUNCH
        ok = prep_kernel<-1>();
        if (hipOccupancyMaxActiveBlocksPerMultiprocessor(&per_cu, (const void*)mk_fwd<-1>, NTHR, LDS_BYTES) != hipSuccess || per_cu < 1) fprintf(stderr, "kernel_launch: occupancy query says %d\n", per_cu);
#else
        ok = prep_kernel<0>() && prep_kernel<1>() && prep_kernel<2>() && prep_kernel<3>() && prep_kernel<4>() && prep_kernel<5>() && prep_kernel<6>() && prep_kernel<7>() && prep_kernel<8>() && prep_kernel<9>() && prep_kernel<10>() && prep_kernel<11>() && prep_kernel<12>() && prep_kernel<13>() && prep_kernel<14>();
#endif
        if (!ok) { fprintf(stderr, "kernel_launch: hipFuncSetAttribute failed\n"); grid = -1; return; }
        (void)hipGetLastError();
        grid = cus;
        if (grid < 64) { grid = -1; return; }
    }
    if (grid < 0) return;
    (void)hipMemsetAsync((char*)d_ws + WS_CTL, 0, CTL_ZERO_BYTES, stream);
    Args a{};
    for (int i = 0; i < 29; ++i) a.in[i] = (const float*)d_in[i];
    a.out = (float*)d_out; a.ws = (unsigned char*)d_ws;
#if MK_ONE_LAUNCH
    a.l_lo = 0; a.l_hi = DEPTH;
    launch_phase<-1>(grid, stream, a);
#else
    for (int l = 0; l < DEPTH; ++l) { a.l_lo = l; a.l_hi = l + 1;
        launch_phase<0>(grid, stream, a); launch_phase<1>(grid, stream, a); launch_phase<2>(grid, stream, a); launch_phase<3>(grid, stream, a); launch_phase<4>(grid, stream, a);
        launch_phase<5>(grid, stream, a); launch_phase<6>(grid, stream, a); launch_phase<7>(grid, stream, a); launch_phase<8>(grid, stream, a); launch_phase<9>(grid, stream, a);
        launch_phase<10>(grid, stream, a); launch_phase<11>(grid, stream, a); launch_phase<12>(grid, stream, a); launch_phase<13>(grid, stream, a); launch_phase<14>(grid, stream, a); }
#endif
}
```

```cpp
#include <hip/hip_runtime.h>
#include <cstdio>
#include <cstdint>
#define MK_ONE_LAUNCH 1
namespace pg8 {
#define PG8_LAS __attribute__((address_space(3)))
typedef unsigned short bf16_t;
typedef short bf16x8 __attribute__((ext_vector_type(8)));
typedef float f32x4 __attribute__((ext_vector_type(4)));
typedef unsigned u32x4 __attribute__((ext_vector_type(4)));
constexpr int BM = 256, BK = 64, HALF = 128, HTB = HALF * BK * 2  , STAGE_BYTES = 8 * HTB, NXCD = 8, WGM = 8;

__host__ __device__ __forceinline__ int lds_byte(int r, int c) { const int st = (r >> 4) * 2 + (c >> 5), rr = r & 15, cc = c & 31, ob = rr * 64 + cc * 2; return st * 1024 + (ob ^ (((ob >> 9) & 1) << 5)); }
__host__ __device__ __forceinline__ void stage_rc(int b, int& R, int& C) { const int st = b / 1024, sb = b % 1024, swz = sb ^ (((sb >> 9) & 1) << 5); R = (st >> 1) * 16 + swz / 64; C = (st & 1) * 32 + (swz % 64) / 2; }
__host__ __device__ __forceinline__ int perm32(int rho) { const int n = rho >> 4, i = rho & 15; return 8 * (i >> 2) + 4 * n + (i & 3); }

struct Unit { int pm, pn, k0; };
struct Gemm { const bf16_t* A; const bf16_t* Bt; int M, N, K, Kl; };

struct StaticOrder {
    int nM, nN, nwg, G, c;
    __host__ __device__ void init(int M, int N, int G_, int c_) { nM = M / BM; nN = N / BM; nwg = nM * nN; G = G_; c = c_; }
    __host__ __device__ bool next(int i, Unit& u) const {
        const long L = (long)i * G + c; if (L >= nwg) return false;
        int wgid = (int)L; { const int q = nwg / NXCD, r = nwg % NXCD, xcd = wgid % NXCD, off = wgid / NXCD; wgid = (xcd < r ? xcd * (q + 1) : r * (q + 1) + (xcd - r) * q) + off; }
        const int nig = WGM * nN, gid = wgid / nig, fm = gid * WGM, gsz = (nM - fm) < WGM ? (nM - fm) : WGM;
        u.pm = fm + ((wgid % nig) % gsz); u.pn = (wgid % nig) / gsz; u.k0 = 0; return true;
    }
    __device__ __forceinline__ void a_ready(const Unit&) const {}
    __device__ __forceinline__ void done(const Unit&) const {}
};
struct SplitOrder {
    int G, c, KS, Kl;
    __host__ __device__ bool next(int i, Unit& u) const { const int L = i * G + c; if (L >= 16 * KS) return false; const int ks = L >> 4, tile = L & 15; u.pm = 64 + (tile >> 3); u.pn = tile & 7; u.k0 = ks * Kl; return true; }
    __device__ __forceinline__ void a_ready(const Unit&) const {}
    __device__ __forceinline__ void done(const Unit&) const {}
};
__device__ __forceinline__ unsigned cvt_pk_bf16(float lo, float hi) { unsigned r; asm volatile("v_cvt_pk_bf16_f32 %0, %1, %2" : "=v"(r) : "v"(lo), "v"(hi)); return r; }
typedef float f32x2 __attribute__((ext_vector_type(2)));
__device__ __forceinline__ f32x2 gelu_pk(f32x2 v) {
    const f32x2 av = __builtin_elementwise_abs(v), d = av * 0.2316418882f + 1.0f;
    f32x2 t; t.x = __builtin_amdgcn_rcpf(d.x); t.y = __builtin_amdgcn_rcpf(d.y);
    f32x2 q = t * 0.5307027145f + (-0.7265760135f); q = q * t + 0.7107068705f; q = q * t + (-0.142248368f); q = q * t + 0.127414796f; q = q * t;
    const f32x2 s = (v * v) * (-0.72134752044f);
    f32x2 e; e.x = __builtin_amdgcn_exp2f(s.x); e.y = __builtin_amdgcn_exp2f(s.y);
    const f32x2 m = v * (q * e), r = v - m;
    f32x2 o; o.x = v.x < 0.f ? m.x : r.x; o.y = v.y < 0.f ? m.y : r.y; return o;
}

typedef unsigned u32x2 __attribute__((ext_vector_type(2)));
__device__ __forceinline__ float silu_f(float g) { return g * __builtin_amdgcn_rcpf(1.0f + __expf(-g)); }
struct EpiSwiGLU {
    static constexpr bool PERM = true, AFTER_DRAIN = false;
    bf16_t* O; int ldc;
    __device__ __forceinline__ void operator()(const f32x4 (&acc)[2][2][4][2], const Unit& u, int wr, int wc, int fr, int fq) const {
        const int row0 = u.pm * BM + wr * 64 + fr, col0 = u.pn * HALF + wc * 32 + 8 * fq;
#pragma unroll
        for (int ai = 0; ai < 2; ++ai)
#pragma unroll
            for (int m = 0; m < 4; ++m) { bf16_t* rowp = O + (size_t)(row0 + ai * HALF + m * 16) * ldc + col0;
                const f32x4 g0 = acc[ai][0][m][0], g1 = acc[ai][0][m][1], u0 = acc[ai][1][m][0], u1 = acc[ai][1][m][1];
                u32x4 w; w.x = cvt_pk_bf16(silu_f(g0[0]) * u0[0], silu_f(g0[1]) * u0[1]); w.y = cvt_pk_bf16(silu_f(g0[2]) * u0[2], silu_f(g0[3]) * u0[3]);
                w.z = cvt_pk_bf16(silu_f(g1[0]) * u1[0], silu_f(g1[1]) * u1[1]); w.w = cvt_pk_bf16(silu_f(g1[2]) * u1[2], silu_f(g1[3]) * u1[3]);
                *(u32x4*)rowp = w; }
    }
};
struct EpiResid {
    static constexpr bool PERM = false, AFTER_DRAIN = false;
    const float* base; float* out; int ldc; float sa, sb;
    __device__ __forceinline__ void operator()(const f32x4 (&acc)[2][2][4][2], const Unit& u, int wr, int wc, int fr, int fq) const {
        const int row0 = u.pm * BM + wr * 64 + fr, col0 = u.pn * BM + wc * 32 + 4 * fq;
#pragma unroll
        for (int ai = 0; ai < 2; ++ai)
#pragma unroll
            for (int m = 0; m < 4; ++m) { const size_t off = (size_t)(row0 + ai * HALF + m * 16) * ldc + col0;
#pragma unroll
                for (int bj = 0; bj < 2; ++bj)
#pragma unroll
                    for (int n = 0; n < 2; ++n) { const f32x4 b = *(const f32x4*)(base + off + bj * HALF + n * 16); *(f32x4*)(out + off + bj * HALF + n * 16) = b * sa + acc[ai][bj][m][n] * sb; } }
    }
};
struct EpiSlab {
    static constexpr bool PERM = false, AFTER_DRAIN = false;
    float* slab; int Kl;
    __device__ __forceinline__ void operator()(const f32x4 (&acc)[2][2][4][2], const Unit& u, int wr, int wc, int fr, int fq) const {
        const int row0 = (u.pm - 64) * BM + wr * 64 + fr, col0 = u.pn * BM + wc * 32 + 4 * fq; float* O = slab + (size_t)(u.k0 / Kl) * (512 * 2048);
#pragma unroll
        for (int ai = 0; ai < 2; ++ai)
#pragma unroll
            for (int m = 0; m < 4; ++m) { float* rowp = O + (size_t)(row0 + ai * HALF + m * 16) * 2048 + col0;
#pragma unroll
                for (int bj = 0; bj < 2; ++bj)
#pragma unroll
                    for (int n = 0; n < 2; ++n) *(f32x4*)(rowp + bj * HALF + n * 16) = acc[ai][bj][m][n]; }
    }
};
struct EpiP {
    static constexpr bool PERM = false, AFTER_DRAIN = false;
    float* P; bf16_t* U; float* GV;
    __device__ __forceinline__ void operator()(const f32x4 (&acc)[2][2][4][2], const Unit& u, int wr, int wc, int fr, int fq) const {
        const int row0 = u.pm * BM + wr * 64 + fr, cw = wc * 32 + 4 * fq;
        const int kind = u.pn < 14 ? 0 : (u.pn < 18 ? 1 : 2);
        float* F = kind == 0 ? P + u.pn * BM + cw : GV + (u.pn - 18) * BM + cw; const int ldf = kind == 0 ? 3584 : 1024;
        bf16_t* Ub = U + (u.pn - 14) * BM + cw;
#pragma unroll
        for (int ai = 0; ai < 2; ++ai)
#pragma unroll
            for (int m = 0; m < 4; ++m) { const size_t row = (size_t)(row0 + ai * HALF + m * 16);
#pragma unroll
                for (int bj = 0; bj < 2; ++bj)
#pragma unroll
                    for (int n = 0; n < 2; ++n) { f32x4 v = acc[ai][bj][m][n];
                        if (kind != 0) { const f32x2 a = gelu_pk((f32x2){v[0], v[1]}), b = gelu_pk((f32x2){v[2], v[3]}); v = (f32x4){a.x, a.y, b.x, b.y}; }
                        if (kind == 1) { u32x2 w; w.x = cvt_pk_bf16(v[0], v[1]); w.y = cvt_pk_bf16(v[2], v[3]); *(u32x2*)(Ub + row * 1024 + bj * HALF + n * 16) = w; }
                        else *(f32x4*)(F + row * ldf + bj * HALF + n * 16) = v; }
                asm volatile("" ::: "memory"); }
    }
};
struct EpiLora {
    static constexpr bool PERM = false, AFTER_DRAIN = false;
    float* base;
    __device__ __forceinline__ void operator()(const f32x4 (&acc)[2][2][4][2], const Unit& u, int wr, int wc, int fr, int fq) const {
        const int row0 = u.pm * BM + wr * 64 + fr, kind = u.pn >> 2, cb = (u.pn & 3) * BM + wc * 32 + 4 * fq;
        float* O = base + (size_t)kind * ((size_t)66 << 18) + cb;
#pragma unroll
        for (int ai = 0; ai < 2; ++ai)
#pragma unroll
            for (int m = 0; m < 4; ++m) { float* rowp = O + (size_t)(row0 + ai * HALF + m * 16) * 1024;
#pragma unroll
                for (int bj = 0; bj < 2; ++bj)
#pragma unroll
                    for (int n = 0; n < 2; ++n) *(f32x4*)(rowp + bj * HALF + n * 16) = acc[ai][bj][m][n]; }
    }
};
template <class Epi, class Sched, bool ALIGN_EPI = false, bool SP2 = false>
__device__ __forceinline__ void gemm_phase(PG8_LAS unsigned char* lds, const Gemm g, const Sched& S, const Epi& E, int tid_in) {
    int tid_ = tid_in; asm volatile("" : "+v"(tid_));
    const int tid = tid_, wid = __builtin_amdgcn_readfirstlane(tid >> 6), lane = tid & 63, wr = wid >> 2, wc = wid & 3, fr = lane & 15, fq = lane >> 4;
    const int K = g.K, nt = g.Kl / BK;
    unsigned voffA[2], voffB[2];
#pragma unroll
    for (int i = 0; i < 2; ++i) { int R, C; stage_rc(tid * 16 + i * 8192, R, C); const int Rb = Epi::PERM ? ((R & ~31) + perm32(R & 31)) : R;
        voffA[i] = (unsigned)(R * K + C) * 2u; voffB[i] = (unsigned)(Rb * K + C) * 2u; }
    const size_t kstep = (size_t)(BK * 2);
    const size_t hstep = (size_t)HALF * K * 2;
    const size_t tstep = 2 * hstep;
    const unsigned ldsw = (unsigned)wid * 1024u;
    const int aoff = lds_byte(wr * 64 + fr, fq * 8), boff = lds_byte(wc * 32 + fr, fq * 8);
#define PG8_SA(b, h) (((b) * 2 + (h)) * HTB)
#define PG8_SB(b, h) ((4 + (b) * 2 + (h)) * HTB)
#define PG8_STAGE(bufoff, gbase, voff) do { _Pragma("unroll") for (int _i = 0; _i < 2; ++_i) \
        __builtin_amdgcn_global_load_lds((const unsigned*)((const char*)(gbase) + (voff)[_i]), (PG8_LAS unsigned*)(lds + (bufoff) + ldsw + _i * 8192), 16, 0, 0); } while (0)
#define PG8_LDA(dst, b, h) do { _Pragma("unroll") for (int m = 0; m < 4; ++m) _Pragma("unroll") for (int k = 0; k < 2; ++k) dst[m][k] = *(const PG8_LAS bf16x8*)(lds + PG8_SA(b, h) + aoff + m * 2048 + k * 1024); } while (0)
#define PG8_LDB(dst, b, h) do { _Pragma("unroll") for (int n = 0; n < 2; ++n) _Pragma("unroll") for (int k = 0; k < 2; ++k) dst[n][k] = *(const PG8_LAS bf16x8*)(lds + PG8_SB(b, h) + boff + n * 2048 + k * 1024); } while (0)
#define PG8_MMA(ai, bj, At, Bt) do { __builtin_amdgcn_s_setprio(1); _Pragma("unroll") for (int m = 0; m < 4; ++m) _Pragma("unroll") for (int n = 0; n < 2; ++n) _Pragma("unroll") for (int k = 0; k < 2; ++k) \
        acc[ai][bj][m][n] = __builtin_amdgcn_mfma_f32_16x16x32_bf16(Bt[n][k], At[m][k], acc[ai][bj][m][n], 0, 0, 0); __builtin_amdgcn_s_setprio(0); } while (0)
#define PG8_WAIT_V(n) asm volatile("s_waitcnt vmcnt(" #n ")" ::: "memory")
#define PG8_WAIT_L(n) asm volatile("s_waitcnt lgkmcnt(" #n ")" ::: "memory")
#define PG8_BAR __builtin_amdgcn_s_barrier()
#define PG8_SCHED __builtin_amdgcn_sched_barrier(0)
    Unit cur, nxt; int ui = 0;
    if (!S.next(0, cur)) return;
    f32x4 acc[2][2][4][2];
    float zz0; asm volatile("v_mov_b32 %0, 0" : "=v"(zz0));
#pragma unroll
    for (int a = 0; a < 2; ++a)
#pragma unroll
        for (int b = 0; b < 2; ++b)
#pragma unroll
            for (int m = 0; m < 4; ++m)
#pragma unroll
                for (int n = 0; n < 2; ++n) acc[a][b][m][n] = (f32x4){zz0, zz0, zz0, zz0};
    bf16x8 At[4][2], B0[2][2], B1[2][2];
    const char* cA = (const char*)g.A + (size_t)cur.pm * tstep + (size_t)cur.k0 * 2; const char* cB = (const char*)g.Bt + (size_t)cur.pn * tstep + (size_t)cur.k0 * 2;
    S.a_ready(cur);
    if constexpr (SP2) {
        PG8_STAGE(PG8_SB(0, 0), cB, voffB); PG8_STAGE(PG8_SB(0, 1), cB + hstep, voffB); PG8_STAGE(PG8_SA(0, 0), cA, voffA); PG8_STAGE(PG8_SA(0, 1), cA + hstep, voffA);
        if (wr == 1) PG8_BAR;
        PG8_WAIT_V(2); PG8_BAR;
        PG8_STAGE(PG8_SB(1, 0), cB + kstep, voffB); PG8_STAGE(PG8_SA(1, 0), cA + kstep, voffA); PG8_STAGE(PG8_SB(1, 1), cB + hstep + kstep, voffB);
        PG8_WAIT_V(6); PG8_BAR;
    } else {
        PG8_STAGE(PG8_SB(0, 0), cB, voffB); PG8_STAGE(PG8_SA(0, 0), cA, voffA); PG8_STAGE(PG8_SB(0, 1), cB + hstep, voffB); PG8_STAGE(PG8_SA(0, 1), cA + hstep, voffA);
        if (wr == 1) PG8_BAR;
        PG8_WAIT_V(4); PG8_BAR;
        PG8_STAGE(PG8_SB(1, 0), cB + kstep, voffB); PG8_STAGE(PG8_SA(1, 0), cA + kstep, voffA); PG8_STAGE(PG8_SB(1, 1), cB + hstep + kstep, voffB);
        PG8_WAIT_V(6); PG8_BAR;
    }
    for (;;) {
        const bool has_next = S.next(ui + 1, nxt);
        const char* nA = has_next ? (const char*)g.A + (size_t)nxt.pm * tstep + (size_t)nxt.k0 * 2 : cA; const char* nB = has_next ? (const char*)g.Bt + (size_t)nxt.pn * tstep + (size_t)nxt.k0 * 2 : cB;
        for (int t = 0; t < nt; t += 2) {
            const bool last = (t == nt - 2);
            const char* a1 = cA + (size_t)(t + 1) * kstep;
            const char* a2 = last ? nA : cA + (size_t)(t + 2) * kstep; const char* b2 = last ? nB : cB + (size_t)(t + 2) * kstep;
            const char* a3 = a2 + kstep; const char* b3 = b2 + kstep;
            if (last && has_next) S.a_ready(nxt);
            if constexpr (SP2) {
            PG8_LDB(B0, 0, 0); PG8_LDB(B1, 0, 1); PG8_SCHED; PG8_LDA(At, 0, 0); PG8_STAGE(PG8_SA(1, 1), a1 + hstep, voffA);
            PG8_WAIT_V(8); PG8_WAIT_L(0); PG8_BAR; PG8_MMA(0, 0, At, B0); PG8_MMA(0, 1, At, B1); PG8_BAR; PG8_SCHED;
            PG8_LDA(At, 0, 1); PG8_STAGE(PG8_SB(0, 0), b2, voffB); PG8_STAGE(PG8_SB(0, 1), b2 + hstep, voffB); PG8_STAGE(PG8_SA(0, 0), a2, voffA);
            PG8_WAIT_V(8); PG8_WAIT_L(0); PG8_BAR; PG8_MMA(1, 0, At, B0); PG8_MMA(1, 1, At, B1); PG8_BAR; PG8_SCHED;
            PG8_LDB(B0, 1, 0); PG8_LDB(B1, 1, 1); PG8_SCHED; PG8_LDA(At, 1, 0); PG8_STAGE(PG8_SA(0, 1), a2 + hstep, voffA);
            PG8_WAIT_V(8); PG8_WAIT_L(0); PG8_BAR; PG8_MMA(0, 0, At, B0); PG8_MMA(0, 1, At, B1); PG8_BAR; PG8_SCHED;
            PG8_LDA(At, 1, 1); PG8_STAGE(PG8_SB(1, 0), b3, voffB); PG8_STAGE(PG8_SB(1, 1), b3 + hstep, voffB); PG8_STAGE(PG8_SA(1, 0), a3, voffA);
            PG8_WAIT_V(8); PG8_WAIT_L(0); PG8_BAR; PG8_MMA(1, 0, At, B0); PG8_MMA(1, 1, At, B1); PG8_BAR; PG8_SCHED;
            } else {
            PG8_LDB(B0, 0, 0); PG8_SCHED; PG8_LDA(At, 0, 0); PG8_STAGE(PG8_SA(1, 1), a1 + hstep, voffA);
            PG8_WAIT_L(8); PG8_BAR; PG8_WAIT_L(0); PG8_MMA(0, 0, At, B0); PG8_BAR; PG8_SCHED;
            PG8_LDB(B1, 0, 1); PG8_STAGE(PG8_SB(0, 0), b2, voffB);
            PG8_BAR; PG8_WAIT_L(0); PG8_MMA(0, 1, At, B1); PG8_BAR;
            PG8_LDA(At, 0, 1); PG8_STAGE(PG8_SA(0, 0), a2, voffA);
            PG8_BAR; PG8_WAIT_L(0); PG8_MMA(1, 0, At, B0); PG8_BAR; PG8_SCHED;
            PG8_STAGE(PG8_SB(0, 1), b2 + hstep, voffB);
            PG8_WAIT_V(6); PG8_BAR; PG8_MMA(1, 1, At, B1); PG8_BAR;
            PG8_LDB(B0, 1, 0); PG8_SCHED; PG8_LDA(At, 1, 0); PG8_STAGE(PG8_SA(0, 1), a2 + hstep, voffA);
            PG8_WAIT_L(8); PG8_BAR; PG8_WAIT_L(0); PG8_MMA(0, 0, At, B0); PG8_BAR; PG8_SCHED;
            PG8_LDB(B1, 1, 1); PG8_STAGE(PG8_SB(1, 0), b3, voffB);
            PG8_BAR; PG8_WAIT_L(0); PG8_MMA(0, 1, At, B1); PG8_BAR;
            PG8_LDA(At, 1, 1); PG8_STAGE(PG8_SA(1, 0), a3, voffA);
            PG8_BAR; PG8_WAIT_L(0); PG8_MMA(1, 0, At, B0); PG8_BAR; PG8_SCHED;
            PG8_STAGE(PG8_SB(1, 1), b3 + hstep, voffB);
            PG8_WAIT_V(6); PG8_BAR; PG8_MMA(1, 1, At, B1); PG8_BAR;
            }
        }
        if constexpr (ALIGN_EPI) { if (wr == 0) PG8_BAR; }
        if constexpr (!Epi::AFTER_DRAIN) { E(acc, cur, wr, wc, fr, fq); S.done(cur); }
        if (!has_next) break;
{ float zz1; asm volatile("v_mov_b32 %0, 0" : "=v"(zz1));
#pragma unroll
        for (int a = 0; a < 2; ++a)
#pragma unroll
            for (int b = 0; b < 2; ++b)
#pragma unroll
                for (int m = 0; m < 4; ++m)
#pragma unroll
                    for (int n = 0; n < 2; ++n) acc[a][b][m][n] = (f32x4){zz1, zz1, zz1, zz1}; }
        cur = nxt; cA = nA; cB = nB; ++ui;
        if constexpr (ALIGN_EPI) { if (wr == 1) PG8_BAR; }
    }
    PG8_WAIT_V(0);
    if constexpr (!ALIGN_EPI) { if (wr == 0) PG8_BAR; }
    PG8_BAR;
    if constexpr (Epi::AFTER_DRAIN) { E.fused(acc, cur, wr, wc, fr, fq, lds, wid, lane); S.done(cur); }
#undef PG8_SA
#undef PG8_SB
#undef PG8_STAGE
#undef PG8_LDA
#undef PG8_LDB
#undef PG8_MMA
#undef PG8_WAIT_V
#undef PG8_WAIT_L
#undef PG8_BAR
#undef PG8_SCHED
}
}
#define GAS __attribute__((address_space(1)))
#define LAS __attribute__((address_space(3)))
typedef unsigned short bf16;
typedef unsigned v4u __attribute__((ext_vector_type(4)));
typedef float f32x4 __attribute__((ext_vector_type(4)));
typedef short bf16x8 __attribute__((ext_vector_type(8)));
typedef GAS unsigned gu32;
typedef GAS unsigned long long gu64;
#define RLX_AGENT __ATOMIC_RELAXED, __HIP_MEMORY_SCOPE_AGENT
#define LDS_WAIT() asm volatile("s_waitcnt lgkmcnt(0)" ::: "memory")
#define VM_WAIT() asm volatile("s_waitcnt vmcnt(0)" ::: "memory")
__device__ __forceinline__ unsigned long long rt() { return __builtin_amdgcn_s_memrealtime(); }
__device__ __forceinline__ unsigned f2bf(float f) { unsigned u = __builtin_bit_cast(unsigned, f); return (u + 0x7fffu + ((u >> 16) & 1u)) >> 16; }
__device__ __forceinline__ unsigned pk2(float lo, float hi) { return f2bf(lo) | (f2bf(hi) << 16); }
#define XB_TMO      128
#define XB_XCNT(j)  (256  + 64 * (j))
#define XB_XSUB(j)  (1280 + 64 * (j))
#define XB_XGEN(j)  (2304 + 64 * (j))
#define XB_TOP      3328
#define XB_TOPGEN   3392
#define XCD_BAR_WORDS 3456
#define XB_SPIN_CAP (1u << 18)

__device__ __forceinline__ unsigned xb_ld(unsigned* p)              { return __hip_atomic_load(p, __ATOMIC_RELAXED, __HIP_MEMORY_SCOPE_AGENT); }
__device__ __forceinline__ unsigned xb_add(unsigned* p, unsigned v) { return __hip_atomic_fetch_add(p, v, __ATOMIC_RELAXED, __HIP_MEMORY_SCOPE_AGENT); }
__device__ __forceinline__ unsigned xb_xcc_id() { return (unsigned)__builtin_amdgcn_s_getreg((3 << 11) | 20) & 0xFu; }
#define XB_SPIN(cond, bar) do { unsigned _sp = 0; while (cond) { __builtin_amdgcn_s_sleep(1); \
    if ((++_sp & 255u) == 0u) { if (xb_ld(&(bar)[XB_TMO])) break; if (_sp > XB_SPIN_CAP) { atomicAdd(&(bar)[XB_TMO], 1u); break; } } } } while (0)

struct XcdBarrier {
    unsigned* bar; unsigned x;
    volatile LAS unsigned* st;
};

__device__ __forceinline__ XcdBarrier xcd_barrier_post(unsigned* bar, volatile LAS unsigned* st, int tid) {
    XcdBarrier b; b.bar = bar; b.x = xb_xcc_id(); b.st = st;
    if (tid == 0) (void)xb_add(&bar[XB_XCNT(b.x)], 1u);
    return b;
}
__device__ __forceinline__ void xcd_barrier_complete(unsigned* bar, unsigned x, unsigned& nloc, unsigned& nx) {
    const unsigned G = gridDim.x * gridDim.y * gridDim.z;
    unsigned sum, cnt, mine, sp = 0u;
    for (;;) {
        sum = 0u; cnt = 0u; mine = 0u;
#pragma unroll
        for (unsigned j = 0; j < 16; ++j) { const unsigned c = xb_ld(&bar[XB_XCNT(j)]); sum += c; cnt += (c > 0u) ? 1u : 0u; mine = (j == x) ? c : mine; }
        if (sum == G) break;
        __builtin_amdgcn_s_sleep(1);
        if ((++sp & 255u) == 0u) { if (xb_ld(&bar[XB_TMO])) break; if (sp > XB_SPIN_CAP) { atomicAdd(&bar[XB_TMO], 1u); break; } }
    }
    nloc = mine > 0u ? mine : 1u; nx = cnt > 0u ? cnt : 1u;
}

__device__ __forceinline__ void xcd_barrier(const XcdBarrier& b, int tid) {
    asm volatile("s_waitcnt vmcnt(0)" ::: "memory");
    __syncthreads();
    if (tid == 0) {
        unsigned* bar = b.bar;
        __builtin_amdgcn_s_waitcnt(0);
        unsigned nloc = b.st[0], nx = b.st[1];
        if (nloc == 0u) { xcd_barrier_complete(bar, b.x, nloc, nx); b.st[0] = nloc; b.st[1] = nx; }
        const unsigned old = xb_add(&bar[XB_XSUB(b.x)], 1u);
        const unsigned gen = old / nloc;
        if (old + 1u == (gen + 1u) * nloc) {
            __builtin_amdgcn_fence(__ATOMIC_RELEASE, "agent");
            asm volatile("s_waitcnt vmcnt(0)" ::: "memory");
            const unsigned og = xb_add(&bar[XB_TOP], 1u);
            const unsigned tg = og / nx;
            if (og + 1u == (tg + 1u) * nx) xb_add(&bar[XB_TOPGEN], 1u);
            else XB_SPIN(xb_ld(&bar[XB_TOPGEN]) == tg, bar);
            __builtin_amdgcn_fence(__ATOMIC_ACQUIRE, "agent");
            xb_add(&bar[XB_XGEN(b.x)], 1u);
            asm volatile("s_waitcnt vmcnt(0)" ::: "memory");
        } else {
            XB_SPIN(xb_ld(&bar[XB_XGEN(b.x)]) == gen, bar);
            __builtin_amdgcn_fence(__ATOMIC_ACQUIRE, "agent");
            asm volatile("s_waitcnt vmcnt(0)" ::: "memory");
        }
    }
    __syncthreads();
}

constexpr int NWAVES = 8, NTHR = 512;
constexpr int DM = 2048, FF = 5632, DEPTH = 4;
constexpr int TP = 16384, NSB = 16, TS = 32, M = TP + NSB * TS;
constexpr int RW = 1024, NH = 16, HN = 64, GMW = 1024, GH = 8, GHD = 128;
constexpr int C_W = 3072, C_A = 3136, C_G = 3200, SHIFT = 3360, INC = 5408;
constexpr int PLD = 3584;
constexpr int N3 = 5632;
constexpr int LK = 384;
constexpr int NL = 3072;
constexpr float ALPHA = 1.6817928305074292f;
constexpr float LN_EPS = 1e-5f, GN_EPS = 64e-5f;
constexpr int NPHASE = 15;

constexpr size_t O_YP = 0, O_SP = 34603008, O_SHP = 34865152, O_SS = 34878592, O_SHS = 39072896, O_GV = 39287936, O_END = 41385088;

constexpr size_t MiB = 1u << 20;
constexpr size_t WS_CTL = 0, CTL_ZERO_BYTES = 1 * MiB;
constexpr size_t WS_X = 1 * MiB;
constexpr size_t WS_Z = 133 * MiB;
constexpr size_t WS_XB = 265 * MiB;
constexpr size_t WS_W = 331 * MiB;
constexpr size_t W_1 = WS_W, W_2 = W_1 + 44 * MiB, W_3 = W_2 + 22 * MiB, W_4 = W_3 + 22 * MiB, W_5 = W_4 + 8 * MiB, W_6 = W_5 + 44 * MiB, W_3B = W_6 + 22 * MiB;
constexpr size_t WS_BIG = 496 * MiB;
constexpr size_t B_H = WS_BIG, B_P = WS_BIG, B_U = WS_BIG + 231 * MiB, B_GV = B_U + 33 * MiB, B_A3B = B_GV + 66 * MiB;
constexpr size_t B_MIX = WS_XB;
constexpr size_t WS_RW = 839 * MiB;
constexpr size_t RWSZ = 66 * MiB;
constexpr size_t WS_END = WS_RW + 8 * RWSZ;
static_assert(W_3B + (size_t)NL * LK * 2 <= WS_BIG && B_A3B + (size_t)M * LK * 2 <= WS_RW, "ws map");
static_assert((size_t)M * DM * 4 == 132 * MiB && (size_t)M * PLD * 4 == 231 * MiB && (size_t)M * 1024 * 4 == 66 * MiB, "ws sizes");
constexpr int CW_TMO = 0, CW_CODE = 1, CW_BAR = 4096;

constexpr int RING_OFF = 0, RING_BYTES = 135168;
constexpr int LDSCTL_OFF = RING_BYTES, MISC_OFF = LDSCTL_OFF + 320;
constexpr int LDS_BYTES = 147456;

struct Args { const float* in[29]; float* out; unsigned char* ws; int l_lo, l_hi; };
#define KOUT() ((float*)karg_ptr<232>())
#define KWS() ((unsigned char*)karg_ptr<240>())
enum InIdx { I_XP = 0, I_XS, I_SRW, I_SSH, I_F1G, I_F1U, I_F1D, I_WIN, I_MU, I_W0, I_WUP, I_A0, I_AUP, I_GUP, I_KK, I_KA, I_RK, I_GNG, I_GNB, I_GLG, I_GLB, I_GWS, I_GBS, I_WOUT, I_F2G, I_F2U, I_F2D, I_LNG, I_LNB };


template <int OFF> __device__ __forceinline__ const float* karg_ptr() {
    const unsigned long long kp = (unsigned long long)__builtin_amdgcn_kernarg_segment_ptr(); unsigned long long v;
    asm volatile("s_load_dwordx2 %0, %1, %2\n\ts_waitcnt lgkmcnt(0)" : "=s"(v) : "s"(kp), "i"(OFF) : "memory");
    return (const float*)v;
}
#define KIN(i) karg_ptr<8 * (i)>()
template <int CTRL> __device__ __forceinline__ float dpp_mov(float x) { return __builtin_bit_cast(float, __builtin_amdgcn_mov_dpp(__builtin_bit_cast(int, x), CTRL, 0xf, 0xf, true)); }
__device__ __forceinline__ float row16_sum(float x) { x += dpp_mov<0x128>(x); x += dpp_mov<0x124>(x); x += dpp_mov<0x122>(x); x += dpp_mov<0x121>(x); return x; }
__device__ __forceinline__ float wave_sum(float v) {
    v = row16_sum(v); const int i = __builtin_bit_cast(int, v);
    const float a = __builtin_bit_cast(float, __builtin_amdgcn_readlane(i, 0)), b = __builtin_bit_cast(float, __builtin_amdgcn_readlane(i, 16)), c = __builtin_bit_cast(float, __builtin_amdgcn_readlane(i, 32)), d = __builtin_bit_cast(float, __builtin_amdgcn_readlane(i, 48));
    return (a + b) + (c + d);
}

template <int MAP> __device__ __forceinline__ void cvt_task(const float* __restrict__ W, int K, int N, bf16* __restrict__ WT, int nb, int k0, int lane) {
    const int n = nb * 256 + 4 * lane; if (n >= N) return;
    const int drow = MAP == 0 ? n : (MAP == 3 ? (n < SHIFT ? n : n + (PLD - SHIFT)) : 256 * (n >> 7) + (n & 127) + (MAP == 2 ? 128 : 0));
    const float* src = W + (size_t)k0 * N + n; bf16* dst = WT + (size_t)drow * K + k0;
#pragma unroll
    for (int kk = 0; kk < 32; kk += 16) { f32x4 v[16];
#pragma unroll
        for (int j = 0; j < 16; ++j) v[j] = *(const f32x4*)(src + (size_t)(kk + j) * N);
#pragma unroll
        for (int i = 0; i < 4; ++i)
#pragma unroll
            for (int hh = 0; hh < 2; ++hh) { v4u o; o.x = pk2(v[8 * hh + 0][i], v[8 * hh + 1][i]); o.y = pk2(v[8 * hh + 2][i], v[8 * hh + 3][i]); o.z = pk2(v[8 * hh + 4][i], v[8 * hh + 5][i]); o.w = pk2(v[8 * hh + 6][i], v[8 * hh + 7][i]);
                *(v4u*)(dst + (size_t)i * K + kk + 8 * hh) = o; } }
}

__device__ __forceinline__ void phase_convert(int l, LAS unsigned char* lds, int wave, int lane, int gw, int NGW) {
    unsigned char* ws = KWS();
    const size_t so = (size_t)l * DM * FF;
    const float *f1g = KIN(I_F1G) + so, *f1u = KIN(I_F1U) + so, *f1d = KIN(I_F1D) + so, *f2g = KIN(I_F2G) + so, *f2u = KIN(I_F2U) + so, *f2d = KIN(I_F2D) + so;
    const float* win = KIN(I_WIN) + (size_t)l * DM * INC; const float* wout = KIN(I_WOUT) + (size_t)l * DM * DM;
    constexpr int T_GU = (FF / 256) * (DM / 32);
    constexpr int T_D = (DM / 256) * (FF / 32);
    constexpr int T_IN = ((INC + 255) / 256) * (DM / 32);
    constexpr int T_O = (DM / 256) * (DM / 32);
    constexpr int NTASK = 4 * T_GU + 2 * T_D + T_IN + T_O;
    for (int it = gw; it < NTASK; it += NGW) {
        int r = it;
        if (r < 4 * T_GU) { const int which = r / T_GU; r -= which * T_GU; const int nb = r % (FF / 256), kb = r / (FF / 256);
            const float* W = which == 0 ? f1g : (which == 1 ? f1u : (which == 2 ? f2g : f2u)); bf16* WT = (bf16*)(ws + (which < 2 ? W_1 : W_5));
            if (which & 1) cvt_task<2>(W, DM, FF, WT, nb, 32 * kb, lane); else cvt_task<1>(W, DM, FF, WT, nb, 32 * kb, lane); continue; }
        r -= 4 * T_GU;
        if (r < 2 * T_D) { const int which = r / T_D; r -= which * T_D; const int nb = r % (DM / 256), kb = r / (DM / 256);
            cvt_task<0>(which == 0 ? f1d : f2d, FF, DM, (bf16*)(ws + (which == 0 ? W_2 : W_6)), nb, 32 * kb, lane); continue; }
        r -= 2 * T_D;
        if (r < T_IN) { const int nb = r % ((INC + 255) / 256), kb = r / ((INC + 255) / 256); cvt_task<3>(win, DM, INC, (bf16*)(ws + W_3), nb, 32 * kb, lane); continue; }
        r -= T_IN;
        { const int nb = r % (DM / 256), kb = r / (DM / 256); cvt_task<0>(wout, DM, DM, (bf16*)(ws + W_4), nb, 32 * kb, lane); }
    }
    { v4u* z = (v4u*)(ws + W_3 + (size_t)SHIFT * DM * 2); const int nz = (PLD - SHIFT) * DM * 2 / 16;
      unsigned z0; asm volatile("v_mov_b32 %0, 0" : "=v"(z0));
      for (int i = gw * 64 + lane; i < nz; i += NGW * 64) z[i] = (v4u){z0, z0, z0, z0}; }
    { bf16* WT = (bf16*)(ws + W_3B); const float* wup = KIN(I_WUP) + (size_t)l * 64 * RW; const float* aup = KIN(I_AUP) + (size_t)l * 64 * RW; const float* gup = KIN(I_GUP) + (size_t)l * 160 * RW;
      for (int i = gw * 64 + lane; i < NL * LK; i += NGW * 64) { const int n = i / LK, k = i % LK, kind = n >> 10, c = n & 1023; float v = 0.f;
          if (kind == 0) { if (k < 64) v = wup[(size_t)k * RW + c]; } else if (kind == 1) { if (k >= 64 && k < 128) v = aup[(size_t)(k - 64) * RW + c]; } else { if (k >= 128 && k < 288) v = gup[(size_t)(k - 128) * RW + c]; }
          WT[i] = (bf16)f2bf(v); } }
    if (l == 0) {
        float* X = (float*)(ws + WS_X); bf16* XB = (bf16*)(ws + WS_XB); const float* xp = KIN(I_XP); const float* xs = KIN(I_XS);
        for (int m = gw; m < M; m += NGW) { const float* src = m < TP ? xp + (size_t)m * DM : xs + (size_t)(m - TP) * DM;
            const f32x4* s4 = (const f32x4*)src + lane; f32x4* d4 = (f32x4*)(X + (size_t)m * DM) + lane; unsigned long long* o8 = (unsigned long long*)(XB + (size_t)m * DM) + lane;
#pragma unroll
            for (int j = 0; j < 8; ++j) { const f32x4 v = s4[64 * j]; d4[64 * j] = v; o8[64 * j] = (unsigned long long)pk2(v.x, v.y) | ((unsigned long long)pk2(v.z, v.w) << 32); } }
    }
}

__device__ __forceinline__ void phase_ln(const float* Z, const float* Xres, const float* slab, int KS, float sa, float sb, const float* g, const float* b, float* Xo, bf16* XBo, int lane, int gw, int NGW) {
    for (int m = gw; m < M; m += NGW) {
        f32x4 v[8]; float s = 0.f;
        if (m < TP) { const f32x4* zr = (const f32x4*)(Z + (size_t)m * DM) + lane;
#pragma unroll
            for (int j = 0; j < 8; ++j) v[j] = zr[64 * j];
        } else { const f32x4* xr = (const f32x4*)(Xres + (size_t)m * DM) + lane; f32x4 a[8];
#pragma unroll
            for (int j = 0; j < 8; ++j) { v[j] = xr[64 * j]; a[j] = (f32x4){0.f, 0.f, 0.f, 0.f}; }
            for (int ks = 0; ks < KS; ++ks) { const f32x4* sr = (const f32x4*)(slab + ((size_t)ks * 512 + (m - TP)) * DM) + lane;
#pragma unroll
                for (int j = 0; j < 8; ++j) a[j] = a[j] + sr[64 * j]; }
#pragma unroll
            for (int j = 0; j < 8; ++j) v[j] = v[j] * sa + a[j] * sb; }
#pragma unroll
        for (int j = 0; j < 8; ++j) s += (v[j].x + v[j].y) + (v[j].z + v[j].w);
        const float mean = wave_sum(s) * (1.f / DM); float s2 = 0.f;
#pragma unroll
        for (int j = 0; j < 8; ++j) { v[j] = v[j] - mean; s2 += (v[j].x * v[j].x + v[j].y * v[j].y) + (v[j].z * v[j].z + v[j].w * v[j].w); }
        const float rstd = 1.f / sqrtf(wave_sum(s2) * (1.f / DM) + LN_EPS);
        f32x4* xo = (f32x4*)(Xo + (size_t)m * DM) + lane;
#pragma unroll
        for (int j = 0; j < 8; ++j) { const f32x4 gg = ((const f32x4*)g)[lane + 64 * j], bb = ((const f32x4*)b)[lane + 64 * j]; const f32x4 o = v[j] * rstd * gg + bb; xo[64 * j] = o;
            if (XBo) ((unsigned long long*)(XBo + (size_t)m * DM) + lane)[64 * j] = (unsigned long long)pk2(o.x, o.y) | ((unsigned long long)pk2(o.z, o.w) << 32); }
    }
}

__device__ __forceinline__ const float* prev_row(const float* ssh, int l, const float* P, int m) {
    if (m < TP) return m == 0 ? nullptr : P + (size_t)(m - 1) * PLD;
    const int b = (m - TP) >> 5, t = (m - TP) & 31;
    return t == 0 ? ssh + (size_t)(l * NSB + b) * SHIFT : P + (size_t)(m - 1) * PLD;
}

__device__ __forceinline__ void phase_prep1(int l, int lane, int gw, int NGW) {
    unsigned char* ws = KWS(); float* outp = KOUT(); const float* P = (const float*)(ws + B_P); float* GV = (float*)(ws + B_GV); bf16* A3B = (bf16*)(ws + B_A3B);
    const float* mu = KIN(I_MU) + (size_t)l * SHIFT; const float* lg = KIN(I_GLG) + (size_t)l * GMW; const float* lb = KIN(I_GLB) + (size_t)l * GMW;
    const float* ssh = KIN(I_SSH);
    for (int m = gw; m < M; m += NGW) {
        const float* pr = P + (size_t)m * PLD; const float* pp = prev_row(ssh, l, P, m);
#pragma unroll
        for (int jj = 0; jj < 6; ++jj) { const int j = jj * 64 + lane; float v = 0.f;
            if (j < 288) { const int c = C_W + j; const float p = pr[c], q = pp ? pp[c] : 0.f; const float xs = p + (q - p) * mu[c];
                if (j < 64) { const float t = __expf(-2.f * fabsf(xs)); const float r = (1.f - t) / (1.f + t); v = xs < 0.f ? -r : r; }
                else if (j < 128) v = xs;
                else v = 1.f / (1.f + __expf(-xs)); }
            A3B[(size_t)m * LK + j] = (bf16)f2bf(v); }
        { f32x4* vr = (f32x4*)(GV + (size_t)m * GMW) + lane; f32x4 v[4]; float s = 0.f;
#pragma unroll
          for (int j = 0; j < 4; ++j) { v[j] = vr[64 * j]; s += (v[j].x + v[j].y) + (v[j].z + v[j].w); }
          const float mean = wave_sum(s) * (1.f / GMW); float s2 = 0.f;
#pragma unroll
          for (int j = 0; j < 4; ++j) { v[j] = v[j] - mean; s2 += (v[j].x * v[j].x + v[j].y * v[j].y) + (v[j].z * v[j].z + v[j].w * v[j].w); }
          const float rstd = 1.f / sqrtf(wave_sum(s2) * (1.f / GMW) + LN_EPS);
          f32x4* go = nullptr; if (m >= TP) go = (f32x4*)(outp + O_GV + ((size_t)l * NSB * TS + (m - TP)) * GMW) + lane;
#pragma unroll
          for (int j = 0; j < 4; ++j) { const f32x4 o = v[j] * rstd * ((const f32x4*)lg)[lane + 64 * j] + ((const f32x4*)lb)[lane + 64 * j]; vr[64 * j] = o; if (go) go[64 * j] = o; } }
        if (m == TP - 1) { float* o = outp + O_SHP + (size_t)l * SHIFT; for (int c = lane; c < SHIFT; c += 64) o[c] = pr[c]; }
        if (m >= TP && ((m - TP) & 31) == 31) { float* o = outp + O_SHS + (size_t)(l * NSB + ((m - TP) >> 5)) * SHIFT; for (int c = lane; c < SHIFT; c += 64) o[c] = pr[c]; }
    }
}

__device__ __forceinline__ void gmlp_unit(int l, LAS unsigned char* lds, int unit, int tid) {
    unsigned char* ws = KWS(); const float* VN = (const float*)(ws + B_GV); const bf16* U = (const bf16*)(ws + B_U); bf16* MIXB = (bf16*)(ws + B_MIX);
    const int ci = unit >> 3, h = unit & 7; int row0, nr; if (ci < 128) { row0 = 128 * ci; nr = 128; } else { row0 = TP + 32 * (ci - 128); nr = 32; }
    const float* wsm = KIN(I_GWS) + ((size_t)l * GH + h) * 128 * 128; const float* bs = KIN(I_GBS) + ((size_t)l * GH + h) * 128;
    LAS f32x4* Lws = (LAS f32x4*)lds; LAS f32x4* Lv = Lws + 4096;
    __syncthreads();
    for (int idx = tid; idx < nr * 32; idx += NTHR) { const int r = idx >> 5, c4 = idx & 31; Lws[idx] = *(const f32x4*)(wsm + r * 128 + 4 * c4); Lv[idx] = *(const f32x4*)(VN + (size_t)(row0 + r) * GMW + h * GHD + 4 * c4); }
    __syncthreads();
    const int rg = tid >> 4, cg = tid & 15;
    if (4 * rg < nr) {
        f32x4 acc[4][2];
#pragma unroll
        for (int r = 0; r < 4; ++r) { const float b0 = bs[4 * rg + r]; acc[r][0] = (f32x4){b0, b0, b0, b0}; acc[r][1] = acc[r][0]; }
        const LAS float* Lwf = (const LAS float*)Lws;
        for (int j = 0; j < 4 * rg + 4; ++j) { const f32x4 v0 = Lv[j * 32 + 2 * cg], v1 = Lv[j * 32 + 2 * cg + 1];
#pragma unroll
            for (int r = 0; r < 4; ++r) { const float w = (j <= 4 * rg + r) ? Lwf[(4 * rg + r) * 128 + j] : 0.f; acc[r][0] += v0 * w; acc[r][1] += v1 * w; } }
#pragma unroll
        for (int r = 0; r < 4; ++r) { const size_t row = (size_t)(row0 + 4 * rg + r); const v4u uu = *(const v4u*)(U + row * GMW + h * GHD + 8 * cg);
            const float u0 = __builtin_bit_cast(float, uu.x << 16), u1 = __builtin_bit_cast(float, uu.x & 0xffff0000u), u2 = __builtin_bit_cast(float, uu.y << 16), u3 = __builtin_bit_cast(float, uu.y & 0xffff0000u);
            const float u4 = __builtin_bit_cast(float, uu.z << 16), u5 = __builtin_bit_cast(float, uu.z & 0xffff0000u), u6 = __builtin_bit_cast(float, uu.w << 16), u7 = __builtin_bit_cast(float, uu.w & 0xffff0000u);
            v4u o; o.x = pk2(u0 * acc[r][0].x, u1 * acc[r][0].y); o.y = pk2(u2 * acc[r][0].z, u3 * acc[r][0].w); o.z = pk2(u4 * acc[r][1].x, u5 * acc[r][1].y); o.w = pk2(u6 * acc[r][1].z, u7 * acc[r][1].w);
            *(v4u*)(MIXB + row * DM + RW + h * GHD + 8 * cg) = o; }
    }
}


constexpr int NCI = 272, NUNIT = NCI * NH;
constexpr size_t SC_G = WS_RW + 3 * RWSZ;
constexpr size_t SC_HL = SC_G + (size_t)NUNIT * 8192;
constexpr size_t SC_RP = SC_HL + (size_t)NUNIT * 16384;
constexpr size_t SC_YL = SC_RP + (size_t)NUNIT * 8192;
constexpr size_t SC_S0 = SC_YL + (size_t)NUNIT * 16384;
constexpr size_t SC_BON = SC_S0 + (size_t)NUNIT * 8192;
constexpr size_t SC_END = SC_BON + (size_t)NUNIT * 256;
static_assert(SC_END <= WS_END, "scan scratch");
constexpr size_t WS_SLAB = SC_G;
static_assert(WS_SLAB + (size_t)11 * 512 * 2048 * 4 <= WS_END, "slab");
typedef unsigned u32x2 __attribute__((ext_vector_type(2)));
constexpr int BLD = 144;
constexpr int LBUF = 9216;
constexpr int LF0 = 7 * LBUF, F0P = 129;
constexpr int LF1 = LF0 + 64 * F0P * 4, F1P = 68;
constexpr int LF2 = LF1 + 64 * F1P * 4;
constexpr int LTOT = LF2 + 16384;
constexpr int LGC = LTOT + 2048;
constexpr int SCAN_LDS = LGC + 256;
static_assert(SCAN_LDS <= RING_BYTES, "scan LDS");

__device__ __forceinline__ bf16x8 ldfrag(const LAS unsigned char* mat, int blk, int ks, int lane) { return *(const LAS bf16x8*)(mat + (16 * blk + (lane & 15)) * BLD + (32 * ks + 8 * (lane >> 4)) * 2); }
#define MFMA16(a, b, c) __builtin_amdgcn_mfma_f32_16x16x32_bf16((a), (b), (c), 0, 0, 0)

__device__ __forceinline__ void scanA_unit(int l, LAS unsigned char* lds, int unit, int tid, int wave) {
    unsigned char* ws = KWS();
    const int lane = tid & 63, ci = unit >> 4, h = unit & 15, cc = 64 * h + lane;
    int m0, n; if (ci < 256) { m0 = 64 * ci; n = 64; } else { m0 = TP + 32 * (ci - 256); n = 32; }
    const float* P = (const float*)(ws + B_P); const float* Wl = (const float*)(ws + WS_RW); const float* Al = (const float*)(ws + WS_RW + RWSZ);
    LAS unsigned char* B0 = lds; LAS unsigned char* B1 = lds + LBUF; LAS unsigned char* B2 = lds + 2 * LBUF; LAS unsigned char* B3 = lds + 3 * LBUF;
    LAS unsigned char* B4 = lds + 4 * LBUF; LAS unsigned char* B5 = lds + 5 * LBUF; LAS unsigned char* B6 = lds + 6 * LBUF;
    LAS float* F0 = (LAS float*)(lds + LF0); LAS float* F1 = (LAS float*)(lds + LF1); LAS float* F2 = (LAS float*)(lds + LF2); LAS float* TOT = (LAS float*)(lds + LTOT); LAS float* GC = (LAS float*)(lds + LGC);
    __syncthreads();
    {
        const float* mu = KIN(I_MU) + (size_t)l * SHIFT;
        const float mu_r = mu[cc], mu_k = mu[RW + cc], mu_v = mu[2 * RW + cc];
        const float w0c = (KIN(I_W0) + (size_t)l * RW)[cc], a0c = (KIN(I_A0) + (size_t)l * RW)[cc], kkc = (KIN(I_KK) + (size_t)l * RW)[cc], kac = (KIN(I_KA) + (size_t)l * RW)[cc], rkc = (KIN(I_RK) + (size_t)l * RW)[cc];
        const int t0 = 8 * wave; const bool live = t0 < n;
        float r[8], kp[8], v[8], kk[8], b[8], lw[8];
        float q_r = 0.f, q_k = 0.f, q_v = 0.f;
        if (live) { const float* pp = prev_row(KIN(I_SSH), l, P, m0 + t0); if (pp) { q_r = pp[cc]; q_k = pp[RW + cc]; q_v = pp[2 * RW + cc]; } }
        float* bon = (float*)(ws + SC_BON) + (size_t)unit * 64;
        float pr_[8], pk_[8], pv_[8], al_[8], wl_[8], bsv[8];
#pragma unroll
        for (int i = 0; i < 8; ++i) { pr_[i] = 0.f; pk_[i] = 0.f; pv_[i] = 0.f; al_[i] = 0.f; wl_[i] = 0.f;
            if (live) { const size_t m = (size_t)(m0 + t0 + i); const float* pr = P + m * PLD; pr_[i] = pr[cc]; pk_[i] = pr[RW + cc]; pv_[i] = pr[2 * RW + cc]; al_[i] = Al[m * RW + cc]; wl_[i] = Wl[m * RW + cc]; } }
#pragma unroll
        for (int i = 0; i < 8; ++i) {
            r[i] = 0.f; kp[i] = 0.f; v[i] = 0.f; kk[i] = 0.f; b[i] = 0.f; lw[i] = 0.f; bsv[i] = 0.f;
            if (live) {
                const float p_r = pr_[i], p_k = pk_[i], p_v = pv_[i];
                const float rr = p_r + (q_r - p_r) * mu_r, kx = p_k + (q_k - p_k) * mu_k, vx = p_v + (q_v - p_v) * mu_v; q_r = p_r; q_k = p_k; q_v = p_v;
                const float av = 1.f / (1.f + __expf(-(a0c + al_[i])));
                const float y = -(w0c + wl_[i]); const float sp = fmaxf(y, 0.f) + __logf(1.0f + __expf(-fabsf(y)));
                const float kkv = kx * kkc; const float n2 = wave_sum(kkv * kkv); const float kn = kkv / fmaxf(sqrtf(n2), 1e-12f);
                const float kpv = kx * (1.f + (av - 1.f) * kac);
                bsv[i] = wave_sum(rr * kpv * rkc);
                r[i] = rr; kp[i] = kpv; v[i] = vx; kk[i] = kn; b[i] = kn * av; lw[i] = -__expf(-sp - 0.5f); }
        }
        if (live && lane < 8) { float bv = bsv[0];
#pragma unroll
            for (int i = 1; i < 8; ++i) bv = lane == i ? bsv[i] : bv;
            bon[t0 + lane] = bv; }
        float pl[8]; pl[0] = lw[0];
#pragma unroll
        for (int i = 1; i < 8; ++i) pl[i] = pl[i - 1] + lw[i];
        TOT[wave * 64 + lane] = pl[7];
        __syncthreads();
        float off = 0.f, lamC = 0.f;
#pragma unroll
        for (int s = 0; s < 8; ++s) { const float tv = TOT[s * 64 + lane]; lamC += tv; if (s < wave) off += tv; }
        if (wave == 0) GC[lane] = __expf(lamC);
        unsigned vt[4], kb[4], bb[4];
#pragma unroll
        for (int i = 0; i < 8; ++i) { const int t = t0 + i; const float lam = off + pl[i];
            const float g_t = __expf(lam), g_p = __expf(lam - lw[i]), g_i = __expf(-lam), g_c = __expf(lamC - lam);
            const float kkt = kk[i] * g_p, rt = r[i] * g_t;
            *(LAS unsigned short*)(B0 + t * BLD + lane * 2) = (unsigned short)f2bf(kkt); F0[t * F0P + lane] = kkt;
            *(LAS unsigned short*)(B1 + t * BLD + lane * 2) = (unsigned short)f2bf(rt); F2[t * 64 + lane] = rt;
            *(LAS unsigned short*)(B2 + t * BLD + lane * 2) = (unsigned short)f2bf(kp[i] * g_i);
            *(LAS unsigned short*)(B3 + t * BLD + lane * 2) = (unsigned short)f2bf(b[i] * g_i);
            const unsigned hv = f2bf(v[i]), hk = f2bf(kp[i] * g_c), hb = f2bf(b[i] * g_c);
            if (i & 1) { vt[i >> 1] |= hv << 16; kb[i >> 1] |= hk << 16; bb[i >> 1] |= hb << 16; } else { vt[i >> 1] = hv; kb[i >> 1] = hk; bb[i >> 1] = hb; } }
        *(LAS v4u*)(B4 + lane * BLD + 16 * wave) = (v4u){vt[0], vt[1], vt[2], vt[3]};
        *(LAS v4u*)(B5 + lane * BLD + 16 * wave) = (v4u){kb[0], kb[1], kb[2], kb[3]};
        *(LAS v4u*)(B6 + lane * BLD + 16 * wave) = (v4u){bb[0], bb[1], bb[2], bb[3]};
    }
    __syncthreads();
    const int rb = wave >> 1, cb0 = (wave & 1) * 2, g = lane >> 4, lc = lane & 15;
    float zf; asm volatile("v_mov_b32 %0, 0" : "=v"(zf));
    const f32x4 z4 = (f32x4){zf, zf, zf, zf};
    {
        f32x4 aab[2] = {z4, z4}, aak[2] = {z4, z4}, arb[2] = {z4, z4}, ark[2] = {z4, z4};
#pragma unroll
        for (int ks = 0; ks < 2; ++ks) { const bf16x8 fk = ldfrag(B0, rb, ks, lane), fr = ldfrag(B1, rb, ks, lane);
#pragma unroll
            for (int c = 0; c < 2; ++c) { const bf16x8 fkh = ldfrag(B2, cb0 + c, ks, lane), fb = ldfrag(B3, cb0 + c, ks, lane);
                aab[c] = MFMA16(fk, fb, aab[c]); aak[c] = MFMA16(fk, fkh, aak[c]); arb[c] = MFMA16(fr, fb, arb[c]); ark[c] = MFMA16(fr, fkh, ark[c]); } }
        __syncthreads();
#pragma unroll
        for (int c = 0; c < 2; ++c)
#pragma unroll
            for (int rg = 0; rg < 4; ++rg) { const int t = 16 * rb + 4 * g + rg, s = 16 * (cb0 + c) + lc;
                F1[t * F1P + (s & 3) * 16 + (s >> 2)] = s < t ? aab[c][rg] : 0.f;
                *(LAS unsigned short*)(B0 + t * BLD + s * 2) = (unsigned short)f2bf(s < t ? aak[c][rg] : 0.f);
                *(LAS unsigned short*)(B1 + t * BLD + s * 2) = (unsigned short)f2bf(s <= t ? arb[c][rg] : 0.f);
                *(LAS unsigned short*)(B2 + t * BLD + s * 2) = (unsigned short)f2bf(s <= t ? ark[c][rg] : 0.f); }
    }
    __syncthreads();
    {
        f32x4 av[2] = {z4, z4};
#pragma unroll
        for (int ks = 0; ks < 2; ++ks) { const bf16x8 fa = ldfrag(B0, rb, ks, lane);
#pragma unroll
            for (int c = 0; c < 2; ++c) av[c] = MFMA16(fa, ldfrag(B4, cb0 + c, ks, lane), av[c]); }
#pragma unroll
        for (int c = 0; c < 2; ++c)
#pragma unroll
            for (int rg = 0; rg < 4; ++rg) F0[(16 * rb + 4 * g + rg) * F0P + 64 + 16 * (cb0 + c) + lc] = av[c][rg];
    }
    __syncthreads();
    {
        const int j = tid >> 2, p = tid & 3; const LAS float* f1p = F1 + p * 16; const LAS float* f0p = F0 + j;
        float x0 = zf, x1 = zf, x2 = zf, x3 = zf, x4 = zf, x5 = zf, x6 = zf, x7 = zf, x8 = zf, x9 = zf, x10 = zf, x11 = zf, x12 = zf, x13 = zf, x14 = zf, x15 = zf;
        { float part = zf; const float xt = f0p[0*F0P] - part; x0 = (p == 0) ? xt : x0; }
        { const f32x4 a0 = *(const LAS f32x4*)(f1p + 1*F1P + 0); float part = a0.x * x0; part += dpp_mov<0xB1>(part); part += dpp_mov<0x4E>(part); const float xt = f0p[1*F0P] - part; x0 = (p == 1) ? xt : x0; }
        { const f32x4 a0 = *(const LAS f32x4*)(f1p + 2*F1P + 0); float part = a0.x * x0; part += dpp_mov<0xB1>(part); part += dpp_mov<0x4E>(part); const float xt = f0p[2*F0P] - part; x0 = (p == 2) ? xt : x0; }
        { const f32x4 a0 = *(const LAS f32x4*)(f1p + 3*F1P + 0); float part = a0.x * x0; part += dpp_mov<0xB1>(part); part += dpp_mov<0x4E>(part); const float xt = f0p[3*F0P] - part; x0 = (p == 3) ? xt : x0; }
        { const f32x4 a0 = *(const LAS f32x4*)(f1p + 4*F1P + 0); float part = a0.x * x0; part += dpp_mov<0xB1>(part); part += dpp_mov<0x4E>(part); const float xt = f0p[4*F0P] - part; x1 = (p == 0) ? xt : x1; }
        { const f32x4 a0 = *(const LAS f32x4*)(f1p + 5*F1P + 0); float part = (a0.x * x0) + (a0.y * x1); part += dpp_mov<0xB1>(part); part += dpp_mov<0x4E>(part); const float xt = f0p[5*F0P] - part; x1 = (p == 1) ? xt : x1; }
        { const f32x4 a0 = *(const LAS f32x4*)(f1p + 6*F1P + 0); float part = (a0.x * x0) + (a0.y * x1); part += dpp_mov<0xB1>(part); part += dpp_mov<0x4E>(part); const float xt = f0p[6*F0P] - part; x1 = (p == 2) ? xt : x1; }
        { const f32x4 a0 = *(const LAS f32x4*)(f1p + 7*F1P + 0); float part = (a0.x * x0) + (a0.y * x1); part += dpp_mov<0xB1>(part); part += dpp_mov<0x4E>(part); const float xt = f0p[7*F0P] - part; x1 = (p == 3) ? xt : x1; }
        { const f32x4 a0 = *(const LAS f32x4*)(f1p + 8*F1P + 0); float part = (a0.x * x0) + (a0.y * x1); part += dpp_mov<0xB1>(part); part += dpp_mov<0x4E>(part); const float xt = f0p[8*F0P] - part; x2 = (p == 0) ? xt : x2; }
        { const f32x4 a0 = *(const LAS f32x4*)(f1p + 9*F1P + 0); float part = (a0.x * x0 + a0.z * x2) + (a0.y * x1); part += dpp_mov<0xB1>(part); part += dpp_mov<0x4E>(part); const float xt = f0p[9*F0P] - part; x2 = (p == 1) ? xt : x2; }
        { const f32x4 a0 = *(const LAS f32x4*)(f1p + 10*F1P + 0); float part = (a0.x * x0 + a0.z * x2) + (a0.y * x1); part += dpp_mov<0xB1>(part); part += dpp_mov<0x4E>(part); const float xt = f0p[10*F0P] - part; x2 = (p == 2) ? xt : x2; }
        { const f32x4 a0 = *(const LAS f32x4*)(f1p + 11*F1P + 0); float part = (a0.x * x0 + a0.z * x2) + (a0.y * x1); part += dpp_mov<0xB1>(part); part += dpp_mov<0x4E>(part); const float xt = f0p[11*F0P] - part; x2 = (p == 3) ? xt : x2; }
        { const f32x4 a0 = *(const LAS f32x4*)(f1p + 12*F1P + 0); float part = (a0.x * x0 + a0.z * x2) + (a0.y * x1); part += dpp_mov<0xB1>(part); part += dpp_mov<0x4E>(part); const float xt = f0p[12*F0P] - part; x3 = (p == 0) ? xt : x3; }
        { const f32x4 a0 = *(const LAS f32x4*)(f1p + 13*F1P + 0); float part = (a0.x * x0 + a0.z * x2) + (a0.y * x1 + a0.w * x3); part += dpp_mov<0xB1>(part); part += dpp_mov<0x4E>(part); const float xt = f0p[13*F0P] - part; x3 = (p == 1) ? xt : x3; }
        { const f32x4 a0 = *(const LAS f32x4*)(f1p + 14*F1P + 0); float part = (a0.x * x0 + a0.z * x2) + (a0.y * x1 + a0.w * x3); part += dpp_mov<0xB1>(part); part += dpp_mov<0x4E>(part); const float xt = f0p[14*F0P] - part; x3 = (p == 2) ? xt : x3; }
        { const f32x4 a0 = *(const LAS f32x4*)(f1p + 15*F1P + 0); float part = (a0.x * x0 + a0.z * x2) + (a0.y * x1 + a0.w * x3); part += dpp_mov<0xB1>(part); part += dpp_mov<0x4E>(part); const float xt = f0p[15*F0P] - part; x3 = (p == 3) ? xt : x3; }
        { const f32x4 a0 = *(const LAS f32x4*)(f1p + 16*F1P + 0); float part = (a0.x * x0 + a0.z * x2) + (a0.y * x1 + a0.w * x3); part += dpp_mov<0xB1>(part); part += dpp_mov<0x4E>(part); const float xt = f0p[16*F0P] - part; x4 = (p == 0) ? xt : x4; }
        { const f32x4 a0 = *(const LAS f32x4*)(f1p + 17*F1P + 0); const f32x4 a1 = *(const LAS f32x4*)(f1p + 17*F1P + 4); float part = (a0.x * x0 + a0.z * x2 + a1.x * x4) + (a0.y * x1 + a0.w * x3); part += dpp_mov<0xB1>(part); part += dpp_mov<0x4E>(part); const float xt = f0p[17*F0P] - part; x4 = (p == 1) ? xt : x4; }
        { const f32x4 a0 = *(const LAS f32x4*)(f1p + 18*F1P + 0); const f32x4 a1 = *(const LAS f32x4*)(f1p + 18*F1P + 4); float part = (a0.x * x0 + a0.z * x2 + a1.x * x4) + (a0.y * x1 + a0.w * x3); part += dpp_mov<0xB1>(part); part += dpp_mov<0x4E>(part); const float xt = f0p[18*F0P] - part; x4 = (p == 2) ? xt : x4; }
        { const f32x4 a0 = *(const LAS f32x4*)(f1p + 19*F1P + 0); const f32x4 a1 = *(const LAS f32x4*)(f1p + 19*F1P + 4); float part = (a0.x * x0 + a0.z * x2 + a1.x * x4) + (a0.y * x1 + a0.w * x3); part += dpp_mov<0xB1>(part); part += dpp_mov<0x4E>(part); const float xt = f0p[19*F0P] - part; x4 = (p == 3) ? xt : x4; }
        { const f32x4 a0 = *(const LAS f32x4*)(f1p + 20*F1P + 0); const f32x4 a1 = *(const LAS f32x4*)(f1p + 20*F1P + 4); float part = (a0.x * x0 + a0.z * x2 + a1.x * x4) + (a0.y * x1 + a0.w * x3); part += dpp_mov<0xB1>(part); part += dpp_mov<0x4E>(part); const float xt = f0p[20*F0P] - part; x5 = (p == 0) ? xt : x5; }
        { const f32x4 a0 = *(const LAS f32x4*)(f1p + 21*F1P + 0); const f32x4 a1 = *(const LAS f32x4*)(f1p + 21*F1P + 4); float part = (a0.x * x0 + a0.z * x2 + a1.x * x4) + (a0.y * x1 + a0.w * x3 + a1.y * x5); part += dpp_mov<0xB1>(part); part += dpp_mov<0x4E>(part); const float xt = f0p[21*F0P] - part; x5 = (p == 1) ? xt : x5; }
        { const f32x4 a0 = *(const LAS f32x4*)(f1p + 22*F1P + 0); const f32x4 a1 = *(const LAS f32x4*)(f1p + 22*F1P + 4); float part = (a0.x * x0 + a0.z * x2 + a1.x * x4) + (a0.y * x1 + a0.w * x3 + a1.y * x5); part += dpp_mov<0xB1>(part); part += dpp_mov<0x4E>(part); const float xt = f0p[22*F0P] - part; x5 = (p == 2) ? xt : x5; }
        { const f32x4 a0 = *(const LAS f32x4*)(f1p + 23*F1P + 0); const f32x4 a1 = *(const LAS f32x4*)(f1p + 23*F1P + 4); float part = (a0.x * x0 + a0.z * x2 + a1.x * x4) + (a0.y * x1 + a0.w * x3 + a1.y * x5); part += dpp_mov<0xB1>(part); part += dpp_mov<0x4E>(part); const float xt = f0p[23*F0P] - part; x5 = (p == 3) ? xt : x5; }
        { const f32x4 a0 = *(const LAS f32x4*)(f1p + 24*F1P + 0); const f32x4 a1 = *(const LAS f32x4*)(f1p + 24*F1P + 4); float part = (a0.x * x0 + a0.z * x2 + a1.x * x4) + (a0.y * x1 + a0.w * x3 + a1.y * x5); part += dpp_mov<0xB1>(part); part += dpp_mov<0x4E>(part); const float xt = f0p[24*F0P] - part; x6 = (p == 0) ? xt : x6; }
        { const f32x4 a0 = *(const LAS f32x4*)(f1p + 25*F1P + 0); const f32x4 a1 = *(const LAS f32x4*)(f1p + 25*F1P + 4); float part = (a0.x * x0 + a0.z * x2 + a1.x * x4 + a1.z * x6) + (a0.y * x1 + a0.w * x3 + a1.y * x5); part += dpp_mov<0xB1>(part); part += dpp_mov<0x4E>(part); const float xt = f0p[25*F0P] - part; x6 = (p == 1) ? xt : x6; }
        { const f32x4 a0 = *(const LAS f32x4*)(f1p + 26*F1P + 0); const f32x4 a1 = *(const LAS f32x4*)(f1p + 26*F1P + 4); float part = (a0.x * x0 + a0.z * x2 + a1.x * x4 + a1.z * x6) + (a0.y * x1 + a0.w * x3 + a1.y * x5); part += dpp_mov<0xB1>(part); part += dpp_mov<0x4E>(part); const float xt = f0p[26*F0P] - part; x6 = (p == 2) ? xt : x6; }
        { const f32x4 a0 = *(const LAS f32x4*)(f1p + 27*F1P + 0); const f32x4 a1 = *(const LAS f32x4*)(f1p + 27*F1P + 4); float part = (a0.x * x0 + a0.z * x2 + a1.x * x4 + a1.z * x6) + (a0.y * x1 + a0.w * x3 + a1.y * x5); part += dpp_mov<0xB1>(part); part += dpp_mov<0x4E>(part); const float xt = f0p[27*F0P] - part; x6 = (p == 3) ? xt : x6; }
        { const f32x4 a0 = *(const LAS f32x4*)(f1p + 28*F1P + 0); const f32x4 a1 = *(const LAS f32x4*)(f1p + 28*F1P + 4); float part = (a0.x * x0 + a0.z * x2 + a1.x * x4 + a1.z * x6) + (a0.y * x1 + a0.w * x3 + a1.y * x5); part += dpp_mov<0xB1>(part); part += dpp_mov<0x4E>(part); const float xt = f0p[28*F0P] - part; x7 = (p == 0) ? xt : x7; }
        { const f32x4 a0 = *(const LAS f32x4*)(f1p + 29*F1P + 0); const f32x4 a1 = *(const LAS f32x4*)(f1p + 29*F1P + 4); float part = (a0.x * x0 + a0.z * x2 + a1.x * x4 + a1.z * x6) + (a0.y * x1 + a0.w * x3 + a1.y * x5 + a1.w * x7); part += dpp_mov<0xB1>(part); part += dpp_mov<0x4E>(part); const float xt = f0p[29*F0P] - part; x7 = (p == 1) ? xt : x7; }
        { const f32x4 a0 = *(const LAS f32x4*)(f1p + 30*F1P + 0); const f32x4 a1 = *(const LAS f32x4*)(f1p + 30*F1P + 4); float part = (a0.x * x0 + a0.z * x2 + a1.x * x4 + a1.z * x6) + (a0.y * x1 + a0.w * x3 + a1.y * x5 + a1.w * x7); part += dpp_mov<0xB1>(part); part += dpp_mov<0x4E>(part); const float xt = f0p[30*F0P] - part; x7 = (p == 2) ? xt : x7; }
        { const f32x4 a0 = *(const LAS f32x4*)(f1p + 31*F1P + 0); const f32x4 a1 = *(const LAS f32x4*)(f1p + 31*F1P + 4); float part = (a0.x * x0 + a0.z * x2 + a1.x * x4 + a1.z * x6) + (a0.y * x1 + a0.w * x3 + a1.y * x5 + a1.w * x7); part += dpp_mov<0xB1>(part); part += dpp_mov<0x4E>(part); const float xt = f0p[31*F0P] - part; x7 = (p == 3) ? xt : x7; }
        { const f32x4 a0 = *(const LAS f32x4*)(f1p + 32*F1P + 0); const f32x4 a1 = *(const LAS f32x4*)(f1p + 32*F1P + 4); float part = (a0.x * x0 + a0.z * x2 + a1.x * x4 + a1.z * x6) + (a0.y * x1 + a0.w * x3 + a1.y * x5 + a1.w * x7); part += dpp_mov<0xB1>(part); part += dpp_mov<0x4E>(part); const float xt = f0p[32*F0P] - part; x8 = (p == 0) ? xt : x8; }
        { const f32x4 a0 = *(const LAS f32x4*)(f1p + 33*F1P + 0); const f32x4 a1 = *(const LAS f32x4*)(f1p + 33*F1P + 4); const f32x4 a2 = *(const LAS f32x4*)(f1p + 33*F1P + 8); float part = (a0.x * x0 + a0.z * x2 + a1.x * x4 + a1.z * x6 + a2.x * x8) + (a0.y * x1 + a0.w * x3 + a1.y * x5 + a1.w * x7); part += dpp_mov<0xB1>(part); part += dpp_mov<0x4E>(part); const float xt = f0p[33*F0P] - part; x8 = (p == 1) ? xt : x8; }
        { const f32x4 a0 = *(const LAS f32x4*)(f1p + 34*F1P + 0); const f32x4 a1 = *(const LAS f32x4*)(f1p + 34*F1P + 4); const f32x4 a2 = *(const LAS f32x4*)(f1p + 34*F1P + 8); float part = (a0.x * x0 + a0.z * x2 + a1.x * x4 + a1.z * x6 + a2.x * x8) + (a0.y * x1 + a0.w * x3 + a1.y * x5 + a1.w * x7); part += dpp_mov<0xB1>(part); part += dpp_mov<0x4E>(part); const float xt = f0p[34*F0P] - part; x8 = (p == 2) ? xt : x8; }
        { const f32x4 a0 = *(const LAS f32x4*)(f1p + 35*F1P + 0); const f32x4 a1 = *(const LAS f32x4*)(f1p + 35*F1P + 4); const f32x4 a2 = *(const LAS f32x4*)(f1p + 35*F1P + 8); float part = (a0.x * x0 + a0.z * x2 + a1.x * x4 + a1.z * x6 + a2.x * x8) + (a0.y * x1 + a0.w * x3 + a1.y * x5 + a1.w * x7); part += dpp_mov<0xB1>(part); part += dpp_mov<0x4E>(part); const float xt = f0p[35*F0P] - part; x8 = (p == 3) ? xt : x8; }
        { const f32x4 a0 = *(const LAS f32x4*)(f1p + 36*F1P + 0); const f32x4 a1 = *(const LAS f32x4*)(f1p + 36*F1P + 4); const f32x4 a2 = *(const LAS f32x4*)(f1p + 36*F1P + 8); float part = (a0.x * x0 + a0.z * x2 + a1.x * x4 + a1.z * x6 + a2.x * x8) + (a0.y * x1 + a0.w * x3 + a1.y * x5 + a1.w * x7); part += dpp_mov<0xB1>(part); part += dpp_mov<0x4E>(part); const float xt = f0p[36*F0P] - part; x9 = (p == 0) ? xt : x9; }
        { const f32x4 a0 = *(const LAS f32x4*)(f1p + 37*F1P + 0); const f32x4 a1 = *(const LAS f32x4*)(f1p + 37*F1P + 4); const f32x4 a2 = *(const LAS f32x4*)(f1p + 37*F1P + 8); float part = (a0.x * x0 + a0.z * x2 + a1.x * x4 + a1.z * x6 + a2.x * x8) + (a0.y * x1 + a0.w * x3 + a1.y * x5 + a1.w * x7 + a2.y * x9); part += dpp_mov<0xB1>(part); part += dpp_mov<0x4E>(part); const float xt = f0p[37*F0P] - part; x9 = (p == 1) ? xt : x9; }
        { const f32x4 a0 = *(const LAS f32x4*)(f1p + 38*F1P + 0); const f32x4 a1 = *(const LAS f32x4*)(f1p + 38*F1P + 4); const f32x4 a2 = *(const LAS f32x4*)(f1p + 38*F1P + 8); float part = (a0.x * x0 + a0.z * x2 + a1.x * x4 + a1.z * x6 + a2.x * x8) + (a0.y * x1 + a0.w * x3 + a1.y * x5 + a1.w * x7 + a2.y * x9); part += dpp_mov<0xB1>(part); part += dpp_mov<0x4E>(part); const float xt = f0p[38*F0P] - part; x9 = (p == 2) ? xt : x9; }
        { const f32x4 a0 = *(const LAS f32x4*)(f1p + 39*F1P + 0); const f32x4 a1 = *(const LAS f32x4*)(f1p + 39*F1P + 4); const f32x4 a2 = *(const LAS f32x4*)(f1p + 39*F1P + 8); float part = (a0.x * x0 + a0.z * x2 + a1.x * x4 + a1.z * x6 + a2.x * x8) + (a0.y * x1 + a0.w * x3 + a1.y * x5 + a1.w * x7 + a2.y * x9); part += dpp_mov<0xB1>(part); part += dpp_mov<0x4E>(part); const float xt = f0p[39*F0P] - part; x9 = (p == 3) ? xt : x9; }
        { const f32x4 a0 = *(const LAS f32x4*)(f1p + 40*F1P + 0); const f32x4 a1 = *(const LAS f32x4*)(f1p + 40*F1P + 4); const f32x4 a2 = *(const LAS f32x4*)(f1p + 40*F1P + 8); float part = (a0.x * x0 + a0.z * x2 + a1.x * x4 + a1.z * x6 + a2.x * x8) + (a0.y * x1 + a0.w * x3 + a1.y * x5 + a1.w * x7 + a2.y * x9); part += dpp_mov<0xB1>(part); part += dpp_mov<0x4E>(part); const float xt = f0p[40*F0P] - part; x10 = (p == 0) ? xt : x10; }
        { const f32x4 a0 = *(const LAS f32x4*)(f1p + 41*F1P + 0); const f32x4 a1 = *(const LAS f32x4*)(f1p + 41*F1P + 4); const f32x4 a2 = *(const LAS f32x4*)(f1p + 41*F1P + 8); float part = (a0.x * x0 + a0.z * x2 + a1.x * x4 + a1.z * x6 + a2.x * x8 + a2.z * x10) + (a0.y * x1 + a0.w * x3 + a1.y * x5 + a1.w * x7 + a2.y * x9); part += dpp_mov<0xB1>(part); part += dpp_mov<0x4E>(part); const float xt = f0p[41*F0P] - part; x10 = (p == 1) ? xt : x10; }
        { const f32x4 a0 = *(const LAS f32x4*)(f1p + 42*F1P + 0); const f32x4 a1 = *(const LAS f32x4*)(f1p + 42*F1P + 4); const f32x4 a2 = *(const LAS f32x4*)(f1p + 42*F1P + 8); float part = (a0.x * x0 + a0.z * x2 + a1.x * x4 + a1.z * x6 + a2.x * x8 + a2.z * x10) + (a0.y * x1 + a0.w * x3 + a1.y * x5 + a1.w * x7 + a2.y * x9); part += dpp_mov<0xB1>(part); part += dpp_mov<0x4E>(part); const float xt = f0p[42*F0P] - part; x10 = (p == 2) ? xt : x10; }
        { const f32x4 a0 = *(const LAS f32x4*)(f1p + 43*F1P + 0); const f32x4 a1 = *(const LAS f32x4*)(f1p + 43*F1P + 4); const f32x4 a2 = *(const LAS f32x4*)(f1p + 43*F1P + 8); float part = (a0.x * x0 + a0.z * x2 + a1.x * x4 + a1.z * x6 + a2.x * x8 + a2.z * x10) + (a0.y * x1 + a0.w * x3 + a1.y * x5 + a1.w * x7 + a2.y * x9); part += dpp_mov<0xB1>(part); part += dpp_mov<0x4E>(part); const float xt = f0p[43*F0P] - part; x10 = (p == 3) ? xt : x10; }
        { const f32x4 a0 = *(const LAS f32x4*)(f1p + 44*F1P + 0); const f32x4 a1 = *(const LAS f32x4*)(f1p + 44*F1P + 4); const f32x4 a2 = *(const LAS f32x4*)(f1p + 44*F1P + 8); float part = (a0.x * x0 + a0.z * x2 + a1.x * x4 + a1.z * x6 + a2.x * x8 + a2.z * x10) + (a0.y * x1 + a0.w * x3 + a1.y * x5 + a1.w * x7 + a2.y * x9); part += dpp_mov<0xB1>(part); part += dpp_mov<0x4E>(part); const float xt = f0p[44*F0P] - part; x11 = (p == 0) ? xt : x11; }
        { const f32x4 a0 = *(const LAS f32x4*)(f1p + 45*F1P + 0); const f32x4 a1 = *(const LAS f32x4*)(f1p + 45*F1P + 4); const f32x4 a2 = *(const LAS f32x4*)(f1p + 45*F1P + 8); float part = (a0.x * x0 + a0.z * x2 + a1.x * x4 + a1.z * x6 + a2.x * x8 + a2.z * x10) + (a0.y * x1 + a0.w * x3 + a1.y * x5 + a1.w * x7 + a2.y * x9 + a2.w * x11); part += dpp_mov<0xB1>(part); part += dpp_mov<0x4E>(part); const float xt = f0p[45*F0P] - part; x11 = (p == 1) ? xt : x11; }
        { const f32x4 a0 = *(const LAS f32x4*)(f1p + 46*F1P + 0); const f32x4 a1 = *(const LAS f32x4*)(f1p + 46*F1P + 4); const f32x4 a2 = *(const LAS f32x4*)(f1p + 46*F1P + 8); float part = (a0.x * x0 + a0.z * x2 + a1.x * x4 + a1.z * x6 + a2.x * x8 + a2.z * x10) + (a0.y * x1 + a0.w * x3 + a1.y * x5 + a1.w * x7 + a2.y * x9 + a2.w * x11); part += dpp_mov<0xB1>(part); part += dpp_mov<0x4E>(part); const float xt = f0p[46*F0P] - part; x11 = (p == 2) ? xt : x11; }
        { const f32x4 a0 = *(const LAS f32x4*)(f1p + 47*F1P + 0); const f32x4 a1 = *(const LAS f32x4*)(f1p + 47*F1P + 4); const f32x4 a2 = *(const LAS f32x4*)(f1p + 47*F1P + 8); float part = (a0.x * x0 + a0.z * x2 + a1.x * x4 + a1.z * x6 + a2.x * x8 + a2.z * x10) + (a0.y * x1 + a0.w * x3 + a1.y * x5 + a1.w * x7 + a2.y * x9 + a2.w * x11); part += dpp_mov<0xB1>(part); part += dpp_mov<0x4E>(part); const float xt = f0p[47*F0P] - part; x11 = (p == 3) ? xt : x11; }
        { const f32x4 a0 = *(const LAS f32x4*)(f1p + 48*F1P + 0); const f32x4 a1 = *(const LAS f32x4*)(f1p + 48*F1P + 4); const f32x4 a2 = *(const LAS f32x4*)(f1p + 48*F1P + 8); float part = (a0.x * x0 + a0.z * x2 + a1.x * x4 + a1.z * x6 + a2.x * x8 + a2.z * x10) + (a0.y * x1 + a0.w * x3 + a1.y * x5 + a1.w * x7 + a2.y * x9 + a2.w * x11); part += dpp_mov<0xB1>(part); part += dpp_mov<0x4E>(part); const float xt = f0p[48*F0P] - part; x12 = (p == 0) ? xt : x12; }
        { const f32x4 a0 = *(const LAS f32x4*)(f1p + 49*F1P + 0); const f32x4 a1 = *(const LAS f32x4*)(f1p + 49*F1P + 4); const f32x4 a2 = *(const LAS f32x4*)(f1p + 49*F1P + 8); const f32x4 a3 = *(const LAS f32x4*)(f1p + 49*F1P + 12); float part = (a0.x * x0 + a0.z * x2 + a1.x * x4 + a1.z * x6 + a2.x * x8 + a2.z * x10 + a3.x * x12) + (a0.y * x1 + a0.w * x3 + a1.y * x5 + a1.w * x7 + a2.y * x9 + a2.w * x11); part += dpp_mov<0xB1>(part); part += dpp_mov<0x4E>(part); const float xt = f0p[49*F0P] - part; x12 = (p == 1) ? xt : x12; }
        { const f32x4 a0 = *(const LAS f32x4*)(f1p + 50*F1P + 0); const f32x4 a1 = *(const LAS f32x4*)(f1p + 50*F1P + 4); const f32x4 a2 = *(const LAS f32x4*)(f1p + 50*F1P + 8); const f32x4 a3 = *(const LAS f32x4*)(f1p + 50*F1P + 12); float part = (a0.x * x0 + a0.z * x2 + a1.x * x4 + a1.z * x6 + a2.x * x8 + a2.z * x10 + a3.x * x12) + (a0.y * x1 + a0.w * x3 + a1.y * x5 + a1.w * x7 + a2.y * x9 + a2.w * x11); part += dpp_mov<0xB1>(part); part += dpp_mov<0x4E>(part); const float xt = f0p[50*F0P] - part; x12 = (p == 2) ? xt : x12; }
        { const f32x4 a0 = *(const LAS f32x4*)(f1p + 51*F1P + 0); const f32x4 a1 = *(const LAS f32x4*)(f1p + 51*F1P + 4); const f32x4 a2 = *(const LAS f32x4*)(f1p + 51*F1P + 8); const f32x4 a3 = *(const LAS f32x4*)(f1p + 51*F1P + 12); float part = (a0.x * x0 + a0.z * x2 + a1.x * x4 + a1.z * x6 + a2.x * x8 + a2.z * x10 + a3.x * x12) + (a0.y * x1 + a0.w * x3 + a1.y * x5 + a1.w * x7 + a2.y * x9 + a2.w * x11); part += dpp_mov<0xB1>(part); part += dpp_mov<0x4E>(part); const float xt = f0p[51*F0P] - part; x12 = (p == 3) ? xt : x12; }
        { const f32x4 a0 = *(const LAS f32x4*)(f1p + 52*F1P + 0); const f32x4 a1 = *(const LAS f32x4*)(f1p + 52*F1P + 4); const f32x4 a2 = *(const LAS f32x4*)(f1p + 52*F1P + 8); const f32x4 a3 = *(const LAS f32x4*)(f1p + 52*F1P + 12); float part = (a0.x * x0 + a0.z * x2 + a1.x * x4 + a1.z * x6 + a2.x * x8 + a2.z * x10 + a3.x * x12) + (a0.y * x1 + a0.w * x3 + a1.y * x5 + a1.w * x7 + a2.y * x9 + a2.w * x11); part += dpp_mov<0xB1>(part); part += dpp_mov<0x4E>(part); const float xt = f0p[52*F0P] - part; x13 = (p == 0) ? xt : x13; }
        { const f32x4 a0 = *(const LAS f32x4*)(f1p + 53*F1P + 0); const f32x4 a1 = *(const LAS f32x4*)(f1p + 53*F1P + 4); const f32x4 a2 = *(const LAS f32x4*)(f1p + 53*F1P + 8); const f32x4 a3 = *(const LAS f32x4*)(f1p + 53*F1P + 12); float part = (a0.x * x0 + a0.z * x2 + a1.x * x4 + a1.z * x6 + a2.x * x8 + a2.z * x10 + a3.x * x12) + (a0.y * x1 + a0.w * x3 + a1.y * x5 + a1.w * x7 + a2.y * x9 + a2.w * x11 + a3.y * x13); part += dpp_mov<0xB1>(part); part += dpp_mov<0x4E>(part); const float xt = f0p[53*F0P] - part; x13 = (p == 1) ? xt : x13; }
        { const f32x4 a0 = *(const LAS f32x4*)(f1p + 54*F1P + 0); const f32x4 a1 = *(const LAS f32x4*)(f1p + 54*F1P + 4); const f32x4 a2 = *(const LAS f32x4*)(f1p + 54*F1P + 8); const f32x4 a3 = *(const LAS f32x4*)(f1p + 54*F1P + 12); float part = (a0.x * x0 + a0.z * x2 + a1.x * x4 + a1.z * x6 + a2.x * x8 + a2.z * x10 + a3.x * x12) + (a0.y * x1 + a0.w * x3 + a1.y * x5 + a1.w * x7 + a2.y * x9 + a2.w * x11 + a3.y * x13); part += dpp_mov<0xB1>(part); part += dpp_mov<0x4E>(part); const float xt = f0p[54*F0P] - part; x13 = (p == 2) ? xt : x13; }
        { const f32x4 a0 = *(const LAS f32x4*)(f1p + 55*F1P + 0); const f32x4 a1 = *(const LAS f32x4*)(f1p + 55*F1P + 4); const f32x4 a2 = *(const LAS f32x4*)(f1p + 55*F1P + 8); const f32x4 a3 = *(const LAS f32x4*)(f1p + 55*F1P + 12); float part = (a0.x * x0 + a0.z * x2 + a1.x * x4 + a1.z * x6 + a2.x * x8 + a2.z * x10 + a3.x * x12) + (a0.y * x1 + a0.w * x3 + a1.y * x5 + a1.w * x7 + a2.y * x9 + a2.w * x11 + a3.y * x13); part += dpp_mov<0xB1>(part); part += dpp_mov<0x4E>(part); const float xt = f0p[55*F0P] - part; x13 = (p == 3) ? xt : x13; }
        { const f32x4 a0 = *(const LAS f32x4*)(f1p + 56*F1P + 0); const f32x4 a1 = *(const LAS f32x4*)(f1p + 56*F1P + 4); const f32x4 a2 = *(const LAS f32x4*)(f1p + 56*F1P + 8); const f32x4 a3 = *(const LAS f32x4*)(f1p + 56*F1P + 12); float part = (a0.x * x0 + a0.z * x2 + a1.x * x4 + a1.z * x6 + a2.x * x8 + a2.z * x10 + a3.x * x12) + (a0.y * x1 + a0.w * x3 + a1.y * x5 + a1.w * x7 + a2.y * x9 + a2.w * x11 + a3.y * x13); part += dpp_mov<0xB1>(part); part += dpp_mov<0x4E>(part); const float xt = f0p[56*F0P] - part; x14 = (p == 0) ? xt : x14; }
        { const f32x4 a0 = *(const LAS f32x4*)(f1p + 57*F1P + 0); const f32x4 a1 = *(const LAS f32x4*)(f1p + 57*F1P + 4); const f32x4 a2 = *(const LAS f32x4*)(f1p + 57*F1P + 8); const f32x4 a3 = *(const LAS f32x4*)(f1p + 57*F1P + 12); float part = (a0.x * x0 + a0.z * x2 + a1.x * x4 + a1.z * x6 + a2.x * x8 + a2.z * x10 + a3.x * x12 + a3.z * x14) + (a0.y * x1 + a0.w * x3 + a1.y * x5 + a1.w * x7 + a2.y * x9 + a2.w * x11 + a3.y * x13); part += dpp_mov<0xB1>(part); part += dpp_mov<0x4E>(part); const float xt = f0p[57*F0P] - part; x14 = (p == 1) ? xt : x14; }
        { const f32x4 a0 = *(const LAS f32x4*)(f1p + 58*F1P + 0); const f32x4 a1 = *(const LAS f32x4*)(f1p + 58*F1P + 4); const f32x4 a2 = *(const LAS f32x4*)(f1p + 58*F1P + 8); const f32x4 a3 = *(const LAS f32x4*)(f1p + 58*F1P + 12); float part = (a0.x * x0 + a0.z * x2 + a1.x * x4 + a1.z * x6 + a2.x * x8 + a2.z * x10 + a3.x * x12 + a3.z * x14) + (a0.y * x1 + a0.w * x3 + a1.y * x5 + a1.w * x7 + a2.y * x9 + a2.w * x11 + a3.y * x13); part += dpp_mov<0xB1>(part); part += dpp_mov<0x4E>(part); const float xt = f0p[58*F0P] - part; x14 = (p == 2) ? xt : x14; }
        { const f32x4 a0 = *(const LAS f32x4*)(f1p + 59*F1P + 0); const f32x4 a1 = *(const LAS f32x4*)(f1p + 59*F1P + 4); const f32x4 a2 = *(const LAS f32x4*)(f1p + 59*F1P + 8); const f32x4 a3 = *(const LAS f32x4*)(f1p + 59*F1P + 12); float part = (a0.x * x0 + a0.z * x2 + a1.x * x4 + a1.z * x6 + a2.x * x8 + a2.z * x10 + a3.x * x12 + a3.z * x14) + (a0.y * x1 + a0.w * x3 + a1.y * x5 + a1.w * x7 + a2.y * x9 + a2.w * x11 + a3.y * x13); part += dpp_mov<0xB1>(part); part += dpp_mov<0x4E>(part); const float xt = f0p[59*F0P] - part; x14 = (p == 3) ? xt : x14; }
        { const f32x4 a0 = *(const LAS f32x4*)(f1p + 60*F1P + 0); const f32x4 a1 = *(const LAS f32x4*)(f1p + 60*F1P + 4); const f32x4 a2 = *(const LAS f32x4*)(f1p + 60*F1P + 8); const f32x4 a3 = *(const LAS f32x4*)(f1p + 60*F1P + 12); float part = (a0.x * x0 + a0.z * x2 + a1.x * x4 + a1.z * x6 + a2.x * x8 + a2.z * x10 + a3.x * x12 + a3.z * x14) + (a0.y * x1 + a0.w * x3 + a1.y * x5 + a1.w * x7 + a2.y * x9 + a2.w * x11 + a3.y * x13); part += dpp_mov<0xB1>(part); part += dpp_mov<0x4E>(part); const float xt = f0p[60*F0P] - part; x15 = (p == 0) ? xt : x15; }
        { const f32x4 a0 = *(const LAS f32x4*)(f1p + 61*F1P + 0); const f32x4 a1 = *(const LAS f32x4*)(f1p + 61*F1P + 4); const f32x4 a2 = *(const LAS f32x4*)(f1p + 61*F1P + 8); const f32x4 a3 = *(const LAS f32x4*)(f1p + 61*F1P + 12); float part = (a0.x * x0 + a0.z * x2 + a1.x * x4 + a1.z * x6 + a2.x * x8 + a2.z * x10 + a3.x * x12 + a3.z * x14) + (a0.y * x1 + a0.w * x3 + a1.y * x5 + a1.w * x7 + a2.y * x9 + a2.w * x11 + a3.y * x13 + a3.w * x15); part += dpp_mov<0xB1>(part); part += dpp_mov<0x4E>(part); const float xt = f0p[61*F0P] - part; x15 = (p == 1) ? xt : x15; }
        { const f32x4 a0 = *(const LAS f32x4*)(f1p + 62*F1P + 0); const f32x4 a1 = *(const LAS f32x4*)(f1p + 62*F1P + 4); const f32x4 a2 = *(const LAS f32x4*)(f1p + 62*F1P + 8); const f32x4 a3 = *(const LAS f32x4*)(f1p + 62*F1P + 12); float part = (a0.x * x0 + a0.z * x2 + a1.x * x4 + a1.z * x6 + a2.x * x8 + a2.z * x10 + a3.x * x12 + a3.z * x14) + (a0.y * x1 + a0.w * x3 + a1.y * x5 + a1.w * x7 + a2.y * x9 + a2.w * x11 + a3.y * x13 + a3.w * x15); part += dpp_mov<0xB1>(part); part += dpp_mov<0x4E>(part); const float xt = f0p[62*F0P] - part; x15 = (p == 2) ? xt : x15; }
        { const f32x4 a0 = *(const LAS f32x4*)(f1p + 63*F1P + 0); const f32x4 a1 = *(const LAS f32x4*)(f1p + 63*F1P + 4); const f32x4 a2 = *(const LAS f32x4*)(f1p + 63*F1P + 8); const f32x4 a3 = *(const LAS f32x4*)(f1p + 63*F1P + 12); float part = (a0.x * x0 + a0.z * x2 + a1.x * x4 + a1.z * x6 + a2.x * x8 + a2.z * x10 + a3.x * x12 + a3.z * x14) + (a0.y * x1 + a0.w * x3 + a1.y * x5 + a1.w * x7 + a2.y * x9 + a2.w * x11 + a3.y * x13 + a3.w * x15); part += dpp_mov<0xB1>(part); part += dpp_mov<0x4E>(part); const float xt = f0p[63*F0P] - part; x15 = (p == 3) ? xt : x15; }
        LAS unsigned char* dst = (wave < 4 ? B3 : B0) + (j & 63) * BLD + p * 2;
        *(LAS unsigned short*)(dst + 0) = (unsigned short)f2bf(-x0);
        *(LAS unsigned short*)(dst + 8) = (unsigned short)f2bf(-x1);
        *(LAS unsigned short*)(dst + 16) = (unsigned short)f2bf(-x2);
        *(LAS unsigned short*)(dst + 24) = (unsigned short)f2bf(-x3);
        *(LAS unsigned short*)(dst + 32) = (unsigned short)f2bf(-x4);
        *(LAS unsigned short*)(dst + 40) = (unsigned short)f2bf(-x5);
        *(LAS unsigned short*)(dst + 48) = (unsigned short)f2bf(-x6);
        *(LAS unsigned short*)(dst + 56) = (unsigned short)f2bf(-x7);
        *(LAS unsigned short*)(dst + 64) = (unsigned short)f2bf(-x8);
        *(LAS unsigned short*)(dst + 72) = (unsigned short)f2bf(-x9);
        *(LAS unsigned short*)(dst + 80) = (unsigned short)f2bf(-x10);
        *(LAS unsigned short*)(dst + 88) = (unsigned short)f2bf(-x11);
        *(LAS unsigned short*)(dst + 96) = (unsigned short)f2bf(-x12);
        *(LAS unsigned short*)(dst + 104) = (unsigned short)f2bf(-x13);
        *(LAS unsigned short*)(dst + 112) = (unsigned short)f2bf(-x14);
        *(LAS unsigned short*)(dst + 120) = (unsigned short)f2bf(-x15);
    }
    __syncthreads();
    {
        f32x4 rp[2], yl[2] = {z4, z4}, gg[2], hl[2] = {z4, z4};
#pragma unroll
        for (int c = 0; c < 2; ++c)
#pragma unroll
            for (int rg = 0; rg < 4; ++rg) { const int row = 16 * rb + 4 * g + rg, col = 16 * (cb0 + c) + lc; rp[c][rg] = F2[row * 64 + col]; gg[c][rg] = row == col ? GC[row] : 0.f; }
#pragma unroll
        for (int ks = 0; ks < 2; ++ks) { const bf16x8 farb = ldfrag(B1, rb, ks, lane), fark = ldfrag(B2, rb, ks, lane), fbb = ldfrag(B6, rb, ks, lane), fkb = ldfrag(B5, rb, ks, lane);
#pragma unroll
            for (int c = 0; c < 2; ++c) { const bf16x8 fp = ldfrag(B3, cb0 + c, ks, lane), fq = ldfrag(B0, cb0 + c, ks, lane), fv = ldfrag(B4, cb0 + c, ks, lane);
                rp[c] = MFMA16(farb, fp, rp[c]); yl[c] = MFMA16(fark, fv, yl[c]); yl[c] = MFMA16(farb, fq, yl[c]);
                gg[c] = MFMA16(fbb, fp, gg[c]); hl[c] = MFMA16(fkb, fv, hl[c]); hl[c] = MFMA16(fbb, fq, hl[c]); } }
        bf16* RPg = (bf16*)(ws + SC_RP) + (size_t)unit * 4096; float* YLg = (float*)(ws + SC_YL) + (size_t)unit * 4096; bf16* Gg_ = (bf16*)(ws + SC_G) + (size_t)unit * 4096; float* HLg = (float*)(ws + SC_HL) + (size_t)unit * 4096;
#pragma unroll
        for (int c = 0; c < 2; ++c)
#pragma unroll
            for (int rg = 0; rg < 4; ++rg) { const int o = (16 * rb + 4 * g + rg) * 64 + 16 * (cb0 + c) + lc;
                RPg[o] = (bf16)f2bf(rp[c][rg]); YLg[o] = yl[c][rg]; Gg_[o] = (bf16)f2bf(gg[c][rg]); HLg[o] = hl[c][rg]; }
    }
}

template <int NSTEP, int PF> __device__ __forceinline__ void scanB_chain(int l, LAS unsigned char* lds, int ci0, int h, int vs, const float* init, float* outp_state, int tid, int wave) {
    unsigned char* ws = KWS();
    const int lane = tid & 63, half = wave >> 2, jr = wave & 3, g = lane >> 4, lc = lane & 15;
    LAS unsigned char* XH = lds + half * 16384;
    const bf16* Gall = (const bf16*)(ws + SC_G); const float* HLall = (const float*)(ws + SC_HL); bf16* S0all = (bf16*)(ws + SC_S0);
    float zf; asm volatile("v_mov_b32 %0, 0" : "=v"(zf));
    f32x4 acc = (f32x4){zf, zf, zf, zf};
    __syncthreads();
    if (init) acc = *(const f32x4*)(init + (16 * vs + lc) * 64 + 16 * jr + 4 * g);
    bf16x8 Gf[PF][2]; f32x4 Lf[PF];
#define SB_ISSUE(slot, c) do { const size_t unit_ = (size_t)(ci0 + (c)) * 16 + h; const bf16* Gp = Gall + unit_ * 4096 + (16 * jr + lc) * 64 + 8 * g; const float* Lp = HLall + unit_ * 4096 + (16 * jr + 4 * g) * 64 + 16 * vs + lc; \
        Gf[slot][0] = *(const bf16x8*)Gp; Gf[slot][1] = *(const bf16x8*)(Gp + 32); Lf[slot] = (f32x4){Lp[0], Lp[64], Lp[128], Lp[192]}; } while (0)
#pragma unroll
    for (int s = 0; s < PF; ++s) if (s < NSTEP) SB_ISSUE(s, s);
    for (int c0 = 0; c0 < NSTEP; c0 += PF) {
#pragma unroll
        for (int s = 0; s < PF; ++s) { const int c = c0 + s; if (NSTEP % PF == 0 || c < NSTEP) {
            const size_t unit = (size_t)(ci0 + c) * 16 + h;
            const unsigned h0 = pk2(acc.x, acc.y), h1 = pk2(acc.z, acc.w);
            const float l0 = acc.x - __builtin_bit_cast(float, h0 << 16), l1 = acc.y - __builtin_bit_cast(float, h0 & 0xffff0000u), l2 = acc.z - __builtin_bit_cast(float, h1 << 16), l3 = acc.w - __builtin_bit_cast(float, h1 & 0xffff0000u);
            LAS unsigned char* xb = XH + (c & 1) * 8192;
            *(LAS u32x2*)(xb + lc * BLD + (16 * jr + 4 * g) * 2) = (u32x2){h0, h1};
            *(LAS u32x2*)(xb + 4096 + lc * BLD + (16 * jr + 4 * g) * 2) = (u32x2){pk2(l0, l1), pk2(l2, l3)};
            *(u32x2*)(S0all + unit * 4096 + (16 * vs + lc) * 64 + 16 * jr + 4 * g) = (u32x2){h0, h1};
            __syncthreads();
            f32x4 a2 = Lf[s];
#pragma unroll
            for (int ks = 0; ks < 2; ++ks) { const bf16x8 bh = *(const LAS bf16x8*)(xb + lc * BLD + (32 * ks + 8 * g) * 2), bl = *(const LAS bf16x8*)(xb + 4096 + lc * BLD + (32 * ks + 8 * g) * 2);
                a2 = MFMA16(Gf[s][ks], bh, a2); a2 = MFMA16(Gf[s][ks], bl, a2); }
            acc = a2;
            if (c + PF < NSTEP) SB_ISSUE(s, c + PF);
        } }
    }
    *(f32x4*)(outp_state + (16 * vs + lc) * 64 + 16 * jr + 4 * g) = acc;
#undef SB_ISSUE
}

__device__ __forceinline__ void scanC_unit(int l, LAS unsigned char* lds, int unit, int tid, int wave) {
    unsigned char* ws = KWS();
    const int lane = tid & 63, ci = unit >> 4, h = unit & 15, cc = 64 * h + lane;
    int m0, n; if (ci < 256) { m0 = 64 * ci; n = 64; } else { m0 = TP + 32 * (ci - 256); n = 32; }
    const int rb = wave >> 1, cb0 = (wave & 1) * 2, g = lane >> 4, lc = lane & 15;
    const bf16* RPg = (const bf16*)(ws + SC_RP) + (size_t)unit * 4096; const float* YLg = (const float*)(ws + SC_YL) + (size_t)unit * 4096; const bf16* S0g = (const bf16*)(ws + SC_S0) + (size_t)unit * 4096;
    LAS float* Yl = (LAS float*)lds;
    f32x4 acc[2];
#pragma unroll
    for (int c = 0; c < 2; ++c)
#pragma unroll
        for (int rg = 0; rg < 4; ++rg) acc[c][rg] = YLg[(16 * rb + 4 * g + rg) * 64 + 16 * (cb0 + c) + lc];
#pragma unroll
    for (int ks = 0; ks < 2; ++ks) { const bf16x8 fa = *(const bf16x8*)(RPg + (16 * rb + lc) * 64 + 32 * ks + 8 * g);
#pragma unroll
        for (int c = 0; c < 2; ++c) acc[c] = MFMA16(fa, *(const bf16x8*)(S0g + (16 * (cb0 + c) + lc) * 64 + 32 * ks + 8 * g), acc[c]); }
    __syncthreads();
#pragma unroll
    for (int c = 0; c < 2; ++c)
#pragma unroll
        for (int rg = 0; rg < 4; ++rg) Yl[(16 * rb + 4 * g + rg) * 65 + 16 * (cb0 + c) + lc] = acc[c][rg];
    __syncthreads();
    const int t0 = 8 * wave;
    if (t0 < n) {
        const float* P = (const float*)(ws + B_P); const float* Gg = (const float*)(ws + WS_RW + 2 * RWSZ); bf16* MIXB = (bf16*)(ws + B_MIX); const float* bon = (const float*)(ws + SC_BON) + (size_t)unit * 64;
        const float mu_v = (KIN(I_MU) + (size_t)l * SHIFT)[2 * RW + cc], gng = (KIN(I_GNG) + (size_t)l * RW)[cc], gnb = (KIN(I_GNB) + (size_t)l * RW)[cc];
        const float* pp = prev_row(KIN(I_SSH), l, P, m0 + t0); float q_v = pp ? pp[2 * RW + cc] : 0.f;
        float pv_[8], gt_[8], bn_[8];
#pragma unroll
        for (int i = 0; i < 8; ++i) { const size_t m = (size_t)(m0 + t0 + i); pv_[i] = P[m * PLD + 2 * RW + cc]; gt_[i] = Gg[m * RW + cc]; bn_[i] = bon[t0 + i]; }
        unsigned short ov[8];
#pragma unroll
        for (int i = 0; i < 8; ++i) { const int t = t0 + i;
            const float y = Yl[t * 65 + lane]; const float ym = wave_sum(y) * (1.f / HN); const float d = y - ym; const float yv = wave_sum(d * d) * (1.f / HN);
            const float yn = d * (1.f / sqrtf(yv + GN_EPS)) * gng + gnb;
            const float p_v = pv_[i]; const float vx = p_v + (q_v - p_v) * mu_v; q_v = p_v;
            ov[i] = (unsigned short)f2bf((yn + bn_[i] * vx) * gt_[i]); }
#pragma unroll
        for (int i = 0; i < 8; ++i) MIXB[(size_t)(m0 + t0 + i) * DM + cc] = (bf16)ov[i];
    }
}

template <int PH> __global__ void __launch_bounds__(NTHR, 2) mk_fwd(Args a) {
    extern __shared__ __attribute__((aligned(16))) unsigned char lds_raw[];
    LAS unsigned char* lds = (LAS unsigned char*)lds_raw;
    const int wave_s = __builtin_amdgcn_readfirstlane((int)threadIdx.x >> 6);
    for (int u = threadIdx.x; u < (LDS_BYTES - LDSCTL_OFF) / 4; u += NTHR) ((LAS unsigned*)(lds + LDSCTL_OFF))[u] = 0u;
    __syncthreads();
    if (PH < 0) (void)xcd_barrier_post((unsigned*)KWS() + CW_BAR, (volatile LAS unsigned*)(lds + MISC_OFF) + 8, (int)threadIdx.x);
#define IN(k) (PH < 0 || PH == (k))
#define PHASE_IDS() int tid_; asm volatile("v_mbcnt_lo_u32_b32 %0, -1, 0\n\tv_mbcnt_hi_u32_b32 %0, -1, %0\n\tv_lshl_add_u32 %0, %1, 6, %0" : "=&v"(tid_) : "s"(wave_s)); const int tid = tid_, lane = tid & 63, wave = wave_s; \
    const int G = gridDim.x, bx = blockIdx.x, vcu = (G % 8 == 0) ? (bx % 8) * (G / 8) + bx / 8 : bx, gw = vcu * NWAVES + wave, NGW = G * NWAVES; unsigned char* ws = KWS(); (void)tid; (void)lane; (void)gw; (void)NGW; (void)ws
#define SEAM() do { if (PH < 0) { XcdBarrier bar_; bar_.bar = (unsigned*)KWS() + CW_BAR; bar_.x = xb_xcc_id(); bar_.st = (volatile LAS unsigned*)(lds + MISC_OFF) + 8; xcd_barrier(bar_, tid); } } while (0)

    for (int l = a.l_lo; l < a.l_hi; ++l) {
        if (IN(0)) { PHASE_IDS(); phase_convert(l, lds, wave, lane, gw, NGW); SEAM(); }
        if (IN(1)) { PHASE_IDS(); pg8::Gemm g{(const bf16*)(ws + WS_XB), (const bf16*)(ws + W_1), M, 2 * FF, DM, DM}; pg8::StaticOrder S; S.init(M, 2 * FF, G, bx); pg8::EpiSwiGLU E{(bf16*)(ws + B_H), FF};
            pg8::gemm_phase<pg8::EpiSwiGLU, pg8::StaticOrder, true, true>(lds + RING_OFF, g, S, E, tid); SEAM(); }
        if (IN(2)) { PHASE_IDS();
            { pg8::Gemm g{(const bf16*)(ws + B_H), (const bf16*)(ws + W_2), TP, DM, FF, FF}; pg8::StaticOrder S; S.init(TP, DM, G, bx); pg8::EpiResid E{(const float*)(ws + WS_X), (float*)(ws + WS_Z), DM, ALPHA, 0.5f};
              pg8::gemm_phase<pg8::EpiResid, pg8::StaticOrder, true, true>(lds + RING_OFF, g, S, E, tid); }
            { pg8::Gemm g{(const bf16*)(ws + B_H), (const bf16*)(ws + W_2), M, DM, FF, 512}; pg8::SplitOrder S{G, bx, 11, 512}; pg8::EpiSlab E{(float*)(ws + WS_SLAB), 512};
              pg8::gemm_phase<pg8::EpiSlab, pg8::SplitOrder, false, true>(lds + RING_OFF, g, S, E, tid); }
            SEAM(); }
        if (IN(3)) { PHASE_IDS(); phase_ln((const float*)(ws + WS_Z), (const float*)(ws + WS_X), (const float*)(ws + WS_SLAB), 11, ALPHA, 0.5f, KIN(I_LNG) + (size_t)l * 3 * DM, KIN(I_LNB) + (size_t)l * 3 * DM, (float*)(ws + WS_X), (bf16*)(ws + WS_XB), lane, gw, NGW); SEAM(); }
        if (IN(4)) { PHASE_IDS(); pg8::Gemm g{(const bf16*)(ws + WS_XB), (const bf16*)(ws + W_3), M, N3, DM, DM}; pg8::StaticOrder S; S.init(M, N3, G, bx); pg8::EpiP E{(float*)(ws + B_P), (bf16*)(ws + B_U), (float*)(ws + B_GV)};
            pg8::gemm_phase<pg8::EpiP, pg8::StaticOrder, true, true>(lds + RING_OFF, g, S, E, tid); SEAM(); }
        if (IN(5)) { PHASE_IDS(); phase_prep1(l, lane, gw, NGW); SEAM(); }
        if (IN(6)) { PHASE_IDS(); pg8::Gemm g{(const bf16*)(ws + B_A3B), (const bf16*)(ws + W_3B), M, NL, LK, LK}; pg8::StaticOrder S; S.init(M, NL, G, bx);
            pg8::EpiLora E{(float*)(ws + WS_RW)};
            pg8::gemm_phase<pg8::EpiLora, pg8::StaticOrder, false, false>(lds + RING_OFF, g, S, E, tid); SEAM(); }
        if (IN(7)) { PHASE_IDS(); for (int u = bx; u < NUNIT; u += G) scanA_unit(l, lds, u, tid, wave); SEAM(); }
        if (IN(8)) { PHASE_IDS();
            if (bx < 32) { const int task = 2 * bx + (wave >> 2), hh = task >> 2; scanB_chain<256, 8>(l, lds, 0, hh, task & 3, nullptr, KOUT() + O_SP + ((size_t)l * NH + hh) * 4096, tid, wave); }
            else { const float* srw = KIN(I_SRW); float* outp = KOUT();
                for (int p = bx - 32; p < 512; p += G - 32) { const int task = 2 * p + (wave >> 2), b = task >> 6, hh = (task >> 2) & 15; const size_t so = (((size_t)l * NSB + b) * NH + hh) * 4096;
                    scanB_chain<1, 1>(l, lds, 256 + b, hh, task & 3, srw + so, outp + O_SS + so, tid, wave); }
                for (int u = bx - 32; u < 144 * 8; u += G - 32) gmlp_unit(l, lds, u, tid); }
            SEAM(); }
        if (IN(9)) { PHASE_IDS(); for (int u = bx; u < NUNIT; u += G) scanC_unit(l, lds, u, tid, wave); SEAM(); }
        if (IN(10)) { PHASE_IDS();
            { pg8::Gemm g{(const bf16*)(ws + B_MIX), (const bf16*)(ws + W_4), TP, DM, DM, DM}; pg8::StaticOrder S; S.init(TP, DM, G, bx); pg8::EpiResid E{(const float*)(ws + WS_X), (float*)(ws + WS_Z), DM, ALPHA, 1.0f};
              pg8::gemm_phase<pg8::EpiResid, pg8::StaticOrder, true, true>(lds + RING_OFF, g, S, E, tid); }
            { pg8::Gemm g{(const bf16*)(ws + B_MIX), (const bf16*)(ws + W_4), M, DM, DM, 256}; pg8::SplitOrder S{G, bx, 8, 256}; pg8::EpiSlab E{(float*)(ws + WS_SLAB), 256};
              pg8::gemm_phase<pg8::EpiSlab, pg8::SplitOrder, false, true>(lds + RING_OFF, g, S, E, tid); }
            SEAM(); }
        if (IN(11)) { PHASE_IDS(); phase_ln((const float*)(ws + WS_Z), (const float*)(ws + WS_X), (const float*)(ws + WS_SLAB), 8, ALPHA, 1.0f, KIN(I_LNG) + (size_t)(l * 3 + 1) * DM, KIN(I_LNB) + (size_t)(l * 3 + 1) * DM, (float*)(ws + WS_X), (bf16*)(ws + WS_XB), lane, gw, NGW); SEAM(); }
        if (IN(12)) { PHASE_IDS(); pg8::Gemm g{(const bf16*)(ws + WS_XB), (const bf16*)(ws + W_5), M, 2 * FF, DM, DM}; pg8::StaticOrder S; S.init(M, 2 * FF, G, bx); pg8::EpiSwiGLU E{(bf16*)(ws + B_H), FF};
            pg8::gemm_phase<pg8::EpiSwiGLU, pg8::StaticOrder, true, true>(lds + RING_OFF, g, S, E, tid); SEAM(); }
        if (IN(13)) { PHASE_IDS();
            { pg8::Gemm g{(const bf16*)(ws + B_H), (const bf16*)(ws + W_6), TP, DM, FF, FF}; pg8::StaticOrder S; S.init(TP, DM, G, bx); pg8::EpiResid E{(const float*)(ws + WS_X), (float*)(ws + WS_Z), DM, ALPHA, 0.5f};
              pg8::gemm_phase<pg8::EpiResid, pg8::StaticOrder, true, true>(lds + RING_OFF, g, S, E, tid); }
            { pg8::Gemm g{(const bf16*)(ws + B_H), (const bf16*)(ws + W_6), M, DM, FF, 512}; pg8::SplitOrder S{G, bx, 11, 512}; pg8::EpiSlab E{(float*)(ws + WS_SLAB), 512};
              pg8::gemm_phase<pg8::EpiSlab, pg8::SplitOrder, false, true>(lds + RING_OFF, g, S, E, tid); }
            SEAM(); }
        if (IN(14)) { PHASE_IDS(); const bool last = (l == DEPTH - 1);
            phase_ln((const float*)(ws + WS_Z), (const float*)(ws + WS_X), (const float*)(ws + WS_SLAB), 11, ALPHA, 0.5f, KIN(I_LNG) + (size_t)(l * 3 + 2) * DM, KIN(I_LNB) + (size_t)(l * 3 + 2) * DM, last ? KOUT() + O_YP : (float*)(ws + WS_X), last ? (bf16*)nullptr : (bf16*)(ws + WS_XB), lane, gw, NGW);
            if (!last) SEAM(); }
    }
#undef IN
#undef SEAM
#undef PHASE_IDS
}

template <int PH> static bool prep_kernel() { return hipFuncSetAttribute((const void*)mk_fwd<PH>, hipFuncAttributeMaxDynamicSharedMemorySize, LDS_BYTES) == hipSuccess; }
template <int PH> static void launch_phase(int grid, hipStream_t stream, Args a) { hipLaunchKernelGGL(mk_fwd<PH>, dim3(grid), dim3(NTHR), LDS_BYTES, stream, a); }
extern "C" void kernel_launch(void* const* d_in, const int* in_sizes, int n_in, void* d_out, int out_size, void* d_ws, size_t ws_size, hipStream_t stream) {
    static int grid = 0;
    if (grid == 0) {
        if (n_in != 29 || (size_t)out_size != O_END || ws_size < WS_END) { fprintf(stderr, "kernel_launch: unexpected shapes: n_in %d out %d ws %zu (need %zu)\n", n_in, out_size, ws_size, (size_t)WS_END); grid = -1; return; }
        int dev = 0, cus = 0, per_cu = 0;
        if (hipGetDevice(&dev) != hipSuccess || hipDeviceGetAttribute(&cus, hipDeviceAttributeMultiprocessorCount, dev) != hipSuccess) { grid = -1; return; }
        bool ok = true;
#if MK_ONE_LAUNCH
        ok = prep_kernel<-1>();
        if (hipOccupancyMaxActiveBlocksPerMultiprocessor(&per_cu, (const void*)mk_fwd<-1>, NTHR, LDS_BYTES) != hipSuccess || per_cu < 1) fprintf(stderr, "kernel_launch: occupancy query says %d\n", per_cu);
#else
        ok = prep_kernel<0>() && prep_kernel<1>() && prep_kernel<2>() && prep_kernel<3>() && prep_kernel<4>() && prep_kernel<5>() && prep_kernel<6>() && prep_kernel<7>() && prep_kernel<8>() && prep_kernel<9>() && prep_kernel<10>() && prep_kernel<11>() && prep_kernel<12>() && prep_kernel<13>() && prep_kernel<14>();
#endif
        if (!ok) { fprintf(stderr, "kernel_launch: hipFuncSetAttribute failed\n"); grid = -1; return; }
        (void)hipGetLastError();
        grid = cus;
        if (grid < 64) { grid = -1; return; }
    }
    if (grid < 0) return;
    (void)hipMemsetAsync((char*)d_ws + WS_CTL, 0, CTL_ZERO_BYTES, stream);
    Args a{};
    for (int i = 0; i < 29; ++i) a.in[i] = (const float*)d_in[i];
    a.out = (float*)d_out; a.ws = (unsigned char*)d_ws;
#if MK_ONE_LAUNCH
    a.l_lo = 0; a.l_hi = DEPTH;
    launch_phase<-1>(grid, stream, a);
#else
    for (int l = 0; l < DEPTH; ++l) { a.l_lo = l; a.l_hi = l + 1;
        launch_phase<0>(grid, stream, a); launch_phase<1>(grid, stream, a); launch_phase<2>(grid, stream, a); launch_phase<3>(grid, stream, a); launch_phase<4>(grid, stream, a);
        launch_phase<5>(grid, stream, a); launch_phase<6>(grid, stream, a); launch_phase<7>(grid, stream, a); launch_phase<8>(grid, stream, a); launch_phase<9>(grid, stream, a);
        launch_phase<10>(grid, stream, a); launch_phase<11>(grid, stream, a); launch_phase<12>(grid, stream, a); launch_phase<13>(grid, stream, a); launch_phase<14>(grid, stream, a); }
#endif
}
```

```cpp
#include <hip/hip_runtime.h>
#include <cstdio>
#include <cstdint>
#define MK_ONE_LAUNCH 1
namespace pg8 {
#define PG8_LAS __attribute__((address_space(3)))
typedef unsigned short bf16_t;
typedef short bf16x8 __attribute__((ext_vector_type(8)));
typedef float f32x4 __attribute__((ext_vector_type(4)));
typedef unsigned u32x4 __attribute__((ext_vector_type(4)));
constexpr int BM = 256, BK = 64, HALF = 128, HTB = HALF * BK * 2  , STAGE_BYTES = 8 * HTB, NXCD = 8, WGM = 8;

__host__ __device__ __forceinline__ int lds_byte(int r, int c) { const int st = (r >> 4) * 2 + (c >> 5), rr = r & 15, cc = c & 31, ob = rr * 64 + cc * 2; return st * 1024 + (ob ^ (((ob >> 9) & 1) << 5)); }
__host__ __device__ __forceinline__ void stage_rc(int b, int& R, int& C) { const int st = b / 1024, sb = b % 1024, swz = sb ^ (((sb >> 9) & 1) << 5); R = (st >> 1) * 16 + swz / 64; C = (st & 1) * 32 + (swz % 64) / 2; }
__host__ __device__ __forceinline__ int perm32(int rho) { const int n = rho >> 4, i = rho & 15; return 8 * (i >> 2) + 4 * n + (i & 3); }

struct Unit { int pm, pn, k0; };
struct Gemm { const bf16_t* A; const bf16_t* Bt; int M, N, K, Kl; };

struct StaticOrder {
    int nM, nN, nwg, G, c;
    __host__ __device__ void init(int M, int N, int G_, int c_) { nM = M / BM; nN = N / BM; nwg = nM * nN; G = G_; c = c_; }
    __host__ __device__ bool next(int i, Unit& u) const {
        const long L = (long)i * G + c; if (L >= nwg) return false;
        int wgid = (int)L; { const int q = nwg / NXCD, r = nwg % NXCD, xcd = wgid % NXCD, off = wgid / NXCD; wgid = (xcd < r ? xcd * (q + 1) : r * (q + 1) + (xcd - r) * q) + off; }
        const int nig = WGM * nN, gid = wgid / nig, fm = gid * WGM, gsz = (nM - fm) < WGM ? (nM - fm) : WGM;
        u.pm = fm + ((wgid % nig) % gsz); u.pn = (wgid % nig) / gsz; u.k0 = 0; return true;
    }
    __device__ __forceinline__ void a_ready(const Unit&) const {}
    __device__ __forceinline__ void done(const Unit&) const {}
};
struct SplitOrder {
    int G, c, KS, Kl;
    __host__ __device__ bool next(int i, Unit& u) const { const int L = i * G + c; if (L >= 16 * KS) return false; const int ks = L >> 4, tile = L & 15; u.pm = 64 + (tile >> 3); u.pn = tile & 7; u.k0 = ks * Kl; return true; }
    __device__ __forceinline__ void a_ready(const Unit&) const {}
    __device__ __forceinline__ void done(const Unit&) const {}
};
__device__ __forceinline__ unsigned cvt_pk_bf16(float lo, float hi) { unsigned r; asm volatile("v_cvt_pk_bf16_f32 %0, %1, %2" : "=v"(r) : "v"(lo), "v"(hi)); return r; }
typedef float f32x2 __attribute__((ext_vector_type(2)));
__device__ __forceinline__ f32x2 gelu_pk(f32x2 v) {
    const f32x2 av = __builtin_elementwise_abs(v), d = av * 0.2316418882f + 1.0f;
    f32x2 t; t.x = __builtin_amdgcn_rcpf(d.x); t.y = __builtin_amdgcn_rcpf(d.y);
    f32x2 q = t * 0.5307027145f + (-0.7265760135f); q = q * t + 0.7107068705f; q = q * t + (-0.142248368f); q = q * t + 0.127414796f; q = q * t;
    const f32x2 s = (v * v) * (-0.72134752044f);
    f32x2 e; e.x = __builtin_amdgcn_exp2f(s.x); e.y = __builtin_amdgcn_exp2f(s.y);
    const f32x2 m = v * (q * e), r = v - m;
    f32x2 o; o.x = v.x < 0.f ? m.x : r.x; o.y = v.y < 0.f ? m.y : r.y; return o;
}

typedef unsigned u32x2 __attribute__((ext_vector_type(2)));
__device__ __forceinline__ float silu_f(float g) { return g * __builtin_amdgcn_rcpf(1.0f + __expf(-g)); }
struct EpiSwiGLU {
    static constexpr bool PERM = true, AFTER_DRAIN = false;
    bf16_t* O; int ldc;
    __device__ __forceinline__ void operator()(const f32x4 (&acc)[2][2][4][2], const Unit& u, int wr, int wc, int fr, int fq) const {
        const int row0 = u.pm * BM + wr * 64 + fr, col0 = u.pn * HALF + wc * 32 + 8 * fq;
#pragma unroll
        for (int ai = 0; ai < 2; ++ai)
#pragma unroll
            for (int m = 0; m < 4; ++m) { bf16_t* rowp = O + (size_t)(row0 + ai * HALF + m * 16) * ldc + col0;
                const f32x4 g0 = acc[ai][0][m][0], g1 = acc[ai][0][m][1], u0 = acc[ai][1][m][0], u1 = acc[ai][1][m][1];
                u32x4 w; w.x = cvt_pk_bf16(silu_f(g0[0]) * u0[0], silu_f(g0[1]) * u0[1]); w.y = cvt_pk_bf16(silu_f(g0[2]) * u0[2], silu_f(g0[3]) * u0[3]);
                w.z = cvt_pk_bf16(silu_f(g1[0]) * u1[0], silu_f(g1[1]) * u1[1]); w.w = cvt_pk_bf16(silu_f(g1[2]) * u1[2], silu_f(g1[3]) * u1[3]);
                *(u32x4*)rowp = w; }
    }
};
struct EpiResid {
    static constexpr bool PERM = false, AFTER_DRAIN = false;
    const float* base; float* out; int ldc; float sa, sb;
    __device__ __forceinline__ void operator()(const f32x4 (&acc)[2][2][4][2], const Unit& u, int wr, int wc, int fr, int fq) const {
        const int row0 = u.pm * BM + wr * 64 + fr, col0 = u.pn * BM + wc * 32 + 4 * fq;
#pragma unroll
        for (int ai = 0; ai < 2; ++ai)
#pragma unroll
            for (int m = 0; m < 4; ++m) { const size_t off = (size_t)(row0 + ai * HALF + m * 16) * ldc + col0;
#pragma unroll
                for (int bj = 0; bj < 2; ++bj)
#pragma unroll
                    for (int n = 0; n < 2; ++n) { const f32x4 b = *(const f32x4*)(base + off + bj * HALF + n * 16); *(f32x4*)(out + off + bj * HALF + n * 16) = b * sa + acc[ai][bj][m][n] * sb; } }
    }
};
struct EpiSlab {
    static constexpr bool PERM = false, AFTER_DRAIN = false;
    float* slab; int Kl;
    __device__ __forceinline__ void operator()(const f32x4 (&acc)[2][2][4][2], const Unit& u, int wr, int wc, int fr, int fq) const {
        const int row0 = (u.pm - 64) * BM + wr * 64 + fr, col0 = u.pn * BM + wc * 32 + 4 * fq; float* O = slab + (size_t)(u.k0 / Kl) * (512 * 2048);
#pragma unroll
        for (int ai = 0; ai < 2; ++ai)
#pragma unroll
            for (int m = 0; m < 4; ++m) { float* rowp = O + (size_t)(row0 + ai * HALF + m * 16) * 2048 + col0;
#pragma unroll
                for (int bj = 0; bj < 2; ++bj)
#pragma unroll
                    for (int n = 0; n < 2; ++n) *(f32x4*)(rowp + bj * HALF + n * 16) = acc[ai][bj][m][n]; }
    }
};
struct EpiP {
    static constexpr bool PERM = false, AFTER_DRAIN = false;
    float* P; bf16_t* U; float* GV;
    __device__ __forceinline__ void operator()(const f32x4 (&acc)[2][2][4][2], const Unit& u, int wr, int wc, int fr, int fq) const {
        const int row0 = u.pm * BM + wr * 64 + fr, cw = wc * 32 + 4 * fq;
        const int kind = u.pn < 14 ? 0 : (u.pn < 18 ? 1 : 2);
        float* F = kind == 0 ? P + u.pn * BM + cw : GV + (u.pn - 18) * BM + cw; const int ldf = kind == 0 ? 3584 : 1024;
        bf16_t* Ub = U + (u.pn - 14) * BM + cw;
#pragma unroll
        for (int ai = 0; ai < 2; ++ai)
#pragma unroll
            for (int m = 0; m < 4; ++m) { const size_t row = (size_t)(row0 + ai * HALF + m * 16);
#pragma unroll
                for (int bj = 0; bj < 2; ++bj)
#pragma unroll
                    for (int n = 0; n < 2; ++n) { f32x4 v = acc[ai][bj][m][n];
                        if (kind != 0) { const f32x2 a = gelu_pk((f32x2){v[0], v[1]}), b = gelu_pk((f32x2){v[2], v[3]}); v = (f32x4){a.x, a.y, b.x, b.y}; }
                        if (kind == 1) { u32x2 w; w.x = cvt_pk_bf16(v[0], v[1]); w.y = cvt_pk_bf16(v[2], v[3]); *(u32x2*)(Ub + row * 1024 + bj * HALF + n * 16) = w; }
                        else *(f32x4*)(F + row * ldf + bj * HALF + n * 16) = v; }
                asm volatile("" ::: "memory"); }
    }
};
struct EpiLora {
    static constexpr bool PERM = false, AFTER_DRAIN = false;
    float* base;
    __device__ __forceinline__ void operator()(const f32x4 (&acc)[2][2][4][2], const Unit& u, int wr, int wc, int fr, int fq) const {
        const int row0 = u.pm * BM + wr * 64 + fr, kind = u.pn >> 2, cb = (u.pn & 3) * BM + wc * 32 + 4 * fq;
        float* O = base + (size_t)kind * ((size_t)66 << 18) + cb;
#pragma unroll
        for (int ai = 0; ai < 2; ++ai)
#pragma unroll
            for (int m = 0; m < 4; ++m) { float* rowp = O + (size_t)(row0 + ai * HALF + m * 16) * 1024;
#pragma unroll
                for (int bj = 0; bj < 2; ++bj)
#pragma unroll
                    for (int n = 0; n < 2; ++n) *(f32x4*)(rowp + bj * HALF + n * 16) = acc[ai][bj][m][n]; }
    }
};
template <class Epi, class Sched, bool ALIGN_EPI = false, bool SP2 = false>
__device__ __forceinline__ void gemm_phase(PG8_LAS unsigned char* lds, const Gemm g, const Sched& S, const Epi& E, int tid_in) {
    int tid_ = tid_in; asm volatile("" : "+v"(tid_));
    const int tid = tid_, wid = __builtin_amdgcn_readfirstlane(tid >> 6), lane = tid & 63, wr = wid >> 2, wc = wid & 3, fr = lane & 15, fq = lane >> 4;
    const int K = g.K, nt = g.Kl / BK;
    unsigned voffA[2], voffB[2];
#pragma unroll
    for (int i = 0; i < 2; ++i) { int R, C; stage_rc(tid * 16 + i * 8192, R, C); const int Rb = Epi::PERM ? ((R & ~31) + perm32(R & 31)) : R;
        voffA[i] = (unsigned)(R * K + C) * 2u; voffB[i] = (unsigned)(Rb * K + C) * 2u; }
    const size_t kstep = (size_t)(BK * 2);
    const size_t hstep = (size_t)HALF * K * 2;
    const size_t tstep = 2 * hstep;
    const unsigned ldsw = (unsigned)wid * 1024u;
    const int aoff = lds_byte(wr * 64 + fr, fq * 8), boff = lds_byte(wc * 32 + fr, fq * 8);
#define PG8_SA(b, h) (((b) * 2 + (h)) * HTB)
#define PG8_SB(b, h) ((4 + (b) * 2 + (h)) * HTB)
#define PG8_STAGE(bufoff, gbase, voff) do { _Pragma("unroll") for (int _i = 0; _i < 2; ++_i) \
        __builtin_amdgcn_global_load_lds((const unsigned*)((const char*)(gbase) + (voff)[_i]), (PG8_LAS unsigned*)(lds + (bufoff) + ldsw + _i * 8192), 16, 0, 0); } while (0)
#define PG8_LDA(dst, b, h) do { _Pragma("unroll") for (int m = 0; m < 4; ++m) _Pragma("unroll") for (int k = 0; k < 2; ++k) dst[m][k] = *(const PG8_LAS bf16x8*)(lds + PG8_SA(b, h) + aoff + m * 2048 + k * 1024); } while (0)
#define PG8_LDB(dst, b, h) do { _Pragma("unroll") for (int n = 0; n < 2; ++n) _Pragma("unroll") for (int k = 0; k < 2; ++k) dst[n][k] = *(const PG8_LAS bf16x8*)(lds + PG8_SB(b, h) + boff + n * 2048 + k * 1024); } while (0)
#define PG8_MMA(ai, bj, At, Bt) do { __builtin_amdgcn_s_setprio(1); _Pragma("unroll") for (int m = 0; m < 4; ++m) _Pragma("unroll") for (int n = 0; n < 2; ++n) _Pragma("unroll") for (int k = 0; k < 2; ++k) \
        acc[ai][bj][m][n] = __builtin_amdgcn_mfma_f32_16x16x32_bf16(Bt[n][k], At[m][k], acc[ai][bj][m][n], 0, 0, 0); __builtin_amdgcn_s_setprio(0); } while (0)
#define PG8_WAIT_V(n) asm volatile("s_waitcnt vmcnt(" #n ")" ::: "memory")
#define PG8_WAIT_L(n) asm volatile("s_waitcnt lgkmcnt(" #n ")" ::: "memory")
#define PG8_BAR __builtin_amdgcn_s_barrier()
#define PG8_SCHED __builtin_amdgcn_sched_barrier(0)
    Unit cur, nxt; int ui = 0;
    if (!S.next(0, cur)) return;
    f32x4 acc[2][2][4][2];
    float zz0; asm volatile("v_mov_b32 %0, 0" : "=v"(zz0));
#pragma unroll
    for (int a = 0; a < 2; ++a)
#pragma unroll
        for (int b = 0; b < 2; ++b)
#pragma unroll
            for (int m = 0; m < 4; ++m)
#pragma unroll
                for (int n = 0; n < 2; ++n) acc[a][b][m][n] = (f32x4){zz0, zz0, zz0, zz0};
    bf16x8 At[4][2], B0[2][2], B1[2][2];
    const char* cA = (const char*)g.A + (size_t)cur.pm * tstep + (size_t)cur.k0 * 2; const char* cB = (const char*)g.Bt + (size_t)cur.pn * tstep + (size_t)cur.k0 * 2;
    S.a_ready(cur);
    if constexpr (SP2) {
        PG8_STAGE(PG8_SB(0, 0), cB, voffB); PG8_STAGE(PG8_SB(0, 1), cB + hstep, voffB); PG8_STAGE(PG8_SA(0, 0), cA, voffA); PG8_STAGE(PG8_SA(0, 1), cA + hstep, voffA);
        if (wr == 1) PG8_BAR;
        PG8_WAIT_V(2); PG8_BAR;
        PG8_STAGE(PG8_SB(1, 0), cB + kstep, voffB); PG8_STAGE(PG8_SA(1, 0), cA + kstep, voffA); PG8_STAGE(PG8_SB(1, 1), cB + hstep + kstep, voffB);
        PG8_WAIT_V(6); PG8_BAR;
    } else {
        PG8_STAGE(PG8_SB(0, 0), cB, voffB); PG8_STAGE(PG8_SA(0, 0), cA, voffA); PG8_STAGE(PG8_SB(0, 1), cB + hstep, voffB); PG8_STAGE(PG8_SA(0, 1), cA + hstep, voffA);
        if (wr == 1) PG8_BAR;
        PG8_WAIT_V(4); PG8_BAR;
        PG8_STAGE(PG8_SB(1, 0), cB + kstep, voffB); PG8_STAGE(PG8_SA(1, 0), cA + kstep, voffA); PG8_STAGE(PG8_SB(1, 1), cB + hstep + kstep, voffB);
        PG8_WAIT_V(6); PG8_BAR;
    }
    for (;;) {
        const bool has_next = S.next(ui + 1, nxt);
        const char* nA = has_next ? (const char*)g.A + (size_t)nxt.pm * tstep + (size_t)nxt.k0 * 2 : cA; const char* nB = has_next ? (const char*)g.Bt + (size_t)nxt.pn * tstep + (size_t)nxt.k0 * 2 : cB;
        for (int t = 0; t < nt; t += 2) {
            const bool last = (t == nt - 2);
            const char* a1 = cA + (size_t)(t + 1) * kstep;
            const char* a2 = last ? nA : cA + (size_t)(t + 2) * kstep; const char* b2 = last ? nB : cB + (size_t)(t + 2) * kstep;
            const char* a3 = a2 + kstep; const char* b3 = b2 + kstep;
            if (last && has_next) S.a_ready(nxt);
            if constexpr (SP2) {
            PG8_LDB(B0, 0, 0); PG8_LDB(B1, 0, 1); PG8_SCHED; PG8_LDA(At, 0, 0); PG8_STAGE(PG8_SA(1, 1), a1 + hstep, voffA);
            PG8_WAIT_V(8); PG8_WAIT_L(0); PG8_BAR; PG8_MMA(0, 0, At, B0); PG8_MMA(0, 1, At, B1); PG8_BAR; PG8_SCHED;
            PG8_LDA(At, 0, 1); PG8_STAGE(PG8_SB(0, 0), b2, voffB); PG8_STAGE(PG8_SB(0, 1), b2 + hstep, voffB); PG8_STAGE(PG8_SA(0, 0), a2, voffA);
            PG8_WAIT_V(8); PG8_WAIT_L(0); PG8_BAR; PG8_MMA(1, 0, At, B0); PG8_MMA(1, 1, At, B1); PG8_BAR; PG8_SCHED;
            PG8_LDB(B0, 1, 0); PG8_LDB(B1, 1, 1); PG8_SCHED; PG8_LDA(At, 1, 0); PG8_STAGE(PG8_SA(0, 1), a2 + hstep, voffA);
            PG8_WAIT_V(8); PG8_WAIT_L(0); PG8_BAR; PG8_MMA(0, 0, At, B0); PG8_MMA(0, 1, At, B1); PG8_BAR; PG8_SCHED;
            PG8_LDA(At, 1, 1); PG8_STAGE(PG8_SB(1, 0), b3, voffB); PG8_STAGE(PG8_SB(1, 1), b3 + hstep, voffB); PG8_STAGE(PG8_SA(1, 0), a3, voffA);
            PG8_WAIT_V(8); PG8_WAIT_L(0); PG8_BAR; PG8_MMA(1, 0, At, B0); PG8_MMA(1, 1, At, B1); PG8_BAR; PG8_SCHED;
            } else {
            PG8_LDB(B0, 0, 0); PG8_SCHED; PG8_LDA(At, 0, 0); PG8_STAGE(PG8_SA(1, 1), a1 + hstep, voffA);
            PG8_WAIT_L(8); PG8_BAR; PG8_WAIT_L(0); PG8_MMA(0, 0, At, B0); PG8_BAR; PG8_SCHED;
            PG8_LDB(B1, 0, 1); PG8_STAGE(PG8_SB(0, 0), b2, voffB);
            PG8_BAR; PG8_WAIT_L(0); PG8_MMA(0, 1, At, B1); PG8_BAR;
            PG8_LDA(At, 0, 1); PG8_STAGE(PG8_SA(0, 0), a2, voffA);
            PG8_BAR; PG8_WAIT_L(0); PG8_MMA(1, 0, At, B0); PG8_BAR; PG8_SCHED;
            PG8_STAGE(PG8_SB(0, 1), b2 + hstep, voffB);
            PG8_WAIT_V(6); PG8_BAR; PG8_MMA(1, 1, At, B1); PG8_BAR;
            PG8_LDB(B0, 1, 0); PG8_SCHED; PG8_LDA(At, 1, 0); PG8_STAGE(PG8_SA(0, 1), a2 + hstep, voffA);
            PG8_WAIT_L(8); PG8_BAR; PG8_WAIT_L(0); PG8_MMA(0, 0, At, B0); PG8_BAR; PG8_SCHED;
            PG8_LDB(B1, 1, 1); PG8_STAGE(PG8_SB(1, 0), b3, voffB);
            PG8_BAR; PG8_WAIT_L(0); PG8_MMA(0, 1, At, B1); PG8_BAR;
            PG8_LDA(At, 1, 1); PG8_STAGE(PG8_SA(1, 0), a3, voffA);
            PG8_BAR; PG8_WAIT_L(0); PG8_MMA(1, 0, At, B0); PG8_BAR; PG8_SCHED;
            PG8_STAGE(PG8_SB(1, 1), b3 + hstep, voffB);
            PG8_WAIT_V(6); PG8_BAR; PG8_MMA(1, 1, At, B1); PG8_BAR;
            }
        }
        if constexpr (ALIGN_EPI) { if (wr == 0) PG8_BAR; }
        if constexpr (!Epi::AFTER_DRAIN) { E(acc, cur, wr, wc, fr, fq); S.done(cur); }
        if (!has_next) break;
{ float zz1; asm volatile("v_mov_b32 %0, 0" : "=v"(zz1));
#pragma unroll
        for (int a = 0; a < 2; ++a)
#pragma unroll
            for (int b = 0; b < 2; ++b)
#pragma unroll
                for (int m = 0; m < 4; ++m)
#pragma unroll
                    for (int n = 0; n < 2; ++n) acc[a][b][m][n] = (f32x4){zz1, zz1, zz1, zz1}; }
        cur = nxt; cA = nA; cB = nB; ++ui;
        if constexpr (ALIGN_EPI) { if (wr == 1) PG8_BAR; }
    }
    PG8_WAIT_V(0);
    if constexpr (!ALIGN_EPI) { if (wr == 0) PG8_BAR; }
    PG8_BAR;
    if constexpr (Epi::AFTER_DRAIN) { E.fused(acc, cur, wr, wc, fr, fq, lds, wid, lane); S.done(cur); }
#undef PG8_SA
#undef PG8_SB
#undef PG8_STAGE
#undef PG8_LDA
#undef PG8_LDB
#undef PG8_MMA
#undef PG8_WAIT_V
#undef PG8_WAIT_L
#undef PG8_BAR
#undef PG8_SCHED
}
}
#define GAS __attribute__((address_space(1)))
#define LAS __attribute__((address_space(3)))
typedef unsigned short bf16;
typedef unsigned v4u __attribute__((ext_vector_type(4)));
typedef float f32x4 __attribute__((ext_vector_type(4)));
typedef short bf16x8 __attribute__((ext_vector_type(8)));
typedef GAS unsigned gu32;
typedef GAS unsigned long long gu64;
#define RLX_AGENT __ATOMIC_RELAXED, __HIP_MEMORY_SCOPE_AGENT
#define LDS_WAIT() asm volatile("s_waitcnt lgkmcnt(0)" ::: "memory")
#define VM_WAIT() asm volatile("s_waitcnt vmcnt(0)" ::: "memory")
__device__ __forceinline__ unsigned long long rt() { return __builtin_amdgcn_s_memrealtime(); }
typedef float f32x2_t __attribute__((ext_vector_type(2))); typedef __bf16 bf16x2_t __attribute__((ext_vector_type(2)));
__device__ __forceinline__ unsigned pk2(float lo, float hi) { const bf16x2_t b = __builtin_convertvector((f32x2_t){lo, hi}, bf16x2_t); return __builtin_bit_cast(unsigned, b); }
__device__ __forceinline__ unsigned f2bf(float f) { return pk2(f, 0.f) & 0xffffu; }
#define XB_TMO      128
#define XB_XCNT(j)  (256  + 64 * (j))
#define XB_XSUB(j)  (1280 + 64 * (j))
#define XB_XGEN(j)  (2304 + 64 * (j))
#define XB_TOP      3328
#define XB_TOPGEN   3392
#define XCD_BAR_WORDS 3456
#define XB_SPIN_CAP (1u << 18)

__device__ __forceinline__ unsigned xb_ld(unsigned* p)              { return __hip_atomic_load(p, __ATOMIC_RELAXED, __HIP_MEMORY_SCOPE_AGENT); }
__device__ __forceinline__ unsigned xb_add(unsigned* p, unsigned v) { return __hip_atomic_fetch_add(p, v, __ATOMIC_RELAXED, __HIP_MEMORY_SCOPE_AGENT); }
__device__ __forceinline__ unsigned xb_xcc_id() { return (unsigned)__builtin_amdgcn_s_getreg((3 << 11) | 20) & 0xFu; }
#define XB_SPIN(cond, bar) do { unsigned _sp = 0; while (cond) { __builtin_amdgcn_s_sleep(1); \
    if ((++_sp & 255u) == 0u) { if (xb_ld(&(bar)[XB_TMO])) break; if (_sp > XB_SPIN_CAP) { atomicAdd(&(bar)[XB_TMO], 1u); break; } } } } while (0)

struct XcdBarrier {
    unsigned* bar; unsigned x;
    volatile LAS unsigned* st;
};

__device__ __forceinline__ XcdBarrier xcd_barrier_post(unsigned* bar, volatile LAS unsigned* st, int tid) {
    XcdBarrier b; b.bar = bar; b.x = xb_xcc_id(); b.st = st;
    if (tid == 0) (void)xb_add(&bar[XB_XCNT(b.x)], 1u);
    return b;
}
__device__ __forceinline__ void xcd_barrier_complete(unsigned* bar, unsigned x, unsigned& nloc, unsigned& nx) {
    const unsigned G = gridDim.x * gridDim.y * gridDim.z;
    unsigned sum, cnt, mine, sp = 0u;
    for (;;) {
        sum = 0u; cnt = 0u; mine = 0u;
#pragma unroll
        for (unsigned j = 0; j < 16; ++j) { const unsigned c = xb_ld(&bar[XB_XCNT(j)]); sum += c; cnt += (c > 0u) ? 1u : 0u; mine = (j == x) ? c : mine; }
        if (sum == G) break;
        __builtin_amdgcn_s_sleep(1);
        if ((++sp & 255u) == 0u) { if (xb_ld(&bar[XB_TMO])) break; if (sp > XB_SPIN_CAP) { atomicAdd(&bar[XB_TMO], 1u); break; } }
    }
    nloc = mine > 0u ? mine : 1u; nx = cnt > 0u ? cnt : 1u;
}

__device__ __forceinline__ void xcd_barrier(const XcdBarrier& b, int tid) {
    asm volatile("s_waitcnt vmcnt(0)" ::: "memory");
    __syncthreads();
    if (tid == 0) {
        unsigned* bar = b.bar;
        __builtin_amdgcn_s_waitcnt(0);
        unsigned nloc = b.st[0], nx = b.st[1];
        if (nloc == 0u) { xcd_barrier_complete(bar, b.x, nloc, nx); b.st[0] = nloc; b.st[1] = nx; }
        const unsigned old = xb_add(&bar[XB_XSUB(b.x)], 1u);
        const unsigned gen = old / nloc;
        if (old + 1u == (gen + 1u) * nloc) {
            __builtin_amdgcn_fence(__ATOMIC_RELEASE, "agent");
            asm volatile("s_waitcnt vmcnt(0)" ::: "memory");
            const unsigned og = xb_add(&bar[XB_TOP], 1u);
            const unsigned tg = og / nx;
            if (og + 1u == (tg + 1u) * nx) xb_add(&bar[XB_TOPGEN], 1u);
            else XB_SPIN(xb_ld(&bar[XB_TOPGEN]) == tg, bar);
            __builtin_amdgcn_fence(__ATOMIC_ACQUIRE, "agent");
            xb_add(&bar[XB_XGEN(b.x)], 1u);
            asm volatile("s_waitcnt vmcnt(0)" ::: "memory");
        } else {
            XB_SPIN(xb_ld(&bar[XB_XGEN(b.x)]) == gen, bar);
            __builtin_amdgcn_fence(__ATOMIC_ACQUIRE, "agent");
            asm volatile("s_waitcnt vmcnt(0)" ::: "memory");
        }
    }
    __syncthreads();
}

constexpr int NWAVES = 8, NTHR = 512;
constexpr int DM = 2048, FF = 5632, DEPTH = 4;
constexpr int TP = 16384, NSB = 16, TS = 32, M = TP + NSB * TS;
constexpr int RW = 1024, NH = 16, HN = 64, GMW = 1024, GH = 8, GHD = 128;
constexpr int C_W = 3072, C_A = 3136, C_G = 3200, SHIFT = 3360, INC = 5408;
constexpr int PLD = 3584;
constexpr int N3 = 5632;
constexpr int LK = 384;
constexpr int NL = 3072;
constexpr float ALPHA = 1.6817928305074292f;
constexpr float LN_EPS = 1e-5f, GN_EPS = 64e-5f;
constexpr int NPHASE = 15;

constexpr size_t O_YP = 0, O_SP = 34603008, O_SHP = 34865152, O_SS = 34878592, O_SHS = 39072896, O_GV = 39287936, O_END = 41385088;

constexpr size_t MiB = 1u << 20;
constexpr size_t WS_CTL = 0, CTL_ZERO_BYTES = 1 * MiB;
constexpr size_t WS_X = 1 * MiB;
constexpr size_t WS_Z = 133 * MiB;
constexpr size_t WS_XB = 265 * MiB;
constexpr size_t WS_W = 331 * MiB;
constexpr size_t W_1 = WS_W, W_2 = W_1 + 44 * MiB, W_3 = W_2 + 22 * MiB, W_4 = W_3 + 22 * MiB, W_5 = W_4 + 8 * MiB, W_6 = W_5 + 44 * MiB, W_3B = W_6 + 22 * MiB;
constexpr size_t WS_BIG = 496 * MiB;
constexpr size_t B_H = WS_BIG, B_P = WS_BIG, B_U = WS_BIG + 231 * MiB, B_GV = B_U + 33 * MiB, B_A3B = B_GV + 66 * MiB;
constexpr size_t B_MIX = WS_XB;
constexpr size_t WS_RW = 839 * MiB;
constexpr size_t RWSZ = 66 * MiB;
constexpr size_t WS_END = WS_RW + 8 * RWSZ;
static_assert(W_3B + (size_t)NL * LK * 2 <= WS_BIG && B_A3B + (size_t)M * LK * 2 <= WS_RW, "ws map");
static_assert((size_t)M * DM * 4 == 132 * MiB && (size_t)M * PLD * 4 == 231 * MiB && (size_t)M * 1024 * 4 == 66 * MiB, "ws sizes");
constexpr int CW_TMO = 0, CW_CODE = 1, CW_BAR = 4096;

constexpr int RING_OFF = 0, RING_BYTES = 135168;
constexpr int LDSCTL_OFF = RING_BYTES, MISC_OFF = LDSCTL_OFF + 320;
constexpr int LDS_BYTES = 147456;

struct Args { const float* in[29]; float* out; unsigned char* ws; int l_lo, l_hi; };
#define KOUT() ((float*)karg_ptr<232>())
#define KWS() ((unsigned char*)karg_ptr<240>())
enum InIdx { I_XP = 0, I_XS, I_SRW, I_SSH, I_F1G, I_F1U, I_F1D, I_WIN, I_MU, I_W0, I_WUP, I_A0, I_AUP, I_GUP, I_KK, I_KA, I_RK, I_GNG, I_GNB, I_GLG, I_GLB, I_GWS, I_GBS, I_WOUT, I_F2G, I_F2U, I_F2D, I_LNG, I_LNB };


template <int OFF> __device__ __forceinline__ const float* karg_ptr() {
    const unsigned long long kp = (unsigned long long)__builtin_amdgcn_kernarg_segment_ptr(); unsigned long long v;
    asm volatile("s_load_dwordx2 %0, %1, %2\n\ts_waitcnt lgkmcnt(0)" : "=s"(v) : "s"(kp), "i"(OFF) : "memory");
    return (const float*)(const GAS float*)v;
}
#define KIN(i) karg_ptr<8 * (i)>()
template <int CTRL> __device__ __forceinline__ float dpp_mov(float x) { return __builtin_bit_cast(float, __builtin_amdgcn_mov_dpp(__builtin_bit_cast(int, x), CTRL, 0xf, 0xf, true)); }
__device__ __forceinline__ float row16_sum(float x) { x += dpp_mov<0x128>(x); x += dpp_mov<0x124>(x); x += dpp_mov<0x122>(x); x += dpp_mov<0x121>(x); return x; }
__device__ __forceinline__ float wave_sum(float v) {
    v = row16_sum(v); const int i = __builtin_bit_cast(int, v);
    const float a = __builtin_bit_cast(float, __builtin_amdgcn_readlane(i, 0)), b = __builtin_bit_cast(float, __builtin_amdgcn_readlane(i, 16)), c = __builtin_bit_cast(float, __builtin_amdgcn_readlane(i, 32)), d = __builtin_bit_cast(float, __builtin_amdgcn_readlane(i, 48));
    return (a + b) + (c + d);
}

template <int MAP> __device__ __forceinline__ void cvt_task(const float* __restrict__ W, int K, int N, bf16* __restrict__ WT, int nb, int k0, int lane) {
    const int n = nb * 256 + 4 * lane; if (n >= N) return;
    const int drow = MAP == 0 ? n : (MAP == 3 ? (n < SHIFT ? n : n + (PLD - SHIFT)) : 256 * (n >> 7) + (n & 127) + (MAP == 2 ? 128 : 0));
    const float* src = W + (size_t)k0 * N + n; bf16* dst = WT + (size_t)drow * K + k0;
#pragma unroll
    for (int kk = 0; kk < 32; kk += 16) { f32x4 v[16];
#pragma unroll
        for (int j = 0; j < 16; ++j) v[j] = *(const f32x4*)(src + (size_t)(kk + j) * N);
#pragma unroll
        for (int i = 0; i < 4; ++i)
#pragma unroll
            for (int hh = 0; hh < 2; ++hh) { v4u o; o.x = pk2(v[8 * hh + 0][i], v[8 * hh + 1][i]); o.y = pk2(v[8 * hh + 2][i], v[8 * hh + 3][i]); o.z = pk2(v[8 * hh + 4][i], v[8 * hh + 5][i]); o.w = pk2(v[8 * hh + 6][i], v[8 * hh + 7][i]);
                *(v4u*)(dst + (size_t)i * K + kk + 8 * hh) = o; } }
}

__device__ __forceinline__ void phase_convert(int l, LAS unsigned char* lds, int wave, int lane, int gw, int NGW) {
    unsigned char* ws = KWS();
    const size_t so = (size_t)l * DM * FF;
    const float *f1g = KIN(I_F1G) + so, *f1u = KIN(I_F1U) + so, *f1d = KIN(I_F1D) + so, *f2g = KIN(I_F2G) + so, *f2u = KIN(I_F2U) + so, *f2d = KIN(I_F2D) + so;
    const float* win = KIN(I_WIN) + (size_t)l * DM * INC; const float* wout = KIN(I_WOUT) + (size_t)l * DM * DM;
    constexpr int T_GU = (FF / 256) * (DM / 32);
    constexpr int T_D = (DM / 256) * (FF / 32);
    constexpr int T_IN = ((INC + 255) / 256) * (DM / 32);
    constexpr int T_O = (DM / 256) * (DM / 32);
    constexpr int NTASK = 4 * T_GU + 2 * T_D + T_IN + T_O;
    for (int it = gw; it < NTASK; it += NGW) {
        int r = it;
        if (r < 4 * T_GU) { const int which = r / T_GU; r -= which * T_GU; const int nb = r % (FF / 256), kb = r / (FF / 256);
            const float* W = which == 0 ? f1g : (which == 1 ? f1u : (which == 2 ? f2g : f2u)); bf16* WT = (bf16*)(ws + (which < 2 ? W_1 : W_5));
            if (which & 1) cvt_task<2>(W, DM, FF, WT, nb, 32 * kb, lane); else cvt_task<1>(W, DM, FF, WT, nb, 32 * kb, lane); continue; }
        r -= 4 * T_GU;
        if (r < 2 * T_D) { const int which = r / T_D; r -= which * T_D; const int nb = r % (DM / 256), kb = r / (DM / 256);
            cvt_task<0>(which == 0 ? f1d : f2d, FF, DM, (bf16*)(ws + (which == 0 ? W_2 : W_6)), nb, 32 * kb, lane); continue; }
        r -= 2 * T_D;
        if (r < T_IN) { const int nb = r % ((INC + 255) / 256), kb = r / ((INC + 255) / 256); cvt_task<3>(win, DM, INC, (bf16*)(ws + W_3), nb, 32 * kb, lane); continue; }
        r -= T_IN;
        { const int nb = r % (DM / 256), kb = r / (DM / 256); cvt_task<0>(wout, DM, DM, (bf16*)(ws + W_4), nb, 32 * kb, lane); }
    }
    { v4u* z = (v4u*)(ws + W_3 + (size_t)SHIFT * DM * 2); const int nz = (PLD - SHIFT) * DM * 2 / 16;
      unsigned z0; asm volatile("v_mov_b32 %0, 0" : "=v"(z0));
      for (int i = gw * 64 + lane; i < nz; i += NGW * 64) z[i] = (v4u){z0, z0, z0, z0}; }
    { bf16* WT = (bf16*)(ws + W_3B); const float* wup = KIN(I_WUP) + (size_t)l * 64 * RW; const float* aup = KIN(I_AUP) + (size_t)l * 64 * RW; const float* gup = KIN(I_GUP) + (size_t)l * 160 * RW;
      for (int i = gw * 64 + lane; i < NL * LK; i += NGW * 64) { const int n = i / LK, k = i % LK, kind = n >> 10, c = n & 1023; float v = 0.f;
          if (kind == 0) { if (k < 64) v = wup[(size_t)k * RW + c]; } else if (kind == 1) { if (k >= 64 && k < 128) v = aup[(size_t)(k - 64) * RW + c]; } else { if (k >= 128 && k < 288) v = gup[(size_t)(k - 128) * RW + c]; }
          WT[i] = (bf16)f2bf(v); } }
    if (l == 0) {
        float* X = (float*)(ws + WS_X); bf16* XB = (bf16*)(ws + WS_XB); const float* xp = KIN(I_XP); const float* xs = KIN(I_XS);
        for (int m = gw; m < M; m += NGW) { const float* src = m < TP ? xp + (size_t)m * DM : xs + (size_t)(m - TP) * DM;
            const f32x4* s4 = (const f32x4*)src + lane; f32x4* d4 = (f32x4*)(X + (size_t)m * DM) + lane; unsigned long long* o8 = (unsigned long long*)(XB + (size_t)m * DM) + lane;
#pragma unroll
            for (int j = 0; j < 8; ++j) { const f32x4 v = s4[64 * j]; d4[64 * j] = v; o8[64 * j] = (unsigned long long)pk2(v.x, v.y) | ((unsigned long long)pk2(v.z, v.w) << 32); } }
    }
}

__device__ __forceinline__ void phase_ln(const float* Z, const float* Xres, const float* slab, int KS, float sa, float sb, const float* g, const float* b, float* Xo, bf16* XBo, int lane, int gw, int NGW) {
    for (int m = gw; m < M; m += NGW) {
        f32x4 v[8]; float s = 0.f;
        if (m < TP) { const f32x4* zr = (const f32x4*)(Z + (size_t)m * DM) + lane;
#pragma unroll
            for (int j = 0; j < 8; ++j) v[j] = zr[64 * j];
        } else { const f32x4* xr = (const f32x4*)(Xres + (size_t)m * DM) + lane; f32x4 a[8];
#pragma unroll
            for (int j = 0; j < 8; ++j) { v[j] = xr[64 * j]; a[j] = (f32x4){0.f, 0.f, 0.f, 0.f}; }
            for (int ks = 0; ks < KS; ++ks) { const f32x4* sr = (const f32x4*)(slab + ((size_t)ks * 512 + (m - TP)) * DM) + lane;
#pragma unroll
                for (int j = 0; j < 8; ++j) a[j] = a[j] + sr[64 * j]; }
#pragma unroll
            for (int j = 0; j < 8; ++j) v[j] = v[j] * sa + a[j] * sb; }
#pragma unroll
        for (int j = 0; j < 8; ++j) s += (v[j].x + v[j].y) + (v[j].z + v[j].w);
        const float mean = wave_sum(s) * (1.f / DM); float s2 = 0.f;
#pragma unroll
        for (int j = 0; j < 8; ++j) { v[j] = v[j] - mean; s2 += (v[j].x * v[j].x + v[j].y * v[j].y) + (v[j].z * v[j].z + v[j].w * v[j].w); }
        const float rstd = 1.f / sqrtf(wave_sum(s2) * (1.f / DM) + LN_EPS);
        f32x4* xo = (f32x4*)(Xo + (size_t)m * DM) + lane;
#pragma unroll
        for (int j = 0; j < 8; ++j) { const f32x4 gg = ((const f32x4*)g)[lane + 64 * j], bb = ((const f32x4*)b)[lane + 64 * j]; const f32x4 o = v[j] * rstd * gg + bb; xo[64 * j] = o;
            if (XBo) ((unsigned long long*)(XBo + (size_t)m * DM) + lane)[64 * j] = (unsigned long long)pk2(o.x, o.y) | ((unsigned long long)pk2(o.z, o.w) << 32); }
    }
}

__device__ __forceinline__ const float* prev_row(const float* ssh, int l, const float* P, int m) {
    if (m < TP) return m == 0 ? nullptr : P + (size_t)(m - 1) * PLD;
    const int b = (m - TP) >> 5, t = (m - TP) & 31;
    return t == 0 ? ssh + (size_t)(l * NSB + b) * SHIFT : P + (size_t)(m - 1) * PLD;
}

__device__ __forceinline__ void phase_prep1(int l, int lane, int gw, int NGW) {
    unsigned char* ws = KWS(); float* outp = KOUT(); const float* P = (const float*)(ws + B_P); float* GV = (float*)(ws + B_GV); bf16* A3B = (bf16*)(ws + B_A3B);
    const float* mu = KIN(I_MU) + (size_t)l * SHIFT; const float* lg = KIN(I_GLG) + (size_t)l * GMW; const float* lb = KIN(I_GLB) + (size_t)l * GMW;
    const float* ssh = KIN(I_SSH);
    for (int m = gw; m < M; m += NGW) {
        const float* pr = P + (size_t)m * PLD; const float* pp = prev_row(ssh, l, P, m);
#pragma unroll
        for (int jj = 0; jj < 6; ++jj) { const int j = jj * 64 + lane; float v = 0.f;
            if (j < 288) { const int c = C_W + j; const float p = pr[c], q = pp ? pp[c] : 0.f; const float xs = p + (q - p) * mu[c];
                if (j < 64) { const float t = __expf(-2.f * fabsf(xs)); const float r = (1.f - t) / (1.f + t); v = xs < 0.f ? -r : r; }
                else if (j < 128) v = xs;
                else v = 1.f / (1.f + __expf(-xs)); }
            A3B[(size_t)m * LK + j] = (bf16)f2bf(v); }
        { f32x4* vr = (f32x4*)(GV + (size_t)m * GMW) + lane; f32x4 v[4]; float s = 0.f;
#pragma unroll
          for (int j = 0; j < 4; ++j) { v[j] = vr[64 * j]; s += (v[j].x + v[j].y) + (v[j].z + v[j].w); }
          const float mean = wave_sum(s) * (1.f / GMW); float s2 = 0.f;
#pragma unroll
          for (int j = 0; j < 4; ++j) { v[j] = v[j] - mean; s2 += (v[j].x * v[j].x + v[j].y * v[j].y) + (v[j].z * v[j].z + v[j].w * v[j].w); }
          const float rstd = 1.f / sqrtf(wave_sum(s2) * (1.f / GMW) + LN_EPS);
          f32x4* go = nullptr; if (m >= TP) go = (f32x4*)(outp + O_GV + ((size_t)l * NSB * TS + (m - TP)) * GMW) + lane;
#pragma unroll
          for (int j = 0; j < 4; ++j) { const f32x4 o = v[j] * rstd * ((const f32x4*)lg)[lane + 64 * j] + ((const f32x4*)lb)[lane + 64 * j]; vr[64 * j] = o; if (go) go[64 * j] = o; } }
        if (m == TP - 1) { float* o = outp + O_SHP + (size_t)l * SHIFT; for (int c = lane; c < SHIFT; c += 64) o[c] = pr[c]; }
        if (m >= TP && ((m - TP) & 31) == 31) { float* o = outp + O_SHS + (size_t)(l * NSB + ((m - TP) >> 5)) * SHIFT; for (int c = lane; c < SHIFT; c += 64) o[c] = pr[c]; }
    }
}

typedef unsigned u32x2g __attribute__((ext_vector_type(2)));
constexpr int GLD = 272, GL_VT = 128 * GLD, GSP = 132;
static_assert(2 * GL_VT <= RING_BYTES && 128 * GSP * 4 <= 2 * GL_VT, "gMLP LDS");
__device__ __forceinline__ void gmlp_unit(int l, LAS unsigned char* lds, int unit, int tid, int wave) {
    unsigned char* ws = KWS(); const float* VN = (const float*)(ws + B_GV); const bf16* U = (const bf16*)(ws + B_U); bf16* MIXB = (bf16*)(ws + B_MIX);
    const int ci = unit >> 3, h = unit & 7; int row0, nr; if (ci < 128) { row0 = 128 * ci; nr = 128; } else { row0 = TP + 32 * (ci - 128); nr = 32; }
    const float* wsm = KIN(I_GWS) + ((size_t)l * GH + h) * 128 * 128; const float* bs = KIN(I_GBS) + ((size_t)l * GH + h) * 128;
    LAS unsigned char* Wb = lds; LAS unsigned char* Vt = lds + GL_VT; LAS float* So = (LAS float*)lds;
    const int lane = tid & 63, g = lane >> 4, lc = lane & 15;
    __syncthreads();
    for (int idx = tid; idx < nr * 32; idx += NTHR) { const int i = idx >> 5, j4 = idx & 31; f32x4 w4 = *(const f32x4*)(wsm + i * 128 + 4 * j4);
        const int j = 4 * j4; if (j > i) w4.x = 0.f; if (j + 1 > i) w4.y = 0.f; if (j + 2 > i) w4.z = 0.f; if (j + 3 > i) w4.w = 0.f;
        *(LAS u32x2g*)(Wb + i * GLD + 8 * j4) = (u32x2g){pk2(w4.x, w4.y), pk2(w4.z, w4.w)}; }
    { const int c = tid & 127, jg = tid >> 7;
      if (32 * jg < nr) { const float* vp = VN + (size_t)(row0 + 32 * jg) * GMW + h * GHD + c; float vv[32];
#pragma unroll
          for (int j = 0; j < 32; ++j) vv[j] = vp[(size_t)j * GMW];
#pragma unroll
          for (int q = 0; q < 4; ++q) *(LAS v4u*)(Vt + c * GLD + (32 * jg + 8 * q) * 2) = (v4u){pk2(vv[8 * q], vv[8 * q + 1]), pk2(vv[8 * q + 2], vv[8 * q + 3]), pk2(vv[8 * q + 4], vv[8 * q + 5]), pk2(vv[8 * q + 6], vv[8 * q + 7])}; } }
    __syncthreads();
    float zf; asm volatile("v_mov_b32 %0, 0" : "=v"(zf));
    f32x4 acc[8];
#pragma unroll
    for (int cb = 0; cb < 8; ++cb) acc[cb] = (f32x4){zf, zf, zf, zf};
    const bool rows_live = 16 * wave < nr;
    if (rows_live) { const int nks = (wave + 2) >> 1;
        for (int ks = 0; ks < nks; ++ks) { const bf16x8 fa = *(const LAS bf16x8*)(Wb + (16 * wave + lc) * GLD + (32 * ks + 8 * g) * 2);
#pragma unroll
            for (int cb = 0; cb < 8; ++cb) acc[cb] = __builtin_amdgcn_mfma_f32_16x16x32_bf16(fa, *(const LAS bf16x8*)(Vt + (16 * cb + lc) * GLD + (32 * ks + 8 * g) * 2), acc[cb], 0, 0, 0); } }
    __syncthreads();
    if (rows_live) {
#pragma unroll
        for (int rg = 0; rg < 4; ++rg) { const int i = 16 * wave + 4 * g + rg; const float b0 = bs[i];
#pragma unroll
            for (int cb = 0; cb < 8; ++cb) So[i * GSP + 16 * cb + lc] = acc[cb][rg] + b0; } }
    __syncthreads();
    const int rq = tid >> 4, cg = tid & 15;
    if (4 * rq < nr) {
#pragma unroll
        for (int r = 0; r < 4; ++r) { const int i = 4 * rq + r; const size_t row = (size_t)(row0 + i); const v4u uu = *(const v4u*)(U + row * GMW + h * GHD + 8 * cg);
            const f32x4 s0 = *(const LAS f32x4*)(So + i * GSP + 8 * cg), s1 = *(const LAS f32x4*)(So + i * GSP + 8 * cg + 4);
            const float u0 = __builtin_bit_cast(float, uu.x << 16), u1 = __builtin_bit_cast(float, uu.x & 0xffff0000u), u2 = __builtin_bit_cast(float, uu.y << 16), u3 = __builtin_bit_cast(float, uu.y & 0xffff0000u);
            const float u4 = __builtin_bit_cast(float, uu.z << 16), u5 = __builtin_bit_cast(float, uu.z & 0xffff0000u), u6 = __builtin_bit_cast(float, uu.w << 16), u7 = __builtin_bit_cast(float, uu.w & 0xffff0000u);
            v4u o; o.x = pk2(u0 * s0.x, u1 * s0.y); o.y = pk2(u2 * s0.z, u3 * s0.w); o.z = pk2(u4 * s1.x, u5 * s1.y); o.w = pk2(u6 * s1.z, u7 * s1.w);
            *(v4u*)(MIXB + row * DM + RW + h * GHD + 8 * cg) = o; }
    }
}


constexpr int NCI = 272, NUNIT = NCI * NH;
constexpr size_t SC_G = WS_RW + 3 * RWSZ;
constexpr size_t SC_HL = SC_G + (size_t)NUNIT * 8192;
constexpr size_t SC_RP = SC_HL + (size_t)NUNIT * 16384;
constexpr size_t SC_YL = SC_RP + (size_t)NUNIT * 8192;
constexpr size_t SC_S0 = SC_YL + (size_t)NUNIT * 16384;
constexpr size_t SC_BON = SC_S0 + (size_t)NUNIT * 8192;
constexpr size_t SC_END = SC_BON + (size_t)NUNIT * 256;
static_assert(SC_END <= WS_END, "scan scratch");
constexpr size_t WS_SLAB = SC_G;
static_assert(WS_SLAB + (size_t)11 * 512 * 2048 * 4 <= WS_END, "slab");
typedef unsigned u32x2 __attribute__((ext_vector_type(2)));
constexpr int BLD = 144;
constexpr int LBUF = 9216;
constexpr int LF0 = 7 * LBUF, F0P = 129;
constexpr int LF1 = LF0 + 64 * F0P * 4, F1P = 68;
constexpr int LF2 = LF1 + 64 * F1P * 4;
constexpr int LTOT = LF2 + 16384;
constexpr int LGC = LTOT + 2048;
constexpr int SCAN_LDS = LGC + 256;
static_assert(SCAN_LDS <= RING_BYTES, "scan LDS");

__device__ __forceinline__ bf16x8 ldfrag(const LAS unsigned char* mat, int blk, int ks, int lane) { return *(const LAS bf16x8*)(mat + (16 * blk + (lane & 15)) * BLD + (32 * ks + 8 * (lane >> 4)) * 2); }
#define MFMA16(a, b, c) __builtin_amdgcn_mfma_f32_16x16x32_bf16((a), (b), (c), 0, 0, 0)

#define LDS_BAR() do { asm volatile("s_waitcnt lgkmcnt(0)" ::: "memory"); __builtin_amdgcn_s_barrier(); asm volatile("" ::: "memory"); } while (0)
__device__ __forceinline__ void scanA_all(int l, LAS unsigned char* lds, int bx, int G, int tid, int wave) {
    unsigned char* ws = KWS();
    const int lane = tid & 63;
    const float* ssh = KIN(I_SSH); const float* mu = KIN(I_MU) + (size_t)l * SHIFT;
    const float *w0p = KIN(I_W0) + (size_t)l * RW, *a0p = KIN(I_A0) + (size_t)l * RW, *kkp = KIN(I_KK) + (size_t)l * RW, *kap = KIN(I_KA) + (size_t)l * RW, *rkp = KIN(I_RK) + (size_t)l * RW;
    float pr_[8], pk_[8], pv_[8], al_[8], wl_[8]; float q_r, q_k, q_v, mu_r, mu_k, mu_v, w0c, a0c, kkc, kac, rkc;
#define SA_LOAD(unit_) do { const int ci_ = (unit_) >> 4, cc_ = 64 * ((unit_) & 15) + lane; const int m0_ = ci_ < 256 ? 64 * ci_ : TP + 32 * (ci_ - 256), n_ = ci_ < 256 ? 64 : 32, t0_ = 8 * wave; \
        const float* P_ = (const float*)(ws + B_P); const float* Wl_ = (const float*)(ws + WS_RW); const float* Al_ = (const float*)(ws + WS_RW + RWSZ); \
        mu_r = mu[cc_]; mu_k = mu[RW + cc_]; mu_v = mu[2 * RW + cc_]; w0c = w0p[cc_]; a0c = a0p[cc_]; kkc = kkp[cc_]; kac = kap[cc_]; rkc = rkp[cc_]; q_r = 0.f; q_k = 0.f; q_v = 0.f; \
        if (t0_ < n_) { const float* pp_ = prev_row(ssh, l, P_, m0_ + t0_); if (pp_) { q_r = pp_[cc_]; q_k = pp_[RW + cc_]; q_v = pp_[2 * RW + cc_]; } } \
        _Pragma("unroll") for (int i = 0; i < 8; ++i) { pr_[i] = 0.f; pk_[i] = 0.f; pv_[i] = 0.f; al_[i] = 0.f; wl_[i] = 0.f; \
            if (t0_ < n_) { const size_t m_ = (size_t)(m0_ + t0_ + i); const float* prow_ = P_ + m_ * PLD; pr_[i] = prow_[cc_]; pk_[i] = prow_[RW + cc_]; pv_[i] = prow_[2 * RW + cc_]; al_[i] = Al_[m_ * RW + cc_]; wl_[i] = Wl_[m_ * RW + cc_]; } } } while (0)
    if (bx < NUNIT) SA_LOAD(bx);
    for (int unit = bx; unit < NUNIT; unit += G) {
    const int ci = unit >> 4;
    int m0, n; if (ci < 256) { m0 = 64 * ci; n = 64; } else { m0 = TP + 32 * (ci - 256); n = 32; }
    (void)m0;
    const float* P = (const float*)(ws + B_P); const float* Wl = (const float*)(ws + WS_RW); const float* Al = (const float*)(ws + WS_RW + RWSZ);
    LAS unsigned char* B0 = lds; LAS unsigned char* B1 = lds + LBUF; LAS unsigned char* B2 = lds + 2 * LBUF; LAS unsigned char* B3 = lds + 3 * LBUF;
    LAS unsigned char* B4 = lds + 4 * LBUF; LAS unsigned char* B5 = lds + 5 * LBUF; LAS unsigned char* B6 = lds + 6 * LBUF;
    LAS float* F0 = (LAS float*)(lds + LF0); LAS float* F1 = (LAS float*)(lds + LF1); LAS float* F2 = (LAS float*)(lds + LF2); LAS float* TOT = (LAS float*)(lds + LTOT); LAS float* GC = (LAS float*)(lds + LGC);
    LDS_BAR();
    {
        const int t0 = 8 * wave; const bool live = t0 < n;
        float r[8], kp[8], v[8], kk[8], b[8], lw[8], bsv[8];
        float* bon = (float*)(ws + SC_BON) + (size_t)unit * 64;
#pragma unroll
        for (int i = 0; i < 8; ++i) {
            r[i] = 0.f; kp[i] = 0.f; v[i] = 0.f; kk[i] = 0.f; b[i] = 0.f; lw[i] = 0.f; bsv[i] = 0.f;
            if (live) {
                const float p_r = pr_[i], p_k = pk_[i], p_v = pv_[i];
                const float rr = p_r + (q_r - p_r) * mu_r, kx = p_k + (q_k - p_k) * mu_k, vx = p_v + (q_v - p_v) * mu_v; q_r = p_r; q_k = p_k; q_v = p_v;
                const float av = 1.f / (1.f + __expf(-(a0c + al_[i])));
                const float y = -(w0c + wl_[i]); const float sp = fmaxf(y, 0.f) + __logf(1.0f + __expf(-fabsf(y)));
                const float kkv = kx * kkc; const float n2 = wave_sum(kkv * kkv); const float kn = kkv / fmaxf(sqrtf(n2), 1e-12f);
                const float kpv = kx * (1.f + (av - 1.f) * kac);
                bsv[i] = wave_sum(rr * kpv * rkc);
                r[i] = rr; kp[i] = kpv; v[i] = vx; kk[i] = kn; b[i] = kn * av; lw[i] = -__expf(-sp - 0.5f); }
        }
        if (live && lane < 8) { float bv = bsv[0];
#pragma unroll
            for (int i = 1; i < 8; ++i) bv = lane == i ? bsv[i] : bv;
            bon[t0 + lane] = bv; }
        if (unit + G < NUNIT) SA_LOAD(unit + G);
        float pl[8]; pl[0] = lw[0];
#pragma unroll
        for (int i = 1; i < 8; ++i) pl[i] = pl[i - 1] + lw[i];
        TOT[wave * 64 + lane] = pl[7];
        LDS_BAR();
        float off = 0.f, lamC = 0.f;
#pragma unroll
        for (int s = 0; s < 8; ++s) { const float tv = TOT[s * 64 + lane]; lamC += tv; if (s < wave) off += tv; }
        if (wave == 0) GC[lane] = __expf(lamC);
        unsigned vt[4], kb[4], bb[4];
#pragma unroll
        for (int i = 0; i < 8; ++i) { const int t = t0 + i; const float lam = off + pl[i];
            const float g_t = __expf(lam), g_p = __expf(lam - lw[i]), g_i = __expf(-lam), g_c = __expf(lamC - lam);
            const float kkt = kk[i] * g_p, rt = r[i] * g_t;
            *(LAS unsigned short*)(B0 + t * BLD + lane * 2) = (unsigned short)f2bf(kkt); F0[t * F0P + lane] = kkt;
            *(LAS unsigned short*)(B1 + t * BLD + lane * 2) = (unsigned short)f2bf(rt); F2[t * 64 + lane] = rt;
            *(LAS unsigned short*)(B2 + t * BLD + lane * 2) = (unsigned short)f2bf(kp[i] * g_i);
            *(LAS unsigned short*)(B3 + t * BLD + lane * 2) = (unsigned short)f2bf(b[i] * g_i);
            const unsigned hv = f2bf(v[i]), hk = f2bf(kp[i] * g_c), hb = f2bf(b[i] * g_c);
            if (i & 1) { vt[i >> 1] |= hv << 16; kb[i >> 1] |= hk << 16; bb[i >> 1] |= hb << 16; } else { vt[i >> 1] = hv; kb[i >> 1] = hk; bb[i >> 1] = hb; } }
        *(LAS v4u*)(B4 + lane * BLD + 16 * wave) = (v4u){vt[0], vt[1], vt[2], vt[3]};
        *(LAS v4u*)(B5 + lane * BLD + 16 * wave) = (v4u){kb[0], kb[1], kb[2], kb[3]};
        *(LAS v4u*)(B6 + lane * BLD + 16 * wave) = (v4u){bb[0], bb[1], bb[2], bb[3]};
    }
    LDS_BAR();
    const int rb = wave >> 1, cb0 = (wave & 1) * 2, g = lane >> 4, lc = lane & 15;
    float zf; asm volatile("v_mov_b32 %0, 0" : "=v"(zf));
    const f32x4 z4 = (f32x4){zf, zf, zf, zf};
    {
        f32x4 aab[2] = {z4, z4}, aak[2] = {z4, z4}, arb[2] = {z4, z4}, ark[2] = {z4, z4};
#pragma unroll
        for (int ks = 0; ks < 2; ++ks) { const bf16x8 fk = ldfrag(B0, rb, ks, lane), fr = ldfrag(B1, rb, ks, lane);
#pragma unroll
            for (int c = 0; c < 2; ++c) { const bf16x8 fkh = ldfrag(B2, cb0 + c, ks, lane), fb = ldfrag(B3, cb0 + c, ks, lane);
                aab[c] = MFMA16(fk, fb, aab[c]); aak[c] = MFMA16(fk, fkh, aak[c]); arb[c] = MFMA16(fr, fb, arb[c]); ark[c] = MFMA16(fr, fkh, ark[c]); } }
        LDS_BAR();
#pragma unroll
        for (int c = 0; c < 2; ++c)
#pragma unroll
            for (int rg = 0; rg < 4; ++rg) { const int t = 16 * rb + 4 * g + rg, s = 16 * (cb0 + c) + lc;
                F1[t * F1P + (s & 3) * 16 + (s >> 2)] = s < t ? aab[c][rg] : 0.f;
                *(LAS unsigned short*)(B0 + t * BLD + s * 2) = (unsigned short)f2bf(s < t ? aak[c][rg] : 0.f);
                *(LAS unsigned short*)(B1 + t * BLD + s * 2) = (unsigned short)f2bf(s <= t ? arb[c][rg] : 0.f);
                *(LAS unsigned short*)(B2 + t * BLD + s * 2) = (unsigned short)f2bf(s <= t ? ark[c][rg] : 0.f); }
    }
    LDS_BAR();
    {
        f32x4 av[2] = {z4, z4};
#pragma unroll
        for (int ks = 0; ks < 2; ++ks) { const bf16x8 fa = ldfrag(B0, rb, ks, lane);
#pragma unroll
            for (int c = 0; c < 2; ++c) av[c] = MFMA16(fa, ldfrag(B4, cb0 + c, ks, lane), av[c]); }
#pragma unroll
        for (int c = 0; c < 2; ++c)
#pragma unroll
            for (int rg = 0; rg < 4; ++rg) F0[(16 * rb + 4 * g + rg) * F0P + 64 + 16 * (cb0 + c) + lc] = av[c][rg];
    }
    LDS_BAR();
    {
        const int j = tid >> 2, p = tid & 3; const LAS float* f1p = F1 + p * 16; const LAS float* f0p = F0 + j;
        float x0 = zf, x1 = zf, x2 = zf, x3 = zf, x4 = zf, x5 = zf, x6 = zf, x7 = zf, x8 = zf, x9 = zf, x10 = zf, x11 = zf, x12 = zf, x13 = zf, x14 = zf, x15 = zf;
        { float part = zf; const float xt = f0p[0*F0P] - part; x0 = (p == 0) ? xt : x0; }
        { const f32x4 a0 = *(const LAS f32x4*)(f1p + 1*F1P + 0); float part = a0.x * x0; part += dpp_mov<0xB1>(part); part += dpp_mov<0x4E>(part); const float xt = f0p[1*F0P] - part; x0 = (p == 1) ? xt : x0; }
        { const f32x4 a0 = *(const LAS f32x4*)(f1p + 2*F1P + 0); float part = a0.x * x0; part += dpp_mov<0xB1>(part); part += dpp_mov<0x4E>(part); const float xt = f0p[2*F0P] - part; x0 = (p == 2) ? xt : x0; }
        { const f32x4 a0 = *(const LAS f32x4*)(f1p + 3*F1P + 0); float part = a0.x * x0; part += dpp_mov<0xB1>(part); part += dpp_mov<0x4E>(part); const float xt = f0p[3*F0P] - part; x0 = (p == 3) ? xt : x0; }
        { const f32x4 a0 = *(const LAS f32x4*)(f1p + 4*F1P + 0); float part = a0.x * x0; part += dpp_mov<0xB1>(part); part += dpp_mov<0x4E>(part); const float xt = f0p[4*F0P] - part; x1 = (p == 0) ? xt : x1; }
        { const f32x4 a0 = *(const LAS f32x4*)(f1p + 5*F1P + 0); float part = (a0.x * x0) + (a0.y * x1); part += dpp_mov<0xB1>(part); part += dpp_mov<0x4E>(part); const float xt = f0p[5*F0P] - part; x1 = (p == 1) ? xt : x1; }
        { const f32x4 a0 = *(const LAS f32x4*)(f1p + 6*F1P + 0); float part = (a0.x * x0) + (a0.y * x1); part += dpp_mov<0xB1>(part); part += dpp_mov<0x4E>(part); const float xt = f0p[6*F0P] - part; x1 = (p == 2) ? xt : x1; }
        { const f32x4 a0 = *(const LAS f32x4*)(f1p + 7*F1P + 0); float part = (a0.x * x0) + (a0.y * x1); part += dpp_mov<0xB1>(part); part += dpp_mov<0x4E>(part); const float xt = f0p[7*F0P] - part; x1 = (p == 3) ? xt : x1; }
        { const f32x4 a0 = *(const LAS f32x4*)(f1p + 8*F1P + 0); float part = (a0.x * x0) + (a0.y * x1); part += dpp_mov<0xB1>(part); part += dpp_mov<0x4E>(part); const float xt = f0p[8*F0P] - part; x2 = (p == 0) ? xt : x2; }
        { const f32x4 a0 = *(const LAS f32x4*)(f1p + 9*F1P + 0); float part = (a0.x * x0 + a0.z * x2) + (a0.y * x1); part += dpp_mov<0xB1>(part); part += dpp_mov<0x4E>(part); const float xt = f0p[9*F0P] - part; x2 = (p == 1) ? xt : x2; }
        { const f32x4 a0 = *(const LAS f32x4*)(f1p + 10*F1P + 0); float part = (a0.x * x0 + a0.z * x2) + (a0.y * x1); part += dpp_mov<0xB1>(part); part += dpp_mov<0x4E>(part); const float xt = f0p[10*F0P] - part; x2 = (p == 2) ? xt : x2; }
        { const f32x4 a0 = *(const LAS f32x4*)(f1p + 11*F1P + 0); float part = (a0.x * x0 + a0.z * x2) + (a0.y * x1); part += dpp_mov<0xB1>(part); part += dpp_mov<0x4E>(part); const float xt = f0p[11*F0P] - part; x2 = (p == 3) ? xt : x2; }
        { const f32x4 a0 = *(const LAS f32x4*)(f1p + 12*F1P + 0); float part = (a0.x * x0 + a0.z * x2) + (a0.y * x1); part += dpp_mov<0xB1>(part); part += dpp_mov<0x4E>(part); const float xt = f0p[12*F0P] - part; x3 = (p == 0) ? xt : x3; }
        { const f32x4 a0 = *(const LAS f32x4*)(f1p + 13*F1P + 0); float part = (a0.x * x0 + a0.z * x2) + (a0.y * x1 + a0.w * x3); part += dpp_mov<0xB1>(part); part += dpp_mov<0x4E>(part); const float xt = f0p[13*F0P] - part; x3 = (p == 1) ? xt : x3; }
        { const f32x4 a0 = *(const LAS f32x4*)(f1p + 14*F1P + 0); float part = (a0.x * x0 + a0.z * x2) + (a0.y * x1 + a0.w * x3); part += dpp_mov<0xB1>(part); part += dpp_mov<0x4E>(part); const float xt = f0p[14*F0P] - part; x3 = (p == 2) ? xt : x3; }
        { const f32x4 a0 = *(const LAS f32x4*)(f1p + 15*F1P + 0); float part = (a0.x * x0 + a0.z * x2) + (a0.y * x1 + a0.w * x3); part += dpp_mov<0xB1>(part); part += dpp_mov<0x4E>(part); const float xt = f0p[15*F0P] - part; x3 = (p == 3) ? xt : x3; }
        { const f32x4 a0 = *(const LAS f32x4*)(f1p + 16*F1P + 0); float part = (a0.x * x0 + a0.z * x2) + (a0.y * x1 + a0.w * x3); part += dpp_mov<0xB1>(part); part += dpp_mov<0x4E>(part); const float xt = f0p[16*F0P] - part; x4 = (p == 0) ? xt : x4; }
        { const f32x4 a0 = *(const LAS f32x4*)(f1p + 17*F1P + 0); const f32x4 a1 = *(const LAS f32x4*)(f1p + 17*F1P + 4); float part = (a0.x * x0 + a0.z * x2 + a1.x * x4) + (a0.y * x1 + a0.w * x3); part += dpp_mov<0xB1>(part); part += dpp_mov<0x4E>(part); const float xt = f0p[17*F0P] - part; x4 = (p == 1) ? xt : x4; }
        { const f32x4 a0 = *(const LAS f32x4*)(f1p + 18*F1P + 0); const f32x4 a1 = *(const LAS f32x4*)(f1p + 18*F1P + 4); float part = (a0.x * x0 + a0.z * x2 + a1.x * x4) + (a0.y * x1 + a0.w * x3); part += dpp_mov<0xB1>(part); part += dpp_mov<0x4E>(part); const float xt = f0p[18*F0P] - part; x4 = (p == 2) ? xt : x4; }
        { const f32x4 a0 = *(const LAS f32x4*)(f1p + 19*F1P + 0); const f32x4 a1 = *(const LAS f32x4*)(f1p + 19*F1P + 4); float part = (a0.x * x0 + a0.z * x2 + a1.x * x4) + (a0.y * x1 + a0.w * x3); part += dpp_mov<0xB1>(part); part += dpp_mov<0x4E>(part); const float xt = f0p[19*F0P] - part; x4 = (p == 3) ? xt : x4; }
        { const f32x4 a0 = *(const LAS f32x4*)(f1p + 20*F1P + 0); const f32x4 a1 = *(const LAS f32x4*)(f1p + 20*F1P + 4); float part = (a0.x * x0 + a0.z * x2 + a1.x * x4) + (a0.y * x1 + a0.w * x3); part += dpp_mov<0xB1>(part); part += dpp_mov<0x4E>(part); const float xt = f0p[20*F0P] - part; x5 = (p == 0) ? xt : x5; }
        { const f32x4 a0 = *(const LAS f32x4*)(f1p + 21*F1P + 0); const f32x4 a1 = *(const LAS f32x4*)(f1p + 21*F1P + 4); float part = (a0.x * x0 + a0.z * x2 + a1.x * x4) + (a0.y * x1 + a0.w * x3 + a1.y * x5); part += dpp_mov<0xB1>(part); part += dpp_mov<0x4E>(part); const float xt = f0p[21*F0P] - part; x5 = (p == 1) ? xt : x5; }
        { const f32x4 a0 = *(const LAS f32x4*)(f1p + 22*F1P + 0); const f32x4 a1 = *(const LAS f32x4*)(f1p + 22*F1P + 4); float part = (a0.x * x0 + a0.z * x2 + a1.x * x4) + (a0.y * x1 + a0.w * x3 + a1.y * x5); part += dpp_mov<0xB1>(part); part += dpp_mov<0x4E>(part); const float xt = f0p[22*F0P] - part; x5 = (p == 2) ? xt : x5; }
        { const f32x4 a0 = *(const LAS f32x4*)(f1p + 23*F1P + 0); const f32x4 a1 = *(const LAS f32x4*)(f1p + 23*F1P + 4); float part = (a0.x * x0 + a0.z * x2 + a1.x * x4) + (a0.y * x1 + a0.w * x3 + a1.y * x5); part += dpp_mov<0xB1>(part); part += dpp_mov<0x4E>(part); const float xt = f0p[23*F0P] - part; x5 = (p == 3) ? xt : x5; }
        { const f32x4 a0 = *(const LAS f32x4*)(f1p + 24*F1P + 0); const f32x4 a1 = *(const LAS f32x4*)(f1p + 24*F1P + 4); float part = (a0.x * x0 + a0.z * x2 + a1.x * x4) + (a0.y * x1 + a0.w * x3 + a1.y * x5); part += dpp_mov<0xB1>(part); part += dpp_mov<0x4E>(part); const float xt = f0p[24*F0P] - part; x6 = (p == 0) ? xt : x6; }
        { const f32x4 a0 = *(const LAS f32x4*)(f1p + 25*F1P + 0); const f32x4 a1 = *(const LAS f32x4*)(f1p + 25*F1P + 4); float part = (a0.x * x0 + a0.z * x2 + a1.x * x4 + a1.z * x6) + (a0.y * x1 + a0.w * x3 + a1.y * x5); part += dpp_mov<0xB1>(part); part += dpp_mov<0x4E>(part); const float xt = f0p[25*F0P] - part; x6 = (p == 1) ? xt : x6; }
        { const f32x4 a0 = *(const LAS f32x4*)(f1p + 26*F1P + 0); const f32x4 a1 = *(const LAS f32x4*)(f1p + 26*F1P + 4); float part = (a0.x * x0 + a0.z * x2 + a1.x * x4 + a1.z * x6) + (a0.y * x1 + a0.w * x3 + a1.y * x5); part += dpp_mov<0xB1>(part); part += dpp_mov<0x4E>(part); const float xt = f0p[26*F0P] - part; x6 = (p == 2) ? xt : x6; }
        { const f32x4 a0 = *(const LAS f32x4*)(f1p + 27*F1P + 0); const f32x4 a1 = *(const LAS f32x4*)(f1p + 27*F1P + 4); float part = (a0.x * x0 + a0.z * x2 + a1.x * x4 + a1.z * x6) + (a0.y * x1 + a0.w * x3 + a1.y * x5); part += dpp_mov<0xB1>(part); part += dpp_mov<0x4E>(part); const float xt = f0p[27*F0P] - part; x6 = (p == 3) ? xt : x6; }
        { const f32x4 a0 = *(const LAS f32x4*)(f1p + 28*F1P + 0); const f32x4 a1 = *(const LAS f32x4*)(f1p + 28*F1P + 4); float part = (a0.x * x0 + a0.z * x2 + a1.x * x4 + a1.z * x6) + (a0.y * x1 + a0.w * x3 + a1.y * x5); part += dpp_mov<0xB1>(part); part += dpp_mov<0x4E>(part); const float xt = f0p[28*F0P] - part; x7 = (p == 0) ? xt : x7; }
        { const f32x4 a0 = *(const LAS f32x4*)(f1p + 29*F1P + 0); const f32x4 a1 = *(const LAS f32x4*)(f1p + 29*F1P + 4); float part = (a0.x * x0 + a0.z * x2 + a1.x * x4 + a1.z * x6) + (a0.y * x1 + a0.w * x3 + a1.y * x5 + a1.w * x7); part += dpp_mov<0xB1>(part); part += dpp_mov<0x4E>(part); const float xt = f0p[29*F0P] - part; x7 = (p == 1) ? xt : x7; }
        { const f32x4 a0 = *(const LAS f32x4*)(f1p + 30*F1P + 0); const f32x4 a1 = *(const LAS f32x4*)(f1p + 30*F1P + 4); float part = (a0.x * x0 + a0.z * x2 + a1.x * x4 + a1.z * x6) + (a0.y * x1 + a0.w * x3 + a1.y * x5 + a1.w * x7); part += dpp_mov<0xB1>(part); part += dpp_mov<0x4E>(part); const float xt = f0p[30*F0P] - part; x7 = (p == 2) ? xt : x7; }
        { const f32x4 a0 = *(const LAS f32x4*)(f1p + 31*F1P + 0); const f32x4 a1 = *(const LAS f32x4*)(f1p + 31*F1P + 4); float part = (a0.x * x0 + a0.z * x2 + a1.x * x4 + a1.z * x6) + (a0.y * x1 + a0.w * x3 + a1.y * x5 + a1.w * x7); part += dpp_mov<0xB1>(part); part += dpp_mov<0x4E>(part); const float xt = f0p[31*F0P] - part; x7 = (p == 3) ? xt : x7; }
        { const f32x4 a0 = *(const LAS f32x4*)(f1p + 32*F1P + 0); const f32x4 a1 = *(const LAS f32x4*)(f1p + 32*F1P + 4); float part = (a0.x * x0 + a0.z * x2 + a1.x * x4 + a1.z * x6) + (a0.y * x1 + a0.w * x3 + a1.y * x5 + a1.w * x7); part += dpp_mov<0xB1>(part); part += dpp_mov<0x4E>(part); const float xt = f0p[32*F0P] - part; x8 = (p == 0) ? xt : x8; }
        { const f32x4 a0 = *(const LAS f32x4*)(f1p + 33*F1P + 0); const f32x4 a1 = *(const LAS f32x4*)(f1p + 33*F1P + 4); const f32x4 a2 = *(const LAS f32x4*)(f1p + 33*F1P + 8); float part = (a0.x * x0 + a0.z * x2 + a1.x * x4 + a1.z * x6 + a2.x * x8) + (a0.y * x1 + a0.w * x3 + a1.y * x5 + a1.w * x7); part += dpp_mov<0xB1>(part); part += dpp_mov<0x4E>(part); const float xt = f0p[33*F0P] - part; x8 = (p == 1) ? xt : x8; }
        { const f32x4 a0 = *(const LAS f32x4*)(f1p + 34*F1P + 0); const f32x4 a1 = *(const LAS f32x4*)(f1p + 34*F1P + 4); const f32x4 a2 = *(const LAS f32x4*)(f1p + 34*F1P + 8); float part = (a0.x * x0 + a0.z * x2 + a1.x * x4 + a1.z * x6 + a2.x * x8) + (a0.y * x1 + a0.w * x3 + a1.y * x5 + a1.w * x7); part += dpp_mov<0xB1>(part); part += dpp_mov<0x4E>(part); const float xt = f0p[34*F0P] - part; x8 = (p == 2) ? xt : x8; }
        { const f32x4 a0 = *(const LAS f32x4*)(f1p + 35*F1P + 0); const f32x4 a1 = *(const LAS f32x4*)(f1p + 35*F1P + 4); const f32x4 a2 = *(const LAS f32x4*)(f1p + 35*F1P + 8); float part = (a0.x * x0 + a0.z * x2 + a1.x * x4 + a1.z * x6 + a2.x * x8) + (a0.y * x1 + a0.w * x3 + a1.y * x5 + a1.w * x7); part += dpp_mov<0xB1>(part); part += dpp_mov<0x4E>(part); const float xt = f0p[35*F0P] - part; x8 = (p == 3) ? xt : x8; }
        { const f32x4 a0 = *(const LAS f32x4*)(f1p + 36*F1P + 0); const f32x4 a1 = *(const LAS f32x4*)(f1p + 36*F1P + 4); const f32x4 a2 = *(const LAS f32x4*)(f1p + 36*F1P + 8); float part = (a0.x * x0 + a0.z * x2 + a1.x * x4 + a1.z * x6 + a2.x * x8) + (a0.y * x1 + a0.w * x3 + a1.y * x5 + a1.w * x7); part += dpp_mov<0xB1>(part); part += dpp_mov<0x4E>(part); const float xt = f0p[36*F0P] - part; x9 = (p == 0) ? xt : x9; }
        { const f32x4 a0 = *(const LAS f32x4*)(f1p + 37*F1P + 0); const f32x4 a1 = *(const LAS f32x4*)(f1p + 37*F1P + 4); const f32x4 a2 = *(const LAS f32x4*)(f1p + 37*F1P + 8); float part = (a0.x * x0 + a0.z * x2 + a1.x * x4 + a1.z * x6 + a2.x * x8) + (a0.y * x1 + a0.w * x3 + a1.y * x5 + a1.w * x7 + a2.y * x9); part += dpp_mov<0xB1>(part); part += dpp_mov<0x4E>(part); const float xt = f0p[37*F0P] - part; x9 = (p == 1) ? xt : x9; }
        { const f32x4 a0 = *(const LAS f32x4*)(f1p + 38*F1P + 0); const f32x4 a1 = *(const LAS f32x4*)(f1p + 38*F1P + 4); const f32x4 a2 = *(const LAS f32x4*)(f1p + 38*F1P + 8); float part = (a0.x * x0 + a0.z * x2 + a1.x * x4 + a1.z * x6 + a2.x * x8) + (a0.y * x1 + a0.w * x3 + a1.y * x5 + a1.w * x7 + a2.y * x9); part += dpp_mov<0xB1>(part); part += dpp_mov<0x4E>(part); const float xt = f0p[38*F0P] - part; x9 = (p == 2) ? xt : x9; }
        { const f32x4 a0 = *(const LAS f32x4*)(f1p + 39*F1P + 0); const f32x4 a1 = *(const LAS f32x4*)(f1p + 39*F1P + 4); const f32x4 a2 = *(const LAS f32x4*)(f1p + 39*F1P + 8); float part = (a0.x * x0 + a0.z * x2 + a1.x * x4 + a1.z * x6 + a2.x * x8) + (a0.y * x1 + a0.w * x3 + a1.y * x5 + a1.w * x7 + a2.y * x9); part += dpp_mov<0xB1>(part); part += dpp_mov<0x4E>(part); const float xt = f0p[39*F0P] - part; x9 = (p == 3) ? xt : x9; }
        { const f32x4 a0 = *(const LAS f32x4*)(f1p + 40*F1P + 0); const f32x4 a1 = *(const LAS f32x4*)(f1p + 40*F1P + 4); const f32x4 a2 = *(const LAS f32x4*)(f1p + 40*F1P + 8); float part = (a0.x * x0 + a0.z * x2 + a1.x * x4 + a1.z * x6 + a2.x * x8) + (a0.y * x1 + a0.w * x3 + a1.y * x5 + a1.w * x7 + a2.y * x9); part += dpp_mov<0xB1>(part); part += dpp_mov<0x4E>(part); const float xt = f0p[40*F0P] - part; x10 = (p == 0) ? xt : x10; }
        { const f32x4 a0 = *(const LAS f32x4*)(f1p + 41*F1P + 0); const f32x4 a1 = *(const LAS f32x4*)(f1p + 41*F1P + 4); const f32x4 a2 = *(const LAS f32x4*)(f1p + 41*F1P + 8); float part = (a0.x * x0 + a0.z * x2 + a1.x * x4 + a1.z * x6 + a2.x * x8 + a2.z * x10) + (a0.y * x1 + a0.w * x3 + a1.y * x5 + a1.w * x7 + a2.y * x9); part += dpp_mov<0xB1>(part); part += dpp_mov<0x4E>(part); const float xt = f0p[41*F0P] - part; x10 = (p == 1) ? xt : x10; }
        { const f32x4 a0 = *(const LAS f32x4*)(f1p + 42*F1P + 0); const f32x4 a1 = *(const LAS f32x4*)(f1p + 42*F1P + 4); const f32x4 a2 = *(const LAS f32x4*)(f1p + 42*F1P + 8); float part = (a0.x * x0 + a0.z * x2 + a1.x * x4 + a1.z * x6 + a2.x * x8 + a2.z * x10) + (a0.y * x1 + a0.w * x3 + a1.y * x5 + a1.w * x7 + a2.y * x9); part += dpp_mov<0xB1>(part); part += dpp_mov<0x4E>(part); const float xt = f0p[42*F0P] - part; x10 = (p == 2) ? xt : x10; }
        { const f32x4 a0 = *(const LAS f32x4*)(f1p + 43*F1P + 0); const f32x4 a1 = *(const LAS f32x4*)(f1p + 43*F1P + 4); const f32x4 a2 = *(const LAS f32x4*)(f1p + 43*F1P + 8); float part = (a0.x * x0 + a0.z * x2 + a1.x * x4 + a1.z * x6 + a2.x * x8 + a2.z * x10) + (a0.y * x1 + a0.w * x3 + a1.y * x5 + a1.w * x7 + a2.y * x9); part += dpp_mov<0xB1>(part); part += dpp_mov<0x4E>(part); const float xt = f0p[43*F0P] - part; x10 = (p == 3) ? xt : x10; }
        { const f32x4 a0 = *(const LAS f32x4*)(f1p + 44*F1P + 0); const f32x4 a1 = *(const LAS f32x4*)(f1p + 44*F1P + 4); const f32x4 a2 = *(const LAS f32x4*)(f1p + 44*F1P + 8); float part = (a0.x * x0 + a0.z * x2 + a1.x * x4 + a1.z * x6 + a2.x * x8 + a2.z * x10) + (a0.y * x1 + a0.w * x3 + a1.y * x5 + a1.w * x7 + a2.y * x9); part += dpp_mov<0xB1>(part); part += dpp_mov<0x4E>(part); const float xt = f0p[44*F0P] - part; x11 = (p == 0) ? xt : x11; }
        { const f32x4 a0 = *(const LAS f32x4*)(f1p + 45*F1P + 0); const f32x4 a1 = *(const LAS f32x4*)(f1p + 45*F1P + 4); const f32x4 a2 = *(const LAS f32x4*)(f1p + 45*F1P + 8); float part = (a0.x * x0 + a0.z * x2 + a1.x * x4 + a1.z * x6 + a2.x * x8 + a2.z * x10) + (a0.y * x1 + a0.w * x3 + a1.y * x5 + a1.w * x7 + a2.y * x9 + a2.w * x11); part += dpp_mov<0xB1>(part); part += dpp_mov<0x4E>(part); const float xt = f0p[45*F0P] - part; x11 = (p == 1) ? xt : x11; }
        { const f32x4 a0 = *(const LAS f32x4*)(f1p + 46*F1P + 0); const f32x4 a1 = *(const LAS f32x4*)(f1p + 46*F1P + 4); const f32x4 a2 = *(const LAS f32x4*)(f1p + 46*F1P + 8); float part = (a0.x * x0 + a0.z * x2 + a1.x * x4 + a1.z * x6 + a2.x * x8 + a2.z * x10) + (a0.y * x1 + a0.w * x3 + a1.y * x5 + a1.w * x7 + a2.y * x9 + a2.w * x11); part += dpp_mov<0xB1>(part); part += dpp_mov<0x4E>(part); const float xt = f0p[46*F0P] - part; x11 = (p == 2) ? xt : x11; }
        { const f32x4 a0 = *(const LAS f32x4*)(f1p + 47*F1P + 0); const f32x4 a1 = *(const LAS f32x4*)(f1p + 47*F1P + 4); const f32x4 a2 = *(const LAS f32x4*)(f1p + 47*F1P + 8); float part = (a0.x * x0 + a0.z * x2 + a1.x * x4 + a1.z * x6 + a2.x * x8 + a2.z * x10) + (a0.y * x1 + a0.w * x3 + a1.y * x5 + a1.w * x7 + a2.y * x9 + a2.w * x11); part += dpp_mov<0xB1>(part); part += dpp_mov<0x4E>(part); const float xt = f0p[47*F0P] - part; x11 = (p == 3) ? xt : x11; }
        { const f32x4 a0 = *(const LAS f32x4*)(f1p + 48*F1P + 0); const f32x4 a1 = *(const LAS f32x4*)(f1p + 48*F1P + 4); const f32x4 a2 = *(const LAS f32x4*)(f1p + 48*F1P + 8); float part = (a0.x * x0 + a0.z * x2 + a1.x * x4 + a1.z * x6 + a2.x * x8 + a2.z * x10) + (a0.y * x1 + a0.w * x3 + a1.y * x5 + a1.w * x7 + a2.y * x9 + a2.w * x11); part += dpp_mov<0xB1>(part); part += dpp_mov<0x4E>(part); const float xt = f0p[48*F0P] - part; x12 = (p == 0) ? xt : x12; }
        { const f32x4 a0 = *(const LAS f32x4*)(f1p + 49*F1P + 0); const f32x4 a1 = *(const LAS f32x4*)(f1p + 49*F1P + 4); const f32x4 a2 = *(const LAS f32x4*)(f1p + 49*F1P + 8); const f32x4 a3 = *(const LAS f32x4*)(f1p + 49*F1P + 12); float part = (a0.x * x0 + a0.z * x2 + a1.x * x4 + a1.z * x6 + a2.x * x8 + a2.z * x10 + a3.x * x12) + (a0.y * x1 + a0.w * x3 + a1.y * x5 + a1.w * x7 + a2.y * x9 + a2.w * x11); part += dpp_mov<0xB1>(part); part += dpp_mov<0x4E>(part); const float xt = f0p[49*F0P] - part; x12 = (p == 1) ? xt : x12; }
        { const f32x4 a0 = *(const LAS f32x4*)(f1p + 50*F1P + 0); const f32x4 a1 = *(const LAS f32x4*)(f1p + 50*F1P + 4); const f32x4 a2 = *(const LAS f32x4*)(f1p + 50*F1P + 8); const f32x4 a3 = *(const LAS f32x4*)(f1p + 50*F1P + 12); float part = (a0.x * x0 + a0.z * x2 + a1.x * x4 + a1.z * x6 + a2.x * x8 + a2.z * x10 + a3.x * x12) + (a0.y * x1 + a0.w * x3 + a1.y * x5 + a1.w * x7 + a2.y * x9 + a2.w * x11); part += dpp_mov<0xB1>(part); part += dpp_mov<0x4E>(part); const float xt = f0p[50*F0P] - part; x12 = (p == 2) ? xt : x12; }
        { const f32x4 a0 = *(const LAS f32x4*)(f1p + 51*F1P + 0); const f32x4 a1 = *(const LAS f32x4*)(f1p + 51*F1P + 4); const f32x4 a2 = *(const LAS f32x4*)(f1p + 51*F1P + 8); const f32x4 a3 = *(const LAS f32x4*)(f1p + 51*F1P + 12); float part = (a0.x * x0 + a0.z * x2 + a1.x * x4 + a1.z * x6 + a2.x * x8 + a2.z * x10 + a3.x * x12) + (a0.y * x1 + a0.w * x3 + a1.y * x5 + a1.w * x7 + a2.y * x9 + a2.w * x11); part += dpp_mov<0xB1>(part); part += dpp_mov<0x4E>(part); const float xt = f0p[51*F0P] - part; x12 = (p == 3) ? xt : x12; }
        { const f32x4 a0 = *(const LAS f32x4*)(f1p + 52*F1P + 0); const f32x4 a1 = *(const LAS f32x4*)(f1p + 52*F1P + 4); const f32x4 a2 = *(const LAS f32x4*)(f1p + 52*F1P + 8); const f32x4 a3 = *(const LAS f32x4*)(f1p + 52*F1P + 12); float part = (a0.x * x0 + a0.z * x2 + a1.x * x4 + a1.z * x6 + a2.x * x8 + a2.z * x10 + a3.x * x12) + (a0.y * x1 + a0.w * x3 + a1.y * x5 + a1.w * x7 + a2.y * x9 + a2.w * x11); part += dpp_mov<0xB1>(part); part += dpp_mov<0x4E>(part); const float xt = f0p[52*F0P] - part; x13 = (p == 0) ? xt : x13; }
        { const f32x4 a0 = *(const LAS f32x4*)(f1p + 53*F1P + 0); const f32x4 a1 = *(const LAS f32x4*)(f1p + 53*F1P + 4); const f32x4 a2 = *(const LAS f32x4*)(f1p + 53*F1P + 8); const f32x4 a3 = *(const LAS f32x4*)(f1p + 53*F1P + 12); float part = (a0.x * x0 + a0.z * x2 + a1.x * x4 + a1.z * x6 + a2.x * x8 + a2.z * x10 + a3.x * x12) + (a0.y * x1 + a0.w * x3 + a1.y * x5 + a1.w * x7 + a2.y * x9 + a2.w * x11 + a3.y * x13); part += dpp_mov<0xB1>(part); part += dpp_mov<0x4E>(part); const float xt = f0p[53*F0P] - part; x13 = (p == 1) ? xt : x13; }
        { const f32x4 a0 = *(const LAS f32x4*)(f1p + 54*F1P + 0); const f32x4 a1 = *(const LAS f32x4*)(f1p + 54*F1P + 4); const f32x4 a2 = *(const LAS f32x4*)(f1p + 54*F1P + 8); const f32x4 a3 = *(const LAS f32x4*)(f1p + 54*F1P + 12); float part = (a0.x * x0 + a0.z * x2 + a1.x * x4 + a1.z * x6 + a2.x * x8 + a2.z * x10 + a3.x * x12) + (a0.y * x1 + a0.w * x3 + a1.y * x5 + a1.w * x7 + a2.y * x9 + a2.w * x11 + a3.y * x13); part += dpp_mov<0xB1>(part); part += dpp_mov<0x4E>(part); const float xt = f0p[54*F0P] - part; x13 = (p == 2) ? xt : x13; }
        { const f32x4 a0 = *(const LAS f32x4*)(f1p + 55*F1P + 0); const f32x4 a1 = *(const LAS f32x4*)(f1p + 55*F1P + 4); const f32x4 a2 = *(const LAS f32x4*)(f1p + 55*F1P + 8); const f32x4 a3 = *(const LAS f32x4*)(f1p + 55*F1P + 12); float part = (a0.x * x0 + a0.z * x2 + a1.x * x4 + a1.z * x6 + a2.x * x8 + a2.z * x10 + a3.x * x12) + (a0.y * x1 + a0.w * x3 + a1.y * x5 + a1.w * x7 + a2.y * x9 + a2.w * x11 + a3.y * x13); part += dpp_mov<0xB1>(part); part += dpp_mov<0x4E>(part); const float xt = f0p[55*F0P] - part; x13 = (p == 3) ? xt : x13; }
        { const f32x4 a0 = *(const LAS f32x4*)(f1p + 56*F1P + 0); const f32x4 a1 = *(const LAS f32x4*)(f1p + 56*F1P + 4); const f32x4 a2 = *(const LAS f32x4*)(f1p + 56*F1P + 8); const f32x4 a3 = *(const LAS f32x4*)(f1p + 56*F1P + 12); float part = (a0.x * x0 + a0.z * x2 + a1.x * x4 + a1.z * x6 + a2.x * x8 + a2.z * x10 + a3.x * x12) + (a0.y * x1 + a0.w * x3 + a1.y * x5 + a1.w * x7 + a2.y * x9 + a2.w * x11 + a3.y * x13); part += dpp_mov<0xB1>(part); part += dpp_mov<0x4E>(part); const float xt = f0p[56*F0P] - part; x14 = (p == 0) ? xt : x14; }
        { const f32x4 a0 = *(const LAS f32x4*)(f1p + 57*F1P + 0); const f32x4 a1 = *(const LAS f32x4*)(f1p + 57*F1P + 4); const f32x4 a2 = *(const LAS f32x4*)(f1p + 57*F1P + 8); const f32x4 a3 = *(const LAS f32x4*)(f1p + 57*F1P + 12); float part = (a0.x * x0 + a0.z * x2 + a1.x * x4 + a1.z * x6 + a2.x * x8 + a2.z * x10 + a3.x * x12 + a3.z * x14) + (a0.y * x1 + a0.w * x3 + a1.y * x5 + a1.w * x7 + a2.y * x9 + a2.w * x11 + a3.y * x13); part += dpp_mov<0xB1>(part); part += dpp_mov<0x4E>(part); const float xt = f0p[57*F0P] - part; x14 = (p == 1) ? xt : x14; }
        { const f32x4 a0 = *(const LAS f32x4*)(f1p + 58*F1P + 0); const f32x4 a1 = *(const LAS f32x4*)(f1p + 58*F1P + 4); const f32x4 a2 = *(const LAS f32x4*)(f1p + 58*F1P + 8); const f32x4 a3 = *(const LAS f32x4*)(f1p + 58*F1P + 12); float part = (a0.x * x0 + a0.z * x2 + a1.x * x4 + a1.z * x6 + a2.x * x8 + a2.z * x10 + a3.x * x12 + a3.z * x14) + (a0.y * x1 + a0.w * x3 + a1.y * x5 + a1.w * x7 + a2.y * x9 + a2.w * x11 + a3.y * x13); part += dpp_mov<0xB1>(part); part += dpp_mov<0x4E>(part); const float xt = f0p[58*F0P] - part; x14 = (p == 2) ? xt : x14; }
        { const f32x4 a0 = *(const LAS f32x4*)(f1p + 59*F1P + 0); const f32x4 a1 = *(const LAS f32x4*)(f1p + 59*F1P + 4); const f32x4 a2 = *(const LAS f32x4*)(f1p + 59*F1P + 8); const f32x4 a3 = *(const LAS f32x4*)(f1p + 59*F1P + 12); float part = (a0.x * x0 + a0.z * x2 + a1.x * x4 + a1.z * x6 + a2.x * x8 + a2.z * x10 + a3.x * x12 + a3.z * x14) + (a0.y * x1 + a0.w * x3 + a1.y * x5 + a1.w * x7 + a2.y * x9 + a2.w * x11 + a3.y * x13); part += dpp_mov<0xB1>(part); part += dpp_mov<0x4E>(part); const float xt = f0p[59*F0P] - part; x14 = (p == 3) ? xt : x14; }
        { const f32x4 a0 = *(const LAS f32x4*)(f1p + 60*F1P + 0); const f32x4 a1 = *(const LAS f32x4*)(f1p + 60*F1P + 4); const f32x4 a2 = *(const LAS f32x4*)(f1p + 60*F1P + 8); const f32x4 a3 = *(const LAS f32x4*)(f1p + 60*F1P + 12); float part = (a0.x * x0 + a0.z * x2 + a1.x * x4 + a1.z * x6 + a2.x * x8 + a2.z * x10 + a3.x * x12 + a3.z * x14) + (a0.y * x1 + a0.w * x3 + a1.y * x5 + a1.w * x7 + a2.y * x9 + a2.w * x11 + a3.y * x13); part += dpp_mov<0xB1>(part); part += dpp_mov<0x4E>(part); const float xt = f0p[60*F0P] - part; x15 = (p == 0) ? xt : x15; }
        { const f32x4 a0 = *(const LAS f32x4*)(f1p + 61*F1P + 0); const f32x4 a1 = *(const LAS f32x4*)(f1p + 61*F1P + 4); const f32x4 a2 = *(const LAS f32x4*)(f1p + 61*F1P + 8); const f32x4 a3 = *(const LAS f32x4*)(f1p + 61*F1P + 12); float part = (a0.x * x0 + a0.z * x2 + a1.x * x4 + a1.z * x6 + a2.x * x8 + a2.z * x10 + a3.x * x12 + a3.z * x14) + (a0.y * x1 + a0.w * x3 + a1.y * x5 + a1.w * x7 + a2.y * x9 + a2.w * x11 + a3.y * x13 + a3.w * x15); part += dpp_mov<0xB1>(part); part += dpp_mov<0x4E>(part); const float xt = f0p[61*F0P] - part; x15 = (p == 1) ? xt : x15; }
        { const f32x4 a0 = *(const LAS f32x4*)(f1p + 62*F1P + 0); const f32x4 a1 = *(const LAS f32x4*)(f1p + 62*F1P + 4); const f32x4 a2 = *(const LAS f32x4*)(f1p + 62*F1P + 8); const f32x4 a3 = *(const LAS f32x4*)(f1p + 62*F1P + 12); float part = (a0.x * x0 + a0.z * x2 + a1.x * x4 + a1.z * x6 + a2.x * x8 + a2.z * x10 + a3.x * x12 + a3.z * x14) + (a0.y * x1 + a0.w * x3 + a1.y * x5 + a1.w * x7 + a2.y * x9 + a2.w * x11 + a3.y * x13 + a3.w * x15); part += dpp_mov<0xB1>(part); part += dpp_mov<0x4E>(part); const float xt = f0p[62*F0P] - part; x15 = (p == 2) ? xt : x15; }
        { const f32x4 a0 = *(const LAS f32x4*)(f1p + 63*F1P + 0); const f32x4 a1 = *(const LAS f32x4*)(f1p + 63*F1P + 4); const f32x4 a2 = *(const LAS f32x4*)(f1p + 63*F1P + 8); const f32x4 a3 = *(const LAS f32x4*)(f1p + 63*F1P + 12); float part = (a0.x * x0 + a0.z * x2 + a1.x * x4 + a1.z * x6 + a2.x * x8 + a2.z * x10 + a3.x * x12 + a3.z * x14) + (a0.y * x1 + a0.w * x3 + a1.y * x5 + a1.w * x7 + a2.y * x9 + a2.w * x11 + a3.y * x13 + a3.w * x15); part += dpp_mov<0xB1>(part); part += dpp_mov<0x4E>(part); const float xt = f0p[63*F0P] - part; x15 = (p == 3) ? xt : x15; }
        LAS unsigned char* dst = (wave < 4 ? B3 : B0) + (j & 63) * BLD + p * 2;
        *(LAS unsigned short*)(dst + 0) = (unsigned short)f2bf(-x0);
        *(LAS unsigned short*)(dst + 8) = (unsigned short)f2bf(-x1);
        *(LAS unsigned short*)(dst + 16) = (unsigned short)f2bf(-x2);
        *(LAS unsigned short*)(dst + 24) = (unsigned short)f2bf(-x3);
        *(LAS unsigned short*)(dst + 32) = (unsigned short)f2bf(-x4);
        *(LAS unsigned short*)(dst + 40) = (unsigned short)f2bf(-x5);
        *(LAS unsigned short*)(dst + 48) = (unsigned short)f2bf(-x6);
        *(LAS unsigned short*)(dst + 56) = (unsigned short)f2bf(-x7);
        *(LAS unsigned short*)(dst + 64) = (unsigned short)f2bf(-x8);
        *(LAS unsigned short*)(dst + 72) = (unsigned short)f2bf(-x9);
        *(LAS unsigned short*)(dst + 80) = (unsigned short)f2bf(-x10);
        *(LAS unsigned short*)(dst + 88) = (unsigned short)f2bf(-x11);
        *(LAS unsigned short*)(dst + 96) = (unsigned short)f2bf(-x12);
        *(LAS unsigned short*)(dst + 104) = (unsigned short)f2bf(-x13);
        *(LAS unsigned short*)(dst + 112) = (unsigned short)f2bf(-x14);
        *(LAS unsigned short*)(dst + 120) = (unsigned short)f2bf(-x15);
    }
    LDS_BAR();
    {
        f32x4 rp[2], yl[2] = {z4, z4}, gg[2], hl[2] = {z4, z4};
#pragma unroll
        for (int c = 0; c < 2; ++c)
#pragma unroll
            for (int rg = 0; rg < 4; ++rg) { const int row = 16 * rb + 4 * g + rg, col = 16 * (cb0 + c) + lc; rp[c][rg] = F2[row * 64 + col]; gg[c][rg] = row == col ? GC[row] : 0.f; }
#pragma unroll
        for (int ks = 0; ks < 2; ++ks) { const bf16x8 farb = ldfrag(B1, rb, ks, lane), fark = ldfrag(B2, rb, ks, lane), fbb = ldfrag(B6, rb, ks, lane), fkb = ldfrag(B5, rb, ks, lane);
#pragma unroll
            for (int c = 0; c < 2; ++c) { const bf16x8 fp = ldfrag(B3, cb0 + c, ks, lane), fq = ldfrag(B0, cb0 + c, ks, lane), fv = ldfrag(B4, cb0 + c, ks, lane);
                rp[c] = MFMA16(farb, fp, rp[c]); yl[c] = MFMA16(fark, fv, yl[c]); yl[c] = MFMA16(farb, fq, yl[c]);
                gg[c] = MFMA16(fbb, fp, gg[c]); hl[c] = MFMA16(fkb, fv, hl[c]); hl[c] = MFMA16(fbb, fq, hl[c]); } }
        bf16* RPg = (bf16*)(ws + SC_RP) + (size_t)unit * 4096; float* YLg = (float*)(ws + SC_YL) + (size_t)unit * 4096; bf16* Gg_ = (bf16*)(ws + SC_G) + (size_t)unit * 4096; float* HLg = (float*)(ws + SC_HL) + (size_t)unit * 4096;
#pragma unroll
        for (int c = 0; c < 2; ++c)
#pragma unroll
            for (int rg = 0; rg < 4; ++rg) { const int o = (16 * rb + 4 * g + rg) * 64 + 16 * (cb0 + c) + lc;
                RPg[o] = (bf16)f2bf(rp[c][rg]); YLg[o] = yl[c][rg]; Gg_[o] = (bf16)f2bf(gg[c][rg]); HLg[o] = hl[c][rg]; }
    }
    }
#undef SA_LOAD
}

template <int NSTEP> __device__ __forceinline__ void scanB_chain(int l, LAS unsigned char* lds, int ci0, int h, int vs, const float* init, float* outp_state, int tid, int wave, bool active  ) {
    unsigned char* ws = KWS();
    const int lane = tid & 63, half = wave >> 2, jr = wave & 3, g = lane >> 4, lc = lane & 15;
    LAS unsigned char* XH = lds + half * 16384;
    const bf16* Gall = (const bf16*)(ws + SC_G); const float* HLall = (const float*)(ws + SC_HL); bf16* S0all = (bf16*)(ws + SC_S0);
    float zf; asm volatile("v_mov_b32 %0, 0" : "=v"(zf));
    f32x4 acc = (f32x4){zf, zf, zf, zf};
    __syncthreads();
    if (init && active) acc = *(const f32x4*)(init + (16 * vs + lc) * 64 + 16 * jr + 4 * g);
    constexpr int PF = NSTEP >= 16 ? 8 : 1;
    bf16x8 GA[PF][2], GB[PF][2]; f32x4 LA[PF], LB[PF];
#define SB_ISSUE(Gx, Lx, slot, c) do { if (active) { const size_t unit_ = (size_t)(ci0 + (c)) * 16 + h; const bf16* Gp = Gall + unit_ * 4096 + (16 * jr + lc) * 64 + 8 * g; const float* Lp = HLall + unit_ * 4096 + (16 * jr + 4 * g) * 64 + 16 * vs + lc; \
        Gx[slot][0] = *(const bf16x8*)Gp; Gx[slot][1] = *(const bf16x8*)(Gp + 32); Lx[slot] = (f32x4){Lp[0], Lp[64], Lp[128], Lp[192]}; } } while (0)
#define SB_STEP(Gx, Lx, slot, c) do { const size_t unit = (size_t)(ci0 + (c)) * 16 + h; LAS unsigned char* xb = XH + ((c) & 1) * 8192; \
        if (active) { const unsigned h0 = pk2(acc.x, acc.y), h1 = pk2(acc.z, acc.w); \
            const float l0 = acc.x - __builtin_bit_cast(float, h0 << 16), l1 = acc.y - __builtin_bit_cast(float, h0 & 0xffff0000u), l2 = acc.z - __builtin_bit_cast(float, h1 << 16), l3 = acc.w - __builtin_bit_cast(float, h1 & 0xffff0000u); \
            *(LAS u32x2*)(xb + lc * BLD + (16 * jr + 4 * g) * 2) = (u32x2){h0, h1}; \
            *(LAS u32x2*)(xb + 4096 + lc * BLD + (16 * jr + 4 * g) * 2) = (u32x2){pk2(l0, l1), pk2(l2, l3)}; \
            *(u32x2*)(S0all + unit * 4096 + (16 * vs + lc) * 64 + 16 * jr + 4 * g) = (u32x2){h0, h1}; }            \
        asm volatile("s_waitcnt lgkmcnt(0)" ::: "memory"); __builtin_amdgcn_s_barrier(); asm volatile("" ::: "memory");     \
        if (active) { f32x4 a2 = Lx[slot]; \
            _Pragma("unroll") for (int ks = 0; ks < 2; ++ks) { const bf16x8 bh = *(const LAS bf16x8*)(xb + lc * BLD + (32 * ks + 8 * g) * 2), bl = *(const LAS bf16x8*)(xb + 4096 + lc * BLD + (32 * ks + 8 * g) * 2); \
                a2 = MFMA16(Gx[slot][ks], bh, a2); a2 = MFMA16(Gx[slot][ks], bl, a2); } \
            acc = a2; } } while (0)
    if constexpr (NSTEP < 16) {
        for (int c = 0; c < NSTEP; ++c) { SB_ISSUE(GA, LA, 0, c); SB_STEP(GA, LA, 0, c); }
    } else {
        static_assert(NSTEP < 16 || NSTEP % 16 == 0, "pass B group structure");
#pragma unroll
        for (int s = 0; s < PF; ++s) SB_ISSUE(GA, LA, s, s);
        for (int c0 = 0; c0 < NSTEP; c0 += 16) {
            SB_STEP(GA, LA, 0, c0);
#pragma unroll
            for (int s = 0; s < PF; ++s) SB_ISSUE(GB, LB, s, c0 + 8 + s);
#pragma unroll
            for (int s = 1; s < PF; ++s) SB_STEP(GA, LA, s, c0 + s);
            SB_STEP(GB, LB, 0, c0 + 8);
            if (c0 + 16 < NSTEP) {
#pragma unroll
                for (int s = 0; s < PF; ++s) SB_ISSUE(GA, LA, s, c0 + 16 + s); }
#pragma unroll
            for (int s = 1; s < PF; ++s) SB_STEP(GB, LB, s, c0 + 8 + s);
        }
    }
    if (active) *(f32x4*)(outp_state + (16 * vs + lc) * 64 + 16 * jr + 4 * g) = acc;
#undef SB_ISSUE
#undef SB_STEP
}

__device__ __forceinline__ void scanC_all(int l, LAS unsigned char* lds, int bx, int G, int tid, int wave) {
    unsigned char* ws = KWS();
    const int lane = tid & 63, rb = wave >> 1, cb0 = (wave & 1) * 2, g = lane >> 4, lc = lane & 15, t0 = 8 * wave;
    const float* ssh = KIN(I_SSH); const float* mu = KIN(I_MU) + (size_t)l * SHIFT; const float* gngp = KIN(I_GNG) + (size_t)l * RW; const float* gnbp = KIN(I_GNB) + (size_t)l * RW;
    const float* P = (const float*)(ws + B_P); const float* Gg = (const float*)(ws + WS_RW + 2 * RWSZ); bf16* MIXB = (bf16*)(ws + B_MIX);
    LAS float* Yl = (LAS float*)lds;
    f32x4 acc[2]; bf16x8 fa[2], fb[2][2]; float pv_[8], gt_[8], bn_[8], q_v, mu_v, gng, gnb;
#define SC_LOAD(unit_) do { const int ci_ = (unit_) >> 4, cc_ = 64 * ((unit_) & 15) + lane; const int m0_ = ci_ < 256 ? 64 * ci_ : TP + 32 * (ci_ - 256), n_ = ci_ < 256 ? 64 : 32; \
        const bf16* RPg = (const bf16*)(ws + SC_RP) + (size_t)(unit_) * 4096; const float* YLg = (const float*)(ws + SC_YL) + (size_t)(unit_) * 4096; const bf16* S0g = (const bf16*)(ws + SC_S0) + (size_t)(unit_) * 4096; const float* bon_ = (const float*)(ws + SC_BON) + (size_t)(unit_) * 64; \
        _Pragma("unroll") for (int c = 0; c < 2; ++c) _Pragma("unroll") for (int rg = 0; rg < 4; ++rg) acc[c][rg] = YLg[(16 * rb + 4 * g + rg) * 64 + 16 * (cb0 + c) + lc]; \
        _Pragma("unroll") for (int ks = 0; ks < 2; ++ks) { fa[ks] = *(const bf16x8*)(RPg + (16 * rb + lc) * 64 + 32 * ks + 8 * g); _Pragma("unroll") for (int c = 0; c < 2; ++c) fb[ks][c] = *(const bf16x8*)(S0g + (16 * (cb0 + c) + lc) * 64 + 32 * ks + 8 * g); } \
        mu_v = mu[2 * RW + cc_]; gng = gngp[cc_]; gnb = gnbp[cc_]; q_v = 0.f; \
        _Pragma("unroll") for (int i = 0; i < 8; ++i) { pv_[i] = 0.f; gt_[i] = 0.f; bn_[i] = 0.f; } \
        if (t0 < n_) { const float* pp_ = prev_row(ssh, l, P, m0_ + t0); if (pp_) q_v = pp_[2 * RW + cc_]; \
            _Pragma("unroll") for (int i = 0; i < 8; ++i) { const size_t m_ = (size_t)(m0_ + t0 + i); pv_[i] = P[m_ * PLD + 2 * RW + cc_]; gt_[i] = Gg[m_ * RW + cc_]; bn_[i] = bon_[t0 + i]; } } } while (0)
    if (bx < NUNIT) SC_LOAD(bx);
    for (int unit = bx; unit < NUNIT; unit += G) {
        const int ci = unit >> 4, cc = 64 * (unit & 15) + lane; const int m0 = ci < 256 ? 64 * ci : TP + 32 * (ci - 256), n = ci < 256 ? 64 : 32;
        f32x4 y2[2] = {acc[0], acc[1]};
#pragma unroll
        for (int ks = 0; ks < 2; ++ks)
#pragma unroll
            for (int c = 0; c < 2; ++c) y2[c] = MFMA16(fa[ks], fb[ks][c], y2[c]);
        LDS_BAR();
#pragma unroll
        for (int c = 0; c < 2; ++c)
#pragma unroll
            for (int rg = 0; rg < 4; ++rg) Yl[(16 * rb + 4 * g + rg) * 65 + 16 * (cb0 + c) + lc] = y2[c][rg];
        LDS_BAR();
        unsigned short ov[8];
        if (t0 < n) {
            float qv = q_v;
#pragma unroll
            for (int i = 0; i < 8; ++i) { const int t = t0 + i;
                const float y = Yl[t * 65 + lane]; const float ym = wave_sum(y) * (1.f / HN); const float d = y - ym; const float yv = wave_sum(d * d) * (1.f / HN);
                const float yn = d * (1.f / sqrtf(yv + GN_EPS)) * gng + gnb;
                const float p_v = pv_[i]; const float vx = p_v + (qv - p_v) * mu_v; qv = p_v;
                ov[i] = (unsigned short)f2bf((yn + bn_[i] * vx) * gt_[i]); }
        }
        if (unit + G < NUNIT) SC_LOAD(unit + G);
        if (t0 < n) {
#pragma unroll
            for (int i = 0; i < 8; ++i) MIXB[(size_t)(m0 + t0 + i) * DM + cc] = (bf16)ov[i];
        }
    }
#undef SC_LOAD
}

template <int PH> __global__ void __launch_bounds__(NTHR, 2) mk_fwd(Args a) {
    extern __shared__ __attribute__((aligned(16))) unsigned char lds_raw[];
    LAS unsigned char* lds = (LAS unsigned char*)lds_raw;
    const int wave_s = __builtin_amdgcn_readfirstlane((int)threadIdx.x >> 6);
    for (int u = threadIdx.x; u < (LDS_BYTES - LDSCTL_OFF) / 4; u += NTHR) ((LAS unsigned*)(lds + LDSCTL_OFF))[u] = 0u;
    __syncthreads();
    if (PH < 0) (void)xcd_barrier_post((unsigned*)KWS() + CW_BAR, (volatile LAS unsigned*)(lds + MISC_OFF) + 8, (int)threadIdx.x);
#define IN(k) (PH < 0 || PH == (k))
#define PHASE_IDS() int tid_; asm volatile("v_mbcnt_lo_u32_b32 %0, -1, 0\n\tv_mbcnt_hi_u32_b32 %0, -1, %0\n\tv_lshl_add_u32 %0, %1, 6, %0" : "=&v"(tid_) : "s"(wave_s)); const int tid = tid_, lane = tid & 63, wave = wave_s; \
    const int G = gridDim.x, bx = blockIdx.x, vcu = (G % 8 == 0) ? (bx % 8) * (G / 8) + bx / 8 : bx, gw = vcu * NWAVES + wave, NGW = G * NWAVES; unsigned char* ws = KWS(); (void)tid; (void)lane; (void)gw; (void)NGW; (void)ws
#define SEAM() do { if (PH < 0) { XcdBarrier bar_; bar_.bar = (unsigned*)KWS() + CW_BAR; bar_.x = xb_xcc_id(); bar_.st = (volatile LAS unsigned*)(lds + MISC_OFF) + 8; xcd_barrier(bar_, tid); } } while (0)

    for (int l = a.l_lo; l < a.l_hi; ++l) {
        if (IN(0)) { PHASE_IDS(); phase_convert(l, lds, wave, lane, gw, NGW); SEAM(); }
        if (IN(1)) { PHASE_IDS(); pg8::Gemm g{(const bf16*)(ws + WS_XB), (const bf16*)(ws + W_1), M, 2 * FF, DM, DM}; pg8::StaticOrder S; S.init(M, 2 * FF, G, bx); pg8::EpiSwiGLU E{(bf16*)(ws + B_H), FF};
            pg8::gemm_phase<pg8::EpiSwiGLU, pg8::StaticOrder, true, true>(lds + RING_OFF, g, S, E, tid); SEAM(); }
        if (IN(2)) { PHASE_IDS();
            { pg8::Gemm g{(const bf16*)(ws + B_H), (const bf16*)(ws + W_2), TP, DM, FF, FF}; pg8::StaticOrder S; S.init(TP, DM, G, bx); pg8::EpiResid E{(const float*)(ws + WS_X), (float*)(ws + WS_Z), DM, ALPHA, 0.5f};
              pg8::gemm_phase<pg8::EpiResid, pg8::StaticOrder, true, true>(lds + RING_OFF, g, S, E, tid); }
            { pg8::Gemm g{(const bf16*)(ws + B_H), (const bf16*)(ws + W_2), M, DM, FF, 512}; pg8::SplitOrder S{G, bx, 11, 512}; pg8::EpiSlab E{(float*)(ws + WS_SLAB), 512};
              pg8::gemm_phase<pg8::EpiSlab, pg8::SplitOrder, false, true>(lds + RING_OFF, g, S, E, tid); }
            SEAM(); }
        if (IN(3)) { PHASE_IDS(); phase_ln((const float*)(ws + WS_Z), (const float*)(ws + WS_X), (const float*)(ws + WS_SLAB), 11, ALPHA, 0.5f, KIN(I_LNG) + (size_t)l * 3 * DM, KIN(I_LNB) + (size_t)l * 3 * DM, (float*)(ws + WS_X), (bf16*)(ws + WS_XB), lane, gw, NGW); SEAM(); }
        if (IN(4)) { PHASE_IDS(); pg8::Gemm g{(const bf16*)(ws + WS_XB), (const bf16*)(ws + W_3), M, N3, DM, DM}; pg8::StaticOrder S; S.init(M, N3, G, bx); pg8::EpiP E{(float*)(ws + B_P), (bf16*)(ws + B_U), (float*)(ws + B_GV)};
            pg8::gemm_phase<pg8::EpiP, pg8::StaticOrder, true, true>(lds + RING_OFF, g, S, E, tid); SEAM(); }
        if (IN(5)) { PHASE_IDS(); phase_prep1(l, lane, gw, NGW); SEAM(); }
        if (IN(6)) { PHASE_IDS(); pg8::Gemm g{(const bf16*)(ws + B_A3B), (const bf16*)(ws + W_3B), M, NL, LK, LK}; pg8::StaticOrder S; S.init(M, NL, G, bx);
            pg8::EpiLora E{(float*)(ws + WS_RW)};
            pg8::gemm_phase<pg8::EpiLora, pg8::StaticOrder, false, false>(lds + RING_OFF, g, S, E, tid); SEAM(); }
        if (IN(7)) { PHASE_IDS(); scanA_all(l, lds, bx, G, tid, wave); SEAM(); }
        if (IN(8)) { PHASE_IDS();
            if (bx < 64) { const int hh = bx >> 2; scanB_chain<256>(l, lds, 0, hh, bx & 3, nullptr, KOUT() + O_SP + ((size_t)l * NH + hh) * 4096, tid, wave, wave < 4); }
            else { const float* srw = KIN(I_SRW); float* outp = KOUT();
                for (int p = bx - 64; p < 512; p += G - 64) { const int task = 2 * p + (wave >> 2), b = task >> 6, hh = (task >> 2) & 15; const size_t so = (((size_t)l * NSB + b) * NH + hh) * 4096;
                    scanB_chain<1>(l, lds, 256 + b, hh, task & 3, srw + so, outp + O_SS + so, tid, wave, true); }
                for (int u = bx - 64; u < 144 * 8; u += G - 64) gmlp_unit(l, lds, u, tid, wave); }
            SEAM(); }
        if (IN(9)) { PHASE_IDS(); scanC_all(l, lds, bx, G, tid, wave); SEAM(); }
        if (IN(10)) { PHASE_IDS();
            { pg8::Gemm g{(const bf16*)(ws + B_MIX), (const bf16*)(ws + W_4), TP, DM, DM, DM}; pg8::StaticOrder S; S.init(TP, DM, G, bx); pg8::EpiResid E{(const float*)(ws + WS_X), (float*)(ws + WS_Z), DM, ALPHA, 1.0f};
              pg8::gemm_phase<pg8::EpiResid, pg8::StaticOrder, true, true>(lds + RING_OFF, g, S, E, tid); }
            { pg8::Gemm g{(const bf16*)(ws + B_MIX), (const bf16*)(ws + W_4), M, DM, DM, 256}; pg8::SplitOrder S{G, bx, 8, 256}; pg8::EpiSlab E{(float*)(ws + WS_SLAB), 256};
              pg8::gemm_phase<pg8::EpiSlab, pg8::SplitOrder, false, true>(lds + RING_OFF, g, S, E, tid); }
            SEAM(); }
        if (IN(11)) { PHASE_IDS(); phase_ln((const float*)(ws + WS_Z), (const float*)(ws + WS_X), (const float*)(ws + WS_SLAB), 8, ALPHA, 1.0f, KIN(I_LNG) + (size_t)(l * 3 + 1) * DM, KIN(I_LNB) + (size_t)(l * 3 + 1) * DM, (float*)(ws + WS_X), (bf16*)(ws + WS_XB), lane, gw, NGW); SEAM(); }
        if (IN(12)) { PHASE_IDS(); pg8::Gemm g{(const bf16*)(ws + WS_XB), (const bf16*)(ws + W_5), M, 2 * FF, DM, DM}; pg8::StaticOrder S; S.init(M, 2 * FF, G, bx); pg8::EpiSwiGLU E{(bf16*)(ws + B_H), FF};
            pg8::gemm_phase<pg8::EpiSwiGLU, pg8::StaticOrder, true, true>(lds + RING_OFF, g, S, E, tid); SEAM(); }
        if (IN(13)) { PHASE_IDS();
            { pg8::Gemm g{(const bf16*)(ws + B_H), (const bf16*)(ws + W_6), TP, DM, FF, FF}; pg8::StaticOrder S; S.init(TP, DM, G, bx); pg8::EpiResid E{(const float*)(ws + WS_X), (float*)(ws + WS_Z), DM, ALPHA, 0.5f};
              pg8::gemm_phase<pg8::EpiResid, pg8::StaticOrder, true, true>(lds + RING_OFF, g, S, E, tid); }
            { pg8::Gemm g{(const bf16*)(ws + B_H), (const bf16*)(ws + W_6), M, DM, FF, 512}; pg8::SplitOrder S{G, bx, 11, 512}; pg8::EpiSlab E{(float*)(ws + WS_SLAB), 512};
              pg8::gemm_phase<pg8::EpiSlab, pg8::SplitOrder, false, true>(lds + RING_OFF, g, S, E, tid); }
            SEAM(); }
        if (IN(14)) { PHASE_IDS(); const bool last = (l == DEPTH - 1);
            phase_ln((const float*)(ws + WS_Z), (const float*)(ws + WS_X), (const float*)(ws + WS_SLAB), 11, ALPHA, 0.5f, KIN(I_LNG) + (size_t)(l * 3 + 2) * DM, KIN(I_LNB) + (size_t)(l * 3 + 2) * DM, last ? KOUT() + O_YP : (float*)(ws + WS_X), last ? (bf16*)nullptr : (bf16*)(ws + WS_XB), lane, gw, NGW);
            if (!last) SEAM(); }
    }
#undef IN
#undef SEAM
#undef PHASE_IDS
}

template <int PH> static bool prep_kernel() { return hipFuncSetAttribute((const void*)mk_fwd<PH>, hipFuncAttributeMaxDynamicSharedMemorySize, LDS_BYTES) == hipSuccess; }
template <int PH> static void launch_phase(int grid, hipStream_t stream, Args a) { hipLaunchKernelGGL(mk_fwd<PH>, dim3(grid), dim3(NTHR), LDS_BYTES, stream, a); }
extern "C" void kernel_launch(void* const* d_in, const int* in_sizes, int n_in, void* d_out, int out_size, void* d_ws, size_t ws_size, hipStream_t stream) {
    static int grid = 0;
    if (grid == 0) {
        if (n_in != 29 || (size_t)out_size != O_END || ws_size < WS_END) { fprintf(stderr, "kernel_launch: unexpected shapes: n_in %d out %d ws %zu (need %zu)\n", n_in, out_size, ws_size, (size_t)WS_END); grid = -1; return; }
        int dev = 0, cus = 0, per_cu = 0;
        if (hipGetDevice(&dev) != hipSuccess || hipDeviceGetAttribute(&cus, hipDeviceAttributeMultiprocessorCount, dev) != hipSuccess) { grid = -1; return; }
        bool ok = true;
#if MK_ONE_LAUNCH
        ok = prep_kernel<-1>();
        if (hipOccupancyMaxActiveBlocksPerMultiprocessor(&per_cu, (const void*)mk_fwd<-1>, NTHR, LDS_BYTES) != hipSuccess || per_cu < 1) fprintf(stderr, "kernel_launch: occupancy query says %d\n", per_cu);
#else
        ok = prep_kernel<0>() && prep_kernel<1>() && prep_kernel<2>() && prep_kernel<3>() && prep_kernel<4>() && prep_kernel<5>() && prep_kernel<6>() && prep_kernel<7>() && prep_kernel<8>() && prep_kernel<9>() && prep_kernel<10>() && prep_kernel<11>() && prep_kernel<12>() && prep_kernel<13>() && prep_kernel<14>();
#endif
        if (!ok) { fprintf(stderr, "kernel_launch: hipFuncSetAttribute failed\n"); grid = -1; return; }
        (void)hipGetLastError();
        grid = cus;
        if (grid < 64) { grid = -1; return; }
    }
    if (grid < 0) return;
    (void)hipMemsetAsync((char*)d_ws + WS_CTL, 0, CTL_ZERO_BYTES, stream);
    Args a{};
    for (int i = 0; i < 29; ++i) a.in[i] = (const float*)d_in[i];
    a.out = (float*)d_out; a.ws = (unsigned char*)d_ws;
#if MK_ONE_LAUNCH
    a.l_lo = 0; a.l_hi = DEPTH;
    launch_phase<-1>(grid, stream, a);
#else
    for (int l = 0; l < DEPTH; ++l) { a.l_lo = l; a.l_hi = l + 1;
        launch_phase<0>(grid, stream, a); launch_phase<1>(grid, stream, a); launch_phase<2>(grid, stream, a); launch_phase<3>(grid, stream, a); launch_phase<4>(grid, stream, a);
        launch_phase<5>(grid, stream, a); launch_phase<6>(grid, stream, a); launch_phase<7>(grid, stream, a); launch_phase<8>(grid, stream, a); launch_phase<9>(grid, stream, a);
        launch_phase<10>(grid, stream, a); launch_phase<11>(grid, stream, a); launch_phase<12>(grid, stream, a); launch_phase<13>(grid, stream, a); launch_phase<14>(grid, stream, a); }
#endif
}
```

```cpp
#include <hip/hip_runtime.h>
#include <cstdio>
#include <cstdint>
#define MK_ONE_LAUNCH 1
namespace pg8 {
#define PG8_LAS __attribute__((address_space(3)))
typedef unsigned short bf16_t;
typedef short bf16x8 __attribute__((ext_vector_type(8)));
typedef float f32x4 __attribute__((ext_vector_type(4)));
typedef unsigned u32x4 __attribute__((ext_vector_type(4)));
constexpr int BM = 256, BK = 64, HALF = 128, HTB = HALF * BK * 2  , STAGE_BYTES = 8 * HTB, NXCD = 8, WGM = 8;

__host__ __device__ __forceinline__ int lds_byte(int r, int c) { const int st = (r >> 4) * 2 + (c >> 5), rr = r & 15, cc = c & 31, ob = rr * 64 + cc * 2; return st * 1024 + (ob ^ (((ob >> 9) & 1) << 5)); }
__host__ __device__ __forceinline__ void stage_rc(int b, int& R, int& C) { const int st = b / 1024, sb = b % 1024, swz = sb ^ (((sb >> 9) & 1) << 5); R = (st >> 1) * 16 + swz / 64; C = (st & 1) * 32 + (swz % 64) / 2; }
__host__ __device__ __forceinline__ int perm32(int rho) { const int n = rho >> 4, i = rho & 15; return 8 * (i >> 2) + 4 * n + (i & 3); }

struct Unit { int pm, pn, k0; };
struct Gemm { const bf16_t* A; const bf16_t* Bt; int M, N, K, Kl; };

struct StaticOrder {
    int nM, nN, nwg, G, c;
    __host__ __device__ void init(int M, int N, int G_, int c_) { nM = M / BM; nN = N / BM; nwg = nM * nN; G = G_; c = c_; }
    __host__ __device__ bool next(int i, Unit& u) const {
        const long L = (long)i * G + c; if (L >= nwg) return false;
        int wgid = (int)L; { const int q = nwg / NXCD, r = nwg % NXCD, xcd = wgid % NXCD, off = wgid / NXCD; wgid = (xcd < r ? xcd * (q + 1) : r * (q + 1) + (xcd - r) * q) + off; }
        const int nig = WGM * nN, gid = wgid / nig, fm = gid * WGM, gsz = (nM - fm) < WGM ? (nM - fm) : WGM;
        u.pm = fm + ((wgid % nig) % gsz); u.pn = (wgid % nig) / gsz; u.k0 = 0; return true;
    }
    __device__ __forceinline__ void a_ready(const Unit&) const {}
    __device__ __forceinline__ void done(const Unit&) const {}
};
struct SplitOrder {
    int G, c, KS, Kl;
    __host__ __device__ bool next(int i, Unit& u) const { const int L = i * G + c; if (L >= 16 * KS) return false; const int ks = L >> 4, tile = L & 15; u.pm = 64 + (tile >> 3); u.pn = tile & 7; u.k0 = ks * Kl; return true; }
    __device__ __forceinline__ void a_ready(const Unit&) const {}
    __device__ __forceinline__ void done(const Unit&) const {}
};
__device__ __forceinline__ unsigned cvt_pk_bf16(float lo, float hi) { unsigned r; asm volatile("v_cvt_pk_bf16_f32 %0, %1, %2" : "=v"(r) : "v"(lo), "v"(hi)); return r; }
typedef float f32x2 __attribute__((ext_vector_type(2)));
__device__ __forceinline__ f32x2 gelu_pk(f32x2 v) {
    const f32x2 av = __builtin_elementwise_abs(v), d = av * 0.2316418882f + 1.0f;
    f32x2 t; t.x = __builtin_amdgcn_rcpf(d.x); t.y = __builtin_amdgcn_rcpf(d.y);
    f32x2 q = t * 0.5307027145f + (-0.7265760135f); q = q * t + 0.7107068705f; q = q * t + (-0.142248368f); q = q * t + 0.127414796f; q = q * t;
    const f32x2 s = (v * v) * (-0.72134752044f);
    f32x2 e; e.x = __builtin_amdgcn_exp2f(s.x); e.y = __builtin_amdgcn_exp2f(s.y);
    const f32x2 m = v * (q * e), r = v - m;
    f32x2 o; o.x = v.x < 0.f ? m.x : r.x; o.y = v.y < 0.f ? m.y : r.y; return o;
}

typedef unsigned u32x2 __attribute__((ext_vector_type(2)));
__device__ __forceinline__ float silu_f(float g) { return g * __builtin_amdgcn_rcpf(1.0f + __expf(-g)); }
struct EpiSwiGLU {
    static constexpr bool PERM = true, AFTER_DRAIN = false;
    bf16_t* O; int ldc;
    __device__ __forceinline__ void operator()(const f32x4 (&acc)[2][2][4][2], const Unit& u, int wr, int wc, int fr, int fq) const {
        const int row0 = u.pm * BM + wr * 64 + fr, col0 = u.pn * HALF + wc * 32 + 8 * fq;
#pragma unroll
        for (int ai = 0; ai < 2; ++ai)
#pragma unroll
            for (int m = 0; m < 4; ++m) { bf16_t* rowp = O + (size_t)(row0 + ai * HALF + m * 16) * ldc + col0;
                const f32x4 g0 = acc[ai][0][m][0], g1 = acc[ai][0][m][1], u0 = acc[ai][1][m][0], u1 = acc[ai][1][m][1];
                u32x4 w; w.x = cvt_pk_bf16(silu_f(g0[0]) * u0[0], silu_f(g0[1]) * u0[1]); w.y = cvt_pk_bf16(silu_f(g0[2]) * u0[2], silu_f(g0[3]) * u0[3]);
                w.z = cvt_pk_bf16(silu_f(g1[0]) * u1[0], silu_f(g1[1]) * u1[1]); w.w = cvt_pk_bf16(silu_f(g1[2]) * u1[2], silu_f(g1[3]) * u1[3]);
                *(u32x4*)rowp = w; }
    }
};
struct EpiResid {
    static constexpr bool PERM = false, AFTER_DRAIN = false;
    const float* base; float* out; int ldc; float sa, sb;
    __device__ __forceinline__ void operator()(const f32x4 (&acc)[2][2][4][2], const Unit& u, int wr, int wc, int fr, int fq) const {
        const int row0 = u.pm * BM + wr * 64 + fr, col0 = u.pn * BM + wc * 32 + 4 * fq;
#pragma unroll
        for (int ai = 0; ai < 2; ++ai)
#pragma unroll
            for (int m = 0; m < 4; ++m) { const size_t off = (size_t)(row0 + ai * HALF + m * 16) * ldc + col0;
#pragma unroll
                for (int bj = 0; bj < 2; ++bj)
#pragma unroll
                    for (int n = 0; n < 2; ++n) { const f32x4 b = *(const f32x4*)(base + off + bj * HALF + n * 16); *(f32x4*)(out + off + bj * HALF + n * 16) = b * sa + acc[ai][bj][m][n] * sb; } }
    }
};
struct EpiSlab {
    static constexpr bool PERM = false, AFTER_DRAIN = false;
    float* slab; int Kl;
    __device__ __forceinline__ void operator()(const f32x4 (&acc)[2][2][4][2], const Unit& u, int wr, int wc, int fr, int fq) const {
        const int row0 = (u.pm - 64) * BM + wr * 64 + fr, col0 = u.pn * BM + wc * 32 + 4 * fq; float* O = slab + (size_t)(u.k0 / Kl) * (512 * 2048);
#pragma unroll
        for (int ai = 0; ai < 2; ++ai)
#pragma unroll
            for (int m = 0; m < 4; ++m) { float* rowp = O + (size_t)(row0 + ai * HALF + m * 16) * 2048 + col0;
#pragma unroll
                for (int bj = 0; bj < 2; ++bj)
#pragma unroll
                    for (int n = 0; n < 2; ++n) *(f32x4*)(rowp + bj * HALF + n * 16) = acc[ai][bj][m][n]; }
    }
};
struct EpiP {
    static constexpr bool PERM = false, AFTER_DRAIN = false;
    float* P; bf16_t* U; float* GV;
    __device__ __forceinline__ void operator()(const f32x4 (&acc)[2][2][4][2], const Unit& u, int wr, int wc, int fr, int fq) const {
        const int row0 = u.pm * BM + wr * 64 + fr, cw = wc * 32 + 4 * fq;
        const int kind = u.pn < 14 ? 0 : (u.pn < 18 ? 1 : 2);
        float* F = kind == 0 ? P + u.pn * BM + cw : GV + (u.pn - 18) * BM + cw; const int ldf = kind == 0 ? 3584 : 1024;
        bf16_t* Ub = U + (u.pn - 14) * BM + cw;
#pragma unroll
        for (int ai = 0; ai < 2; ++ai)
#pragma unroll
            for (int m = 0; m < 4; ++m) { const size_t row = (size_t)(row0 + ai * HALF + m * 16);
#pragma unroll
                for (int bj = 0; bj < 2; ++bj)
#pragma unroll
                    for (int n = 0; n < 2; ++n) { f32x4 v = acc[ai][bj][m][n];
                        if (kind != 0) { const f32x2 a = gelu_pk((f32x2){v[0], v[1]}), b = gelu_pk((f32x2){v[2], v[3]}); v = (f32x4){a.x, a.y, b.x, b.y}; }
                        if (kind == 1) { u32x2 w; w.x = cvt_pk_bf16(v[0], v[1]); w.y = cvt_pk_bf16(v[2], v[3]); *(u32x2*)(Ub + row * 1024 + bj * HALF + n * 16) = w; }
                        else *(f32x4*)(F + row * ldf + bj * HALF + n * 16) = v; }
                asm volatile("" ::: "memory"); }
    }
};
struct EpiLora {
    static constexpr bool PERM = false, AFTER_DRAIN = false;
    float* base;
    __device__ __forceinline__ void operator()(const f32x4 (&acc)[2][2][4][2], const Unit& u, int wr, int wc, int fr, int fq) const {
        const int row0 = u.pm * BM + wr * 64 + fr, kind = u.pn >> 2, cb = (u.pn & 3) * BM + wc * 32 + 4 * fq;
        float* O = base + (size_t)kind * ((size_t)66 << 18) + cb;
#pragma unroll
        for (int ai = 0; ai < 2; ++ai)
#pragma unroll
            for (int m = 0; m < 4; ++m) { float* rowp = O + (size_t)(row0 + ai * HALF + m * 16) * 1024;
#pragma unroll
                for (int bj = 0; bj < 2; ++bj)
#pragma unroll
                    for (int n = 0; n < 2; ++n) *(f32x4*)(rowp + bj * HALF + n * 16) = acc[ai][bj][m][n]; }
    }
};
template <class Epi, class Sched, bool ALIGN_EPI = false, bool SP2 = false>
__device__ __forceinline__ void gemm_phase(PG8_LAS unsigned char* lds, const Gemm g, const Sched& S, const Epi& E, int tid_in) {
    int tid_ = tid_in; asm volatile("" : "+v"(tid_));
    const int tid = tid_, wid = __builtin_amdgcn_readfirstlane(tid >> 6), lane = tid & 63, wr = wid >> 2, wc = wid & 3, fr = lane & 15, fq = lane >> 4;
    const int K = g.K, nt = g.Kl / BK;
    unsigned voffA[2], voffB[2];
#pragma unroll
    for (int i = 0; i < 2; ++i) { int R, C; stage_rc(tid * 16 + i * 8192, R, C); const int Rb = Epi::PERM ? ((R & ~31) + perm32(R & 31)) : R;
        voffA[i] = (unsigned)(R * K + C) * 2u; voffB[i] = (unsigned)(Rb * K + C) * 2u; }
    const size_t kstep = (size_t)(BK * 2);
    const size_t hstep = (size_t)HALF * K * 2;
    const size_t tstep = 2 * hstep;
    const unsigned ldsw = (unsigned)wid * 1024u;
    const int aoff = lds_byte(wr * 64 + fr, fq * 8), boff = lds_byte(wc * 32 + fr, fq * 8);
#define PG8_SA(b, h) (((b) * 2 + (h)) * HTB)
#define PG8_SB(b, h) ((4 + (b) * 2 + (h)) * HTB)
#define PG8_STAGE(bufoff, gbase, voff) do { _Pragma("unroll") for (int _i = 0; _i < 2; ++_i) \
        __builtin_amdgcn_global_load_lds((const unsigned*)((const char*)(gbase) + (voff)[_i]), (PG8_LAS unsigned*)(lds + (bufoff) + ldsw + _i * 8192), 16, 0, 0); } while (0)
#define PG8_LDA(dst, b, h) do { _Pragma("unroll") for (int m = 0; m < 4; ++m) _Pragma("unroll") for (int k = 0; k < 2; ++k) dst[m][k] = *(const PG8_LAS bf16x8*)(lds + PG8_SA(b, h) + aoff + m * 2048 + k * 1024); } while (0)
#define PG8_LDB(dst, b, h) do { _Pragma("unroll") for (int n = 0; n < 2; ++n) _Pragma("unroll") for (int k = 0; k < 2; ++k) dst[n][k] = *(const PG8_LAS bf16x8*)(lds + PG8_SB(b, h) + boff + n * 2048 + k * 1024); } while (0)
#define PG8_MMA(ai, bj, At, Bt) do { __builtin_amdgcn_s_setprio(1); _Pragma("unroll") for (int m = 0; m < 4; ++m) _Pragma("unroll") for (int n = 0; n < 2; ++n) _Pragma("unroll") for (int k = 0; k < 2; ++k) \
        acc[ai][bj][m][n] = __builtin_amdgcn_mfma_f32_16x16x32_bf16(Bt[n][k], At[m][k], acc[ai][bj][m][n], 0, 0, 0); __builtin_amdgcn_s_setprio(0); } while (0)
#define PG8_WAIT_V(n) asm volatile("s_waitcnt vmcnt(" #n ")" ::: "memory")
#define PG8_WAIT_L(n) asm volatile("s_waitcnt lgkmcnt(" #n ")" ::: "memory")
#define PG8_BAR __builtin_amdgcn_s_barrier()
#define PG8_SCHED __builtin_amdgcn_sched_barrier(0)
    Unit cur, nxt; int ui = 0;
    if (!S.next(0, cur)) return;
    f32x4 acc[2][2][4][2];
    float zz0; asm volatile("v_mov_b32 %0, 0" : "=v"(zz0));
#pragma unroll
    for (int a = 0; a < 2; ++a)
#pragma unroll
        for (int b = 0; b < 2; ++b)
#pragma unroll
            for (int m = 0; m < 4; ++m)
#pragma unroll
                for (int n = 0; n < 2; ++n) acc[a][b][m][n] = (f32x4){zz0, zz0, zz0, zz0};
    bf16x8 At[4][2], B0[2][2], B1[2][2];
    const char* cA = (const char*)g.A + (size_t)cur.pm * tstep + (size_t)cur.k0 * 2; const char* cB = (const char*)g.Bt + (size_t)cur.pn * tstep + (size_t)cur.k0 * 2;
    S.a_ready(cur);
    if constexpr (SP2) {
        PG8_STAGE(PG8_SB(0, 0), cB, voffB); PG8_STAGE(PG8_SB(0, 1), cB + hstep, voffB); PG8_STAGE(PG8_SA(0, 0), cA, voffA); PG8_STAGE(PG8_SA(0, 1), cA + hstep, voffA);
        if (wr == 1) PG8_BAR;
        PG8_WAIT_V(2); PG8_BAR;
        PG8_STAGE(PG8_SB(1, 0), cB + kstep, voffB); PG8_STAGE(PG8_SA(1, 0), cA + kstep, voffA); PG8_STAGE(PG8_SB(1, 1), cB + hstep + kstep, voffB);
        PG8_WAIT_V(6); PG8_BAR;
    } else {
        PG8_STAGE(PG8_SB(0, 0), cB, voffB); PG8_STAGE(PG8_SA(0, 0), cA, voffA); PG8_STAGE(PG8_SB(0, 1), cB + hstep, voffB); PG8_STAGE(PG8_SA(0, 1), cA + hstep, voffA);
        if (wr == 1) PG8_BAR;
        PG8_WAIT_V(4); PG8_BAR;
        PG8_STAGE(PG8_SB(1, 0), cB + kstep, voffB); PG8_STAGE(PG8_SA(1, 0), cA + kstep, voffA); PG8_STAGE(PG8_SB(1, 1), cB + hstep + kstep, voffB);
        PG8_WAIT_V(6); PG8_BAR;
    }
    for (;;) {
        const bool has_next = S.next(ui + 1, nxt);
        const char* nA = has_next ? (const char*)g.A + (size_t)nxt.pm * tstep + (size_t)nxt.k0 * 2 : cA; const char* nB = has_next ? (const char*)g.Bt + (size_t)nxt.pn * tstep + (size_t)nxt.k0 * 2 : cB;
        for (int t = 0; t < nt; t += 2) {
            const bool last = (t == nt - 2);
            const char* a1 = cA + (size_t)(t + 1) * kstep;
            const char* a2 = last ? nA : cA + (size_t)(t + 2) * kstep; const char* b2 = last ? nB : cB + (size_t)(t + 2) * kstep;
            const char* a3 = a2 + kstep; const char* b3 = b2 + kstep;
            if (last && has_next) S.a_ready(nxt);
            if constexpr (SP2) {
            PG8_LDB(B0, 0, 0); PG8_LDB(B1, 0, 1); PG8_SCHED; PG8_LDA(At, 0, 0); PG8_STAGE(PG8_SA(1, 1), a1 + hstep, voffA);
            PG8_WAIT_V(8); PG8_WAIT_L(0); PG8_BAR; PG8_MMA(0, 0, At, B0); PG8_MMA(0, 1, At, B1); PG8_BAR; PG8_SCHED;
            PG8_LDA(At, 0, 1); PG8_STAGE(PG8_SB(0, 0), b2, voffB); PG8_STAGE(PG8_SB(0, 1), b2 + hstep, voffB); PG8_STAGE(PG8_SA(0, 0), a2, voffA);
            PG8_WAIT_V(8); PG8_WAIT_L(0); PG8_BAR; PG8_MMA(1, 0, At, B0); PG8_MMA(1, 1, At, B1); PG8_BAR; PG8_SCHED;
            PG8_LDB(B0, 1, 0); PG8_LDB(B1, 1, 1); PG8_SCHED; PG8_LDA(At, 1, 0); PG8_STAGE(PG8_SA(0, 1), a2 + hstep, voffA);
            PG8_WAIT_V(8); PG8_WAIT_L(0); PG8_BAR; PG8_MMA(0, 0, At, B0); PG8_MMA(0, 1, At, B1); PG8_BAR; PG8_SCHED;
            PG8_LDA(At, 1, 1); PG8_STAGE(PG8_SB(1, 0), b3, voffB); PG8_STAGE(PG8_SB(1, 1), b3 + hstep, voffB); PG8_STAGE(PG8_SA(1, 0), a3, voffA);
            PG8_WAIT_V(8); PG8_WAIT_L(0); PG8_BAR; PG8_MMA(1, 0, At, B0); PG8_MMA(1, 1, At, B1); PG8_BAR; PG8_SCHED;
            } else {
            PG8_LDB(B0, 0, 0); PG8_SCHED; PG8_LDA(At, 0, 0); PG8_STAGE(PG8_SA(1, 1), a1 + hstep, voffA);
            PG8_WAIT_L(8); PG8_BAR; PG8_WAIT_L(0); PG8_MMA(0, 0, At, B0); PG8_BAR; PG8_SCHED;
            PG8_LDB(B1, 0, 1); PG8_STAGE(PG8_SB(0, 0), b2, voffB);
            PG8_BAR; PG8_WAIT_L(0); PG8_MMA(0, 1, At, B1); PG8_BAR;
            PG8_LDA(At, 0, 1); PG8_STAGE(PG8_SA(0, 0), a2, voffA);
            PG8_BAR; PG8_WAIT_L(0); PG8_MMA(1, 0, At, B0); PG8_BAR; PG8_SCHED;
            PG8_STAGE(PG8_SB(0, 1), b2 + hstep, voffB);
            PG8_WAIT_V(6); PG8_BAR; PG8_MMA(1, 1, At, B1); PG8_BAR;
            PG8_LDB(B0, 1, 0); PG8_SCHED; PG8_LDA(At, 1, 0); PG8_STAGE(PG8_SA(0, 1), a2 + hstep, voffA);
            PG8_WAIT_L(8); PG8_BAR; PG8_WAIT_L(0); PG8_MMA(0, 0, At, B0); PG8_BAR; PG8_SCHED;
            PG8_LDB(B1, 1, 1); PG8_STAGE(PG8_SB(1, 0), b3, voffB);
            PG8_BAR; PG8_WAIT_L(0); PG8_MMA(0, 1, At, B1); PG8_BAR;
            PG8_LDA(At, 1, 1); PG8_STAGE(PG8_SA(1, 0), a3, voffA);
            PG8_BAR; PG8_WAIT_L(0); PG8_MMA(1, 0, At, B0); PG8_BAR; PG8_SCHED;
            PG8_STAGE(PG8_SB(1, 1), b3 + hstep, voffB);
            PG8_WAIT_V(6); PG8_BAR; PG8_MMA(1, 1, At, B1); PG8_BAR;
            }
        }
        if constexpr (ALIGN_EPI) { if (wr == 0) PG8_BAR; }
        if constexpr (!Epi::AFTER_DRAIN) { E(acc, cur, wr, wc, fr, fq); S.done(cur); }
        if (!has_next) break;
{ float zz1; asm volatile("v_mov_b32 %0, 0" : "=v"(zz1));
#pragma unroll
        for (int a = 0; a < 2; ++a)
#pragma unroll
            for (int b = 0; b < 2; ++b)
#pragma unroll
                for (int m = 0; m < 4; ++m)
#pragma unroll
                    for (int n = 0; n < 2; ++n) acc[a][b][m][n] = (f32x4){zz1, zz1, zz1, zz1}; }
        cur = nxt; cA = nA; cB = nB; ++ui;
        if constexpr (ALIGN_EPI) { if (wr == 1) PG8_BAR; }
    }
    PG8_WAIT_V(0);
    if constexpr (!ALIGN_EPI) { if (wr == 0) PG8_BAR; }
    PG8_BAR;
    if constexpr (Epi::AFTER_DRAIN) { E.fused(acc, cur, wr, wc, fr, fq, lds, wid, lane); S.done(cur); }
#undef PG8_SA
#undef PG8_SB
#undef PG8_STAGE
#undef PG8_LDA
#undef PG8_LDB
#undef PG8_MMA
#undef PG8_WAIT_V
#undef PG8_WAIT_L
#undef PG8_BAR
#undef PG8_SCHED
}
}
#define GAS __attribute__((address_space(1)))
#define LAS __attribute__((address_space(3)))
typedef unsigned short bf16;
typedef unsigned v4u __attribute__((ext_vector_type(4)));
typedef float f32x4 __attribute__((ext_vector_type(4)));
typedef short bf16x8 __attribute__((ext_vector_type(8)));
typedef GAS unsigned gu32;
typedef GAS unsigned long long gu64;
#define RLX_AGENT __ATOMIC_RELAXED, __HIP_MEMORY_SCOPE_AGENT
#define LDS_WAIT() asm volatile("s_waitcnt lgkmcnt(0)" ::: "memory")
#define VM_WAIT() asm volatile("s_waitcnt vmcnt(0)" ::: "memory")
__device__ __forceinline__ unsigned long long rt() { return __builtin_amdgcn_s_memrealtime(); }
typedef float f32x2_t __attribute__((ext_vector_type(2))); typedef __bf16 bf16x2_t __attribute__((ext_vector_type(2)));
__device__ __forceinline__ unsigned pk2(float lo, float hi) { const bf16x2_t b = __builtin_convertvector((f32x2_t){lo, hi}, bf16x2_t); return __builtin_bit_cast(unsigned, b); }
__device__ __forceinline__ unsigned f2bf(float f) { return pk2(f, 0.f) & 0xffffu; }
#define XB_TMO      128
#define XB_XCNT(j)  (256  + 64 * (j))
#define XB_XSUB(j)  (1280 + 64 * (j))
#define XB_XGEN(j)  (2304 + 64 * (j))
#define XB_TOP      3328
#define XB_TOPGEN   3392
#define XCD_BAR_WORDS 3456
#define XB_SPIN_CAP (1u << 18)

__device__ __forceinline__ unsigned xb_ld(unsigned* p)              { return __hip_atomic_load(p, __ATOMIC_RELAXED, __HIP_MEMORY_SCOPE_AGENT); }
__device__ __forceinline__ unsigned xb_add(unsigned* p, unsigned v) { return __hip_atomic_fetch_add(p, v, __ATOMIC_RELAXED, __HIP_MEMORY_SCOPE_AGENT); }
__device__ __forceinline__ unsigned xb_xcc_id() { return (unsigned)__builtin_amdgcn_s_getreg((3 << 11) | 20) & 0xFu; }
#define XB_SPIN(cond, bar) do { unsigned _sp = 0; while (cond) { __builtin_amdgcn_s_sleep(1); \
    if ((++_sp & 255u) == 0u) { if (xb_ld(&(bar)[XB_TMO])) break; if (_sp > XB_SPIN_CAP) { atomicAdd(&(bar)[XB_TMO], 1u); break; } } } } while (0)

struct XcdBarrier {
    unsigned* bar; unsigned x;
    volatile LAS unsigned* st;
};

__device__ __forceinline__ XcdBarrier xcd_barrier_post(unsigned* bar, volatile LAS unsigned* st, int tid) {
    XcdBarrier b; b.bar = bar; b.x = xb_xcc_id(); b.st = st;
    if (tid == 0) (void)xb_add(&bar[XB_XCNT(b.x)], 1u);
    return b;
}
__device__ __forceinline__ void xcd_barrier_complete(unsigned* bar, unsigned x, unsigned& nloc, unsigned& nx) {
    const unsigned G = gridDim.x * gridDim.y * gridDim.z;
    unsigned sum, cnt, mine, sp = 0u;
    for (;;) {
        sum = 0u; cnt = 0u; mine = 0u;
#pragma unroll
        for (unsigned j = 0; j < 16; ++j) { const unsigned c = xb_ld(&bar[XB_XCNT(j)]); sum += c; cnt += (c > 0u) ? 1u : 0u; mine = (j == x) ? c : mine; }
        if (sum == G) break;
        __builtin_amdgcn_s_sleep(1);
        if ((++sp & 255u) == 0u) { if (xb_ld(&bar[XB_TMO])) break; if (sp > XB_SPIN_CAP) { atomicAdd(&bar[XB_TMO], 1u); break; } }
    }
    nloc = mine > 0u ? mine : 1u; nx = cnt > 0u ? cnt : 1u;
}

__device__ __forceinline__ void xcd_barrier(const XcdBarrier& b, int tid) {
    asm volatile("s_waitcnt vmcnt(0)" ::: "memory");
    __syncthreads();
    if (tid == 0) {
        unsigned* bar = b.bar;
        __builtin_amdgcn_s_waitcnt(0);
        unsigned nloc = b.st[0], nx = b.st[1];
        if (nloc == 0u) { xcd_barrier_complete(bar, b.x, nloc, nx); b.st[0] = nloc; b.st[1] = nx; }
        const unsigned old = xb_add(&bar[XB_XSUB(b.x)], 1u);
        const unsigned gen = old / nloc;
        if (old + 1u == (gen + 1u) * nloc) {
            __builtin_amdgcn_fence(__ATOMIC_RELEASE, "agent");
            asm volatile("s_waitcnt vmcnt(0)" ::: "memory");
            const unsigned og = xb_add(&bar[XB_TOP], 1u);
            const unsigned tg = og / nx;
            if (og + 1u == (tg + 1u) * nx) xb_add(&bar[XB_TOPGEN], 1u);
            else XB_SPIN(xb_ld(&bar[XB_TOPGEN]) == tg, bar);
            __builtin_amdgcn_fence(__ATOMIC_ACQUIRE, "agent");
            xb_add(&bar[XB_XGEN(b.x)], 1u);
            asm volatile("s_waitcnt vmcnt(0)" ::: "memory");
        } else {
            XB_SPIN(xb_ld(&bar[XB_XGEN(b.x)]) == gen, bar);
            __builtin_amdgcn_fence(__ATOMIC_ACQUIRE, "agent");
            asm volatile("s_waitcnt vmcnt(0)" ::: "memory");
        }
    }
    __syncthreads();
}

constexpr int NWAVES = 8, NTHR = 512;
constexpr int DM = 2048, FF = 5632, DEPTH = 4;
constexpr int TP = 16384, NSB = 16, TS = 32, M = TP + NSB * TS;
constexpr int RW = 1024, NH = 16, HN = 64, GMW = 1024, GH = 8, GHD = 128;
constexpr int C_W = 3072, C_A = 3136, C_G = 3200, SHIFT = 3360, INC = 5408;
constexpr int PLD = 3584;
constexpr int N3 = 5632;
constexpr int LK = 384;
constexpr int NL = 3072;
constexpr float ALPHA = 1.6817928305074292f;
constexpr float LN_EPS = 1e-5f, GN_EPS = 64e-5f;
constexpr int NPHASE = 15;

constexpr size_t O_YP = 0, O_SP = 34603008, O_SHP = 34865152, O_SS = 34878592, O_SHS = 39072896, O_GV = 39287936, O_END = 41385088;

constexpr size_t MiB = 1u << 20;
constexpr size_t WS_CTL = 0, CTL_ZERO_BYTES = 1 * MiB;
constexpr size_t WS_X = 1 * MiB;
constexpr size_t WS_Z = 133 * MiB;
constexpr size_t WS_XB = 265 * MiB;
constexpr size_t WS_W = 331 * MiB;
constexpr size_t W_1 = WS_W, W_2 = W_1 + 44 * MiB, W_3 = W_2 + 22 * MiB, W_4 = W_3 + 22 * MiB, W_5 = W_4 + 8 * MiB, W_6 = W_5 + 44 * MiB, W_3B = W_6 + 22 * MiB;
constexpr size_t WS_BIG = 496 * MiB;
constexpr size_t B_H = WS_BIG, B_P = WS_BIG, B_U = WS_BIG + 231 * MiB, B_GV = B_U + 33 * MiB, B_A3B = B_GV + 66 * MiB;
constexpr size_t B_MIX = WS_XB;
constexpr size_t WS_RW = 839 * MiB;
constexpr size_t RWSZ = 66 * MiB;
constexpr size_t WS_END = WS_RW + 8 * RWSZ;
static_assert(W_3B + (size_t)NL * LK * 2 <= WS_BIG && B_A3B + (size_t)M * LK * 2 <= WS_RW, "ws map");
static_assert((size_t)M * DM * 4 == 132 * MiB && (size_t)M * PLD * 4 == 231 * MiB && (size_t)M * 1024 * 4 == 66 * MiB, "ws sizes");
constexpr int CW_TMO = 0, CW_CODE = 1, CW_BAR = 4096;

constexpr int RING_OFF = 0, RING_BYTES = 135168;
constexpr int LDSCTL_OFF = RING_BYTES, MISC_OFF = LDSCTL_OFF + 320;
constexpr int LDS_BYTES = 147456;

struct Args { const float* in[29]; float* out; unsigned char* ws; int l_lo, l_hi; };
#define KOUT() ((float*)karg_ptr<232>())
#define KWS() ((unsigned char*)karg_ptr<240>())
enum InIdx { I_XP = 0, I_XS, I_SRW, I_SSH, I_F1G, I_F1U, I_F1D, I_WIN, I_MU, I_W0, I_WUP, I_A0, I_AUP, I_GUP, I_KK, I_KA, I_RK, I_GNG, I_GNB, I_GLG, I_GLB, I_GWS, I_GBS, I_WOUT, I_F2G, I_F2U, I_F2D, I_LNG, I_LNB };


template <int OFF> __device__ __forceinline__ const float* karg_ptr() {
    const unsigned long long kp = (unsigned long long)__builtin_amdgcn_kernarg_segment_ptr(); unsigned long long v;
    asm volatile("s_load_dwordx2 %0, %1, %2\n\ts_waitcnt lgkmcnt(0)" : "=s"(v) : "s"(kp), "i"(OFF) : "memory");
    return (const float*)(const GAS float*)v;
}
#define KIN(i) karg_ptr<8 * (i)>()
template <int CTRL> __device__ __forceinline__ float dpp_mov(float x) { return __builtin_bit_cast(float, __builtin_amdgcn_mov_dpp(__builtin_bit_cast(int, x), CTRL, 0xf, 0xf, true)); }
__device__ __forceinline__ float row16_sum(float x) { x += dpp_mov<0x128>(x); x += dpp_mov<0x124>(x); x += dpp_mov<0x122>(x); x += dpp_mov<0x121>(x); return x; }
__device__ __forceinline__ float wave_sum(float v) {
    v = row16_sum(v); const int i = __builtin_bit_cast(int, v);
    const float a = __builtin_bit_cast(float, __builtin_amdgcn_readlane(i, 0)), b = __builtin_bit_cast(float, __builtin_amdgcn_readlane(i, 16)), c = __builtin_bit_cast(float, __builtin_amdgcn_readlane(i, 32)), d = __builtin_bit_cast(float, __builtin_amdgcn_readlane(i, 48));
    return (a + b) + (c + d);
}

template <int MAP> __device__ __forceinline__ void cvt_task(const float* __restrict__ W, int K, int N, bf16* __restrict__ WT, int nb, int k0, int lane) {
    const int n = nb * 256 + 4 * lane; if (n >= N) return;
    const int drow = MAP == 0 ? n : (MAP == 3 ? (n < SHIFT ? n : n + (PLD - SHIFT)) : 256 * (n >> 7) + (n & 127) + (MAP == 2 ? 128 : 0));
    const float* src = W + (size_t)k0 * N + n; bf16* dst = WT + (size_t)drow * K + k0;
#pragma unroll
    for (int kk = 0; kk < 32; kk += 16) { f32x4 v[16];
#pragma unroll
        for (int j = 0; j < 16; ++j) v[j] = *(const f32x4*)(src + (size_t)(kk + j) * N);
#pragma unroll
        for (int i = 0; i < 4; ++i)
#pragma unroll
            for (int hh = 0; hh < 2; ++hh) { v4u o; o.x = pk2(v[8 * hh + 0][i], v[8 * hh + 1][i]); o.y = pk2(v[8 * hh + 2][i], v[8 * hh + 3][i]); o.z = pk2(v[8 * hh + 4][i], v[8 * hh + 5][i]); o.w = pk2(v[8 * hh + 6][i], v[8 * hh + 7][i]);
                *(v4u*)(dst + (size_t)i * K + kk + 8 * hh) = o; } }
}

__device__ __forceinline__ void phase_convert(int l, LAS unsigned char* lds, int wave, int lane, int gw, int NGW) {
    unsigned char* ws = KWS();
    const size_t so = (size_t)l * DM * FF;
    const float *f1g = KIN(I_F1G) + so, *f1u = KIN(I_F1U) + so, *f1d = KIN(I_F1D) + so, *f2g = KIN(I_F2G) + so, *f2u = KIN(I_F2U) + so, *f2d = KIN(I_F2D) + so;
    const float* win = KIN(I_WIN) + (size_t)l * DM * INC; const float* wout = KIN(I_WOUT) + (size_t)l * DM * DM;
    constexpr int T_GU = (FF / 256) * (DM / 32);
    constexpr int T_D = (DM / 256) * (FF / 32);
    constexpr int T_IN = ((INC + 255) / 256) * (DM / 32);
    constexpr int T_O = (DM / 256) * (DM / 32);
    constexpr int NTASK = 4 * T_GU + 2 * T_D + T_IN + T_O;
    for (int it = gw; it < NTASK; it += NGW) {
        int r = it;
        if (r < 4 * T_GU) { const int which = r / T_GU; r -= which * T_GU; const int nb = r % (FF / 256), kb = r / (FF / 256);
            const float* W = which == 0 ? f1g : (which == 1 ? f1u : (which == 2 ? f2g : f2u)); bf16* WT = (bf16*)(ws + (which < 2 ? W_1 : W_5));
            if (which & 1) cvt_task<2>(W, DM, FF, WT, nb, 32 * kb, lane); else cvt_task<1>(W, DM, FF, WT, nb, 32 * kb, lane); continue; }
        r -= 4 * T_GU;
        if (r < 2 * T_D) { const int which = r / T_D; r -= which * T_D; const int nb = r % (DM / 256), kb = r / (DM / 256);
            cvt_task<0>(which == 0 ? f1d : f2d, FF, DM, (bf16*)(ws + (which == 0 ? W_2 : W_6)), nb, 32 * kb, lane); continue; }
        r -= 2 * T_D;
        if (r < T_IN) { const int nb = r % ((INC + 255) / 256), kb = r / ((INC + 255) / 256); cvt_task<3>(win, DM, INC, (bf16*)(ws + W_3), nb, 32 * kb, lane); continue; }
        r -= T_IN;
        { const int nb = r % (DM / 256), kb = r / (DM / 256); cvt_task<0>(wout, DM, DM, (bf16*)(ws + W_4), nb, 32 * kb, lane); }
    }
    { v4u* z = (v4u*)(ws + W_3 + (size_t)SHIFT * DM * 2); const int nz = (PLD - SHIFT) * DM * 2 / 16;
      unsigned z0; asm volatile("v_mov_b32 %0, 0" : "=v"(z0));
      for (int i = gw * 64 + lane; i < nz; i += NGW * 64) z[i] = (v4u){z0, z0, z0, z0}; }
    { bf16* WT = (bf16*)(ws + W_3B); const float* wup = KIN(I_WUP) + (size_t)l * 64 * RW; const float* aup = KIN(I_AUP) + (size_t)l * 64 * RW; const float* gup = KIN(I_GUP) + (size_t)l * 160 * RW;
      for (int i = gw * 64 + lane; i < NL * LK; i += NGW * 64) { const int n = i / LK, k = i % LK, kind = n >> 10, c = n & 1023; float v = 0.f;
          if (kind == 0) { if (k < 64) v = wup[(size_t)k * RW + c]; } else if (kind == 1) { if (k >= 64 && k < 128) v = aup[(size_t)(k - 64) * RW + c]; } else { if (k >= 128 && k < 288) v = gup[(size_t)(k - 128) * RW + c]; }
          WT[i] = (bf16)f2bf(v); } }
    if (l == 0) {
        float* X = (float*)(ws + WS_X); bf16* XB = (bf16*)(ws + WS_XB); const float* xp = KIN(I_XP); const float* xs = KIN(I_XS);
        for (int m = gw; m < M; m += NGW) { const float* src = m < TP ? xp + (size_t)m * DM : xs + (size_t)(m - TP) * DM;
            const f32x4* s4 = (const f32x4*)src + lane; f32x4* d4 = (f32x4*)(X + (size_t)m * DM) + lane; unsigned long long* o8 = (unsigned long long*)(XB + (size_t)m * DM) + lane;
#pragma unroll
            for (int j = 0; j < 8; ++j) { const f32x4 v = s4[64 * j]; d4[64 * j] = v; o8[64 * j] = (unsigned long long)pk2(v.x, v.y) | ((unsigned long long)pk2(v.z, v.w) << 32); } }
    }
}

__device__ __forceinline__ void phase_ln(const float* Z, const float* Xres, const float* slab, int KS, float sa, float sb, const float* g, const float* b, float* Xo, bf16* XBo, int lane, int gw, int NGW) {
    for (int m = gw; m < M; m += NGW) {
        f32x4 v[8]; float s = 0.f;
        if (m < TP) { const f32x4* zr = (const f32x4*)(Z + (size_t)m * DM) + lane;
#pragma unroll
            for (int j = 0; j < 8; ++j) v[j] = zr[64 * j];
        } else { const f32x4* xr = (const f32x4*)(Xres + (size_t)m * DM) + lane; f32x4 a[8];
#pragma unroll
            for (int j = 0; j < 8; ++j) { v[j] = xr[64 * j]; a[j] = (f32x4){0.f, 0.f, 0.f, 0.f}; }
            for (int ks = 0; ks < KS; ++ks) { const f32x4* sr = (const f32x4*)(slab + ((size_t)ks * 512 + (m - TP)) * DM) + lane;
#pragma unroll
                for (int j = 0; j < 8; ++j) a[j] = a[j] + sr[64 * j]; }
#pragma unroll
            for (int j = 0; j < 8; ++j) v[j] = v[j] * sa + a[j] * sb; }
#pragma unroll
        for (int j = 0; j < 8; ++j) s += (v[j].x + v[j].y) + (v[j].z + v[j].w);
        const float mean = wave_sum(s) * (1.f / DM); float s2 = 0.f;
#pragma unroll
        for (int j = 0; j < 8; ++j) { v[j] = v[j] - mean; s2 += (v[j].x * v[j].x + v[j].y * v[j].y) + (v[j].z * v[j].z + v[j].w * v[j].w); }
        const float rstd = 1.f / sqrtf(wave_sum(s2) * (1.f / DM) + LN_EPS);
        f32x4* xo = (f32x4*)(Xo + (size_t)m * DM) + lane;
#pragma unroll
        for (int j = 0; j < 8; ++j) { const f32x4 gg = ((const f32x4*)g)[lane + 64 * j], bb = ((const f32x4*)b)[lane + 64 * j]; const f32x4 o = v[j] * rstd * gg + bb; xo[64 * j] = o;
            if (XBo) ((unsigned long long*)(XBo + (size_t)m * DM) + lane)[64 * j] = (unsigned long long)pk2(o.x, o.y) | ((unsigned long long)pk2(o.z, o.w) << 32); }
    }
}

__device__ __forceinline__ const float* prev_row(const float* ssh, int l, const float* P, int m) {
    if (m < TP) return m == 0 ? nullptr : P + (size_t)(m - 1) * PLD;
    const int b = (m - TP) >> 5, t = (m - TP) & 31;
    return t == 0 ? ssh + (size_t)(l * NSB + b) * SHIFT : P + (size_t)(m - 1) * PLD;
}

__device__ __forceinline__ void phase_prep1(int l, int lane, int gw, int NGW) {
    unsigned char* ws = KWS(); float* outp = KOUT(); const float* P = (const float*)(ws + B_P); float* GV = (float*)(ws + B_GV); bf16* A3B = (bf16*)(ws + B_A3B);
    const float* mu = KIN(I_MU) + (size_t)l * SHIFT; const float* lg = KIN(I_GLG) + (size_t)l * GMW; const float* lb = KIN(I_GLB) + (size_t)l * GMW;
    const float* ssh = KIN(I_SSH);
    for (int m = gw; m < M; m += NGW) {
        const float* pr = P + (size_t)m * PLD; const float* pp = prev_row(ssh, l, P, m);
#pragma unroll
        for (int jj = 0; jj < 6; ++jj) { const int j = jj * 64 + lane; float v = 0.f;
            if (j < 288) { const int c = C_W + j; const float p = pr[c], q = pp ? pp[c] : 0.f; const float xs = p + (q - p) * mu[c];
                if (j < 64) { const float t = __expf(-2.f * fabsf(xs)); const float r = (1.f - t) / (1.f + t); v = xs < 0.f ? -r : r; }
                else if (j < 128) v = xs;
                else v = 1.f / (1.f + __expf(-xs)); }
            A3B[(size_t)m * LK + j] = (bf16)f2bf(v); }
        { f32x4* vr = (f32x4*)(GV + (size_t)m * GMW) + lane; f32x4 v[4]; float s = 0.f;
#pragma unroll
          for (int j = 0; j < 4; ++j) { v[j] = vr[64 * j]; s += (v[j].x + v[j].y) + (v[j].z + v[j].w); }
          const float mean = wave_sum(s) * (1.f / GMW); float s2 = 0.f;
#pragma unroll
          for (int j = 0; j < 4; ++j) { v[j] = v[j] - mean; s2 += (v[j].x * v[j].x + v[j].y * v[j].y) + (v[j].z * v[j].z + v[j].w * v[j].w); }
          const float rstd = 1.f / sqrtf(wave_sum(s2) * (1.f / GMW) + LN_EPS);
          f32x4* go = nullptr; if (m >= TP) go = (f32x4*)(outp + O_GV + ((size_t)l * NSB * TS + (m - TP)) * GMW) + lane;
#pragma unroll
          for (int j = 0; j < 4; ++j) { const f32x4 o = v[j] * rstd * ((const f32x4*)lg)[lane + 64 * j] + ((const f32x4*)lb)[lane + 64 * j]; vr[64 * j] = o; if (go) go[64 * j] = o; } }
        if (m == TP - 1) { float* o = outp + O_SHP + (size_t)l * SHIFT; for (int c = lane; c < SHIFT; c += 64) o[c] = pr[c]; }
        if (m >= TP && ((m - TP) & 31) == 31) { float* o = outp + O_SHS + (size_t)(l * NSB + ((m - TP) >> 5)) * SHIFT; for (int c = lane; c < SHIFT; c += 64) o[c] = pr[c]; }
    }
}

typedef unsigned u32x2g __attribute__((ext_vector_type(2)));
constexpr int GLD = 272, GL_VT = 128 * GLD, GSP = 132;
static_assert(2 * GL_VT <= RING_BYTES && 128 * GSP * 4 <= 2 * GL_VT, "gMLP LDS");
__device__ __forceinline__ void gmlp_unit(int l, LAS unsigned char* lds, int unit, int tid, int wave) {
    unsigned char* ws = KWS(); const float* VN = (const float*)(ws + B_GV); const bf16* U = (const bf16*)(ws + B_U); bf16* MIXB = (bf16*)(ws + B_MIX);
    const int ci = unit >> 3, h = unit & 7; int row0, nr; if (ci < 128) { row0 = 128 * ci; nr = 128; } else { row0 = TP + 32 * (ci - 128); nr = 32; }
    const float* wsm = KIN(I_GWS) + ((size_t)l * GH + h) * 128 * 128; const float* bs = KIN(I_GBS) + ((size_t)l * GH + h) * 128;
    LAS unsigned char* Wb = lds; LAS unsigned char* Vt = lds + GL_VT; LAS float* So = (LAS float*)lds;
    const int lane = tid & 63, g = lane >> 4, lc = lane & 15;
    __syncthreads();
    for (int idx = tid; idx < nr * 32; idx += NTHR) { const int i = idx >> 5, j4 = idx & 31; f32x4 w4 = *(const f32x4*)(wsm + i * 128 + 4 * j4);
        const int j = 4 * j4; if (j > i) w4.x = 0.f; if (j + 1 > i) w4.y = 0.f; if (j + 2 > i) w4.z = 0.f; if (j + 3 > i) w4.w = 0.f;
        *(LAS u32x2g*)(Wb + i * GLD + 8 * j4) = (u32x2g){pk2(w4.x, w4.y), pk2(w4.z, w4.w)}; }
    { const int c = tid & 127, jg = tid >> 7;
      if (32 * jg < nr) { const float* vp = VN + (size_t)(row0 + 32 * jg) * GMW + h * GHD + c; float vv[32];
#pragma unroll
          for (int j = 0; j < 32; ++j) vv[j] = vp[(size_t)j * GMW];
#pragma unroll
          for (int q = 0; q < 4; ++q) *(LAS v4u*)(Vt + c * GLD + (32 * jg + 8 * q) * 2) = (v4u){pk2(vv[8 * q], vv[8 * q + 1]), pk2(vv[8 * q + 2], vv[8 * q + 3]), pk2(vv[8 * q + 4], vv[8 * q + 5]), pk2(vv[8 * q + 6], vv[8 * q + 7])}; } }
    __syncthreads();
    float zf; asm volatile("v_mov_b32 %0, 0" : "=v"(zf));
    f32x4 acc[8];
#pragma unroll
    for (int cb = 0; cb < 8; ++cb) acc[cb] = (f32x4){zf, zf, zf, zf};
    const bool rows_live = 16 * wave < nr;
    if (rows_live) { const int nks = (wave + 2) >> 1;
        for (int ks = 0; ks < nks; ++ks) { const bf16x8 fa = *(const LAS bf16x8*)(Wb + (16 * wave + lc) * GLD + (32 * ks + 8 * g) * 2);
#pragma unroll
            for (int cb = 0; cb < 8; ++cb) acc[cb] = __builtin_amdgcn_mfma_f32_16x16x32_bf16(fa, *(const LAS bf16x8*)(Vt + (16 * cb + lc) * GLD + (32 * ks + 8 * g) * 2), acc[cb], 0, 0, 0); } }
    __syncthreads();
    if (rows_live) {
#pragma unroll
        for (int rg = 0; rg < 4; ++rg) { const int i = 16 * wave + 4 * g + rg; const float b0 = bs[i];
#pragma unroll
            for (int cb = 0; cb < 8; ++cb) So[i * GSP + 16 * cb + lc] = acc[cb][rg] + b0; } }
    __syncthreads();
    const int rq = tid >> 4, cg = tid & 15;
    if (4 * rq < nr) {
#pragma unroll
        for (int r = 0; r < 4; ++r) { const int i = 4 * rq + r; const size_t row = (size_t)(row0 + i); const v4u uu = *(const v4u*)(U + row * GMW + h * GHD + 8 * cg);
            const f32x4 s0 = *(const LAS f32x4*)(So + i * GSP + 8 * cg), s1 = *(const LAS f32x4*)(So + i * GSP + 8 * cg + 4);
            const float u0 = __builtin_bit_cast(float, uu.x << 16), u1 = __builtin_bit_cast(float, uu.x & 0xffff0000u), u2 = __builtin_bit_cast(float, uu.y << 16), u3 = __builtin_bit_cast(float, uu.y & 0xffff0000u);
            const float u4 = __builtin_bit_cast(float, uu.z << 16), u5 = __builtin_bit_cast(float, uu.z & 0xffff0000u), u6 = __builtin_bit_cast(float, uu.w << 16), u7 = __builtin_bit_cast(float, uu.w & 0xffff0000u);
            v4u o; o.x = pk2(u0 * s0.x, u1 * s0.y); o.y = pk2(u2 * s0.z, u3 * s0.w); o.z = pk2(u4 * s1.x, u5 * s1.y); o.w = pk2(u6 * s1.z, u7 * s1.w);
            *(v4u*)(MIXB + row * DM + RW + h * GHD + 8 * cg) = o; }
    }
}


constexpr int NCI = 272, NUNIT = NCI * NH;
constexpr size_t SC_G = WS_RW + 3 * RWSZ;
constexpr size_t SC_HL = SC_G + (size_t)NUNIT * 8192;
constexpr size_t SC_RP = SC_HL + (size_t)NUNIT * 16384;
constexpr size_t SC_YL = SC_RP + (size_t)NUNIT * 8192;
constexpr size_t SC_S0 = SC_YL + (size_t)NUNIT * 16384;
constexpr size_t SC_BON = SC_S0 + (size_t)NUNIT * 8192;
constexpr size_t SC_END = SC_BON + (size_t)NUNIT * 256;
static_assert(SC_END <= WS_END, "scan scratch");
constexpr size_t WS_SLAB = SC_G;
static_assert(WS_SLAB + (size_t)11 * 512 * 2048 * 4 <= WS_END, "slab");
typedef unsigned u32x2 __attribute__((ext_vector_type(2)));
constexpr int BLD = 144;
constexpr int LBUF = 9216;
constexpr int LF0 = 7 * LBUF, F0P = 129;
constexpr int LF1 = LF0 + 64 * F0P * 4, F1P = 68;
constexpr int LF2 = LF1 + 64 * F1P * 4;
constexpr int LTOT = LF2 + 16384;
constexpr int LGC = LTOT + 2048;
constexpr int SCAN_LDS = LGC + 256;
static_assert(SCAN_LDS <= RING_BYTES, "scan LDS");

__device__ __forceinline__ bf16x8 ldfrag(const LAS unsigned char* mat, int blk, int ks, int lane) { return *(const LAS bf16x8*)(mat + (16 * blk + (lane & 15)) * BLD + (32 * ks + 8 * (lane >> 4)) * 2); }
#define MFMA16(a, b, c) __builtin_amdgcn_mfma_f32_16x16x32_bf16((a), (b), (c), 0, 0, 0)

#define LDS_BAR() do { asm volatile("s_waitcnt lgkmcnt(0)" ::: "memory"); __builtin_amdgcn_s_barrier(); asm volatile("" ::: "memory"); } while (0)
__device__ __forceinline__ void scanA_all(int l, LAS unsigned char* lds, int bx, int G, int tid, int wave) {
    unsigned char* ws = KWS();
    const int lane = tid & 63;
    const float* ssh = KIN(I_SSH); const float* mu = KIN(I_MU) + (size_t)l * SHIFT;
    const float *w0p = KIN(I_W0) + (size_t)l * RW, *a0p = KIN(I_A0) + (size_t)l * RW, *kkp = KIN(I_KK) + (size_t)l * RW, *kap = KIN(I_KA) + (size_t)l * RW, *rkp = KIN(I_RK) + (size_t)l * RW;
    float pr_[8], pk_[8], pv_[8], al_[8], wl_[8]; float q_r, q_k, q_v, mu_r, mu_k, mu_v, w0c, a0c, kkc, kac, rkc;
#define SA_LOAD(unit_) do { const int ci_ = (unit_) >> 4, cc_ = 64 * ((unit_) & 15) + lane; const int m0_ = ci_ < 256 ? 64 * ci_ : TP + 32 * (ci_ - 256), n_ = ci_ < 256 ? 64 : 32, t0_ = 8 * wave; \
        const float* P_ = (const float*)(ws + B_P); const float* Wl_ = (const float*)(ws + WS_RW); const float* Al_ = (const float*)(ws + WS_RW + RWSZ); \
        mu_r = mu[cc_]; mu_k = mu[RW + cc_]; mu_v = mu[2 * RW + cc_]; w0c = w0p[cc_]; a0c = a0p[cc_]; kkc = kkp[cc_]; kac = kap[cc_]; rkc = rkp[cc_]; q_r = 0.f; q_k = 0.f; q_v = 0.f; \
        if (t0_ < n_) { const float* pp_ = prev_row(ssh, l, P_, m0_ + t0_); if (pp_) { q_r = pp_[cc_]; q_k = pp_[RW + cc_]; q_v = pp_[2 * RW + cc_]; } } \
        _Pragma("unroll") for (int i = 0; i < 8; ++i) { pr_[i] = 0.f; pk_[i] = 0.f; pv_[i] = 0.f; al_[i] = 0.f; wl_[i] = 0.f; \
            if (t0_ < n_) { const size_t m_ = (size_t)(m0_ + t0_ + i); const float* prow_ = P_ + m_ * PLD; pr_[i] = prow_[cc_]; pk_[i] = prow_[RW + cc_]; pv_[i] = prow_[2 * RW + cc_]; al_[i] = Al_[m_ * RW + cc_]; wl_[i] = Wl_[m_ * RW + cc_]; } } } while (0)
    if (bx < NUNIT) SA_LOAD(bx);
    for (int unit = bx; unit < NUNIT; unit += G) {
    const int ci = unit >> 4;
    int m0, n; if (ci < 256) { m0 = 64 * ci; n = 64; } else { m0 = TP + 32 * (ci - 256); n = 32; }
    (void)m0;
    const float* P = (const float*)(ws + B_P); const float* Wl = (const float*)(ws + WS_RW); const float* Al = (const float*)(ws + WS_RW + RWSZ);
    LAS unsigned char* B0 = lds; LAS unsigned char* B1 = lds + LBUF; LAS unsigned char* B2 = lds + 2 * LBUF; LAS unsigned char* B3 = lds + 3 * LBUF;
    LAS unsigned char* B4 = lds + 4 * LBUF; LAS unsigned char* B5 = lds + 5 * LBUF; LAS unsigned char* B6 = lds + 6 * LBUF;
    LAS float* F0 = (LAS float*)(lds + LF0); LAS float* F1 = (LAS float*)(lds + LF1); LAS float* F2 = (LAS float*)(lds + LF2); LAS float* TOT = (LAS float*)(lds + LTOT); LAS float* GC = (LAS float*)(lds + LGC);
    LDS_BAR();
    {
        const int t0 = 8 * wave; const bool live = t0 < n;
        float r[8], kp[8], v[8], kk[8], b[8], lw[8], bsv[8];
        float* bon = (float*)(ws + SC_BON) + (size_t)unit * 64;
#pragma unroll
        for (int i = 0; i < 8; ++i) {
            r[i] = 0.f; kp[i] = 0.f; v[i] = 0.f; kk[i] = 0.f; b[i] = 0.f; lw[i] = 0.f; bsv[i] = 0.f;
            if (live) {
                const float p_r = pr_[i], p_k = pk_[i], p_v = pv_[i];
                const float rr = p_r + (q_r - p_r) * mu_r, kx = p_k + (q_k - p_k) * mu_k, vx = p_v + (q_v - p_v) * mu_v; q_r = p_r; q_k = p_k; q_v = p_v;
                const float av = 1.f / (1.f + __expf(-(a0c + al_[i])));
                const float y = -(w0c + wl_[i]); const float sp = fmaxf(y, 0.f) + __logf(1.0f + __expf(-fabsf(y)));
                const float kkv = kx * kkc; const float n2 = wave_sum(kkv * kkv); const float kn = kkv / fmaxf(sqrtf(n2), 1e-12f);
                const float kpv = kx * (1.f + (av - 1.f) * kac);
                bsv[i] = wave_sum(rr * kpv * rkc);
                r[i] = rr; kp[i] = kpv; v[i] = vx; kk[i] = kn; b[i] = kn * av; lw[i] = -__expf(-sp - 0.5f); }
        }
        if (live && lane < 8) { float bv = bsv[0];
#pragma unroll
            for (int i = 1; i < 8; ++i) bv = lane == i ? bsv[i] : bv;
            bon[t0 + lane] = bv; }
        if (unit + G < NUNIT) SA_LOAD(unit + G);
        float pl[8]; pl[0] = lw[0];
#pragma unroll
        for (int i = 1; i < 8; ++i) pl[i] = pl[i - 1] + lw[i];
        TOT[wave * 64 + lane] = pl[7];
        LDS_BAR();
        float off = 0.f, lamC = 0.f;
#pragma unroll
        for (int s = 0; s < 8; ++s) { const float tv = TOT[s * 64 + lane]; lamC += tv; if (s < wave) off += tv; }
        if (wave == 0) GC[lane] = __expf(lamC);
        unsigned vt[4], kb[4], bb[4];
#pragma unroll
        for (int i = 0; i < 8; ++i) { const int t = t0 + i; const float lam = off + pl[i];
            const float g_t = __expf(lam), g_p = __expf(lam - lw[i]), g_i = __expf(-lam), g_c = __expf(lamC - lam);
            const float kkt = kk[i] * g_p, rt = r[i] * g_t;
            *(LAS unsigned short*)(B0 + t * BLD + lane * 2) = (unsigned short)f2bf(kkt); F0[t * F0P + lane] = kkt;
            *(LAS unsigned short*)(B1 + t * BLD + lane * 2) = (unsigned short)f2bf(rt); F2[t * 64 + lane] = rt;
            *(LAS unsigned short*)(B2 + t * BLD + lane * 2) = (unsigned short)f2bf(kp[i] * g_i);
            *(LAS unsigned short*)(B3 + t * BLD + lane * 2) = (unsigned short)f2bf(b[i] * g_i);
            const unsigned hv = f2bf(v[i]), hk = f2bf(kp[i] * g_c), hb = f2bf(b[i] * g_c);
            if (i & 1) { vt[i >> 1] |= hv << 16; kb[i >> 1] |= hk << 16; bb[i >> 1] |= hb << 16; } else { vt[i >> 1] = hv; kb[i >> 1] = hk; bb[i >> 1] = hb; } }
        *(LAS v4u*)(B4 + lane * BLD + 16 * wave) = (v4u){vt[0], vt[1], vt[2], vt[3]};
        *(LAS v4u*)(B5 + lane * BLD + 16 * wave) = (v4u){kb[0], kb[1], kb[2], kb[3]};
        *(LAS v4u*)(B6 + lane * BLD + 16 * wave) = (v4u){bb[0], bb[1], bb[2], bb[3]};
    }
    LDS_BAR();
    const int rb = wave >> 1, cb0 = (wave & 1) * 2, g = lane >> 4, lc = lane & 15;
    float zf; asm volatile("v_mov_b32 %0, 0" : "=v"(zf));
    const f32x4 z4 = (f32x4){zf, zf, zf, zf};
    {
        f32x4 aab[2] = {z4, z4}, aak[2] = {z4, z4}, arb[2] = {z4, z4}, ark[2] = {z4, z4};
#pragma unroll
        for (int ks = 0; ks < 2; ++ks) { const bf16x8 fk = ldfrag(B0, rb, ks, lane), fr = ldfrag(B1, rb, ks, lane);
#pragma unroll
            for (int c = 0; c < 2; ++c) { const bf16x8 fkh = ldfrag(B2, cb0 + c, ks, lane), fb = ldfrag(B3, cb0 + c, ks, lane);
                aab[c] = MFMA16(fk, fb, aab[c]); aak[c] = MFMA16(fk, fkh, aak[c]); arb[c] = MFMA16(fr, fb, arb[c]); ark[c] = MFMA16(fr, fkh, ark[c]); } }
        LDS_BAR();
#pragma unroll
        for (int c = 0; c < 2; ++c)
#pragma unroll
            for (int rg = 0; rg < 4; ++rg) { const int t = 16 * rb + 4 * g + rg, s = 16 * (cb0 + c) + lc;
                F1[t * F1P + (s & 3) * 16 + (s >> 2)] = s < t ? aab[c][rg] : 0.f;
                *(LAS unsigned short*)(B0 + t * BLD + s * 2) = (unsigned short)f2bf(s < t ? aak[c][rg] : 0.f);
                *(LAS unsigned short*)(B1 + t * BLD + s * 2) = (unsigned short)f2bf(s <= t ? arb[c][rg] : 0.f);
                *(LAS unsigned short*)(B2 + t * BLD + s * 2) = (unsigned short)f2bf(s <= t ? ark[c][rg] : 0.f); }
    }
    LDS_BAR();
    {
        f32x4 av[2] = {z4, z4};
#pragma unroll
        for (int ks = 0; ks < 2; ++ks) { const bf16x8 fa = ldfrag(B0, rb, ks, lane);
#pragma unroll
            for (int c = 0; c < 2; ++c) av[c] = MFMA16(fa, ldfrag(B4, cb0 + c, ks, lane), av[c]); }
#pragma unroll
        for (int c = 0; c < 2; ++c)
#pragma unroll
            for (int rg = 0; rg < 4; ++rg) F0[(16 * rb + 4 * g + rg) * F0P + 64 + 16 * (cb0 + c) + lc] = av[c][rg];
    }
    LDS_BAR();
    {
        const int j = tid >> 2, p = tid & 3; const LAS float* f1p = F1 + p * 16; const LAS float* f0p = F0 + j;
        float x0 = zf, x1 = zf, x2 = zf, x3 = zf, x4 = zf, x5 = zf, x6 = zf, x7 = zf, x8 = zf, x9 = zf, x10 = zf, x11 = zf, x12 = zf, x13 = zf, x14 = zf, x15 = zf;
        { float part = zf; const float xt = f0p[0*F0P] - part; x0 = (p == 0) ? xt : x0; }
        { const f32x4 a0 = *(const LAS f32x4*)(f1p + 1*F1P + 0); float part = a0.x * x0; part += dpp_mov<0xB1>(part); part += dpp_mov<0x4E>(part); const float xt = f0p[1*F0P] - part; x0 = (p == 1) ? xt : x0; }
        { const f32x4 a0 = *(const LAS f32x4*)(f1p + 2*F1P + 0); float part = a0.x * x0; part += dpp_mov<0xB1>(part); part += dpp_mov<0x4E>(part); const float xt = f0p[2*F0P] - part; x0 = (p == 2) ? xt : x0; }
        { const f32x4 a0 = *(const LAS f32x4*)(f1p + 3*F1P + 0); float part = a0.x * x0; part += dpp_mov<0xB1>(part); part += dpp_mov<0x4E>(part); const float xt = f0p[3*F0P] - part; x0 = (p == 3) ? xt : x0; }
        { const f32x4 a0 = *(const LAS f32x4*)(f1p + 4*F1P + 0); float part = a0.x * x0; part += dpp_mov<0xB1>(part); part += dpp_mov<0x4E>(part); const float xt = f0p[4*F0P] - part; x1 = (p == 0) ? xt : x1; }
        { const f32x4 a0 = *(const LAS f32x4*)(f1p + 5*F1P + 0); float part = (a0.x * x0) + (a0.y * x1); part += dpp_mov<0xB1>(part); part += dpp_mov<0x4E>(part); const float xt = f0p[5*F0P] - part; x1 = (p == 1) ? xt : x1; }
        { const f32x4 a0 = *(const LAS f32x4*)(f1p + 6*F1P + 0); float part = (a0.x * x0) + (a0.y * x1); part += dpp_mov<0xB1>(part); part += dpp_mov<0x4E>(part); const float xt = f0p[6*F0P] - part; x1 = (p == 2) ? xt : x1; }
        { const f32x4 a0 = *(const LAS f32x4*)(f1p + 7*F1P + 0); float part = (a0.x * x0) + (a0.y * x1); part += dpp_mov<0xB1>(part); part += dpp_mov<0x4E>(part); const float xt = f0p[7*F0P] - part; x1 = (p == 3) ? xt : x1; }
        { const f32x4 a0 = *(const LAS f32x4*)(f1p + 8*F1P + 0); float part = (a0.x * x0) + (a0.y * x1); part += dpp_mov<0xB1>(part); part += dpp_mov<0x4E>(part); const float xt = f0p[8*F0P] - part; x2 = (p == 0) ? xt : x2; }
        { const f32x4 a0 = *(const LAS f32x4*)(f1p + 9*F1P + 0); float part = (a0.x * x0 + a0.z * x2) + (a0.y * x1); part += dpp_mov<0xB1>(part); part += dpp_mov<0x4E>(part); const float xt = f0p[9*F0P] - part; x2 = (p == 1) ? xt : x2; }
        { const f32x4 a0 = *(const LAS f32x4*)(f1p + 10*F1P + 0); float part = (a0.x * x0 + a0.z * x2) + (a0.y * x1); part += dpp_mov<0xB1>(part); part += dpp_mov<0x4E>(part); const float xt = f0p[10*F0P] - part; x2 = (p == 2) ? xt : x2; }
        { const f32x4 a0 = *(const LAS f32x4*)(f1p + 11*F1P + 0); float part = (a0.x * x0 + a0.z * x2) + (a0.y * x1); part += dpp_mov<0xB1>(part); part += dpp_mov<0x4E>(part); const float xt = f0p[11*F0P] - part; x2 = (p == 3) ? xt : x2; }
        { const f32x4 a0 = *(const LAS f32x4*)(f1p + 12*F1P + 0); float part = (a0.x * x0 + a0.z * x2) + (a0.y * x1); part += dpp_mov<0xB1>(part); part += dpp_mov<0x4E>(part); const float xt = f0p[12*F0P] - part; x3 = (p == 0) ? xt : x3; }
        { const f32x4 a0 = *(const LAS f32x4*)(f1p + 13*F1P + 0); float part = (a0.x * x0 + a0.z * x2) + (a0.y * x1 + a0.w * x3); part += dpp_mov<0xB1>(part); part += dpp_mov<0x4E>(part); const float xt = f0p[13*F0P] - part; x3 = (p == 1) ? xt : x3; }
        { const f32x4 a0 = *(const LAS f32x4*)(f1p + 14*F1P + 0); float part = (a0.x * x0 + a0.z * x2) + (a0.y * x1 + a0.w * x3); part += dpp_mov<0xB1>(part); part += dpp_mov<0x4E>(part); const float xt = f0p[14*F0P] - part; x3 = (p == 2) ? xt : x3; }
        { const f32x4 a0 = *(const LAS f32x4*)(f1p + 15*F1P + 0); float part = (a0.x * x0 + a0.z * x2) + (a0.y * x1 + a0.w * x3); part += dpp_mov<0xB1>(part); part += dpp_mov<0x4E>(part); const float xt = f0p[15*F0P] - part; x3 = (p == 3) ? xt : x3; }
        { const f32x4 a0 = *(const LAS f32x4*)(f1p + 16*F1P + 0); float part = (a0.x * x0 + a0.z * x2) + (a0.y * x1 + a0.w * x3); part += dpp_mov<0xB1>(part); part += dpp_mov<0x4E>(part); const float xt = f0p[16*F0P] - part; x4 = (p == 0) ? xt : x4; }
        { const f32x4 a0 = *(const LAS f32x4*)(f1p + 17*F1P + 0); const f32x4 a1 = *(const LAS f32x4*)(f1p + 17*F1P + 4); float part = (a0.x * x0 + a0.z * x2 + a1.x * x4) + (a0.y * x1 + a0.w * x3); part += dpp_mov<0xB1>(part); part += dpp_mov<0x4E>(part); const float xt = f0p[17*F0P] - part; x4 = (p == 1) ? xt : x4; }
        { const f32x4 a0 = *(const LAS f32x4*)(f1p + 18*F1P + 0); const f32x4 a1 = *(const LAS f32x4*)(f1p + 18*F1P + 4); float part = (a0.x * x0 + a0.z * x2 + a1.x * x4) + (a0.y * x1 + a0.w * x3); part += dpp_mov<0xB1>(part); part += dpp_mov<0x4E>(part); const float xt = f0p[18*F0P] - part; x4 = (p == 2) ? xt : x4; }
        { const f32x4 a0 = *(const LAS f32x4*)(f1p + 19*F1P + 0); const f32x4 a1 = *(const LAS f32x4*)(f1p + 19*F1P + 4); float part = (a0.x * x0 + a0.z * x2 + a1.x * x4) + (a0.y * x1 + a0.w * x3); part += dpp_mov<0xB1>(part); part += dpp_mov<0x4E>(part); const float xt = f0p[19*F0P] - part; x4 = (p == 3) ? xt : x4; }
        { const f32x4 a0 = *(const LAS f32x4*)(f1p + 20*F1P + 0); const f32x4 a1 = *(const LAS f32x4*)(f1p + 20*F1P + 4); float part = (a0.x * x0 + a0.z * x2 + a1.x * x4) + (a0.y * x1 + a0.w * x3); part += dpp_mov<0xB1>(part); part += dpp_mov<0x4E>(part); const float xt = f0p[20*F0P] - part; x5 = (p == 0) ? xt : x5; }
        { const f32x4 a0 = *(const LAS f32x4*)(f1p + 21*F1P + 0); const f32x4 a1 = *(const LAS f32x4*)(f1p + 21*F1P + 4); float part = (a0.x * x0 + a0.z * x2 + a1.x * x4) + (a0.y * x1 + a0.w * x3 + a1.y * x5); part += dpp_mov<0xB1>(part); part += dpp_mov<0x4E>(part); const float xt = f0p[21*F0P] - part; x5 = (p == 1) ? xt : x5; }
        { const f32x4 a0 = *(const LAS f32x4*)(f1p + 22*F1P + 0); const f32x4 a1 = *(const LAS f32x4*)(f1p + 22*F1P + 4); float part = (a0.x * x0 + a0.z * x2 + a1.x * x4) + (a0.y * x1 + a0.w * x3 + a1.y * x5); part += dpp_mov<0xB1>(part); part += dpp_mov<0x4E>(part); const float xt = f0p[22*F0P] - part; x5 = (p == 2) ? xt : x5; }
        { const f32x4 a0 = *(const LAS f32x4*)(f1p + 23*F1P + 0); const f32x4 a1 = *(const LAS f32x4*)(f1p + 23*F1P + 4); float part = (a0.x * x0 + a0.z * x2 + a1.x * x4) + (a0.y * x1 + a0.w * x3 + a1.y * x5); part += dpp_mov<0xB1>(part); part += dpp_mov<0x4E>(part); const float xt = f0p[23*F0P] - part; x5 = (p == 3) ? xt : x5; }
        { const f32x4 a0 = *(const LAS f32x4*)(f1p + 24*F1P + 0); const f32x4 a1 = *(const LAS f32x4*)(f1p + 24*F1P + 4); float part = (a0.x * x0 + a0.z * x2 + a1.x * x4) + (a0.y * x1 + a0.w * x3 + a1.y * x5); part += dpp_mov<0xB1>(part); part += dpp_mov<0x4E>(part); const float xt = f0p[24*F0P] - part; x6 = (p == 0) ? xt : x6; }
        { const f32x4 a0 = *(const LAS f32x4*)(f1p + 25*F1P + 0); const f32x4 a1 = *(const LAS f32x4*)(f1p + 25*F1P + 4); float part = (a0.x * x0 + a0.z * x2 + a1.x * x4 + a1.z * x6) + (a0.y * x1 + a0.w * x3 + a1.y * x5); part += dpp_mov<0xB1>(part); part += dpp_mov<0x4E>(part); const float xt = f0p[25*F0P] - part; x6 = (p == 1) ? xt : x6; }
        { const f32x4 a0 = *(const LAS f32x4*)(f1p + 26*F1P + 0); const f32x4 a1 = *(const LAS f32x4*)(f1p + 26*F1P + 4); float part = (a0.x * x0 + a0.z * x2 + a1.x * x4 + a1.z * x6) + (a0.y * x1 + a0.w * x3 + a1.y * x5); part += dpp_mov<0xB1>(part); part += dpp_mov<0x4E>(part); const float xt = f0p[26*F0P] - part; x6 = (p == 2) ? xt : x6; }
        { const f32x4 a0 = *(const LAS f32x4*)(f1p + 27*F1P + 0); const f32x4 a1 = *(const LAS f32x4*)(f1p + 27*F1P + 4); float part = (a0.x * x0 + a0.z * x2 + a1.x * x4 + a1.z * x6) + (a0.y * x1 + a0.w * x3 + a1.y * x5); part += dpp_mov<0xB1>(part); part += dpp_mov<0x4E>(part); const float xt = f0p[27*F0P] - part; x6 = (p == 3) ? xt : x6; }
        { const f32x4 a0 = *(const LAS f32x4*)(f1p + 28*F1P + 0); const f32x4 a1 = *(const LAS f32x4*)(f1p + 28*F1P + 4); float part = (a0.x * x0 + a0.z * x2 + a1.x * x4 + a1.z * x6) + (a0.y * x1 + a0.w * x3 + a1.y * x5); part += dpp_mov<0xB1>(part); part += dpp_mov<0x4E>(part); const float xt = f0p[28*F0P] - part; x7 = (p == 0) ? xt : x7; }
        { const f32x4 a0 = *(const LAS f32x4*)(f1p + 29*F1P + 0); const f32x4 a1 = *(const LAS f32x4*)(f1p + 29*F1P + 4); float part = (a0.x * x0 + a0.z * x2 + a1.x * x4 + a1.z * x6) + (a0.y * x1 + a0.w * x3 + a1.y * x5 + a1.w * x7); part += dpp_mov<0xB1>(part); part += dpp_mov<0x4E>(part); const float xt = f0p[29*F0P] - part; x7 = (p == 1) ? xt : x7; }
        { const f32x4 a0 = *(const LAS f32x4*)(f1p + 30*F1P + 0); const f32x4 a1 = *(const LAS f32x4*)(f1p + 30*F1P + 4); float part = (a0.x * x0 + a0.z * x2 + a1.x * x4 + a1.z * x6) + (a0.y * x1 + a0.w * x3 + a1.y * x5 + a1.w * x7); part += dpp_mov<0xB1>(part); part += dpp_mov<0x4E>(part); const float xt = f0p[30*F0P] - part; x7 = (p == 2) ? xt : x7; }
        { const f32x4 a0 = *(const LAS f32x4*)(f1p + 31*F1P + 0); const f32x4 a1 = *(const LAS f32x4*)(f1p + 31*F1P + 4); float part = (a0.x * x0 + a0.z * x2 + a1.x * x4 + a1.z * x6) + (a0.y * x1 + a0.w * x3 + a1.y * x5 + a1.w * x7); part += dpp_mov<0xB1>(part); part += dpp_mov<0x4E>(part); const float xt = f0p[31*F0P] - part; x7 = (p == 3) ? xt : x7; }
        { const f32x4 a0 = *(const LAS f32x4*)(f1p + 32*F1P + 0); const f32x4 a1 = *(const LAS f32x4*)(f1p + 32*F1P + 4); float part = (a0.x * x0 + a0.z * x2 + a1.x * x4 + a1.z * x6) + (a0.y * x1 + a0.w * x3 + a1.y * x5 + a1.w * x7); part += dpp_mov<0xB1>(part); part += dpp_mov<0x4E>(part); const float xt = f0p[32*F0P] - part; x8 = (p == 0) ? xt : x8; }
        { const f32x4 a0 = *(const LAS f32x4*)(f1p + 33*F1P + 0); const f32x4 a1 = *(const LAS f32x4*)(f1p + 33*F1P + 4); const f32x4 a2 = *(const LAS f32x4*)(f1p + 33*F1P + 8); float part = (a0.x * x0 + a0.z * x2 + a1.x * x4 + a1.z * x6 + a2.x * x8) + (a0.y * x1 + a0.w * x3 + a1.y * x5 + a1.w * x7); part += dpp_mov<0xB1>(part); part += dpp_mov<0x4E>(part); const float xt = f0p[33*F0P] - part; x8 = (p == 1) ? xt : x8; }
        { const f32x4 a0 = *(const LAS f32x4*)(f1p + 34*F1P + 0); const f32x4 a1 = *(const LAS f32x4*)(f1p + 34*F1P + 4); const f32x4 a2 = *(const LAS f32x4*)(f1p + 34*F1P + 8); float part = (a0.x * x0 + a0.z * x2 + a1.x * x4 + a1.z * x6 + a2.x * x8) + (a0.y * x1 + a0.w * x3 + a1.y * x5 + a1.w * x7); part += dpp_mov<0xB1>(part); part += dpp_mov<0x4E>(part); const float xt = f0p[34*F0P] - part; x8 = (p == 2) ? xt : x8; }
        { const f32x4 a0 = *(const LAS f32x4*)(f1p + 35*F1P + 0); const f32x4 a1 = *(const LAS f32x4*)(f1p + 35*F1P + 4); const f32x4 a2 = *(const LAS f32x4*)(f1p + 35*F1P + 8); float part = (a0.x * x0 + a0.z * x2 + a1.x * x4 + a1.z * x6 + a2.x * x8) + (a0.y * x1 + a0.w * x3 + a1.y * x5 + a1.w * x7); part += dpp_mov<0xB1>(part); part += dpp_mov<0x4E>(part); const float xt = f0p[35*F0P] - part; x8 = (p == 3) ? xt : x8; }
        { const f32x4 a0 = *(const LAS f32x4*)(f1p + 36*F1P + 0); const f32x4 a1 = *(const LAS f32x4*)(f1p + 36*F1P + 4); const f32x4 a2 = *(const LAS f32x4*)(f1p + 36*F1P + 8); float part = (a0.x * x0 + a0.z * x2 + a1.x * x4 + a1.z * x6 + a2.x * x8) + (a0.y * x1 + a0.w * x3 + a1.y * x5 + a1.w * x7); part += dpp_mov<0xB1>(part); part += dpp_mov<0x4E>(part); const float xt = f0p[36*F0P] - part; x9 = (p == 0) ? xt : x9; }
        { const f32x4 a0 = *(const LAS f32x4*)(f1p + 37*F1P + 0); const f32x4 a1 = *(const LAS f32x4*)(f1p + 37*F1P + 4); const f32x4 a2 = *(const LAS f32x4*)(f1p + 37*F1P + 8); float part = (a0.x * x0 + a0.z * x2 + a1.x * x4 + a1.z * x6 + a2.x * x8) + (a0.y * x1 + a0.w * x3 + a1.y * x5 + a1.w * x7 + a2.y * x9); part += dpp_mov<0xB1>(part); part += dpp_mov<0x4E>(part); const float xt = f0p[37*F0P] - part; x9 = (p == 1) ? xt : x9; }
        { const f32x4 a0 = *(const LAS f32x4*)(f1p + 38*F1P + 0); const f32x4 a1 = *(const LAS f32x4*)(f1p + 38*F1P + 4); const f32x4 a2 = *(const LAS f32x4*)(f1p + 38*F1P + 8); float part = (a0.x * x0 + a0.z * x2 + a1.x * x4 + a1.z * x6 + a2.x * x8) + (a0.y * x1 + a0.w * x3 + a1.y * x5 + a1.w * x7 + a2.y * x9); part += dpp_mov<0xB1>(part); part += dpp_mov<0x4E>(part); const float xt = f0p[38*F0P] - part; x9 = (p == 2) ? xt : x9; }
        { const f32x4 a0 = *(const LAS f32x4*)(f1p + 39*F1P + 0); const f32x4 a1 = *(const LAS f32x4*)(f1p + 39*F1P + 4); const f32x4 a2 = *(const LAS f32x4*)(f1p + 39*F1P + 8); float part = (a0.x * x0 + a0.z * x2 + a1.x * x4 + a1.z * x6 + a2.x * x8) + (a0.y * x1 + a0.w * x3 + a1.y * x5 + a1.w * x7 + a2.y * x9); part += dpp_mov<0xB1>(part); part += dpp_mov<0x4E>(part); const float xt = f0p[39*F0P] - part; x9 = (p == 3) ? xt : x9; }
        { const f32x4 a0 = *(const LAS f32x4*)(f1p + 40*F1P + 0); const f32x4 a1 = *(const LAS f32x4*)(f1p + 40*F1P + 4); const f32x4 a2 = *(const LAS f32x4*)(f1p + 40*F1P + 8); float part = (a0.x * x0 + a0.z * x2 + a1.x * x4 + a1.z * x6 + a2.x * x8) + (a0.y * x1 + a0.w * x3 + a1.y * x5 + a1.w * x7 + a2.y * x9); part += dpp_mov<0xB1>(part); part += dpp_mov<0x4E>(part); const float xt = f0p[40*F0P] - part; x10 = (p == 0) ? xt : x10; }
        { const f32x4 a0 = *(const LAS f32x4*)(f1p + 41*F1P + 0); const f32x4 a1 = *(const LAS f32x4*)(f1p + 41*F1P + 4); const f32x4 a2 = *(const LAS f32x4*)(f1p + 41*F1P + 8); float part = (a0.x * x0 + a0.z * x2 + a1.x * x4 + a1.z * x6 + a2.x * x8 + a2.z * x10) + (a0.y * x1 + a0.w * x3 + a1.y * x5 + a1.w * x7 + a2.y * x9); part += dpp_mov<0xB1>(part); part += dpp_mov<0x4E>(part); const float xt = f0p[41*F0P] - part; x10 = (p == 1) ? xt : x10; }
        { const f32x4 a0 = *(const LAS f32x4*)(f1p + 42*F1P + 0); const f32x4 a1 = *(const LAS f32x4*)(f1p + 42*F1P + 4); const f32x4 a2 = *(const LAS f32x4*)(f1p + 42*F1P + 8); float part = (a0.x * x0 + a0.z * x2 + a1.x * x4 + a1.z * x6 + a2.x * x8 + a2.z * x10) + (a0.y * x1 + a0.w * x3 + a1.y * x5 + a1.w * x7 + a2.y * x9); part += dpp_mov<0xB1>(part); part += dpp_mov<0x4E>(part); const float xt = f0p[42*F0P] - part; x10 = (p == 2) ? xt : x10; }
        { const f32x4 a0 = *(const LAS f32x4*)(f1p + 43*F1P + 0); const f32x4 a1 = *(const LAS f32x4*)(f1p + 43*F1P + 4); const f32x4 a2 = *(const LAS f32x4*)(f1p + 43*F1P + 8); float part = (a0.x * x0 + a0.z * x2 + a1.x * x4 + a1.z * x6 + a2.x * x8 + a2.z * x10) + (a0.y * x1 + a0.w * x3 + a1.y * x5 + a1.w * x7 + a2.y * x9); part += dpp_mov<0xB1>(part); part += dpp_mov<0x4E>(part); const float xt = f0p[43*F0P] - part; x10 = (p == 3) ? xt : x10; }
        { const f32x4 a0 = *(const LAS f32x4*)(f1p + 44*F1P + 0); const f32x4 a1 = *(const LAS f32x4*)(f1p + 44*F1P + 4); const f32x4 a2 = *(const LAS f32x4*)(f1p + 44*F1P + 8); float part = (a0.x * x0 + a0.z * x2 + a1.x * x4 + a1.z * x6 + a2.x * x8 + a2.z * x10) + (a0.y * x1 + a0.w * x3 + a1.y * x5 + a1.w * x7 + a2.y * x9); part += dpp_mov<0xB1>(part); part += dpp_mov<0x4E>(part); const float xt = f0p[44*F0P] - part; x11 = (p == 0) ? xt : x11; }
        { const f32x4 a0 = *(const LAS f32x4*)(f1p + 45*F1P + 0); const f32x4 a1 = *(const LAS f32x4*)(f1p + 45*F1P + 4); const f32x4 a2 = *(const LAS f32x4*)(f1p + 45*F1P + 8); float part = (a0.x * x0 + a0.z * x2 + a1.x * x4 + a1.z * x6 + a2.x * x8 + a2.z * x10) + (a0.y * x1 + a0.w * x3 + a1.y * x5 + a1.w * x7 + a2.y * x9 + a2.w * x11); part += dpp_mov<0xB1>(part); part += dpp_mov<0x4E>(part); const float xt = f0p[45*F0P] - part; x11 = (p == 1) ? xt : x11; }
        { const f32x4 a0 = *(const LAS f32x4*)(f1p + 46*F1P + 0); const f32x4 a1 = *(const LAS f32x4*)(f1p + 46*F1P + 4); const f32x4 a2 = *(const LAS f32x4*)(f1p + 46*F1P + 8); float part = (a0.x * x0 + a0.z * x2 + a1.x * x4 + a1.z * x6 + a2.x * x8 + a2.z * x10) + (a0.y * x1 + a0.w * x3 + a1.y * x5 + a1.w * x7 + a2.y * x9 + a2.w * x11); part += dpp_mov<0xB1>(part); part += dpp_mov<0x4E>(part); const float xt = f0p[46*F0P] - part; x11 = (p == 2) ? xt : x11; }
        { const f32x4 a0 = *(const LAS f32x4*)(f1p + 47*F1P + 0); const f32x4 a1 = *(const LAS f32x4*)(f1p + 47*F1P + 4); const f32x4 a2 = *(const LAS f32x4*)(f1p + 47*F1P + 8); float part = (a0.x * x0 + a0.z * x2 + a1.x * x4 + a1.z * x6 + a2.x * x8 + a2.z * x10) + (a0.y * x1 + a0.w * x3 + a1.y * x5 + a1.w * x7 + a2.y * x9 + a2.w * x11); part += dpp_mov<0xB1>(part); part += dpp_mov<0x4E>(part); const float xt = f0p[47*F0P] - part; x11 = (p == 3) ? xt : x11; }
        { const f32x4 a0 = *(const LAS f32x4*)(f1p + 48*F1P + 0); const f32x4 a1 = *(const LAS f32x4*)(f1p + 48*F1P + 4); const f32x4 a2 = *(const LAS f32x4*)(f1p + 48*F1P + 8); float part = (a0.x * x0 + a0.z * x2 + a1.x * x4 + a1.z * x6 + a2.x * x8 + a2.z * x10) + (a0.y * x1 + a0.w * x3 + a1.y * x5 + a1.w * x7 + a2.y * x9 + a2.w * x11); part += dpp_mov<0xB1>(part); part += dpp_mov<0x4E>(part); const float xt = f0p[48*F0P] - part; x12 = (p == 0) ? xt : x12; }
        { const f32x4 a0 = *(const LAS f32x4*)(f1p + 49*F1P + 0); const f32x4 a1 = *(const LAS f32x4*)(f1p + 49*F1P + 4); const f32x4 a2 = *(const LAS f32x4*)(f1p + 49*F1P + 8); const f32x4 a3 = *(const LAS f32x4*)(f1p + 49*F1P + 12); float part = (a0.x * x0 + a0.z * x2 + a1.x * x4 + a1.z * x6 + a2.x * x8 + a2.z * x10 + a3.x * x12) + (a0.y * x1 + a0.w * x3 + a1.y * x5 + a1.w * x7 + a2.y * x9 + a2.w * x11); part += dpp_mov<0xB1>(part); part += dpp_mov<0x4E>(part); const float xt = f0p[49*F0P] - part; x12 = (p == 1) ? xt : x12; }
        { const f32x4 a0 = *(const LAS f32x4*)(f1p + 50*F1P + 0); const f32x4 a1 = *(const LAS f32x4*)(f1p + 50*F1P + 4); const f32x4 a2 = *(const LAS f32x4*)(f1p + 50*F1P + 8); const f32x4 a3 = *(const LAS f32x4*)(f1p + 50*F1P + 12); float part = (a0.x * x0 + a0.z * x2 + a1.x * x4 + a1.z * x6 + a2.x * x8 + a2.z * x10 + a3.x * x12) + (a0.y * x1 + a0.w * x3 + a1.y * x5 + a1.w * x7 + a2.y * x9 + a2.w * x11); part += dpp_mov<0xB1>(part); part += dpp_mov<0x4E>(part); const float xt = f0p[50*F0P] - part; x12 = (p == 2) ? xt : x12; }
        { const f32x4 a0 = *(const LAS f32x4*)(f1p + 51*F1P + 0); const f32x4 a1 = *(const LAS f32x4*)(f1p + 51*F1P + 4); const f32x4 a2 = *(const LAS f32x4*)(f1p + 51*F1P + 8); const f32x4 a3 = *(const LAS f32x4*)(f1p + 51*F1P + 12); float part = (a0.x * x0 + a0.z * x2 + a1.x * x4 + a1.z * x6 + a2.x * x8 + a2.z * x10 + a3.x * x12) + (a0.y * x1 + a0.w * x3 + a1.y * x5 + a1.w * x7 + a2.y * x9 + a2.w * x11); part += dpp_mov<0xB1>(part); part += dpp_mov<0x4E>(part); const float xt = f0p[51*F0P] - part; x12 = (p == 3) ? xt : x12; }
        { const f32x4 a0 = *(const LAS f32x4*)(f1p + 52*F1P + 0); const f32x4 a1 = *(const LAS f32x4*)(f1p + 52*F1P + 4); const f32x4 a2 = *(const LAS f32x4*)(f1p + 52*F1P + 8); const f32x4 a3 = *(const LAS f32x4*)(f1p + 52*F1P + 12); float part = (a0.x * x0 + a0.z * x2 + a1.x * x4 + a1.z * x6 + a2.x * x8 + a2.z * x10 + a3.x * x12) + (a0.y * x1 + a0.w * x3 + a1.y * x5 + a1.w * x7 + a2.y * x9 + a2.w * x11); part += dpp_mov<0xB1>(part); part += dpp_mov<0x4E>(part); const float xt = f0p[52*F0P] - part; x13 = (p == 0) ? xt : x13; }
        { const f32x4 a0 = *(const LAS f32x4*)(f1p + 53*F1P + 0); const f32x4 a1 = *(const LAS f32x4*)(f1p + 53*F1P + 4); const f32x4 a2 = *(const LAS f32x4*)(f1p + 53*F1P + 8); const f32x4 a3 = *(const LAS f32x4*)(f1p + 53*F1P + 12); float part = (a0.x * x0 + a0.z * x2 + a1.x * x4 + a1.z * x6 + a2.x * x8 + a2.z * x10 + a3.x * x12) + (a0.y * x1 + a0.w * x3 + a1.y * x5 + a1.w * x7 + a2.y * x9 + a2.w * x11 + a3.y * x13); part += dpp_mov<0xB1>(part); part += dpp_mov<0x4E>(part); const float xt = f0p[53*F0P] - part; x13 = (p == 1) ? xt : x13; }
        { const f32x4 a0 = *(const LAS f32x4*)(f1p + 54*F1P + 0); const f32x4 a1 = *(const LAS f32x4*)(f1p + 54*F1P + 4); const f32x4 a2 = *(const LAS f32x4*)(f1p + 54*F1P + 8); const f32x4 a3 = *(const LAS f32x4*)(f1p + 54*F1P + 12); float part = (a0.x * x0 + a0.z * x2 + a1.x * x4 + a1.z * x6 + a2.x * x8 + a2.z * x10 + a3.x * x12) + (a0.y * x1 + a0.w * x3 + a1.y * x5 + a1.w * x7 + a2.y * x9 + a2.w * x11 + a3.y * x13); part += dpp_mov<0xB1>(part); part += dpp_mov<0x4E>(part); const float xt = f0p[54*F0P] - part; x13 = (p == 2) ? xt : x13; }
        { const f32x4 a0 = *(const LAS f32x4*)(f1p + 55*F1P + 0); const f32x4 a1 = *(const LAS f32x4*)(f1p + 55*F1P + 4); const f32x4 a2 = *(const LAS f32x4*)(f1p + 55*F1P + 8); const f32x4 a3 = *(const LAS f32x4*)(f1p + 55*F1P + 12); float part = (a0.x * x0 + a0.z * x2 + a1.x * x4 + a1.z * x6 + a2.x * x8 + a2.z * x10 + a3.x * x12) + (a0.y * x1 + a0.w * x3 + a1.y * x5 + a1.w * x7 + a2.y * x9 + a2.w * x11 + a3.y * x13); part += dpp_mov<0xB1>(part); part += dpp_mov<0x4E>(part); const float xt = f0p[55*F0P] - part; x13 = (p == 3) ? xt : x13; }
        { const f32x4 a0 = *(const LAS f32x4*)(f1p + 56*F1P + 0); const f32x4 a1 = *(const LAS f32x4*)(f1p + 56*F1P + 4); const f32x4 a2 = *(const LAS f32x4*)(f1p + 56*F1P + 8); const f32x4 a3 = *(const LAS f32x4*)(f1p + 56*F1P + 12); float part = (a0.x * x0 + a0.z * x2 + a1.x * x4 + a1.z * x6 + a2.x * x8 + a2.z * x10 + a3.x * x12) + (a0.y * x1 + a0.w * x3 + a1.y * x5 + a1.w * x7 + a2.y * x9 + a2.w * x11 + a3.y * x13); part += dpp_mov<0xB1>(part); part += dpp_mov<0x4E>(part); const float xt = f0p[56*F0P] - part; x14 = (p == 0) ? xt : x14; }
        { const f32x4 a0 = *(const LAS f32x4*)(f1p + 57*F1P + 0); const f32x4 a1 = *(const LAS f32x4*)(f1p + 57*F1P + 4); const f32x4 a2 = *(const LAS f32x4*)(f1p + 57*F1P + 8); const f32x4 a3 = *(const LAS f32x4*)(f1p + 57*F1P + 12); float part = (a0.x * x0 + a0.z * x2 + a1.x * x4 + a1.z * x6 + a2.x * x8 + a2.z * x10 + a3.x * x12 + a3.z * x14) + (a0.y * x1 + a0.w * x3 + a1.y * x5 + a1.w * x7 + a2.y * x9 + a2.w * x11 + a3.y * x13); part += dpp_mov<0xB1>(part); part += dpp_mov<0x4E>(part); const float xt = f0p[57*F0P] - part; x14 = (p == 1) ? xt : x14; }
        { const f32x4 a0 = *(const LAS f32x4*)(f1p + 58*F1P + 0); const f32x4 a1 = *(const LAS f32x4*)(f1p + 58*F1P + 4); const f32x4 a2 = *(const LAS f32x4*)(f1p + 58*F1P + 8); const f32x4 a3 = *(const LAS f32x4*)(f1p + 58*F1P + 12); float part = (a0.x * x0 + a0.z * x2 + a1.x * x4 + a1.z * x6 + a2.x * x8 + a2.z * x10 + a3.x * x12 + a3.z * x14) + (a0.y * x1 + a0.w * x3 + a1.y * x5 + a1.w * x7 + a2.y * x9 + a2.w * x11 + a3.y * x13); part += dpp_mov<0xB1>(part); part += dpp_mov<0x4E>(part); const float xt = f0p[58*F0P] - part; x14 = (p == 2) ? xt : x14; }
        { const f32x4 a0 = *(const LAS f32x4*)(f1p + 59*F1P + 0); const f32x4 a1 = *(const LAS f32x4*)(f1p + 59*F1P + 4); const f32x4 a2 = *(const LAS f32x4*)(f1p + 59*F1P + 8); const f32x4 a3 = *(const LAS f32x4*)(f1p + 59*F1P + 12); float part = (a0.x * x0 + a0.z * x2 + a1.x * x4 + a1.z * x6 + a2.x * x8 + a2.z * x10 + a3.x * x12 + a3.z * x14) + (a0.y * x1 + a0.w * x3 + a1.y * x5 + a1.w * x7 + a2.y * x9 + a2.w * x11 + a3.y * x13); part += dpp_mov<0xB1>(part); part += dpp_mov<0x4E>(part); const float xt = f0p[59*F0P] - part; x14 = (p == 3) ? xt : x14; }
        { const f32x4 a0 = *(const LAS f32x4*)(f1p + 60*F1P + 0); const f32x4 a1 = *(const LAS f32x4*)(f1p + 60*F1P + 4); const f32x4 a2 = *(const LAS f32x4*)(f1p + 60*F1P + 8); const f32x4 a3 = *(const LAS f32x4*)(f1p + 60*F1P + 12); float part = (a0.x * x0 + a0.z * x2 + a1.x * x4 + a1.z * x6 + a2.x * x8 + a2.z * x10 + a3.x * x12 + a3.z * x14) + (a0.y * x1 + a0.w * x3 + a1.y * x5 + a1.w * x7 + a2.y * x9 + a2.w * x11 + a3.y * x13); part += dpp_mov<0xB1>(part); part += dpp_mov<0x4E>(part); const float xt = f0p[60*F0P] - part; x15 = (p == 0) ? xt : x15; }
        { const f32x4 a0 = *(const LAS f32x4*)(f1p + 61*F1P + 0); const f32x4 a1 = *(const LAS f32x4*)(f1p + 61*F1P + 4); const f32x4 a2 = *(const LAS f32x4*)(f1p + 61*F1P + 8); const f32x4 a3 = *(const LAS f32x4*)(f1p + 61*F1P + 12); float part = (a0.x * x0 + a0.z * x2 + a1.x * x4 + a1.z * x6 + a2.x * x8 + a2.z * x10 + a3.x * x12 + a3.z * x14) + (a0.y * x1 + a0.w * x3 + a1.y * x5 + a1.w * x7 + a2.y * x9 + a2.w * x11 + a3.y * x13 + a3.w * x15); part += dpp_mov<0xB1>(part); part += dpp_mov<0x4E>(part); const float xt = f0p[61*F0P] - part; x15 = (p == 1) ? xt : x15; }
        { const f32x4 a0 = *(const LAS f32x4*)(f1p + 62*F1P + 0); const f32x4 a1 = *(const LAS f32x4*)(f1p + 62*F1P + 4); const f32x4 a2 = *(const LAS f32x4*)(f1p + 62*F1P + 8); const f32x4 a3 = *(const LAS f32x4*)(f1p + 62*F1P + 12); float part = (a0.x * x0 + a0.z * x2 + a1.x * x4 + a1.z * x6 + a2.x * x8 + a2.z * x10 + a3.x * x12 + a3.z * x14) + (a0.y * x1 + a0.w * x3 + a1.y * x5 + a1.w * x7 + a2.y * x9 + a2.w * x11 + a3.y * x13 + a3.w * x15); part += dpp_mov<0xB1>(part); part += dpp_mov<0x4E>(part); const float xt = f0p[62*F0P] - part; x15 = (p == 2) ? xt : x15; }
        { const f32x4 a0 = *(const LAS f32x4*)(f1p + 63*F1P + 0); const f32x4 a1 = *(const LAS f32x4*)(f1p + 63*F1P + 4); const f32x4 a2 = *(const LAS f32x4*)(f1p + 63*F1P + 8); const f32x4 a3 = *(const LAS f32x4*)(f1p + 63*F1P + 12); float part = (a0.x * x0 + a0.z * x2 + a1.x * x4 + a1.z * x6 + a2.x * x8 + a2.z * x10 + a3.x * x12 + a3.z * x14) + (a0.y * x1 + a0.w * x3 + a1.y * x5 + a1.w * x7 + a2.y * x9 + a2.w * x11 + a3.y * x13 + a3.w * x15); part += dpp_mov<0xB1>(part); part += dpp_mov<0x4E>(part); const float xt = f0p[63*F0P] - part; x15 = (p == 3) ? xt : x15; }
        LAS unsigned char* dst = (wave < 4 ? B3 : B0) + (j & 63) * BLD + p * 2;
        *(LAS unsigned short*)(dst + 0) = (unsigned short)f2bf(-x0);
        *(LAS unsigned short*)(dst + 8) = (unsigned short)f2bf(-x1);
        *(LAS unsigned short*)(dst + 16) = (unsigned short)f2bf(-x2);
        *(LAS unsigned short*)(dst + 24) = (unsigned short)f2bf(-x3);
        *(LAS unsigned short*)(dst + 32) = (unsigned short)f2bf(-x4);
        *(LAS unsigned short*)(dst + 40) = (unsigned short)f2bf(-x5);
        *(LAS unsigned short*)(dst + 48) = (unsigned short)f2bf(-x6);
        *(LAS unsigned short*)(dst + 56) = (unsigned short)f2bf(-x7);
        *(LAS unsigned short*)(dst + 64) = (unsigned short)f2bf(-x8);
        *(LAS unsigned short*)(dst + 72) = (unsigned short)f2bf(-x9);
        *(LAS unsigned short*)(dst + 80) = (unsigned short)f2bf(-x10);
        *(LAS unsigned short*)(dst + 88) = (unsigned short)f2bf(-x11);
        *(LAS unsigned short*)(dst + 96) = (unsigned short)f2bf(-x12);
        *(LAS unsigned short*)(dst + 104) = (unsigned short)f2bf(-x13);
        *(LAS unsigned short*)(dst + 112) = (unsigned short)f2bf(-x14);
        *(LAS unsigned short*)(dst + 120) = (unsigned short)f2bf(-x15);
    }
    LDS_BAR();
    {
        f32x4 rpT[2], yl[2] = {z4, z4}, gT[2], hl[2] = {z4, z4};
#pragma unroll
        for (int c = 0; c < 2; ++c) { const int colx = 16 * (cb0 + c) + lc; rpT[c] = *(const LAS f32x4*)(F2 + colx * 64 + 16 * rb + 4 * g);
#pragma unroll
            for (int rg = 0; rg < 4; ++rg) { const int row = 16 * rb + 4 * g + rg; gT[c][rg] = row == colx ? GC[row] : 0.f; } }
#pragma unroll
        for (int ks = 0; ks < 2; ++ks) { const bf16x8 fnp = ldfrag(B3, rb, ks, lane), farb = ldfrag(B1, rb, ks, lane), fark = ldfrag(B2, rb, ks, lane), fbb = ldfrag(B6, rb, ks, lane), fkb = ldfrag(B5, rb, ks, lane);
#pragma unroll
            for (int c = 0; c < 2; ++c) { const bf16x8 carb = ldfrag(B1, cb0 + c, ks, lane), cbb = ldfrag(B6, cb0 + c, ks, lane), fq = ldfrag(B0, cb0 + c, ks, lane), fv = ldfrag(B4, cb0 + c, ks, lane);
                rpT[c] = MFMA16(fnp, carb, rpT[c]);
                gT[c] = MFMA16(fnp, cbb, gT[c]);
                yl[c] = MFMA16(fark, fv, yl[c]); yl[c] = MFMA16(farb, fq, yl[c]);
                hl[c] = MFMA16(fkb, fv, hl[c]); hl[c] = MFMA16(fbb, fq, hl[c]); } }
        bf16* RPg = (bf16*)(ws + SC_RP) + (size_t)unit * 4096; float* YLg = (float*)(ws + SC_YL) + (size_t)unit * 4096; bf16* Gg_ = (bf16*)(ws + SC_G) + (size_t)unit * 4096; float* HLg = (float*)(ws + SC_HL) + (size_t)unit * 4096;
#pragma unroll
        for (int c = 0; c < 2; ++c) { const int o = (16 * (cb0 + c) + lc) * 64 + 16 * rb + 4 * g;
            *(u32x2*)(RPg + o) = (u32x2){pk2(rpT[c][0], rpT[c][1]), pk2(rpT[c][2], rpT[c][3])};
            *(u32x2*)(Gg_ + o) = (u32x2){pk2(gT[c][0], gT[c][1]), pk2(gT[c][2], gT[c][3])};
            *(f32x4*)(HLg + o) = hl[c];
            *(f32x4*)(YLg + ((rb * 4 + cb0 + c) * 64 + lane) * 4) = yl[c]; }
    }
    }
#undef SA_LOAD
}

template <int NSTEP> __device__ __forceinline__ void scanB_chain(int l, LAS unsigned char* lds, int ci0, int h, int vs, const float* init, float* outp_state, int tid, int wave) {
    unsigned char* ws = KWS();
    const int lane = tid & 63, half = wave >> 2, jr = wave & 3, g = lane >> 4, lc = lane & 15;
    LAS unsigned char* XH = lds + half * 16384;
    const bf16* Gall = (const bf16*)(ws + SC_G); const float* HLall = (const float*)(ws + SC_HL); bf16* S0all = (bf16*)(ws + SC_S0);
    float zf; asm volatile("v_mov_b32 %0, 0" : "=v"(zf));
    f32x4 acc = (f32x4){zf, zf, zf, zf};
    __syncthreads();
    if (init) acc = *(const f32x4*)(init + (16 * vs + lc) * 64 + 16 * jr + 4 * g);
    constexpr int PF = NSTEP >= 16 ? 8 : 1;
    bf16x8 GA[PF][2], GB[PF][2]; f32x4 LA[PF], LB[PF];
#define SB_ISSUE(Gx, Lx, slot, c) do { const size_t unit_ = (size_t)(ci0 + (c)) * 16 + h; const bf16* Gp = Gall + unit_ * 4096 + (16 * jr + lc) * 64 + 8 * g; const float* Lp = HLall + unit_ * 4096 + (16 * vs + lc) * 64 + 16 * jr + 4 * g; \
        Gx[slot][0] = *(const bf16x8*)Gp; Gx[slot][1] = *(const bf16x8*)(Gp + 32); Lx[slot] = *(const f32x4*)Lp; } while (0)
#define SB_STEP(Gx, Lx, slot, c) do { const size_t unit = (size_t)(ci0 + (c)) * 16 + h; LAS unsigned char* xb = XH + ((c) & 1) * 8192; \
        const unsigned h0 = pk2(acc.x, acc.y), h1 = pk2(acc.z, acc.w); \
        const float l0 = acc.x - __builtin_bit_cast(float, h0 << 16), l1 = acc.y - __builtin_bit_cast(float, h0 & 0xffff0000u), l2 = acc.z - __builtin_bit_cast(float, h1 << 16), l3 = acc.w - __builtin_bit_cast(float, h1 & 0xffff0000u); \
        *(LAS u32x2*)(xb + lc * BLD + (16 * jr + 4 * g) * 2) = (u32x2){h0, h1}; \
        *(LAS u32x2*)(xb + 4096 + lc * BLD + (16 * jr + 4 * g) * 2) = (u32x2){pk2(l0, l1), pk2(l2, l3)}; \
        *(u32x2*)(S0all + unit * 4096 + (16 * vs + lc) * 64 + 16 * jr + 4 * g) = (u32x2){h0, h1};              \
        asm volatile("s_waitcnt lgkmcnt(0)" ::: "memory"); __builtin_amdgcn_s_barrier(); asm volatile("" ::: "memory");     \
        f32x4 a2 = Lx[slot]; \
        _Pragma("unroll") for (int ks = 0; ks < 2; ++ks) { const bf16x8 bh = *(const LAS bf16x8*)(xb + lc * BLD + (32 * ks + 8 * g) * 2), bl = *(const LAS bf16x8*)(xb + 4096 + lc * BLD + (32 * ks + 8 * g) * 2); \
            a2 = MFMA16(Gx[slot][ks], bh, a2); a2 = MFMA16(Gx[slot][ks], bl, a2); } \
        acc = a2; } while (0)
    if constexpr (NSTEP < 16) {
        for (int c = 0; c < NSTEP; ++c) { SB_ISSUE(GA, LA, 0, c); SB_STEP(GA, LA, 0, c); }
    } else {
        static_assert(NSTEP < 16 || NSTEP % 16 == 0, "pass B group structure");
#pragma unroll
        for (int s = 0; s < PF; ++s) SB_ISSUE(GA, LA, s, s);
        for (int c0 = 0; c0 < NSTEP; c0 += 16) {
            SB_STEP(GA, LA, 0, c0);
#pragma unroll
            for (int s = 0; s < PF; ++s) SB_ISSUE(GB, LB, s, c0 + 8 + s);
#pragma unroll
            for (int s = 1; s < PF; ++s) SB_STEP(GA, LA, s, c0 + s);
            SB_STEP(GB, LB, 0, c0 + 8);
            if (c0 + 16 < NSTEP) {
#pragma unroll
                for (int s = 0; s < PF; ++s) SB_ISSUE(GA, LA, s, c0 + 16 + s); }
#pragma unroll
            for (int s = 1; s < PF; ++s) SB_STEP(GB, LB, s, c0 + 8 + s);
        }
    }
    *(f32x4*)(outp_state + (16 * vs + lc) * 64 + 16 * jr + 4 * g) = acc;
#undef SB_ISSUE
#undef SB_STEP
}

template <int NSTEP> __device__ __forceinline__ void scanB_idle() { __syncthreads(); for (int c = 0; c < NSTEP; ++c) { asm volatile("" ::: "memory"); __builtin_amdgcn_s_barrier(); asm volatile("" ::: "memory"); } }

__device__ __forceinline__ void scanC_all(int l, LAS unsigned char* lds, int bx, int G, int tid, int wave) {
    unsigned char* ws = KWS();
    const int lane = tid & 63, rb = wave >> 1, cb0 = (wave & 1) * 2, g = lane >> 4, lc = lane & 15, t0 = 8 * wave;
    const float* ssh = KIN(I_SSH); const float* mu = KIN(I_MU) + (size_t)l * SHIFT; const float* gngp = KIN(I_GNG) + (size_t)l * RW; const float* gnbp = KIN(I_GNB) + (size_t)l * RW;
    const float* P = (const float*)(ws + B_P); const float* Gg = (const float*)(ws + WS_RW + 2 * RWSZ); bf16* MIXB = (bf16*)(ws + B_MIX);
    LAS float* Yl = (LAS float*)lds;
    f32x4 acc[2]; bf16x8 fa[2], fb[2][2]; float pv_[8], gt_[8], bn_[8], q_v, mu_v, gng, gnb;
#define SC_LOAD(unit_) do { const int ci_ = (unit_) >> 4, cc_ = 64 * ((unit_) & 15) + lane; const int m0_ = ci_ < 256 ? 64 * ci_ : TP + 32 * (ci_ - 256), n_ = ci_ < 256 ? 64 : 32; \
        const bf16* RPg = (const bf16*)(ws + SC_RP) + (size_t)(unit_) * 4096; const float* YLg = (const float*)(ws + SC_YL) + (size_t)(unit_) * 4096; const bf16* S0g = (const bf16*)(ws + SC_S0) + (size_t)(unit_) * 4096; const float* bon_ = (const float*)(ws + SC_BON) + (size_t)(unit_) * 64; \
        _Pragma("unroll") for (int c = 0; c < 2; ++c) acc[c] = *(const f32x4*)(YLg + ((rb * 4 + cb0 + c) * 64 + lane) * 4); \
        _Pragma("unroll") for (int ks = 0; ks < 2; ++ks) { fa[ks] = *(const bf16x8*)(RPg + (16 * rb + lc) * 64 + 32 * ks + 8 * g); _Pragma("unroll") for (int c = 0; c < 2; ++c) fb[ks][c] = *(const bf16x8*)(S0g + (16 * (cb0 + c) + lc) * 64 + 32 * ks + 8 * g); } \
        mu_v = mu[2 * RW + cc_]; gng = gngp[cc_]; gnb = gnbp[cc_]; q_v = 0.f; \
        _Pragma("unroll") for (int i = 0; i < 8; ++i) { pv_[i] = 0.f; gt_[i] = 0.f; bn_[i] = 0.f; } \
        if (t0 < n_) { const float* pp_ = prev_row(ssh, l, P, m0_ + t0); if (pp_) q_v = pp_[2 * RW + cc_]; \
            _Pragma("unroll") for (int i = 0; i < 8; ++i) { const size_t m_ = (size_t)(m0_ + t0 + i); pv_[i] = P[m_ * PLD + 2 * RW + cc_]; gt_[i] = Gg[m_ * RW + cc_]; bn_[i] = bon_[t0 + i]; } } } while (0)
    if (bx < NUNIT) SC_LOAD(bx);
    for (int unit = bx; unit < NUNIT; unit += G) {
        const int ci = unit >> 4, cc = 64 * (unit & 15) + lane; const int m0 = ci < 256 ? 64 * ci : TP + 32 * (ci - 256), n = ci < 256 ? 64 : 32;
        f32x4 y2[2] = {acc[0], acc[1]};
#pragma unroll
        for (int ks = 0; ks < 2; ++ks)
#pragma unroll
            for (int c = 0; c < 2; ++c) y2[c] = MFMA16(fa[ks], fb[ks][c], y2[c]);
        LDS_BAR();
#pragma unroll
        for (int c = 0; c < 2; ++c)
#pragma unroll
            for (int rg = 0; rg < 4; ++rg) Yl[(16 * rb + 4 * g + rg) * 65 + 16 * (cb0 + c) + lc] = y2[c][rg];
        LDS_BAR();
        unsigned short ov[8];
        if (t0 < n) {
            float qv = q_v;
#pragma unroll
            for (int i = 0; i < 8; ++i) { const int t = t0 + i;
                const float y = Yl[t * 65 + lane]; const float ym = wave_sum(y) * (1.f / HN); const float d = y - ym; const float yv = wave_sum(d * d) * (1.f / HN);
                const float yn = d * (1.f / sqrtf(yv + GN_EPS)) * gng + gnb;
                const float p_v = pv_[i]; const float vx = p_v + (qv - p_v) * mu_v; qv = p_v;
                ov[i] = (unsigned short)f2bf((yn + bn_[i] * vx) * gt_[i]); }
        }
        if (unit + G < NUNIT) SC_LOAD(unit + G);
        if (t0 < n) {
#pragma unroll
            for (int i = 0; i < 8; ++i) MIXB[(size_t)(m0 + t0 + i) * DM + cc] = (bf16)ov[i];
        }
    }
#undef SC_LOAD
}

template <int PH> __global__ void __launch_bounds__(NTHR, 2) mk_fwd(Args a) {
    extern __shared__ __attribute__((aligned(16))) unsigned char lds_raw[];
    LAS unsigned char* lds = (LAS unsigned char*)lds_raw;
    const int wave_s = __builtin_amdgcn_readfirstlane((int)threadIdx.x >> 6);
    for (int u = threadIdx.x; u < (LDS_BYTES - LDSCTL_OFF) / 4; u += NTHR) ((LAS unsigned*)(lds + LDSCTL_OFF))[u] = 0u;
    __syncthreads();
    if (PH < 0) (void)xcd_barrier_post((unsigned*)KWS() + CW_BAR, (volatile LAS unsigned*)(lds + MISC_OFF) + 8, (int)threadIdx.x);
#define IN(k) (PH < 0 || PH == (k))
#define PHASE_IDS() int tid_; asm volatile("v_mbcnt_lo_u32_b32 %0, -1, 0\n\tv_mbcnt_hi_u32_b32 %0, -1, %0\n\tv_lshl_add_u32 %0, %1, 6, %0" : "=&v"(tid_) : "s"(wave_s)); const int tid = tid_, lane = tid & 63, wave = wave_s; \
    const int G = gridDim.x, bx = blockIdx.x, vcu = (G % 8 == 0) ? (bx % 8) * (G / 8) + bx / 8 : bx, gw = vcu * NWAVES + wave, NGW = G * NWAVES; unsigned char* ws = KWS(); (void)tid; (void)lane; (void)gw; (void)NGW; (void)ws
#define SEAM() do { if (PH < 0) { XcdBarrier bar_; bar_.bar = (unsigned*)KWS() + CW_BAR; bar_.x = xb_xcc_id(); bar_.st = (volatile LAS unsigned*)(lds + MISC_OFF) + 8; xcd_barrier(bar_, tid); } } while (0)

    for (int l = a.l_lo; l < a.l_hi; ++l) {
        if (IN(0)) { PHASE_IDS(); phase_convert(l, lds, wave, lane, gw, NGW); SEAM(); }
        if (IN(1)) { PHASE_IDS(); pg8::Gemm g{(const bf16*)(ws + WS_XB), (const bf16*)(ws + W_1), M, 2 * FF, DM, DM}; pg8::StaticOrder S; S.init(M, 2 * FF, G, bx); pg8::EpiSwiGLU E{(bf16*)(ws + B_H), FF};
            pg8::gemm_phase<pg8::EpiSwiGLU, pg8::StaticOrder, true, true>(lds + RING_OFF, g, S, E, tid); SEAM(); }
        if (IN(2)) { PHASE_IDS();
            { pg8::Gemm g{(const bf16*)(ws + B_H), (const bf16*)(ws + W_2), TP, DM, FF, FF}; pg8::StaticOrder S; S.init(TP, DM, G, bx); pg8::EpiResid E{(const float*)(ws + WS_X), (float*)(ws + WS_Z), DM, ALPHA, 0.5f};
              pg8::gemm_phase<pg8::EpiResid, pg8::StaticOrder, true, true>(lds + RING_OFF, g, S, E, tid); }
            { pg8::Gemm g{(const bf16*)(ws + B_H), (const bf16*)(ws + W_2), M, DM, FF, 512}; pg8::SplitOrder S{G, bx, 11, 512}; pg8::EpiSlab E{(float*)(ws + WS_SLAB), 512};
              pg8::gemm_phase<pg8::EpiSlab, pg8::SplitOrder, false, true>(lds + RING_OFF, g, S, E, tid); }
            SEAM(); }
        if (IN(3)) { PHASE_IDS(); phase_ln((const float*)(ws + WS_Z), (const float*)(ws + WS_X), (const float*)(ws + WS_SLAB), 11, ALPHA, 0.5f, KIN(I_LNG) + (size_t)l * 3 * DM, KIN(I_LNB) + (size_t)l * 3 * DM, (float*)(ws + WS_X), (bf16*)(ws + WS_XB), lane, gw, NGW); SEAM(); }
        if (IN(4)) { PHASE_IDS(); pg8::Gemm g{(const bf16*)(ws + WS_XB), (const bf16*)(ws + W_3), M, N3, DM, DM}; pg8::StaticOrder S; S.init(M, N3, G, bx); pg8::EpiP E{(float*)(ws + B_P), (bf16*)(ws + B_U), (float*)(ws + B_GV)};
            pg8::gemm_phase<pg8::EpiP, pg8::StaticOrder, true, true>(lds + RING_OFF, g, S, E, tid); SEAM(); }
        if (IN(5)) { PHASE_IDS(); phase_prep1(l, lane, gw, NGW); SEAM(); }
        if (IN(6)) { PHASE_IDS(); pg8::Gemm g{(const bf16*)(ws + B_A3B), (const bf16*)(ws + W_3B), M, NL, LK, LK}; pg8::StaticOrder S; S.init(M, NL, G, bx);
            pg8::EpiLora E{(float*)(ws + WS_RW)};
            pg8::gemm_phase<pg8::EpiLora, pg8::StaticOrder, false, false>(lds + RING_OFF, g, S, E, tid); SEAM(); }
        if (IN(7)) { PHASE_IDS(); scanA_all(l, lds, bx, G, tid, wave); SEAM(); }
        if (IN(8)) { PHASE_IDS();
            if (bx < 64) { const int hh = bx >> 2; if (wave < 4) scanB_chain<256>(l, lds, 0, hh, bx & 3, nullptr, KOUT() + O_SP + ((size_t)l * NH + hh) * 4096, tid, wave); else scanB_idle<256>(); }
            else { const float* srw = KIN(I_SRW); float* outp = KOUT();
                for (int p = bx - 64; p < 512; p += G - 64) { const int task = 2 * p + (wave >> 2), b = task >> 6, hh = (task >> 2) & 15; const size_t so = (((size_t)l * NSB + b) * NH + hh) * 4096;
                    scanB_chain<1>(l, lds, 256 + b, hh, task & 3, srw + so, outp + O_SS + so, tid, wave); }
                for (int u = bx - 64; u < 144 * 8; u += G - 64) gmlp_unit(l, lds, u, tid, wave); }
            SEAM(); }
        if (IN(9)) { PHASE_IDS(); scanC_all(l, lds, bx, G, tid, wave); SEAM(); }
        if (IN(10)) { PHASE_IDS();
            { pg8::Gemm g{(const bf16*)(ws + B_MIX), (const bf16*)(ws + W_4), TP, DM, DM, DM}; pg8::StaticOrder S; S.init(TP, DM, G, bx); pg8::EpiResid E{(const float*)(ws + WS_X), (float*)(ws + WS_Z), DM, ALPHA, 1.0f};
              pg8::gemm_phase<pg8::EpiResid, pg8::StaticOrder, true, true>(lds + RING_OFF, g, S, E, tid); }
            { pg8::Gemm g{(const bf16*)(ws + B_MIX), (const bf16*)(ws + W_4), M, DM, DM, 256}; pg8::SplitOrder S{G, bx, 8, 256}; pg8::EpiSlab E{(float*)(ws + WS_SLAB), 256};
              pg8::gemm_phase<pg8::EpiSlab, pg8::SplitOrder, false, true>(lds + RING_OFF, g, S, E, tid); }
            SEAM(); }
        if (IN(11)) { PHASE_IDS(); phase_ln((const float*)(ws + WS_Z), (const float*)(ws + WS_X), (const float*)(ws + WS_SLAB), 8, ALPHA, 1.0f, KIN(I_LNG) + (size_t)(l * 3 + 1) * DM, KIN(I_LNB) + (size_t)(l * 3 + 1) * DM, (float*)(ws + WS_X), (bf16*)(ws + WS_XB), lane, gw, NGW); SEAM(); }
        if (IN(12)) { PHASE_IDS(); pg8::Gemm g{(const bf16*)(ws + WS_XB), (const bf16*)(ws + W_5), M, 2 * FF, DM, DM}; pg8::StaticOrder S; S.init(M, 2 * FF, G, bx); pg8::EpiSwiGLU E{(bf16*)(ws + B_H), FF};
            pg8::gemm_phase<pg8::EpiSwiGLU, pg8::StaticOrder, true, true>(lds + RING_OFF, g, S, E, tid); SEAM(); }
        if (IN(13)) { PHASE_IDS();
            { pg8::Gemm g{(const bf16*)(ws + B_H), (const bf16*)(ws + W_6), TP, DM, FF, FF}; pg8::StaticOrder S; S.init(TP, DM, G, bx); pg8::EpiResid E{(const float*)(ws + WS_X), (float*)(ws + WS_Z), DM, ALPHA, 0.5f};
              pg8::gemm_phase<pg8::EpiResid, pg8::StaticOrder, true, true>(lds + RING_OFF, g, S, E, tid); }
            { pg8::Gemm g{(const bf16*)(ws + B_H), (const bf16*)(ws + W_6), M, DM, FF, 512}; pg8::SplitOrder S{G, bx, 11, 512}; pg8::EpiSlab E{(float*)(ws + WS_SLAB), 512};
              pg8::gemm_phase<pg8::EpiSlab, pg8::SplitOrder, false, true>(lds + RING_OFF, g, S, E, tid); }
            SEAM(); }
        if (IN(14)) { PHASE_IDS(); const bool last = (l == DEPTH - 1);
            phase_ln((const float*)(ws + WS_Z), (const float*)(ws + WS_X), (const float*)(ws + WS_SLAB), 11, ALPHA, 0.5f, KIN(I_LNG) + (size_t)(l * 3 + 2) * DM, KIN(I_LNB) + (size_t)(l * 3 + 2) * DM, last ? KOUT() + O_YP : (float*)(ws + WS_X), last ? (bf16*)nullptr : (bf16*)(ws + WS_XB), lane, gw, NGW);
            if (!last) SEAM(); }
    }
#undef IN
#undef SEAM
#undef PHASE_IDS
}

template <int PH> static bool prep_kernel() { return hipFuncSetAttribute((const void*)mk_fwd<PH>, hipFuncAttributeMaxDynamicSharedMemorySize, LDS_BYTES) == hipSuccess; }
template <int PH> static void launch_phase(int grid, hipStream_t stream, Args a) { hipLaunchKernelGGL(mk_fwd<PH>, dim3(grid), dim3(NTHR), LDS_BYTES, stream, a); }
extern "C" void kernel_launch(void* const* d_in, const int* in_sizes, int n_in, void* d_out, int out_size, void* d_ws, size_t ws_size, hipStream_t stream) {
    static int grid = 0;
    if (grid == 0) {
        if (n_in != 29 || (size_t)out_size != O_END || ws_size < WS_END) { fprintf(stderr, "kernel_launch: unexpected shapes: n_in %d out %d ws %zu (need %zu)\n", n_in, out_size, ws_size, (size_t)WS_END); grid = -1; return; }
        int dev = 0, cus = 0, per_cu = 0;
        if (hipGetDevice(&dev) != hipSuccess || hipDeviceGetAttribute(&cus, hipDeviceAttributeMultiprocessorCount, dev) != hipSuccess) { grid = -1; return; }
        bool ok = true;
#if MK_ONE_LAUNCH
        ok = prep_kernel<-1>();
        if (hipOccupancyMaxActiveBlocksPerMultiprocessor(&per_cu, (const void*)mk_fwd<-1>, NTHR, LDS_BYTES) != hipSuccess || per_cu < 1) fprintf(stderr, "kernel_launch: occupancy query says %d\n", per_cu);
#else
        ok = prep_kernel<0>() && prep_kernel<1>() && prep_kernel<2>() && prep_kernel<3>() && prep_kernel<4>() && prep_kernel<5>() && prep_kernel<6>() && prep_kernel<7>() && prep_kernel<8>() && prep_kernel<9>() && prep_kernel<10>() && prep_kernel<11>() && prep_kernel<12>() && prep_kernel<13>() && prep_kernel<14>();
#endif
        if (!ok) { fprintf(stderr, "kernel_launch: hipFuncSetAttribute failed\n"); grid = -1; return; }
        (void)hipGetLastError();
        grid = cus;
        if (grid < 64) { grid = -1; return; }
    }
    if (grid < 0) return;
    (void)hipMemsetAsync((char*)d_ws + WS_CTL, 0, CTL_ZERO_BYTES, stream);
    Args a{};
    for (int i = 0; i < 29; ++i) a.in[i] = (const float*)d_in[i];
    a.out = (float*)d_out; a.ws = (unsigned char*)d_ws;
#if MK_ONE_LAUNCH
    a.l_lo = 0; a.l_hi = DEPTH;
    launch_phase<-1>(grid, stream, a);
#else
    for (int l = 0; l < DEPTH; ++l) { a.l_lo = l; a.l_hi = l + 1;
        launch_phase<0>(grid, stream, a); launch_phase<1>(grid, stream, a); launch_phase<2>(grid, stream, a); launch_phase<3>(grid, stream, a); launch_phase<4>(grid, stream, a);
        launch_phase<5>(grid, stream, a); launch_phase<6>(grid, stream, a); launch_phase<7>(grid, stream, a); launch_phase<8>(grid, stream, a); launch_phase<9>(grid, stream, a);
        launch_phase<10>(grid, stream, a); launch_phase<11>(grid, stream, a); launch_phase<12>(grid, stream, a); launch_phase<13>(grid, stream, a); launch_phase<14>(grid, stream, a); }
#endif
}
```

```cpp
#include <hip/hip_runtime.h>
#include <cstdio>
#include <cstdint>
#define MK_ONE_LAUNCH 1
namespace pg8 {
#define PG8_LAS __attribute__((address_space(3)))
typedef unsigned short bf16_t;
typedef short bf16x8 __attribute__((ext_vector_type(8)));
typedef float f32x4 __attribute__((ext_vector_type(4)));
typedef unsigned u32x4 __attribute__((ext_vector_type(4)));
constexpr int BM = 256, BK = 64, HALF = 128, HTB = HALF * BK * 2  , STAGE_BYTES = 8 * HTB, NXCD = 8, WGM = 8;

__host__ __device__ __forceinline__ int lds_byte(int r, int c) { const int st = (r >> 4) * 2 + (c >> 5), rr = r & 15, cc = c & 31, ob = rr * 64 + cc * 2; return st * 1024 + (ob ^ (((ob >> 9) & 1) << 5)); }
__host__ __device__ __forceinline__ void stage_rc(int b, int& R, int& C) { const int st = b / 1024, sb = b % 1024, swz = sb ^ (((sb >> 9) & 1) << 5); R = (st >> 1) * 16 + swz / 64; C = (st & 1) * 32 + (swz % 64) / 2; }
__host__ __device__ __forceinline__ int perm32(int rho) { const int n = rho >> 4, i = rho & 15; return 8 * (i >> 2) + 4 * n + (i & 3); }

struct Unit { int pm, pn, k0; };
struct Gemm { const bf16_t* A; const bf16_t* Bt; int M, N, K, Kl; };

struct StaticOrder {
    int nM, nN, nwg, G, c;
    __host__ __device__ void init(int M, int N, int G_, int c_) { nM = M / BM; nN = N / BM; nwg = nM * nN; G = G_; c = c_; }
    __host__ __device__ bool next(int i, Unit& u) const {
        const long L = (long)i * G + c; if (L >= nwg) return false;
        int wgid = (int)L; { const int q = nwg / NXCD, r = nwg % NXCD, xcd = wgid % NXCD, off = wgid / NXCD; wgid = (xcd < r ? xcd * (q + 1) : r * (q + 1) + (xcd - r) * q) + off; }
        const int nig = WGM * nN, gid = wgid / nig, fm = gid * WGM, gsz = (nM - fm) < WGM ? (nM - fm) : WGM;
        u.pm = fm + ((wgid % nig) % gsz); u.pn = (wgid % nig) / gsz; u.k0 = 0; return true;
    }
    __device__ __forceinline__ void a_ready(const Unit&) const {}
    __device__ __forceinline__ void done(const Unit&) const {}
};
struct SplitOrder {
    int G, c, KS, Kl;
    __host__ __device__ bool next(int i, Unit& u) const { const int L = i * G + c; if (L >= 16 * KS) return false; const int ks = L >> 4, tile = L & 15; u.pm = 64 + (tile >> 3); u.pn = tile & 7; u.k0 = ks * Kl; return true; }
    __device__ __forceinline__ void a_ready(const Unit&) const {}
    __device__ __forceinline__ void done(const Unit&) const {}
};
__device__ __forceinline__ unsigned cvt_pk_bf16(float lo, float hi) { unsigned r; asm volatile("v_cvt_pk_bf16_f32 %0, %1, %2" : "=v"(r) : "v"(lo), "v"(hi)); return r; }
typedef float f32x2 __attribute__((ext_vector_type(2)));
__device__ __forceinline__ f32x2 gelu_pk(f32x2 v) {
    const f32x2 av = __builtin_elementwise_abs(v), d = av * 0.2316418882f + 1.0f;
    f32x2 t; t.x = __builtin_amdgcn_rcpf(d.x); t.y = __builtin_amdgcn_rcpf(d.y);
    f32x2 q = t * 0.5307027145f + (-0.7265760135f); q = q * t + 0.7107068705f; q = q * t + (-0.142248368f); q = q * t + 0.127414796f; q = q * t;
    const f32x2 s = (v * v) * (-0.72134752044f);
    f32x2 e; e.x = __builtin_amdgcn_exp2f(s.x); e.y = __builtin_amdgcn_exp2f(s.y);
    const f32x2 m = v * (q * e), r = v - m;
    f32x2 o; o.x = v.x < 0.f ? m.x : r.x; o.y = v.y < 0.f ? m.y : r.y; return o;
}

typedef unsigned u32x2 __attribute__((ext_vector_type(2)));
__device__ __forceinline__ float silu_f(float g) { return g * __builtin_amdgcn_rcpf(1.0f + __expf(-g)); }
struct EpiSwiGLU {
    static constexpr bool PERM = true, AFTER_DRAIN = false;
    bf16_t* O; int ldc;
    __device__ __forceinline__ void operator()(const f32x4 (&acc)[2][2][4][2], const Unit& u, int wr, int wc, int fr, int fq) const {
        const int row0 = u.pm * BM + wr * 64 + fr, col0 = u.pn * HALF + wc * 32 + 8 * fq;
#pragma unroll
        for (int ai = 0; ai < 2; ++ai)
#pragma unroll
            for (int m = 0; m < 4; ++m) { bf16_t* rowp = O + (size_t)(row0 + ai * HALF + m * 16) * ldc + col0;
                const f32x4 g0 = acc[ai][0][m][0], g1 = acc[ai][0][m][1], u0 = acc[ai][1][m][0], u1 = acc[ai][1][m][1];
                u32x4 w; w.x = cvt_pk_bf16(silu_f(g0[0]) * u0[0], silu_f(g0[1]) * u0[1]); w.y = cvt_pk_bf16(silu_f(g0[2]) * u0[2], silu_f(g0[3]) * u0[3]);
                w.z = cvt_pk_bf16(silu_f(g1[0]) * u1[0], silu_f(g1[1]) * u1[1]); w.w = cvt_pk_bf16(silu_f(g1[2]) * u1[2], silu_f(g1[3]) * u1[3]);
                *(u32x4*)rowp = w; }
    }
};
struct EpiResid {
    static constexpr bool PERM = false, AFTER_DRAIN = false;
    const bf16_t* base; float* out; int ldc; float sa, sb;
    __device__ __forceinline__ void operator()(const f32x4 (&acc)[2][2][4][2], const Unit& u, int wr, int wc, int fr, int fq) const {
        const int row0 = u.pm * BM + wr * 64 + fr, col0 = u.pn * BM + wc * 32 + 4 * fq;
#pragma unroll
        for (int ai = 0; ai < 2; ++ai)
#pragma unroll
            for (int m = 0; m < 4; ++m) { const size_t off = (size_t)(row0 + ai * HALF + m * 16) * ldc + col0;
#pragma unroll
                for (int bj = 0; bj < 2; ++bj)
#pragma unroll
                    for (int n = 0; n < 2; ++n) { const u32x2 bb = *(const u32x2*)(base + off + bj * HALF + n * 16);
                        const f32x4 b = (f32x4){__builtin_bit_cast(float, bb.x << 16), __builtin_bit_cast(float, bb.x & 0xffff0000u), __builtin_bit_cast(float, bb.y << 16), __builtin_bit_cast(float, bb.y & 0xffff0000u)};
                        *(f32x4*)(out + off + bj * HALF + n * 16) = b * sa + acc[ai][bj][m][n] * sb; } }
    }
};
struct EpiSlab {
    static constexpr bool PERM = false, AFTER_DRAIN = false;
    float* slab; int Kl;
    __device__ __forceinline__ void operator()(const f32x4 (&acc)[2][2][4][2], const Unit& u, int wr, int wc, int fr, int fq) const {
        const int row0 = (u.pm - 64) * BM + wr * 64 + fr, col0 = u.pn * BM + wc * 32 + 4 * fq; float* O = slab + (size_t)(u.k0 / Kl) * (512 * 2048);
#pragma unroll
        for (int ai = 0; ai < 2; ++ai)
#pragma unroll
            for (int m = 0; m < 4; ++m) { float* rowp = O + (size_t)(row0 + ai * HALF + m * 16) * 2048 + col0;
#pragma unroll
                for (int bj = 0; bj < 2; ++bj)
#pragma unroll
                    for (int n = 0; n < 2; ++n) *(f32x4*)(rowp + bj * HALF + n * 16) = acc[ai][bj][m][n]; }
    }
};
struct EpiP {
    static constexpr bool PERM = false, AFTER_DRAIN = false;
    float* P; bf16_t* U; float* GV;
    __device__ __forceinline__ void operator()(const f32x4 (&acc)[2][2][4][2], const Unit& u, int wr, int wc, int fr, int fq) const {
        const int row0 = u.pm * BM + wr * 64 + fr, cw = wc * 32 + 4 * fq;
        const int kind = u.pn < 14 ? 0 : (u.pn < 18 ? 1 : 2);
        float* F = kind == 0 ? P + u.pn * BM + cw : GV + (u.pn - 18) * BM + cw; const int ldf = kind == 0 ? 3584 : 1024;
        bf16_t* Ub = U + (u.pn - 14) * BM + cw;
#pragma unroll
        for (int ai = 0; ai < 2; ++ai)
#pragma unroll
            for (int m = 0; m < 4; ++m) { const size_t row = (size_t)(row0 + ai * HALF + m * 16);
#pragma unroll
                for (int bj = 0; bj < 2; ++bj)
#pragma unroll
                    for (int n = 0; n < 2; ++n) { f32x4 v = acc[ai][bj][m][n];
                        if (kind != 0) { const f32x2 a = gelu_pk((f32x2){v[0], v[1]}), b = gelu_pk((f32x2){v[2], v[3]}); v = (f32x4){a.x, a.y, b.x, b.y}; }
                        if (kind == 1) { u32x2 w; w.x = cvt_pk_bf16(v[0], v[1]); w.y = cvt_pk_bf16(v[2], v[3]); *(u32x2*)(Ub + row * 1024 + bj * HALF + n * 16) = w; }
                        else *(f32x4*)(F + row * ldf + bj * HALF + n * 16) = v; }
                asm volatile("" ::: "memory"); }
    }
};
struct EpiLora {
    static constexpr bool PERM = false, AFTER_DRAIN = false;
    float* base;
    __device__ __forceinline__ void operator()(const f32x4 (&acc)[2][2][4][2], const Unit& u, int wr, int wc, int fr, int fq) const {
        const int row0 = u.pm * BM + wr * 64 + fr, kind = u.pn >> 2, cb = (u.pn & 3) * BM + wc * 32 + 4 * fq;
        float* O = base + (size_t)kind * ((size_t)66 << 18) + cb;
#pragma unroll
        for (int ai = 0; ai < 2; ++ai)
#pragma unroll
            for (int m = 0; m < 4; ++m) { float* rowp = O + (size_t)(row0 + ai * HALF + m * 16) * 1024;
#pragma unroll
                for (int bj = 0; bj < 2; ++bj)
#pragma unroll
                    for (int n = 0; n < 2; ++n) *(f32x4*)(rowp + bj * HALF + n * 16) = acc[ai][bj][m][n]; }
    }
};
template <class Epi, class Sched, bool ALIGN_EPI = false, bool SP2 = false>
__device__ __forceinline__ void gemm_phase(PG8_LAS unsigned char* lds, const Gemm g, const Sched& S, const Epi& E, int tid_in) {
    int tid_ = tid_in; asm volatile("" : "+v"(tid_));
    const int tid = tid_, wid = __builtin_amdgcn_readfirstlane(tid >> 6), lane = tid & 63, wr = wid >> 2, wc = wid & 3, fr = lane & 15, fq = lane >> 4;
    const int K = g.K, nt = g.Kl / BK;
    unsigned voffA[2], voffB[2];
#pragma unroll
    for (int i = 0; i < 2; ++i) { int R, C; stage_rc(tid * 16 + i * 8192, R, C); const int Rb = Epi::PERM ? ((R & ~31) + perm32(R & 31)) : R;
        voffA[i] = (unsigned)(R * K + C) * 2u; voffB[i] = (unsigned)(Rb * K + C) * 2u; }
    const size_t kstep = (size_t)(BK * 2);
    const size_t hstep = (size_t)HALF * K * 2;
    const size_t tstep = 2 * hstep;
    const unsigned ldsw = (unsigned)wid * 1024u;
    const int aoff = lds_byte(wr * 64 + fr, fq * 8), boff = lds_byte(wc * 32 + fr, fq * 8);
#define PG8_SA(b, h) (((b) * 2 + (h)) * HTB)
#define PG8_SB(b, h) ((4 + (b) * 2 + (h)) * HTB)
#define PG8_STAGE(bufoff, gbase, voff) do { _Pragma("unroll") for (int _i = 0; _i < 2; ++_i) \
        __builtin_amdgcn_global_load_lds((const unsigned*)((const char*)(gbase) + (voff)[_i]), (PG8_LAS unsigned*)(lds + (bufoff) + ldsw + _i * 8192), 16, 0, 0); } while (0)
#define PG8_LDA(dst, b, h) do { _Pragma("unroll") for (int m = 0; m < 4; ++m) _Pragma("unroll") for (int k = 0; k < 2; ++k) dst[m][k] = *(const PG8_LAS bf16x8*)(lds + PG8_SA(b, h) + aoff + m * 2048 + k * 1024); } while (0)
#define PG8_LDB(dst, b, h) do { _Pragma("unroll") for (int n = 0; n < 2; ++n) _Pragma("unroll") for (int k = 0; k < 2; ++k) dst[n][k] = *(const PG8_LAS bf16x8*)(lds + PG8_SB(b, h) + boff + n * 2048 + k * 1024); } while (0)
#define PG8_MMA(ai, bj, At, Bt) do { __builtin_amdgcn_s_setprio(1); _Pragma("unroll") for (int m = 0; m < 4; ++m) _Pragma("unroll") for (int n = 0; n < 2; ++n) _Pragma("unroll") for (int k = 0; k < 2; ++k) \
        acc[ai][bj][m][n] = __builtin_amdgcn_mfma_f32_16x16x32_bf16(Bt[n][k], At[m][k], acc[ai][bj][m][n], 0, 0, 0); __builtin_amdgcn_s_setprio(0); } while (0)
#define PG8_WAIT_V(n) asm volatile("s_waitcnt vmcnt(" #n ")" ::: "memory")
#define PG8_WAIT_L(n) asm volatile("s_waitcnt lgkmcnt(" #n ")" ::: "memory")
#define PG8_BAR __builtin_amdgcn_s_barrier()
#define PG8_SCHED __builtin_amdgcn_sched_barrier(0)
    Unit cur, nxt; int ui = 0;
    if (!S.next(0, cur)) return;
    f32x4 acc[2][2][4][2];
    float zz0; asm volatile("v_mov_b32 %0, 0" : "=v"(zz0));
#pragma unroll
    for (int a = 0; a < 2; ++a)
#pragma unroll
        for (int b = 0; b < 2; ++b)
#pragma unroll
            for (int m = 0; m < 4; ++m)
#pragma unroll
                for (int n = 0; n < 2; ++n) acc[a][b][m][n] = (f32x4){zz0, zz0, zz0, zz0};
    bf16x8 At[4][2], B0[2][2], B1[2][2];
    const char* cA = (const char*)g.A + (size_t)cur.pm * tstep + (size_t)cur.k0 * 2; const char* cB = (const char*)g.Bt + (size_t)cur.pn * tstep + (size_t)cur.k0 * 2;
    S.a_ready(cur);
    if constexpr (SP2) {
        PG8_STAGE(PG8_SB(0, 0), cB, voffB); PG8_STAGE(PG8_SB(0, 1), cB + hstep, voffB); PG8_STAGE(PG8_SA(0, 0), cA, voffA); PG8_STAGE(PG8_SA(0, 1), cA + hstep, voffA);
        if (wr == 1) PG8_BAR;
        PG8_WAIT_V(2); PG8_BAR;
        PG8_STAGE(PG8_SB(1, 0), cB + kstep, voffB); PG8_STAGE(PG8_SA(1, 0), cA + kstep, voffA); PG8_STAGE(PG8_SB(1, 1), cB + hstep + kstep, voffB);
        PG8_WAIT_V(6); PG8_BAR;
    } else {
        PG8_STAGE(PG8_SB(0, 0), cB, voffB); PG8_STAGE(PG8_SA(0, 0), cA, voffA); PG8_STAGE(PG8_SB(0, 1), cB + hstep, voffB); PG8_STAGE(PG8_SA(0, 1), cA + hstep, voffA);
        if (wr == 1) PG8_BAR;
        PG8_WAIT_V(4); PG8_BAR;
        PG8_STAGE(PG8_SB(1, 0), cB + kstep, voffB); PG8_STAGE(PG8_SA(1, 0), cA + kstep, voffA); PG8_STAGE(PG8_SB(1, 1), cB + hstep + kstep, voffB);
        PG8_WAIT_V(6); PG8_BAR;
    }
    for (;;) {
        const bool has_next = S.next(ui + 1, nxt);
        const char* nA = has_next ? (const char*)g.A + (size_t)nxt.pm * tstep + (size_t)nxt.k0 * 2 : cA; const char* nB = has_next ? (const char*)g.Bt + (size_t)nxt.pn * tstep + (size_t)nxt.k0 * 2 : cB;
        for (int t = 0; t < nt; t += 2) {
            const bool last = (t == nt - 2);
            const char* a1 = cA + (size_t)(t + 1) * kstep;
            const char* a2 = last ? nA : cA + (size_t)(t + 2) * kstep; const char* b2 = last ? nB : cB + (size_t)(t + 2) * kstep;
            const char* a3 = a2 + kstep; const char* b3 = b2 + kstep;
            if (last && has_next) S.a_ready(nxt);
            if constexpr (SP2) {
            PG8_LDB(B0, 0, 0); PG8_LDB(B1, 0, 1); PG8_SCHED; PG8_LDA(At, 0, 0); PG8_STAGE(PG8_SA(1, 1), a1 + hstep, voffA);
            PG8_WAIT_V(8); PG8_WAIT_L(0); PG8_BAR; PG8_MMA(0, 0, At, B0); PG8_MMA(0, 1, At, B1); PG8_BAR; PG8_SCHED;
            PG8_LDA(At, 0, 1); PG8_STAGE(PG8_SB(0, 0), b2, voffB); PG8_STAGE(PG8_SB(0, 1), b2 + hstep, voffB); PG8_STAGE(PG8_SA(0, 0), a2, voffA);
            PG8_WAIT_V(8); PG8_WAIT_L(0); PG8_BAR; PG8_MMA(1, 0, At, B0); PG8_MMA(1, 1, At, B1); PG8_BAR; PG8_SCHED;
            PG8_LDB(B0, 1, 0); PG8_LDB(B1, 1, 1); PG8_SCHED; PG8_LDA(At, 1, 0); PG8_STAGE(PG8_SA(0, 1), a2 + hstep, voffA);
            PG8_WAIT_V(8); PG8_WAIT_L(0); PG8_BAR; PG8_MMA(0, 0, At, B0); PG8_MMA(0, 1, At, B1); PG8_BAR; PG8_SCHED;
            PG8_LDA(At, 1, 1); PG8_STAGE(PG8_SB(1, 0), b3, voffB); PG8_STAGE(PG8_SB(1, 1), b3 + hstep, voffB); PG8_STAGE(PG8_SA(1, 0), a3, voffA);
            PG8_WAIT_V(8); PG8_WAIT_L(0); PG8_BAR; PG8_MMA(1, 0, At, B0); PG8_MMA(1, 1, At, B1); PG8_BAR; PG8_SCHED;
            } else {
            PG8_LDB(B0, 0, 0); PG8_SCHED; PG8_LDA(At, 0, 0); PG8_STAGE(PG8_SA(1, 1), a1 + hstep, voffA);
            PG8_WAIT_L(8); PG8_BAR; PG8_WAIT_L(0); PG8_MMA(0, 0, At, B0); PG8_BAR; PG8_SCHED;
            PG8_LDB(B1, 0, 1); PG8_STAGE(PG8_SB(0, 0), b2, voffB);
            PG8_BAR; PG8_WAIT_L(0); PG8_MMA(0, 1, At, B1); PG8_BAR;
            PG8_LDA(At, 0, 1); PG8_STAGE(PG8_SA(0, 0), a2, voffA);
            PG8_BAR; PG8_WAIT_L(0); PG8_MMA(1, 0, At, B0); PG8_BAR; PG8_SCHED;
            PG8_STAGE(PG8_SB(0, 1), b2 + hstep, voffB);
            PG8_WAIT_V(6); PG8_BAR; PG8_MMA(1, 1, At, B1); PG8_BAR;
            PG8_LDB(B0, 1, 0); PG8_SCHED; PG8_LDA(At, 1, 0); PG8_STAGE(PG8_SA(0, 1), a2 + hstep, voffA);
            PG8_WAIT_L(8); PG8_BAR; PG8_WAIT_L(0); PG8_MMA(0, 0, At, B0); PG8_BAR; PG8_SCHED;
            PG8_LDB(B1, 1, 1); PG8_STAGE(PG8_SB(1, 0), b3, voffB);
            PG8_BAR; PG8_WAIT_L(0); PG8_MMA(0, 1, At, B1); PG8_BAR;
            PG8_LDA(At, 1, 1); PG8_STAGE(PG8_SA(1, 0), a3, voffA);
            PG8_BAR; PG8_WAIT_L(0); PG8_MMA(1, 0, At, B0); PG8_BAR; PG8_SCHED;
            PG8_STAGE(PG8_SB(1, 1), b3 + hstep, voffB);
            PG8_WAIT_V(6); PG8_BAR; PG8_MMA(1, 1, At, B1); PG8_BAR;
            }
        }
        if constexpr (ALIGN_EPI) { if (wr == 0) PG8_BAR; }
        if constexpr (!Epi::AFTER_DRAIN) { E(acc, cur, wr, wc, fr, fq); S.done(cur); }
        if (!has_next) break;
{ float zz1; asm volatile("v_mov_b32 %0, 0" : "=v"(zz1));
#pragma unroll
        for (int a = 0; a < 2; ++a)
#pragma unroll
            for (int b = 0; b < 2; ++b)
#pragma unroll
                for (int m = 0; m < 4; ++m)
#pragma unroll
                    for (int n = 0; n < 2; ++n) acc[a][b][m][n] = (f32x4){zz1, zz1, zz1, zz1}; }
        cur = nxt; cA = nA; cB = nB; ++ui;
        if constexpr (ALIGN_EPI) { if (wr == 1) PG8_BAR; }
    }
    PG8_WAIT_V(0);
    if constexpr (!ALIGN_EPI) { if (wr == 0) PG8_BAR; }
    PG8_BAR;
    if constexpr (Epi::AFTER_DRAIN) { E.fused(acc, cur, wr, wc, fr, fq, lds, wid, lane); S.done(cur); }
#undef PG8_SA
#undef PG8_SB
#undef PG8_STAGE
#undef PG8_LDA
#undef PG8_LDB
#undef PG8_MMA
#undef PG8_WAIT_V
#undef PG8_WAIT_L
#undef PG8_BAR
#undef PG8_SCHED
}
}
#define GAS __attribute__((address_space(1)))
#define LAS __attribute__((address_space(3)))
typedef unsigned short bf16;
typedef unsigned v4u __attribute__((ext_vector_type(4)));
typedef float f32x4 __attribute__((ext_vector_type(4)));
typedef short bf16x8 __attribute__((ext_vector_type(8)));
typedef GAS unsigned gu32;
typedef GAS unsigned long long gu64;
#define RLX_AGENT __ATOMIC_RELAXED, __HIP_MEMORY_SCOPE_AGENT
#define LDS_WAIT() asm volatile("s_waitcnt lgkmcnt(0)" ::: "memory")
#define VM_WAIT() asm volatile("s_waitcnt vmcnt(0)" ::: "memory")
__device__ __forceinline__ unsigned long long rt() { return __builtin_amdgcn_s_memrealtime(); }
typedef float f32x2_t __attribute__((ext_vector_type(2))); typedef __bf16 bf16x2_t __attribute__((ext_vector_type(2)));
__device__ __forceinline__ unsigned pk2(float lo, float hi) { const bf16x2_t b = __builtin_convertvector((f32x2_t){lo, hi}, bf16x2_t); return __builtin_bit_cast(unsigned, b); }
__device__ __forceinline__ unsigned f2bf(float f) { return pk2(f, 0.f) & 0xffffu; }
#define XB_TMO      128
#define XB_XCNT(j)  (256  + 64 * (j))
#define XB_XSUB(j)  (1280 + 64 * (j))
#define XB_XGEN(j)  (2304 + 64 * (j))
#define XB_TOP      3328
#define XB_TOPGEN   3392
#define XCD_BAR_WORDS 3456
#define XB_SPIN_CAP (1u << 18)

__device__ __forceinline__ unsigned xb_ld(unsigned* p)              { return __hip_atomic_load(p, __ATOMIC_RELAXED, __HIP_MEMORY_SCOPE_AGENT); }
__device__ __forceinline__ unsigned xb_add(unsigned* p, unsigned v) { return __hip_atomic_fetch_add(p, v, __ATOMIC_RELAXED, __HIP_MEMORY_SCOPE_AGENT); }
__device__ __forceinline__ unsigned xb_xcc_id() { return (unsigned)__builtin_amdgcn_s_getreg((3 << 11) | 20) & 0xFu; }
#define XB_SPIN(cond, bar) do { unsigned _sp = 0; while (cond) { __builtin_amdgcn_s_sleep(1); \
    if ((++_sp & 255u) == 0u) { if (xb_ld(&(bar)[XB_TMO])) break; if (_sp > XB_SPIN_CAP) { atomicAdd(&(bar)[XB_TMO], 1u); break; } } } } while (0)

struct XcdBarrier {
    unsigned* bar; unsigned x;
    volatile LAS unsigned* st;
};

__device__ __forceinline__ XcdBarrier xcd_barrier_post(unsigned* bar, volatile LAS unsigned* st, int tid) {
    XcdBarrier b; b.bar = bar; b.x = xb_xcc_id(); b.st = st;
    if (tid == 0) (void)xb_add(&bar[XB_XCNT(b.x)], 1u);
    return b;
}
__device__ __forceinline__ void xcd_barrier_complete(unsigned* bar, unsigned x, unsigned& nloc, unsigned& nx) {
    const unsigned G = gridDim.x * gridDim.y * gridDim.z;
    unsigned sum, cnt, mine, sp = 0u;
    for (;;) {
        sum = 0u; cnt = 0u; mine = 0u;
#pragma unroll
        for (unsigned j = 0; j < 16; ++j) { const unsigned c = xb_ld(&bar[XB_XCNT(j)]); sum += c; cnt += (c > 0u) ? 1u : 0u; mine = (j == x) ? c : mine; }
        if (sum == G) break;
        __builtin_amdgcn_s_sleep(1);
        if ((++sp & 255u) == 0u) { if (xb_ld(&bar[XB_TMO])) break; if (sp > XB_SPIN_CAP) { atomicAdd(&bar[XB_TMO], 1u); break; } }
    }
    nloc = mine > 0u ? mine : 1u; nx = cnt > 0u ? cnt : 1u;
}

__device__ __forceinline__ void xcd_barrier(const XcdBarrier& b, int tid) {
    asm volatile("s_waitcnt vmcnt(0)" ::: "memory");
    __syncthreads();
    if (tid == 0) {
        unsigned* bar = b.bar;
        __builtin_amdgcn_s_waitcnt(0);
        unsigned nloc = b.st[0], nx = b.st[1];
        if (nloc == 0u) { xcd_barrier_complete(bar, b.x, nloc, nx); b.st[0] = nloc; b.st[1] = nx; }
        const unsigned old = xb_add(&bar[XB_XSUB(b.x)], 1u);
        const unsigned gen = old / nloc;
        if (old + 1u == (gen + 1u) * nloc) {
            __builtin_amdgcn_fence(__ATOMIC_RELEASE, "agent");
            asm volatile("s_waitcnt vmcnt(0)" ::: "memory");
            const unsigned og = xb_add(&bar[XB_TOP], 1u);
            const unsigned tg = og / nx;
            if (og + 1u == (tg + 1u) * nx) xb_add(&bar[XB_TOPGEN], 1u);
            else XB_SPIN(xb_ld(&bar[XB_TOPGEN]) == tg, bar);
            __builtin_amdgcn_fence(__ATOMIC_ACQUIRE, "agent");
            xb_add(&bar[XB_XGEN(b.x)], 1u);
            asm volatile("s_waitcnt vmcnt(0)" ::: "memory");
        } else {
            XB_SPIN(xb_ld(&bar[XB_XGEN(b.x)]) == gen, bar);
            __builtin_amdgcn_fence(__ATOMIC_ACQUIRE, "agent");
            asm volatile("s_waitcnt vmcnt(0)" ::: "memory");
        }
    }
    __syncthreads();
}

constexpr int NWAVES = 8, NTHR = 512;
constexpr int DM = 2048, FF = 5632, DEPTH = 4;
constexpr int TP = 16384, NSB = 16, TS = 32, M = TP + NSB * TS;
constexpr int RW = 1024, NH = 16, HN = 64, GMW = 1024, GH = 8, GHD = 128;
constexpr int C_W = 3072, C_A = 3136, C_G = 3200, SHIFT = 3360, INC = 5408;
constexpr int PLD = 3584;
constexpr int N3 = 5632;
constexpr int LK = 384;
constexpr int NL = 3072;
constexpr float ALPHA = 1.6817928305074292f;
constexpr float LN_EPS = 1e-5f, GN_EPS = 64e-5f;
constexpr int NPHASE = 15;

constexpr size_t O_YP = 0, O_SP = 34603008, O_SHP = 34865152, O_SS = 34878592, O_SHS = 39072896, O_GV = 39287936, O_END = 41385088;

constexpr size_t MiB = 1u << 20;
constexpr size_t WS_CTL = 0, CTL_ZERO_BYTES = 1 * MiB;
constexpr size_t WS_X = 1 * MiB;
constexpr size_t WS_Z = 133 * MiB;
constexpr size_t WS_XB = 265 * MiB;
constexpr size_t WS_W = 331 * MiB;
constexpr size_t W_1 = WS_W, W_2 = W_1 + 44 * MiB, W_3 = W_2 + 22 * MiB, W_4 = W_3 + 22 * MiB, W_5 = W_4 + 8 * MiB, W_6 = W_5 + 44 * MiB, W_3B = W_6 + 22 * MiB;
constexpr size_t WS_BIG = 496 * MiB;
constexpr size_t B_H = WS_BIG, B_P = WS_BIG, B_U = WS_BIG + 231 * MiB, B_GV = B_U + 33 * MiB, B_A3B = B_GV + 66 * MiB;
constexpr size_t B_MIX = WS_X;
constexpr size_t WS_RW = 839 * MiB;
constexpr size_t RWSZ = 66 * MiB;
constexpr size_t WS_END = WS_RW + 8 * RWSZ;
static_assert(W_3B + (size_t)NL * LK * 2 <= WS_BIG && B_A3B + (size_t)M * LK * 2 <= WS_RW, "ws map");
static_assert(B_MIX + (size_t)M * DM * 2 <= WS_X + (size_t)TP * DM * 4, "MIXB under the sample rows of X");
static_assert((size_t)M * DM * 4 == 132 * MiB && (size_t)M * PLD * 4 == 231 * MiB && (size_t)M * 1024 * 4 == 66 * MiB, "ws sizes");
constexpr int CW_TMO = 0, CW_CODE = 1, CW_BAR = 4096;

constexpr int RING_OFF = 0, RING_BYTES = 135168;
constexpr int LDSCTL_OFF = RING_BYTES, MISC_OFF = LDSCTL_OFF + 320;
constexpr int LDS_BYTES = 147456;

struct Args { const float* in[29]; float* out; unsigned char* ws; int l_lo, l_hi; };
#define KOUT() ((float*)karg_ptr<232>())
#define KWS() ((unsigned char*)karg_ptr<240>())
enum InIdx { I_XP = 0, I_XS, I_SRW, I_SSH, I_F1G, I_F1U, I_F1D, I_WIN, I_MU, I_W0, I_WUP, I_A0, I_AUP, I_GUP, I_KK, I_KA, I_RK, I_GNG, I_GNB, I_GLG, I_GLB, I_GWS, I_GBS, I_WOUT, I_F2G, I_F2U, I_F2D, I_LNG, I_LNB };


template <int OFF> __device__ __forceinline__ const float* karg_ptr() {
    const unsigned long long kp = (unsigned long long)__builtin_amdgcn_kernarg_segment_ptr(); unsigned long long v;
    asm volatile("s_load_dwordx2 %0, %1, %2\n\ts_waitcnt lgkmcnt(0)" : "=s"(v) : "s"(kp), "i"(OFF) : "memory");
    return (const float*)(const GAS float*)v;
}
#define KIN(i) karg_ptr<8 * (i)>()
template <int CTRL> __device__ __forceinline__ float dpp_mov(float x) { return __builtin_bit_cast(float, __builtin_amdgcn_mov_dpp(__builtin_bit_cast(int, x), CTRL, 0xf, 0xf, true)); }
__device__ __forceinline__ float row16_sum(float x) { x += dpp_mov<0x128>(x); x += dpp_mov<0x124>(x); x += dpp_mov<0x122>(x); x += dpp_mov<0x121>(x); return x; }
__device__ __forceinline__ float wave_sum(float v) {
    v = row16_sum(v); const int i = __builtin_bit_cast(int, v);
    const float a = __builtin_bit_cast(float, __builtin_amdgcn_readlane(i, 0)), b = __builtin_bit_cast(float, __builtin_amdgcn_readlane(i, 16)), c = __builtin_bit_cast(float, __builtin_amdgcn_readlane(i, 32)), d = __builtin_bit_cast(float, __builtin_amdgcn_readlane(i, 48));
    return (a + b) + (c + d);
}

template <int MAP> __device__ __forceinline__ void cvt_task(const float* __restrict__ W, int K, int N, bf16* __restrict__ WT, int nb, int k0, int lane) {
    const int n = nb * 256 + 4 * lane; if (n >= N) return;
    const int drow = MAP == 0 ? n : (MAP == 3 ? (n < SHIFT ? n : n + (PLD - SHIFT)) : 256 * (n >> 7) + (n & 127) + (MAP == 2 ? 128 : 0));
    const float* src = W + (size_t)k0 * N + n; bf16* dst = WT + (size_t)drow * K + k0;
#pragma unroll
    for (int kk = 0; kk < 32; kk += 16) { f32x4 v[16];
#pragma unroll
        for (int j = 0; j < 16; ++j) v[j] = *(const f32x4*)(src + (size_t)(kk + j) * N);
#pragma unroll
        for (int i = 0; i < 4; ++i)
#pragma unroll
            for (int hh = 0; hh < 2; ++hh) { v4u o; o.x = pk2(v[8 * hh + 0][i], v[8 * hh + 1][i]); o.y = pk2(v[8 * hh + 2][i], v[8 * hh + 3][i]); o.z = pk2(v[8 * hh + 4][i], v[8 * hh + 5][i]); o.w = pk2(v[8 * hh + 6][i], v[8 * hh + 7][i]);
                *(v4u*)(dst + (size_t)i * K + kk + 8 * hh) = o; } }
}

__device__ __forceinline__ void phase_convert(int l, LAS unsigned char* lds, int wave, int lane, int gw, int NGW) {
    unsigned char* ws = KWS();
    const size_t so = (size_t)l * DM * FF;
    const float *f1g = KIN(I_F1G) + so, *f1u = KIN(I_F1U) + so, *f1d = KIN(I_F1D) + so, *f2g = KIN(I_F2G) + so, *f2u = KIN(I_F2U) + so, *f2d = KIN(I_F2D) + so;
    const float* win = KIN(I_WIN) + (size_t)l * DM * INC; const float* wout = KIN(I_WOUT) + (size_t)l * DM * DM;
    constexpr int T_GU = (FF / 256) * (DM / 32);
    constexpr int T_D = (DM / 256) * (FF / 32);
    constexpr int T_IN = ((INC + 255) / 256) * (DM / 32);
    constexpr int T_O = (DM / 256) * (DM / 32);
    constexpr int NTASK = 4 * T_GU + 2 * T_D + T_IN + T_O;
    for (int it = gw; it < NTASK; it += NGW) {
        int r = it;
        if (r < 4 * T_GU) { const int which = r / T_GU; r -= which * T_GU; const int nb = r % (FF / 256), kb = r / (FF / 256);
            const float* W = which == 0 ? f1g : (which == 1 ? f1u : (which == 2 ? f2g : f2u)); bf16* WT = (bf16*)(ws + (which < 2 ? W_1 : W_5));
            if (which & 1) cvt_task<2>(W, DM, FF, WT, nb, 32 * kb, lane); else cvt_task<1>(W, DM, FF, WT, nb, 32 * kb, lane); continue; }
        r -= 4 * T_GU;
        if (r < 2 * T_D) { const int which = r / T_D; r -= which * T_D; const int nb = r % (DM / 256), kb = r / (DM / 256);
            cvt_task<0>(which == 0 ? f1d : f2d, FF, DM, (bf16*)(ws + (which == 0 ? W_2 : W_6)), nb, 32 * kb, lane); continue; }
        r -= 2 * T_D;
        if (r < T_IN) { const int nb = r % ((INC + 255) / 256), kb = r / ((INC + 255) / 256); cvt_task<3>(win, DM, INC, (bf16*)(ws + W_3), nb, 32 * kb, lane); continue; }
        r -= T_IN;
        { const int nb = r % (DM / 256), kb = r / (DM / 256); cvt_task<0>(wout, DM, DM, (bf16*)(ws + W_4), nb, 32 * kb, lane); }
    }
    { v4u* z = (v4u*)(ws + W_3 + (size_t)SHIFT * DM * 2); const int nz = (PLD - SHIFT) * DM * 2 / 16;
      unsigned z0; asm volatile("v_mov_b32 %0, 0" : "=v"(z0));
      for (int i = gw * 64 + lane; i < nz; i += NGW * 64) z[i] = (v4u){z0, z0, z0, z0}; }
    { bf16* WT = (bf16*)(ws + W_3B); const float* wup = KIN(I_WUP) + (size_t)l * 64 * RW; const float* aup = KIN(I_AUP) + (size_t)l * 64 * RW; const float* gup = KIN(I_GUP) + (size_t)l * 160 * RW;
      for (int i = gw * 64 + lane; i < NL * LK; i += NGW * 64) { const int n = i / LK, k = i % LK, kind = n >> 10, c = n & 1023; float v = 0.f;
          if (kind == 0) { if (k < 64) v = wup[(size_t)k * RW + c]; } else if (kind == 1) { if (k >= 64 && k < 128) v = aup[(size_t)(k - 64) * RW + c]; } else { if (k >= 128 && k < 288) v = gup[(size_t)(k - 128) * RW + c]; }
          WT[i] = (bf16)f2bf(v); } }
    if (l == 0) {
        float* X = (float*)(ws + WS_X); bf16* XB = (bf16*)(ws + WS_XB); const float* xp = KIN(I_XP); const float* xs = KIN(I_XS);
        for (int m = gw; m < M; m += NGW) { const float* src = m < TP ? xp + (size_t)m * DM : xs + (size_t)(m - TP) * DM;
            const f32x4* s4 = (const f32x4*)src + lane; f32x4* d4 = (f32x4*)(X + (size_t)m * DM) + lane; unsigned long long* o8 = (unsigned long long*)(XB + (size_t)m * DM) + lane;
#pragma unroll
            for (int j = 0; j < 8; ++j) { const f32x4 v = s4[64 * j]; if (m >= TP) d4[64 * j] = v; o8[64 * j] = (unsigned long long)pk2(v.x, v.y) | ((unsigned long long)pk2(v.z, v.w) << 32); } }
    }
}

__device__ __forceinline__ void phase_ln(const float* Z, const float* Xres, const float* slab, int KS, float sa, float sb, const float* g, const float* b, float* Xo, bf16* XBo, bool all_rows, int lane, int gw, int NGW) {
    for (int m = gw; m < M; m += NGW) {
        f32x4 v[8]; float s = 0.f;
        if (m < TP) { const f32x4* zr = (const f32x4*)(Z + (size_t)m * DM) + lane;
#pragma unroll
            for (int j = 0; j < 8; ++j) v[j] = zr[64 * j];
        } else { const f32x4* xr = (const f32x4*)(Xres + (size_t)m * DM) + lane; f32x4 a[8];
#pragma unroll
            for (int j = 0; j < 8; ++j) { v[j] = xr[64 * j]; a[j] = (f32x4){0.f, 0.f, 0.f, 0.f}; }
            for (int ks = 0; ks < KS; ++ks) { const f32x4* sr = (const f32x4*)(slab + ((size_t)ks * 512 + (m - TP)) * DM) + lane;
#pragma unroll
                for (int j = 0; j < 8; ++j) a[j] = a[j] + sr[64 * j]; }
#pragma unroll
            for (int j = 0; j < 8; ++j) v[j] = v[j] * sa + a[j] * sb; }
#pragma unroll
        for (int j = 0; j < 8; ++j) s += (v[j].x + v[j].y) + (v[j].z + v[j].w);
        const float mean = wave_sum(s) * (1.f / DM); float s2 = 0.f;
#pragma unroll
        for (int j = 0; j < 8; ++j) { v[j] = v[j] - mean; s2 += (v[j].x * v[j].x + v[j].y * v[j].y) + (v[j].z * v[j].z + v[j].w * v[j].w); }
        const float rstd = 1.f / sqrtf(wave_sum(s2) * (1.f / DM) + LN_EPS);
        f32x4* xo = (f32x4*)(Xo + (size_t)m * DM) + lane; const bool wx = all_rows || m >= TP;
#pragma unroll
        for (int j = 0; j < 8; ++j) { const f32x4 gg = ((const f32x4*)g)[lane + 64 * j], bb = ((const f32x4*)b)[lane + 64 * j]; const f32x4 o = v[j] * rstd * gg + bb; if (wx) xo[64 * j] = o;
            if (XBo) ((unsigned long long*)(XBo + (size_t)m * DM) + lane)[64 * j] = (unsigned long long)pk2(o.x, o.y) | ((unsigned long long)pk2(o.z, o.w) << 32); }
    }
}

__device__ __forceinline__ const float* prev_row(const float* ssh, int l, const float* P, int m) {
    if (m < TP) return m == 0 ? nullptr : P + (size_t)(m - 1) * PLD;
    const int b = (m - TP) >> 5, t = (m - TP) & 31;
    return t == 0 ? ssh + (size_t)(l * NSB + b) * SHIFT : P + (size_t)(m - 1) * PLD;
}

__device__ __forceinline__ void phase_prep1(int l, int lane, int gw, int NGW) {
    unsigned char* ws = KWS(); float* outp = KOUT(); const float* P = (const float*)(ws + B_P); float* GV = (float*)(ws + B_GV); bf16* A3B = (bf16*)(ws + B_A3B);
    const float* mu = KIN(I_MU) + (size_t)l * SHIFT; const float* lg = KIN(I_GLG) + (size_t)l * GMW; const float* lb = KIN(I_GLB) + (size_t)l * GMW;
    const float* ssh = KIN(I_SSH);
    for (int m = gw; m < M; m += NGW) {
        const float* pr = P + (size_t)m * PLD; const float* pp = prev_row(ssh, l, P, m);
#pragma unroll
        for (int jj = 0; jj < 6; ++jj) { const int j = jj * 64 + lane; float v = 0.f;
            if (j < 288) { const int c = C_W + j; const float p = pr[c], q = pp ? pp[c] : 0.f; const float xs = p + (q - p) * mu[c];
                if (j < 64) { const float t = __expf(-2.f * fabsf(xs)); const float r = (1.f - t) / (1.f + t); v = xs < 0.f ? -r : r; }
                else if (j < 128) v = xs;
                else v = 1.f / (1.f + __expf(-xs)); }
            A3B[(size_t)m * LK + j] = (bf16)f2bf(v); }
        { f32x4* vr = (f32x4*)(GV + (size_t)m * GMW) + lane; f32x4 v[4]; float s = 0.f;
#pragma unroll
          for (int j = 0; j < 4; ++j) { v[j] = vr[64 * j]; s += (v[j].x + v[j].y) + (v[j].z + v[j].w); }
          const float mean = wave_sum(s) * (1.f / GMW); float s2 = 0.f;
#pragma unroll
          for (int j = 0; j < 4; ++j) { v[j] = v[j] - mean; s2 += (v[j].x * v[j].x + v[j].y * v[j].y) + (v[j].z * v[j].z + v[j].w * v[j].w); }
          const float rstd = 1.f / sqrtf(wave_sum(s2) * (1.f / GMW) + LN_EPS);
          f32x4* go = nullptr; if (m >= TP) go = (f32x4*)(outp + O_GV + ((size_t)l * NSB * TS + (m - TP)) * GMW) + lane;
#pragma unroll
          for (int j = 0; j < 4; ++j) { const f32x4 o = v[j] * rstd * ((const f32x4*)lg)[lane + 64 * j] + ((const f32x4*)lb)[lane + 64 * j]; vr[64 * j] = o; if (go) go[64 * j] = o; } }
        if (m == TP - 1) { float* o = outp + O_SHP + (size_t)l * SHIFT; for (int c = lane; c < SHIFT; c += 64) o[c] = pr[c]; }
        if (m >= TP && ((m - TP) & 31) == 31) { float* o = outp + O_SHS + (size_t)(l * NSB + ((m - TP) >> 5)) * SHIFT; for (int c = lane; c < SHIFT; c += 64) o[c] = pr[c]; }
    }
}

typedef unsigned u32x2g __attribute__((ext_vector_type(2)));
constexpr int GLD = 272, GL_VT = 128 * GLD, GSP = 132;
static_assert(2 * GL_VT <= RING_BYTES && 128 * GSP * 4 <= 2 * GL_VT, "gMLP LDS");
__device__ __forceinline__ void gmlp_unit(int l, LAS unsigned char* lds, int unit, int tid, int wave) {
    unsigned char* ws = KWS(); const float* VN = (const float*)(ws + B_GV); const bf16* U = (const bf16*)(ws + B_U); bf16* MIXB = (bf16*)(ws + B_MIX);
    const int ci = unit >> 3, h = unit & 7; int row0, nr; if (ci < 128) { row0 = 128 * ci; nr = 128; } else { row0 = TP + 32 * (ci - 128); nr = 32; }
    const float* wsm = KIN(I_GWS) + ((size_t)l * GH + h) * 128 * 128; const float* bs = KIN(I_GBS) + ((size_t)l * GH + h) * 128;
    LAS unsigned char* Wb = lds; LAS unsigned char* Vt = lds + GL_VT; LAS float* So = (LAS float*)lds;
    const int lane = tid & 63, g = lane >> 4, lc = lane & 15;
    __syncthreads();
    for (int idx = tid; idx < nr * 32; idx += NTHR) { const int i = idx >> 5, j4 = idx & 31; f32x4 w4 = *(const f32x4*)(wsm + i * 128 + 4 * j4);
        const int j = 4 * j4; if (j > i) w4.x = 0.f; if (j + 1 > i) w4.y = 0.f; if (j + 2 > i) w4.z = 0.f; if (j + 3 > i) w4.w = 0.f;
        *(LAS u32x2g*)(Wb + i * GLD + 8 * j4) = (u32x2g){pk2(w4.x, w4.y), pk2(w4.z, w4.w)}; }
    { const int c = tid & 127, jg = tid >> 7;
      if (32 * jg < nr) { const float* vp = VN + (size_t)(row0 + 32 * jg) * GMW + h * GHD + c; float vv[32];
#pragma unroll
          for (int j = 0; j < 32; ++j) vv[j] = vp[(size_t)j * GMW];
#pragma unroll
          for (int q = 0; q < 4; ++q) *(LAS v4u*)(Vt + c * GLD + (32 * jg + 8 * q) * 2) = (v4u){pk2(vv[8 * q], vv[8 * q + 1]), pk2(vv[8 * q + 2], vv[8 * q + 3]), pk2(vv[8 * q + 4], vv[8 * q + 5]), pk2(vv[8 * q + 6], vv[8 * q + 7])}; } }
    __syncthreads();
    float zf; asm volatile("v_mov_b32 %0, 0" : "=v"(zf));
    f32x4 acc[8];
#pragma unroll
    for (int cb = 0; cb < 8; ++cb) acc[cb] = (f32x4){zf, zf, zf, zf};
    const bool rows_live = 16 * wave < nr;
    if (rows_live) { const int nks = (wave + 2) >> 1;
        for (int ks = 0; ks < nks; ++ks) { const bf16x8 fa = *(const LAS bf16x8*)(Wb + (16 * wave + lc) * GLD + (32 * ks + 8 * g) * 2);
#pragma unroll
            for (int cb = 0; cb < 8; ++cb) acc[cb] = __builtin_amdgcn_mfma_f32_16x16x32_bf16(fa, *(const LAS bf16x8*)(Vt + (16 * cb + lc) * GLD + (32 * ks + 8 * g) * 2), acc[cb], 0, 0, 0); } }
    __syncthreads();
    if (rows_live) {
#pragma unroll
        for (int rg = 0; rg < 4; ++rg) { const int i = 16 * wave + 4 * g + rg; const float b0 = bs[i];
#pragma unroll
            for (int cb = 0; cb < 8; ++cb) So[i * GSP + 16 * cb + lc] = acc[cb][rg] + b0; } }
    __syncthreads();
    const int rq = tid >> 4, cg = tid & 15;
    if (4 * rq < nr) {
#pragma unroll
        for (int r = 0; r < 4; ++r) { const int i = 4 * rq + r; const size_t row = (size_t)(row0 + i); const v4u uu = *(const v4u*)(U + row * GMW + h * GHD + 8 * cg);
            const f32x4 s0 = *(const LAS f32x4*)(So + i * GSP + 8 * cg), s1 = *(const LAS f32x4*)(So + i * GSP + 8 * cg + 4);
            const float u0 = __builtin_bit_cast(float, uu.x << 16), u1 = __builtin_bit_cast(float, uu.x & 0xffff0000u), u2 = __builtin_bit_cast(float, uu.y << 16), u3 = __builtin_bit_cast(float, uu.y & 0xffff0000u);
            const float u4 = __builtin_bit_cast(float, uu.z << 16), u5 = __builtin_bit_cast(float, uu.z & 0xffff0000u), u6 = __builtin_bit_cast(float, uu.w << 16), u7 = __builtin_bit_cast(float, uu.w & 0xffff0000u);
            v4u o; o.x = pk2(u0 * s0.x, u1 * s0.y); o.y = pk2(u2 * s0.z, u3 * s0.w); o.z = pk2(u4 * s1.x, u5 * s1.y); o.w = pk2(u6 * s1.z, u7 * s1.w);
            *(v4u*)(MIXB + row * DM + RW + h * GHD + 8 * cg) = o; }
    }
}


constexpr int NCI = 272, NUNIT = NCI * NH;
constexpr size_t SC_G = WS_RW + 3 * RWSZ;
constexpr size_t SC_HL = SC_G + (size_t)NUNIT * 8192;
constexpr size_t SC_RP = SC_HL + (size_t)NUNIT * 16384;
constexpr size_t SC_YL = SC_RP + (size_t)NUNIT * 8192;
constexpr size_t SC_S0 = SC_YL + (size_t)NUNIT * 16384;
constexpr size_t SC_BON = SC_S0 + (size_t)NUNIT * 8192;
constexpr size_t SC_END = SC_BON + (size_t)NUNIT * 256;
static_assert(SC_END <= WS_END, "scan scratch");
constexpr size_t WS_SLAB = SC_G;
static_assert(WS_SLAB + (size_t)11 * 512 * 2048 * 4 <= WS_END, "slab");
typedef unsigned u32x2 __attribute__((ext_vector_type(2)));
constexpr int BLD = 144;
constexpr int LBUF = 9216;
constexpr int LF0 = 7 * LBUF, F0P = 129;
constexpr int LF1 = LF0 + 64 * F0P * 4, F1P = 68;
constexpr int LF2 = LF1 + 64 * F1P * 4;
constexpr int LTOT = LF2 + 16384;
constexpr int LGC = LTOT + 2048;
constexpr int SCAN_LDS = LGC + 256;
static_assert(SCAN_LDS <= RING_BYTES, "scan LDS");

__device__ __forceinline__ bf16x8 ldfrag(const LAS unsigned char* mat, int blk, int ks, int lane) { return *(const LAS bf16x8*)(mat + (16 * blk + (lane & 15)) * BLD + (32 * ks + 8 * (lane >> 4)) * 2); }
#define MFMA16(a, b, c) __builtin_amdgcn_mfma_f32_16x16x32_bf16((a), (b), (c), 0, 0, 0)

#define LDS_BAR() do { asm volatile("s_waitcnt lgkmcnt(0)" ::: "memory"); __builtin_amdgcn_s_barrier(); asm volatile("" ::: "memory"); } while (0)
__device__ __forceinline__ void scanA_all(int l, LAS unsigned char* lds, int bx, int G, int tid, int wave) {
    unsigned char* ws = KWS();
    const int lane = tid & 63;
    const float* ssh = KIN(I_SSH); const float* mu = KIN(I_MU) + (size_t)l * SHIFT;
    const float *w0p = KIN(I_W0) + (size_t)l * RW, *a0p = KIN(I_A0) + (size_t)l * RW, *kkp = KIN(I_KK) + (size_t)l * RW, *kap = KIN(I_KA) + (size_t)l * RW, *rkp = KIN(I_RK) + (size_t)l * RW;
    float pr_[8], pk_[8], pv_[8], al_[8], wl_[8]; float q_r, q_k, q_v, mu_r, mu_k, mu_v, w0c, a0c, kkc, kac, rkc;
#define SA_LOAD(unit_) do { const int ci_ = (unit_) >> 4, cc_ = 64 * ((unit_) & 15) + lane; const int m0_ = ci_ < 256 ? 64 * ci_ : TP + 32 * (ci_ - 256), n_ = ci_ < 256 ? 64 : 32, t0_ = 8 * wave; \
        const float* P_ = (const float*)(ws + B_P); const float* Wl_ = (const float*)(ws + WS_RW); const float* Al_ = (const float*)(ws + WS_RW + RWSZ); \
        mu_r = mu[cc_]; mu_k = mu[RW + cc_]; mu_v = mu[2 * RW + cc_]; w0c = w0p[cc_]; a0c = a0p[cc_]; kkc = kkp[cc_]; kac = kap[cc_]; rkc = rkp[cc_]; q_r = 0.f; q_k = 0.f; q_v = 0.f; \
        if (t0_ < n_) { const float* pp_ = prev_row(ssh, l, P_, m0_ + t0_); if (pp_) { q_r = pp_[cc_]; q_k = pp_[RW + cc_]; q_v = pp_[2 * RW + cc_]; } } \
        _Pragma("unroll") for (int i = 0; i < 8; ++i) { pr_[i] = 0.f; pk_[i] = 0.f; pv_[i] = 0.f; al_[i] = 0.f; wl_[i] = 0.f; \
            if (t0_ < n_) { const size_t m_ = (size_t)(m0_ + t0_ + i); const float* prow_ = P_ + m_ * PLD; pr_[i] = prow_[cc_]; pk_[i] = prow_[RW + cc_]; pv_[i] = prow_[2 * RW + cc_]; al_[i] = Al_[m_ * RW + cc_]; wl_[i] = Wl_[m_ * RW + cc_]; } } } while (0)
    if (bx < NUNIT) SA_LOAD(bx);
    for (int unit = bx; unit < NUNIT; unit += G) {
    const int ci = unit >> 4;
    int m0, n; if (ci < 256) { m0 = 64 * ci; n = 64; } else { m0 = TP + 32 * (ci - 256); n = 32; }
    (void)m0;
    const float* P = (const float*)(ws + B_P); const float* Wl = (const float*)(ws + WS_RW); const float* Al = (const float*)(ws + WS_RW + RWSZ);
    LAS unsigned char* B0 = lds; LAS unsigned char* B1 = lds + LBUF; LAS unsigned char* B2 = lds + 2 * LBUF; LAS unsigned char* B3 = lds + 3 * LBUF;
    LAS unsigned char* B4 = lds + 4 * LBUF; LAS unsigned char* B5 = lds + 5 * LBUF; LAS unsigned char* B6 = lds + 6 * LBUF;
    LAS float* F0 = (LAS float*)(lds + LF0); LAS float* F1 = (LAS float*)(lds + LF1); LAS float* F2 = (LAS float*)(lds + LF2); LAS float* TOT = (LAS float*)(lds + LTOT); LAS float* GC = (LAS float*)(lds + LGC);
    LDS_BAR();
    {
        const int t0 = 8 * wave; const bool live = t0 < n;
        float r[8], kp[8], v[8], kk[8], b[8], lw[8], bsv[8];
        float* bon = (float*)(ws + SC_BON) + (size_t)unit * 64;
#pragma unroll
        for (int i = 0; i < 8; ++i) {
            r[i] = 0.f; kp[i] = 0.f; v[i] = 0.f; kk[i] = 0.f; b[i] = 0.f; lw[i] = 0.f; bsv[i] = 0.f;
            if (live) {
                const float p_r = pr_[i], p_k = pk_[i], p_v = pv_[i];
                const float rr = p_r + (q_r - p_r) * mu_r, kx = p_k + (q_k - p_k) * mu_k, vx = p_v + (q_v - p_v) * mu_v; q_r = p_r; q_k = p_k; q_v = p_v;
                const float av = 1.f / (1.f + __expf(-(a0c + al_[i])));
                const float y = -(w0c + wl_[i]); const float sp = fmaxf(y, 0.f) + __logf(1.0f + __expf(-fabsf(y)));
                const float kkv = kx * kkc; const float n2 = wave_sum(kkv * kkv); const float kn = kkv / fmaxf(sqrtf(n2), 1e-12f);
                const float kpv = kx * (1.f + (av - 1.f) * kac);
                bsv[i] = wave_sum(rr * kpv * rkc);
                r[i] = rr; kp[i] = kpv; v[i] = vx; kk[i] = kn; b[i] = kn * av; lw[i] = -__expf(-sp - 0.5f); }
        }
        if (live && lane < 8) { float bv = bsv[0];
#pragma unroll
            for (int i = 1; i < 8; ++i) bv = lane == i ? bsv[i] : bv;
            bon[t0 + lane] = bv; }
        if (unit + G < NUNIT) SA_LOAD(unit + G);
        float pl[8]; pl[0] = lw[0];
#pragma unroll
        for (int i = 1; i < 8; ++i) pl[i] = pl[i - 1] + lw[i];
        TOT[wave * 64 + lane] = pl[7];
        LDS_BAR();
        float off = 0.f, lamC = 0.f;
#pragma unroll
        for (int s = 0; s < 8; ++s) { const float tv = TOT[s * 64 + lane]; lamC += tv; if (s < wave) off += tv; }
        if (wave == 0) GC[lane] = __expf(lamC);
        unsigned vt[4], kb[4], bb[4];
#pragma unroll
        for (int i = 0; i < 8; ++i) { const int t = t0 + i; const float lam = off + pl[i];
            const float g_t = __expf(lam), g_p = __expf(lam - lw[i]), g_i = __expf(-lam), g_c = __expf(lamC - lam);
            const float kkt = kk[i] * g_p, rt = r[i] * g_t;
            *(LAS unsigned short*)(B0 + t * BLD + lane * 2) = (unsigned short)f2bf(kkt); F0[t * F0P + lane] = kkt;
            *(LAS unsigned short*)(B1 + t * BLD + lane * 2) = (unsigned short)f2bf(rt); F2[t * 64 + lane] = rt;
            *(LAS unsigned short*)(B2 + t * BLD + lane * 2) = (unsigned short)f2bf(kp[i] * g_i);
            *(LAS unsigned short*)(B3 + t * BLD + lane * 2) = (unsigned short)f2bf(b[i] * g_i);
            const unsigned hv = f2bf(v[i]), hk = f2bf(kp[i] * g_c), hb = f2bf(b[i] * g_c);
            if (i & 1) { vt[i >> 1] |= hv << 16; kb[i >> 1] |= hk << 16; bb[i >> 1] |= hb << 16; } else { vt[i >> 1] = hv; kb[i >> 1] = hk; bb[i >> 1] = hb; } }
        *(LAS v4u*)(B4 + lane * BLD + 16 * wave) = (v4u){vt[0], vt[1], vt[2], vt[3]};
        *(LAS v4u*)(B5 + lane * BLD + 16 * wave) = (v4u){kb[0], kb[1], kb[2], kb[3]};
        *(LAS v4u*)(B6 + lane * BLD + 16 * wave) = (v4u){bb[0], bb[1], bb[2], bb[3]};
    }
    LDS_BAR();
    const int rb = wave >> 1, cb0 = (wave & 1) * 2, g = lane >> 4, lc = lane & 15;
    float zf; asm volatile("v_mov_b32 %0, 0" : "=v"(zf));
    const f32x4 z4 = (f32x4){zf, zf, zf, zf};
    {
        f32x4 aab[2] = {z4, z4}, aak[2] = {z4, z4}, arb[2] = {z4, z4}, ark[2] = {z4, z4};
#pragma unroll
        for (int ks = 0; ks < 2; ++ks) { const bf16x8 fk = ldfrag(B0, rb, ks, lane), fr = ldfrag(B1, rb, ks, lane);
#pragma unroll
            for (int c = 0; c < 2; ++c) { const bf16x8 fkh = ldfrag(B2, cb0 + c, ks, lane), fb = ldfrag(B3, cb0 + c, ks, lane);
                aab[c] = MFMA16(fk, fb, aab[c]); aak[c] = MFMA16(fk, fkh, aak[c]); arb[c] = MFMA16(fr, fb, arb[c]); ark[c] = MFMA16(fr, fkh, ark[c]); } }
        LDS_BAR();
#pragma unroll
        for (int c = 0; c < 2; ++c)
#pragma unroll
            for (int rg = 0; rg < 4; ++rg) { const int t = 16 * rb + 4 * g + rg, s = 16 * (cb0 + c) + lc;
                F1[t * F1P + (s & 3) * 16 + (s >> 2)] = s < t ? aab[c][rg] : 0.f;
                *(LAS unsigned short*)(B0 + t * BLD + s * 2) = (unsigned short)f2bf(s < t ? aak[c][rg] : 0.f);
                *(LAS unsigned short*)(B1 + t * BLD + s * 2) = (unsigned short)f2bf(s <= t ? arb[c][rg] : 0.f);
                *(LAS unsigned short*)(B2 + t * BLD + s * 2) = (unsigned short)f2bf(s <= t ? ark[c][rg] : 0.f); }
    }
    LDS_BAR();
    {
        f32x4 av[2] = {z4, z4};
#pragma unroll
        for (int ks = 0; ks < 2; ++ks) { const bf16x8 fa = ldfrag(B0, rb, ks, lane);
#pragma unroll
            for (int c = 0; c < 2; ++c) av[c] = MFMA16(fa, ldfrag(B4, cb0 + c, ks, lane), av[c]); }
#pragma unroll
        for (int c = 0; c < 2; ++c)
#pragma unroll
            for (int rg = 0; rg < 4; ++rg) F0[(16 * rb + 4 * g + rg) * F0P + 64 + 16 * (cb0 + c) + lc] = av[c][rg];
    }
    LDS_BAR();
    {
        const int j = tid >> 2, p = tid & 3; const LAS float* f1p = F1 + p * 16; const LAS float* f0p = F0 + j;
        float x0 = zf, x1 = zf, x2 = zf, x3 = zf, x4 = zf, x5 = zf, x6 = zf, x7 = zf, x8 = zf, x9 = zf, x10 = zf, x11 = zf, x12 = zf, x13 = zf, x14 = zf, x15 = zf;
        { float part = zf; const float xt = f0p[0*F0P] - part; x0 = (p == 0) ? xt : x0; }
        { const f32x4 a0 = *(const LAS f32x4*)(f1p + 1*F1P + 0); float part = a0.x * x0; part += dpp_mov<0xB1>(part); part += dpp_mov<0x4E>(part); const float xt = f0p[1*F0P] - part; x0 = (p == 1) ? xt : x0; }
        { const f32x4 a0 = *(const LAS f32x4*)(f1p + 2*F1P + 0); float part = a0.x * x0; part += dpp_mov<0xB1>(part); part += dpp_mov<0x4E>(part); const float xt = f0p[2*F0P] - part; x0 = (p == 2) ? xt : x0; }
        { const f32x4 a0 = *(const LAS f32x4*)(f1p + 3*F1P + 0); float part = a0.x * x0; part += dpp_mov<0xB1>(part); part += dpp_mov<0x4E>(part); const float xt = f0p[3*F0P] - part; x0 = (p == 3) ? xt : x0; }
        { const f32x4 a0 = *(const LAS f32x4*)(f1p + 4*F1P + 0); float part = a0.x * x0; part += dpp_mov<0xB1>(part); part += dpp_mov<0x4E>(part); const float xt = f0p[4*F0P] - part; x1 = (p == 0) ? xt : x1; }
        { const f32x4 a0 = *(const LAS f32x4*)(f1p + 5*F1P + 0); float part = (a0.x * x0) + (a0.y * x1); part += dpp_mov<0xB1>(part); part += dpp_mov<0x4E>(part); const float xt = f0p[5*F0P] - part; x1 = (p == 1) ? xt : x1; }
        { const f32x4 a0 = *(const LAS f32x4*)(f1p + 6*F1P + 0); float part = (a0.x * x0) + (a0.y * x1); part += dpp_mov<0xB1>(part); part += dpp_mov<0x4E>(part); const float xt = f0p[6*F0P] - part; x1 = (p == 2) ? xt : x1; }
        { const f32x4 a0 = *(const LAS f32x4*)(f1p + 7*F1P + 0); float part = (a0.x * x0) + (a0.y * x1); part += dpp_mov<0xB1>(part); part += dpp_mov<0x4E>(part); const float xt = f0p[7*F0P] - part; x1 = (p == 3) ? xt : x1; }
        { const f32x4 a0 = *(const LAS f32x4*)(f1p + 8*F1P + 0); float part = (a0.x * x0) + (a0.y * x1); part += dpp_mov<0xB1>(part); part += dpp_mov<0x4E>(part); const float xt = f0p[8*F0P] - part; x2 = (p == 0) ? xt : x2; }
        { const f32x4 a0 = *(const LAS f32x4*)(f1p + 9*F1P + 0); float part = (a0.x * x0 + a0.z * x2) + (a0.y * x1); part += dpp_mov<0xB1>(part); part += dpp_mov<0x4E>(part); const float xt = f0p[9*F0P] - part; x2 = (p == 1) ? xt : x2; }
        { const f32x4 a0 = *(const LAS f32x4*)(f1p + 10*F1P + 0); float part = (a0.x * x0 + a0.z * x2) + (a0.y * x1); part += dpp_mov<0xB1>(part); part += dpp_mov<0x4E>(part); const float xt = f0p[10*F0P] - part; x2 = (p == 2) ? xt : x2; }
        { const f32x4 a0 = *(const LAS f32x4*)(f1p + 11*F1P + 0); float part = (a0.x * x0 + a0.z * x2) + (a0.y * x1); part += dpp_mov<0xB1>(part); part += dpp_mov<0x4E>(part); const float xt = f0p[11*F0P] - part; x2 = (p == 3) ? xt : x2; }
        { const f32x4 a0 = *(const LAS f32x4*)(f1p + 12*F1P + 0); float part = (a0.x * x0 + a0.z * x2) + (a0.y * x1); part += dpp_mov<0xB1>(part); part += dpp_mov<0x4E>(part); const float xt = f0p[12*F0P] - part; x3 = (p == 0) ? xt : x3; }
        { const f32x4 a0 = *(const LAS f32x4*)(f1p + 13*F1P + 0); float part = (a0.x * x0 + a0.z * x2) + (a0.y * x1 + a0.w * x3); part += dpp_mov<0xB1>(part); part += dpp_mov<0x4E>(part); const float xt = f0p[13*F0P] - part; x3 = (p == 1) ? xt : x3; }
        { const f32x4 a0 = *(const LAS f32x4*)(f1p + 14*F1P + 0); float part = (a0.x * x0 + a0.z * x2) + (a0.y * x1 + a0.w * x3); part += dpp_mov<0xB1>(part); part += dpp_mov<0x4E>(part); const float xt = f0p[14*F0P] - part; x3 = (p == 2) ? xt : x3; }
        { const f32x4 a0 = *(const LAS f32x4*)(f1p + 15*F1P + 0); float part = (a0.x * x0 + a0.z * x2) + (a0.y * x1 + a0.w * x3); part += dpp_mov<0xB1>(part); part += dpp_mov<0x4E>(part); const float xt = f0p[15*F0P] - part; x3 = (p == 3) ? xt : x3; }
        { const f32x4 a0 = *(const LAS f32x4*)(f1p + 16*F1P + 0); float part = (a0.x * x0 + a0.z * x2) + (a0.y * x1 + a0.w * x3); part += dpp_mov<0xB1>(part); part += dpp_mov<0x4E>(part); const float xt = f0p[16*F0P] - part; x4 = (p == 0) ? xt : x4; }
        { const f32x4 a0 = *(const LAS f32x4*)(f1p + 17*F1P + 0); const f32x4 a1 = *(const LAS f32x4*)(f1p + 17*F1P + 4); float part = (a0.x * x0 + a0.z * x2 + a1.x * x4) + (a0.y * x1 + a0.w * x3); part += dpp_mov<0xB1>(part); part += dpp_mov<0x4E>(part); const float xt = f0p[17*F0P] - part; x4 = (p == 1) ? xt : x4; }
        { const f32x4 a0 = *(const LAS f32x4*)(f1p + 18*F1P + 0); const f32x4 a1 = *(const LAS f32x4*)(f1p + 18*F1P + 4); float part = (a0.x * x0 + a0.z * x2 + a1.x * x4) + (a0.y * x1 + a0.w * x3); part += dpp_mov<0xB1>(part); part += dpp_mov<0x4E>(part); const float xt = f0p[18*F0P] - part; x4 = (p == 2) ? xt : x4; }
        { const f32x4 a0 = *(const LAS f32x4*)(f1p + 19*F1P + 0); const f32x4 a1 = *(const LAS f32x4*)(f1p + 19*F1P + 4); float part = (a0.x * x0 + a0.z * x2 + a1.x * x4) + (a0.y * x1 + a0.w * x3); part += dpp_mov<0xB1>(part); part += dpp_mov<0x4E>(part); const float xt = f0p[19*F0P] - part; x4 = (p == 3) ? xt : x4; }
        { const f32x4 a0 = *(const LAS f32x4*)(f1p + 20*F1P + 0); const f32x4 a1 = *(const LAS f32x4*)(f1p + 20*F1P + 4); float part = (a0.x * x0 + a0.z * x2 + a1.x * x4) + (a0.y * x1 + a0.w * x3); part += dpp_mov<0xB1>(part); part += dpp_mov<0x4E>(part); const float xt = f0p[20*F0P] - part; x5 = (p == 0) ? xt : x5; }
        { const f32x4 a0 = *(const LAS f32x4*)(f1p + 21*F1P + 0); const f32x4 a1 = *(const LAS f32x4*)(f1p + 21*F1P + 4); float part = (a0.x * x0 + a0.z * x2 + a1.x * x4) + (a0.y * x1 + a0.w * x3 + a1.y * x5); part += dpp_mov<0xB1>(part); part += dpp_mov<0x4E>(part); const float xt = f0p[21*F0P] - part; x5 = (p == 1) ? xt : x5; }
        { const f32x4 a0 = *(const LAS f32x4*)(f1p + 22*F1P + 0); const f32x4 a1 = *(const LAS f32x4*)(f1p + 22*F1P + 4); float part = (a0.x * x0 + a0.z * x2 + a1.x * x4) + (a0.y * x1 + a0.w * x3 + a1.y * x5); part += dpp_mov<0xB1>(part); part += dpp_mov<0x4E>(part); const float xt = f0p[22*F0P] - part; x5 = (p == 2) ? xt : x5; }
        { const f32x4 a0 = *(const LAS f32x4*)(f1p + 23*F1P + 0); const f32x4 a1 = *(const LAS f32x4*)(f1p + 23*F1P + 4); float part = (a0.x * x0 + a0.z * x2 + a1.x * x4) + (a0.y * x1 + a0.w * x3 + a1.y * x5); part += dpp_mov<0xB1>(part); part += dpp_mov<0x4E>(part); const float xt = f0p[23*F0P] - part; x5 = (p == 3) ? xt : x5; }
        { const f32x4 a0 = *(const LAS f32x4*)(f1p + 24*F1P + 0); const f32x4 a1 = *(const LAS f32x4*)(f1p + 24*F1P + 4); float part = (a0.x * x0 + a0.z * x2 + a1.x * x4) + (a0.y * x1 + a0.w * x3 + a1.y * x5); part += dpp_mov<0xB1>(part); part += dpp_mov<0x4E>(part); const float xt = f0p[24*F0P] - part; x6 = (p == 0) ? xt : x6; }
        { const f32x4 a0 = *(const LAS f32x4*)(f1p + 25*F1P + 0); const f32x4 a1 = *(const LAS f32x4*)(f1p + 25*F1P + 4); float part = (a0.x * x0 + a0.z * x2 + a1.x * x4 + a1.z * x6) + (a0.y * x1 + a0.w * x3 + a1.y * x5); part += dpp_mov<0xB1>(part); part += dpp_mov<0x4E>(part); const float xt = f0p[25*F0P] - part; x6 = (p == 1) ? xt : x6; }
        { const f32x4 a0 = *(const LAS f32x4*)(f1p + 26*F1P + 0); const f32x4 a1 = *(const LAS f32x4*)(f1p + 26*F1P + 4); float part = (a0.x * x0 + a0.z * x2 + a1.x * x4 + a1.z * x6) + (a0.y * x1 + a0.w * x3 + a1.y * x5); part += dpp_mov<0xB1>(part); part += dpp_mov<0x4E>(part); const float xt = f0p[26*F0P] - part; x6 = (p == 2) ? xt : x6; }
        { const f32x4 a0 = *(const LAS f32x4*)(f1p + 27*F1P + 0); const f32x4 a1 = *(const LAS f32x4*)(f1p + 27*F1P + 4); float part = (a0.x * x0 + a0.z * x2 + a1.x * x4 + a1.z * x6) + (a0.y * x1 + a0.w * x3 + a1.y * x5); part += dpp_mov<0xB1>(part); part += dpp_mov<0x4E>(part); const float xt = f0p[27*F0P] - part; x6 = (p == 3) ? xt : x6; }
        { const f32x4 a0 = *(const LAS f32x4*)(f1p + 28*F1P + 0); const f32x4 a1 = *(const LAS f32x4*)(f1p + 28*F1P + 4); float part = (a0.x * x0 + a0.z * x2 + a1.x * x4 + a1.z * x6) + (a0.y * x1 + a0.w * x3 + a1.y * x5); part += dpp_mov<0xB1>(part); part += dpp_mov<0x4E>(part); const float xt = f0p[28*F0P] - part; x7 = (p == 0) ? xt : x7; }
        { const f32x4 a0 = *(const LAS f32x4*)(f1p + 29*F1P + 0); const f32x4 a1 = *(const LAS f32x4*)(f1p + 29*F1P + 4); float part = (a0.x * x0 + a0.z * x2 + a1.x * x4 + a1.z * x6) + (a0.y * x1 + a0.w * x3 + a1.y * x5 + a1.w * x7); part += dpp_mov<0xB1>(part); part += dpp_mov<0x4E>(part); const float xt = f0p[29*F0P] - part; x7 = (p == 1) ? xt : x7; }
        { const f32x4 a0 = *(const LAS f32x4*)(f1p + 30*F1P + 0); const f32x4 a1 = *(const LAS f32x4*)(f1p + 30*F1P + 4); float part = (a0.x * x0 + a0.z * x2 + a1.x * x4 + a1.z * x6) + (a0.y * x1 + a0.w * x3 + a1.y * x5 + a1.w * x7); part += dpp_mov<0xB1>(part); part += dpp_mov<0x4E>(part); const float xt = f0p[30*F0P] - part; x7 = (p == 2) ? xt : x7; }
        { const f32x4 a0 = *(const LAS f32x4*)(f1p + 31*F1P + 0); const f32x4 a1 = *(const LAS f32x4*)(f1p + 31*F1P + 4); float part = (a0.x * x0 + a0.z * x2 + a1.x * x4 + a1.z * x6) + (a0.y * x1 + a0.w * x3 + a1.y * x5 + a1.w * x7); part += dpp_mov<0xB1>(part); part += dpp_mov<0x4E>(part); const float xt = f0p[31*F0P] - part; x7 = (p == 3) ? xt : x7; }
        { const f32x4 a0 = *(const LAS f32x4*)(f1p + 32*F1P + 0); const f32x4 a1 = *(const LAS f32x4*)(f1p + 32*F1P + 4); float part = (a0.x * x0 + a0.z * x2 + a1.x * x4 + a1.z * x6) + (a0.y * x1 + a0.w * x3 + a1.y * x5 + a1.w * x7); part += dpp_mov<0xB1>(part); part += dpp_mov<0x4E>(part); const float xt = f0p[32*F0P] - part; x8 = (p == 0) ? xt : x8; }
        { const f32x4 a0 = *(const LAS f32x4*)(f1p + 33*F1P + 0); const f32x4 a1 = *(const LAS f32x4*)(f1p + 33*F1P + 4); const f32x4 a2 = *(const LAS f32x4*)(f1p + 33*F1P + 8); float part = (a0.x * x0 + a0.z * x2 + a1.x * x4 + a1.z * x6 + a2.x * x8) + (a0.y * x1 + a0.w * x3 + a1.y * x5 + a1.w * x7); part += dpp_mov<0xB1>(part); part += dpp_mov<0x4E>(part); const float xt = f0p[33*F0P] - part; x8 = (p == 1) ? xt : x8; }
        { const f32x4 a0 = *(const LAS f32x4*)(f1p + 34*F1P + 0); const f32x4 a1 = *(const LAS f32x4*)(f1p + 34*F1P + 4); const f32x4 a2 = *(const LAS f32x4*)(f1p + 34*F1P + 8); float part = (a0.x * x0 + a0.z * x2 + a1.x * x4 + a1.z * x6 + a2.x * x8) + (a0.y * x1 + a0.w * x3 + a1.y * x5 + a1.w * x7); part += dpp_mov<0xB1>(part); part += dpp_mov<0x4E>(part); const float xt = f0p[34*F0P] - part; x8 = (p == 2) ? xt : x8; }
        { const f32x4 a0 = *(const LAS f32x4*)(f1p + 35*F1P + 0); const f32x4 a1 = *(const LAS f32x4*)(f1p + 35*F1P + 4); const f32x4 a2 = *(const LAS f32x4*)(f1p + 35*F1P + 8); float part = (a0.x * x0 + a0.z * x2 + a1.x * x4 + a1.z * x6 + a2.x * x8) + (a0.y * x1 + a0.w * x3 + a1.y * x5 + a1.w * x7); part += dpp_mov<0xB1>(part); part += dpp_mov<0x4E>(part); const float xt = f0p[35*F0P] - part; x8 = (p == 3) ? xt : x8; }
        { const f32x4 a0 = *(const LAS f32x4*)(f1p + 36*F1P + 0); const f32x4 a1 = *(const LAS f32x4*)(f1p + 36*F1P + 4); const f32x4 a2 = *(const LAS f32x4*)(f1p + 36*F1P + 8); float part = (a0.x * x0 + a0.z * x2 + a1.x * x4 + a1.z * x6 + a2.x * x8) + (a0.y * x1 + a0.w * x3 + a1.y * x5 + a1.w * x7); part += dpp_mov<0xB1>(part); part += dpp_mov<0x4E>(part); const float xt = f0p[36*F0P] - part; x9 = (p == 0) ? xt : x9; }
        { const f32x4 a0 = *(const LAS f32x4*)(f1p + 37*F1P + 0); const f32x4 a1 = *(const LAS f32x4*)(f1p + 37*F1P + 4); const f32x4 a2 = *(const LAS f32x4*)(f1p + 37*F1P + 8); float part = (a0.x * x0 + a0.z * x2 + a1.x * x4 + a1.z * x6 + a2.x * x8) + (a0.y * x1 + a0.w * x3 + a1.y * x5 + a1.w * x7 + a2.y * x9); part += dpp_mov<0xB1>(part); part += dpp_mov<0x4E>(part); const float xt = f0p[37*F0P] - part; x9 = (p == 1) ? xt : x9; }
        { const f32x4 a0 = *(const LAS f32x4*)(f1p + 38*F1P + 0); const f32x4 a1 = *(const LAS f32x4*)(f1p + 38*F1P + 4); const f32x4 a2 = *(const LAS f32x4*)(f1p + 38*F1P + 8); float part = (a0.x * x0 + a0.z * x2 + a1.x * x4 + a1.z * x6 + a2.x * x8) + (a0.y * x1 + a0.w * x3 + a1.y * x5 + a1.w * x7 + a2.y * x9); part += dpp_mov<0xB1>(part); part += dpp_mov<0x4E>(part); const float xt = f0p[38*F0P] - part; x9 = (p == 2) ? xt : x9; }
        { const f32x4 a0 = *(const LAS f32x4*)(f1p + 39*F1P + 0); const f32x4 a1 = *(const LAS f32x4*)(f1p + 39*F1P + 4); const f32x4 a2 = *(const LAS f32x4*)(f1p + 39*F1P + 8); float part = (a0.x * x0 + a0.z * x2 + a1.x * x4 + a1.z * x6 + a2.x * x8) + (a0.y * x1 + a0.w * x3 + a1.y * x5 + a1.w * x7 + a2.y * x9); part += dpp_mov<0xB1>(part); part += dpp_mov<0x4E>(part); const float xt = f0p[39*F0P] - part; x9 = (p == 3) ? xt : x9; }
        { const f32x4 a0 = *(const LAS f32x4*)(f1p + 40*F1P + 0); const f32x4 a1 = *(const LAS f32x4*)(f1p + 40*F1P + 4); const f32x4 a2 = *(const LAS f32x4*)(f1p + 40*F1P + 8); float part = (a0.x * x0 + a0.z * x2 + a1.x * x4 + a1.z * x6 + a2.x * x8) + (a0.y * x1 + a0.w * x3 + a1.y * x5 + a1.w * x7 + a2.y * x9); part += dpp_mov<0xB1>(part); part += dpp_mov<0x4E>(part); const float xt = f0p[40*F0P] - part; x10 = (p == 0) ? xt : x10; }
        { const f32x4 a0 = *(const LAS f32x4*)(f1p + 41*F1P + 0); const f32x4 a1 = *(const LAS f32x4*)(f1p + 41*F1P + 4); const f32x4 a2 = *(const LAS f32x4*)(f1p + 41*F1P + 8); float part = (a0.x * x0 + a0.z * x2 + a1.x * x4 + a1.z * x6 + a2.x * x8 + a2.z * x10) + (a0.y * x1 + a0.w * x3 + a1.y * x5 + a1.w * x7 + a2.y * x9); part += dpp_mov<0xB1>(part); part += dpp_mov<0x4E>(part); const float xt = f0p[41*F0P] - part; x10 = (p == 1) ? xt : x10; }
        { const f32x4 a0 = *(const LAS f32x4*)(f1p + 42*F1P + 0); const f32x4 a1 = *(const LAS f32x4*)(f1p + 42*F1P + 4); const f32x4 a2 = *(const LAS f32x4*)(f1p + 42*F1P + 8); float part = (a0.x * x0 + a0.z * x2 + a1.x * x4 + a1.z * x6 + a2.x * x8 + a2.z * x10) + (a0.y * x1 + a0.w * x3 + a1.y * x5 + a1.w * x7 + a2.y * x9); part += dpp_mov<0xB1>(part); part += dpp_mov<0x4E>(part); const float xt = f0p[42*F0P] - part; x10 = (p == 2) ? xt : x10; }
        { const f32x4 a0 = *(const LAS f32x4*)(f1p + 43*F1P + 0); const f32x4 a1 = *(const LAS f32x4*)(f1p + 43*F1P + 4); const f32x4 a2 = *(const LAS f32x4*)(f1p + 43*F1P + 8); float part = (a0.x * x0 + a0.z * x2 + a1.x * x4 + a1.z * x6 + a2.x * x8 + a2.z * x10) + (a0.y * x1 + a0.w * x3 + a1.y * x5 + a1.w * x7 + a2.y * x9); part += dpp_mov<0xB1>(part); part += dpp_mov<0x4E>(part); const float xt = f0p[43*F0P] - part; x10 = (p == 3) ? xt : x10; }
        { const f32x4 a0 = *(const LAS f32x4*)(f1p + 44*F1P + 0); const f32x4 a1 = *(const LAS f32x4*)(f1p + 44*F1P + 4); const f32x4 a2 = *(const LAS f32x4*)(f1p + 44*F1P + 8); float part = (a0.x * x0 + a0.z * x2 + a1.x * x4 + a1.z * x6 + a2.x * x8 + a2.z * x10) + (a0.y * x1 + a0.w * x3 + a1.y * x5 + a1.w * x7 + a2.y * x9); part += dpp_mov<0xB1>(part); part += dpp_mov<0x4E>(part); const float xt = f0p[44*F0P] - part; x11 = (p == 0) ? xt : x11; }
        { const f32x4 a0 = *(const LAS f32x4*)(f1p + 45*F1P + 0); const f32x4 a1 = *(const LAS f32x4*)(f1p + 45*F1P + 4); const f32x4 a2 = *(const LAS f32x4*)(f1p + 45*F1P + 8); float part = (a0.x * x0 + a0.z * x2 + a1.x * x4 + a1.z * x6 + a2.x * x8 + a2.z * x10) + (a0.y * x1 + a0.w * x3 + a1.y * x5 + a1.w * x7 + a2.y * x9 + a2.w * x11); part += dpp_mov<0xB1>(part); part += dpp_mov<0x4E>(part); const float xt = f0p[45*F0P] - part; x11 = (p == 1) ? xt : x11; }
        { const f32x4 a0 = *(const LAS f32x4*)(f1p + 46*F1P + 0); const f32x4 a1 = *(const LAS f32x4*)(f1p + 46*F1P + 4); const f32x4 a2 = *(const LAS f32x4*)(f1p + 46*F1P + 8); float part = (a0.x * x0 + a0.z * x2 + a1.x * x4 + a1.z * x6 + a2.x * x8 + a2.z * x10) + (a0.y * x1 + a0.w * x3 + a1.y * x5 + a1.w * x7 + a2.y * x9 + a2.w * x11); part += dpp_mov<0xB1>(part); part += dpp_mov<0x4E>(part); const float xt = f0p[46*F0P] - part; x11 = (p == 2) ? xt : x11; }
        { const f32x4 a0 = *(const LAS f32x4*)(f1p + 47*F1P + 0); const f32x4 a1 = *(const LAS f32x4*)(f1p + 47*F1P + 4); const f32x4 a2 = *(const LAS f32x4*)(f1p + 47*F1P + 8); float part = (a0.x * x0 + a0.z * x2 + a1.x * x4 + a1.z * x6 + a2.x * x8 + a2.z * x10) + (a0.y * x1 + a0.w * x3 + a1.y * x5 + a1.w * x7 + a2.y * x9 + a2.w * x11); part += dpp_mov<0xB1>(part); part += dpp_mov<0x4E>(part); const float xt = f0p[47*F0P] - part; x11 = (p == 3) ? xt : x11; }
        { const f32x4 a0 = *(const LAS f32x4*)(f1p + 48*F1P + 0); const f32x4 a1 = *(const LAS f32x4*)(f1p + 48*F1P + 4); const f32x4 a2 = *(const LAS f32x4*)(f1p + 48*F1P + 8); float part = (a0.x * x0 + a0.z * x2 + a1.x * x4 + a1.z * x6 + a2.x * x8 + a2.z * x10) + (a0.y * x1 + a0.w * x3 + a1.y * x5 + a1.w * x7 + a2.y * x9 + a2.w * x11); part += dpp_mov<0xB1>(part); part += dpp_mov<0x4E>(part); const float xt = f0p[48*F0P] - part; x12 = (p == 0) ? xt : x12; }
        { const f32x4 a0 = *(const LAS f32x4*)(f1p + 49*F1P + 0); const f32x4 a1 = *(const LAS f32x4*)(f1p + 49*F1P + 4); const f32x4 a2 = *(const LAS f32x4*)(f1p + 49*F1P + 8); const f32x4 a3 = *(const LAS f32x4*)(f1p + 49*F1P + 12); float part = (a0.x * x0 + a0.z * x2 + a1.x * x4 + a1.z * x6 + a2.x * x8 + a2.z * x10 + a3.x * x12) + (a0.y * x1 + a0.w * x3 + a1.y * x5 + a1.w * x7 + a2.y * x9 + a2.w * x11); part += dpp_mov<0xB1>(part); part += dpp_mov<0x4E>(part); const float xt = f0p[49*F0P] - part; x12 = (p == 1) ? xt : x12; }
        { const f32x4 a0 = *(const LAS f32x4*)(f1p + 50*F1P + 0); const f32x4 a1 = *(const LAS f32x4*)(f1p + 50*F1P + 4); const f32x4 a2 = *(const LAS f32x4*)(f1p + 50*F1P + 8); const f32x4 a3 = *(const LAS f32x4*)(f1p + 50*F1P + 12); float part = (a0.x * x0 + a0.z * x2 + a1.x * x4 + a1.z * x6 + a2.x * x8 + a2.z * x10 + a3.x * x12) + (a0.y * x1 + a0.w * x3 + a1.y * x5 + a1.w * x7 + a2.y * x9 + a2.w * x11); part += dpp_mov<0xB1>(part); part += dpp_mov<0x4E>(part); const float xt = f0p[50*F0P] - part; x12 = (p == 2) ? xt : x12; }
        { const f32x4 a0 = *(const LAS f32x4*)(f1p + 51*F1P + 0); const f32x4 a1 = *(const LAS f32x4*)(f1p + 51*F1P + 4); const f32x4 a2 = *(const LAS f32x4*)(f1p + 51*F1P + 8); const f32x4 a3 = *(const LAS f32x4*)(f1p + 51*F1P + 12); float part = (a0.x * x0 + a0.z * x2 + a1.x * x4 + a1.z * x6 + a2.x * x8 + a2.z * x10 + a3.x * x12) + (a0.y * x1 + a0.w * x3 + a1.y * x5 + a1.w * x7 + a2.y * x9 + a2.w * x11); part += dpp_mov<0xB1>(part); part += dpp_mov<0x4E>(part); const float xt = f0p[51*F0P] - part; x12 = (p == 3) ? xt : x12; }
        { const f32x4 a0 = *(const LAS f32x4*)(f1p + 52*F1P + 0); const f32x4 a1 = *(const LAS f32x4*)(f1p + 52*F1P + 4); const f32x4 a2 = *(const LAS f32x4*)(f1p + 52*F1P + 8); const f32x4 a3 = *(const LAS f32x4*)(f1p + 52*F1P + 12); float part = (a0.x * x0 + a0.z * x2 + a1.x * x4 + a1.z * x6 + a2.x * x8 + a2.z * x10 + a3.x * x12) + (a0.y * x1 + a0.w * x3 + a1.y * x5 + a1.w * x7 + a2.y * x9 + a2.w * x11); part += dpp_mov<0xB1>(part); part += dpp_mov<0x4E>(part); const float xt = f0p[52*F0P] - part; x13 = (p == 0) ? xt : x13; }
        { const f32x4 a0 = *(const LAS f32x4*)(f1p + 53*F1P + 0); const f32x4 a1 = *(const LAS f32x4*)(f1p + 53*F1P + 4); const f32x4 a2 = *(const LAS f32x4*)(f1p + 53*F1P + 8); const f32x4 a3 = *(const LAS f32x4*)(f1p + 53*F1P + 12); float part = (a0.x * x0 + a0.z * x2 + a1.x * x4 + a1.z * x6 + a2.x * x8 + a2.z * x10 + a3.x * x12) + (a0.y * x1 + a0.w * x3 + a1.y * x5 + a1.w * x7 + a2.y * x9 + a2.w * x11 + a3.y * x13); part += dpp_mov<0xB1>(part); part += dpp_mov<0x4E>(part); const float xt = f0p[53*F0P] - part; x13 = (p == 1) ? xt : x13; }
        { const f32x4 a0 = *(const LAS f32x4*)(f1p + 54*F1P + 0); const f32x4 a1 = *(const LAS f32x4*)(f1p + 54*F1P + 4); const f32x4 a2 = *(const LAS f32x4*)(f1p + 54*F1P + 8); const f32x4 a3 = *(const LAS f32x4*)(f1p + 54*F1P + 12); float part = (a0.x * x0 + a0.z * x2 + a1.x * x4 + a1.z * x6 + a2.x * x8 + a2.z * x10 + a3.x * x12) + (a0.y * x1 + a0.w * x3 + a1.y * x5 + a1.w * x7 + a2.y * x9 + a2.w * x11 + a3.y * x13); part += dpp_mov<0xB1>(part); part += dpp_mov<0x4E>(part); const float xt = f0p[54*F0P] - part; x13 = (p == 2) ? xt : x13; }
        { const f32x4 a0 = *(const LAS f32x4*)(f1p + 55*F1P + 0); const f32x4 a1 = *(const LAS f32x4*)(f1p + 55*F1P + 4); const f32x4 a2 = *(const LAS f32x4*)(f1p + 55*F1P + 8); const f32x4 a3 = *(const LAS f32x4*)(f1p + 55*F1P + 12); float part = (a0.x * x0 + a0.z * x2 + a1.x * x4 + a1.z * x6 + a2.x * x8 + a2.z * x10 + a3.x * x12) + (a0.y * x1 + a0.w * x3 + a1.y * x5 + a1.w * x7 + a2.y * x9 + a2.w * x11 + a3.y * x13); part += dpp_mov<0xB1>(part); part += dpp_mov<0x4E>(part); const float xt = f0p[55*F0P] - part; x13 = (p == 3) ? xt : x13; }
        { const f32x4 a0 = *(const LAS f32x4*)(f1p + 56*F1P + 0); const f32x4 a1 = *(const LAS f32x4*)(f1p + 56*F1P + 4); const f32x4 a2 = *(const LAS f32x4*)(f1p + 56*F1P + 8); const f32x4 a3 = *(const LAS f32x4*)(f1p + 56*F1P + 12); float part = (a0.x * x0 + a0.z * x2 + a1.x * x4 + a1.z * x6 + a2.x * x8 + a2.z * x10 + a3.x * x12) + (a0.y * x1 + a0.w * x3 + a1.y * x5 + a1.w * x7 + a2.y * x9 + a2.w * x11 + a3.y * x13); part += dpp_mov<0xB1>(part); part += dpp_mov<0x4E>(part); const float xt = f0p[56*F0P] - part; x14 = (p == 0) ? xt : x14; }
        { const f32x4 a0 = *(const LAS f32x4*)(f1p + 57*F1P + 0); const f32x4 a1 = *(const LAS f32x4*)(f1p + 57*F1P + 4); const f32x4 a2 = *(const LAS f32x4*)(f1p + 57*F1P + 8); const f32x4 a3 = *(const LAS f32x4*)(f1p + 57*F1P + 12); float part = (a0.x * x0 + a0.z * x2 + a1.x * x4 + a1.z * x6 + a2.x * x8 + a2.z * x10 + a3.x * x12 + a3.z * x14) + (a0.y * x1 + a0.w * x3 + a1.y * x5 + a1.w * x7 + a2.y * x9 + a2.w * x11 + a3.y * x13); part += dpp_mov<0xB1>(part); part += dpp_mov<0x4E>(part); const float xt = f0p[57*F0P] - part; x14 = (p == 1) ? xt : x14; }
        { const f32x4 a0 = *(const LAS f32x4*)(f1p + 58*F1P + 0); const f32x4 a1 = *(const LAS f32x4*)(f1p + 58*F1P + 4); const f32x4 a2 = *(const LAS f32x4*)(f1p + 58*F1P + 8); const f32x4 a3 = *(const LAS f32x4*)(f1p + 58*F1P + 12); float part = (a0.x * x0 + a0.z * x2 + a1.x * x4 + a1.z * x6 + a2.x * x8 + a2.z * x10 + a3.x * x12 + a3.z * x14) + (a0.y * x1 + a0.w * x3 + a1.y * x5 + a1.w * x7 + a2.y * x9 + a2.w * x11 + a3.y * x13); part += dpp_mov<0xB1>(part); part += dpp_mov<0x4E>(part); const float xt = f0p[58*F0P] - part; x14 = (p == 2) ? xt : x14; }
        { const f32x4 a0 = *(const LAS f32x4*)(f1p + 59*F1P + 0); const f32x4 a1 = *(const LAS f32x4*)(f1p + 59*F1P + 4); const f32x4 a2 = *(const LAS f32x4*)(f1p + 59*F1P + 8); const f32x4 a3 = *(const LAS f32x4*)(f1p + 59*F1P + 12); float part = (a0.x * x0 + a0.z * x2 + a1.x * x4 + a1.z * x6 + a2.x * x8 + a2.z * x10 + a3.x * x12 + a3.z * x14) + (a0.y * x1 + a0.w * x3 + a1.y * x5 + a1.w * x7 + a2.y * x9 + a2.w * x11 + a3.y * x13); part += dpp_mov<0xB1>(part); part += dpp_mov<0x4E>(part); const float xt = f0p[59*F0P] - part; x14 = (p == 3) ? xt : x14; }
        { const f32x4 a0 = *(const LAS f32x4*)(f1p + 60*F1P + 0); const f32x4 a1 = *(const LAS f32x4*)(f1p + 60*F1P + 4); const f32x4 a2 = *(const LAS f32x4*)(f1p + 60*F1P + 8); const f32x4 a3 = *(const LAS f32x4*)(f1p + 60*F1P + 12); float part = (a0.x * x0 + a0.z * x2 + a1.x * x4 + a1.z * x6 + a2.x * x8 + a2.z * x10 + a3.x * x12 + a3.z * x14) + (a0.y * x1 + a0.w * x3 + a1.y * x5 + a1.w * x7 + a2.y * x9 + a2.w * x11 + a3.y * x13); part += dpp_mov<0xB1>(part); part += dpp_mov<0x4E>(part); const float xt = f0p[60*F0P] - part; x15 = (p == 0) ? xt : x15; }
        { const f32x4 a0 = *(const LAS f32x4*)(f1p + 61*F1P + 0); const f32x4 a1 = *(const LAS f32x4*)(f1p + 61*F1P + 4); const f32x4 a2 = *(const LAS f32x4*)(f1p + 61*F1P + 8); const f32x4 a3 = *(const LAS f32x4*)(f1p + 61*F1P + 12); float part = (a0.x * x0 + a0.z * x2 + a1.x * x4 + a1.z * x6 + a2.x * x8 + a2.z * x10 + a3.x * x12 + a3.z * x14) + (a0.y * x1 + a0.w * x3 + a1.y * x5 + a1.w * x7 + a2.y * x9 + a2.w * x11 + a3.y * x13 + a3.w * x15); part += dpp_mov<0xB1>(part); part += dpp_mov<0x4E>(part); const float xt = f0p[61*F0P] - part; x15 = (p == 1) ? xt : x15; }
        { const f32x4 a0 = *(const LAS f32x4*)(f1p + 62*F1P + 0); const f32x4 a1 = *(const LAS f32x4*)(f1p + 62*F1P + 4); const f32x4 a2 = *(const LAS f32x4*)(f1p + 62*F1P + 8); const f32x4 a3 = *(const LAS f32x4*)(f1p + 62*F1P + 12); float part = (a0.x * x0 + a0.z * x2 + a1.x * x4 + a1.z * x6 + a2.x * x8 + a2.z * x10 + a3.x * x12 + a3.z * x14) + (a0.y * x1 + a0.w * x3 + a1.y * x5 + a1.w * x7 + a2.y * x9 + a2.w * x11 + a3.y * x13 + a3.w * x15); part += dpp_mov<0xB1>(part); part += dpp_mov<0x4E>(part); const float xt = f0p[62*F0P] - part; x15 = (p == 2) ? xt : x15; }
        { const f32x4 a0 = *(const LAS f32x4*)(f1p + 63*F1P + 0); const f32x4 a1 = *(const LAS f32x4*)(f1p + 63*F1P + 4); const f32x4 a2 = *(const LAS f32x4*)(f1p + 63*F1P + 8); const f32x4 a3 = *(const LAS f32x4*)(f1p + 63*F1P + 12); float part = (a0.x * x0 + a0.z * x2 + a1.x * x4 + a1.z * x6 + a2.x * x8 + a2.z * x10 + a3.x * x12 + a3.z * x14) + (a0.y * x1 + a0.w * x3 + a1.y * x5 + a1.w * x7 + a2.y * x9 + a2.w * x11 + a3.y * x13 + a3.w * x15); part += dpp_mov<0xB1>(part); part += dpp_mov<0x4E>(part); const float xt = f0p[63*F0P] - part; x15 = (p == 3) ? xt : x15; }
        LAS unsigned char* dst = (wave < 4 ? B3 : B0) + (j & 63) * BLD + p * 2;
        *(LAS unsigned short*)(dst + 0) = (unsigned short)f2bf(-x0);
        *(LAS unsigned short*)(dst + 8) = (unsigned short)f2bf(-x1);
        *(LAS unsigned short*)(dst + 16) = (unsigned short)f2bf(-x2);
        *(LAS unsigned short*)(dst + 24) = (unsigned short)f2bf(-x3);
        *(LAS unsigned short*)(dst + 32) = (unsigned short)f2bf(-x4);
        *(LAS unsigned short*)(dst + 40) = (unsigned short)f2bf(-x5);
        *(LAS unsigned short*)(dst + 48) = (unsigned short)f2bf(-x6);
        *(LAS unsigned short*)(dst + 56) = (unsigned short)f2bf(-x7);
        *(LAS unsigned short*)(dst + 64) = (unsigned short)f2bf(-x8);
        *(LAS unsigned short*)(dst + 72) = (unsigned short)f2bf(-x9);
        *(LAS unsigned short*)(dst + 80) = (unsigned short)f2bf(-x10);
        *(LAS unsigned short*)(dst + 88) = (unsigned short)f2bf(-x11);
        *(LAS unsigned short*)(dst + 96) = (unsigned short)f2bf(-x12);
        *(LAS unsigned short*)(dst + 104) = (unsigned short)f2bf(-x13);
        *(LAS unsigned short*)(dst + 112) = (unsigned short)f2bf(-x14);
        *(LAS unsigned short*)(dst + 120) = (unsigned short)f2bf(-x15);
    }
    LDS_BAR();
    {
        f32x4 rpT[2], yl[2] = {z4, z4}, gT[2], hl[2] = {z4, z4};
#pragma unroll
        for (int c = 0; c < 2; ++c) { const int colx = 16 * (cb0 + c) + lc; rpT[c] = *(const LAS f32x4*)(F2 + colx * 64 + 16 * rb + 4 * g);
#pragma unroll
            for (int rg = 0; rg < 4; ++rg) { const int row = 16 * rb + 4 * g + rg; gT[c][rg] = row == colx ? GC[row] : 0.f; } }
#pragma unroll
        for (int ks = 0; ks < 2; ++ks) { const bf16x8 fnp = ldfrag(B3, rb, ks, lane), farb = ldfrag(B1, rb, ks, lane), fark = ldfrag(B2, rb, ks, lane), fbb = ldfrag(B6, rb, ks, lane), fkb = ldfrag(B5, rb, ks, lane);
#pragma unroll
            for (int c = 0; c < 2; ++c) { const bf16x8 carb = ldfrag(B1, cb0 + c, ks, lane), cbb = ldfrag(B6, cb0 + c, ks, lane), fq = ldfrag(B0, cb0 + c, ks, lane), fv = ldfrag(B4, cb0 + c, ks, lane);
                rpT[c] = MFMA16(fnp, carb, rpT[c]);
                gT[c] = MFMA16(fnp, cbb, gT[c]);
                yl[c] = MFMA16(fark, fv, yl[c]); yl[c] = MFMA16(farb, fq, yl[c]);
                hl[c] = MFMA16(fkb, fv, hl[c]); hl[c] = MFMA16(fbb, fq, hl[c]); } }
        bf16* RPg = (bf16*)(ws + SC_RP) + (size_t)unit * 4096; float* YLg = (float*)(ws + SC_YL) + (size_t)unit * 4096; bf16* Gg_ = (bf16*)(ws + SC_G) + (size_t)unit * 4096; float* HLg = (float*)(ws + SC_HL) + (size_t)unit * 4096;
#pragma unroll
        for (int c = 0; c < 2; ++c) { const int o = (16 * (cb0 + c) + lc) * 64 + 16 * rb + 4 * g;
            *(u32x2*)(RPg + o) = (u32x2){pk2(rpT[c][0], rpT[c][1]), pk2(rpT[c][2], rpT[c][3])};
            *(u32x2*)(Gg_ + o) = (u32x2){pk2(gT[c][0], gT[c][1]), pk2(gT[c][2], gT[c][3])};
            *(f32x4*)(HLg + o) = hl[c];
            *(f32x4*)(YLg + ((rb * 4 + cb0 + c) * 64 + lane) * 4) = yl[c]; }
    }
    }
#undef SA_LOAD
}

template <int NSTEP> __device__ __forceinline__ void scanB_chain(int l, LAS unsigned char* lds, int ci0, int h, int vs, const float* init, float* outp_state, int tid, int wave) {
    unsigned char* ws = KWS();
    const int lane = tid & 63, half = wave >> 2, jr = wave & 3, g = lane >> 4, lc = lane & 15;
    LAS unsigned char* XH = lds + half * 16384;
    const bf16* Gall = (const bf16*)(ws + SC_G); const float* HLall = (const float*)(ws + SC_HL); bf16* S0all = (bf16*)(ws + SC_S0);
    float zf; asm volatile("v_mov_b32 %0, 0" : "=v"(zf));
    f32x4 acc = (f32x4){zf, zf, zf, zf};
    __syncthreads();
    if (init) acc = *(const f32x4*)(init + (16 * vs + lc) * 64 + 16 * jr + 4 * g);
    constexpr int PF = NSTEP >= 16 ? 8 : 1;
    bf16x8 GA[PF][2], GB[PF][2]; f32x4 LA[PF], LB[PF];
#define SB_ISSUE(Gx, Lx, slot, c) do { const size_t unit_ = (size_t)(ci0 + (c)) * 16 + h; const bf16* Gp = Gall + unit_ * 4096 + (16 * jr + lc) * 64 + 8 * g; const float* Lp = HLall + unit_ * 4096 + (16 * vs + lc) * 64 + 16 * jr + 4 * g; \
        Gx[slot][0] = *(const bf16x8*)Gp; Gx[slot][1] = *(const bf16x8*)(Gp + 32); Lx[slot] = *(const f32x4*)Lp; } while (0)
#define SB_STEP(Gx, Lx, slot, c) do { const size_t unit = (size_t)(ci0 + (c)) * 16 + h; LAS unsigned char* xb = XH + ((c) & 1) * 8192; \
        const unsigned h0 = pk2(acc.x, acc.y), h1 = pk2(acc.z, acc.w); \
        const float l0 = acc.x - __builtin_bit_cast(float, h0 << 16), l1 = acc.y - __builtin_bit_cast(float, h0 & 0xffff0000u), l2 = acc.z - __builtin_bit_cast(float, h1 << 16), l3 = acc.w - __builtin_bit_cast(float, h1 & 0xffff0000u); \
        *(LAS u32x2*)(xb + lc * BLD + (16 * jr + 4 * g) * 2) = (u32x2){h0, h1}; \
        *(LAS u32x2*)(xb + 4096 + lc * BLD + (16 * jr + 4 * g) * 2) = (u32x2){pk2(l0, l1), pk2(l2, l3)}; \
        *(u32x2*)(S0all + unit * 4096 + (16 * vs + lc) * 64 + 16 * jr + 4 * g) = (u32x2){h0, h1};              \
        asm volatile("s_waitcnt lgkmcnt(0)" ::: "memory"); __builtin_amdgcn_s_barrier(); asm volatile("" ::: "memory");     \
        f32x4 a2 = Lx[slot]; \
        _Pragma("unroll") for (int ks = 0; ks < 2; ++ks) { const bf16x8 bh = *(const LAS bf16x8*)(xb + lc * BLD + (32 * ks + 8 * g) * 2), bl = *(const LAS bf16x8*)(xb + 4096 + lc * BLD + (32 * ks + 8 * g) * 2); \
            a2 = MFMA16(Gx[slot][ks], bh, a2); a2 = MFMA16(Gx[slot][ks], bl, a2); } \
        acc = a2; } while (0)
    if constexpr (NSTEP < 16) {
        for (int c = 0; c < NSTEP; ++c) { SB_ISSUE(GA, LA, 0, c); SB_STEP(GA, LA, 0, c); }
    } else {
        static_assert(NSTEP < 16 || NSTEP % 16 == 0, "pass B group structure");
#pragma unroll
        for (int s = 0; s < PF; ++s) SB_ISSUE(GA, LA, s, s);
        for (int c0 = 0; c0 < NSTEP; c0 += 16) {
            SB_STEP(GA, LA, 0, c0);
#pragma unroll
            for (int s = 0; s < PF; ++s) SB_ISSUE(GB, LB, s, c0 + 8 + s);
#pragma unroll
            for (int s = 1; s < PF; ++s) SB_STEP(GA, LA, s, c0 + s);
            SB_STEP(GB, LB, 0, c0 + 8);
            if (c0 + 16 < NSTEP) {
#pragma unroll
                for (int s = 0; s < PF; ++s) SB_ISSUE(GA, LA, s, c0 + 16 + s); }
#pragma unroll
            for (int s = 1; s < PF; ++s) SB_STEP(GB, LB, s, c0 + 8 + s);
        }
    }
    *(f32x4*)(outp_state + (16 * vs + lc) * 64 + 16 * jr + 4 * g) = acc;
#undef SB_ISSUE
#undef SB_STEP
}

template <int NSTEP> __device__ __forceinline__ void scanB_idle() { __syncthreads(); for (int c = 0; c < NSTEP; ++c) { asm volatile("" ::: "memory"); __builtin_amdgcn_s_barrier(); asm volatile("" ::: "memory"); } }

__device__ __forceinline__ void scanC_all(int l, LAS unsigned char* lds, int bx, int G, int tid, int wave) {
    unsigned char* ws = KWS();
    const int lane = tid & 63, rb = wave >> 1, cb0 = (wave & 1) * 2, g = lane >> 4, lc = lane & 15, t0 = 8 * wave;
    const float* ssh = KIN(I_SSH); const float* mu = KIN(I_MU) + (size_t)l * SHIFT; const float* gngp = KIN(I_GNG) + (size_t)l * RW; const float* gnbp = KIN(I_GNB) + (size_t)l * RW;
    const float* P = (const float*)(ws + B_P); const float* Gg = (const float*)(ws + WS_RW + 2 * RWSZ); bf16* MIXB = (bf16*)(ws + B_MIX);
    LAS float* Yl = (LAS float*)lds;
    f32x4 acc[2]; bf16x8 fa[2], fb[2][2]; float pv_[8], gt_[8], bn_[8], q_v, mu_v, gng, gnb;
#define SC_LOAD(unit_) do { const int ci_ = (unit_) >> 4, cc_ = 64 * ((unit_) & 15) + lane; const int m0_ = ci_ < 256 ? 64 * ci_ : TP + 32 * (ci_ - 256), n_ = ci_ < 256 ? 64 : 32; \
        const bf16* RPg = (const bf16*)(ws + SC_RP) + (size_t)(unit_) * 4096; const float* YLg = (const float*)(ws + SC_YL) + (size_t)(unit_) * 4096; const bf16* S0g = (const bf16*)(ws + SC_S0) + (size_t)(unit_) * 4096; const float* bon_ = (const float*)(ws + SC_BON) + (size_t)(unit_) * 64; \
        _Pragma("unroll") for (int c = 0; c < 2; ++c) acc[c] = *(const f32x4*)(YLg + ((rb * 4 + cb0 + c) * 64 + lane) * 4); \
        _Pragma("unroll") for (int ks = 0; ks < 2; ++ks) { fa[ks] = *(const bf16x8*)(RPg + (16 * rb + lc) * 64 + 32 * ks + 8 * g); _Pragma("unroll") for (int c = 0; c < 2; ++c) fb[ks][c] = *(const bf16x8*)(S0g + (16 * (cb0 + c) + lc) * 64 + 32 * ks + 8 * g); } \
        mu_v = mu[2 * RW + cc_]; gng = gngp[cc_]; gnb = gnbp[cc_]; q_v = 0.f; \
        _Pragma("unroll") for (int i = 0; i < 8; ++i) { pv_[i] = 0.f; gt_[i] = 0.f; bn_[i] = 0.f; } \
        if (t0 < n_) { const float* pp_ = prev_row(ssh, l, P, m0_ + t0); if (pp_) q_v = pp_[2 * RW + cc_]; \
            _Pragma("unroll") for (int i = 0; i < 8; ++i) { const size_t m_ = (size_t)(m0_ + t0 + i); pv_[i] = P[m_ * PLD + 2 * RW + cc_]; gt_[i] = Gg[m_ * RW + cc_]; bn_[i] = bon_[t0 + i]; } } } while (0)
    if (bx < NUNIT) SC_LOAD(bx);
    for (int unit = bx; unit < NUNIT; unit += G) {
        const int ci = unit >> 4, cc = 64 * (unit & 15) + lane; const int m0 = ci < 256 ? 64 * ci : TP + 32 * (ci - 256), n = ci < 256 ? 64 : 32;
        f32x4 y2[2] = {acc[0], acc[1]};
#pragma unroll
        for (int ks = 0; ks < 2; ++ks)
#pragma unroll
            for (int c = 0; c < 2; ++c) y2[c] = MFMA16(fa[ks], fb[ks][c], y2[c]);
        LDS_BAR();
#pragma unroll
        for (int c = 0; c < 2; ++c)
#pragma unroll
            for (int rg = 0; rg < 4; ++rg) Yl[(16 * rb + 4 * g + rg) * 65 + 16 * (cb0 + c) + lc] = y2[c][rg];
        LDS_BAR();
        unsigned short ov[8];
        if (t0 < n) {
            float qv = q_v;
#pragma unroll
            for (int i = 0; i < 8; ++i) { const int t = t0 + i;
                const float y = Yl[t * 65 + lane]; const float ym = wave_sum(y) * (1.f / HN); const float d = y - ym; const float yv = wave_sum(d * d) * (1.f / HN);
                const float yn = d * (1.f / sqrtf(yv + GN_EPS)) * gng + gnb;
                const float p_v = pv_[i]; const float vx = p_v + (qv - p_v) * mu_v; qv = p_v;
                ov[i] = (unsigned short)f2bf((yn + bn_[i] * vx) * gt_[i]); }
        }
        if (unit + G < NUNIT) SC_LOAD(unit + G);
        if (t0 < n) {
#pragma unroll
            for (int i = 0; i < 8; ++i) MIXB[(size_t)(m0 + t0 + i) * DM + cc] = (bf16)ov[i];
        }
    }
#undef SC_LOAD
}

template <int PH> __global__ void __launch_bounds__(NTHR, 2) mk_fwd(Args a) {
    extern __shared__ __attribute__((aligned(16))) unsigned char lds_raw[];
    LAS unsigned char* lds = (LAS unsigned char*)lds_raw;
    const int wave_s = __builtin_amdgcn_readfirstlane((int)threadIdx.x >> 6);
    for (int u = threadIdx.x; u < (LDS_BYTES - LDSCTL_OFF) / 4; u += NTHR) ((LAS unsigned*)(lds + LDSCTL_OFF))[u] = 0u;
    __syncthreads();
    if (PH < 0) (void)xcd_barrier_post((unsigned*)KWS() + CW_BAR, (volatile LAS unsigned*)(lds + MISC_OFF) + 8, (int)threadIdx.x);
#define IN(k) (PH < 0 || PH == (k))
#define PHASE_IDS() int tid_; asm volatile("v_mbcnt_lo_u32_b32 %0, -1, 0\n\tv_mbcnt_hi_u32_b32 %0, -1, %0\n\tv_lshl_add_u32 %0, %1, 6, %0" : "=&v"(tid_) : "s"(wave_s)); const int tid = tid_, lane = tid & 63, wave = wave_s; \
    const int G = gridDim.x, bx = blockIdx.x, vcu = (G % 8 == 0) ? (bx % 8) * (G / 8) + bx / 8 : bx, gw = vcu * NWAVES + wave, NGW = G * NWAVES; unsigned char* ws = KWS(); (void)tid; (void)lane; (void)gw; (void)NGW; (void)ws
#define SEAM() do { if (PH < 0) { XcdBarrier bar_; bar_.bar = (unsigned*)KWS() + CW_BAR; bar_.x = xb_xcc_id(); bar_.st = (volatile LAS unsigned*)(lds + MISC_OFF) + 8; xcd_barrier(bar_, tid); } } while (0)

    for (int l = a.l_lo; l < a.l_hi; ++l) {
        if (IN(0)) { PHASE_IDS(); phase_convert(l, lds, wave, lane, gw, NGW); SEAM(); }
        if (IN(1)) { PHASE_IDS(); pg8::Gemm g{(const bf16*)(ws + WS_XB), (const bf16*)(ws + W_1), M, 2 * FF, DM, DM}; pg8::StaticOrder S; S.init(M, 2 * FF, G, bx); pg8::EpiSwiGLU E{(bf16*)(ws + B_H), FF};
            pg8::gemm_phase<pg8::EpiSwiGLU, pg8::StaticOrder, true, true>(lds + RING_OFF, g, S, E, tid); SEAM(); }
        if (IN(2)) { PHASE_IDS();
            { pg8::Gemm g{(const bf16*)(ws + B_H), (const bf16*)(ws + W_2), TP, DM, FF, FF}; pg8::StaticOrder S; S.init(TP, DM, G, bx); pg8::EpiResid E{(const bf16*)(ws + WS_XB), (float*)(ws + WS_Z), DM, ALPHA, 0.5f};
              pg8::gemm_phase<pg8::EpiResid, pg8::StaticOrder, true, true>(lds + RING_OFF, g, S, E, tid); }
            { pg8::Gemm g{(const bf16*)(ws + B_H), (const bf16*)(ws + W_2), M, DM, FF, 512}; pg8::SplitOrder S{G, bx, 11, 512}; pg8::EpiSlab E{(float*)(ws + WS_SLAB), 512};
              pg8::gemm_phase<pg8::EpiSlab, pg8::SplitOrder, false, true>(lds + RING_OFF, g, S, E, tid); }
            SEAM(); }
        if (IN(3)) { PHASE_IDS(); phase_ln((const float*)(ws + WS_Z), (const float*)(ws + WS_X), (const float*)(ws + WS_SLAB), 11, ALPHA, 0.5f, KIN(I_LNG) + (size_t)l * 3 * DM, KIN(I_LNB) + (size_t)l * 3 * DM, (float*)(ws + WS_X), (bf16*)(ws + WS_XB), false, lane, gw, NGW); SEAM(); }
        if (IN(4)) { PHASE_IDS(); pg8::Gemm g{(const bf16*)(ws + WS_XB), (const bf16*)(ws + W_3), M, N3, DM, DM}; pg8::StaticOrder S; S.init(M, N3, G, bx); pg8::EpiP E{(float*)(ws + B_P), (bf16*)(ws + B_U), (float*)(ws + B_GV)};
            pg8::gemm_phase<pg8::EpiP, pg8::StaticOrder, true, true>(lds + RING_OFF, g, S, E, tid); SEAM(); }
        if (IN(5)) { PHASE_IDS(); phase_prep1(l, lane, gw, NGW); SEAM(); }
        if (IN(6)) { PHASE_IDS(); pg8::Gemm g{(const bf16*)(ws + B_A3B), (const bf16*)(ws + W_3B), M, NL, LK, LK}; pg8::StaticOrder S; S.init(M, NL, G, bx);
            pg8::EpiLora E{(float*)(ws + WS_RW)};
            pg8::gemm_phase<pg8::EpiLora, pg8::StaticOrder, false, false>(lds + RING_OFF, g, S, E, tid); SEAM(); }
        if (IN(7)) { PHASE_IDS(); scanA_all(l, lds, bx, G, tid, wave); SEAM(); }
        if (IN(8)) { PHASE_IDS();
            if (bx < 64) { const int hh = bx >> 2; if (wave < 4) scanB_chain<256>(l, lds, 0, hh, bx & 3, nullptr, KOUT() + O_SP + ((size_t)l * NH + hh) * 4096, tid, wave); else scanB_idle<256>(); }
            else { const float* srw = KIN(I_SRW); float* outp = KOUT();
                for (int p = bx - 64; p < 512; p += G - 64) { const int task = 2 * p + (wave >> 2), b = task >> 6, hh = (task >> 2) & 15; const size_t so = (((size_t)l * NSB + b) * NH + hh) * 4096;
                    scanB_chain<1>(l, lds, 256 + b, hh, task & 3, srw + so, outp + O_SS + so, tid, wave); }
                for (int u = bx - 64; u < 144 * 8; u += G - 64) gmlp_unit(l, lds, u, tid, wave); }
            SEAM(); }
        if (IN(9)) { PHASE_IDS(); scanC_all(l, lds, bx, G, tid, wave); SEAM(); }
        if (IN(10)) { PHASE_IDS();
            { pg8::Gemm g{(const bf16*)(ws + B_MIX), (const bf16*)(ws + W_4), TP, DM, DM, DM}; pg8::StaticOrder S; S.init(TP, DM, G, bx); pg8::EpiResid E{(const bf16*)(ws + WS_XB), (float*)(ws + WS_Z), DM, ALPHA, 1.0f};
              pg8::gemm_phase<pg8::EpiResid, pg8::StaticOrder, true, true>(lds + RING_OFF, g, S, E, tid); }
            { pg8::Gemm g{(const bf16*)(ws + B_MIX), (const bf16*)(ws + W_4), M, DM, DM, 256}; pg8::SplitOrder S{G, bx, 8, 256}; pg8::EpiSlab E{(float*)(ws + WS_SLAB), 256};
              pg8::gemm_phase<pg8::EpiSlab, pg8::SplitOrder, false, true>(lds + RING_OFF, g, S, E, tid); }
            SEAM(); }
        if (IN(11)) { PHASE_IDS(); phase_ln((const float*)(ws + WS_Z), (const float*)(ws + WS_X), (const float*)(ws + WS_SLAB), 8, ALPHA, 1.0f, KIN(I_LNG) + (size_t)(l * 3 + 1) * DM, KIN(I_LNB) + (size_t)(l * 3 + 1) * DM, (float*)(ws + WS_X), (bf16*)(ws + WS_XB), false, lane, gw, NGW); SEAM(); }
        if (IN(12)) { PHASE_IDS(); pg8::Gemm g{(const bf16*)(ws + WS_XB), (const bf16*)(ws + W_5), M, 2 * FF, DM, DM}; pg8::StaticOrder S; S.init(M, 2 * FF, G, bx); pg8::EpiSwiGLU E{(bf16*)(ws + B_H), FF};
            pg8::gemm_phase<pg8::EpiSwiGLU, pg8::StaticOrder, true, true>(lds + RING_OFF, g, S, E, tid); SEAM(); }
        if (IN(13)) { PHASE_IDS();
            { pg8::Gemm g{(const bf16*)(ws + B_H), (const bf16*)(ws + W_6), TP, DM, FF, FF}; pg8::StaticOrder S; S.init(TP, DM, G, bx); pg8::EpiResid E{(const bf16*)(ws + WS_XB), (float*)(ws + WS_Z), DM, ALPHA, 0.5f};
              pg8::gemm_phase<pg8::EpiResid, pg8::StaticOrder, true, true>(lds + RING_OFF, g, S, E, tid); }
            { pg8::Gemm g{(const bf16*)(ws + B_H), (const bf16*)(ws + W_6), M, DM, FF, 512}; pg8::SplitOrder S{G, bx, 11, 512}; pg8::EpiSlab E{(float*)(ws + WS_SLAB), 512};
              pg8::gemm_phase<pg8::EpiSlab, pg8::SplitOrder, false, true>(lds + RING_OFF, g, S, E, tid); }
            SEAM(); }
        if (IN(14)) { PHASE_IDS(); const bool last = (l == DEPTH - 1);
            phase_ln((const float*)(ws + WS_Z), (const float*)(ws + WS_X), (const float*)(ws + WS_SLAB), 11, ALPHA, 0.5f, KIN(I_LNG) + (size_t)(l * 3 + 2) * DM, KIN(I_LNB) + (size_t)(l * 3 + 2) * DM, last ? KOUT() + O_YP : (float*)(ws + WS_X), last ? (bf16*)nullptr : (bf16*)(ws + WS_XB), last, lane, gw, NGW);
            if (!last) SEAM(); }
    }
#undef IN
#undef SEAM
#undef PHASE_IDS
}

template <int PH> static bool prep_kernel() { return hipFuncSetAttribute((const void*)mk_fwd<PH>, hipFuncAttributeMaxDynamicSharedMemorySize, LDS_BYTES) == hipSuccess; }
template <int PH> static void launch_phase(int grid, hipStream_t stream, Args a) { hipLaunchKernelGGL(mk_fwd<PH>, dim3(grid), dim3(NTHR), LDS_BYTES, stream, a); }
extern "C" void kernel_launch(void* const* d_in, const int* in_sizes, int n_in, void* d_out, int out_size, void* d_ws, size_t ws_size, hipStream_t stream) {
    static int grid = 0;
    if (grid == 0) {
        if (n_in != 29 || (size_t)out_size != O_END || ws_size < WS_END) { fprintf(stderr, "kernel_launch: unexpected shapes: n_in %d out %d ws %zu (need %zu)\n", n_in, out_size, ws_size, (size_t)WS_END); grid = -1; return; }
        int dev = 0, cus = 0, per_cu = 0;
        if (hipGetDevice(&dev) != hipSuccess || hipDeviceGetAttribute(&cus, hipDeviceAttributeMultiprocessorCount, dev) != hipSuccess) { grid = -1; return; }
        bool ok = true;
#if MK_ONE_LAUNCH
        ok = prep_kernel<-1>();
        if (hipOccupancyMaxActiveBlocksPerMultiprocessor(&per_cu, (const void*)mk_fwd<-1>, NTHR, LDS_BYTES) != hipSuccess || per_cu < 1) fprintf(stderr, "kernel_launch: occupancy query says %d\n", per_cu);
#else
        ok = prep_kernel<0>() && prep_kernel<1>() && prep_kernel<2>() && prep_kernel<3>() && prep_kernel<4>() && prep_kernel<5>() && prep_kernel<6>() && prep_kernel<7>() && prep_kernel<8>() && prep_kernel<9>() && prep_kernel<10>() && prep_kernel<11>() && prep_kernel<12>() && prep_kernel<13>() && prep_kernel<14>();
#endif
        if (!ok) { fprintf(stderr, "kernel_launch: hipFuncSetAttribute failed\n"); grid = -1; return; }
        (void)hipGetLastError();
        grid = cus;
        if (grid < 64) { grid = -1; return; }
    }
    if (grid < 0) return;
    (void)hipMemsetAsync((char*)d_ws + WS_CTL, 0, CTL_ZERO_BYTES, stream);
    Args a{};
    for (int i = 0; i < 29; ++i) a.in[i] = (const float*)d_in[i];
    a.out = (float*)d_out; a.ws = (unsigned char*)d_ws;
#if MK_ONE_LAUNCH
    a.l_lo = 0; a.l_hi = DEPTH;
    launch_phase<-1>(grid, stream, a);
#else
    for (int l = 0; l < DEPTH; ++l) { a.l_lo = l; a.l_hi = l + 1;
        launch_phase<0>(grid, stream, a); launch_phase<1>(grid, stream, a); launch_phase<2>(grid, stream, a); launch_phase<3>(grid, stream, a); launch_phase<4>(grid, stream, a);
        launch_phase<5>(grid, stream, a); launch_phase<6>(grid, stream, a); launch_phase<7>(grid, stream, a); launch_phase<8>(grid, stream, a); launch_phase<9>(grid, stream, a);
        launch_phase<10>(grid, stream, a); launch_phase<11>(grid, stream, a); launch_phase<12>(grid, stream, a); launch_phase<13>(grid, stream, a); launch_phase<14>(grid, stream, a); }
#endif
}
```

```cpp
#include <hip/hip_runtime.h>
#include <cstdio>
#include <cstdint>
#define MK_ONE_LAUNCH 1
namespace pg8 {
#define PG8_LAS __attribute__((address_space(3)))
typedef unsigned short bf16_t;
typedef short bf16x8 __attribute__((ext_vector_type(8)));
typedef float f32x4 __attribute__((ext_vector_type(4)));
typedef unsigned u32x4 __attribute__((ext_vector_type(4)));
constexpr int BM = 256, BK = 64, HALF = 128, HTB = HALF * BK * 2  , STAGE_BYTES = 8 * HTB, NXCD = 8, WGM = 8;

__host__ __device__ __forceinline__ int lds_byte(int r, int c) { const int st = (r >> 4) * 2 + (c >> 5), rr = r & 15, cc = c & 31, ob = rr * 64 + cc * 2; return st * 1024 + (ob ^ (((ob >> 9) & 1) << 5)); }
__host__ __device__ __forceinline__ void stage_rc(int b, int& R, int& C) { const int st = b / 1024, sb = b % 1024, swz = sb ^ (((sb >> 9) & 1) << 5); R = (st >> 1) * 16 + swz / 64; C = (st & 1) * 32 + (swz % 64) / 2; }
__host__ __device__ __forceinline__ int perm32(int rho) { const int n = rho >> 4, i = rho & 15; return 8 * (i >> 2) + 4 * n + (i & 3); }

struct Unit { int pm, pn, k0; };
struct Gemm { const bf16_t* A; const bf16_t* Bt; int M, N, K, Kl; };

struct StaticOrder {
    int nM, nN, nwg, G, c;
    __host__ __device__ void init(int M, int N, int G_, int c_) { nM = M / BM; nN = N / BM; nwg = nM * nN; G = G_; c = c_; }
    __host__ __device__ bool next(int i, Unit& u) const {
        const long L = (long)i * G + c; if (L >= nwg) return false;
        int wgid = (int)L; { const int q = nwg / NXCD, r = nwg % NXCD, xcd = wgid % NXCD, off = wgid / NXCD; wgid = (xcd < r ? xcd * (q + 1) : r * (q + 1) + (xcd - r) * q) + off; }
        const int nig = WGM * nN, gid = wgid / nig, fm = gid * WGM, gsz = (nM - fm) < WGM ? (nM - fm) : WGM;
        u.pm = fm + ((wgid % nig) % gsz); u.pn = (wgid % nig) / gsz; u.k0 = 0; return true;
    }
    __device__ __forceinline__ void a_ready(const Unit&) const {}
    __device__ __forceinline__ void done(const Unit&) const {}
};
struct SplitOrder {
    int G, c, KS, Kl;
    __host__ __device__ bool next(int i, Unit& u) const { const int L = i * G + c; if (L >= 16 * KS) return false; const int ks = L >> 4, tile = L & 15; u.pm = 64 + (tile >> 3); u.pn = tile & 7; u.k0 = ks * Kl; return true; }
    __device__ __forceinline__ void a_ready(const Unit&) const {}
    __device__ __forceinline__ void done(const Unit&) const {}
};
__device__ __forceinline__ unsigned cvt_pk_bf16(float lo, float hi) { unsigned r; asm volatile("v_cvt_pk_bf16_f32 %0, %1, %2" : "=v"(r) : "v"(lo), "v"(hi)); return r; }
typedef float f32x2 __attribute__((ext_vector_type(2)));
__device__ __forceinline__ f32x2 gelu_pk(f32x2 v) {
    const f32x2 av = __builtin_elementwise_abs(v), d = av * 0.2316418882f + 1.0f;
    f32x2 t; t.x = __builtin_amdgcn_rcpf(d.x); t.y = __builtin_amdgcn_rcpf(d.y);
    f32x2 q = t * 0.5307027145f + (-0.7265760135f); q = q * t + 0.7107068705f; q = q * t + (-0.142248368f); q = q * t + 0.127414796f; q = q * t;
    const f32x2 s = (v * v) * (-0.72134752044f);
    f32x2 e; e.x = __builtin_amdgcn_exp2f(s.x); e.y = __builtin_amdgcn_exp2f(s.y);
    const f32x2 m = v * (q * e), r = v - m;
    f32x2 o; o.x = v.x < 0.f ? m.x : r.x; o.y = v.y < 0.f ? m.y : r.y; return o;
}

typedef unsigned u32x2 __attribute__((ext_vector_type(2)));
__device__ __forceinline__ float silu_f(float g) { return g * __builtin_amdgcn_rcpf(1.0f + __expf(-g)); }
struct EpiSwiGLU {
    static constexpr bool PERM = true, AFTER_DRAIN = false;
    bf16_t* O; int ldc;
    __device__ __forceinline__ void operator()(const f32x4 (&acc)[2][2][4][2], const Unit& u, int wr, int wc, int fr, int fq) const {
        const int row0 = u.pm * BM + wr * 64 + fr, col0 = u.pn * HALF + wc * 32 + 8 * fq;
#pragma unroll
        for (int ai = 0; ai < 2; ++ai)
#pragma unroll
            for (int m = 0; m < 4; ++m) { bf16_t* rowp = O + (size_t)(row0 + ai * HALF + m * 16) * ldc + col0;
                const f32x4 g0 = acc[ai][0][m][0], g1 = acc[ai][0][m][1], u0 = acc[ai][1][m][0], u1 = acc[ai][1][m][1];
                u32x4 w; w.x = cvt_pk_bf16(silu_f(g0[0]) * u0[0], silu_f(g0[1]) * u0[1]); w.y = cvt_pk_bf16(silu_f(g0[2]) * u0[2], silu_f(g0[3]) * u0[3]);
                w.z = cvt_pk_bf16(silu_f(g1[0]) * u1[0], silu_f(g1[1]) * u1[1]); w.w = cvt_pk_bf16(silu_f(g1[2]) * u1[2], silu_f(g1[3]) * u1[3]);
                *(u32x4*)rowp = w; }
    }
};
struct EpiSwiGLU8 {
    static constexpr bool PERM = true, AFTER_DRAIN = false;
    unsigned char* O; int ldc;
    __device__ __forceinline__ void operator()(const f32x4 (&acc)[2][2][4][2], const Unit& u, int wr, int wc, int fr, int fq) const {
        const int row0 = u.pm * BM + wr * 64 + fr, col0 = u.pn * HALF + wc * 32 + 8 * fq;
#pragma unroll
        for (int ai = 0; ai < 2; ++ai)
#pragma unroll
            for (int m = 0; m < 4; ++m) { unsigned char* rowp = O + (size_t)(row0 + ai * HALF + m * 16) * ldc + col0;
                const f32x4 g0 = acc[ai][0][m][0], g1 = acc[ai][0][m][1], u0 = acc[ai][1][m][0] * 4.0f, u1 = acc[ai][1][m][1] * 4.0f;
                unsigned w0 = 0u, w1 = 0u;
                w0 = __builtin_amdgcn_cvt_pk_fp8_f32(silu_f(g0[0]) * u0[0], silu_f(g0[1]) * u0[1], w0, false); w0 = __builtin_amdgcn_cvt_pk_fp8_f32(silu_f(g0[2]) * u0[2], silu_f(g0[3]) * u0[3], w0, true);
                w1 = __builtin_amdgcn_cvt_pk_fp8_f32(silu_f(g1[0]) * u1[0], silu_f(g1[1]) * u1[1], w1, false); w1 = __builtin_amdgcn_cvt_pk_fp8_f32(silu_f(g1[2]) * u1[2], silu_f(g1[3]) * u1[3], w1, true);
                *(u32x2*)rowp = (u32x2){w0, w1}; }
    }
};
struct EpiResid {
    static constexpr bool PERM = false, AFTER_DRAIN = false;
    const bf16_t* base; float* out; int ldc; float sa, sb;
    __device__ __forceinline__ void operator()(const f32x4 (&acc)[2][2][4][2], const Unit& u, int wr, int wc, int fr, int fq) const {
        const int row0 = u.pm * BM + wr * 64 + fr, col0 = u.pn * BM + wc * 32 + 4 * fq;
#pragma unroll
        for (int ai = 0; ai < 2; ++ai)
#pragma unroll
            for (int m = 0; m < 4; ++m) { const size_t off = (size_t)(row0 + ai * HALF + m * 16) * ldc + col0;
#pragma unroll
                for (int bj = 0; bj < 2; ++bj)
#pragma unroll
                    for (int n = 0; n < 2; ++n) { const u32x2 bb = *(const u32x2*)(base + off + bj * HALF + n * 16);
                        const f32x4 b = (f32x4){__builtin_bit_cast(float, bb.x << 16), __builtin_bit_cast(float, bb.x & 0xffff0000u), __builtin_bit_cast(float, bb.y << 16), __builtin_bit_cast(float, bb.y & 0xffff0000u)};
                        *(f32x4*)(out + off + bj * HALF + n * 16) = b * sa + acc[ai][bj][m][n] * sb; } }
    }
};
struct EpiSlab {
    static constexpr bool PERM = false, AFTER_DRAIN = false;
    float* slab; int Kl;
    __device__ __forceinline__ void operator()(const f32x4 (&acc)[2][2][4][2], const Unit& u, int wr, int wc, int fr, int fq) const {
        const int row0 = (u.pm - 64) * BM + wr * 64 + fr, col0 = u.pn * BM + wc * 32 + 4 * fq; float* O = slab + (size_t)(u.k0 / Kl) * (512 * 2048);
#pragma unroll
        for (int ai = 0; ai < 2; ++ai)
#pragma unroll
            for (int m = 0; m < 4; ++m) { float* rowp = O + (size_t)(row0 + ai * HALF + m * 16) * 2048 + col0;
#pragma unroll
                for (int bj = 0; bj < 2; ++bj)
#pragma unroll
                    for (int n = 0; n < 2; ++n) *(f32x4*)(rowp + bj * HALF + n * 16) = acc[ai][bj][m][n]; }
    }
};
struct EpiP {
    static constexpr bool PERM = false, AFTER_DRAIN = false;
    float* P; bf16_t* U; float* GV;
    __device__ __forceinline__ void operator()(const f32x4 (&acc)[2][2][4][2], const Unit& u, int wr, int wc, int fr, int fq) const {
        const int row0 = u.pm * BM + wr * 64 + fr, cw = wc * 32 + 4 * fq;
        const int kind = u.pn < 14 ? 0 : (u.pn < 18 ? 1 : 2);
        float* F = kind == 0 ? P + u.pn * BM + cw : GV + (u.pn - 18) * BM + cw; const int ldf = kind == 0 ? 3584 : 1024;
        bf16_t* Ub = U + (u.pn - 14) * BM + cw;
#pragma unroll
        for (int ai = 0; ai < 2; ++ai)
#pragma unroll
            for (int m = 0; m < 4; ++m) { const size_t row = (size_t)(row0 + ai * HALF + m * 16);
#pragma unroll
                for (int bj = 0; bj < 2; ++bj)
#pragma unroll
                    for (int n = 0; n < 2; ++n) { f32x4 v = acc[ai][bj][m][n];
                        if (kind != 0) { const f32x2 a = gelu_pk((f32x2){v[0], v[1]}), b = gelu_pk((f32x2){v[2], v[3]}); v = (f32x4){a.x, a.y, b.x, b.y}; }
                        if (kind == 1) { u32x2 w; w.x = cvt_pk_bf16(v[0], v[1]); w.y = cvt_pk_bf16(v[2], v[3]); *(u32x2*)(Ub + row * 1024 + bj * HALF + n * 16) = w; }
                        else *(f32x4*)(F + row * ldf + bj * HALF + n * 16) = v; }
                asm volatile("" ::: "memory"); }
    }
};
struct EpiLora {
    static constexpr bool PERM = false, AFTER_DRAIN = false;
    float* base;
    __device__ __forceinline__ void operator()(const f32x4 (&acc)[2][2][4][2], const Unit& u, int wr, int wc, int fr, int fq) const {
        const int row0 = u.pm * BM + wr * 64 + fr, kind = u.pn >> 2, cb = (u.pn & 3) * BM + wc * 32 + 4 * fq;
        float* O = base + (size_t)kind * ((size_t)66 << 18) + cb;
#pragma unroll
        for (int ai = 0; ai < 2; ++ai)
#pragma unroll
            for (int m = 0; m < 4; ++m) { float* rowp = O + (size_t)(row0 + ai * HALF + m * 16) * 1024;
#pragma unroll
                for (int bj = 0; bj < 2; ++bj)
#pragma unroll
                    for (int n = 0; n < 2; ++n) *(f32x4*)(rowp + bj * HALF + n * 16) = acc[ai][bj][m][n]; }
    }
};
typedef int pg8_v4i __attribute__((ext_vector_type(4))); typedef int pg8_v8i __attribute__((ext_vector_type(8)));
__device__ __forceinline__ pg8_v8i cat8(bf16x8 a, bf16x8 b) { const pg8_v4i x = __builtin_bit_cast(pg8_v4i, a), y = __builtin_bit_cast(pg8_v4i, b); return __builtin_shufflevector(x, y, 0, 1, 2, 3, 4, 5, 6, 7); }
template <class Epi, class Sched, bool ALIGN_EPI = false, bool SP2 = false, int F8 = 0>
__device__ __forceinline__ void gemm_phase(PG8_LAS unsigned char* lds, const Gemm g, const Sched& S, const Epi& E, int tid_in) {
    int tid_ = tid_in; asm volatile("" : "+v"(tid_));
    const int tid = tid_, wid = __builtin_amdgcn_readfirstlane(tid >> 6), lane = tid & 63, wr = wid >> 2, wc = wid & 3, fr = lane & 15, fq = lane >> 4;
    constexpr int ES = F8 ? 1 : 2;
    const int K = g.K, nt = g.Kl / (F8 ? 2 * BK : BK);
    unsigned voffA[2], voffB[2];
#pragma unroll
    for (int i = 0; i < 2; ++i) { int R, C; stage_rc(tid * 16 + i * 8192, R, C); const int Rb = Epi::PERM ? ((R & ~31) + perm32(R & 31)) : R;
        voffA[i] = (unsigned)(R * K * ES + C * 2); voffB[i] = (unsigned)(Rb * K * ES + C * 2); }
    const size_t kstep = (size_t)(BK * 2);
    const size_t hstep = (size_t)HALF * K * ES;
    const size_t tstep = 2 * hstep;
    const unsigned ldsw = (unsigned)wid * 1024u;
    const int aoff = lds_byte(wr * 64 + fr, fq * 8), boff = lds_byte(wc * 32 + fr, fq * 8);
#define PG8_SA(b, h) (((b) * 2 + (h)) * HTB)
#define PG8_SB(b, h) ((4 + (b) * 2 + (h)) * HTB)
#define PG8_STAGE(bufoff, gbase, voff) do { _Pragma("unroll") for (int _i = 0; _i < 2; ++_i) \
        __builtin_amdgcn_global_load_lds((const unsigned*)((const char*)(gbase) + (voff)[_i]), (PG8_LAS unsigned*)(lds + (bufoff) + ldsw + _i * 8192), 16, 0, 0); } while (0)
#define PG8_LDA(dst, b, h) do { _Pragma("unroll") for (int m = 0; m < 4; ++m) { if constexpr (F8 != 0) dst##_F[m] = cat8(*(const PG8_LAS bf16x8*)(lds + PG8_SA(b, h) + aoff + m * 2048), *(const PG8_LAS bf16x8*)(lds + PG8_SA(b, h) + aoff + m * 2048 + 1024)); \
        else { _Pragma("unroll") for (int k = 0; k < 2; ++k) dst[m][k] = *(const PG8_LAS bf16x8*)(lds + PG8_SA(b, h) + aoff + m * 2048 + k * 1024); } } } while (0)
#define PG8_LDB(dst, b, h) do { _Pragma("unroll") for (int n = 0; n < 2; ++n) { if constexpr (F8 != 0) dst##_F[n] = cat8(*(const PG8_LAS bf16x8*)(lds + PG8_SB(b, h) + boff + n * 2048), *(const PG8_LAS bf16x8*)(lds + PG8_SB(b, h) + boff + n * 2048 + 1024)); \
        else { _Pragma("unroll") for (int k = 0; k < 2; ++k) dst[n][k] = *(const PG8_LAS bf16x8*)(lds + PG8_SB(b, h) + boff + n * 2048 + k * 1024); } } } while (0)
#define PG8_MMA(ai, bj, At, Bt) do { __builtin_amdgcn_s_setprio(1); _Pragma("unroll") for (int m = 0; m < 4; ++m) _Pragma("unroll") for (int n = 0; n < 2; ++n) { \
        if constexpr (F8 != 0) asm volatile("v_mfma_scale_f32_16x16x128_f8f6f4 %0, %1, %2, %0, %3, %4 op_sel_hi:[0,0,0]" : "+v"(acc[ai][bj][m][n]) : "v"(Bt##_F[n]), "v"(At##_F[m]), "v"(sc_w), "v"(sc_a)); \
        else { _Pragma("unroll") for (int k = 0; k < 2; ++k) acc[ai][bj][m][n] = __builtin_amdgcn_mfma_f32_16x16x32_bf16(Bt[n][k], At[m][k], acc[ai][bj][m][n], 0, 0, 0); } } __builtin_amdgcn_s_setprio(0); } while (0)
#define PG8_WAIT_V(n) asm volatile("s_waitcnt vmcnt(" #n ")" ::: "memory")
#define PG8_WAIT_L(n) asm volatile("s_waitcnt lgkmcnt(" #n ")" ::: "memory")
#define PG8_BAR __builtin_amdgcn_s_barrier()
#define PG8_SCHED __builtin_amdgcn_sched_barrier(0)
    Unit cur, nxt; int ui = 0;
    if (!S.next(0, cur)) return;
    f32x4 acc[2][2][4][2];
    float zz0; asm volatile("v_mov_b32 %0, 0" : "=v"(zz0));
    const int sc_w = (F8 >> 8) * 0x01010101, sc_a = (F8 & 255) * 0x01010101; (void)sc_w; (void)sc_a;
#pragma unroll
    for (int a = 0; a < 2; ++a)
#pragma unroll
        for (int b = 0; b < 2; ++b)
#pragma unroll
            for (int m = 0; m < 4; ++m)
#pragma unroll
                for (int n = 0; n < 2; ++n) acc[a][b][m][n] = (f32x4){zz0, zz0, zz0, zz0};
    bf16x8 At[4][2], B0[2][2], B1[2][2]; pg8_v8i At8[4], B08[2], B18[2];
#define At_F At8
#define B0_F B08
#define B1_F B18
    const char* cA = (const char*)g.A + (size_t)cur.pm * tstep + (size_t)cur.k0 * ES; const char* cB = (const char*)g.Bt + (size_t)cur.pn * tstep + (size_t)cur.k0 * ES;
    S.a_ready(cur);
    if constexpr (SP2) {
        PG8_STAGE(PG8_SB(0, 0), cB, voffB); PG8_STAGE(PG8_SB(0, 1), cB + hstep, voffB); PG8_STAGE(PG8_SA(0, 0), cA, voffA); PG8_STAGE(PG8_SA(0, 1), cA + hstep, voffA);
        if (wr == 1) PG8_BAR;
        PG8_WAIT_V(2); PG8_BAR;
        PG8_STAGE(PG8_SB(1, 0), cB + kstep, voffB); PG8_STAGE(PG8_SA(1, 0), cA + kstep, voffA); PG8_STAGE(PG8_SB(1, 1), cB + hstep + kstep, voffB);
        PG8_WAIT_V(6); PG8_BAR;
    } else {
        PG8_STAGE(PG8_SB(0, 0), cB, voffB); PG8_STAGE(PG8_SA(0, 0), cA, voffA); PG8_STAGE(PG8_SB(0, 1), cB + hstep, voffB); PG8_STAGE(PG8_SA(0, 1), cA + hstep, voffA);
        if (wr == 1) PG8_BAR;
        PG8_WAIT_V(4); PG8_BAR;
        PG8_STAGE(PG8_SB(1, 0), cB + kstep, voffB); PG8_STAGE(PG8_SA(1, 0), cA + kstep, voffA); PG8_STAGE(PG8_SB(1, 1), cB + hstep + kstep, voffB);
        PG8_WAIT_V(6); PG8_BAR;
    }
    for (;;) {
        const bool has_next = S.next(ui + 1, nxt);
        const char* nA = has_next ? (const char*)g.A + (size_t)nxt.pm * tstep + (size_t)nxt.k0 * ES : cA; const char* nB = has_next ? (const char*)g.Bt + (size_t)nxt.pn * tstep + (size_t)nxt.k0 * ES : cB;
        for (int t = 0; t < nt; t += 2) {
            const bool last = (t == nt - 2);
            const char* a1 = cA + (size_t)(t + 1) * kstep;
            const char* a2 = last ? nA : cA + (size_t)(t + 2) * kstep; const char* b2 = last ? nB : cB + (size_t)(t + 2) * kstep;
            const char* a3 = a2 + kstep; const char* b3 = b2 + kstep;
            if (last && has_next) S.a_ready(nxt);
            if constexpr (SP2) {
            PG8_LDB(B0, 0, 0); PG8_LDB(B1, 0, 1); PG8_SCHED; PG8_LDA(At, 0, 0); PG8_STAGE(PG8_SA(1, 1), a1 + hstep, voffA);
            PG8_WAIT_V(8); PG8_WAIT_L(0); PG8_BAR; PG8_MMA(0, 0, At, B0); PG8_MMA(0, 1, At, B1); PG8_BAR; PG8_SCHED;
            PG8_LDA(At, 0, 1); PG8_STAGE(PG8_SB(0, 0), b2, voffB); PG8_STAGE(PG8_SB(0, 1), b2 + hstep, voffB); PG8_STAGE(PG8_SA(0, 0), a2, voffA);
            PG8_WAIT_V(8); PG8_WAIT_L(0); PG8_BAR; PG8_MMA(1, 0, At, B0); PG8_MMA(1, 1, At, B1); PG8_BAR; PG8_SCHED;
            PG8_LDB(B0, 1, 0); PG8_LDB(B1, 1, 1); PG8_SCHED; PG8_LDA(At, 1, 0); PG8_STAGE(PG8_SA(0, 1), a2 + hstep, voffA);
            PG8_WAIT_V(8); PG8_WAIT_L(0); PG8_BAR; PG8_MMA(0, 0, At, B0); PG8_MMA(0, 1, At, B1); PG8_BAR; PG8_SCHED;
            PG8_LDA(At, 1, 1); PG8_STAGE(PG8_SB(1, 0), b3, voffB); PG8_STAGE(PG8_SB(1, 1), b3 + hstep, voffB); PG8_STAGE(PG8_SA(1, 0), a3, voffA);
            PG8_WAIT_V(8); PG8_WAIT_L(0); PG8_BAR; PG8_MMA(1, 0, At, B0); PG8_MMA(1, 1, At, B1); PG8_BAR; PG8_SCHED;
            } else {
            PG8_LDB(B0, 0, 0); PG8_SCHED; PG8_LDA(At, 0, 0); PG8_STAGE(PG8_SA(1, 1), a1 + hstep, voffA);
            PG8_WAIT_L(8); PG8_BAR; PG8_WAIT_L(0); PG8_MMA(0, 0, At, B0); PG8_BAR; PG8_SCHED;
            PG8_LDB(B1, 0, 1); PG8_STAGE(PG8_SB(0, 0), b2, voffB);
            PG8_BAR; PG8_WAIT_L(0); PG8_MMA(0, 1, At, B1); PG8_BAR;
            PG8_LDA(At, 0, 1); PG8_STAGE(PG8_SA(0, 0), a2, voffA);
            PG8_BAR; PG8_WAIT_L(0); PG8_MMA(1, 0, At, B0); PG8_BAR; PG8_SCHED;
            PG8_STAGE(PG8_SB(0, 1), b2 + hstep, voffB);
            PG8_WAIT_V(6); PG8_BAR; PG8_MMA(1, 1, At, B1); PG8_BAR;
            PG8_LDB(B0, 1, 0); PG8_SCHED; PG8_LDA(At, 1, 0); PG8_STAGE(PG8_SA(0, 1), a2 + hstep, voffA);
            PG8_WAIT_L(8); PG8_BAR; PG8_WAIT_L(0); PG8_MMA(0, 0, At, B0); PG8_BAR; PG8_SCHED;
            PG8_LDB(B1, 1, 1); PG8_STAGE(PG8_SB(1, 0), b3, voffB);
            PG8_BAR; PG8_WAIT_L(0); PG8_MMA(0, 1, At, B1); PG8_BAR;
            PG8_LDA(At, 1, 1); PG8_STAGE(PG8_SA(1, 0), a3, voffA);
            PG8_BAR; PG8_WAIT_L(0); PG8_MMA(1, 0, At, B0); PG8_BAR; PG8_SCHED;
            PG8_STAGE(PG8_SB(1, 1), b3 + hstep, voffB);
            PG8_WAIT_V(6); PG8_BAR; PG8_MMA(1, 1, At, B1); PG8_BAR;
            }
        }
        if constexpr (F8 != 0) { asm volatile("s_nop 15\n\ts_nop 15\n\ts_nop 15\n\ts_nop 15" ::: "memory"); }
        if constexpr (ALIGN_EPI) { if (wr == 0) PG8_BAR; }
        if constexpr (!Epi::AFTER_DRAIN) { int l2_ = tid; asm volatile("" : "+v"(l2_));
            E(acc, cur, wr, wc, l2_ & 15, (l2_ & 63) >> 4); S.done(cur); }
        if (!has_next) break;
{ float zz1; asm volatile("v_mov_b32 %0, 0" : "=v"(zz1));
#pragma unroll
        for (int a = 0; a < 2; ++a)
#pragma unroll
            for (int b = 0; b < 2; ++b)
#pragma unroll
                for (int m = 0; m < 4; ++m)
#pragma unroll
                    for (int n = 0; n < 2; ++n) acc[a][b][m][n] = (f32x4){zz1, zz1, zz1, zz1}; }
        cur = nxt; cA = nA; cB = nB; ++ui;
        if constexpr (ALIGN_EPI) { if (wr == 1) PG8_BAR; }
    }
    PG8_WAIT_V(0);
    if constexpr (!ALIGN_EPI) { if (wr == 0) PG8_BAR; }
    PG8_BAR;
    if constexpr (Epi::AFTER_DRAIN) { E.fused(acc, cur, wr, wc, fr, fq, lds, wid, lane); S.done(cur); }
#undef PG8_SA
#undef PG8_SB
#undef PG8_STAGE
#undef PG8_LDA
#undef PG8_LDB
#undef PG8_MMA
#undef PG8_WAIT_V
#undef PG8_WAIT_L
#undef PG8_BAR
#undef PG8_SCHED
#undef At_F
#undef B0_F
#undef B1_F
}
}
#define GAS __attribute__((address_space(1)))
#define LAS __attribute__((address_space(3)))
typedef unsigned short bf16;
typedef unsigned v4u __attribute__((ext_vector_type(4)));
typedef float f32x4 __attribute__((ext_vector_type(4)));
typedef short bf16x8 __attribute__((ext_vector_type(8)));
typedef GAS unsigned gu32;
typedef GAS unsigned long long gu64;
#define RLX_AGENT __ATOMIC_RELAXED, __HIP_MEMORY_SCOPE_AGENT
#define LDS_WAIT() asm volatile("s_waitcnt lgkmcnt(0)" ::: "memory")
#define VM_WAIT() asm volatile("s_waitcnt vmcnt(0)" ::: "memory")
__device__ __forceinline__ unsigned long long rt() { return __builtin_amdgcn_s_memrealtime(); }
typedef float f32x2_t __attribute__((ext_vector_type(2))); typedef __bf16 bf16x2_t __attribute__((ext_vector_type(2)));
__device__ __forceinline__ unsigned pk2(float lo, float hi) { const bf16x2_t b = __builtin_convertvector((f32x2_t){lo, hi}, bf16x2_t); return __builtin_bit_cast(unsigned, b); }
__device__ __forceinline__ unsigned f2bf(float f) { return pk2(f, 0.f) & 0xffffu; }
#define XB_TMO      128
#define XB_XCNT(j)  (256  + 64 * (j))
#define XB_XSUB(j)  (1280 + 64 * (j))
#define XB_XGEN(j)  (2304 + 64 * (j))
#define XB_TOP      3328
#define XB_TOPGEN   3392
#define XCD_BAR_WORDS 3456
#define XB_SPIN_CAP (1u << 18)

__device__ __forceinline__ unsigned xb_ld(unsigned* p)              { return __hip_atomic_load(p, __ATOMIC_RELAXED, __HIP_MEMORY_SCOPE_AGENT); }
__device__ __forceinline__ unsigned xb_add(unsigned* p, unsigned v) { return __hip_atomic_fetch_add(p, v, __ATOMIC_RELAXED, __HIP_MEMORY_SCOPE_AGENT); }
__device__ __forceinline__ unsigned xb_xcc_id() { return (unsigned)__builtin_amdgcn_s_getreg((3 << 11) | 20) & 0xFu; }
#define XB_SPIN(cond, bar) do { unsigned _sp = 0; while (cond) { __builtin_amdgcn_s_sleep(1); \
    if ((++_sp & 255u) == 0u) { if (xb_ld(&(bar)[XB_TMO])) break; if (_sp > XB_SPIN_CAP) { atomicAdd(&(bar)[XB_TMO], 1u); break; } } } } while (0)

struct XcdBarrier {
    unsigned* bar; unsigned x;
    volatile LAS unsigned* st;
};

__device__ __forceinline__ XcdBarrier xcd_barrier_post(unsigned* bar, volatile LAS unsigned* st, int tid) {
    XcdBarrier b; b.bar = bar; b.x = xb_xcc_id(); b.st = st;
    if (tid == 0) (void)xb_add(&bar[XB_XCNT(b.x)], 1u);
    return b;
}
__device__ __forceinline__ void xcd_barrier_complete(unsigned* bar, unsigned x, unsigned& nloc, unsigned& nx) {
    const unsigned G = gridDim.x * gridDim.y * gridDim.z;
    unsigned sum, cnt, mine, sp = 0u;
    for (;;) {
        sum = 0u; cnt = 0u; mine = 0u;
#pragma unroll
        for (unsigned j = 0; j < 16; ++j) { const unsigned c = xb_ld(&bar[XB_XCNT(j)]); sum += c; cnt += (c > 0u) ? 1u : 0u; mine = (j == x) ? c : mine; }
        if (sum == G) break;
        __builtin_amdgcn_s_sleep(1);
        if ((++sp & 255u) == 0u) { if (xb_ld(&bar[XB_TMO])) break; if (sp > XB_SPIN_CAP) { atomicAdd(&bar[XB_TMO], 1u); break; } }
    }
    nloc = mine > 0u ? mine : 1u; nx = cnt > 0u ? cnt : 1u;
}

__device__ __forceinline__ void xcd_barrier(const XcdBarrier& b, int tid) {
    asm volatile("s_waitcnt vmcnt(0)" ::: "memory");
    __syncthreads();
    if (tid == 0) {
        unsigned* bar = b.bar;
        __builtin_amdgcn_s_waitcnt(0);
        unsigned nloc = b.st[0], nx = b.st[1];
        if (nloc == 0u) { xcd_barrier_complete(bar, b.x, nloc, nx); b.st[0] = nloc; b.st[1] = nx; }
        const unsigned old = xb_add(&bar[XB_XSUB(b.x)], 1u);
        const unsigned gen = old / nloc;
        if (old + 1u == (gen + 1u) * nloc) {
            __builtin_amdgcn_fence(__ATOMIC_RELEASE, "agent");
            asm volatile("s_waitcnt vmcnt(0)" ::: "memory");
            const unsigned og = xb_add(&bar[XB_TOP], 1u);
            const unsigned tg = og / nx;
            if (og + 1u == (tg + 1u) * nx) xb_add(&bar[XB_TOPGEN], 1u);
            else XB_SPIN(xb_ld(&bar[XB_TOPGEN]) == tg, bar);
            __builtin_amdgcn_fence(__ATOMIC_ACQUIRE, "agent");
            xb_add(&bar[XB_XGEN(b.x)], 1u);
            asm volatile("s_waitcnt vmcnt(0)" ::: "memory");
        } else {
            XB_SPIN(xb_ld(&bar[XB_XGEN(b.x)]) == gen, bar);
            __builtin_amdgcn_fence(__ATOMIC_ACQUIRE, "agent");
            asm volatile("s_waitcnt vmcnt(0)" ::: "memory");
        }
    }
    __syncthreads();
}

constexpr int NWAVES = 8, NTHR = 512;
constexpr int DM = 2048, FF = 5632, DEPTH = 4;
constexpr int TP = 16384, NSB = 16, TS = 32, M = TP + NSB * TS;
constexpr int RW = 1024, NH = 16, HN = 64, GMW = 1024, GH = 8, GHD = 128;
constexpr int C_W = 3072, C_A = 3136, C_G = 3200, SHIFT = 3360, INC = 5408;
constexpr int PLD = 3584;
constexpr int N3 = 5632;
constexpr int LK = 384;
constexpr int NL = 3072;
constexpr float ALPHA = 1.6817928305074292f;
constexpr float LN_EPS = 1e-5f, GN_EPS = 64e-5f;
constexpr int NPHASE = 15;

constexpr size_t O_YP = 0, O_SP = 34603008, O_SHP = 34865152, O_SS = 34878592, O_SHS = 39072896, O_GV = 39287936, O_END = 41385088;

constexpr size_t MiB = 1u << 20;
constexpr size_t WS_CTL = 0, CTL_ZERO_BYTES = 1 * MiB;
constexpr size_t WS_X = 1 * MiB;
constexpr size_t WS_Z = 133 * MiB;
constexpr size_t WS_XB = 265 * MiB;
constexpr size_t WS_W = 331 * MiB;
constexpr size_t W_1 = WS_W, W_2 = W_1 + 44 * MiB, W_3 = W_2 + 22 * MiB, W_4 = W_3 + 22 * MiB, W_5 = W_4 + 8 * MiB, W_6 = W_5 + 44 * MiB, W_3B = W_6 + 22 * MiB;
constexpr size_t W_1B = 1367 * MiB, W_2B = 1411 * MiB, W_4B = 1433 * MiB;
constexpr size_t W_5B = 67 * MiB, W_3BB = 111 * MiB;
constexpr size_t W_3B2 = 1277 * MiB, W_6B = 1299 * MiB;
constexpr size_t WS_TOP = 1441 * MiB;
__host__ __device__ constexpr size_t wofs(int i, int par) {
    return i == 1 ? (par ? W_1B : W_1) : i == 2 ? (par ? W_2B : W_2) : i == 3 ? (par ? W_3B2 : W_3) : i == 4 ? (par ? W_4B : W_4) : i == 5 ? (par ? W_5B : W_5) : i == 6 ? (par ? W_6B : W_6) : (par ? W_3BB : W_3B); }
constexpr size_t WS_BIG = 496 * MiB;
constexpr size_t B_XB8 = WS_BIG + 96 * MiB;
constexpr size_t B_H = WS_BIG, B_P = WS_BIG, B_U = WS_BIG + 231 * MiB, B_GV = B_U + 33 * MiB, B_A3B = B_GV + 66 * MiB;
constexpr size_t B_MIX = WS_X;
constexpr size_t WS_RW = 839 * MiB;
constexpr size_t RWSZ = 66 * MiB;
constexpr size_t WS_END = WS_RW + 8 * RWSZ;
static_assert(W_3B + (size_t)NL * LK * 2 <= WS_BIG && B_A3B + (size_t)M * LK * 2 <= WS_RW, "ws map");
static_assert(B_MIX + (size_t)M * DM * 2 <= WS_X + (size_t)TP * DM * 4, "MIXB under the sample rows of X");
static_assert((size_t)M * DM * 4 == 132 * MiB && (size_t)M * PLD * 4 == 231 * MiB && (size_t)M * 1024 * 4 == 66 * MiB, "ws sizes");
constexpr int CW_TMO = 0, CW_CODE = 1, CW_BAR = 4096;

constexpr int RING_OFF = 0, RING_BYTES = 135168;
constexpr int LDSCTL_OFF = RING_BYTES, MISC_OFF = LDSCTL_OFF + 320;
constexpr int LDS_BYTES = 147456;

struct Args { const float* in[29]; float* out; unsigned char* ws; int l_lo, l_hi; };
#define KOUT() ((float*)karg_ptr<232>())
#define KWS() ((unsigned char*)karg_ptr<240>())
enum InIdx { I_XP = 0, I_XS, I_SRW, I_SSH, I_F1G, I_F1U, I_F1D, I_WIN, I_MU, I_W0, I_WUP, I_A0, I_AUP, I_GUP, I_KK, I_KA, I_RK, I_GNG, I_GNB, I_GLG, I_GLB, I_GWS, I_GBS, I_WOUT, I_F2G, I_F2U, I_F2D, I_LNG, I_LNB };


template <int OFF> __device__ __forceinline__ const float* karg_ptr() {
    const unsigned long long kp = (unsigned long long)__builtin_amdgcn_kernarg_segment_ptr(); unsigned long long v;
    asm volatile("s_load_dwordx2 %0, %1, %2\n\ts_waitcnt lgkmcnt(0)" : "=s"(v) : "s"(kp), "i"(OFF) : "memory");
    return (const float*)(const GAS float*)v;
}
#define KIN(i) karg_ptr<8 * (i)>()
template <int CTRL> __device__ __forceinline__ float dpp_mov(float x) { return __builtin_bit_cast(float, __builtin_amdgcn_mov_dpp(__builtin_bit_cast(int, x), CTRL, 0xf, 0xf, true)); }
__device__ __forceinline__ float row16_sum(float x) { x += dpp_mov<0x128>(x); x += dpp_mov<0x124>(x); x += dpp_mov<0x122>(x); x += dpp_mov<0x121>(x); return x; }
__device__ __forceinline__ float wave_sum(float v) {
    v = row16_sum(v); const int i = __builtin_bit_cast(int, v);
    const float a = __builtin_bit_cast(float, __builtin_amdgcn_readlane(i, 0)), b = __builtin_bit_cast(float, __builtin_amdgcn_readlane(i, 16)), c = __builtin_bit_cast(float, __builtin_amdgcn_readlane(i, 32)), d = __builtin_bit_cast(float, __builtin_amdgcn_readlane(i, 48));
    return (a + b) + (c + d);
}

template <int MAP> __device__ __forceinline__ void cvt_task(const float* __restrict__ W, int K, int N, bf16* __restrict__ WT, int nb, int k0, int lane) {
    const int n = nb * 256 + 4 * lane; if (n >= N) return;
    const int drow = MAP == 0 ? n : (MAP == 3 ? (n < SHIFT ? n : n + (PLD - SHIFT)) : 256 * (n >> 7) + (n & 127) + (MAP == 2 ? 128 : 0));
    const float* src = W + (size_t)k0 * N + n; bf16* dst = WT + (size_t)drow * K + k0;
#pragma unroll
    for (int kk = 0; kk < 32; kk += 16) { f32x4 v[16];
#pragma unroll
        for (int j = 0; j < 16; ++j) v[j] = *(const f32x4*)(src + (size_t)(kk + j) * N);
#pragma unroll
        for (int i = 0; i < 4; ++i)
#pragma unroll
            for (int hh = 0; hh < 2; ++hh) { v4u o; o.x = pk2(v[8 * hh + 0][i], v[8 * hh + 1][i]); o.y = pk2(v[8 * hh + 2][i], v[8 * hh + 3][i]); o.z = pk2(v[8 * hh + 4][i], v[8 * hh + 5][i]); o.w = pk2(v[8 * hh + 6][i], v[8 * hh + 7][i]);
                *(v4u*)(dst + (size_t)i * K + kk + 8 * hh) = o; } }
}

template <int MAP> __device__ __forceinline__ void cvt_task8(const float* __restrict__ W, int K, int N, unsigned char* __restrict__ WT, int nb, int k0, int lane) {
    const int n = nb * 256 + 4 * lane; if (n >= N) return;
    const int drow = MAP == 0 ? n : 256 * (n >> 7) + (n & 127) + (MAP == 2 ? 128 : 0);
    const float* src = W + (size_t)k0 * N + n; unsigned char* dst = WT + (size_t)drow * K + k0;
#pragma unroll
    for (int kk = 0; kk < 32; kk += 16) { f32x4 v[16];
#pragma unroll
        for (int j = 0; j < 16; ++j) v[j] = *(const f32x4*)(src + (size_t)(kk + j) * N) * 64.0f;
#pragma unroll
        for (int i = 0; i < 4; ++i) { v4u o;
#pragma unroll
            for (int q = 0; q < 4; ++q) { unsigned w = 0u; w = __builtin_amdgcn_cvt_pk_fp8_f32(v[4 * q][i], v[4 * q + 1][i], w, false); w = __builtin_amdgcn_cvt_pk_fp8_f32(v[4 * q + 2][i], v[4 * q + 3][i], w, true); o[q] = w; }
            *(v4u*)(dst + (size_t)i * K + kk) = o; } }
}

constexpr int CV_T_GU = (FF / 256) * (DM / 32), CV_T_D = (DM / 256) * (FF / 32), CV_T_IN = ((INC + 255) / 256) * (DM / 32), CV_T_O = (DM / 256) * (DM / 32), CV_NTASK = 4 * CV_T_GU + 2 * CV_T_D + CV_T_IN + CV_T_O;
__device__ __forceinline__ void phase_convert(int l, int par, int t_lo, int t_hi, bool small, bool inputs, int lane, int idx, int cnt) {
    unsigned char* ws = KWS();
    const size_t so = (size_t)l * DM * FF;
    const float *f1g = KIN(I_F1G) + so, *f1u = KIN(I_F1U) + so, *f1d = KIN(I_F1D) + so, *f2g = KIN(I_F2G) + so, *f2u = KIN(I_F2U) + so, *f2d = KIN(I_F2D) + so;
    const float* win = KIN(I_WIN) + (size_t)l * DM * INC; const float* wout = KIN(I_WOUT) + (size_t)l * DM * DM;
    constexpr int T_GU = CV_T_GU, T_D = CV_T_D, T_IN = CV_T_IN;
    for (int it = t_lo + idx; it < t_hi; it += cnt) {
        int r = it;
        if (r < 4 * T_GU) { const int which = r / T_GU; r -= which * T_GU; const int nb = r % (FF / 256), kb = r / (FF / 256);
            const float* W = which == 0 ? f1g : (which == 1 ? f1u : (which == 2 ? f2g : f2u)); unsigned char* WT = ws + (which < 2 ? wofs(1, par) : wofs(5, par));
            if (which & 1) cvt_task8<2>(W, DM, FF, WT, nb, 32 * kb, lane); else cvt_task8<1>(W, DM, FF, WT, nb, 32 * kb, lane); continue; }
        r -= 4 * T_GU;
        if (r < 2 * T_D) { const int which = r / T_D; r -= which * T_D; const int nb = r % (DM / 256), kb = r / (DM / 256);
            cvt_task8<0>(which == 0 ? f1d : f2d, FF, DM, ws + (which == 0 ? wofs(2, par) : wofs(6, par)), nb, 32 * kb, lane); continue; }
        r -= 2 * T_D;
        if (r < T_IN) { const int nb = r % ((INC + 255) / 256), kb = r / ((INC + 255) / 256); cvt_task<3>(win, DM, INC, (bf16*)(ws + wofs(3, par)), nb, 32 * kb, lane); continue; }
        r -= T_IN;
        { const int nb = r % (DM / 256), kb = r / (DM / 256); cvt_task<0>(wout, DM, DM, (bf16*)(ws + wofs(4, par)), nb, 32 * kb, lane); }
    }
    if (small) {
        { v4u* z = (v4u*)(ws + wofs(3, par) + (size_t)SHIFT * DM * 2); const int nz = (PLD - SHIFT) * DM * 2 / 16;
          unsigned z0; asm volatile("v_mov_b32 %0, 0" : "=v"(z0));
          for (int i = idx * 64 + lane; i < nz; i += cnt * 64) z[i] = (v4u){z0, z0, z0, z0}; }
        { bf16* WT = (bf16*)(ws + wofs(7, par)); const float* wup = KIN(I_WUP) + (size_t)l * 64 * RW; const float* aup = KIN(I_AUP) + (size_t)l * 64 * RW; const float* gup = KIN(I_GUP) + (size_t)l * 160 * RW;
          for (int i = idx * 64 + lane; i < NL * LK; i += cnt * 64) { const int n = i / LK, k = i % LK, kind = n >> 10, c = n & 1023; float v = 0.f;
              if (kind == 0) { if (k < 64) v = wup[(size_t)k * RW + c]; } else if (kind == 1) { if (k >= 64 && k < 128) v = aup[(size_t)(k - 64) * RW + c]; } else { if (k >= 128 && k < 288) v = gup[(size_t)(k - 128) * RW + c]; }
              WT[i] = (bf16)f2bf(v); } }
    }
    if (inputs) {
        float* X = (float*)(ws + WS_X); bf16* XB = (bf16*)(ws + WS_XB); const float* xp = KIN(I_XP); const float* xs = KIN(I_XS);
        for (int m = idx; m < M; m += cnt) { const float* src = m < TP ? xp + (size_t)m * DM : xs + (size_t)(m - TP) * DM;
            const f32x4* s4 = (const f32x4*)src + lane; f32x4* d4 = (f32x4*)(X + (size_t)m * DM) + lane; unsigned long long* o8 = (unsigned long long*)(XB + (size_t)m * DM) + lane; unsigned* q8 = (unsigned*)(ws + B_XB8 + (size_t)m * DM) + lane;
#pragma unroll
            for (int j = 0; j < 8; ++j) { const f32x4 v = s4[64 * j]; if (m >= TP) d4[64 * j] = v; o8[64 * j] = (unsigned long long)pk2(v.x, v.y) | ((unsigned long long)pk2(v.z, v.w) << 32);
                unsigned w = 0u; w = __builtin_amdgcn_cvt_pk_fp8_f32(v.x, v.y, w, false); w = __builtin_amdgcn_cvt_pk_fp8_f32(v.z, v.w, w, true); q8[64 * j] = w; } }
    }
}

__device__ __forceinline__ void phase_ln(const float* Z, const float* Xres, const float* slab, int KS, float sa, float sb, const float* g, const float* b, float* Xo, bf16* XBo, unsigned char* XB8o  , bool all_rows, int lane, int gw, int NGW) {
    for (int m = gw; m < M; m += NGW) {
        f32x4 v[8]; float s = 0.f;
        if (m < TP) { const f32x4* zr = (const f32x4*)(Z + (size_t)m * DM) + lane;
#pragma unroll
            for (int j = 0; j < 8; ++j) v[j] = zr[64 * j];
        } else { const f32x4* xr = (const f32x4*)(Xres + (size_t)m * DM) + lane; f32x4 a[8];
#pragma unroll
            for (int j = 0; j < 8; ++j) { v[j] = xr[64 * j]; a[j] = (f32x4){0.f, 0.f, 0.f, 0.f}; }
            for (int ks = 0; ks < KS; ++ks) { const f32x4* sr = (const f32x4*)(slab + ((size_t)ks * 512 + (m - TP)) * DM) + lane;
#pragma unroll
                for (int j = 0; j < 8; ++j) a[j] = a[j] + sr[64 * j]; }
#pragma unroll
            for (int j = 0; j < 8; ++j) v[j] = v[j] * sa + a[j] * sb; }
#pragma unroll
        for (int j = 0; j < 8; ++j) s += (v[j].x + v[j].y) + (v[j].z + v[j].w);
        const float mean = wave_sum(s) * (1.f / DM); float s2 = 0.f;
#pragma unroll
        for (int j = 0; j < 8; ++j) { v[j] = v[j] - mean; s2 += (v[j].x * v[j].x + v[j].y * v[j].y) + (v[j].z * v[j].z + v[j].w * v[j].w); }
        const float rstd = 1.f / sqrtf(wave_sum(s2) * (1.f / DM) + LN_EPS);
        f32x4* xo = (f32x4*)(Xo + (size_t)m * DM) + lane; const bool wx = all_rows || m >= TP;
#pragma unroll
        for (int j = 0; j < 8; ++j) { const f32x4 gg = ((const f32x4*)g)[lane + 64 * j], bb = ((const f32x4*)b)[lane + 64 * j]; const f32x4 o = v[j] * rstd * gg + bb; if (wx) xo[64 * j] = o;
            if (XBo) ((unsigned long long*)(XBo + (size_t)m * DM) + lane)[64 * j] = (unsigned long long)pk2(o.x, o.y) | ((unsigned long long)pk2(o.z, o.w) << 32);
            if (XB8o) { unsigned w = 0u; w = __builtin_amdgcn_cvt_pk_fp8_f32(o.x, o.y, w, false); w = __builtin_amdgcn_cvt_pk_fp8_f32(o.z, o.w, w, true); ((unsigned*)(XB8o + (size_t)m * DM) + lane)[64 * j] = w; } }
    }
}

__device__ __forceinline__ const float* prev_row(const float* ssh, int l, const float* P, int m) {
    if (m < TP) return m == 0 ? nullptr : P + (size_t)(m - 1) * PLD;
    const int b = (m - TP) >> 5, t = (m - TP) & 31;
    return t == 0 ? ssh + (size_t)(l * NSB + b) * SHIFT : P + (size_t)(m - 1) * PLD;
}

__device__ __forceinline__ void phase_prep1(int l, int lane, int gw, int NGW) {
    unsigned char* ws = KWS(); float* outp = KOUT(); const float* P = (const float*)(ws + B_P); float* GV = (float*)(ws + B_GV); bf16* A3B = (bf16*)(ws + B_A3B);
    const float* mu = KIN(I_MU) + (size_t)l * SHIFT; const float* lg = KIN(I_GLG) + (size_t)l * GMW; const float* lb = KIN(I_GLB) + (size_t)l * GMW;
    const float* ssh = KIN(I_SSH);
    for (int m = gw; m < M; m += NGW) {
        const float* pr = P + (size_t)m * PLD; const float* pp = prev_row(ssh, l, P, m);
#pragma unroll
        for (int jj = 0; jj < 6; ++jj) { const int j = jj * 64 + lane; float v = 0.f;
            if (j < 288) { const int c = C_W + j; const float p = pr[c], q = pp ? pp[c] : 0.f; const float xs = p + (q - p) * mu[c];
                if (j < 64) { const float t = __expf(-2.f * fabsf(xs)); const float r = (1.f - t) / (1.f + t); v = xs < 0.f ? -r : r; }
                else if (j < 128) v = xs;
                else v = 1.f / (1.f + __expf(-xs)); }
            A3B[(size_t)m * LK + j] = (bf16)f2bf(v); }
        { f32x4* vr = (f32x4*)(GV + (size_t)m * GMW) + lane; f32x4 v[4]; float s = 0.f;
#pragma unroll
          for (int j = 0; j < 4; ++j) { v[j] = vr[64 * j]; s += (v[j].x + v[j].y) + (v[j].z + v[j].w); }
          const float mean = wave_sum(s) * (1.f / GMW); float s2 = 0.f;
#pragma unroll
          for (int j = 0; j < 4; ++j) { v[j] = v[j] - mean; s2 += (v[j].x * v[j].x + v[j].y * v[j].y) + (v[j].z * v[j].z + v[j].w * v[j].w); }
          const float rstd = 1.f / sqrtf(wave_sum(s2) * (1.f / GMW) + LN_EPS);
          f32x4* go = nullptr; if (m >= TP) go = (f32x4*)(outp + O_GV + ((size_t)l * NSB * TS + (m - TP)) * GMW) + lane;
#pragma unroll
          for (int j = 0; j < 4; ++j) { const f32x4 o = v[j] * rstd * ((const f32x4*)lg)[lane + 64 * j] + ((const f32x4*)lb)[lane + 64 * j]; vr[64 * j] = o; if (go) go[64 * j] = o; } }
        if (m == TP - 1) { float* o = outp + O_SHP + (size_t)l * SHIFT; for (int c = lane; c < SHIFT; c += 64) o[c] = pr[c]; }
        if (m >= TP && ((m - TP) & 31) == 31) { float* o = outp + O_SHS + (size_t)(l * NSB + ((m - TP) >> 5)) * SHIFT; for (int c = lane; c < SHIFT; c += 64) o[c] = pr[c]; }
    }
}

typedef unsigned u32x2g __attribute__((ext_vector_type(2)));
constexpr int GLD = 272, GL_VT = 128 * GLD, GSP = 132;
static_assert(2 * GL_VT <= RING_BYTES && 128 * GSP * 4 <= 2 * GL_VT, "gMLP LDS");
__device__ __forceinline__ void gmlp_unit(int l, LAS unsigned char* lds, int unit, int tid, int wave) {
    unsigned char* ws = KWS(); const float* VN = (const float*)(ws + B_GV); const bf16* U = (const bf16*)(ws + B_U); bf16* MIXB = (bf16*)(ws + B_MIX);
    const int ci = unit >> 3, h = unit & 7; int row0, nr; if (ci < 128) { row0 = 128 * ci; nr = 128; } else { row0 = TP + 32 * (ci - 128); nr = 32; }
    const float* wsm = KIN(I_GWS) + ((size_t)l * GH + h) * 128 * 128; const float* bs = KIN(I_GBS) + ((size_t)l * GH + h) * 128;
    LAS unsigned char* Wb = lds; LAS unsigned char* Vt = lds + GL_VT; LAS float* So = (LAS float*)lds;
    const int lane = tid & 63, g = lane >> 4, lc = lane & 15;
    __syncthreads();
    for (int idx = tid; idx < nr * 32; idx += NTHR) { const int i = idx >> 5, j4 = idx & 31; f32x4 w4 = *(const f32x4*)(wsm + i * 128 + 4 * j4);
        const int j = 4 * j4; if (j > i) w4.x = 0.f; if (j + 1 > i) w4.y = 0.f; if (j + 2 > i) w4.z = 0.f; if (j + 3 > i) w4.w = 0.f;
        *(LAS u32x2g*)(Wb + i * GLD + 8 * j4) = (u32x2g){pk2(w4.x, w4.y), pk2(w4.z, w4.w)}; }
    { const int c = tid & 127, jg = tid >> 7;
      if (32 * jg < nr) { const float* vp = VN + (size_t)(row0 + 32 * jg) * GMW + h * GHD + c; float vv[32];
#pragma unroll
          for (int j = 0; j < 32; ++j) vv[j] = vp[(size_t)j * GMW];
#pragma unroll
          for (int q = 0; q < 4; ++q) *(LAS v4u*)(Vt + c * GLD + (32 * jg + 8 * q) * 2) = (v4u){pk2(vv[8 * q], vv[8 * q + 1]), pk2(vv[8 * q + 2], vv[8 * q + 3]), pk2(vv[8 * q + 4], vv[8 * q + 5]), pk2(vv[8 * q + 6], vv[8 * q + 7])}; } }
    __syncthreads();
    float zf; asm volatile("v_mov_b32 %0, 0" : "=v"(zf));
    f32x4 acc[8];
#pragma unroll
    for (int cb = 0; cb < 8; ++cb) acc[cb] = (f32x4){zf, zf, zf, zf};
    const bool rows_live = 16 * wave < nr;
    if (rows_live) { const int nks = (wave + 2) >> 1;
        for (int ks = 0; ks < nks; ++ks) { const bf16x8 fa = *(const LAS bf16x8*)(Wb + (16 * wave + lc) * GLD + (32 * ks + 8 * g) * 2);
#pragma unroll
            for (int cb = 0; cb < 8; ++cb) acc[cb] = __builtin_amdgcn_mfma_f32_16x16x32_bf16(fa, *(const LAS bf16x8*)(Vt + (16 * cb + lc) * GLD + (32 * ks + 8 * g) * 2), acc[cb], 0, 0, 0); } }
    __syncthreads();
    if (rows_live) {
#pragma unroll
        for (int rg = 0; rg < 4; ++rg) { const int i = 16 * wave + 4 * g + rg; const float b0 = bs[i];
#pragma unroll
            for (int cb = 0; cb < 8; ++cb) So[i * GSP + 16 * cb + lc] = acc[cb][rg] + b0; } }
    __syncthreads();
    const int rq = tid >> 4, cg = tid & 15;
    if (4 * rq < nr) {
#pragma unroll
        for (int r = 0; r < 4; ++r) { const int i = 4 * rq + r; const size_t row = (size_t)(row0 + i); const v4u uu = *(const v4u*)(U + row * GMW + h * GHD + 8 * cg);
            const f32x4 s0 = *(const LAS f32x4*)(So + i * GSP + 8 * cg), s1 = *(const LAS f32x4*)(So + i * GSP + 8 * cg + 4);
            const float u0 = __builtin_bit_cast(float, uu.x << 16), u1 = __builtin_bit_cast(float, uu.x & 0xffff0000u), u2 = __builtin_bit_cast(float, uu.y << 16), u3 = __builtin_bit_cast(float, uu.y & 0xffff0000u);
            const float u4 = __builtin_bit_cast(float, uu.z << 16), u5 = __builtin_bit_cast(float, uu.z & 0xffff0000u), u6 = __builtin_bit_cast(float, uu.w << 16), u7 = __builtin_bit_cast(float, uu.w & 0xffff0000u);
            v4u o; o.x = pk2(u0 * s0.x, u1 * s0.y); o.y = pk2(u2 * s0.z, u3 * s0.w); o.z = pk2(u4 * s1.x, u5 * s1.y); o.w = pk2(u6 * s1.z, u7 * s1.w);
            *(v4u*)(MIXB + row * DM + RW + h * GHD + 8 * cg) = o; }
    }
}


constexpr int NCI = 272, NUNIT = NCI * NH;
constexpr size_t SC_G = WS_RW + 3 * RWSZ;
constexpr size_t SC_HL = SC_G + (size_t)NUNIT * 8192;
constexpr size_t SC_RP = SC_HL + (size_t)NUNIT * 16384;
constexpr size_t SC_YL = SC_RP + (size_t)NUNIT * 8192;
constexpr size_t SC_S0 = SC_YL + (size_t)NUNIT * 16384;
constexpr size_t SC_BON = SC_S0 + (size_t)NUNIT * 8192;
constexpr size_t SC_END = SC_BON + (size_t)NUNIT * 256;
static_assert(SC_END <= WS_END, "scan scratch");
constexpr size_t WS_SLAB = SC_G;
static_assert(WS_SLAB + (size_t)11 * 512 * 2048 * 4 <= WS_END, "slab");
typedef unsigned u32x2 __attribute__((ext_vector_type(2)));
constexpr int BLD = 144;
constexpr int LBUF = 9216;
constexpr int LF0 = 7 * LBUF, F0P = 129;
constexpr int LF1 = LF0 + 64 * F0P * 4, F1P = 68;
constexpr int LF2 = LF1 + 64 * F1P * 4;
constexpr int LTOT = LF2 + 16384;
constexpr int LGC = LTOT + 2048;
constexpr int SCAN_LDS = LGC + 256;
static_assert(SCAN_LDS <= RING_BYTES, "scan LDS");

__device__ __forceinline__ bf16x8 ldfrag(const LAS unsigned char* mat, int blk, int ks, int lane) { return *(const LAS bf16x8*)(mat + (16 * blk + (lane & 15)) * BLD + (32 * ks + 8 * (lane >> 4)) * 2); }
#define MFMA16(a, b, c) __builtin_amdgcn_mfma_f32_16x16x32_bf16((a), (b), (c), 0, 0, 0)

#define LDS_BAR() do { asm volatile("s_waitcnt lgkmcnt(0)" ::: "memory"); __builtin_amdgcn_s_barrier(); asm volatile("" ::: "memory"); } while (0)
__device__ __forceinline__ void scanA_all(int l, LAS unsigned char* lds, int bx, int G, int tid, int wave) {
    unsigned char* ws = KWS();
    const int lane = tid & 63;
    const float* ssh = KIN(I_SSH); const float* mu = KIN(I_MU) + (size_t)l * SHIFT;
    const float *w0p = KIN(I_W0) + (size_t)l * RW, *a0p = KIN(I_A0) + (size_t)l * RW, *kkp = KIN(I_KK) + (size_t)l * RW, *kap = KIN(I_KA) + (size_t)l * RW, *rkp = KIN(I_RK) + (size_t)l * RW;
    float pr_[8], pk_[8], pv_[8], al_[8], wl_[8]; float q_r, q_k, q_v, mu_r, mu_k, mu_v, w0c, a0c, kkc, kac, rkc;
#define SA_LOAD(unit_) do { const int ci_ = (unit_) >> 4, cc_ = 64 * ((unit_) & 15) + lane; const int m0_ = ci_ < 256 ? 64 * ci_ : TP + 32 * (ci_ - 256), n_ = ci_ < 256 ? 64 : 32, t0_ = 8 * wave; \
        const float* P_ = (const float*)(ws + B_P); const float* Wl_ = (const float*)(ws + WS_RW); const float* Al_ = (const float*)(ws + WS_RW + RWSZ); \
        mu_r = mu[cc_]; mu_k = mu[RW + cc_]; mu_v = mu[2 * RW + cc_]; w0c = w0p[cc_]; a0c = a0p[cc_]; kkc = kkp[cc_]; kac = kap[cc_]; rkc = rkp[cc_]; q_r = 0.f; q_k = 0.f; q_v = 0.f; \
        if (t0_ < n_) { const float* pp_ = prev_row(ssh, l, P_, m0_ + t0_); if (pp_) { q_r = pp_[cc_]; q_k = pp_[RW + cc_]; q_v = pp_[2 * RW + cc_]; } } \
        _Pragma("unroll") for (int i = 0; i < 8; ++i) { pr_[i] = 0.f; pk_[i] = 0.f; pv_[i] = 0.f; al_[i] = 0.f; wl_[i] = 0.f; \
            if (t0_ < n_) { const size_t m_ = (size_t)(m0_ + t0_ + i); const float* prow_ = P_ + m_ * PLD; pr_[i] = prow_[cc_]; pk_[i] = prow_[RW + cc_]; pv_[i] = prow_[2 * RW + cc_]; al_[i] = Al_[m_ * RW + cc_]; wl_[i] = Wl_[m_ * RW + cc_]; } } } while (0)
    if (bx < NUNIT) SA_LOAD(bx);
    for (int unit = bx; unit < NUNIT; unit += G) {
    const int ci = unit >> 4;
    int m0, n; if (ci < 256) { m0 = 64 * ci; n = 64; } else { m0 = TP + 32 * (ci - 256); n = 32; }
    (void)m0;
    const float* P = (const float*)(ws + B_P); const float* Wl = (const float*)(ws + WS_RW); const float* Al = (const float*)(ws + WS_RW + RWSZ);
    LAS unsigned char* B0 = lds; LAS unsigned char* B1 = lds + LBUF; LAS unsigned char* B2 = lds + 2 * LBUF; LAS unsigned char* B3 = lds + 3 * LBUF;
    LAS unsigned char* B4 = lds + 4 * LBUF; LAS unsigned char* B5 = lds + 5 * LBUF; LAS unsigned char* B6 = lds + 6 * LBUF;
    LAS float* F0 = (LAS float*)(lds + LF0); LAS float* F1 = (LAS float*)(lds + LF1); LAS float* F2 = (LAS float*)(lds + LF2); LAS float* TOT = (LAS float*)(lds + LTOT); LAS float* GC = (LAS float*)(lds + LGC);
    LDS_BAR();
    {
        const int t0 = 8 * wave; const bool live = t0 < n;
        float r[8], kp[8], v[8], kk[8], b[8], lw[8], bsv[8];
        float* bon = (float*)(ws + SC_BON) + (size_t)unit * 64;
#pragma unroll
        for (int i = 0; i < 8; ++i) {
            r[i] = 0.f; kp[i] = 0.f; v[i] = 0.f; kk[i] = 0.f; b[i] = 0.f; lw[i] = 0.f; bsv[i] = 0.f;
            if (live) {
                const float p_r = pr_[i], p_k = pk_[i], p_v = pv_[i];
                const float rr = p_r + (q_r - p_r) * mu_r, kx = p_k + (q_k - p_k) * mu_k, vx = p_v + (q_v - p_v) * mu_v; q_r = p_r; q_k = p_k; q_v = p_v;
                const float av = __builtin_amdgcn_rcpf(1.f + __expf(-(a0c + al_[i])));
                const float sg = __builtin_amdgcn_rcpf(1.f + __expf(-(w0c + wl_[i])));
                const float kkv = kx * kkc; const float n2 = wave_sum(kkv * kkv); const float kn = kkv * __builtin_amdgcn_rsqf(fmaxf(n2, 1e-24f));
                const float kpv = kx * (1.f + (av - 1.f) * kac);
                bsv[i] = wave_sum(rr * kpv * rkc);
                r[i] = rr; kp[i] = kpv; v[i] = vx; kk[i] = kn; b[i] = kn * av; lw[i] = -0.60653065971263342f * sg; }
        }
        if (live && lane < 8) { float bv = bsv[0];
#pragma unroll
            for (int i = 1; i < 8; ++i) bv = lane == i ? bsv[i] : bv;
            bon[t0 + lane] = bv; }
        if (unit + G < NUNIT) SA_LOAD(unit + G);
        float pl[8]; pl[0] = lw[0];
#pragma unroll
        for (int i = 1; i < 8; ++i) pl[i] = pl[i - 1] + lw[i];
        TOT[wave * 64 + lane] = pl[7];
        LDS_BAR();
        float off = 0.f, lamC = 0.f;
#pragma unroll
        for (int s = 0; s < 8; ++s) { const float tv = TOT[s * 64 + lane]; lamC += tv; if (s < wave) off += tv; }
        const float gC = __expf(lamC); if (wave == 0) GC[lane] = gC;
        unsigned vt[4], kb[4], bb[4];
#pragma unroll
        for (int i = 0; i < 8; ++i) { const int t = t0 + i; const float lam = off + pl[i];
            const float g_t = __expf(lam), g_p = __expf(lam - lw[i]), g_i = __expf(-lam), g_c = gC * g_i;
            const float kkt = kk[i] * g_p, rt = r[i] * g_t;
            *(LAS unsigned short*)(B0 + t * BLD + lane * 2) = (unsigned short)f2bf(kkt); F0[t * F0P + lane] = kkt;
            *(LAS unsigned short*)(B1 + t * BLD + lane * 2) = (unsigned short)f2bf(rt); F2[t * 64 + lane] = rt;
            *(LAS unsigned short*)(B2 + t * BLD + lane * 2) = (unsigned short)f2bf(kp[i] * g_i);
            *(LAS unsigned short*)(B3 + t * BLD + lane * 2) = (unsigned short)f2bf(b[i] * g_i);
            const unsigned hv = f2bf(v[i]), hk = f2bf(kp[i] * g_c), hb = f2bf(b[i] * g_c);
            if (i & 1) { vt[i >> 1] |= hv << 16; kb[i >> 1] |= hk << 16; bb[i >> 1] |= hb << 16; } else { vt[i >> 1] = hv; kb[i >> 1] = hk; bb[i >> 1] = hb; } }
        *(LAS v4u*)(B4 + lane * BLD + 16 * wave) = (v4u){vt[0], vt[1], vt[2], vt[3]};
        *(LAS v4u*)(B5 + lane * BLD + 16 * wave) = (v4u){kb[0], kb[1], kb[2], kb[3]};
        *(LAS v4u*)(B6 + lane * BLD + 16 * wave) = (v4u){bb[0], bb[1], bb[2], bb[3]};
    }
    LDS_BAR();
    const int rb = wave >> 1, cb0 = (wave & 1) * 2, g = lane >> 4, lc = lane & 15;
    float zf; asm volatile("v_mov_b32 %0, 0" : "=v"(zf));
    const f32x4 z4 = (f32x4){zf, zf, zf, zf};
    {
        f32x4 aab[2] = {z4, z4}, aak[2] = {z4, z4}, arb[2] = {z4, z4}, ark[2] = {z4, z4};
#pragma unroll
        for (int ks = 0; ks < 2; ++ks) { const bf16x8 fk = ldfrag(B0, rb, ks, lane), fr = ldfrag(B1, rb, ks, lane);
#pragma unroll
            for (int c = 0; c < 2; ++c) { const bf16x8 fkh = ldfrag(B2, cb0 + c, ks, lane), fb = ldfrag(B3, cb0 + c, ks, lane);
                aab[c] = MFMA16(fk, fb, aab[c]); aak[c] = MFMA16(fk, fkh, aak[c]); arb[c] = MFMA16(fr, fb, arb[c]); ark[c] = MFMA16(fr, fkh, ark[c]); } }
        LDS_BAR();
#pragma unroll
        for (int c = 0; c < 2; ++c)
#pragma unroll
            for (int rg = 0; rg < 4; ++rg) { const int t = 16 * rb + 4 * g + rg, s = 16 * (cb0 + c) + lc;
                F1[t * F1P + (s & 3) * 16 + (s >> 2)] = s < t ? aab[c][rg] : 0.f;
                *(LAS unsigned short*)(B0 + t * BLD + s * 2) = (unsigned short)f2bf(s < t ? aak[c][rg] : 0.f);
                *(LAS unsigned short*)(B1 + t * BLD + s * 2) = (unsigned short)f2bf(s <= t ? arb[c][rg] : 0.f);
                *(LAS unsigned short*)(B2 + t * BLD + s * 2) = (unsigned short)f2bf(s <= t ? ark[c][rg] : 0.f); }
    }
    LDS_BAR();
    {
        f32x4 av[2] = {z4, z4};
#pragma unroll
        for (int ks = 0; ks < 2; ++ks) { const bf16x8 fa = ldfrag(B0, rb, ks, lane);
#pragma unroll
            for (int c = 0; c < 2; ++c) av[c] = MFMA16(fa, ldfrag(B4, cb0 + c, ks, lane), av[c]); }
#pragma unroll
        for (int c = 0; c < 2; ++c)
#pragma unroll
            for (int rg = 0; rg < 4; ++rg) F0[(16 * rb + 4 * g + rg) * F0P + 64 + 16 * (cb0 + c) + lc] = av[c][rg];
    }
    LDS_BAR();
    {
        const int j = tid >> 2, p = tid & 3; const LAS float* f1p = F1 + p * 16; const LAS float* f0p = F0 + j;
        float x0 = zf, x1 = zf, x2 = zf, x3 = zf, x4 = zf, x5 = zf, x6 = zf, x7 = zf, x8 = zf, x9 = zf, x10 = zf, x11 = zf, x12 = zf, x13 = zf, x14 = zf, x15 = zf;
        { float part = zf; const float xt = f0p[0*F0P] - part; x0 = (p == 0) ? xt : x0; }
        { const f32x4 a0 = *(const LAS f32x4*)(f1p + 1*F1P + 0); float part = a0.x * x0; part += dpp_mov<0xB1>(part); part += dpp_mov<0x4E>(part); const float xt = f0p[1*F0P] - part; x0 = (p == 1) ? xt : x0; }
        { const f32x4 a0 = *(const LAS f32x4*)(f1p + 2*F1P + 0); float part = a0.x * x0; part += dpp_mov<0xB1>(part); part += dpp_mov<0x4E>(part); const float xt = f0p[2*F0P] - part; x0 = (p == 2) ? xt : x0; }
        { const f32x4 a0 = *(const LAS f32x4*)(f1p + 3*F1P + 0); float part = a0.x * x0; part += dpp_mov<0xB1>(part); part += dpp_mov<0x4E>(part); const float xt = f0p[3*F0P] - part; x0 = (p == 3) ? xt : x0; }
        { const f32x4 a0 = *(const LAS f32x4*)(f1p + 4*F1P + 0); float part = a0.x * x0; part += dpp_mov<0xB1>(part); part += dpp_mov<0x4E>(part); const float xt = f0p[4*F0P] - part; x1 = (p == 0) ? xt : x1; }
        { const f32x4 a0 = *(const LAS f32x4*)(f1p + 5*F1P + 0); float part = (a0.x * x0) + (a0.y * x1); part += dpp_mov<0xB1>(part); part += dpp_mov<0x4E>(part); const float xt = f0p[5*F0P] - part; x1 = (p == 1) ? xt : x1; }
        { const f32x4 a0 = *(const LAS f32x4*)(f1p + 6*F1P + 0); float part = (a0.x * x0) + (a0.y * x1); part += dpp_mov<0xB1>(part); part += dpp_mov<0x4E>(part); const float xt = f0p[6*F0P] - part; x1 = (p == 2) ? xt : x1; }
        { const f32x4 a0 = *(const LAS f32x4*)(f1p + 7*F1P + 0); float part = (a0.x * x0) + (a0.y * x1); part += dpp_mov<0xB1>(part); part += dpp_mov<0x4E>(part); const float xt = f0p[7*F0P] - part; x1 = (p == 3) ? xt : x1; }
        { const f32x4 a0 = *(const LAS f32x4*)(f1p + 8*F1P + 0); float part = (a0.x * x0) + (a0.y * x1); part += dpp_mov<0xB1>(part); part += dpp_mov<0x4E>(part); const float xt = f0p[8*F0P] - part; x2 = (p == 0) ? xt : x2; }
        { const f32x4 a0 = *(const LAS f32x4*)(f1p + 9*F1P + 0); float part = (a0.x * x0 + a0.z * x2) + (a0.y * x1); part += dpp_mov<0xB1>(part); part += dpp_mov<0x4E>(part); const float xt = f0p[9*F0P] - part; x2 = (p == 1) ? xt : x2; }
        { const f32x4 a0 = *(const LAS f32x4*)(f1p + 10*F1P + 0); float part = (a0.x * x0 + a0.z * x2) + (a0.y * x1); part += dpp_mov<0xB1>(part); part += dpp_mov<0x4E>(part); const float xt = f0p[10*F0P] - part; x2 = (p == 2) ? xt : x2; }
        { const f32x4 a0 = *(const LAS f32x4*)(f1p + 11*F1P + 0); float part = (a0.x * x0 + a0.z * x2) + (a0.y * x1); part += dpp_mov<0xB1>(part); part += dpp_mov<0x4E>(part); const float xt = f0p[11*F0P] - part; x2 = (p == 3) ? xt : x2; }
        { const f32x4 a0 = *(const LAS f32x4*)(f1p + 12*F1P + 0); float part = (a0.x * x0 + a0.z * x2) + (a0.y * x1); part += dpp_mov<0xB1>(part); part += dpp_mov<0x4E>(part); const float xt = f0p[12*F0P] - part; x3 = (p == 0) ? xt : x3; }
        { const f32x4 a0 = *(const LAS f32x4*)(f1p + 13*F1P + 0); float part = (a0.x * x0 + a0.z * x2) + (a0.y * x1 + a0.w * x3); part += dpp_mov<0xB1>(part); part += dpp_mov<0x4E>(part); const float xt = f0p[13*F0P] - part; x3 = (p == 1) ? xt : x3; }
        { const f32x4 a0 = *(const LAS f32x4*)(f1p + 14*F1P + 0); float part = (a0.x * x0 + a0.z * x2) + (a0.y * x1 + a0.w * x3); part += dpp_mov<0xB1>(part); part += dpp_mov<0x4E>(part); const float xt = f0p[14*F0P] - part; x3 = (p == 2) ? xt : x3; }
        { const f32x4 a0 = *(const LAS f32x4*)(f1p + 15*F1P + 0); float part = (a0.x * x0 + a0.z * x2) + (a0.y * x1 + a0.w * x3); part += dpp_mov<0xB1>(part); part += dpp_mov<0x4E>(part); const float xt = f0p[15*F0P] - part; x3 = (p == 3) ? xt : x3; }
        { const f32x4 a0 = *(const LAS f32x4*)(f1p + 16*F1P + 0); float part = (a0.x * x0 + a0.z * x2) + (a0.y * x1 + a0.w * x3); part += dpp_mov<0xB1>(part); part += dpp_mov<0x4E>(part); const float xt = f0p[16*F0P] - part; x4 = (p == 0) ? xt : x4; }
        { const f32x4 a0 = *(const LAS f32x4*)(f1p + 17*F1P + 0); const f32x4 a1 = *(const LAS f32x4*)(f1p + 17*F1P + 4); float part = (a0.x * x0 + a0.z * x2 + a1.x * x4) + (a0.y * x1 + a0.w * x3); part += dpp_mov<0xB1>(part); part += dpp_mov<0x4E>(part); const float xt = f0p[17*F0P] - part; x4 = (p == 1) ? xt : x4; }
        { const f32x4 a0 = *(const LAS f32x4*)(f1p + 18*F1P + 0); const f32x4 a1 = *(const LAS f32x4*)(f1p + 18*F1P + 4); float part = (a0.x * x0 + a0.z * x2 + a1.x * x4) + (a0.y * x1 + a0.w * x3); part += dpp_mov<0xB1>(part); part += dpp_mov<0x4E>(part); const float xt = f0p[18*F0P] - part; x4 = (p == 2) ? xt : x4; }
        { const f32x4 a0 = *(const LAS f32x4*)(f1p + 19*F1P + 0); const f32x4 a1 = *(const LAS f32x4*)(f1p + 19*F1P + 4); float part = (a0.x * x0 + a0.z * x2 + a1.x * x4) + (a0.y * x1 + a0.w * x3); part += dpp_mov<0xB1>(part); part += dpp_mov<0x4E>(part); const float xt = f0p[19*F0P] - part; x4 = (p == 3) ? xt : x4; }
        { const f32x4 a0 = *(const LAS f32x4*)(f1p + 20*F1P + 0); const f32x4 a1 = *(const LAS f32x4*)(f1p + 20*F1P + 4); float part = (a0.x * x0 + a0.z * x2 + a1.x * x4) + (a0.y * x1 + a0.w * x3); part += dpp_mov<0xB1>(part); part += dpp_mov<0x4E>(part); const float xt = f0p[20*F0P] - part; x5 = (p == 0) ? xt : x5; }
        { const f32x4 a0 = *(const LAS f32x4*)(f1p + 21*F1P + 0); const f32x4 a1 = *(const LAS f32x4*)(f1p + 21*F1P + 4); float part = (a0.x * x0 + a0.z * x2 + a1.x * x4) + (a0.y * x1 + a0.w * x3 + a1.y * x5); part += dpp_mov<0xB1>(part); part += dpp_mov<0x4E>(part); const float xt = f0p[21*F0P] - part; x5 = (p == 1) ? xt : x5; }
        { const f32x4 a0 = *(const LAS f32x4*)(f1p + 22*F1P + 0); const f32x4 a1 = *(const LAS f32x4*)(f1p + 22*F1P + 4); float part = (a0.x * x0 + a0.z * x2 + a1.x * x4) + (a0.y * x1 + a0.w * x3 + a1.y * x5); part += dpp_mov<0xB1>(part); part += dpp_mov<0x4E>(part); const float xt = f0p[22*F0P] - part; x5 = (p == 2) ? xt : x5; }
        { const f32x4 a0 = *(const LAS f32x4*)(f1p + 23*F1P + 0); const f32x4 a1 = *(const LAS f32x4*)(f1p + 23*F1P + 4); float part = (a0.x * x0 + a0.z * x2 + a1.x * x4) + (a0.y * x1 + a0.w * x3 + a1.y * x5); part += dpp_mov<0xB1>(part); part += dpp_mov<0x4E>(part); const float xt = f0p[23*F0P] - part; x5 = (p == 3) ? xt : x5; }
        { const f32x4 a0 = *(const LAS f32x4*)(f1p + 24*F1P + 0); const f32x4 a1 = *(const LAS f32x4*)(f1p + 24*F1P + 4); float part = (a0.x * x0 + a0.z * x2 + a1.x * x4) + (a0.y * x1 + a0.w * x3 + a1.y * x5); part += dpp_mov<0xB1>(part); part += dpp_mov<0x4E>(part); const float xt = f0p[24*F0P] - part; x6 = (p == 0) ? xt : x6; }
        { const f32x4 a0 = *(const LAS f32x4*)(f1p + 25*F1P + 0); const f32x4 a1 = *(const LAS f32x4*)(f1p + 25*F1P + 4); float part = (a0.x * x0 + a0.z * x2 + a1.x * x4 + a1.z * x6) + (a0.y * x1 + a0.w * x3 + a1.y * x5); part += dpp_mov<0xB1>(part); part += dpp_mov<0x4E>(part); const float xt = f0p[25*F0P] - part; x6 = (p == 1) ? xt : x6; }
        { const f32x4 a0 = *(const LAS f32x4*)(f1p + 26*F1P + 0); const f32x4 a1 = *(const LAS f32x4*)(f1p + 26*F1P + 4); float part = (a0.x * x0 + a0.z * x2 + a1.x * x4 + a1.z * x6) + (a0.y * x1 + a0.w * x3 + a1.y * x5); part += dpp_mov<0xB1>(part); part += dpp_mov<0x4E>(part); const float xt = f0p[26*F0P] - part; x6 = (p == 2) ? xt : x6; }
        { const f32x4 a0 = *(const LAS f32x4*)(f1p + 27*F1P + 0); const f32x4 a1 = *(const LAS f32x4*)(f1p + 27*F1P + 4); float part = (a0.x * x0 + a0.z * x2 + a1.x * x4 + a1.z * x6) + (a0.y * x1 + a0.w * x3 + a1.y * x5); part += dpp_mov<0xB1>(part); part += dpp_mov<0x4E>(part); const float xt = f0p[27*F0P] - part; x6 = (p == 3) ? xt : x6; }
        { const f32x4 a0 = *(const LAS f32x4*)(f1p + 28*F1P + 0); const f32x4 a1 = *(const LAS f32x4*)(f1p + 28*F1P + 4); float part = (a0.x * x0 + a0.z * x2 + a1.x * x4 + a1.z * x6) + (a0.y * x1 + a0.w * x3 + a1.y * x5); part += dpp_mov<0xB1>(part); part += dpp_mov<0x4E>(part); const float xt = f0p[28*F0P] - part; x7 = (p == 0) ? xt : x7; }
        { const f32x4 a0 = *(const LAS f32x4*)(f1p + 29*F1P + 0); const f32x4 a1 = *(const LAS f32x4*)(f1p + 29*F1P + 4); float part = (a0.x * x0 + a0.z * x2 + a1.x * x4 + a1.z * x6) + (a0.y * x1 + a0.w * x3 + a1.y * x5 + a1.w * x7); part += dpp_mov<0xB1>(part); part += dpp_mov<0x4E>(part); const float xt = f0p[29*F0P] - part; x7 = (p == 1) ? xt : x7; }
        { const f32x4 a0 = *(const LAS f32x4*)(f1p + 30*F1P + 0); const f32x4 a1 = *(const LAS f32x4*)(f1p + 30*F1P + 4); float part = (a0.x * x0 + a0.z * x2 + a1.x * x4 + a1.z * x6) + (a0.y * x1 + a0.w * x3 + a1.y * x5 + a1.w * x7); part += dpp_mov<0xB1>(part); part += dpp_mov<0x4E>(part); const float xt = f0p[30*F0P] - part; x7 = (p == 2) ? xt : x7; }
        { const f32x4 a0 = *(const LAS f32x4*)(f1p + 31*F1P + 0); const f32x4 a1 = *(const LAS f32x4*)(f1p + 31*F1P + 4); float part = (a0.x * x0 + a0.z * x2 + a1.x * x4 + a1.z * x6) + (a0.y * x1 + a0.w * x3 + a1.y * x5 + a1.w * x7); part += dpp_mov<0xB1>(part); part += dpp_mov<0x4E>(part); const float xt = f0p[31*F0P] - part; x7 = (p == 3) ? xt : x7; }
        { const f32x4 a0 = *(const LAS f32x4*)(f1p + 32*F1P + 0); const f32x4 a1 = *(const LAS f32x4*)(f1p + 32*F1P + 4); float part = (a0.x * x0 + a0.z * x2 + a1.x * x4 + a1.z * x6) + (a0.y * x1 + a0.w * x3 + a1.y * x5 + a1.w * x7); part += dpp_mov<0xB1>(part); part += dpp_mov<0x4E>(part); const float xt = f0p[32*F0P] - part; x8 = (p == 0) ? xt : x8; }
        { const f32x4 a0 = *(const LAS f32x4*)(f1p + 33*F1P + 0); const f32x4 a1 = *(const LAS f32x4*)(f1p + 33*F1P + 4); const f32x4 a2 = *(const LAS f32x4*)(f1p + 33*F1P + 8); float part = (a0.x * x0 + a0.z * x2 + a1.x * x4 + a1.z * x6 + a2.x * x8) + (a0.y * x1 + a0.w * x3 + a1.y * x5 + a1.w * x7); part += dpp_mov<0xB1>(part); part += dpp_mov<0x4E>(part); const float xt = f0p[33*F0P] - part; x8 = (p == 1) ? xt : x8; }
        { const f32x4 a0 = *(const LAS f32x4*)(f1p + 34*F1P + 0); const f32x4 a1 = *(const LAS f32x4*)(f1p + 34*F1P + 4); const f32x4 a2 = *(const LAS f32x4*)(f1p + 34*F1P + 8); float part = (a0.x * x0 + a0.z * x2 + a1.x * x4 + a1.z * x6 + a2.x * x8) + (a0.y * x1 + a0.w * x3 + a1.y * x5 + a1.w * x7); part += dpp_mov<0xB1>(part); part += dpp_mov<0x4E>(part); const float xt = f0p[34*F0P] - part; x8 = (p == 2) ? xt : x8; }
        { const f32x4 a0 = *(const LAS f32x4*)(f1p + 35*F1P + 0); const f32x4 a1 = *(const LAS f32x4*)(f1p + 35*F1P + 4); const f32x4 a2 = *(const LAS f32x4*)(f1p + 35*F1P + 8); float part = (a0.x * x0 + a0.z * x2 + a1.x * x4 + a1.z * x6 + a2.x * x8) + (a0.y * x1 + a0.w * x3 + a1.y * x5 + a1.w * x7); part += dpp_mov<0xB1>(part); part += dpp_mov<0x4E>(part); const float xt = f0p[35*F0P] - part; x8 = (p == 3) ? xt : x8; }
        { const f32x4 a0 = *(const LAS f32x4*)(f1p + 36*F1P + 0); const f32x4 a1 = *(const LAS f32x4*)(f1p + 36*F1P + 4); const f32x4 a2 = *(const LAS f32x4*)(f1p + 36*F1P + 8); float part = (a0.x * x0 + a0.z * x2 + a1.x * x4 + a1.z * x6 + a2.x * x8) + (a0.y * x1 + a0.w * x3 + a1.y * x5 + a1.w * x7); part += dpp_mov<0xB1>(part); part += dpp_mov<0x4E>(part); const float xt = f0p[36*F0P] - part; x9 = (p == 0) ? xt : x9; }
        { const f32x4 a0 = *(const LAS f32x4*)(f1p + 37*F1P + 0); const f32x4 a1 = *(const LAS f32x4*)(f1p + 37*F1P + 4); const f32x4 a2 = *(const LAS f32x4*)(f1p + 37*F1P + 8); float part = (a0.x * x0 + a0.z * x2 + a1.x * x4 + a1.z * x6 + a2.x * x8) + (a0.y * x1 + a0.w * x3 + a1.y * x5 + a1.w * x7 + a2.y * x9); part += dpp_mov<0xB1>(part); part += dpp_mov<0x4E>(part); const float xt = f0p[37*F0P] - part; x9 = (p == 1) ? xt : x9; }
        { const f32x4 a0 = *(const LAS f32x4*)(f1p + 38*F1P + 0); const f32x4 a1 = *(const LAS f32x4*)(f1p + 38*F1P + 4); const f32x4 a2 = *(const LAS f32x4*)(f1p + 38*F1P + 8); float part = (a0.x * x0 + a0.z * x2 + a1.x * x4 + a1.z * x6 + a2.x * x8) + (a0.y * x1 + a0.w * x3 + a1.y * x5 + a1.w * x7 + a2.y * x9); part += dpp_mov<0xB1>(part); part += dpp_mov<0x4E>(part); const float xt = f0p[38*F0P] - part; x9 = (p == 2) ? xt : x9; }
        { const f32x4 a0 = *(const LAS f32x4*)(f1p + 39*F1P + 0); const f32x4 a1 = *(const LAS f32x4*)(f1p + 39*F1P + 4); const f32x4 a2 = *(const LAS f32x4*)(f1p + 39*F1P + 8); float part = (a0.x * x0 + a0.z * x2 + a1.x * x4 + a1.z * x6 + a2.x * x8) + (a0.y * x1 + a0.w * x3 + a1.y * x5 + a1.w * x7 + a2.y * x9); part += dpp_mov<0xB1>(part); part += dpp_mov<0x4E>(part); const float xt = f0p[39*F0P] - part; x9 = (p == 3) ? xt : x9; }
        { const f32x4 a0 = *(const LAS f32x4*)(f1p + 40*F1P + 0); const f32x4 a1 = *(const LAS f32x4*)(f1p + 40*F1P + 4); const f32x4 a2 = *(const LAS f32x4*)(f1p + 40*F1P + 8); float part = (a0.x * x0 + a0.z * x2 + a1.x * x4 + a1.z * x6 + a2.x * x8) + (a0.y * x1 + a0.w * x3 + a1.y * x5 + a1.w * x7 + a2.y * x9); part += dpp_mov<0xB1>(part); part += dpp_mov<0x4E>(part); const float xt = f0p[40*F0P] - part; x10 = (p == 0) ? xt : x10; }
        { const f32x4 a0 = *(const LAS f32x4*)(f1p + 41*F1P + 0); const f32x4 a1 = *(const LAS f32x4*)(f1p + 41*F1P + 4); const f32x4 a2 = *(const LAS f32x4*)(f1p + 41*F1P + 8); float part = (a0.x * x0 + a0.z * x2 + a1.x * x4 + a1.z * x6 + a2.x * x8 + a2.z * x10) + (a0.y * x1 + a0.w * x3 + a1.y * x5 + a1.w * x7 + a2.y * x9); part += dpp_mov<0xB1>(part); part += dpp_mov<0x4E>(part); const float xt = f0p[41*F0P] - part; x10 = (p == 1) ? xt : x10; }
        { const f32x4 a0 = *(const LAS f32x4*)(f1p + 42*F1P + 0); const f32x4 a1 = *(const LAS f32x4*)(f1p + 42*F1P + 4); const f32x4 a2 = *(const LAS f32x4*)(f1p + 42*F1P + 8); float part = (a0.x * x0 + a0.z * x2 + a1.x * x4 + a1.z * x6 + a2.x * x8 + a2.z * x10) + (a0.y * x1 + a0.w * x3 + a1.y * x5 + a1.w * x7 + a2.y * x9); part += dpp_mov<0xB1>(part); part += dpp_mov<0x4E>(part); const float xt = f0p[42*F0P] - part; x10 = (p == 2) ? xt : x10; }
        { const f32x4 a0 = *(const LAS f32x4*)(f1p + 43*F1P + 0); const f32x4 a1 = *(const LAS f32x4*)(f1p + 43*F1P + 4); const f32x4 a2 = *(const LAS f32x4*)(f1p + 43*F1P + 8); float part = (a0.x * x0 + a0.z * x2 + a1.x * x4 + a1.z * x6 + a2.x * x8 + a2.z * x10) + (a0.y * x1 + a0.w * x3 + a1.y * x5 + a1.w * x7 + a2.y * x9); part += dpp_mov<0xB1>(part); part += dpp_mov<0x4E>(part); const float xt = f0p[43*F0P] - part; x10 = (p == 3) ? xt : x10; }
        { const f32x4 a0 = *(const LAS f32x4*)(f1p + 44*F1P + 0); const f32x4 a1 = *(const LAS f32x4*)(f1p + 44*F1P + 4); const f32x4 a2 = *(const LAS f32x4*)(f1p + 44*F1P + 8); float part = (a0.x * x0 + a0.z * x2 + a1.x * x4 + a1.z * x6 + a2.x * x8 + a2.z * x10) + (a0.y * x1 + a0.w * x3 + a1.y * x5 + a1.w * x7 + a2.y * x9); part += dpp_mov<0xB1>(part); part += dpp_mov<0x4E>(part); const float xt = f0p[44*F0P] - part; x11 = (p == 0) ? xt : x11; }
        { const f32x4 a0 = *(const LAS f32x4*)(f1p + 45*F1P + 0); const f32x4 a1 = *(const LAS f32x4*)(f1p + 45*F1P + 4); const f32x4 a2 = *(const LAS f32x4*)(f1p + 45*F1P + 8); float part = (a0.x * x0 + a0.z * x2 + a1.x * x4 + a1.z * x6 + a2.x * x8 + a2.z * x10) + (a0.y * x1 + a0.w * x3 + a1.y * x5 + a1.w * x7 + a2.y * x9 + a2.w * x11); part += dpp_mov<0xB1>(part); part += dpp_mov<0x4E>(part); const float xt = f0p[45*F0P] - part; x11 = (p == 1) ? xt : x11; }
        { const f32x4 a0 = *(const LAS f32x4*)(f1p + 46*F1P + 0); const f32x4 a1 = *(const LAS f32x4*)(f1p + 46*F1P + 4); const f32x4 a2 = *(const LAS f32x4*)(f1p + 46*F1P + 8); float part = (a0.x * x0 + a0.z * x2 + a1.x * x4 + a1.z * x6 + a2.x * x8 + a2.z * x10) + (a0.y * x1 + a0.w * x3 + a1.y * x5 + a1.w * x7 + a2.y * x9 + a2.w * x11); part += dpp_mov<0xB1>(part); part += dpp_mov<0x4E>(part); const float xt = f0p[46*F0P] - part; x11 = (p == 2) ? xt : x11; }
        { const f32x4 a0 = *(const LAS f32x4*)(f1p + 47*F1P + 0); const f32x4 a1 = *(const LAS f32x4*)(f1p + 47*F1P + 4); const f32x4 a2 = *(const LAS f32x4*)(f1p + 47*F1P + 8); float part = (a0.x * x0 + a0.z * x2 + a1.x * x4 + a1.z * x6 + a2.x * x8 + a2.z * x10) + (a0.y * x1 + a0.w * x3 + a1.y * x5 + a1.w * x7 + a2.y * x9 + a2.w * x11); part += dpp_mov<0xB1>(part); part += dpp_mov<0x4E>(part); const float xt = f0p[47*F0P] - part; x11 = (p == 3) ? xt : x11; }
        { const f32x4 a0 = *(const LAS f32x4*)(f1p + 48*F1P + 0); const f32x4 a1 = *(const LAS f32x4*)(f1p + 48*F1P + 4); const f32x4 a2 = *(const LAS f32x4*)(f1p + 48*F1P + 8); float part = (a0.x * x0 + a0.z * x2 + a1.x * x4 + a1.z * x6 + a2.x * x8 + a2.z * x10) + (a0.y * x1 + a0.w * x3 + a1.y * x5 + a1.w * x7 + a2.y * x9 + a2.w * x11); part += dpp_mov<0xB1>(part); part += dpp_mov<0x4E>(part); const float xt = f0p[48*F0P] - part; x12 = (p == 0) ? xt : x12; }
        { const f32x4 a0 = *(const LAS f32x4*)(f1p + 49*F1P + 0); const f32x4 a1 = *(const LAS f32x4*)(f1p + 49*F1P + 4); const f32x4 a2 = *(const LAS f32x4*)(f1p + 49*F1P + 8); const f32x4 a3 = *(const LAS f32x4*)(f1p + 49*F1P + 12); float part = (a0.x * x0 + a0.z * x2 + a1.x * x4 + a1.z * x6 + a2.x * x8 + a2.z * x10 + a3.x * x12) + (a0.y * x1 + a0.w * x3 + a1.y * x5 + a1.w * x7 + a2.y * x9 + a2.w * x11); part += dpp_mov<0xB1>(part); part += dpp_mov<0x4E>(part); const float xt = f0p[49*F0P] - part; x12 = (p == 1) ? xt : x12; }
        { const f32x4 a0 = *(const LAS f32x4*)(f1p + 50*F1P + 0); const f32x4 a1 = *(const LAS f32x4*)(f1p + 50*F1P + 4); const f32x4 a2 = *(const LAS f32x4*)(f1p + 50*F1P + 8); const f32x4 a3 = *(const LAS f32x4*)(f1p + 50*F1P + 12); float part = (a0.x * x0 + a0.z * x2 + a1.x * x4 + a1.z * x6 + a2.x * x8 + a2.z * x10 + a3.x * x12) + (a0.y * x1 + a0.w * x3 + a1.y * x5 + a1.w * x7 + a2.y * x9 + a2.w * x11); part += dpp_mov<0xB1>(part); part += dpp_mov<0x4E>(part); const float xt = f0p[50*F0P] - part; x12 = (p == 2) ? xt : x12; }
        { const f32x4 a0 = *(const LAS f32x4*)(f1p + 51*F1P + 0); const f32x4 a1 = *(const LAS f32x4*)(f1p + 51*F1P + 4); const f32x4 a2 = *(const LAS f32x4*)(f1p + 51*F1P + 8); const f32x4 a3 = *(const LAS f32x4*)(f1p + 51*F1P + 12); float part = (a0.x * x0 + a0.z * x2 + a1.x * x4 + a1.z * x6 + a2.x * x8 + a2.z * x10 + a3.x * x12) + (a0.y * x1 + a0.w * x3 + a1.y * x5 + a1.w * x7 + a2.y * x9 + a2.w * x11); part += dpp_mov<0xB1>(part); part += dpp_mov<0x4E>(part); const float xt = f0p[51*F0P] - part; x12 = (p == 3) ? xt : x12; }
        { const f32x4 a0 = *(const LAS f32x4*)(f1p + 52*F1P + 0); const f32x4 a1 = *(const LAS f32x4*)(f1p + 52*F1P + 4); const f32x4 a2 = *(const LAS f32x4*)(f1p + 52*F1P + 8); const f32x4 a3 = *(const LAS f32x4*)(f1p + 52*F1P + 12); float part = (a0.x * x0 + a0.z * x2 + a1.x * x4 + a1.z * x6 + a2.x * x8 + a2.z * x10 + a3.x * x12) + (a0.y * x1 + a0.w * x3 + a1.y * x5 + a1.w * x7 + a2.y * x9 + a2.w * x11); part += dpp_mov<0xB1>(part); part += dpp_mov<0x4E>(part); const float xt = f0p[52*F0P] - part; x13 = (p == 0) ? xt : x13; }
        { const f32x4 a0 = *(const LAS f32x4*)(f1p + 53*F1P + 0); const f32x4 a1 = *(const LAS f32x4*)(f1p + 53*F1P + 4); const f32x4 a2 = *(const LAS f32x4*)(f1p + 53*F1P + 8); const f32x4 a3 = *(const LAS f32x4*)(f1p + 53*F1P + 12); float part = (a0.x * x0 + a0.z * x2 + a1.x * x4 + a1.z * x6 + a2.x * x8 + a2.z * x10 + a3.x * x12) + (a0.y * x1 + a0.w * x3 + a1.y * x5 + a1.w * x7 + a2.y * x9 + a2.w * x11 + a3.y * x13); part += dpp_mov<0xB1>(part); part += dpp_mov<0x4E>(part); const float xt = f0p[53*F0P] - part; x13 = (p == 1) ? xt : x13; }
        { const f32x4 a0 = *(const LAS f32x4*)(f1p + 54*F1P + 0); const f32x4 a1 = *(const LAS f32x4*)(f1p + 54*F1P + 4); const f32x4 a2 = *(const LAS f32x4*)(f1p + 54*F1P + 8); const f32x4 a3 = *(const LAS f32x4*)(f1p + 54*F1P + 12); float part = (a0.x * x0 + a0.z * x2 + a1.x * x4 + a1.z * x6 + a2.x * x8 + a2.z * x10 + a3.x * x12) + (a0.y * x1 + a0.w * x3 + a1.y * x5 + a1.w * x7 + a2.y * x9 + a2.w * x11 + a3.y * x13); part += dpp_mov<0xB1>(part); part += dpp_mov<0x4E>(part); const float xt = f0p[54*F0P] - part; x13 = (p == 2) ? xt : x13; }
        { const f32x4 a0 = *(const LAS f32x4*)(f1p + 55*F1P + 0); const f32x4 a1 = *(const LAS f32x4*)(f1p + 55*F1P + 4); const f32x4 a2 = *(const LAS f32x4*)(f1p + 55*F1P + 8); const f32x4 a3 = *(const LAS f32x4*)(f1p + 55*F1P + 12); float part = (a0.x * x0 + a0.z * x2 + a1.x * x4 + a1.z * x6 + a2.x * x8 + a2.z * x10 + a3.x * x12) + (a0.y * x1 + a0.w * x3 + a1.y * x5 + a1.w * x7 + a2.y * x9 + a2.w * x11 + a3.y * x13); part += dpp_mov<0xB1>(part); part += dpp_mov<0x4E>(part); const float xt = f0p[55*F0P] - part; x13 = (p == 3) ? xt : x13; }
        { const f32x4 a0 = *(const LAS f32x4*)(f1p + 56*F1P + 0); const f32x4 a1 = *(const LAS f32x4*)(f1p + 56*F1P + 4); const f32x4 a2 = *(const LAS f32x4*)(f1p + 56*F1P + 8); const f32x4 a3 = *(const LAS f32x4*)(f1p + 56*F1P + 12); float part = (a0.x * x0 + a0.z * x2 + a1.x * x4 + a1.z * x6 + a2.x * x8 + a2.z * x10 + a3.x * x12) + (a0.y * x1 + a0.w * x3 + a1.y * x5 + a1.w * x7 + a2.y * x9 + a2.w * x11 + a3.y * x13); part += dpp_mov<0xB1>(part); part += dpp_mov<0x4E>(part); const float xt = f0p[56*F0P] - part; x14 = (p == 0) ? xt : x14; }
        { const f32x4 a0 = *(const LAS f32x4*)(f1p + 57*F1P + 0); const f32x4 a1 = *(const LAS f32x4*)(f1p + 57*F1P + 4); const f32x4 a2 = *(const LAS f32x4*)(f1p + 57*F1P + 8); const f32x4 a3 = *(const LAS f32x4*)(f1p + 57*F1P + 12); float part = (a0.x * x0 + a0.z * x2 + a1.x * x4 + a1.z * x6 + a2.x * x8 + a2.z * x10 + a3.x * x12 + a3.z * x14) + (a0.y * x1 + a0.w * x3 + a1.y * x5 + a1.w * x7 + a2.y * x9 + a2.w * x11 + a3.y * x13); part += dpp_mov<0xB1>(part); part += dpp_mov<0x4E>(part); const float xt = f0p[57*F0P] - part; x14 = (p == 1) ? xt : x14; }
        { const f32x4 a0 = *(const LAS f32x4*)(f1p + 58*F1P + 0); const f32x4 a1 = *(const LAS f32x4*)(f1p + 58*F1P + 4); const f32x4 a2 = *(const LAS f32x4*)(f1p + 58*F1P + 8); const f32x4 a3 = *(const LAS f32x4*)(f1p + 58*F1P + 12); float part = (a0.x * x0 + a0.z * x2 + a1.x * x4 + a1.z * x6 + a2.x * x8 + a2.z * x10 + a3.x * x12 + a3.z * x14) + (a0.y * x1 + a0.w * x3 + a1.y * x5 + a1.w * x7 + a2.y * x9 + a2.w * x11 + a3.y * x13); part += dpp_mov<0xB1>(part); part += dpp_mov<0x4E>(part); const float xt = f0p[58*F0P] - part; x14 = (p == 2) ? xt : x14; }
        { const f32x4 a0 = *(const LAS f32x4*)(f1p + 59*F1P + 0); const f32x4 a1 = *(const LAS f32x4*)(f1p + 59*F1P + 4); const f32x4 a2 = *(const LAS f32x4*)(f1p + 59*F1P + 8); const f32x4 a3 = *(const LAS f32x4*)(f1p + 59*F1P + 12); float part = (a0.x * x0 + a0.z * x2 + a1.x * x4 + a1.z * x6 + a2.x * x8 + a2.z * x10 + a3.x * x12 + a3.z * x14) + (a0.y * x1 + a0.w * x3 + a1.y * x5 + a1.w * x7 + a2.y * x9 + a2.w * x11 + a3.y * x13); part += dpp_mov<0xB1>(part); part += dpp_mov<0x4E>(part); const float xt = f0p[59*F0P] - part; x14 = (p == 3) ? xt : x14; }
        { const f32x4 a0 = *(const LAS f32x4*)(f1p + 60*F1P + 0); const f32x4 a1 = *(const LAS f32x4*)(f1p + 60*F1P + 4); const f32x4 a2 = *(const LAS f32x4*)(f1p + 60*F1P + 8); const f32x4 a3 = *(const LAS f32x4*)(f1p + 60*F1P + 12); float part = (a0.x * x0 + a0.z * x2 + a1.x * x4 + a1.z * x6 + a2.x * x8 + a2.z * x10 + a3.x * x12 + a3.z * x14) + (a0.y * x1 + a0.w * x3 + a1.y * x5 + a1.w * x7 + a2.y * x9 + a2.w * x11 + a3.y * x13); part += dpp_mov<0xB1>(part); part += dpp_mov<0x4E>(part); const float xt = f0p[60*F0P] - part; x15 = (p == 0) ? xt : x15; }
        { const f32x4 a0 = *(const LAS f32x4*)(f1p + 61*F1P + 0); const f32x4 a1 = *(const LAS f32x4*)(f1p + 61*F1P + 4); const f32x4 a2 = *(const LAS f32x4*)(f1p + 61*F1P + 8); const f32x4 a3 = *(const LAS f32x4*)(f1p + 61*F1P + 12); float part = (a0.x * x0 + a0.z * x2 + a1.x * x4 + a1.z * x6 + a2.x * x8 + a2.z * x10 + a3.x * x12 + a3.z * x14) + (a0.y * x1 + a0.w * x3 + a1.y * x5 + a1.w * x7 + a2.y * x9 + a2.w * x11 + a3.y * x13 + a3.w * x15); part += dpp_mov<0xB1>(part); part += dpp_mov<0x4E>(part); const float xt = f0p[61*F0P] - part; x15 = (p == 1) ? xt : x15; }
        { const f32x4 a0 = *(const LAS f32x4*)(f1p + 62*F1P + 0); const f32x4 a1 = *(const LAS f32x4*)(f1p + 62*F1P + 4); const f32x4 a2 = *(const LAS f32x4*)(f1p + 62*F1P + 8); const f32x4 a3 = *(const LAS f32x4*)(f1p + 62*F1P + 12); float part = (a0.x * x0 + a0.z * x2 + a1.x * x4 + a1.z * x6 + a2.x * x8 + a2.z * x10 + a3.x * x12 + a3.z * x14) + (a0.y * x1 + a0.w * x3 + a1.y * x5 + a1.w * x7 + a2.y * x9 + a2.w * x11 + a3.y * x13 + a3.w * x15); part += dpp_mov<0xB1>(part); part += dpp_mov<0x4E>(part); const float xt = f0p[62*F0P] - part; x15 = (p == 2) ? xt : x15; }
        { const f32x4 a0 = *(const LAS f32x4*)(f1p + 63*F1P + 0); const f32x4 a1 = *(const LAS f32x4*)(f1p + 63*F1P + 4); const f32x4 a2 = *(const LAS f32x4*)(f1p + 63*F1P + 8); const f32x4 a3 = *(const LAS f32x4*)(f1p + 63*F1P + 12); float part = (a0.x * x0 + a0.z * x2 + a1.x * x4 + a1.z * x6 + a2.x * x8 + a2.z * x10 + a3.x * x12 + a3.z * x14) + (a0.y * x1 + a0.w * x3 + a1.y * x5 + a1.w * x7 + a2.y * x9 + a2.w * x11 + a3.y * x13 + a3.w * x15); part += dpp_mov<0xB1>(part); part += dpp_mov<0x4E>(part); const float xt = f0p[63*F0P] - part; x15 = (p == 3) ? xt : x15; }
        LAS unsigned char* dst = (wave < 4 ? B3 : B0) + (j & 63) * BLD + p * 2;
        *(LAS unsigned short*)(dst + 0) = (unsigned short)f2bf(-x0);
        *(LAS unsigned short*)(dst + 8) = (unsigned short)f2bf(-x1);
        *(LAS unsigned short*)(dst + 16) = (unsigned short)f2bf(-x2);
        *(LAS unsigned short*)(dst + 24) = (unsigned short)f2bf(-x3);
        *(LAS unsigned short*)(dst + 32) = (unsigned short)f2bf(-x4);
        *(LAS unsigned short*)(dst + 40) = (unsigned short)f2bf(-x5);
        *(LAS unsigned short*)(dst + 48) = (unsigned short)f2bf(-x6);
        *(LAS unsigned short*)(dst + 56) = (unsigned short)f2bf(-x7);
        *(LAS unsigned short*)(dst + 64) = (unsigned short)f2bf(-x8);
        *(LAS unsigned short*)(dst + 72) = (unsigned short)f2bf(-x9);
        *(LAS unsigned short*)(dst + 80) = (unsigned short)f2bf(-x10);
        *(LAS unsigned short*)(dst + 88) = (unsigned short)f2bf(-x11);
        *(LAS unsigned short*)(dst + 96) = (unsigned short)f2bf(-x12);
        *(LAS unsigned short*)(dst + 104) = (unsigned short)f2bf(-x13);
        *(LAS unsigned short*)(dst + 112) = (unsigned short)f2bf(-x14);
        *(LAS unsigned short*)(dst + 120) = (unsigned short)f2bf(-x15);
    }
    LDS_BAR();
    {
        f32x4 rpT[2], yl[2] = {z4, z4}, gT[2], hl[2] = {z4, z4};
#pragma unroll
        for (int c = 0; c < 2; ++c) { const int colx = 16 * (cb0 + c) + lc; rpT[c] = *(const LAS f32x4*)(F2 + colx * 64 + 16 * rb + 4 * g);
#pragma unroll
            for (int rg = 0; rg < 4; ++rg) { const int row = 16 * rb + 4 * g + rg; gT[c][rg] = row == colx ? GC[row] : 0.f; } }
#pragma unroll
        for (int ks = 0; ks < 2; ++ks) { const bf16x8 fnp = ldfrag(B3, rb, ks, lane), farb = ldfrag(B1, rb, ks, lane), fark = ldfrag(B2, rb, ks, lane), fbb = ldfrag(B6, rb, ks, lane), fkb = ldfrag(B5, rb, ks, lane);
#pragma unroll
            for (int c = 0; c < 2; ++c) { const bf16x8 carb = ldfrag(B1, cb0 + c, ks, lane), cbb = ldfrag(B6, cb0 + c, ks, lane), fq = ldfrag(B0, cb0 + c, ks, lane), fv = ldfrag(B4, cb0 + c, ks, lane);
                rpT[c] = MFMA16(fnp, carb, rpT[c]);
                gT[c] = MFMA16(fnp, cbb, gT[c]);
                yl[c] = MFMA16(fark, fv, yl[c]); yl[c] = MFMA16(farb, fq, yl[c]);
                hl[c] = MFMA16(fkb, fv, hl[c]); hl[c] = MFMA16(fbb, fq, hl[c]); } }
        bf16* RPg = (bf16*)(ws + SC_RP) + (size_t)unit * 4096; float* YLg = (float*)(ws + SC_YL) + (size_t)unit * 4096; bf16* Gg_ = (bf16*)(ws + SC_G) + (size_t)unit * 4096; float* HLg = (float*)(ws + SC_HL) + (size_t)unit * 4096;
#pragma unroll
        for (int c = 0; c < 2; ++c) { const int o = (16 * (cb0 + c) + lc) * 64 + 16 * rb + 4 * g;
            *(u32x2*)(RPg + o) = (u32x2){pk2(rpT[c][0], rpT[c][1]), pk2(rpT[c][2], rpT[c][3])};
            *(u32x2*)(Gg_ + o) = (u32x2){pk2(gT[c][0], gT[c][1]), pk2(gT[c][2], gT[c][3])};
            *(f32x4*)(HLg + o) = hl[c];
            *(f32x4*)(YLg + ((rb * 4 + cb0 + c) * 64 + lane) * 4) = yl[c]; }
    }
    }
#undef SA_LOAD
}

template <int NSTEP> __device__ __forceinline__ void scanB_chain(int l, LAS unsigned char* lds, int ci0, int h, int vs, const float* init, float* outp_state, int tid, int wave) {
    unsigned char* ws = KWS();
    const int lane = tid & 63, half = wave >> 2, jr = wave & 3, g = lane >> 4, lc = lane & 15;
    LAS unsigned char* XH = lds + half * 16384;
    const bf16* Gall = (const bf16*)(ws + SC_G); const float* HLall = (const float*)(ws + SC_HL); bf16* S0all = (bf16*)(ws + SC_S0);
    float zf; asm volatile("v_mov_b32 %0, 0" : "=v"(zf));
    f32x4 acc = (f32x4){zf, zf, zf, zf};
    __syncthreads();
    if (init) acc = *(const f32x4*)(init + (16 * vs + lc) * 64 + 16 * jr + 4 * g);
    constexpr int PF = NSTEP >= 16 ? 8 : 1;
    bf16x8 GA[PF][2], GB[PF][2]; f32x4 LA[PF], LB[PF];
#define SB_ISSUE(Gx, Lx, slot, c) do { const size_t unit_ = (size_t)(ci0 + (c)) * 16 + h; const bf16* Gp = Gall + unit_ * 4096 + (16 * jr + lc) * 64 + 8 * g; const float* Lp = HLall + unit_ * 4096 + (16 * vs + lc) * 64 + 16 * jr + 4 * g; \
        Gx[slot][0] = *(const bf16x8*)Gp; Gx[slot][1] = *(const bf16x8*)(Gp + 32); Lx[slot] = *(const f32x4*)Lp; } while (0)
#define SB_STEP(Gx, Lx, slot, c) do { const size_t unit = (size_t)(ci0 + (c)) * 16 + h; LAS unsigned char* xb = XH + ((c) & 1) * 8192; \
        const unsigned h0 = pk2(acc.x, acc.y), h1 = pk2(acc.z, acc.w); \
        const float l0 = acc.x - __builtin_bit_cast(float, h0 << 16), l1 = acc.y - __builtin_bit_cast(float, h0 & 0xffff0000u), l2 = acc.z - __builtin_bit_cast(float, h1 << 16), l3 = acc.w - __builtin_bit_cast(float, h1 & 0xffff0000u); \
        *(LAS u32x2*)(xb + lc * BLD + (16 * jr + 4 * g) * 2) = (u32x2){h0, h1}; \
        *(LAS u32x2*)(xb + 4096 + lc * BLD + (16 * jr + 4 * g) * 2) = (u32x2){pk2(l0, l1), pk2(l2, l3)}; \
        *(u32x2*)(S0all + unit * 4096 + (16 * vs + lc) * 64 + 16 * jr + 4 * g) = (u32x2){h0, h1};              \
        asm volatile("s_waitcnt lgkmcnt(0)" ::: "memory"); __builtin_amdgcn_s_barrier(); asm volatile("" ::: "memory");     \
        f32x4 a2 = Lx[slot]; \
        _Pragma("unroll") for (int ks = 0; ks < 2; ++ks) { const bf16x8 bh = *(const LAS bf16x8*)(xb + lc * BLD + (32 * ks + 8 * g) * 2), bl = *(const LAS bf16x8*)(xb + 4096 + lc * BLD + (32 * ks + 8 * g) * 2); \
            a2 = MFMA16(Gx[slot][ks], bh, a2); a2 = MFMA16(Gx[slot][ks], bl, a2); } \
        acc = a2; } while (0)
    if constexpr (NSTEP < 16) {
        for (int c = 0; c < NSTEP; ++c) { SB_ISSUE(GA, LA, 0, c); SB_STEP(GA, LA, 0, c); }
    } else {
        static_assert(NSTEP < 16 || NSTEP % 16 == 0, "pass B group structure");
#pragma unroll
        for (int s = 0; s < PF; ++s) SB_ISSUE(GA, LA, s, s);
        for (int c0 = 0; c0 < NSTEP; c0 += 16) {
            SB_STEP(GA, LA, 0, c0);
#pragma unroll
            for (int s = 0; s < PF; ++s) SB_ISSUE(GB, LB, s, c0 + 8 + s);
#pragma unroll
            for (int s = 1; s < PF; ++s) SB_STEP(GA, LA, s, c0 + s);
            SB_STEP(GB, LB, 0, c0 + 8);
            if (c0 + 16 < NSTEP) {
#pragma unroll
                for (int s = 0; s < PF; ++s) SB_ISSUE(GA, LA, s, c0 + 16 + s); }
#pragma unroll
            for (int s = 1; s < PF; ++s) SB_STEP(GB, LB, s, c0 + 8 + s);
        }
    }
    *(f32x4*)(outp_state + (16 * vs + lc) * 64 + 16 * jr + 4 * g) = acc;
#undef SB_ISSUE
#undef SB_STEP
}

template <int NSTEP> __device__ __forceinline__ void scanB_idle() { __syncthreads(); for (int c = 0; c < NSTEP; ++c) { asm volatile("" ::: "memory"); __builtin_amdgcn_s_barrier(); asm volatile("" ::: "memory"); } }

__device__ __forceinline__ void scanC_all(int l, LAS unsigned char* lds, int bx, int G, int tid, int wave) {
    unsigned char* ws = KWS();
    const int lane = tid & 63, rb = wave >> 1, cb0 = (wave & 1) * 2, g = lane >> 4, lc = lane & 15, t0 = 8 * wave;
    const float* ssh = KIN(I_SSH); const float* mu = KIN(I_MU) + (size_t)l * SHIFT; const float* gngp = KIN(I_GNG) + (size_t)l * RW; const float* gnbp = KIN(I_GNB) + (size_t)l * RW;
    const float* P = (const float*)(ws + B_P); const float* Gg = (const float*)(ws + WS_RW + 2 * RWSZ); bf16* MIXB = (bf16*)(ws + B_MIX);
    LAS float* Yl = (LAS float*)lds;
    f32x4 acc[2]; bf16x8 fa[2], fb[2][2]; float pv_[8], gt_[8], bn_[8], q_v, mu_v, gng, gnb;
#define SC_LOAD_A(unit_) do { const bf16* RPg = (const bf16*)(ws + SC_RP) + (size_t)(unit_) * 4096; const float* YLg = (const float*)(ws + SC_YL) + (size_t)(unit_) * 4096; const bf16* S0g = (const bf16*)(ws + SC_S0) + (size_t)(unit_) * 4096; \
        _Pragma("unroll") for (int c = 0; c < 2; ++c) acc[c] = *(const f32x4*)(YLg + ((rb * 4 + cb0 + c) * 64 + lane) * 4); \
        _Pragma("unroll") for (int ks = 0; ks < 2; ++ks) { fa[ks] = *(const bf16x8*)(RPg + (16 * rb + lc) * 64 + 32 * ks + 8 * g); _Pragma("unroll") for (int c = 0; c < 2; ++c) fb[ks][c] = *(const bf16x8*)(S0g + (16 * (cb0 + c) + lc) * 64 + 32 * ks + 8 * g); } } while (0)
#define SC_LOAD_B(unit_) do { const int ci_ = (unit_) >> 4, cc_ = 64 * ((unit_) & 15) + lane; const int m0_ = ci_ < 256 ? 64 * ci_ : TP + 32 * (ci_ - 256), n_ = ci_ < 256 ? 64 : 32; const float* bon_ = (const float*)(ws + SC_BON) + (size_t)(unit_) * 64; \
        mu_v = mu[2 * RW + cc_]; gng = gngp[cc_]; gnb = gnbp[cc_]; q_v = 0.f; \
        _Pragma("unroll") for (int i = 0; i < 8; ++i) { pv_[i] = 0.f; gt_[i] = 0.f; bn_[i] = 0.f; } \
        if (t0 < n_) { const float* pp_ = prev_row(ssh, l, P, m0_ + t0); if (pp_) q_v = pp_[2 * RW + cc_]; \
            _Pragma("unroll") for (int i = 0; i < 8; ++i) { const size_t m_ = (size_t)(m0_ + t0 + i); pv_[i] = P[m_ * PLD + 2 * RW + cc_]; gt_[i] = Gg[m_ * RW + cc_]; bn_[i] = bon_[t0 + i]; } } } while (0)
    if (bx < NUNIT) { SC_LOAD_A(bx); SC_LOAD_B(bx); }
    for (int unit = bx; unit < NUNIT; unit += G) {
        const int ci = unit >> 4, cc = 64 * (unit & 15) + lane; const int m0 = ci < 256 ? 64 * ci : TP + 32 * (ci - 256), n = ci < 256 ? 64 : 32;
        f32x4 y2[2] = {acc[0], acc[1]};
#pragma unroll
        for (int ks = 0; ks < 2; ++ks)
#pragma unroll
            for (int c = 0; c < 2; ++c) y2[c] = MFMA16(fa[ks], fb[ks][c], y2[c]);
        if (unit + G < NUNIT) SC_LOAD_A(unit + G);
        LDS_BAR();
#pragma unroll
        for (int c = 0; c < 2; ++c)
#pragma unroll
            for (int rg = 0; rg < 4; ++rg) Yl[(16 * rb + 4 * g + rg) * 65 + 16 * (cb0 + c) + lc] = y2[c][rg];
        LDS_BAR();
        unsigned short ov[8];
        if (t0 < n) {
            float qv = q_v;
#pragma unroll
            for (int i = 0; i < 8; ++i) { const int t = t0 + i;
                const float y = Yl[t * 65 + lane]; const float ym = wave_sum(y) * (1.f / HN); const float d = y - ym; const float yv = wave_sum(d * d) * (1.f / HN);
                const float yn = d * (1.f / sqrtf(yv + GN_EPS)) * gng + gnb;
                const float p_v = pv_[i]; const float vx = p_v + (qv - p_v) * mu_v; qv = p_v;
                ov[i] = (unsigned short)f2bf((yn + bn_[i] * vx) * gt_[i]); }
        }
        if (unit + G < NUNIT) SC_LOAD_B(unit + G);
        if (t0 < n) {
#pragma unroll
            for (int i = 0; i < 8; ++i) MIXB[(size_t)(m0 + t0 + i) * DM + cc] = (bf16)ov[i];
        }
    }
#undef SC_LOAD_A
#undef SC_LOAD_B
}

template <int PH> __global__ void __launch_bounds__(NTHR, 2) mk_fwd(Args a) {
    extern __shared__ __attribute__((aligned(16))) unsigned char lds_raw[];
    LAS unsigned char* lds = (LAS unsigned char*)lds_raw;
    const int wave_s = __builtin_amdgcn_readfirstlane((int)threadIdx.x >> 6);
    for (int u = threadIdx.x; u < (LDS_BYTES - LDSCTL_OFF) / 4; u += NTHR) ((LAS unsigned*)(lds + LDSCTL_OFF))[u] = 0u;
    __syncthreads();
    if (PH < 0) (void)xcd_barrier_post((unsigned*)KWS() + CW_BAR, (volatile LAS unsigned*)(lds + MISC_OFF) + 8, (int)threadIdx.x);
#define IN(k) (PH < 0 || PH == (k))
#define PHASE_IDS() int tid_; asm volatile("v_mbcnt_lo_u32_b32 %0, -1, 0\n\tv_mbcnt_hi_u32_b32 %0, -1, %0\n\tv_lshl_add_u32 %0, %1, 6, %0" : "=&v"(tid_) : "s"(wave_s)); const int tid = tid_, lane = tid & 63, wave = wave_s; \
    const int G = gridDim.x, bx = blockIdx.x, vcu = (G % 8 == 0) ? (bx % 8) * (G / 8) + bx / 8 : bx, gw = vcu * NWAVES + wave, NGW = G * NWAVES; unsigned char* ws = KWS(); (void)tid; (void)lane; (void)gw; (void)NGW; (void)ws
#define SEAM() do { if (PH < 0) { XcdBarrier bar_; bar_.bar = (unsigned*)KWS() + CW_BAR; bar_.x = xb_xcc_id(); bar_.st = (volatile LAS unsigned*)(lds + MISC_OFF) + 8; xcd_barrier(bar_, tid); } } while (0)

    for (int l = a.l_lo; l < a.l_hi; ++l) {
        const int par = l & 1;
        if (IN(0) && (PH >= 0 || l == a.l_lo)) { PHASE_IDS(); phase_convert(l, par, 0, CV_NTASK, true, l == 0, lane, gw, NGW); SEAM(); }
#define CVT_TAIL(nwg, t_lo, t_hi, small) do { if (PH < 0 && l + 1 < a.l_hi) { const int rounds_ = ((nwg) + G - 1) / G, first_ = (nwg) - (rounds_ - 1) * G; \
            if (first_ < G && bx >= first_) phase_convert(l + 1, par ^ 1, (t_lo), (t_hi), (small), false, lane, (bx - first_) * NWAVES + wave, (G - first_) * NWAVES); } } while (0)
        constexpr int CV_A = (CV_NTASK * 2) / 5, CV_B = (CV_NTASK * 11) / 20;
        if (IN(1)) { PHASE_IDS(); pg8::Gemm g{(const bf16*)(ws + B_XB8), (const bf16*)(ws + wofs(1, par)), M, 2 * FF, DM, DM}; pg8::StaticOrder S; S.init(M, 2 * FF, G, bx); pg8::EpiSwiGLU8 E{ws + B_H, FF};
            pg8::gemm_phase<pg8::EpiSwiGLU8, pg8::StaticOrder, true, true, (121 << 8) | 127>(lds + RING_OFF, g, S, E, tid); CVT_TAIL((M / 256) * (2 * FF / 256), 0, CV_A, false); SEAM(); }
        if (IN(2)) { PHASE_IDS();
            { pg8::Gemm g{(const bf16*)(ws + B_H), (const bf16*)(ws + wofs(2, par)), TP, DM, FF, FF}; pg8::StaticOrder S; S.init(TP, DM, G, bx); pg8::EpiResid E{(const bf16*)(ws + WS_XB), (float*)(ws + WS_Z), DM, ALPHA, 0.5f};
              pg8::gemm_phase<pg8::EpiResid, pg8::StaticOrder, true, true, (121 << 8) | 125>(lds + RING_OFF, g, S, E, tid); }
            { pg8::Gemm g{(const bf16*)(ws + B_H), (const bf16*)(ws + wofs(2, par)), M, DM, FF, 512}; pg8::SplitOrder S{G, bx, 11, 512}; pg8::EpiSlab E{(float*)(ws + WS_SLAB), 512};
              pg8::gemm_phase<pg8::EpiSlab, pg8::SplitOrder, false, true, (121 << 8) | 125>(lds + RING_OFF, g, S, E, tid); }
            SEAM(); }
        if (IN(3)) { PHASE_IDS(); phase_ln((const float*)(ws + WS_Z), (const float*)(ws + WS_X), (const float*)(ws + WS_SLAB), 11, ALPHA, 0.5f, KIN(I_LNG) + (size_t)l * 3 * DM, KIN(I_LNB) + (size_t)l * 3 * DM, (float*)(ws + WS_X), (bf16*)(ws + WS_XB), (unsigned char*)nullptr, false, lane, gw, NGW); SEAM(); }
        if (IN(4)) { PHASE_IDS(); pg8::Gemm g{(const bf16*)(ws + WS_XB), (const bf16*)(ws + wofs(3, par)), M, N3, DM, DM}; pg8::StaticOrder S; S.init(M, N3, G, bx); pg8::EpiP E{(float*)(ws + B_P), (bf16*)(ws + B_U), (float*)(ws + B_GV)};
            pg8::gemm_phase<pg8::EpiP, pg8::StaticOrder, true, true>(lds + RING_OFF, g, S, E, tid); CVT_TAIL((M / 256) * (N3 / 256), CV_A, CV_B, true); SEAM(); }
        if (IN(5)) { PHASE_IDS(); phase_prep1(l, lane, gw, NGW); SEAM(); }
        if (IN(6)) { PHASE_IDS(); pg8::Gemm g{(const bf16*)(ws + B_A3B), (const bf16*)(ws + wofs(7, par)), M, NL, LK, LK}; pg8::StaticOrder S; S.init(M, NL, G, bx);
            pg8::EpiLora E{(float*)(ws + WS_RW)};
            pg8::gemm_phase<pg8::EpiLora, pg8::StaticOrder, false, false>(lds + RING_OFF, g, S, E, tid); SEAM(); }
        if (IN(7)) { PHASE_IDS(); scanA_all(l, lds, bx, G, tid, wave); SEAM(); }
        if (IN(8)) { PHASE_IDS();
            if (bx < 64) { const int hh = bx >> 2; if (wave < 4) scanB_chain<256>(l, lds, 0, hh, bx & 3, nullptr, KOUT() + O_SP + ((size_t)l * NH + hh) * 4096, tid, wave); else scanB_idle<256>(); }
            else { const float* srw = KIN(I_SRW); float* outp = KOUT();
                for (int p = bx - 64; p < 512; p += G - 64) { const int task = 2 * p + (wave >> 2), b = task >> 6, hh = (task >> 2) & 15; const size_t so = (((size_t)l * NSB + b) * NH + hh) * 4096;
                    scanB_chain<1>(l, lds, 256 + b, hh, task & 3, srw + so, outp + O_SS + so, tid, wave); }
                for (int u = bx - 64; u < 144 * 8; u += G - 64) gmlp_unit(l, lds, u, tid, wave); }
            SEAM(); }
        if (IN(9)) { PHASE_IDS(); scanC_all(l, lds, bx, G, tid, wave); SEAM(); }
        if (IN(10)) { PHASE_IDS();
            { pg8::Gemm g{(const bf16*)(ws + B_MIX), (const bf16*)(ws + wofs(4, par)), TP, DM, DM, DM}; pg8::StaticOrder S; S.init(TP, DM, G, bx); pg8::EpiResid E{(const bf16*)(ws + WS_XB), (float*)(ws + WS_Z), DM, ALPHA, 1.0f};
              pg8::gemm_phase<pg8::EpiResid, pg8::StaticOrder, true, true>(lds + RING_OFF, g, S, E, tid); }
            { pg8::Gemm g{(const bf16*)(ws + B_MIX), (const bf16*)(ws + wofs(4, par)), M, DM, DM, 256}; pg8::SplitOrder S{G, bx, 8, 256}; pg8::EpiSlab E{(float*)(ws + WS_SLAB), 256};
              pg8::gemm_phase<pg8::EpiSlab, pg8::SplitOrder, false, true>(lds + RING_OFF, g, S, E, tid); }
            SEAM(); }
        if (IN(11)) { PHASE_IDS(); phase_ln((const float*)(ws + WS_Z), (const float*)(ws + WS_X), (const float*)(ws + WS_SLAB), 8, ALPHA, 1.0f, KIN(I_LNG) + (size_t)(l * 3 + 1) * DM, KIN(I_LNB) + (size_t)(l * 3 + 1) * DM, (float*)(ws + WS_X), (bf16*)(ws + WS_XB), ws + B_XB8, false, lane, gw, NGW); SEAM(); }
        if (IN(12)) { PHASE_IDS(); pg8::Gemm g{(const bf16*)(ws + B_XB8), (const bf16*)(ws + wofs(5, par)), M, 2 * FF, DM, DM}; pg8::StaticOrder S; S.init(M, 2 * FF, G, bx); pg8::EpiSwiGLU8 E{ws + B_H, FF};
            pg8::gemm_phase<pg8::EpiSwiGLU8, pg8::StaticOrder, true, true, (121 << 8) | 127>(lds + RING_OFF, g, S, E, tid); CVT_TAIL((M / 256) * (2 * FF / 256), CV_B, CV_NTASK, false); SEAM(); }
        if (IN(13)) { PHASE_IDS();
            { pg8::Gemm g{(const bf16*)(ws + B_H), (const bf16*)(ws + wofs(6, par)), TP, DM, FF, FF}; pg8::StaticOrder S; S.init(TP, DM, G, bx); pg8::EpiResid E{(const bf16*)(ws + WS_XB), (float*)(ws + WS_Z), DM, ALPHA, 0.5f};
              pg8::gemm_phase<pg8::EpiResid, pg8::StaticOrder, true, true, (121 << 8) | 125>(lds + RING_OFF, g, S, E, tid); }
            { pg8::Gemm g{(const bf16*)(ws + B_H), (const bf16*)(ws + wofs(6, par)), M, DM, FF, 512}; pg8::SplitOrder S{G, bx, 11, 512}; pg8::EpiSlab E{(float*)(ws + WS_SLAB), 512};
              pg8::gemm_phase<pg8::EpiSlab, pg8::SplitOrder, false, true, (121 << 8) | 125>(lds + RING_OFF, g, S, E, tid); }
            SEAM(); }
        if (IN(14)) { PHASE_IDS(); const bool last = (l == DEPTH - 1);
            phase_ln((const float*)(ws + WS_Z), (const float*)(ws + WS_X), (const float*)(ws + WS_SLAB), 11, ALPHA, 0.5f, KIN(I_LNG) + (size_t)(l * 3 + 2) * DM, KIN(I_LNB) + (size_t)(l * 3 + 2) * DM, last ? KOUT() + O_YP : (float*)(ws + WS_X), last ? (bf16*)nullptr : (bf16*)(ws + WS_XB), last ? (unsigned char*)nullptr : ws + B_XB8, last, lane, gw, NGW);
            if (!last) SEAM(); }
    }
#undef IN
#undef CVT_TAIL
#undef SEAM
#undef PHASE_IDS
}

template <int PH> static bool prep_kernel() { return hipFuncSetAttribute((const void*)mk_fwd<PH>, hipFuncAttributeMaxDynamicSharedMemorySize, LDS_BYTES) == hipSuccess; }
template <int PH> static void launch_phase(int grid, hipStream_t stream, Args a) { hipLaunchKernelGGL(mk_fwd<PH>, dim3(grid), dim3(NTHR), LDS_BYTES, stream, a); }
extern "C" void kernel_launch(void* const* d_in, const int* in_sizes, int n_in, void* d_out, int out_size, void* d_ws, size_t ws_size, hipStream_t stream) {
    static int grid = 0;
    if (grid == 0) {
        if (n_in != 29 || (size_t)out_size != O_END || ws_size < WS_TOP) { fprintf(stderr, "kernel_launch: unexpected shapes: n_in %d out %d ws %zu (need %zu)\n", n_in, out_size, ws_size, (size_t)WS_TOP); grid = -1; return; }
        int dev = 0, cus = 0, per_cu = 0;
        if (hipGetDevice(&dev) != hipSuccess || hipDeviceGetAttribute(&cus, hipDeviceAttributeMultiprocessorCount, dev) != hipSuccess) { grid = -1; return; }
        bool ok = true;
#if MK_ONE_LAUNCH
        ok = prep_kernel<-1>();
        if (hipOccupancyMaxActiveBlocksPerMultiprocessor(&per_cu, (const void*)mk_fwd<-1>, NTHR, LDS_BYTES) != hipSuccess || per_cu < 1) fprintf(stderr, "kernel_launch: occupancy query says %d\n", per_cu);
#else
        ok = prep_kernel<0>() && prep_kernel<1>() && prep_kernel<2>() && prep_kernel<3>() && prep_kernel<4>() && prep_kernel<5>() && prep_kernel<6>() && prep_kernel<7>() && prep_kernel<8>() && prep_kernel<9>() && prep_kernel<10>() && prep_kernel<11>() && prep_kernel<12>() && prep_kernel<13>() && prep_kernel<14>();
#endif
        if (!ok) { fprintf(stderr, "kernel_launch: hipFuncSetAttribute failed\n"); grid = -1; return; }
        (void)hipGetLastError();
        grid = cus;
        if (grid < 64) { grid = -1; return; }
    }
    if (grid < 0) return;
    (void)hipMemsetAsync((char*)d_ws + WS_CTL, 0, CTL_ZERO_BYTES, stream);
    Args a{};
    for (int i = 0; i < 29; ++i) a.in[i] = (const float*)d_in[i];
    a.out = (float*)d_out; a.ws = (unsigned char*)d_ws;
#if MK_ONE_LAUNCH
    a.l_lo = 0; a.l_hi = DEPTH;
    launch_phase<-1>(grid, stream, a);
#else
    for (int l = 0; l < DEPTH; ++l) { a.l_lo = l; a.l_hi = l + 1;
        launch_phase<0>(grid, stream, a); launch_phase<1>(grid, stream, a); launch_phase<2>(grid, stream, a); launch_phase<3>(grid, stream, a); launch_phase<4>(grid, stream, a);
        launch_phase<5>(grid, stream, a); launch_phase<6>(grid, stream, a); launch_phase<7>(grid, stream, a); launch_phase<8>(grid, stream, a); launch_phase<9>(grid, stream, a);
        launch_phase<10>(grid, stream, a); launch_phase<11>(grid, stream, a); launch_phase<12>(grid, stream, a); launch_phase<13>(grid, stream, a); launch_phase<14>(grid, stream, a); }
#endif
}
```

```cpp
#include <hip/hip_runtime.h>
#include <cstdio>
#include <cstdint>
#define MK_ONE_LAUNCH 1
namespace pg8 {
#define PG8_LAS __attribute__((address_space(3)))
typedef unsigned short bf16_t;
typedef short bf16x8 __attribute__((ext_vector_type(8)));
typedef float f32x4 __attribute__((ext_vector_type(4)));
typedef unsigned u32x4 __attribute__((ext_vector_type(4)));
constexpr int BM = 256, BK = 64, HALF = 128, HTB = HALF * BK * 2  , STAGE_BYTES = 8 * HTB, NXCD = 8, WGM = 8;

__host__ __device__ __forceinline__ int lds_byte(int r, int c) { const int st = (r >> 4) * 2 + (c >> 5), rr = r & 15, cc = c & 31, ob = rr * 64 + cc * 2; return st * 1024 + (ob ^ (((ob >> 9) & 1) << 5)); }
__host__ __device__ __forceinline__ void stage_rc(int b, int& R, int& C) { const int st = b / 1024, sb = b % 1024, swz = sb ^ (((sb >> 9) & 1) << 5); R = (st >> 1) * 16 + swz / 64; C = (st & 1) * 32 + (swz % 64) / 2; }
__host__ __device__ __forceinline__ int perm32(int rho) { const int n = rho >> 4, i = rho & 15; return 8 * (i >> 2) + 4 * n + (i & 3); }

struct Unit { int pm, pn, k0; };
struct Gemm { const bf16_t* A; const bf16_t* Bt; int M, N, K, Kl; };

struct StaticOrder {
    int nM, nN, nwg, G, c;
    __host__ __device__ void init(int M, int N, int G_, int c_) { nM = M / BM; nN = N / BM; nwg = nM * nN; G = G_; c = c_; }
    __host__ __device__ bool next(int i, Unit& u) const {
        const long L = (long)i * G + c; if (L >= nwg) return false;
        int wgid = (int)L; { const int q = nwg / NXCD, r = nwg % NXCD, xcd = wgid % NXCD, off = wgid / NXCD; wgid = (xcd < r ? xcd * (q + 1) : r * (q + 1) + (xcd - r) * q) + off; }
        const int nig = WGM * nN, gid = wgid / nig, fm = gid * WGM, gsz = (nM - fm) < WGM ? (nM - fm) : WGM;
        u.pm = fm + ((wgid % nig) % gsz); u.pn = (wgid % nig) / gsz; u.k0 = 0; return true;
    }
    __device__ __forceinline__ void a_ready(const Unit&) const {}
    __device__ __forceinline__ void done(const Unit&) const {}
};
struct SplitOrder {
    int G, c, KS, Kl;
    __host__ __device__ bool next(int i, Unit& u) const { const int L = i * G + c; if (L >= 16 * KS) return false; const int ks = L >> 4, tile = L & 15; u.pm = 64 + (tile >> 3); u.pn = tile & 7; u.k0 = ks * Kl; return true; }
    __device__ __forceinline__ void a_ready(const Unit&) const {}
    __device__ __forceinline__ void done(const Unit&) const {}
};
__device__ __forceinline__ unsigned cvt_pk_bf16(float lo, float hi) { unsigned r; asm volatile("v_cvt_pk_bf16_f32 %0, %1, %2" : "=v"(r) : "v"(lo), "v"(hi)); return r; }
typedef float f32x2 __attribute__((ext_vector_type(2)));
__device__ __forceinline__ f32x2 gelu_pk(f32x2 v) {
    const f32x2 av = __builtin_elementwise_abs(v), d = av * 0.2316418882f + 1.0f;
    f32x2 t; t.x = __builtin_amdgcn_rcpf(d.x); t.y = __builtin_amdgcn_rcpf(d.y);
    f32x2 q = t * 0.5307027145f + (-0.7265760135f); q = q * t + 0.7107068705f; q = q * t + (-0.142248368f); q = q * t + 0.127414796f; q = q * t;
    const f32x2 s = (v * v) * (-0.72134752044f);
    f32x2 e; e.x = __builtin_amdgcn_exp2f(s.x); e.y = __builtin_amdgcn_exp2f(s.y);
    const f32x2 m = v * (q * e), r = v - m;
    f32x2 o; o.x = v.x < 0.f ? m.x : r.x; o.y = v.y < 0.f ? m.y : r.y; return o;
}

typedef unsigned u32x2 __attribute__((ext_vector_type(2)));
__device__ __forceinline__ float silu_f(float g) { return g * __builtin_amdgcn_rcpf(1.0f + __expf(-g)); }
struct EpiSwiGLU {
    static constexpr bool PERM = true, AFTER_DRAIN = false;
    bf16_t* O; int ldc;
    __device__ __forceinline__ void operator()(const f32x4 (&acc)[2][2][4][2], const Unit& u, int wr, int wc, int fr, int fq) const {
        const int row0 = u.pm * BM + wr * 64 + fr, col0 = u.pn * HALF + wc * 32 + 8 * fq;
#pragma unroll
        for (int ai = 0; ai < 2; ++ai)
#pragma unroll
            for (int m = 0; m < 4; ++m) { bf16_t* rowp = O + (size_t)(row0 + ai * HALF + m * 16) * ldc + col0;
                const f32x4 g0 = acc[ai][0][m][0], g1 = acc[ai][0][m][1], u0 = acc[ai][1][m][0], u1 = acc[ai][1][m][1];
                u32x4 w; w.x = cvt_pk_bf16(silu_f(g0[0]) * u0[0], silu_f(g0[1]) * u0[1]); w.y = cvt_pk_bf16(silu_f(g0[2]) * u0[2], silu_f(g0[3]) * u0[3]);
                w.z = cvt_pk_bf16(silu_f(g1[0]) * u1[0], silu_f(g1[1]) * u1[1]); w.w = cvt_pk_bf16(silu_f(g1[2]) * u1[2], silu_f(g1[3]) * u1[3]);
                *(u32x4*)rowp = w; }
    }
};
struct EpiSwiGLU8 {
    static constexpr bool PERM = true, AFTER_DRAIN = false;
    unsigned char* O; int ldc;
    __device__ __forceinline__ void operator()(const f32x4 (&acc)[2][2][4][2], const Unit& u, int wr, int wc, int fr, int fq) const {
        const int row0 = u.pm * BM + wr * 64 + fr, col0 = u.pn * HALF + wc * 32 + 8 * fq;
#pragma unroll
        for (int ai = 0; ai < 2; ++ai)
#pragma unroll
            for (int m = 0; m < 4; ++m) { unsigned char* rowp = O + (size_t)(row0 + ai * HALF + m * 16) * ldc + col0;
                const f32x4 g0 = acc[ai][0][m][0], g1 = acc[ai][0][m][1], u0 = acc[ai][1][m][0] * 4.0f, u1 = acc[ai][1][m][1] * 4.0f;
                unsigned w0 = 0u, w1 = 0u;
                w0 = __builtin_amdgcn_cvt_pk_fp8_f32(silu_f(g0[0]) * u0[0], silu_f(g0[1]) * u0[1], w0, false); w0 = __builtin_amdgcn_cvt_pk_fp8_f32(silu_f(g0[2]) * u0[2], silu_f(g0[3]) * u0[3], w0, true);
                w1 = __builtin_amdgcn_cvt_pk_fp8_f32(silu_f(g1[0]) * u1[0], silu_f(g1[1]) * u1[1], w1, false); w1 = __builtin_amdgcn_cvt_pk_fp8_f32(silu_f(g1[2]) * u1[2], silu_f(g1[3]) * u1[3], w1, true);
                *(u32x2*)rowp = (u32x2){w0, w1}; }
    }
};
struct EpiResid {
    static constexpr bool PERM = false, AFTER_DRAIN = false;
    const bf16_t* base; float* out; int ldc; float sa, sb;
    __device__ __forceinline__ void operator()(const f32x4 (&acc)[2][2][4][2], const Unit& u, int wr, int wc, int fr, int fq) const {
        const int row0 = u.pm * BM + wr * 64 + fr, col0 = u.pn * BM + wc * 32 + 4 * fq;
#pragma unroll
        for (int ai = 0; ai < 2; ++ai)
#pragma unroll
            for (int m = 0; m < 4; ++m) { const size_t off = (size_t)(row0 + ai * HALF + m * 16) * ldc + col0;
#pragma unroll
                for (int bj = 0; bj < 2; ++bj)
#pragma unroll
                    for (int n = 0; n < 2; ++n) { const u32x2 bb = *(const u32x2*)(base + off + bj * HALF + n * 16);
                        const f32x4 b = (f32x4){__builtin_bit_cast(float, bb.x << 16), __builtin_bit_cast(float, bb.x & 0xffff0000u), __builtin_bit_cast(float, bb.y << 16), __builtin_bit_cast(float, bb.y & 0xffff0000u)};
                        *(f32x4*)(out + off + bj * HALF + n * 16) = b * sa + acc[ai][bj][m][n] * sb; } }
    }
};
struct EpiSlab {
    static constexpr bool PERM = false, AFTER_DRAIN = false;
    float* slab; int Kl;
    __device__ __forceinline__ void operator()(const f32x4 (&acc)[2][2][4][2], const Unit& u, int wr, int wc, int fr, int fq) const {
        const int row0 = (u.pm - 64) * BM + wr * 64 + fr, col0 = u.pn * BM + wc * 32 + 4 * fq; float* O = slab + (size_t)(u.k0 / Kl) * (512 * 2048);
#pragma unroll
        for (int ai = 0; ai < 2; ++ai)
#pragma unroll
            for (int m = 0; m < 4; ++m) { float* rowp = O + (size_t)(row0 + ai * HALF + m * 16) * 2048 + col0;
#pragma unroll
                for (int bj = 0; bj < 2; ++bj)
#pragma unroll
                    for (int n = 0; n < 2; ++n) *(f32x4*)(rowp + bj * HALF + n * 16) = acc[ai][bj][m][n]; }
    }
};
struct EpiP {
    static constexpr bool PERM = false, AFTER_DRAIN = false;
    float* P; bf16_t* U; float* GV;
    __device__ __forceinline__ void operator()(const f32x4 (&acc)[2][2][4][2], const Unit& u, int wr, int wc, int fr, int fq) const {
        const int row0 = u.pm * BM + wr * 64 + fr, cw = wc * 32 + 4 * fq;
        const int kind = u.pn < 14 ? 0 : (u.pn < 18 ? 1 : 2);
        float* F = kind == 0 ? P + u.pn * BM + cw : GV + (u.pn - 18) * BM + cw; const int ldf = kind == 0 ? 3584 : 1024;
        bf16_t* Ub = U + (u.pn - 14) * BM + cw;
#pragma unroll
        for (int ai = 0; ai < 2; ++ai)
#pragma unroll
            for (int m = 0; m < 4; ++m) { const size_t row = (size_t)(row0 + ai * HALF + m * 16);
#pragma unroll
                for (int bj = 0; bj < 2; ++bj)
#pragma unroll
                    for (int n = 0; n < 2; ++n) { f32x4 v = acc[ai][bj][m][n];
                        if (kind != 0) { const f32x2 a = gelu_pk((f32x2){v[0], v[1]}), b = gelu_pk((f32x2){v[2], v[3]}); v = (f32x4){a.x, a.y, b.x, b.y}; }
                        if (kind == 1) { u32x2 w; w.x = cvt_pk_bf16(v[0], v[1]); w.y = cvt_pk_bf16(v[2], v[3]); *(u32x2*)(Ub + row * 1024 + bj * HALF + n * 16) = w; }
                        else *(f32x4*)(F + row * ldf + bj * HALF + n * 16) = v; }
                asm volatile("" ::: "memory"); }
    }
};
struct EpiLora {
    static constexpr bool PERM = false, AFTER_DRAIN = false;
    float* base;
    __device__ __forceinline__ void operator()(const f32x4 (&acc)[2][2][4][2], const Unit& u, int wr, int wc, int fr, int fq) const {
        const int row0 = u.pm * BM + wr * 64 + fr, kind = u.pn >> 2, cb = (u.pn & 3) * BM + wc * 32 + 4 * fq;
        float* O = base + (size_t)kind * ((size_t)66 << 18) + cb;
#pragma unroll
        for (int ai = 0; ai < 2; ++ai)
#pragma unroll
            for (int m = 0; m < 4; ++m) { float* rowp = O + (size_t)(row0 + ai * HALF + m * 16) * 1024;
#pragma unroll
                for (int bj = 0; bj < 2; ++bj)
#pragma unroll
                    for (int n = 0; n < 2; ++n) *(f32x4*)(rowp + bj * HALF + n * 16) = acc[ai][bj][m][n]; }
    }
};
typedef int pg8_v4i __attribute__((ext_vector_type(4))); typedef int pg8_v8i __attribute__((ext_vector_type(8)));
__device__ __forceinline__ pg8_v8i cat8(bf16x8 a, bf16x8 b) { const pg8_v4i x = __builtin_bit_cast(pg8_v4i, a), y = __builtin_bit_cast(pg8_v4i, b); return __builtin_shufflevector(x, y, 0, 1, 2, 3, 4, 5, 6, 7); }
template <class Epi, class Sched, bool ALIGN_EPI = false, bool SP2 = false, int F8 = 0>
__device__ __forceinline__ void gemm_phase(PG8_LAS unsigned char* lds, const Gemm g, const Sched& S, const Epi& E, int tid_in) {
    int tid_ = tid_in; asm volatile("" : "+v"(tid_));
    const int tid = tid_, wid = __builtin_amdgcn_readfirstlane(tid >> 6), lane = tid & 63, wr = wid >> 2, wc = wid & 3, fr = lane & 15, fq = lane >> 4;
    constexpr int ES = F8 ? 1 : 2;
    const int K = g.K, nt = g.Kl / (F8 ? 2 * BK : BK);
    unsigned voffA[2], voffB[2];
#pragma unroll
    for (int i = 0; i < 2; ++i) { int R, C; stage_rc(tid * 16 + i * 8192, R, C); const int Rb = Epi::PERM ? ((R & ~31) + perm32(R & 31)) : R;
        voffA[i] = (unsigned)(R * K * ES + C * 2); voffB[i] = (unsigned)(Rb * K * ES + C * 2); }
    const size_t kstep = (size_t)(BK * 2);
    const size_t hstep = (size_t)HALF * K * ES;
    const size_t tstep = 2 * hstep;
    const unsigned ldsw = (unsigned)wid * 1024u;
    const int aoff = lds_byte(wr * 64 + fr, fq * 8), boff = lds_byte(wc * 32 + fr, fq * 8);
#define PG8_SA(b, h) (((b) * 2 + (h)) * HTB)
#define PG8_SB(b, h) ((4 + (b) * 2 + (h)) * HTB)
#define PG8_STAGE(bufoff, gbase, voff) do { _Pragma("unroll") for (int _i = 0; _i < 2; ++_i) \
        __builtin_amdgcn_global_load_lds((const unsigned*)((const char*)(gbase) + (voff)[_i]), (PG8_LAS unsigned*)(lds + (bufoff) + ldsw + _i * 8192), 16, 0, 0); } while (0)
#define PG8_LDA(dst, b, h) do { _Pragma("unroll") for (int m = 0; m < 4; ++m) { if constexpr (F8 != 0) dst##_F[m] = cat8(*(const PG8_LAS bf16x8*)(lds + PG8_SA(b, h) + aoff + m * 2048), *(const PG8_LAS bf16x8*)(lds + PG8_SA(b, h) + aoff + m * 2048 + 1024)); \
        else { _Pragma("unroll") for (int k = 0; k < 2; ++k) dst[m][k] = *(const PG8_LAS bf16x8*)(lds + PG8_SA(b, h) + aoff + m * 2048 + k * 1024); } } } while (0)
#define PG8_LDB(dst, b, h) do { _Pragma("unroll") for (int n = 0; n < 2; ++n) { if constexpr (F8 != 0) dst##_F[n] = cat8(*(const PG8_LAS bf16x8*)(lds + PG8_SB(b, h) + boff + n * 2048), *(const PG8_LAS bf16x8*)(lds + PG8_SB(b, h) + boff + n * 2048 + 1024)); \
        else { _Pragma("unroll") for (int k = 0; k < 2; ++k) dst[n][k] = *(const PG8_LAS bf16x8*)(lds + PG8_SB(b, h) + boff + n * 2048 + k * 1024); } } } while (0)
#define PG8_MMA(ai, bj, At, Bt) do { __builtin_amdgcn_s_setprio(1); _Pragma("unroll") for (int m = 0; m < 4; ++m) _Pragma("unroll") for (int n = 0; n < 2; ++n) { \
        if constexpr (F8 != 0) asm volatile("v_mfma_scale_f32_16x16x128_f8f6f4 %0, %1, %2, %0, %3, %4 op_sel_hi:[0,0,0]" : "+v"(acc[ai][bj][m][n]) : "v"(Bt##_F[n]), "v"(At##_F[m]), "v"(sc_w), "v"(sc_a)); \
        else { _Pragma("unroll") for (int k = 0; k < 2; ++k) acc[ai][bj][m][n] = __builtin_amdgcn_mfma_f32_16x16x32_bf16(Bt[n][k], At[m][k], acc[ai][bj][m][n], 0, 0, 0); } } __builtin_amdgcn_s_setprio(0); } while (0)
#define PG8_WAIT_V(n) asm volatile("s_waitcnt vmcnt(" #n ")" ::: "memory")
#define PG8_WAIT_L(n) asm volatile("s_waitcnt lgkmcnt(" #n ")" ::: "memory")
#define PG8_BAR __builtin_amdgcn_s_barrier()
#define PG8_SCHED __builtin_amdgcn_sched_barrier(0)
    Unit cur, nxt; int ui = 0;
    if (!S.next(0, cur)) return;
    f32x4 acc[2][2][4][2];
    float zz0; asm volatile("v_mov_b32 %0, 0" : "=v"(zz0));
    const int sc_w = (F8 >> 8) * 0x01010101, sc_a = (F8 & 255) * 0x01010101; (void)sc_w; (void)sc_a;
#pragma unroll
    for (int a = 0; a < 2; ++a)
#pragma unroll
        for (int b = 0; b < 2; ++b)
#pragma unroll
            for (int m = 0; m < 4; ++m)
#pragma unroll
                for (int n = 0; n < 2; ++n) acc[a][b][m][n] = (f32x4){zz0, zz0, zz0, zz0};
    bf16x8 At[4][2], B0[2][2], B1[2][2]; pg8_v8i At8[4], B08[2], B18[2];
#define At_F At8
#define B0_F B08
#define B1_F B18
    const char* cA = (const char*)g.A + (size_t)cur.pm * tstep + (size_t)cur.k0 * ES; const char* cB = (const char*)g.Bt + (size_t)cur.pn * tstep + (size_t)cur.k0 * ES;
    S.a_ready(cur);
    if constexpr (SP2) {
        PG8_STAGE(PG8_SB(0, 0), cB, voffB); PG8_STAGE(PG8_SB(0, 1), cB + hstep, voffB); PG8_STAGE(PG8_SA(0, 0), cA, voffA); PG8_STAGE(PG8_SA(0, 1), cA + hstep, voffA);
        if (wr == 1) PG8_BAR;
        PG8_WAIT_V(2); PG8_BAR;
        PG8_STAGE(PG8_SB(1, 0), cB + kstep, voffB); PG8_STAGE(PG8_SA(1, 0), cA + kstep, voffA); PG8_STAGE(PG8_SB(1, 1), cB + hstep + kstep, voffB);
        PG8_WAIT_V(6); PG8_BAR;
    } else {
        PG8_STAGE(PG8_SB(0, 0), cB, voffB); PG8_STAGE(PG8_SA(0, 0), cA, voffA); PG8_STAGE(PG8_SB(0, 1), cB + hstep, voffB); PG8_STAGE(PG8_SA(0, 1), cA + hstep, voffA);
        if (wr == 1) PG8_BAR;
        PG8_WAIT_V(4); PG8_BAR;
        PG8_STAGE(PG8_SB(1, 0), cB + kstep, voffB); PG8_STAGE(PG8_SA(1, 0), cA + kstep, voffA); PG8_STAGE(PG8_SB(1, 1), cB + hstep + kstep, voffB);
        PG8_WAIT_V(6); PG8_BAR;
    }
    for (;;) {
        const bool has_next = S.next(ui + 1, nxt);
        const char* nA = has_next ? (const char*)g.A + (size_t)nxt.pm * tstep + (size_t)nxt.k0 * ES : cA; const char* nB = has_next ? (const char*)g.Bt + (size_t)nxt.pn * tstep + (size_t)nxt.k0 * ES : cB;
        for (int t = 0; t < nt; t += 2) {
            const bool last = (t == nt - 2);
            const char* a1 = cA + (size_t)(t + 1) * kstep;
            const char* a2 = last ? nA : cA + (size_t)(t + 2) * kstep; const char* b2 = last ? nB : cB + (size_t)(t + 2) * kstep;
            const char* a3 = a2 + kstep; const char* b3 = b2 + kstep;
            if (last && has_next) S.a_ready(nxt);
            if constexpr (SP2) {
            PG8_LDB(B0, 0, 0); PG8_LDB(B1, 0, 1); PG8_SCHED; PG8_LDA(At, 0, 0); PG8_STAGE(PG8_SA(1, 1), a1 + hstep, voffA);
            PG8_WAIT_V(8); PG8_WAIT_L(0); PG8_BAR; PG8_MMA(0, 0, At, B0); PG8_MMA(0, 1, At, B1); PG8_BAR; PG8_SCHED;
            PG8_LDA(At, 0, 1); PG8_STAGE(PG8_SB(0, 0), b2, voffB); PG8_STAGE(PG8_SB(0, 1), b2 + hstep, voffB); PG8_STAGE(PG8_SA(0, 0), a2, voffA);
            PG8_WAIT_V(8); PG8_WAIT_L(0); PG8_BAR; PG8_MMA(1, 0, At, B0); PG8_MMA(1, 1, At, B1); PG8_BAR; PG8_SCHED;
            PG8_LDB(B0, 1, 0); PG8_LDB(B1, 1, 1); PG8_SCHED; PG8_LDA(At, 1, 0); PG8_STAGE(PG8_SA(0, 1), a2 + hstep, voffA);
            PG8_WAIT_V(8); PG8_WAIT_L(0); PG8_BAR; PG8_MMA(0, 0, At, B0); PG8_MMA(0, 1, At, B1); PG8_BAR; PG8_SCHED;
            PG8_LDA(At, 1, 1); PG8_STAGE(PG8_SB(1, 0), b3, voffB); PG8_STAGE(PG8_SB(1, 1), b3 + hstep, voffB); PG8_STAGE(PG8_SA(1, 0), a3, voffA);
            PG8_WAIT_V(8); PG8_WAIT_L(0); PG8_BAR; PG8_MMA(1, 0, At, B0); PG8_MMA(1, 1, At, B1); PG8_BAR; PG8_SCHED;
            } else {
            PG8_LDB(B0, 0, 0); PG8_SCHED; PG8_LDA(At, 0, 0); PG8_STAGE(PG8_SA(1, 1), a1 + hstep, voffA);
            PG8_WAIT_L(8); PG8_BAR; PG8_WAIT_L(0); PG8_MMA(0, 0, At, B0); PG8_BAR; PG8_SCHED;
            PG8_LDB(B1, 0, 1); PG8_STAGE(PG8_SB(0, 0), b2, voffB);
            PG8_BAR; PG8_WAIT_L(0); PG8_MMA(0, 1, At, B1); PG8_BAR;
            PG8_LDA(At, 0, 1); PG8_STAGE(PG8_SA(0, 0), a2, voffA);
            PG8_BAR; PG8_WAIT_L(0); PG8_MMA(1, 0, At, B0); PG8_BAR; PG8_SCHED;
            PG8_STAGE(PG8_SB(0, 1), b2 + hstep, voffB);
            PG8_WAIT_V(6); PG8_BAR; PG8_MMA(1, 1, At, B1); PG8_BAR;
            PG8_LDB(B0, 1, 0); PG8_SCHED; PG8_LDA(At, 1, 0); PG8_STAGE(PG8_SA(0, 1), a2 + hstep, voffA);
            PG8_WAIT_L(8); PG8_BAR; PG8_WAIT_L(0); PG8_MMA(0, 0, At, B0); PG8_BAR; PG8_SCHED;
            PG8_LDB(B1, 1, 1); PG8_STAGE(PG8_SB(1, 0), b3, voffB);
            PG8_BAR; PG8_WAIT_L(0); PG8_MMA(0, 1, At, B1); PG8_BAR;
            PG8_LDA(At, 1, 1); PG8_STAGE(PG8_SA(1, 0), a3, voffA);
            PG8_BAR; PG8_WAIT_L(0); PG8_MMA(1, 0, At, B0); PG8_BAR; PG8_SCHED;
            PG8_STAGE(PG8_SB(1, 1), b3 + hstep, voffB);
            PG8_WAIT_V(6); PG8_BAR; PG8_MMA(1, 1, At, B1); PG8_BAR;
            }
        }
        if constexpr (F8 != 0) { asm volatile("s_nop 15\n\ts_nop 15\n\ts_nop 15\n\ts_nop 15" ::: "memory"); }
        if constexpr (ALIGN_EPI) { if (wr == 0) PG8_BAR; }
        if constexpr (!Epi::AFTER_DRAIN) { int l2_ = tid; asm volatile("" : "+v"(l2_));
            E(acc, cur, wr, wc, l2_ & 15, (l2_ & 63) >> 4); S.done(cur); }
        if (!has_next) break;
{ float zz1; asm volatile("v_mov_b32 %0, 0" : "=v"(zz1));
#pragma unroll
        for (int a = 0; a < 2; ++a)
#pragma unroll
            for (int b = 0; b < 2; ++b)
#pragma unroll
                for (int m = 0; m < 4; ++m)
#pragma unroll
                    for (int n = 0; n < 2; ++n) acc[a][b][m][n] = (f32x4){zz1, zz1, zz1, zz1}; }
        cur = nxt; cA = nA; cB = nB; ++ui;
        if constexpr (ALIGN_EPI) { if (wr == 1) PG8_BAR; }
    }
    PG8_WAIT_V(0);
    if constexpr (!ALIGN_EPI) { if (wr == 0) PG8_BAR; }
    PG8_BAR;
    if constexpr (Epi::AFTER_DRAIN) { E.fused(acc, cur, wr, wc, fr, fq, lds, wid, lane); S.done(cur); }
#undef PG8_SA
#undef PG8_SB
#undef PG8_STAGE
#undef PG8_LDA
#undef PG8_LDB
#undef PG8_MMA
#undef PG8_WAIT_V
#undef PG8_WAIT_L
#undef PG8_BAR
#undef PG8_SCHED
#undef At_F
#undef B0_F
#undef B1_F
}
}
#define GAS __attribute__((address_space(1)))
#define LAS __attribute__((address_space(3)))
typedef unsigned short bf16;
typedef unsigned v4u __attribute__((ext_vector_type(4)));
typedef float f32x4 __attribute__((ext_vector_type(4)));
typedef short bf16x8 __attribute__((ext_vector_type(8)));
typedef GAS unsigned gu32;
typedef GAS unsigned long long gu64;
#define RLX_AGENT __ATOMIC_RELAXED, __HIP_MEMORY_SCOPE_AGENT
#define LDS_WAIT() asm volatile("s_waitcnt lgkmcnt(0)" ::: "memory")
#define VM_WAIT() asm volatile("s_waitcnt vmcnt(0)" ::: "memory")
__device__ __forceinline__ unsigned long long rt() { return __builtin_amdgcn_s_memrealtime(); }
typedef float f32x2_t __attribute__((ext_vector_type(2))); typedef __bf16 bf16x2_t __attribute__((ext_vector_type(2)));
__device__ __forceinline__ unsigned pk2(float lo, float hi) { const bf16x2_t b = __builtin_convertvector((f32x2_t){lo, hi}, bf16x2_t); return __builtin_bit_cast(unsigned, b); }
__device__ __forceinline__ unsigned f2bf(float f) { return pk2(f, 0.f) & 0xffffu; }
#define XB_TMO      128
#define XB_XCNT(j)  (256  + 64 * (j))
#define XB_XSUB(j)  (1280 + 64 * (j))
#define XB_XGEN(j)  (2304 + 64 * (j))
#define XB_TOP      3328
#define XB_TOPGEN   3392
#define XCD_BAR_WORDS 3456
#define XB_SPIN_CAP (1u << 18)

__device__ __forceinline__ unsigned xb_ld(unsigned* p)              { return __hip_atomic_load(p, __ATOMIC_RELAXED, __HIP_MEMORY_SCOPE_AGENT); }
__device__ __forceinline__ unsigned xb_add(unsigned* p, unsigned v) { return __hip_atomic_fetch_add(p, v, __ATOMIC_RELAXED, __HIP_MEMORY_SCOPE_AGENT); }
__device__ __forceinline__ unsigned xb_xcc_id() { return (unsigned)__builtin_amdgcn_s_getreg((3 << 11) | 20) & 0xFu; }
#define XB_SPIN(cond, bar) do { unsigned _sp = 0; while (cond) { __builtin_amdgcn_s_sleep(1); \
    if ((++_sp & 255u) == 0u) { if (xb_ld(&(bar)[XB_TMO])) break; if (_sp > XB_SPIN_CAP) { atomicAdd(&(bar)[XB_TMO], 1u); break; } } } } while (0)

struct XcdBarrier {
    unsigned* bar; unsigned x;
    volatile LAS unsigned* st;
};

__device__ __forceinline__ XcdBarrier xcd_barrier_post(unsigned* bar, volatile LAS unsigned* st, int tid) {
    XcdBarrier b; b.bar = bar; b.x = xb_xcc_id(); b.st = st;
    if (tid == 0) (void)xb_add(&bar[XB_XCNT(b.x)], 1u);
    return b;
}
__device__ __forceinline__ void xcd_barrier_complete(unsigned* bar, unsigned x, unsigned& nloc, unsigned& nx) {
    const unsigned G = gridDim.x * gridDim.y * gridDim.z;
    unsigned sum, cnt, mine, sp = 0u;
    for (;;) {
        sum = 0u; cnt = 0u; mine = 0u;
#pragma unroll
        for (unsigned j = 0; j < 16; ++j) { const unsigned c = xb_ld(&bar[XB_XCNT(j)]); sum += c; cnt += (c > 0u) ? 1u : 0u; mine = (j == x) ? c : mine; }
        if (sum == G) break;
        __builtin_amdgcn_s_sleep(1);
        if ((++sp & 255u) == 0u) { if (xb_ld(&bar[XB_TMO])) break; if (sp > XB_SPIN_CAP) { atomicAdd(&bar[XB_TMO], 1u); break; } }
    }
    nloc = mine > 0u ? mine : 1u; nx = cnt > 0u ? cnt : 1u;
}

__device__ __forceinline__ void xcd_barrier(const XcdBarrier& b, int tid) {
    asm volatile("s_waitcnt vmcnt(0)" ::: "memory");
    __syncthreads();
    if (tid == 0) {
        unsigned* bar = b.bar;
        __builtin_amdgcn_s_waitcnt(0);
        unsigned nloc = b.st[0], nx = b.st[1];
        if (nloc == 0u) { xcd_barrier_complete(bar, b.x, nloc, nx); b.st[0] = nloc; b.st[1] = nx; }
        const unsigned old = xb_add(&bar[XB_XSUB(b.x)], 1u);
        const unsigned gen = old / nloc;
        if (old + 1u == (gen + 1u) * nloc) {
            __builtin_amdgcn_fence(__ATOMIC_RELEASE, "agent");
            asm volatile("s_waitcnt vmcnt(0)" ::: "memory");
            const unsigned og = xb_add(&bar[XB_TOP], 1u);
            const unsigned tg = og / nx;
            if (og + 1u == (tg + 1u) * nx) xb_add(&bar[XB_TOPGEN], 1u);
            else XB_SPIN(xb_ld(&bar[XB_TOPGEN]) == tg, bar);
            __builtin_amdgcn_fence(__ATOMIC_ACQUIRE, "agent");
            xb_add(&bar[XB_XGEN(b.x)], 1u);
            asm volatile("s_waitcnt vmcnt(0)" ::: "memory");
        } else {
            XB_SPIN(xb_ld(&bar[XB_XGEN(b.x)]) == gen, bar);
            __builtin_amdgcn_fence(__ATOMIC_ACQUIRE, "agent");
            asm volatile("s_waitcnt vmcnt(0)" ::: "memory");
        }
    }
    __syncthreads();
}

constexpr int NWAVES = 8, NTHR = 512;
constexpr int DM = 2048, FF = 5632, DEPTH = 4;
constexpr int TP = 16384, NSB = 16, TS = 32, M = TP + NSB * TS;
constexpr int RW = 1024, NH = 16, HN = 64, GMW = 1024, GH = 8, GHD = 128;
constexpr int C_W = 3072, C_A = 3136, C_G = 3200, SHIFT = 3360, INC = 5408;
constexpr int PLD = 3584;
constexpr int N3 = 5632;
constexpr int LK = 384;
constexpr int NL = 3072;
constexpr float ALPHA = 1.6817928305074292f;
constexpr float LN_EPS = 1e-5f, GN_EPS = 64e-5f;
constexpr int NPHASE = 15;

constexpr size_t O_YP = 0, O_SP = 34603008, O_SHP = 34865152, O_SS = 34878592, O_SHS = 39072896, O_GV = 39287936, O_END = 41385088;

constexpr size_t MiB = 1u << 20;
constexpr size_t WS_CTL = 0, CTL_ZERO_BYTES = 1 * MiB;
constexpr size_t WS_X = 1 * MiB;
constexpr size_t WS_Z = 133 * MiB;
constexpr size_t WS_XB = 265 * MiB;
constexpr size_t WS_W = 331 * MiB;
constexpr size_t W_1 = WS_W, W_2 = W_1 + 44 * MiB, W_3 = W_2 + 22 * MiB, W_4 = W_3 + 22 * MiB, W_5 = W_4 + 8 * MiB, W_6 = W_5 + 44 * MiB, W_3B = W_6 + 22 * MiB;
constexpr size_t W_1B = 1367 * MiB, W_2B = 1411 * MiB, W_4B = 1433 * MiB;
constexpr size_t W_5B = 67 * MiB, W_3BB = 111 * MiB;
constexpr size_t W_3B2 = 1277 * MiB, W_6B = 1299 * MiB;
constexpr size_t WS_TOP = 1441 * MiB;
__host__ __device__ constexpr size_t wofs(int i, int par) {
    return i == 1 ? (par ? W_1B : W_1) : i == 2 ? (par ? W_2B : W_2) : i == 3 ? (par ? W_3B2 : W_3) : i == 4 ? (par ? W_4B : W_4) : i == 5 ? (par ? W_5B : W_5) : i == 6 ? (par ? W_6B : W_6) : (par ? W_3BB : W_3B); }
constexpr size_t WS_BIG = 496 * MiB;
constexpr size_t B_XB8 = WS_BIG + 96 * MiB;
constexpr size_t B_H = WS_BIG, B_P = WS_BIG, B_U = WS_BIG + 231 * MiB, B_GV = B_U + 33 * MiB, B_A3B = B_GV + 66 * MiB;
constexpr size_t B_MIX = WS_X;
constexpr size_t WS_RW = 839 * MiB;
constexpr size_t RWSZ = 66 * MiB;
constexpr size_t WS_END = WS_RW + 8 * RWSZ;
static_assert(W_3B + (size_t)NL * LK * 2 <= WS_BIG && B_A3B + (size_t)M * LK * 2 <= WS_RW, "ws map");
static_assert(B_MIX + (size_t)M * DM * 2 <= WS_X + (size_t)TP * DM * 4, "MIXB under the sample rows of X");
static_assert((size_t)M * DM * 4 == 132 * MiB && (size_t)M * PLD * 4 == 231 * MiB && (size_t)M * 1024 * 4 == 66 * MiB, "ws sizes");
constexpr int CW_TMO = 0, CW_CODE = 1, CW_BAR = 4096;

constexpr int RING_OFF = 0, RING_BYTES = 135168;
constexpr int LDSCTL_OFF = RING_BYTES, MISC_OFF = LDSCTL_OFF + 320;
constexpr int LDS_BYTES = 147456;

struct Args { const float* in[29]; float* out; unsigned char* ws; int l_lo, l_hi; };
#define KOUT() ((float*)karg_ptr<232>())
#define KWS() ((unsigned char*)karg_ptr<240>())
enum InIdx { I_XP = 0, I_XS, I_SRW, I_SSH, I_F1G, I_F1U, I_F1D, I_WIN, I_MU, I_W0, I_WUP, I_A0, I_AUP, I_GUP, I_KK, I_KA, I_RK, I_GNG, I_GNB, I_GLG, I_GLB, I_GWS, I_GBS, I_WOUT, I_F2G, I_F2U, I_F2D, I_LNG, I_LNB };


template <int OFF> __device__ __forceinline__ const float* karg_ptr() {
    const unsigned long long kp = (unsigned long long)__builtin_amdgcn_kernarg_segment_ptr(); unsigned long long v;
    asm volatile("s_load_dwordx2 %0, %1, %2\n\ts_waitcnt lgkmcnt(0)" : "=s"(v) : "s"(kp), "i"(OFF) : "memory");
    return (const float*)(const GAS float*)v;
}
#define KIN(i) karg_ptr<8 * (i)>()
template <int CTRL> __device__ __forceinline__ float dpp_mov(float x) { return __builtin_bit_cast(float, __builtin_amdgcn_mov_dpp(__builtin_bit_cast(int, x), CTRL, 0xf, 0xf, true)); }
__device__ __forceinline__ float row16_sum(float x) { x += dpp_mov<0x128>(x); x += dpp_mov<0x124>(x); x += dpp_mov<0x122>(x); x += dpp_mov<0x121>(x); return x; }
__device__ __forceinline__ float wave_sum(float v) {
    v = row16_sum(v); const int i = __builtin_bit_cast(int, v);
    const float a = __builtin_bit_cast(float, __builtin_amdgcn_readlane(i, 0)), b = __builtin_bit_cast(float, __builtin_amdgcn_readlane(i, 16)), c = __builtin_bit_cast(float, __builtin_amdgcn_readlane(i, 32)), d = __builtin_bit_cast(float, __builtin_amdgcn_readlane(i, 48));
    return (a + b) + (c + d);
}

template <int MAP> __device__ __forceinline__ void cvt_task(const float* __restrict__ W, int K, int N, bf16* __restrict__ WT, int nb, int k0, int lane) {
    const int n = nb * 256 + 4 * lane; if (n >= N) return;
    const int drow = MAP == 0 ? n : (MAP == 3 ? (n < SHIFT ? n : n + (PLD - SHIFT)) : 256 * (n >> 7) + (n & 127) + (MAP == 2 ? 128 : 0));
    const float* src = W + (size_t)k0 * N + n; bf16* dst = WT + (size_t)drow * K + k0;
#pragma unroll
    for (int kk = 0; kk < 32; kk += 16) { f32x4 v[16];
#pragma unroll
        for (int j = 0; j < 16; ++j) v[j] = *(const f32x4*)(src + (size_t)(kk + j) * N);
#pragma unroll
        for (int i = 0; i < 4; ++i)
#pragma unroll
            for (int hh = 0; hh < 2; ++hh) { v4u o; o.x = pk2(v[8 * hh + 0][i], v[8 * hh + 1][i]); o.y = pk2(v[8 * hh + 2][i], v[8 * hh + 3][i]); o.z = pk2(v[8 * hh + 4][i], v[8 * hh + 5][i]); o.w = pk2(v[8 * hh + 6][i], v[8 * hh + 7][i]);
                *(v4u*)(dst + (size_t)i * K + kk + 8 * hh) = o; } }
}

template <int MAP> __device__ __forceinline__ void cvt_task8(const float* __restrict__ W, int K, int N, unsigned char* __restrict__ WT, int nb, int k0, int lane) {
    const int n = nb * 256 + 4 * lane; if (n >= N) return;
    const int drow = MAP == 0 ? n : 256 * (n >> 7) + (n & 127) + (MAP == 2 ? 128 : 0);
    const float* src = W + (size_t)k0 * N + n; unsigned char* dst = WT + (size_t)drow * K + k0;
#pragma unroll
    for (int kk = 0; kk < 32; kk += 16) { f32x4 v[16];
#pragma unroll
        for (int j = 0; j < 16; ++j) v[j] = *(const f32x4*)(src + (size_t)(kk + j) * N) * 64.0f;
#pragma unroll
        for (int i = 0; i < 4; ++i) { v4u o;
#pragma unroll
            for (int q = 0; q < 4; ++q) { unsigned w = 0u; w = __builtin_amdgcn_cvt_pk_fp8_f32(v[4 * q][i], v[4 * q + 1][i], w, false); w = __builtin_amdgcn_cvt_pk_fp8_f32(v[4 * q + 2][i], v[4 * q + 3][i], w, true); o[q] = w; }
            *(v4u*)(dst + (size_t)i * K + kk) = o; } }
}

constexpr int CV_T_GU = (FF / 256) * (DM / 32), CV_T_D = (DM / 256) * (FF / 32), CV_T_IN = ((INC + 255) / 256) * (DM / 32), CV_T_O = (DM / 256) * (DM / 32), CV_NTASK = 4 * CV_T_GU + 2 * CV_T_D + CV_T_IN + CV_T_O;
__device__ __forceinline__ void phase_convert(int l, int par, int t_lo, int t_hi, bool small, bool inputs, int lane, int idx, int cnt) {
    unsigned char* ws = KWS();
    const size_t so = (size_t)l * DM * FF;
    const float *f1g = KIN(I_F1G) + so, *f1u = KIN(I_F1U) + so, *f1d = KIN(I_F1D) + so, *f2g = KIN(I_F2G) + so, *f2u = KIN(I_F2U) + so, *f2d = KIN(I_F2D) + so;
    const float* win = KIN(I_WIN) + (size_t)l * DM * INC; const float* wout = KIN(I_WOUT) + (size_t)l * DM * DM;
    constexpr int T_GU = CV_T_GU, T_D = CV_T_D, T_IN = CV_T_IN;
    for (int it = t_lo + idx; it < t_hi; it += cnt) {
        int r = it;
        if (r < 4 * T_GU) { const int which = r / T_GU; r -= which * T_GU; const int nb = r % (FF / 256), kb = r / (FF / 256);
            const float* W = which == 0 ? f1g : (which == 1 ? f1u : (which == 2 ? f2g : f2u)); unsigned char* WT = ws + (which < 2 ? wofs(1, par) : wofs(5, par));
            if (which & 1) cvt_task8<2>(W, DM, FF, WT, nb, 32 * kb, lane); else cvt_task8<1>(W, DM, FF, WT, nb, 32 * kb, lane); continue; }
        r -= 4 * T_GU;
        if (r < 2 * T_D) { const int which = r / T_D; r -= which * T_D; const int nb = r % (DM / 256), kb = r / (DM / 256);
            cvt_task8<0>(which == 0 ? f1d : f2d, FF, DM, ws + (which == 0 ? wofs(2, par) : wofs(6, par)), nb, 32 * kb, lane); continue; }
        r -= 2 * T_D;
        if (r < T_IN) { const int nb = r % ((INC + 255) / 256), kb = r / ((INC + 255) / 256); cvt_task<3>(win, DM, INC, (bf16*)(ws + wofs(3, par)), nb, 32 * kb, lane); continue; }
        r -= T_IN;
        { const int nb = r % (DM / 256), kb = r / (DM / 256); cvt_task<0>(wout, DM, DM, (bf16*)(ws + wofs(4, par)), nb, 32 * kb, lane); }
    }
    if (small) {
        { v4u* z = (v4u*)(ws + wofs(3, par) + (size_t)SHIFT * DM * 2); const int nz = (PLD - SHIFT) * DM * 2 / 16;
          unsigned z0; asm volatile("v_mov_b32 %0, 0" : "=v"(z0));
          for (int i = idx * 64 + lane; i < nz; i += cnt * 64) z[i] = (v4u){z0, z0, z0, z0}; }
        { bf16* WT = (bf16*)(ws + wofs(7, par)); const float* wup = KIN(I_WUP) + (size_t)l * 64 * RW; const float* aup = KIN(I_AUP) + (size_t)l * 64 * RW; const float* gup = KIN(I_GUP) + (size_t)l * 160 * RW;
          for (int i = idx * 64 + lane; i < NL * LK; i += cnt * 64) { const int n = i / LK, k = i % LK, kind = n >> 10, c = n & 1023; float v = 0.f;
              if (kind == 0) { if (k < 64) v = wup[(size_t)k * RW + c]; } else if (kind == 1) { if (k >= 64 && k < 128) v = aup[(size_t)(k - 64) * RW + c]; } else { if (k >= 128 && k < 288) v = gup[(size_t)(k - 128) * RW + c]; }
              WT[i] = (bf16)f2bf(v); } }
    }
    if (inputs) {
        float* X = (float*)(ws + WS_X); bf16* XB = (bf16*)(ws + WS_XB); const float* xp = KIN(I_XP); const float* xs = KIN(I_XS);
        for (int m = idx; m < M; m += cnt) { const float* src = m < TP ? xp + (size_t)m * DM : xs + (size_t)(m - TP) * DM;
            const f32x4* s4 = (const f32x4*)src + lane; f32x4* d4 = (f32x4*)(X + (size_t)m * DM) + lane; unsigned long long* o8 = (unsigned long long*)(XB + (size_t)m * DM) + lane; unsigned* q8 = (unsigned*)(ws + B_XB8 + (size_t)m * DM) + lane;
#pragma unroll
            for (int j = 0; j < 8; ++j) { const f32x4 v = s4[64 * j]; if (m >= TP) d4[64 * j] = v; o8[64 * j] = (unsigned long long)pk2(v.x, v.y) | ((unsigned long long)pk2(v.z, v.w) << 32);
                unsigned w = 0u; w = __builtin_amdgcn_cvt_pk_fp8_f32(v.x, v.y, w, false); w = __builtin_amdgcn_cvt_pk_fp8_f32(v.z, v.w, w, true); q8[64 * j] = w; } }
    }
}

__device__ __forceinline__ void phase_ln(const float* Z, const float* Xres, const float* slab, int KS, float sa, float sb, const float* g, const float* b, float* Xo, bf16* XBo, unsigned char* XB8o  , bool all_rows, int lane, int gw, int NGW) {
    const bool deal = NGW == 2048; const int nit = deal ? (gw < 512 ? 3 : 10) : (M - gw + NGW - 1) / NGW;
    for (int it = 0; it < nit; ++it) {
        const int m = !deal ? gw + it * NGW : (gw < 512 ? (it == 0 ? TP + gw : 2 * gw + it - 1) : 1024 + (gw - 512) + it * 1536);
        f32x4 v[8]; float s = 0.f;
        if (m < TP) { const f32x4* zr = (const f32x4*)(Z + (size_t)m * DM) + lane;
#pragma unroll
            for (int j = 0; j < 8; ++j) v[j] = zr[64 * j];
        } else { const f32x4* xr = (const f32x4*)(Xres + (size_t)m * DM) + lane; f32x4 a[8];
#pragma unroll
            for (int j = 0; j < 8; ++j) { v[j] = xr[64 * j]; a[j] = (f32x4){0.f, 0.f, 0.f, 0.f}; }
            for (int ks = 0; ks < KS; ++ks) { const f32x4* sr = (const f32x4*)(slab + ((size_t)ks * 512 + (m - TP)) * DM) + lane;
#pragma unroll
                for (int j = 0; j < 8; ++j) a[j] = a[j] + sr[64 * j]; }
#pragma unroll
            for (int j = 0; j < 8; ++j) v[j] = v[j] * sa + a[j] * sb; }
#pragma unroll
        for (int j = 0; j < 8; ++j) s += (v[j].x + v[j].y) + (v[j].z + v[j].w);
        const float mean = wave_sum(s) * (1.f / DM); float s2 = 0.f;
#pragma unroll
        for (int j = 0; j < 8; ++j) { v[j] = v[j] - mean; s2 += (v[j].x * v[j].x + v[j].y * v[j].y) + (v[j].z * v[j].z + v[j].w * v[j].w); }
        const float rstd = 1.f / sqrtf(wave_sum(s2) * (1.f / DM) + LN_EPS);
        f32x4* xo = (f32x4*)(Xo + (size_t)m * DM) + lane; const bool wx = all_rows || m >= TP;
#pragma unroll
        for (int j = 0; j < 8; ++j) { const f32x4 gg = ((const f32x4*)g)[lane + 64 * j], bb = ((const f32x4*)b)[lane + 64 * j]; const f32x4 o = v[j] * rstd * gg + bb; if (wx) xo[64 * j] = o;
            if (XBo) ((unsigned long long*)(XBo + (size_t)m * DM) + lane)[64 * j] = (unsigned long long)pk2(o.x, o.y) | ((unsigned long long)pk2(o.z, o.w) << 32);
            if (XB8o) { unsigned w = 0u; w = __builtin_amdgcn_cvt_pk_fp8_f32(o.x, o.y, w, false); w = __builtin_amdgcn_cvt_pk_fp8_f32(o.z, o.w, w, true); ((unsigned*)(XB8o + (size_t)m * DM) + lane)[64 * j] = w; } }
    }
}

__device__ __forceinline__ const float* prev_row(const float* ssh, int l, const float* P, int m) {
    if (m < TP) return m == 0 ? nullptr : P + (size_t)(m - 1) * PLD;
    const int b = (m - TP) >> 5, t = (m - TP) & 31;
    return t == 0 ? ssh + (size_t)(l * NSB + b) * SHIFT : P + (size_t)(m - 1) * PLD;
}

__device__ __forceinline__ void phase_prep1(int l, int lane, int gw, int NGW) {
    unsigned char* ws = KWS(); float* outp = KOUT(); const float* P = (const float*)(ws + B_P); float* GV = (float*)(ws + B_GV); bf16* A3B = (bf16*)(ws + B_A3B);
    const float* mu = KIN(I_MU) + (size_t)l * SHIFT; const float* lg = KIN(I_GLG) + (size_t)l * GMW; const float* lb = KIN(I_GLB) + (size_t)l * GMW;
    const float* ssh = KIN(I_SSH);
    for (int m = gw; m < M; m += NGW) {
        const float* pr = P + (size_t)m * PLD; const float* pp = prev_row(ssh, l, P, m);
#pragma unroll
        for (int jj = 0; jj < 6; ++jj) { const int j = jj * 64 + lane; float v = 0.f;
            if (j < 288) { const int c = C_W + j; const float p = pr[c], q = pp ? pp[c] : 0.f; const float xs = p + (q - p) * mu[c];
                if (j < 64) { const float t = __expf(-2.f * fabsf(xs)); const float r = (1.f - t) / (1.f + t); v = xs < 0.f ? -r : r; }
                else if (j < 128) v = xs;
                else v = 1.f / (1.f + __expf(-xs)); }
            A3B[(size_t)m * LK + j] = (bf16)f2bf(v); }
        { f32x4* vr = (f32x4*)(GV + (size_t)m * GMW) + lane; f32x4 v[4]; float s = 0.f;
#pragma unroll
          for (int j = 0; j < 4; ++j) { v[j] = vr[64 * j]; s += (v[j].x + v[j].y) + (v[j].z + v[j].w); }
          const float mean = wave_sum(s) * (1.f / GMW); float s2 = 0.f;
#pragma unroll
          for (int j = 0; j < 4; ++j) { v[j] = v[j] - mean; s2 += (v[j].x * v[j].x + v[j].y * v[j].y) + (v[j].z * v[j].z + v[j].w * v[j].w); }
          const float rstd = 1.f / sqrtf(wave_sum(s2) * (1.f / GMW) + LN_EPS);
          f32x4* go = nullptr; if (m >= TP) go = (f32x4*)(outp + O_GV + ((size_t)l * NSB * TS + (m - TP)) * GMW) + lane;
#pragma unroll
          for (int j = 0; j < 4; ++j) { const f32x4 o = v[j] * rstd * ((const f32x4*)lg)[lane + 64 * j] + ((const f32x4*)lb)[lane + 64 * j]; vr[64 * j] = o; if (go) go[64 * j] = o; } }
        if (m == TP - 1) { float* o = outp + O_SHP + (size_t)l * SHIFT; for (int c = lane; c < SHIFT; c += 64) o[c] = pr[c]; }
        if (m >= TP && ((m - TP) & 31) == 31) { float* o = outp + O_SHS + (size_t)(l * NSB + ((m - TP) >> 5)) * SHIFT; for (int c = lane; c < SHIFT; c += 64) o[c] = pr[c]; }
    }
}

typedef unsigned u32x2g __attribute__((ext_vector_type(2)));
constexpr int GLD = 272, GL_VT = 128 * GLD, GSP = 132;
static_assert(2 * GL_VT <= RING_BYTES && 128 * GSP * 4 <= 2 * GL_VT, "gMLP LDS");
__device__ __forceinline__ void gmlp_unit(int l, LAS unsigned char* lds, int unit, int tid, int wave) {
    unsigned char* ws = KWS(); const float* VN = (const float*)(ws + B_GV); const bf16* U = (const bf16*)(ws + B_U); bf16* MIXB = (bf16*)(ws + B_MIX);
    const int ci = unit >> 3, h = unit & 7; int row0, nr; if (ci < 128) { row0 = 128 * ci; nr = 128; } else { row0 = TP + 32 * (ci - 128); nr = 32; }
    const float* wsm = KIN(I_GWS) + ((size_t)l * GH + h) * 128 * 128; const float* bs = KIN(I_GBS) + ((size_t)l * GH + h) * 128;
    LAS unsigned char* Wb = lds; LAS unsigned char* Vt = lds + GL_VT; LAS float* So = (LAS float*)lds;
    const int lane = tid & 63, g = lane >> 4, lc = lane & 15;
    __syncthreads();
    for (int idx = tid; idx < nr * 32; idx += NTHR) { const int i = idx >> 5, j4 = idx & 31; f32x4 w4 = *(const f32x4*)(wsm + i * 128 + 4 * j4);
        const int j = 4 * j4; if (j > i) w4.x = 0.f; if (j + 1 > i) w4.y = 0.f; if (j + 2 > i) w4.z = 0.f; if (j + 3 > i) w4.w = 0.f;
        *(LAS u32x2g*)(Wb + i * GLD + 8 * j4) = (u32x2g){pk2(w4.x, w4.y), pk2(w4.z, w4.w)}; }
    { const int c = tid & 127, jg = tid >> 7;
      if (32 * jg < nr) { const float* vp = VN + (size_t)(row0 + 32 * jg) * GMW + h * GHD + c; float vv[32];
#pragma unroll
          for (int j = 0; j < 32; ++j) vv[j] = vp[(size_t)j * GMW];
#pragma unroll
          for (int q = 0; q < 4; ++q) *(LAS v4u*)(Vt + c * GLD + (32 * jg + 8 * q) * 2) = (v4u){pk2(vv[8 * q], vv[8 * q + 1]), pk2(vv[8 * q + 2], vv[8 * q + 3]), pk2(vv[8 * q + 4], vv[8 * q + 5]), pk2(vv[8 * q + 6], vv[8 * q + 7])}; } }
    __syncthreads();
    float zf; asm volatile("v_mov_b32 %0, 0" : "=v"(zf));
    f32x4 acc[8];
#pragma unroll
    for (int cb = 0; cb < 8; ++cb) acc[cb] = (f32x4){zf, zf, zf, zf};
    const bool rows_live = 16 * wave < nr;
    if (rows_live) { const int nks = (wave + 2) >> 1;
        for (int ks = 0; ks < nks; ++ks) { const bf16x8 fa = *(const LAS bf16x8*)(Wb + (16 * wave + lc) * GLD + (32 * ks + 8 * g) * 2);
#pragma unroll
            for (int cb = 0; cb < 8; ++cb) acc[cb] = __builtin_amdgcn_mfma_f32_16x16x32_bf16(fa, *(const LAS bf16x8*)(Vt + (16 * cb + lc) * GLD + (32 * ks + 8 * g) * 2), acc[cb], 0, 0, 0); } }
    __syncthreads();
    if (rows_live) {
#pragma unroll
        for (int rg = 0; rg < 4; ++rg) { const int i = 16 * wave + 4 * g + rg; const float b0 = bs[i];
#pragma unroll
            for (int cb = 0; cb < 8; ++cb) So[i * GSP + 16 * cb + lc] = acc[cb][rg] + b0; } }
    __syncthreads();
    const int rq = tid >> 4, cg = tid & 15;
    if (4 * rq < nr) {
#pragma unroll
        for (int r = 0; r < 4; ++r) { const int i = 4 * rq + r; const size_t row = (size_t)(row0 + i); const v4u uu = *(const v4u*)(U + row * GMW + h * GHD + 8 * cg);
            const f32x4 s0 = *(const LAS f32x4*)(So + i * GSP + 8 * cg), s1 = *(const LAS f32x4*)(So + i * GSP + 8 * cg + 4);
            const float u0 = __builtin_bit_cast(float, uu.x << 16), u1 = __builtin_bit_cast(float, uu.x & 0xffff0000u), u2 = __builtin_bit_cast(float, uu.y << 16), u3 = __builtin_bit_cast(float, uu.y & 0xffff0000u);
            const float u4 = __builtin_bit_cast(float, uu.z << 16), u5 = __builtin_bit_cast(float, uu.z & 0xffff0000u), u6 = __builtin_bit_cast(float, uu.w << 16), u7 = __builtin_bit_cast(float, uu.w & 0xffff0000u);
            v4u o; o.x = pk2(u0 * s0.x, u1 * s0.y); o.y = pk2(u2 * s0.z, u3 * s0.w); o.z = pk2(u4 * s1.x, u5 * s1.y); o.w = pk2(u6 * s1.z, u7 * s1.w);
            *(v4u*)(MIXB + row * DM + RW + h * GHD + 8 * cg) = o; }
    }
}


constexpr int NCI = 272, NUNIT = NCI * NH;
constexpr size_t SC_G = WS_RW + 3 * RWSZ;
constexpr size_t SC_HL = SC_G + (size_t)NUNIT * 8192;
constexpr size_t SC_RP = SC_HL + (size_t)NUNIT * 16384;
constexpr size_t SC_YL = SC_RP + (size_t)NUNIT * 8192;
constexpr size_t SC_S0 = SC_YL + (size_t)NUNIT * 16384;
constexpr size_t SC_BON = SC_S0 + (size_t)NUNIT * 8192;
constexpr size_t SC_END = SC_BON + (size_t)NUNIT * 256;
static_assert(SC_END <= WS_END, "scan scratch");
constexpr size_t WS_SLAB = SC_G;
static_assert(WS_SLAB + (size_t)11 * 512 * 2048 * 4 <= WS_END, "slab");
typedef unsigned u32x2 __attribute__((ext_vector_type(2)));
constexpr int BLD = 144;
constexpr int LBUF = 9216;
constexpr int LF0 = 7 * LBUF, F0P = 129;
constexpr int LF1 = LF0 + 64 * F0P * 4, F1P = 68;
constexpr int LF2 = LF1 + 64 * F1P * 4;
constexpr int LTOT = LF2 + 16384;
constexpr int LGC = LTOT + 2048;
constexpr int SCAN_LDS = LGC + 256;
static_assert(SCAN_LDS <= RING_BYTES, "scan LDS");

__device__ __forceinline__ bf16x8 ldfrag(const LAS unsigned char* mat, int blk, int ks, int lane) { return *(const LAS bf16x8*)(mat + (16 * blk + (lane & 15)) * BLD + (32 * ks + 8 * (lane >> 4)) * 2); }
#define MFMA16(a, b, c) __builtin_amdgcn_mfma_f32_16x16x32_bf16((a), (b), (c), 0, 0, 0)

#define LDS_BAR() do { asm volatile("s_waitcnt lgkmcnt(0)" ::: "memory"); __builtin_amdgcn_s_barrier(); asm volatile("" ::: "memory"); } while (0)
__device__ __forceinline__ void scanA_all(int l, LAS unsigned char* lds, int bx, int G, int tid, int wave) {
    unsigned char* ws = KWS();
    const int lane = tid & 63;
    const float* ssh = KIN(I_SSH); const float* mu = KIN(I_MU) + (size_t)l * SHIFT;
    const float *w0p = KIN(I_W0) + (size_t)l * RW, *a0p = KIN(I_A0) + (size_t)l * RW, *kkp = KIN(I_KK) + (size_t)l * RW, *kap = KIN(I_KA) + (size_t)l * RW, *rkp = KIN(I_RK) + (size_t)l * RW;
    float pr_[8], pk_[8], pv_[8], al_[8], wl_[8]; float q_r, q_k, q_v, mu_r, mu_k, mu_v, w0c, a0c, kkc, kac, rkc;
#define SA_LOAD(unit_) do { const int ci_ = (unit_) >> 4, cc_ = 64 * ((unit_) & 15) + lane; const int m0_ = ci_ < 256 ? 64 * ci_ : TP + 32 * (ci_ - 256), n_ = ci_ < 256 ? 64 : 32, t0_ = 8 * wave; \
        const float* P_ = (const float*)(ws + B_P); const float* Wl_ = (const float*)(ws + WS_RW); const float* Al_ = (const float*)(ws + WS_RW + RWSZ); \
        mu_r = mu[cc_]; mu_k = mu[RW + cc_]; mu_v = mu[2 * RW + cc_]; w0c = w0p[cc_]; a0c = a0p[cc_]; kkc = kkp[cc_]; kac = kap[cc_]; rkc = rkp[cc_]; q_r = 0.f; q_k = 0.f; q_v = 0.f; \
        if (t0_ < n_) { const float* pp_ = prev_row(ssh, l, P_, m0_ + t0_); if (pp_) { q_r = pp_[cc_]; q_k = pp_[RW + cc_]; q_v = pp_[2 * RW + cc_]; } } \
        _Pragma("unroll") for (int i = 0; i < 8; ++i) { pr_[i] = 0.f; pk_[i] = 0.f; pv_[i] = 0.f; al_[i] = 0.f; wl_[i] = 0.f; \
            if (t0_ < n_) { const size_t m_ = (size_t)(m0_ + t0_ + i); const float* prow_ = P_ + m_ * PLD; pr_[i] = prow_[cc_]; pk_[i] = prow_[RW + cc_]; pv_[i] = prow_[2 * RW + cc_]; al_[i] = Al_[m_ * RW + cc_]; wl_[i] = Wl_[m_ * RW + cc_]; } } } while (0)
    if (bx < NUNIT) SA_LOAD(bx);
    for (int unit = bx; unit < NUNIT; unit += G) {
    const int ci = unit >> 4;
    int m0, n; if (ci < 256) { m0 = 64 * ci; n = 64; } else { m0 = TP + 32 * (ci - 256); n = 32; }
    (void)m0;
    const float* P = (const float*)(ws + B_P); const float* Wl = (const float*)(ws + WS_RW); const float* Al = (const float*)(ws + WS_RW + RWSZ);
    LAS unsigned char* B0 = lds; LAS unsigned char* B1 = lds + LBUF; LAS unsigned char* B2 = lds + 2 * LBUF; LAS unsigned char* B3 = lds + 3 * LBUF;
    LAS unsigned char* B4 = lds + 4 * LBUF; LAS unsigned char* B5 = lds + 5 * LBUF; LAS unsigned char* B6 = lds + 6 * LBUF;
    LAS float* F0 = (LAS float*)(lds + LF0); LAS float* F1 = (LAS float*)(lds + LF1); LAS float* F2 = (LAS float*)(lds + LF2); LAS float* TOT = (LAS float*)(lds + LTOT); LAS float* GC = (LAS float*)(lds + LGC);
    LDS_BAR();
    {
        const int t0 = 8 * wave; const bool live = t0 < n;
        float r[8], kp[8], v[8], kk[8], b[8], lw[8], bsv[8];
        float* bon = (float*)(ws + SC_BON) + (size_t)unit * 64;
#pragma unroll
        for (int i = 0; i < 8; ++i) {
            r[i] = 0.f; kp[i] = 0.f; v[i] = 0.f; kk[i] = 0.f; b[i] = 0.f; lw[i] = 0.f; bsv[i] = 0.f;
            if (live) {
                const float p_r = pr_[i], p_k = pk_[i], p_v = pv_[i];
                const float rr = p_r + (q_r - p_r) * mu_r, kx = p_k + (q_k - p_k) * mu_k, vx = p_v + (q_v - p_v) * mu_v; q_r = p_r; q_k = p_k; q_v = p_v;
                const float av = __builtin_amdgcn_rcpf(1.f + __expf(-(a0c + al_[i])));
                const float sg = __builtin_amdgcn_rcpf(1.f + __expf(-(w0c + wl_[i])));
                const float kkv = kx * kkc; const float n2 = wave_sum(kkv * kkv); const float kn = kkv * __builtin_amdgcn_rsqf(fmaxf(n2, 1e-24f));
                const float kpv = kx * (1.f + (av - 1.f) * kac);
                bsv[i] = wave_sum(rr * kpv * rkc);
                r[i] = rr; kp[i] = kpv; v[i] = vx; kk[i] = kn; b[i] = kn * av; lw[i] = -0.60653065971263342f * sg; }
        }
        if (live && lane < 8) { float bv = bsv[0];
#pragma unroll
            for (int i = 1; i < 8; ++i) bv = lane == i ? bsv[i] : bv;
            bon[t0 + lane] = bv; }
        if (unit + G < NUNIT) SA_LOAD(unit + G);
        float pl[8]; pl[0] = lw[0];
#pragma unroll
        for (int i = 1; i < 8; ++i) pl[i] = pl[i - 1] + lw[i];
        TOT[wave * 64 + lane] = pl[7];
        LDS_BAR();
        float off = 0.f, lamC = 0.f;
#pragma unroll
        for (int s = 0; s < 8; ++s) { const float tv = TOT[s * 64 + lane]; lamC += tv; if (s < wave) off += tv; }
        const float gC = __expf(lamC); if (wave == 0) GC[lane] = gC;
        unsigned vt[4], kb[4], bb[4];
#pragma unroll
        for (int i = 0; i < 8; ++i) { const int t = t0 + i; const float lam = off + pl[i];
            const float g_t = __expf(lam), g_p = __expf(lam - lw[i]), g_i = __expf(-lam), g_c = gC * g_i;
            const float kkt = kk[i] * g_p, rt = r[i] * g_t;
            *(LAS unsigned short*)(B0 + t * BLD + lane * 2) = (unsigned short)f2bf(kkt); F0[t * F0P + lane] = kkt;
            *(LAS unsigned short*)(B1 + t * BLD + lane * 2) = (unsigned short)f2bf(rt); F2[t * 64 + lane] = rt;
            *(LAS unsigned short*)(B2 + t * BLD + lane * 2) = (unsigned short)f2bf(kp[i] * g_i);
            *(LAS unsigned short*)(B3 + t * BLD + lane * 2) = (unsigned short)f2bf(b[i] * g_i);
            const unsigned hv = f2bf(v[i]), hk = f2bf(kp[i] * g_c), hb = f2bf(b[i] * g_c);
            if (i & 1) { vt[i >> 1] |= hv << 16; kb[i >> 1] |= hk << 16; bb[i >> 1] |= hb << 16; } else { vt[i >> 1] = hv; kb[i >> 1] = hk; bb[i >> 1] = hb; } }
        *(LAS v4u*)(B4 + lane * BLD + 16 * wave) = (v4u){vt[0], vt[1], vt[2], vt[3]};
        *(LAS v4u*)(B5 + lane * BLD + 16 * wave) = (v4u){kb[0], kb[1], kb[2], kb[3]};
        *(LAS v4u*)(B6 + lane * BLD + 16 * wave) = (v4u){bb[0], bb[1], bb[2], bb[3]};
    }
    LDS_BAR();
    const int rb = wave >> 1, cb0 = (wave & 1) * 2, g = lane >> 4, lc = lane & 15;
    float zf; asm volatile("v_mov_b32 %0, 0" : "=v"(zf));
    const f32x4 z4 = (f32x4){zf, zf, zf, zf};
    {
        f32x4 aab[2] = {z4, z4}, aak[2] = {z4, z4}, arb[2] = {z4, z4}, ark[2] = {z4, z4};
#pragma unroll
        for (int ks = 0; ks < 2; ++ks) { const bf16x8 fk = ldfrag(B0, rb, ks, lane), fr = ldfrag(B1, rb, ks, lane);
#pragma unroll
            for (int c = 0; c < 2; ++c) { const bf16x8 fkh = ldfrag(B2, cb0 + c, ks, lane), fb = ldfrag(B3, cb0 + c, ks, lane);
                aab[c] = MFMA16(fk, fb, aab[c]); aak[c] = MFMA16(fk, fkh, aak[c]); arb[c] = MFMA16(fr, fb, arb[c]); ark[c] = MFMA16(fr, fkh, ark[c]); } }
        LDS_BAR();
#pragma unroll
        for (int c = 0; c < 2; ++c)
#pragma unroll
            for (int rg = 0; rg < 4; ++rg) { const int t = 16 * rb + 4 * g + rg, s = 16 * (cb0 + c) + lc;
                F1[t * F1P + (s & 3) * 16 + (s >> 2)] = s < t ? aab[c][rg] : 0.f;
                *(LAS unsigned short*)(B0 + t * BLD + s * 2) = (unsigned short)f2bf(s < t ? aak[c][rg] : 0.f);
                *(LAS unsigned short*)(B1 + t * BLD + s * 2) = (unsigned short)f2bf(s <= t ? arb[c][rg] : 0.f);
                *(LAS unsigned short*)(B2 + t * BLD + s * 2) = (unsigned short)f2bf(s <= t ? ark[c][rg] : 0.f); }
    }
    LDS_BAR();
    {
        f32x4 av[2] = {z4, z4};
#pragma unroll
        for (int ks = 0; ks < 2; ++ks) { const bf16x8 fa = ldfrag(B0, rb, ks, lane);
#pragma unroll
            for (int c = 0; c < 2; ++c) av[c] = MFMA16(fa, ldfrag(B4, cb0 + c, ks, lane), av[c]); }
#pragma unroll
        for (int c = 0; c < 2; ++c)
#pragma unroll
            for (int rg = 0; rg < 4; ++rg) F0[(16 * rb + 4 * g + rg) * F0P + 64 + 16 * (cb0 + c) + lc] = av[c][rg];
    }
    LDS_BAR();
    {
        const int j = tid >> 2, p = tid & 3; const LAS float* f1p = F1 + p * 16; const LAS float* f0p = F0 + j;
        float x0 = zf, x1 = zf, x2 = zf, x3 = zf, x4 = zf, x5 = zf, x6 = zf, x7 = zf, x8 = zf, x9 = zf, x10 = zf, x11 = zf, x12 = zf, x13 = zf, x14 = zf, x15 = zf;
        { float part = zf; const float xt = f0p[0*F0P] - part; x0 = (p == 0) ? xt : x0; }
        { const f32x4 a0 = *(const LAS f32x4*)(f1p + 1*F1P + 0); float part = a0.x * x0; part += dpp_mov<0xB1>(part); part += dpp_mov<0x4E>(part); const float xt = f0p[1*F0P] - part; x0 = (p == 1) ? xt : x0; }
        { const f32x4 a0 = *(const LAS f32x4*)(f1p + 2*F1P + 0); float part = a0.x * x0; part += dpp_mov<0xB1>(part); part += dpp_mov<0x4E>(part); const float xt = f0p[2*F0P] - part; x0 = (p == 2) ? xt : x0; }
        { const f32x4 a0 = *(const LAS f32x4*)(f1p + 3*F1P + 0); float part = a0.x * x0; part += dpp_mov<0xB1>(part); part += dpp_mov<0x4E>(part); const float xt = f0p[3*F0P] - part; x0 = (p == 3) ? xt : x0; }
        { const f32x4 a0 = *(const LAS f32x4*)(f1p + 4*F1P + 0); float part = a0.x * x0; part += dpp_mov<0xB1>(part); part += dpp_mov<0x4E>(part); const float xt = f0p[4*F0P] - part; x1 = (p == 0) ? xt : x1; }
        { const f32x4 a0 = *(const LAS f32x4*)(f1p + 5*F1P + 0); float part = (a0.x * x0) + (a0.y * x1); part += dpp_mov<0xB1>(part); part += dpp_mov<0x4E>(part); const float xt = f0p[5*F0P] - part; x1 = (p == 1) ? xt : x1; }
        { const f32x4 a0 = *(const LAS f32x4*)(f1p + 6*F1P + 0); float part = (a0.x * x0) + (a0.y * x1); part += dpp_mov<0xB1>(part); part += dpp_mov<0x4E>(part); const float xt = f0p[6*F0P] - part; x1 = (p == 2) ? xt : x1; }
        { const f32x4 a0 = *(const LAS f32x4*)(f1p + 7*F1P + 0); float part = (a0.x * x0) + (a0.y * x1); part += dpp_mov<0xB1>(part); part += dpp_mov<0x4E>(part); const float xt = f0p[7*F0P] - part; x1 = (p == 3) ? xt : x1; }
        { const f32x4 a0 = *(const LAS f32x4*)(f1p + 8*F1P + 0); float part = (a0.x * x0) + (a0.y * x1); part += dpp_mov<0xB1>(part); part += dpp_mov<0x4E>(part); const float xt = f0p[8*F0P] - part; x2 = (p == 0) ? xt : x2; }
        { const f32x4 a0 = *(const LAS f32x4*)(f1p + 9*F1P + 0); float part = (a0.x * x0 + a0.z * x2) + (a0.y * x1); part += dpp_mov<0xB1>(part); part += dpp_mov<0x4E>(part); const float xt = f0p[9*F0P] - part; x2 = (p == 1) ? xt : x2; }
        { const f32x4 a0 = *(const LAS f32x4*)(f1p + 10*F1P + 0); float part = (a0.x * x0 + a0.z * x2) + (a0.y * x1); part += dpp_mov<0xB1>(part); part += dpp_mov<0x4E>(part); const float xt = f0p[10*F0P] - part; x2 = (p == 2) ? xt : x2; }
        { const f32x4 a0 = *(const LAS f32x4*)(f1p + 11*F1P + 0); float part = (a0.x * x0 + a0.z * x2) + (a0.y * x1); part += dpp_mov<0xB1>(part); part += dpp_mov<0x4E>(part); const float xt = f0p[11*F0P] - part; x2 = (p == 3) ? xt : x2; }
        { const f32x4 a0 = *(const LAS f32x4*)(f1p + 12*F1P + 0); float part = (a0.x * x0 + a0.z * x2) + (a0.y * x1); part += dpp_mov<0xB1>(part); part += dpp_mov<0x4E>(part); const float xt = f0p[12*F0P] - part; x3 = (p == 0) ? xt : x3; }
        { const f32x4 a0 = *(const LAS f32x4*)(f1p + 13*F1P + 0); float part = (a0.x * x0 + a0.z * x2) + (a0.y * x1 + a0.w * x3); part += dpp_mov<0xB1>(part); part += dpp_mov<0x4E>(part); const float xt = f0p[13*F0P] - part; x3 = (p == 1) ? xt : x3; }
        { const f32x4 a0 = *(const LAS f32x4*)(f1p + 14*F1P + 0); float part = (a0.x * x0 + a0.z * x2) + (a0.y * x1 + a0.w * x3); part += dpp_mov<0xB1>(part); part += dpp_mov<0x4E>(part); const float xt = f0p[14*F0P] - part; x3 = (p == 2) ? xt : x3; }
        { const f32x4 a0 = *(const LAS f32x4*)(f1p + 15*F1P + 0); float part = (a0.x * x0 + a0.z * x2) + (a0.y * x1 + a0.w * x3); part += dpp_mov<0xB1>(part); part += dpp_mov<0x4E>(part); const float xt = f0p[15*F0P] - part; x3 = (p == 3) ? xt : x3; }
        { const f32x4 a0 = *(const LAS f32x4*)(f1p + 16*F1P + 0); float part = (a0.x * x0 + a0.z * x2) + (a0.y * x1 + a0.w * x3); part += dpp_mov<0xB1>(part); part += dpp_mov<0x4E>(part); const float xt = f0p[16*F0P] - part; x4 = (p == 0) ? xt : x4; }
        { const f32x4 a0 = *(const LAS f32x4*)(f1p + 17*F1P + 0); const f32x4 a1 = *(const LAS f32x4*)(f1p + 17*F1P + 4); float part = (a0.x * x0 + a0.z * x2 + a1.x * x4) + (a0.y * x1 + a0.w * x3); part += dpp_mov<0xB1>(part); part += dpp_mov<0x4E>(part); const float xt = f0p[17*F0P] - part; x4 = (p == 1) ? xt : x4; }
        { const f32x4 a0 = *(const LAS f32x4*)(f1p + 18*F1P + 0); const f32x4 a1 = *(const LAS f32x4*)(f1p + 18*F1P + 4); float part = (a0.x * x0 + a0.z * x2 + a1.x * x4) + (a0.y * x1 + a0.w * x3); part += dpp_mov<0xB1>(part); part += dpp_mov<0x4E>(part); const float xt = f0p[18*F0P] - part; x4 = (p == 2) ? xt : x4; }
        { const f32x4 a0 = *(const LAS f32x4*)(f1p + 19*F1P + 0); const f32x4 a1 = *(const LAS f32x4*)(f1p + 19*F1P + 4); float part = (a0.x * x0 + a0.z * x2 + a1.x * x4) + (a0.y * x1 + a0.w * x3); part += dpp_mov<0xB1>(part); part += dpp_mov<0x4E>(part); const float xt = f0p[19*F0P] - part; x4 = (p == 3) ? xt : x4; }
        { const f32x4 a0 = *(const LAS f32x4*)(f1p + 20*F1P + 0); const f32x4 a1 = *(const LAS f32x4*)(f1p + 20*F1P + 4); float part = (a0.x * x0 + a0.z * x2 + a1.x * x4) + (a0.y * x1 + a0.w * x3); part += dpp_mov<0xB1>(part); part += dpp_mov<0x4E>(part); const float xt = f0p[20*F0P] - part; x5 = (p == 0) ? xt : x5; }
        { const f32x4 a0 = *(const LAS f32x4*)(f1p + 21*F1P + 0); const f32x4 a1 = *(const LAS f32x4*)(f1p + 21*F1P + 4); float part = (a0.x * x0 + a0.z * x2 + a1.x * x4) + (a0.y * x1 + a0.w * x3 + a1.y * x5); part += dpp_mov<0xB1>(part); part += dpp_mov<0x4E>(part); const float xt = f0p[21*F0P] - part; x5 = (p == 1) ? xt : x5; }
        { const f32x4 a0 = *(const LAS f32x4*)(f1p + 22*F1P + 0); const f32x4 a1 = *(const LAS f32x4*)(f1p + 22*F1P + 4); float part = (a0.x * x0 + a0.z * x2 + a1.x * x4) + (a0.y * x1 + a0.w * x3 + a1.y * x5); part += dpp_mov<0xB1>(part); part += dpp_mov<0x4E>(part); const float xt = f0p[22*F0P] - part; x5 = (p == 2) ? xt : x5; }
        { const f32x4 a0 = *(const LAS f32x4*)(f1p + 23*F1P + 0); const f32x4 a1 = *(const LAS f32x4*)(f1p + 23*F1P + 4); float part = (a0.x * x0 + a0.z * x2 + a1.x * x4) + (a0.y * x1 + a0.w * x3 + a1.y * x5); part += dpp_mov<0xB1>(part); part += dpp_mov<0x4E>(part); const float xt = f0p[23*F0P] - part; x5 = (p == 3) ? xt : x5; }
        { const f32x4 a0 = *(const LAS f32x4*)(f1p + 24*F1P + 0); const f32x4 a1 = *(const LAS f32x4*)(f1p + 24*F1P + 4); float part = (a0.x * x0 + a0.z * x2 + a1.x * x4) + (a0.y * x1 + a0.w * x3 + a1.y * x5); part += dpp_mov<0xB1>(part); part += dpp_mov<0x4E>(part); const float xt = f0p[24*F0P] - part; x6 = (p == 0) ? xt : x6; }
        { const f32x4 a0 = *(const LAS f32x4*)(f1p + 25*F1P + 0); const f32x4 a1 = *(const LAS f32x4*)(f1p + 25*F1P + 4); float part = (a0.x * x0 + a0.z * x2 + a1.x * x4 + a1.z * x6) + (a0.y * x1 + a0.w * x3 + a1.y * x5); part += dpp_mov<0xB1>(part); part += dpp_mov<0x4E>(part); const float xt = f0p[25*F0P] - part; x6 = (p == 1) ? xt : x6; }
        { const f32x4 a0 = *(const LAS f32x4*)(f1p + 26*F1P + 0); const f32x4 a1 = *(const LAS f32x4*)(f1p + 26*F1P + 4); float part = (a0.x * x0 + a0.z * x2 + a1.x * x4 + a1.z * x6) + (a0.y * x1 + a0.w * x3 + a1.y * x5); part += dpp_mov<0xB1>(part); part += dpp_mov<0x4E>(part); const float xt = f0p[26*F0P] - part; x6 = (p == 2) ? xt : x6; }
        { const f32x4 a0 = *(const LAS f32x4*)(f1p + 27*F1P + 0); const f32x4 a1 = *(const LAS f32x4*)(f1p + 27*F1P + 4); float part = (a0.x * x0 + a0.z * x2 + a1.x * x4 + a1.z * x6) + (a0.y * x1 + a0.w * x3 + a1.y * x5); part += dpp_mov<0xB1>(part); part += dpp_mov<0x4E>(part); const float xt = f0p[27*F0P] - part; x6 = (p == 3) ? xt : x6; }
        { const f32x4 a0 = *(const LAS f32x4*)(f1p + 28*F1P + 0); const f32x4 a1 = *(const LAS f32x4*)(f1p + 28*F1P + 4); float part = (a0.x * x0 + a0.z * x2 + a1.x * x4 + a1.z * x6) + (a0.y * x1 + a0.w * x3 + a1.y * x5); part += dpp_mov<0xB1>(part); part += dpp_mov<0x4E>(part); const float xt = f0p[28*F0P] - part; x7 = (p == 0) ? xt : x7; }
        { const f32x4 a0 = *(const LAS f32x4*)(f1p + 29*F1P + 0); const f32x4 a1 = *(const LAS f32x4*)(f1p + 29*F1P + 4); float part = (a0.x * x0 + a0.z * x2 + a1.x * x4 + a1.z * x6) + (a0.y * x1 + a0.w * x3 + a1.y * x5 + a1.w * x7); part += dpp_mov<0xB1>(part); part += dpp_mov<0x4E>(part); const float xt = f0p[29*F0P] - part; x7 = (p == 1) ? xt : x7; }
        { const f32x4 a0 = *(const LAS f32x4*)(f1p + 30*F1P + 0); const f32x4 a1 = *(const LAS f32x4*)(f1p + 30*F1P + 4); float part = (a0.x * x0 + a0.z * x2 + a1.x * x4 + a1.z * x6) + (a0.y * x1 + a0.w * x3 + a1.y * x5 + a1.w * x7); part += dpp_mov<0xB1>(part); part += dpp_mov<0x4E>(part); const float xt = f0p[30*F0P] - part; x7 = (p == 2) ? xt : x7; }
        { const f32x4 a0 = *(const LAS f32x4*)(f1p + 31*F1P + 0); const f32x4 a1 = *(const LAS f32x4*)(f1p + 31*F1P + 4); float part = (a0.x * x0 + a0.z * x2 + a1.x * x4 + a1.z * x6) + (a0.y * x1 + a0.w * x3 + a1.y * x5 + a1.w * x7); part += dpp_mov<0xB1>(part); part += dpp_mov<0x4E>(part); const float xt = f0p[31*F0P] - part; x7 = (p == 3) ? xt : x7; }
        { const f32x4 a0 = *(const LAS f32x4*)(f1p + 32*F1P + 0); const f32x4 a1 = *(const LAS f32x4*)(f1p + 32*F1P + 4); float part = (a0.x * x0 + a0.z * x2 + a1.x * x4 + a1.z * x6) + (a0.y * x1 + a0.w * x3 + a1.y * x5 + a1.w * x7); part += dpp_mov<0xB1>(part); part += dpp_mov<0x4E>(part); const float xt = f0p[32*F0P] - part; x8 = (p == 0) ? xt : x8; }
        { const f32x4 a0 = *(const LAS f32x4*)(f1p + 33*F1P + 0); const f32x4 a1 = *(const LAS f32x4*)(f1p + 33*F1P + 4); const f32x4 a2 = *(const LAS f32x4*)(f1p + 33*F1P + 8); float part = (a0.x * x0 + a0.z * x2 + a1.x * x4 + a1.z * x6 + a2.x * x8) + (a0.y * x1 + a0.w * x3 + a1.y * x5 + a1.w * x7); part += dpp_mov<0xB1>(part); part += dpp_mov<0x4E>(part); const float xt = f0p[33*F0P] - part; x8 = (p == 1) ? xt : x8; }
        { const f32x4 a0 = *(const LAS f32x4*)(f1p + 34*F1P + 0); const f32x4 a1 = *(const LAS f32x4*)(f1p + 34*F1P + 4); const f32x4 a2 = *(const LAS f32x4*)(f1p + 34*F1P + 8); float part = (a0.x * x0 + a0.z * x2 + a1.x * x4 + a1.z * x6 + a2.x * x8) + (a0.y * x1 + a0.w * x3 + a1.y * x5 + a1.w * x7); part += dpp_mov<0xB1>(part); part += dpp_mov<0x4E>(part); const float xt = f0p[34*F0P] - part; x8 = (p == 2) ? xt : x8; }
        { const f32x4 a0 = *(const LAS f32x4*)(f1p + 35*F1P + 0); const f32x4 a1 = *(const LAS f32x4*)(f1p + 35*F1P + 4); const f32x4 a2 = *(const LAS f32x4*)(f1p + 35*F1P + 8); float part = (a0.x * x0 + a0.z * x2 + a1.x * x4 + a1.z * x6 + a2.x * x8) + (a0.y * x1 + a0.w * x3 + a1.y * x5 + a1.w * x7); part += dpp_mov<0xB1>(part); part += dpp_mov<0x4E>(part); const float xt = f0p[35*F0P] - part; x8 = (p == 3) ? xt : x8; }
        { const f32x4 a0 = *(const LAS f32x4*)(f1p + 36*F1P + 0); const f32x4 a1 = *(const LAS f32x4*)(f1p + 36*F1P + 4); const f32x4 a2 = *(const LAS f32x4*)(f1p + 36*F1P + 8); float part = (a0.x * x0 + a0.z * x2 + a1.x * x4 + a1.z * x6 + a2.x * x8) + (a0.y * x1 + a0.w * x3 + a1.y * x5 + a1.w * x7); part += dpp_mov<0xB1>(part); part += dpp_mov<0x4E>(part); const float xt = f0p[36*F0P] - part; x9 = (p == 0) ? xt : x9; }
        { const f32x4 a0 = *(const LAS f32x4*)(f1p + 37*F1P + 0); const f32x4 a1 = *(const LAS f32x4*)(f1p + 37*F1P + 4); const f32x4 a2 = *(const LAS f32x4*)(f1p + 37*F1P + 8); float part = (a0.x * x0 + a0.z * x2 + a1.x * x4 + a1.z * x6 + a2.x * x8) + (a0.y * x1 + a0.w * x3 + a1.y * x5 + a1.w * x7 + a2.y * x9); part += dpp_mov<0xB1>(part); part += dpp_mov<0x4E>(part); const float xt = f0p[37*F0P] - part; x9 = (p == 1) ? xt : x9; }
        { const f32x4 a0 = *(const LAS f32x4*)(f1p + 38*F1P + 0); const f32x4 a1 = *(const LAS f32x4*)(f1p + 38*F1P + 4); const f32x4 a2 = *(const LAS f32x4*)(f1p + 38*F1P + 8); float part = (a0.x * x0 + a0.z * x2 + a1.x * x4 + a1.z * x6 + a2.x * x8) + (a0.y * x1 + a0.w * x3 + a1.y * x5 + a1.w * x7 + a2.y * x9); part += dpp_mov<0xB1>(part); part += dpp_mov<0x4E>(part); const float xt = f0p[38*F0P] - part; x9 = (p == 2) ? xt : x9; }
        { const f32x4 a0 = *(const LAS f32x4*)(f1p + 39*F1P + 0); const f32x4 a1 = *(const LAS f32x4*)(f1p + 39*F1P + 4); const f32x4 a2 = *(const LAS f32x4*)(f1p + 39*F1P + 8); float part = (a0.x * x0 + a0.z * x2 + a1.x * x4 + a1.z * x6 + a2.x * x8) + (a0.y * x1 + a0.w * x3 + a1.y * x5 + a1.w * x7 + a2.y * x9); part += dpp_mov<0xB1>(part); part += dpp_mov<0x4E>(part); const float xt = f0p[39*F0P] - part; x9 = (p == 3) ? xt : x9; }
        { const f32x4 a0 = *(const LAS f32x4*)(f1p + 40*F1P + 0); const f32x4 a1 = *(const LAS f32x4*)(f1p + 40*F1P + 4); const f32x4 a2 = *(const LAS f32x4*)(f1p + 40*F1P + 8); float part = (a0.x * x0 + a0.z * x2 + a1.x * x4 + a1.z * x6 + a2.x * x8) + (a0.y * x1 + a0.w * x3 + a1.y * x5 + a1.w * x7 + a2.y * x9); part += dpp_mov<0xB1>(part); part += dpp_mov<0x4E>(part); const float xt = f0p[40*F0P] - part; x10 = (p == 0) ? xt : x10; }
        { const f32x4 a0 = *(const LAS f32x4*)(f1p + 41*F1P + 0); const f32x4 a1 = *(const LAS f32x4*)(f1p + 41*F1P + 4); const f32x4 a2 = *(const LAS f32x4*)(f1p + 41*F1P + 8); float part = (a0.x * x0 + a0.z * x2 + a1.x * x4 + a1.z * x6 + a2.x * x8 + a2.z * x10) + (a0.y * x1 + a0.w * x3 + a1.y * x5 + a1.w * x7 + a2.y * x9); part += dpp_mov<0xB1>(part); part += dpp_mov<0x4E>(part); const float xt = f0p[41*F0P] - part; x10 = (p == 1) ? xt : x10; }
        { const f32x4 a0 = *(const LAS f32x4*)(f1p + 42*F1P + 0); const f32x4 a1 = *(const LAS f32x4*)(f1p + 42*F1P + 4); const f32x4 a2 = *(const LAS f32x4*)(f1p + 42*F1P + 8); float part = (a0.x * x0 + a0.z * x2 + a1.x * x4 + a1.z * x6 + a2.x * x8 + a2.z * x10) + (a0.y * x1 + a0.w * x3 + a1.y * x5 + a1.w * x7 + a2.y * x9); part += dpp_mov<0xB1>(part); part += dpp_mov<0x4E>(part); const float xt = f0p[42*F0P] - part; x10 = (p == 2) ? xt : x10; }
        { const f32x4 a0 = *(const LAS f32x4*)(f1p + 43*F1P + 0); const f32x4 a1 = *(const LAS f32x4*)(f1p + 43*F1P + 4); const f32x4 a2 = *(const LAS f32x4*)(f1p + 43*F1P + 8); float part = (a0.x * x0 + a0.z * x2 + a1.x * x4 + a1.z * x6 + a2.x * x8 + a2.z * x10) + (a0.y * x1 + a0.w * x3 + a1.y * x5 + a1.w * x7 + a2.y * x9); part += dpp_mov<0xB1>(part); part += dpp_mov<0x4E>(part); const float xt = f0p[43*F0P] - part; x10 = (p == 3) ? xt : x10; }
        { const f32x4 a0 = *(const LAS f32x4*)(f1p + 44*F1P + 0); const f32x4 a1 = *(const LAS f32x4*)(f1p + 44*F1P + 4); const f32x4 a2 = *(const LAS f32x4*)(f1p + 44*F1P + 8); float part = (a0.x * x0 + a0.z * x2 + a1.x * x4 + a1.z * x6 + a2.x * x8 + a2.z * x10) + (a0.y * x1 + a0.w * x3 + a1.y * x5 + a1.w * x7 + a2.y * x9); part += dpp_mov<0xB1>(part); part += dpp_mov<0x4E>(part); const float xt = f0p[44*F0P] - part; x11 = (p == 0) ? xt : x11; }
        { const f32x4 a0 = *(const LAS f32x4*)(f1p + 45*F1P + 0); const f32x4 a1 = *(const LAS f32x4*)(f1p + 45*F1P + 4); const f32x4 a2 = *(const LAS f32x4*)(f1p + 45*F1P + 8); float part = (a0.x * x0 + a0.z * x2 + a1.x * x4 + a1.z * x6 + a2.x * x8 + a2.z * x10) + (a0.y * x1 + a0.w * x3 + a1.y * x5 + a1.w * x7 + a2.y * x9 + a2.w * x11); part += dpp_mov<0xB1>(part); part += dpp_mov<0x4E>(part); const float xt = f0p[45*F0P] - part; x11 = (p == 1) ? xt : x11; }
        { const f32x4 a0 = *(const LAS f32x4*)(f1p + 46*F1P + 0); const f32x4 a1 = *(const LAS f32x4*)(f1p + 46*F1P + 4); const f32x4 a2 = *(const LAS f32x4*)(f1p + 46*F1P + 8); float part = (a0.x * x0 + a0.z * x2 + a1.x * x4 + a1.z * x6 + a2.x * x8 + a2.z * x10) + (a0.y * x1 + a0.w * x3 + a1.y * x5 + a1.w * x7 + a2.y * x9 + a2.w * x11); part += dpp_mov<0xB1>(part); part += dpp_mov<0x4E>(part); const float xt = f0p[46*F0P] - part; x11 = (p == 2) ? xt : x11; }
        { const f32x4 a0 = *(const LAS f32x4*)(f1p + 47*F1P + 0); const f32x4 a1 = *(const LAS f32x4*)(f1p + 47*F1P + 4); const f32x4 a2 = *(const LAS f32x4*)(f1p + 47*F1P + 8); float part = (a0.x * x0 + a0.z * x2 + a1.x * x4 + a1.z * x6 + a2.x * x8 + a2.z * x10) + (a0.y * x1 + a0.w * x3 + a1.y * x5 + a1.w * x7 + a2.y * x9 + a2.w * x11); part += dpp_mov<0xB1>(part); part += dpp_mov<0x4E>(part); const float xt = f0p[47*F0P] - part; x11 = (p == 3) ? xt : x11; }
        { const f32x4 a0 = *(const LAS f32x4*)(f1p + 48*F1P + 0); const f32x4 a1 = *(const LAS f32x4*)(f1p + 48*F1P + 4); const f32x4 a2 = *(const LAS f32x4*)(f1p + 48*F1P + 8); float part = (a0.x * x0 + a0.z * x2 + a1.x * x4 + a1.z * x6 + a2.x * x8 + a2.z * x10) + (a0.y * x1 + a0.w * x3 + a1.y * x5 + a1.w * x7 + a2.y * x9 + a2.w * x11); part += dpp_mov<0xB1>(part); part += dpp_mov<0x4E>(part); const float xt = f0p[48*F0P] - part; x12 = (p == 0) ? xt : x12; }
        { const f32x4 a0 = *(const LAS f32x4*)(f1p + 49*F1P + 0); const f32x4 a1 = *(const LAS f32x4*)(f1p + 49*F1P + 4); const f32x4 a2 = *(const LAS f32x4*)(f1p + 49*F1P + 8); const f32x4 a3 = *(const LAS f32x4*)(f1p + 49*F1P + 12); float part = (a0.x * x0 + a0.z * x2 + a1.x * x4 + a1.z * x6 + a2.x * x8 + a2.z * x10 + a3.x * x12) + (a0.y * x1 + a0.w * x3 + a1.y * x5 + a1.w * x7 + a2.y * x9 + a2.w * x11); part += dpp_mov<0xB1>(part); part += dpp_mov<0x4E>(part); const float xt = f0p[49*F0P] - part; x12 = (p == 1) ? xt : x12; }
        { const f32x4 a0 = *(const LAS f32x4*)(f1p + 50*F1P + 0); const f32x4 a1 = *(const LAS f32x4*)(f1p + 50*F1P + 4); const f32x4 a2 = *(const LAS f32x4*)(f1p + 50*F1P + 8); const f32x4 a3 = *(const LAS f32x4*)(f1p + 50*F1P + 12); float part = (a0.x * x0 + a0.z * x2 + a1.x * x4 + a1.z * x6 + a2.x * x8 + a2.z * x10 + a3.x * x12) + (a0.y * x1 + a0.w * x3 + a1.y * x5 + a1.w * x7 + a2.y * x9 + a2.w * x11); part += dpp_mov<0xB1>(part); part += dpp_mov<0x4E>(part); const float xt = f0p[50*F0P] - part; x12 = (p == 2) ? xt : x12; }
        { const f32x4 a0 = *(const LAS f32x4*)(f1p + 51*F1P + 0); const f32x4 a1 = *(const LAS f32x4*)(f1p + 51*F1P + 4); const f32x4 a2 = *(const LAS f32x4*)(f1p + 51*F1P + 8); const f32x4 a3 = *(const LAS f32x4*)(f1p + 51*F1P + 12); float part = (a0.x * x0 + a0.z * x2 + a1.x * x4 + a1.z * x6 + a2.x * x8 + a2.z * x10 + a3.x * x12) + (a0.y * x1 + a0.w * x3 + a1.y * x5 + a1.w * x7 + a2.y * x9 + a2.w * x11); part += dpp_mov<0xB1>(part); part += dpp_mov<0x4E>(part); const float xt = f0p[51*F0P] - part; x12 = (p == 3) ? xt : x12; }
        { const f32x4 a0 = *(const LAS f32x4*)(f1p + 52*F1P + 0); const f32x4 a1 = *(const LAS f32x4*)(f1p + 52*F1P + 4); const f32x4 a2 = *(const LAS f32x4*)(f1p + 52*F1P + 8); const f32x4 a3 = *(const LAS f32x4*)(f1p + 52*F1P + 12); float part = (a0.x * x0 + a0.z * x2 + a1.x * x4 + a1.z * x6 + a2.x * x8 + a2.z * x10 + a3.x * x12) + (a0.y * x1 + a0.w * x3 + a1.y * x5 + a1.w * x7 + a2.y * x9 + a2.w * x11); part += dpp_mov<0xB1>(part); part += dpp_mov<0x4E>(part); const float xt = f0p[52*F0P] - part; x13 = (p == 0) ? xt : x13; }
        { const f32x4 a0 = *(const LAS f32x4*)(f1p + 53*F1P + 0); const f32x4 a1 = *(const LAS f32x4*)(f1p + 53*F1P + 4); const f32x4 a2 = *(const LAS f32x4*)(f1p + 53*F1P + 8); const f32x4 a3 = *(const LAS f32x4*)(f1p + 53*F1P + 12); float part = (a0.x * x0 + a0.z * x2 + a1.x * x4 + a1.z * x6 + a2.x * x8 + a2.z * x10 + a3.x * x12) + (a0.y * x1 + a0.w * x3 + a1.y * x5 + a1.w * x7 + a2.y * x9 + a2.w * x11 + a3.y * x13); part += dpp_mov<0xB1>(part); part += dpp_mov<0x4E>(part); const float xt = f0p[53*F0P] - part; x13 = (p == 1) ? xt : x13; }
        { const f32x4 a0 = *(const LAS f32x4*)(f1p + 54*F1P + 0); const f32x4 a1 = *(const LAS f32x4*)(f1p + 54*F1P + 4); const f32x4 a2 = *(const LAS f32x4*)(f1p + 54*F1P + 8); const f32x4 a3 = *(const LAS f32x4*)(f1p + 54*F1P + 12); float part = (a0.x * x0 + a0.z * x2 + a1.x * x4 + a1.z * x6 + a2.x * x8 + a2.z * x10 + a3.x * x12) + (a0.y * x1 + a0.w * x3 + a1.y * x5 + a1.w * x7 + a2.y * x9 + a2.w * x11 + a3.y * x13); part += dpp_mov<0xB1>(part); part += dpp_mov<0x4E>(part); const float xt = f0p[54*F0P] - part; x13 = (p == 2) ? xt : x13; }
        { const f32x4 a0 = *(const LAS f32x4*)(f1p + 55*F1P + 0); const f32x4 a1 = *(const LAS f32x4*)(f1p + 55*F1P + 4); const f32x4 a2 = *(const LAS f32x4*)(f1p + 55*F1P + 8); const f32x4 a3 = *(const LAS f32x4*)(f1p + 55*F1P + 12); float part = (a0.x * x0 + a0.z * x2 + a1.x * x4 + a1.z * x6 + a2.x * x8 + a2.z * x10 + a3.x * x12) + (a0.y * x1 + a0.w * x3 + a1.y * x5 + a1.w * x7 + a2.y * x9 + a2.w * x11 + a3.y * x13); part += dpp_mov<0xB1>(part); part += dpp_mov<0x4E>(part); const float xt = f0p[55*F0P] - part; x13 = (p == 3) ? xt : x13; }
        { const f32x4 a0 = *(const LAS f32x4*)(f1p + 56*F1P + 0); const f32x4 a1 = *(const LAS f32x4*)(f1p + 56*F1P + 4); const f32x4 a2 = *(const LAS f32x4*)(f1p + 56*F1P + 8); const f32x4 a3 = *(const LAS f32x4*)(f1p + 56*F1P + 12); float part = (a0.x * x0 + a0.z * x2 + a1.x * x4 + a1.z * x6 + a2.x * x8 + a2.z * x10 + a3.x * x12) + (a0.y * x1 + a0.w * x3 + a1.y * x5 + a1.w * x7 + a2.y * x9 + a2.w * x11 + a3.y * x13); part += dpp_mov<0xB1>(part); part += dpp_mov<0x4E>(part); const float xt = f0p[56*F0P] - part; x14 = (p == 0) ? xt : x14; }
        { const f32x4 a0 = *(const LAS f32x4*)(f1p + 57*F1P + 0); const f32x4 a1 = *(const LAS f32x4*)(f1p + 57*F1P + 4); const f32x4 a2 = *(const LAS f32x4*)(f1p + 57*F1P + 8); const f32x4 a3 = *(const LAS f32x4*)(f1p + 57*F1P + 12); float part = (a0.x * x0 + a0.z * x2 + a1.x * x4 + a1.z * x6 + a2.x * x8 + a2.z * x10 + a3.x * x12 + a3.z * x14) + (a0.y * x1 + a0.w * x3 + a1.y * x5 + a1.w * x7 + a2.y * x9 + a2.w * x11 + a3.y * x13); part += dpp_mov<0xB1>(part); part += dpp_mov<0x4E>(part); const float xt = f0p[57*F0P] - part; x14 = (p == 1) ? xt : x14; }
        { const f32x4 a0 = *(const LAS f32x4*)(f1p + 58*F1P + 0); const f32x4 a1 = *(const LAS f32x4*)(f1p + 58*F1P + 4); const f32x4 a2 = *(const LAS f32x4*)(f1p + 58*F1P + 8); const f32x4 a3 = *(const LAS f32x4*)(f1p + 58*F1P + 12); float part = (a0.x * x0 + a0.z * x2 + a1.x * x4 + a1.z * x6 + a2.x * x8 + a2.z * x10 + a3.x * x12 + a3.z * x14) + (a0.y * x1 + a0.w * x3 + a1.y * x5 + a1.w * x7 + a2.y * x9 + a2.w * x11 + a3.y * x13); part += dpp_mov<0xB1>(part); part += dpp_mov<0x4E>(part); const float xt = f0p[58*F0P] - part; x14 = (p == 2) ? xt : x14; }
        { const f32x4 a0 = *(const LAS f32x4*)(f1p + 59*F1P + 0); const f32x4 a1 = *(const LAS f32x4*)(f1p + 59*F1P + 4); const f32x4 a2 = *(const LAS f32x4*)(f1p + 59*F1P + 8); const f32x4 a3 = *(const LAS f32x4*)(f1p + 59*F1P + 12); float part = (a0.x * x0 + a0.z * x2 + a1.x * x4 + a1.z * x6 + a2.x * x8 + a2.z * x10 + a3.x * x12 + a3.z * x14) + (a0.y * x1 + a0.w * x3 + a1.y * x5 + a1.w * x7 + a2.y * x9 + a2.w * x11 + a3.y * x13); part += dpp_mov<0xB1>(part); part += dpp_mov<0x4E>(part); const float xt = f0p[59*F0P] - part; x14 = (p == 3) ? xt : x14; }
        { const f32x4 a0 = *(const LAS f32x4*)(f1p + 60*F1P + 0); const f32x4 a1 = *(const LAS f32x4*)(f1p + 60*F1P + 4); const f32x4 a2 = *(const LAS f32x4*)(f1p + 60*F1P + 8); const f32x4 a3 = *(const LAS f32x4*)(f1p + 60*F1P + 12); float part = (a0.x * x0 + a0.z * x2 + a1.x * x4 + a1.z * x6 + a2.x * x8 + a2.z * x10 + a3.x * x12 + a3.z * x14) + (a0.y * x1 + a0.w * x3 + a1.y * x5 + a1.w * x7 + a2.y * x9 + a2.w * x11 + a3.y * x13); part += dpp_mov<0xB1>(part); part += dpp_mov<0x4E>(part); const float xt = f0p[60*F0P] - part; x15 = (p == 0) ? xt : x15; }
        { const f32x4 a0 = *(const LAS f32x4*)(f1p + 61*F1P + 0); const f32x4 a1 = *(const LAS f32x4*)(f1p + 61*F1P + 4); const f32x4 a2 = *(const LAS f32x4*)(f1p + 61*F1P + 8); const f32x4 a3 = *(const LAS f32x4*)(f1p + 61*F1P + 12); float part = (a0.x * x0 + a0.z * x2 + a1.x * x4 + a1.z * x6 + a2.x * x8 + a2.z * x10 + a3.x * x12 + a3.z * x14) + (a0.y * x1 + a0.w * x3 + a1.y * x5 + a1.w * x7 + a2.y * x9 + a2.w * x11 + a3.y * x13 + a3.w * x15); part += dpp_mov<0xB1>(part); part += dpp_mov<0x4E>(part); const float xt = f0p[61*F0P] - part; x15 = (p == 1) ? xt : x15; }
        { const f32x4 a0 = *(const LAS f32x4*)(f1p + 62*F1P + 0); const f32x4 a1 = *(const LAS f32x4*)(f1p + 62*F1P + 4); const f32x4 a2 = *(const LAS f32x4*)(f1p + 62*F1P + 8); const f32x4 a3 = *(const LAS f32x4*)(f1p + 62*F1P + 12); float part = (a0.x * x0 + a0.z * x2 + a1.x * x4 + a1.z * x6 + a2.x * x8 + a2.z * x10 + a3.x * x12 + a3.z * x14) + (a0.y * x1 + a0.w * x3 + a1.y * x5 + a1.w * x7 + a2.y * x9 + a2.w * x11 + a3.y * x13 + a3.w * x15); part += dpp_mov<0xB1>(part); part += dpp_mov<0x4E>(part); const float xt = f0p[62*F0P] - part; x15 = (p == 2) ? xt : x15; }
        { const f32x4 a0 = *(const LAS f32x4*)(f1p + 63*F1P + 0); const f32x4 a1 = *(const LAS f32x4*)(f1p + 63*F1P + 4); const f32x4 a2 = *(const LAS f32x4*)(f1p + 63*F1P + 8); const f32x4 a3 = *(const LAS f32x4*)(f1p + 63*F1P + 12); float part = (a0.x * x0 + a0.z * x2 + a1.x * x4 + a1.z * x6 + a2.x * x8 + a2.z * x10 + a3.x * x12 + a3.z * x14) + (a0.y * x1 + a0.w * x3 + a1.y * x5 + a1.w * x7 + a2.y * x9 + a2.w * x11 + a3.y * x13 + a3.w * x15); part += dpp_mov<0xB1>(part); part += dpp_mov<0x4E>(part); const float xt = f0p[63*F0P] - part; x15 = (p == 3) ? xt : x15; }
        LAS unsigned char* dst = (wave < 4 ? B3 : B0) + (j & 63) * BLD + p * 2;
        *(LAS unsigned short*)(dst + 0) = (unsigned short)f2bf(-x0);
        *(LAS unsigned short*)(dst + 8) = (unsigned short)f2bf(-x1);
        *(LAS unsigned short*)(dst + 16) = (unsigned short)f2bf(-x2);
        *(LAS unsigned short*)(dst + 24) = (unsigned short)f2bf(-x3);
        *(LAS unsigned short*)(dst + 32) = (unsigned short)f2bf(-x4);
        *(LAS unsigned short*)(dst + 40) = (unsigned short)f2bf(-x5);
        *(LAS unsigned short*)(dst + 48) = (unsigned short)f2bf(-x6);
        *(LAS unsigned short*)(dst + 56) = (unsigned short)f2bf(-x7);
        *(LAS unsigned short*)(dst + 64) = (unsigned short)f2bf(-x8);
        *(LAS unsigned short*)(dst + 72) = (unsigned short)f2bf(-x9);
        *(LAS unsigned short*)(dst + 80) = (unsigned short)f2bf(-x10);
        *(LAS unsigned short*)(dst + 88) = (unsigned short)f2bf(-x11);
        *(LAS unsigned short*)(dst + 96) = (unsigned short)f2bf(-x12);
        *(LAS unsigned short*)(dst + 104) = (unsigned short)f2bf(-x13);
        *(LAS unsigned short*)(dst + 112) = (unsigned short)f2bf(-x14);
        *(LAS unsigned short*)(dst + 120) = (unsigned short)f2bf(-x15);
    }
    LDS_BAR();
    {
        f32x4 rpT[2], yl[2] = {z4, z4}, gT[2], hl[2] = {z4, z4};
#pragma unroll
        for (int c = 0; c < 2; ++c) { const int colx = 16 * (cb0 + c) + lc; rpT[c] = *(const LAS f32x4*)(F2 + colx * 64 + 16 * rb + 4 * g);
#pragma unroll
            for (int rg = 0; rg < 4; ++rg) { const int row = 16 * rb + 4 * g + rg; gT[c][rg] = row == colx ? GC[row] : 0.f; } }
#pragma unroll
        for (int ks = 0; ks < 2; ++ks) { const bf16x8 fnp = ldfrag(B3, rb, ks, lane), farb = ldfrag(B1, rb, ks, lane), fark = ldfrag(B2, rb, ks, lane), fbb = ldfrag(B6, rb, ks, lane), fkb = ldfrag(B5, rb, ks, lane);
#pragma unroll
            for (int c = 0; c < 2; ++c) { const bf16x8 carb = ldfrag(B1, cb0 + c, ks, lane), cbb = ldfrag(B6, cb0 + c, ks, lane), fq = ldfrag(B0, cb0 + c, ks, lane), fv = ldfrag(B4, cb0 + c, ks, lane);
                rpT[c] = MFMA16(fnp, carb, rpT[c]);
                gT[c] = MFMA16(fnp, cbb, gT[c]);
                yl[c] = MFMA16(fark, fv, yl[c]); yl[c] = MFMA16(farb, fq, yl[c]);
                hl[c] = MFMA16(fkb, fv, hl[c]); hl[c] = MFMA16(fbb, fq, hl[c]); } }
        bf16* RPg = (bf16*)(ws + SC_RP) + (size_t)unit * 4096; float* YLg = (float*)(ws + SC_YL) + (size_t)unit * 4096; bf16* Gg_ = (bf16*)(ws + SC_G) + (size_t)unit * 4096; float* HLg = (float*)(ws + SC_HL) + (size_t)unit * 4096;
#pragma unroll
        for (int c = 0; c < 2; ++c) { const int o = (16 * (cb0 + c) + lc) * 64 + 16 * rb + 4 * g;
            *(u32x2*)(RPg + o) = (u32x2){pk2(rpT[c][0], rpT[c][1]), pk2(rpT[c][2], rpT[c][3])};
            *(u32x2*)(Gg_ + o) = (u32x2){pk2(gT[c][0], gT[c][1]), pk2(gT[c][2], gT[c][3])};
            *(f32x4*)(HLg + o) = hl[c];
            *(f32x4*)(YLg + ((rb * 4 + cb0 + c) * 64 + lane) * 4) = yl[c]; }
    }
    }
#undef SA_LOAD
}

template <int NSTEP> __device__ __forceinline__ void scanB_chain(int l, LAS unsigned char* lds, int ci0, int h, int vs, const float* init, float* outp_state, int tid, int wave) {
    unsigned char* ws = KWS();
    const int lane = tid & 63, half = wave >> 2, jr = wave & 3, g = lane >> 4, lc = lane & 15;
    LAS unsigned char* XH = lds + half * 16384;
    const bf16* Gall = (const bf16*)(ws + SC_G); const float* HLall = (const float*)(ws + SC_HL); bf16* S0all = (bf16*)(ws + SC_S0);
    float zf; asm volatile("v_mov_b32 %0, 0" : "=v"(zf));
    f32x4 acc = (f32x4){zf, zf, zf, zf};
    __syncthreads();
    if (init) acc = *(const f32x4*)(init + (16 * vs + lc) * 64 + 16 * jr + 4 * g);
    constexpr int PF = NSTEP >= 16 ? 8 : 1;
    bf16x8 GA[PF][2], GB[PF][2]; f32x4 LA[PF], LB[PF];
#define SB_ISSUE(Gx, Lx, slot, c) do { const size_t unit_ = (size_t)(ci0 + (c)) * 16 + h; const bf16* Gp = Gall + unit_ * 4096 + (16 * jr + lc) * 64 + 8 * g; const float* Lp = HLall + unit_ * 4096 + (16 * vs + lc) * 64 + 16 * jr + 4 * g; \
        Gx[slot][0] = *(const bf16x8*)Gp; Gx[slot][1] = *(const bf16x8*)(Gp + 32); Lx[slot] = *(const f32x4*)Lp; } while (0)
#define SB_STEP(Gx, Lx, slot, c) do { const size_t unit = (size_t)(ci0 + (c)) * 16 + h; LAS unsigned char* xb = XH + ((c) & 1) * 8192; \
        const unsigned h0 = pk2(acc.x, acc.y), h1 = pk2(acc.z, acc.w); \
        const float l0 = acc.x - __builtin_bit_cast(float, h0 << 16), l1 = acc.y - __builtin_bit_cast(float, h0 & 0xffff0000u), l2 = acc.z - __builtin_bit_cast(float, h1 << 16), l3 = acc.w - __builtin_bit_cast(float, h1 & 0xffff0000u); \
        *(LAS u32x2*)(xb + lc * BLD + (16 * jr + 4 * g) * 2) = (u32x2){h0, h1}; \
        *(LAS u32x2*)(xb + 4096 + lc * BLD + (16 * jr + 4 * g) * 2) = (u32x2){pk2(l0, l1), pk2(l2, l3)}; \
        *(u32x2*)(S0all + unit * 4096 + (16 * vs + lc) * 64 + 16 * jr + 4 * g) = (u32x2){h0, h1};              \
        asm volatile("s_waitcnt lgkmcnt(0)" ::: "memory"); __builtin_amdgcn_s_barrier(); asm volatile("" ::: "memory");     \
        f32x4 a2 = Lx[slot]; \
        _Pragma("unroll") for (int ks = 0; ks < 2; ++ks) { const bf16x8 bh = *(const LAS bf16x8*)(xb + lc * BLD + (32 * ks + 8 * g) * 2), bl = *(const LAS bf16x8*)(xb + 4096 + lc * BLD + (32 * ks + 8 * g) * 2); \
            a2 = MFMA16(Gx[slot][ks], bh, a2); a2 = MFMA16(Gx[slot][ks], bl, a2); } \
        acc = a2; } while (0)
    if constexpr (NSTEP < 16) {
        for (int c = 0; c < NSTEP; ++c) { SB_ISSUE(GA, LA, 0, c); SB_STEP(GA, LA, 0, c); }
    } else {
        static_assert(NSTEP < 16 || NSTEP % 16 == 0, "pass B group structure");
#pragma unroll
        for (int s = 0; s < PF; ++s) SB_ISSUE(GA, LA, s, s);
        for (int c0 = 0; c0 < NSTEP; c0 += 16) {
            SB_STEP(GA, LA, 0, c0);
#pragma unroll
            for (int s = 0; s < PF; ++s) SB_ISSUE(GB, LB, s, c0 + 8 + s);
#pragma unroll
            for (int s = 1; s < PF; ++s) SB_STEP(GA, LA, s, c0 + s);
            SB_STEP(GB, LB, 0, c0 + 8);
            if (c0 + 16 < NSTEP) {
#pragma unroll
                for (int s = 0; s < PF; ++s) SB_ISSUE(GA, LA, s, c0 + 16 + s); }
#pragma unroll
            for (int s = 1; s < PF; ++s) SB_STEP(GB, LB, s, c0 + 8 + s);
        }
    }
    *(f32x4*)(outp_state + (16 * vs + lc) * 64 + 16 * jr + 4 * g) = acc;
#undef SB_ISSUE
#undef SB_STEP
}

template <int NSTEP> __device__ __forceinline__ void scanB_idle() { __syncthreads(); for (int c = 0; c < NSTEP; ++c) { asm volatile("" ::: "memory"); __builtin_amdgcn_s_barrier(); asm volatile("" ::: "memory"); } }

__device__ __forceinline__ void scanC_all(int l, LAS unsigned char* lds, int bx, int G, int tid, int wave) {
    unsigned char* ws = KWS();
    const int lane = tid & 63, rb = wave >> 1, cb0 = (wave & 1) * 2, g = lane >> 4, lc = lane & 15, t0 = 8 * wave;
    const float* ssh = KIN(I_SSH); const float* mu = KIN(I_MU) + (size_t)l * SHIFT; const float* gngp = KIN(I_GNG) + (size_t)l * RW; const float* gnbp = KIN(I_GNB) + (size_t)l * RW;
    const float* P = (const float*)(ws + B_P); const float* Gg = (const float*)(ws + WS_RW + 2 * RWSZ); bf16* MIXB = (bf16*)(ws + B_MIX);
    LAS float* Yl = (LAS float*)lds;
    f32x4 acc[2]; bf16x8 fa[2], fb[2][2]; float pv_[8], gt_[8], bn_[8], q_v, mu_v, gng, gnb;
#define SC_LOAD_A(unit_) do { const bf16* RPg = (const bf16*)(ws + SC_RP) + (size_t)(unit_) * 4096; const float* YLg = (const float*)(ws + SC_YL) + (size_t)(unit_) * 4096; const bf16* S0g = (const bf16*)(ws + SC_S0) + (size_t)(unit_) * 4096; \
        _Pragma("unroll") for (int c = 0; c < 2; ++c) acc[c] = *(const f32x4*)(YLg + ((rb * 4 + cb0 + c) * 64 + lane) * 4); \
        _Pragma("unroll") for (int ks = 0; ks < 2; ++ks) { fa[ks] = *(const bf16x8*)(RPg + (16 * rb + lc) * 64 + 32 * ks + 8 * g); _Pragma("unroll") for (int c = 0; c < 2; ++c) fb[ks][c] = *(const bf16x8*)(S0g + (16 * (cb0 + c) + lc) * 64 + 32 * ks + 8 * g); } } while (0)
#define SC_LOAD_B(unit_) do { const int ci_ = (unit_) >> 4, cc_ = 64 * ((unit_) & 15) + lane; const int m0_ = ci_ < 256 ? 64 * ci_ : TP + 32 * (ci_ - 256), n_ = ci_ < 256 ? 64 : 32; const float* bon_ = (const float*)(ws + SC_BON) + (size_t)(unit_) * 64; \
        mu_v = mu[2 * RW + cc_]; gng = gngp[cc_]; gnb = gnbp[cc_]; q_v = 0.f; \
        _Pragma("unroll") for (int i = 0; i < 8; ++i) { pv_[i] = 0.f; gt_[i] = 0.f; bn_[i] = 0.f; } \
        if (t0 < n_) { const float* pp_ = prev_row(ssh, l, P, m0_ + t0); if (pp_) q_v = pp_[2 * RW + cc_]; \
            _Pragma("unroll") for (int i = 0; i < 8; ++i) { const size_t m_ = (size_t)(m0_ + t0 + i); pv_[i] = P[m_ * PLD + 2 * RW + cc_]; gt_[i] = Gg[m_ * RW + cc_]; bn_[i] = bon_[t0 + i]; } } } while (0)
    if (bx < NUNIT) { SC_LOAD_A(bx); SC_LOAD_B(bx); }
    for (int unit = bx; unit < NUNIT; unit += G) {
        const int ci = unit >> 4, cc = 64 * (unit & 15) + lane; const int m0 = ci < 256 ? 64 * ci : TP + 32 * (ci - 256), n = ci < 256 ? 64 : 32;
        f32x4 y2[2] = {acc[0], acc[1]};
#pragma unroll
        for (int ks = 0; ks < 2; ++ks)
#pragma unroll
            for (int c = 0; c < 2; ++c) y2[c] = MFMA16(fa[ks], fb[ks][c], y2[c]);
        if (unit + G < NUNIT) SC_LOAD_A(unit + G);
        LDS_BAR();
#pragma unroll
        for (int c = 0; c < 2; ++c)
#pragma unroll
            for (int rg = 0; rg < 4; ++rg) Yl[(16 * rb + 4 * g + rg) * 65 + 16 * (cb0 + c) + lc] = y2[c][rg];
        LDS_BAR();
        unsigned short ov[8];
        if (t0 < n) {
            float qv = q_v;
#pragma unroll
            for (int i = 0; i < 8; ++i) { const int t = t0 + i;
                const float y = Yl[t * 65 + lane]; const float ym = wave_sum(y) * (1.f / HN); const float d = y - ym; const float yv = wave_sum(d * d) * (1.f / HN);
                const float yn = d * (1.f / sqrtf(yv + GN_EPS)) * gng + gnb;
                const float p_v = pv_[i]; const float vx = p_v + (qv - p_v) * mu_v; qv = p_v;
                ov[i] = (unsigned short)f2bf((yn + bn_[i] * vx) * gt_[i]); }
        }
        if (unit + G < NUNIT) SC_LOAD_B(unit + G);
        if (t0 < n) {
#pragma unroll
            for (int i = 0; i < 8; ++i) MIXB[(size_t)(m0 + t0 + i) * DM + cc] = (bf16)ov[i];
        }
    }
#undef SC_LOAD_A
#undef SC_LOAD_B
}

template <int PH> __global__ void __launch_bounds__(NTHR, 2) mk_fwd(Args a) {
    extern __shared__ __attribute__((aligned(16))) unsigned char lds_raw[];
    LAS unsigned char* lds = (LAS unsigned char*)lds_raw;
    const int wave_s = __builtin_amdgcn_readfirstlane((int)threadIdx.x >> 6);
    for (int u = threadIdx.x; u < (LDS_BYTES - LDSCTL_OFF) / 4; u += NTHR) ((LAS unsigned*)(lds + LDSCTL_OFF))[u] = 0u;
    __syncthreads();
    if (PH < 0) (void)xcd_barrier_post((unsigned*)KWS() + CW_BAR, (volatile LAS unsigned*)(lds + MISC_OFF) + 8, (int)threadIdx.x);
#define IN(k) (PH < 0 || PH == (k))
#define PHASE_IDS() int tid_; asm volatile("v_mbcnt_lo_u32_b32 %0, -1, 0\n\tv_mbcnt_hi_u32_b32 %0, -1, %0\n\tv_lshl_add_u32 %0, %1, 6, %0" : "=&v"(tid_) : "s"(wave_s)); const int tid = tid_, lane = tid & 63, wave = wave_s; \
    const int G = gridDim.x, bx = blockIdx.x, vcu = (G % 8 == 0) ? (bx % 8) * (G / 8) + bx / 8 : bx, gw = vcu * NWAVES + wave, NGW = G * NWAVES; unsigned char* ws = KWS(); (void)tid; (void)lane; (void)gw; (void)NGW; (void)ws
#define SEAM() do { if (PH < 0) { XcdBarrier bar_; bar_.bar = (unsigned*)KWS() + CW_BAR; bar_.x = xb_xcc_id(); bar_.st = (volatile LAS unsigned*)(lds + MISC_OFF) + 8; xcd_barrier(bar_, tid); } } while (0)

    for (int l = a.l_lo; l < a.l_hi; ++l) {
        const int par = l & 1;
        if (IN(0) && (PH >= 0 || l == a.l_lo)) { PHASE_IDS(); phase_convert(l, par, 0, CV_NTASK, true, l == 0, lane, gw, NGW); SEAM(); }
#define CVT_TAIL(nwg, t_lo, t_hi, small) do { if (PH < 0 && l + 1 < a.l_hi) { const int rounds_ = ((nwg) + G - 1) / G, first_ = (nwg) - (rounds_ - 1) * G; \
            if (first_ < G && bx >= first_) phase_convert(l + 1, par ^ 1, (t_lo), (t_hi), (small), false, lane, (bx - first_) * NWAVES + wave, (G - first_) * NWAVES); } } while (0)
        constexpr int CV_A = (CV_NTASK * 2) / 5, CV_B = (CV_NTASK * 11) / 20;
        if (IN(1)) { PHASE_IDS(); pg8::Gemm g{(const bf16*)(ws + B_XB8), (const bf16*)(ws + wofs(1, par)), M, 2 * FF, DM, DM}; pg8::StaticOrder S; S.init(M, 2 * FF, G, bx); pg8::EpiSwiGLU8 E{ws + B_H, FF};
            pg8::gemm_phase<pg8::EpiSwiGLU8, pg8::StaticOrder, true, true, (121 << 8) | 127>(lds + RING_OFF, g, S, E, tid); CVT_TAIL((M / 256) * (2 * FF / 256), 0, CV_A, false); SEAM(); }
        if (IN(2)) { PHASE_IDS();
            { pg8::Gemm g{(const bf16*)(ws + B_H), (const bf16*)(ws + wofs(2, par)), TP, DM, FF, FF}; pg8::StaticOrder S; S.init(TP, DM, G, bx); pg8::EpiResid E{(const bf16*)(ws + WS_XB), (float*)(ws + WS_Z), DM, ALPHA, 0.5f};
              pg8::gemm_phase<pg8::EpiResid, pg8::StaticOrder, true, true, (121 << 8) | 125>(lds + RING_OFF, g, S, E, tid); }
            { pg8::Gemm g{(const bf16*)(ws + B_H), (const bf16*)(ws + wofs(2, par)), M, DM, FF, 512}; pg8::SplitOrder S{G, bx, 11, 512}; pg8::EpiSlab E{(float*)(ws + WS_SLAB), 512};
              pg8::gemm_phase<pg8::EpiSlab, pg8::SplitOrder, false, true, (121 << 8) | 125>(lds + RING_OFF, g, S, E, tid); }
            SEAM(); }
        if (IN(3)) { PHASE_IDS(); phase_ln((const float*)(ws + WS_Z), (const float*)(ws + WS_X), (const float*)(ws + WS_SLAB), 11, ALPHA, 0.5f, KIN(I_LNG) + (size_t)l * 3 * DM, KIN(I_LNB) + (size_t)l * 3 * DM, (float*)(ws + WS_X), (bf16*)(ws + WS_XB), (unsigned char*)nullptr, false, lane, gw, NGW); SEAM(); }
        if (IN(4)) { PHASE_IDS(); pg8::Gemm g{(const bf16*)(ws + WS_XB), (const bf16*)(ws + wofs(3, par)), M, N3, DM, DM}; pg8::StaticOrder S; S.init(M, N3, G, bx); pg8::EpiP E{(float*)(ws + B_P), (bf16*)(ws + B_U), (float*)(ws + B_GV)};
            pg8::gemm_phase<pg8::EpiP, pg8::StaticOrder, true, true>(lds + RING_OFF, g, S, E, tid); CVT_TAIL((M / 256) * (N3 / 256), CV_A, CV_B, true); SEAM(); }
        if (IN(5)) { PHASE_IDS(); phase_prep1(l, lane, gw, NGW); SEAM(); }
        if (IN(6)) { PHASE_IDS(); pg8::Gemm g{(const bf16*)(ws + B_A3B), (const bf16*)(ws + wofs(7, par)), M, NL, LK, LK}; pg8::StaticOrder S; S.init(M, NL, G, bx);
            pg8::EpiLora E{(float*)(ws + WS_RW)};
            pg8::gemm_phase<pg8::EpiLora, pg8::StaticOrder, false, false>(lds + RING_OFF, g, S, E, tid); SEAM(); }
        if (IN(7)) { PHASE_IDS(); scanA_all(l, lds, bx, G, tid, wave); SEAM(); }
        if (IN(8)) { PHASE_IDS();
            if (bx < 64) { const int hh = bx >> 2; if (wave < 4) scanB_chain<256>(l, lds, 0, hh, bx & 3, nullptr, KOUT() + O_SP + ((size_t)l * NH + hh) * 4096, tid, wave); else scanB_idle<256>(); }
            else { const float* srw = KIN(I_SRW); float* outp = KOUT();
                for (int p = bx - 64; p < 512; p += G - 64) { const int task = 2 * p + (wave >> 2), b = task >> 6, hh = (task >> 2) & 15; const size_t so = (((size_t)l * NSB + b) * NH + hh) * 4096;
                    scanB_chain<1>(l, lds, 256 + b, hh, task & 3, srw + so, outp + O_SS + so, tid, wave); }
                for (int u = bx - 64; u < 144 * 8; u += G - 64) gmlp_unit(l, lds, u, tid, wave); }
            SEAM(); }
        if (IN(9)) { PHASE_IDS(); scanC_all(l, lds, bx, G, tid, wave); SEAM(); }
        if (IN(10)) { PHASE_IDS();
            { pg8::Gemm g{(const bf16*)(ws + B_MIX), (const bf16*)(ws + wofs(4, par)), TP, DM, DM, DM}; pg8::StaticOrder S; S.init(TP, DM, G, bx); pg8::EpiResid E{(const bf16*)(ws + WS_XB), (float*)(ws + WS_Z), DM, ALPHA, 1.0f};
              pg8::gemm_phase<pg8::EpiResid, pg8::StaticOrder, true, true>(lds + RING_OFF, g, S, E, tid); }
            { pg8::Gemm g{(const bf16*)(ws + B_MIX), (const bf16*)(ws + wofs(4, par)), M, DM, DM, 256}; pg8::SplitOrder S{G, bx, 8, 256}; pg8::EpiSlab E{(float*)(ws + WS_SLAB), 256};
              pg8::gemm_phase<pg8::EpiSlab, pg8::SplitOrder, false, true>(lds + RING_OFF, g, S, E, tid); }
            SEAM(); }
        if (IN(11)) { PHASE_IDS(); phase_ln((const float*)(ws + WS_Z), (const float*)(ws + WS_X), (const float*)(ws + WS_SLAB), 8, ALPHA, 1.0f, KIN(I_LNG) + (size_t)(l * 3 + 1) * DM, KIN(I_LNB) + (size_t)(l * 3 + 1) * DM, (float*)(ws + WS_X), (bf16*)(ws + WS_XB), ws + B_XB8, false, lane, gw, NGW); SEAM(); }
        if (IN(12)) { PHASE_IDS(); pg8::Gemm g{(const bf16*)(ws + B_XB8), (const bf16*)(ws + wofs(5, par)), M, 2 * FF, DM, DM}; pg8::StaticOrder S; S.init(M, 2 * FF, G, bx); pg8::EpiSwiGLU8 E{ws + B_H, FF};
            pg8::gemm_phase<pg8::EpiSwiGLU8, pg8::StaticOrder, true, true, (121 << 8) | 127>(lds + RING_OFF, g, S, E, tid); CVT_TAIL((M / 256) * (2 * FF / 256), CV_B, CV_NTASK, false); SEAM(); }
        if (IN(13)) { PHASE_IDS();
            { pg8::Gemm g{(const bf16*)(ws + B_H), (const bf16*)(ws + wofs(6, par)), TP, DM, FF, FF}; pg8::StaticOrder S; S.init(TP, DM, G, bx); pg8::EpiResid E{(const bf16*)(ws + WS_XB), (float*)(ws + WS_Z), DM, ALPHA, 0.5f};
              pg8::gemm_phase<pg8::EpiResid, pg8::StaticOrder, true, true, (121 << 8) | 125>(lds + RING_OFF, g, S, E, tid); }
            { pg8::Gemm g{(const bf16*)(ws + B_H), (const bf16*)(ws + wofs(6, par)), M, DM, FF, 512}; pg8::SplitOrder S{G, bx, 11, 512}; pg8::EpiSlab E{(float*)(ws + WS_SLAB), 512};
              pg8::gemm_phase<pg8::EpiSlab, pg8::SplitOrder, false, true, (121 << 8) | 125>(lds + RING_OFF, g, S, E, tid); }
            SEAM(); }
        if (IN(14)) { PHASE_IDS(); const bool last = (l == DEPTH - 1);
            phase_ln((const float*)(ws + WS_Z), (const float*)(ws + WS_X), (const float*)(ws + WS_SLAB), 11, ALPHA, 0.5f, KIN(I_LNG) + (size_t)(l * 3 + 2) * DM, KIN(I_LNB) + (size_t)(l * 3 + 2) * DM, last ? KOUT() + O_YP : (float*)(ws + WS_X), last ? (bf16*)nullptr : (bf16*)(ws + WS_XB), last ? (unsigned char*)nullptr : ws + B_XB8, last, lane, gw, NGW);
            if (!last) SEAM(); }
    }
#undef IN
#undef CVT_TAIL
#undef SEAM
#undef PHASE_IDS
}

template <int PH> static bool prep_kernel() { return hipFuncSetAttribute((const void*)mk_fwd<PH>, hipFuncAttributeMaxDynamicSharedMemorySize, LDS_BYTES) == hipSuccess; }
template <int PH> static void launch_phase(int grid, hipStream_t stream, Args a) { hipLaunchKernelGGL(mk_fwd<PH>, dim3(grid), dim3(NTHR), LDS_BYTES, stream, a); }
extern "C" void kernel_launch(void* const* d_in, const int* in_sizes, int n_in, void* d_out, int out_size, void* d_ws, size_t ws_size, hipStream_t stream) {
    static int grid = 0;
    if (grid == 0) {
        if (n_in != 29 || (size_t)out_size != O_END || ws_size < WS_TOP) { fprintf(stderr, "kernel_launch: unexpected shapes: n_in %d out %d ws %zu (need %zu)\n", n_in, out_size, ws_size, (size_t)WS_TOP); grid = -1; return; }
        int dev = 0, cus = 0, per_cu = 0;
        if (hipGetDevice(&dev) != hipSuccess || hipDeviceGetAttribute(&cus, hipDeviceAttributeMultiprocessorCount, dev) != hipSuccess) { grid = -1; return; }
        bool ok = true;
#if MK_ONE_LAUNCH
        ok = prep_kernel<-1>();
        if (hipOccupancyMaxActiveBlocksPerMultiprocessor(&per_cu, (const void*)mk_fwd<-1>, NTHR, LDS_BYTES) != hipSuccess || per_cu < 1) fprintf(stderr, "kernel_launch: occupancy query says %d\n", per_cu);
#else
        ok = prep_kernel<0>() && prep_kernel<1>() && prep_kernel<2>() && prep_kernel<3>() && prep_kernel<4>() && prep_kernel<5>() && prep_kernel<6>() && prep_kernel<7>() && prep_kernel<8>() && prep_kernel<9>() && prep_kernel<10>() && prep_kernel<11>() && prep_kernel<12>() && prep_kernel<13>() && prep_kernel<14>();
#endif
        if (!ok) { fprintf(stderr, "kernel_launch: hipFuncSetAttribute failed\n"); grid = -1; return; }
        (void)hipGetLastError();
        grid = cus;
        if (grid < 64) { grid = -1; return; }
    }
    if (grid < 0) return;
    (void)hipMemsetAsync((char*)d_ws + WS_CTL, 0, CTL_ZERO_BYTES, stream);
    Args a{};
    for (int i = 0; i < 29; ++i) a.in[i] = (const float*)d_in[i];
    a.out = (float*)d_out; a.ws = (unsigned char*)d_ws;
#if MK_ONE_LAUNCH
    a.l_lo = 0; a.l_hi = DEPTH;
    launch_phase<-1>(grid, stream, a);
#else
    for (int l = 0; l < DEPTH; ++l) { a.l_lo = l; a.l_hi = l + 1;
        launch_phase<0>(grid, stream, a); launch_phase<1>(grid, stream, a); launch_phase<2>(grid, stream, a); launch_phase<3>(grid, stream, a); launch_phase<4>(grid, stream, a);
        launch_phase<5>(grid, stream, a); launch_phase<6>(grid, stream, a); launch_phase<7>(grid, stream, a); launch_phase<8>(grid, stream, a); launch_phase<9>(grid, stream, a);
        launch_phase<10>(grid, stream, a); launch_phase<11>(grid, stream, a); launch_phase<12>(grid, stream, a); launch_phase<13>(grid, stream, a); launch_phase<14>(grid, stream, a); }
#endif
}
```

```cpp
#include <hip/hip_runtime.h>
#include <cstdio>
#include <cstdint>
#define MK_ONE_LAUNCH 1
namespace pg8 {
#define PG8_LAS __attribute__((address_space(3)))
typedef unsigned short bf16_t;
typedef short bf16x8 __attribute__((ext_vector_type(8)));
typedef float f32x4 __attribute__((ext_vector_type(4)));
typedef unsigned u32x4 __attribute__((ext_vector_type(4)));
constexpr int BM = 256, BK = 64, HALF = 128, HTB = HALF * BK * 2  , STAGE_BYTES = 8 * HTB, NXCD = 8, WGM = 8;

__host__ __device__ __forceinline__ int lds_byte(int r, int c) { const int st = (r >> 4) * 2 + (c >> 5), rr = r & 15, cc = c & 31, ob = rr * 64 + cc * 2; return st * 1024 + (ob ^ (((ob >> 9) & 1) << 5)); }
__host__ __device__ __forceinline__ void stage_rc(int b, int& R, int& C) { const int st = b / 1024, sb = b % 1024, swz = sb ^ (((sb >> 9) & 1) << 5); R = (st >> 1) * 16 + swz / 64; C = (st & 1) * 32 + (swz % 64) / 2; }
__host__ __device__ __forceinline__ int perm32(int rho) { const int n = rho >> 4, i = rho & 15; return 8 * (i >> 2) + 4 * n + (i & 3); }

struct Unit { int pm, pn, k0; };
struct Gemm { const bf16_t* A; const bf16_t* Bt; int M, N, K, Kl; };

struct StaticOrder {
    int nM, nN, nwg, G, c;
    __host__ __device__ void init(int M, int N, int G_, int c_) { nM = M / BM; nN = N / BM; nwg = nM * nN; G = G_; c = c_; }
    __host__ __device__ bool next(int i, Unit& u) const {
        const long L = (long)i * G + c; if (L >= nwg) return false;
        int wgid = (int)L; { const int q = nwg / NXCD, r = nwg % NXCD, xcd = wgid % NXCD, off = wgid / NXCD; wgid = (xcd < r ? xcd * (q + 1) : r * (q + 1) + (xcd - r) * q) + off; }
        const int nig = WGM * nN, gid = wgid / nig, fm = gid * WGM, gsz = (nM - fm) < WGM ? (nM - fm) : WGM;
        u.pm = fm + ((wgid % nig) % gsz); u.pn = (wgid % nig) / gsz; u.k0 = 0; return true;
    }
    __device__ __forceinline__ void a_ready(const Unit&) const {}
    __device__ __forceinline__ void done(const Unit&) const {}
};
struct SplitOrder {
    int G, c, KS, Kl;
    __host__ __device__ bool next(int i, Unit& u) const { const int L = i * G + c; if (L >= 16 * KS) return false; const int ks = L >> 4, tile = L & 15; u.pm = 64 + (tile >> 3); u.pn = tile & 7; u.k0 = ks * Kl; return true; }
    __device__ __forceinline__ void a_ready(const Unit&) const {}
    __device__ __forceinline__ void done(const Unit&) const {}
};
__device__ __forceinline__ unsigned cvt_pk_bf16(float lo, float hi) { unsigned r; asm volatile("v_cvt_pk_bf16_f32 %0, %1, %2" : "=v"(r) : "v"(lo), "v"(hi)); return r; }
typedef float f32x2 __attribute__((ext_vector_type(2)));
__device__ __forceinline__ f32x2 gelu_pk(f32x2 v) {
    const f32x2 av = __builtin_elementwise_abs(v), d = av * 0.2316418882f + 1.0f;
    f32x2 t; t.x = __builtin_amdgcn_rcpf(d.x); t.y = __builtin_amdgcn_rcpf(d.y);
    f32x2 q = t * 0.5307027145f + (-0.7265760135f); q = q * t + 0.7107068705f; q = q * t + (-0.142248368f); q = q * t + 0.127414796f; q = q * t;
    const f32x2 s = (v * v) * (-0.72134752044f);
    f32x2 e; e.x = __builtin_amdgcn_exp2f(s.x); e.y = __builtin_amdgcn_exp2f(s.y);
    const f32x2 m = v * (q * e), r = v - m;
    f32x2 o; o.x = v.x < 0.f ? m.x : r.x; o.y = v.y < 0.f ? m.y : r.y; return o;
}

typedef unsigned u32x2 __attribute__((ext_vector_type(2)));
__device__ __forceinline__ float silu_f(float g) { return g * __builtin_amdgcn_rcpf(1.0f + __expf(-g)); }
struct EpiSwiGLU {
    static constexpr bool PERM = true, AFTER_DRAIN = false;
    bf16_t* O; int ldc;
    __device__ __forceinline__ void operator()(const f32x4 (&acc)[2][2][4][2], const Unit& u, int wr, int wc, int fr, int fq) const {
        const int row0 = u.pm * BM + wr * 64 + fr, col0 = u.pn * HALF + wc * 32 + 8 * fq;
#pragma unroll
        for (int ai = 0; ai < 2; ++ai)
#pragma unroll
            for (int m = 0; m < 4; ++m) { bf16_t* rowp = O + (size_t)(row0 + ai * HALF + m * 16) * ldc + col0;
                const f32x4 g0 = acc[ai][0][m][0], g1 = acc[ai][0][m][1], u0 = acc[ai][1][m][0], u1 = acc[ai][1][m][1];
                u32x4 w; w.x = cvt_pk_bf16(silu_f(g0[0]) * u0[0], silu_f(g0[1]) * u0[1]); w.y = cvt_pk_bf16(silu_f(g0[2]) * u0[2], silu_f(g0[3]) * u0[3]);
                w.z = cvt_pk_bf16(silu_f(g1[0]) * u1[0], silu_f(g1[1]) * u1[1]); w.w = cvt_pk_bf16(silu_f(g1[2]) * u1[2], silu_f(g1[3]) * u1[3]);
                *(u32x4*)rowp = w; }
    }
};
struct EpiSwiGLU8 {
    static constexpr bool PERM = true, AFTER_DRAIN = false;
    unsigned char* O; int ldc;
    __device__ __forceinline__ void operator()(const f32x4 (&acc)[2][2][4][2], const Unit& u, int wr, int wc, int fr, int fq) const {
        const int row0 = u.pm * BM + wr * 64 + fr, col0 = u.pn * HALF + wc * 32 + 8 * fq;
#pragma unroll
        for (int ai = 0; ai < 2; ++ai)
#pragma unroll
            for (int m = 0; m < 4; ++m) { unsigned char* rowp = O + (size_t)(row0 + ai * HALF + m * 16) * ldc + col0;
                const f32x4 g0 = acc[ai][0][m][0], g1 = acc[ai][0][m][1], u0 = acc[ai][1][m][0] * 4.0f, u1 = acc[ai][1][m][1] * 4.0f;
                unsigned w0 = 0u, w1 = 0u;
                w0 = __builtin_amdgcn_cvt_pk_fp8_f32(silu_f(g0[0]) * u0[0], silu_f(g0[1]) * u0[1], w0, false); w0 = __builtin_amdgcn_cvt_pk_fp8_f32(silu_f(g0[2]) * u0[2], silu_f(g0[3]) * u0[3], w0, true);
                w1 = __builtin_amdgcn_cvt_pk_fp8_f32(silu_f(g1[0]) * u1[0], silu_f(g1[1]) * u1[1], w1, false); w1 = __builtin_amdgcn_cvt_pk_fp8_f32(silu_f(g1[2]) * u1[2], silu_f(g1[3]) * u1[3], w1, true);
                *(u32x2*)rowp = (u32x2){w0, w1}; }
    }
};
struct EpiResid {
    static constexpr bool PERM = false, AFTER_DRAIN = false;
    const bf16_t* base; float* out; int ldc; float sa, sb;
    __device__ __forceinline__ void operator()(const f32x4 (&acc)[2][2][4][2], const Unit& u, int wr, int wc, int fr, int fq) const {
        const int row0 = u.pm * BM + wr * 64 + fr, col0 = u.pn * BM + wc * 32 + 4 * fq;
#pragma unroll
        for (int ai = 0; ai < 2; ++ai)
#pragma unroll
            for (int m = 0; m < 4; ++m) { const size_t off = (size_t)(row0 + ai * HALF + m * 16) * ldc + col0;
#pragma unroll
                for (int bj = 0; bj < 2; ++bj)
#pragma unroll
                    for (int n = 0; n < 2; ++n) { const u32x2 bb = *(const u32x2*)(base + off + bj * HALF + n * 16);
                        const f32x4 b = (f32x4){__builtin_bit_cast(float, bb.x << 16), __builtin_bit_cast(float, bb.x & 0xffff0000u), __builtin_bit_cast(float, bb.y << 16), __builtin_bit_cast(float, bb.y & 0xffff0000u)};
                        *(f32x4*)(out + off + bj * HALF + n * 16) = b * sa + acc[ai][bj][m][n] * sb; } }
    }
};
struct EpiSlab {
    static constexpr bool PERM = false, AFTER_DRAIN = false;
    float* slab; int Kl;
    __device__ __forceinline__ void operator()(const f32x4 (&acc)[2][2][4][2], const Unit& u, int wr, int wc, int fr, int fq) const {
        const int row0 = (u.pm - 64) * BM + wr * 64 + fr, col0 = u.pn * BM + wc * 32 + 4 * fq; float* O = slab + (size_t)(u.k0 / Kl) * (512 * 2048);
#pragma unroll
        for (int ai = 0; ai < 2; ++ai)
#pragma unroll
            for (int m = 0; m < 4; ++m) { float* rowp = O + (size_t)(row0 + ai * HALF + m * 16) * 2048 + col0;
#pragma unroll
                for (int bj = 0; bj < 2; ++bj)
#pragma unroll
                    for (int n = 0; n < 2; ++n) *(f32x4*)(rowp + bj * HALF + n * 16) = acc[ai][bj][m][n]; }
    }
};
struct EpiP {
    static constexpr bool PERM = false, AFTER_DRAIN = false;
    float* P; bf16_t* U; float* GV;
    __device__ __forceinline__ void operator()(const f32x4 (&acc)[2][2][4][2], const Unit& u, int wr, int wc, int fr, int fq) const {
        const int row0 = u.pm * BM + wr * 64 + fr, cw = wc * 32 + 4 * fq;
        const int kind = u.pn < 14 ? 0 : (u.pn < 18 ? 1 : 2);
        float* F = kind == 0 ? P + u.pn * BM + cw : GV + (u.pn - 18) * BM + cw; const int ldf = kind == 0 ? 3584 : 1024;
        bf16_t* Ub = U + (u.pn - 14) * BM + cw;
#pragma unroll
        for (int ai = 0; ai < 2; ++ai)
#pragma unroll
            for (int m = 0; m < 4; ++m) { const size_t row = (size_t)(row0 + ai * HALF + m * 16);
#pragma unroll
                for (int bj = 0; bj < 2; ++bj)
#pragma unroll
                    for (int n = 0; n < 2; ++n) { f32x4 v = acc[ai][bj][m][n];
                        if (kind != 0) { const f32x2 a = gelu_pk((f32x2){v[0], v[1]}), b = gelu_pk((f32x2){v[2], v[3]}); v = (f32x4){a.x, a.y, b.x, b.y}; }
                        if (kind == 1) { u32x2 w; w.x = cvt_pk_bf16(v[0], v[1]); w.y = cvt_pk_bf16(v[2], v[3]); *(u32x2*)(Ub + row * 1024 + bj * HALF + n * 16) = w; }
                        else *(f32x4*)(F + row * ldf + bj * HALF + n * 16) = v; }
                asm volatile("" ::: "memory"); }
    }
};
struct EpiLora {
    static constexpr bool PERM = false, AFTER_DRAIN = false;
    float* base;
    __device__ __forceinline__ void operator()(const f32x4 (&acc)[2][2][4][2], const Unit& u, int wr, int wc, int fr, int fq) const {
        const int row0 = u.pm * BM + wr * 64 + fr, kind = u.pn >> 2, cb = (u.pn & 3) * BM + wc * 32 + 4 * fq;
        float* O = base + (size_t)kind * ((size_t)66 << 18) + cb;
#pragma unroll
        for (int ai = 0; ai < 2; ++ai)
#pragma unroll
            for (int m = 0; m < 4; ++m) { float* rowp = O + (size_t)(row0 + ai * HALF + m * 16) * 1024;
#pragma unroll
                for (int bj = 0; bj < 2; ++bj)
#pragma unroll
                    for (int n = 0; n < 2; ++n) *(f32x4*)(rowp + bj * HALF + n * 16) = acc[ai][bj][m][n]; }
    }
};
typedef int pg8_v4i __attribute__((ext_vector_type(4))); typedef int pg8_v8i __attribute__((ext_vector_type(8)));
__device__ __forceinline__ pg8_v8i cat8(bf16x8 a, bf16x8 b) { const pg8_v4i x = __builtin_bit_cast(pg8_v4i, a), y = __builtin_bit_cast(pg8_v4i, b); return __builtin_shufflevector(x, y, 0, 1, 2, 3, 4, 5, 6, 7); }
template <class Epi, class Sched, bool ALIGN_EPI = false, bool SP2 = false, int F8 = 0>
__device__ __forceinline__ void gemm_phase(PG8_LAS unsigned char* lds, const Gemm g, const Sched& S, const Epi& E, int tid_in) {
    int tid_ = tid_in; asm volatile("" : "+v"(tid_));
    const int tid = tid_, wid = __builtin_amdgcn_readfirstlane(tid >> 6), lane = tid & 63, wr = wid >> 2, wc = wid & 3, fr = lane & 15, fq = lane >> 4;
    constexpr int ES = F8 ? 1 : 2;
    const int K = g.K, nt = g.Kl / (F8 ? 2 * BK : BK);
    unsigned voffA[2], voffB[2];
#pragma unroll
    for (int i = 0; i < 2; ++i) { int R, C; stage_rc(tid * 16 + i * 8192, R, C); const int Rb = Epi::PERM ? ((R & ~31) + perm32(R & 31)) : R;
        voffA[i] = (unsigned)(R * K * ES + C * 2); voffB[i] = (unsigned)(Rb * K * ES + C * 2); }
    const size_t kstep = (size_t)(BK * 2);
    const size_t hstep = (size_t)HALF * K * ES;
    const size_t tstep = 2 * hstep;
    const unsigned ldsw = (unsigned)wid * 1024u;
    const int aoff = lds_byte(wr * 64 + fr, fq * 8), boff = lds_byte(wc * 32 + fr, fq * 8);
#define PG8_SA(b, h) (((b) * 2 + (h)) * HTB)
#define PG8_SB(b, h) ((4 + (b) * 2 + (h)) * HTB)
#define PG8_STAGE(bufoff, gbase, voff) do { _Pragma("unroll") for (int _i = 0; _i < 2; ++_i) \
        __builtin_amdgcn_global_load_lds((const unsigned*)((const char*)(gbase) + (voff)[_i]), (PG8_LAS unsigned*)(lds + (bufoff) + ldsw + _i * 8192), 16, 0, 0); } while (0)
#define PG8_LDA(dst, b, h) do { _Pragma("unroll") for (int m = 0; m < 4; ++m) { if constexpr (F8 != 0) dst##_F[m] = cat8(*(const PG8_LAS bf16x8*)(lds + PG8_SA(b, h) + aoff + m * 2048), *(const PG8_LAS bf16x8*)(lds + PG8_SA(b, h) + aoff + m * 2048 + 1024)); \
        else { _Pragma("unroll") for (int k = 0; k < 2; ++k) dst[m][k] = *(const PG8_LAS bf16x8*)(lds + PG8_SA(b, h) + aoff + m * 2048 + k * 1024); } } } while (0)
#define PG8_LDB(dst, b, h) do { _Pragma("unroll") for (int n = 0; n < 2; ++n) { if constexpr (F8 != 0) dst##_F[n] = cat8(*(const PG8_LAS bf16x8*)(lds + PG8_SB(b, h) + boff + n * 2048), *(const PG8_LAS bf16x8*)(lds + PG8_SB(b, h) + boff + n * 2048 + 1024)); \
        else { _Pragma("unroll") for (int k = 0; k < 2; ++k) dst[n][k] = *(const PG8_LAS bf16x8*)(lds + PG8_SB(b, h) + boff + n * 2048 + k * 1024); } } } while (0)
#define PG8_MMA(ai, bj, At, Bt) do { __builtin_amdgcn_s_setprio(1); _Pragma("unroll") for (int m = 0; m < 4; ++m) _Pragma("unroll") for (int n = 0; n < 2; ++n) { \
        if constexpr (F8 != 0) asm volatile("v_mfma_scale_f32_16x16x128_f8f6f4 %0, %1, %2, %0, %3, %4 op_sel_hi:[0,0,0]" : "+v"(acc[ai][bj][m][n]) : "v"(Bt##_F[n]), "v"(At##_F[m]), "v"(sc_w), "v"(sc_a)); \
        else { _Pragma("unroll") for (int k = 0; k < 2; ++k) acc[ai][bj][m][n] = __builtin_amdgcn_mfma_f32_16x16x32_bf16(Bt[n][k], At[m][k], acc[ai][bj][m][n], 0, 0, 0); } } __builtin_amdgcn_s_setprio(0); } while (0)
#define PG8_WAIT_V(n) asm volatile("s_waitcnt vmcnt(" #n ")" ::: "memory")
#define PG8_WAIT_L(n) asm volatile("s_waitcnt lgkmcnt(" #n ")" ::: "memory")
#define PG8_BAR __builtin_amdgcn_s_barrier()
#define PG8_SCHED __builtin_amdgcn_sched_barrier(0)
    Unit cur, nxt; int ui = 0;
    if (!S.next(0, cur)) return;
    f32x4 acc[2][2][4][2];
    float zz0; asm volatile("v_mov_b32 %0, 0" : "=v"(zz0));
    const int sc_w = (F8 >> 8) * 0x01010101, sc_a = (F8 & 255) * 0x01010101; (void)sc_w; (void)sc_a;
#pragma unroll
    for (int a = 0; a < 2; ++a)
#pragma unroll
        for (int b = 0; b < 2; ++b)
#pragma unroll
            for (int m = 0; m < 4; ++m)
#pragma unroll
                for (int n = 0; n < 2; ++n) acc[a][b][m][n] = (f32x4){zz0, zz0, zz0, zz0};
    bf16x8 At[4][2], B0[2][2], B1[2][2]; pg8_v8i At8[4], B08[2], B18[2];
#define At_F At8
#define B0_F B08
#define B1_F B18
    const char* cA = (const char*)g.A + (size_t)cur.pm * tstep + (size_t)cur.k0 * ES; const char* cB = (const char*)g.Bt + (size_t)cur.pn * tstep + (size_t)cur.k0 * ES;
    S.a_ready(cur);
    if constexpr (SP2) {
        PG8_STAGE(PG8_SB(0, 0), cB, voffB); PG8_STAGE(PG8_SB(0, 1), cB + hstep, voffB); PG8_STAGE(PG8_SA(0, 0), cA, voffA); PG8_STAGE(PG8_SA(0, 1), cA + hstep, voffA);
        if (wr == 1) PG8_BAR;
        PG8_WAIT_V(2); PG8_BAR;
        PG8_STAGE(PG8_SB(1, 0), cB + kstep, voffB); PG8_STAGE(PG8_SA(1, 0), cA + kstep, voffA); PG8_STAGE(PG8_SB(1, 1), cB + hstep + kstep, voffB);
        PG8_WAIT_V(6); PG8_BAR;
    } else {
        PG8_STAGE(PG8_SB(0, 0), cB, voffB); PG8_STAGE(PG8_SA(0, 0), cA, voffA); PG8_STAGE(PG8_SB(0, 1), cB + hstep, voffB); PG8_STAGE(PG8_SA(0, 1), cA + hstep, voffA);
        if (wr == 1) PG8_BAR;
        PG8_WAIT_V(4); PG8_BAR;
        PG8_STAGE(PG8_SB(1, 0), cB + kstep, voffB); PG8_STAGE(PG8_SA(1, 0), cA + kstep, voffA); PG8_STAGE(PG8_SB(1, 1), cB + hstep + kstep, voffB);
        PG8_WAIT_V(6); PG8_BAR;
    }
    for (;;) {
        const bool has_next = S.next(ui + 1, nxt);
        const char* nA = has_next ? (const char*)g.A + (size_t)nxt.pm * tstep + (size_t)nxt.k0 * ES : cA; const char* nB = has_next ? (const char*)g.Bt + (size_t)nxt.pn * tstep + (size_t)nxt.k0 * ES : cB;
        for (int t = 0; t < nt; t += 2) {
            const bool last = (t == nt - 2);
            const char* a1 = cA + (size_t)(t + 1) * kstep;
            const char* a2 = last ? nA : cA + (size_t)(t + 2) * kstep; const char* b2 = last ? nB : cB + (size_t)(t + 2) * kstep;
            const char* a3 = a2 + kstep; const char* b3 = b2 + kstep;
            if (last && has_next) S.a_ready(nxt);
            if constexpr (SP2) {
            PG8_LDB(B0, 0, 0); PG8_LDB(B1, 0, 1); PG8_SCHED; PG8_LDA(At, 0, 0); PG8_STAGE(PG8_SA(1, 1), a1 + hstep, voffA);
            PG8_WAIT_V(8); PG8_WAIT_L(0); PG8_BAR; PG8_MMA(0, 0, At, B0); PG8_MMA(0, 1, At, B1); PG8_BAR; PG8_SCHED;
            PG8_LDA(At, 0, 1); PG8_STAGE(PG8_SB(0, 0), b2, voffB); PG8_STAGE(PG8_SB(0, 1), b2 + hstep, voffB); PG8_STAGE(PG8_SA(0, 0), a2, voffA);
            PG8_WAIT_V(8); PG8_WAIT_L(0); PG8_BAR; PG8_MMA(1, 0, At, B0); PG8_MMA(1, 1, At, B1); PG8_BAR; PG8_SCHED;
            PG8_LDB(B0, 1, 0); PG8_LDB(B1, 1, 1); PG8_SCHED; PG8_LDA(At, 1, 0); PG8_STAGE(PG8_SA(0, 1), a2 + hstep, voffA);
            PG8_WAIT_V(8); PG8_WAIT_L(0); PG8_BAR; PG8_MMA(0, 0, At, B0); PG8_MMA(0, 1, At, B1); PG8_BAR; PG8_SCHED;
            PG8_LDA(At, 1, 1); PG8_STAGE(PG8_SB(1, 0), b3, voffB); PG8_STAGE(PG8_SB(1, 1), b3 + hstep, voffB); PG8_STAGE(PG8_SA(1, 0), a3, voffA);
            PG8_WAIT_V(8); PG8_WAIT_L(0); PG8_BAR; PG8_MMA(1, 0, At, B0); PG8_MMA(1, 1, At, B1); PG8_BAR; PG8_SCHED;
            } else {
            PG8_LDB(B0, 0, 0); PG8_SCHED; PG8_LDA(At, 0, 0); PG8_STAGE(PG8_SA(1, 1), a1 + hstep, voffA);
            PG8_WAIT_L(8); PG8_BAR; PG8_WAIT_L(0); PG8_MMA(0, 0, At, B0); PG8_BAR; PG8_SCHED;
            PG8_LDB(B1, 0, 1); PG8_STAGE(PG8_SB(0, 0), b2, voffB);
            PG8_BAR; PG8_WAIT_L(0); PG8_MMA(0, 1, At, B1); PG8_BAR;
            PG8_LDA(At, 0, 1); PG8_STAGE(PG8_SA(0, 0), a2, voffA);
            PG8_BAR; PG8_WAIT_L(0); PG8_MMA(1, 0, At, B0); PG8_BAR; PG8_SCHED;
            PG8_STAGE(PG8_SB(0, 1), b2 + hstep, voffB);
            PG8_WAIT_V(6); PG8_BAR; PG8_MMA(1, 1, At, B1); PG8_BAR;
            PG8_LDB(B0, 1, 0); PG8_SCHED; PG8_LDA(At, 1, 0); PG8_STAGE(PG8_SA(0, 1), a2 + hstep, voffA);
            PG8_WAIT_L(8); PG8_BAR; PG8_WAIT_L(0); PG8_MMA(0, 0, At, B0); PG8_BAR; PG8_SCHED;
            PG8_LDB(B1, 1, 1); PG8_STAGE(PG8_SB(1, 0), b3, voffB);
            PG8_BAR; PG8_WAIT_L(0); PG8_MMA(0, 1, At, B1); PG8_BAR;
            PG8_LDA(At, 1, 1); PG8_STAGE(PG8_SA(1, 0), a3, voffA);
            PG8_BAR; PG8_WAIT_L(0); PG8_MMA(1, 0, At, B0); PG8_BAR; PG8_SCHED;
            PG8_STAGE(PG8_SB(1, 1), b3 + hstep, voffB);
            PG8_WAIT_V(6); PG8_BAR; PG8_MMA(1, 1, At, B1); PG8_BAR;
            }
        }
        if constexpr (F8 != 0) { asm volatile("s_nop 15\n\ts_nop 15\n\ts_nop 15\n\ts_nop 15" ::: "memory"); }
        if constexpr (ALIGN_EPI) { if (wr == 0) PG8_BAR; }
        if constexpr (!Epi::AFTER_DRAIN) { int l2_ = tid; asm volatile("" : "+v"(l2_));
            E(acc, cur, wr, wc, l2_ & 15, (l2_ & 63) >> 4); S.done(cur); }
        if (!has_next) break;
{ float zz1; asm volatile("v_mov_b32 %0, 0" : "=v"(zz1));
#pragma unroll
        for (int a = 0; a < 2; ++a)
#pragma unroll
            for (int b = 0; b < 2; ++b)
#pragma unroll
                for (int m = 0; m < 4; ++m)
#pragma unroll
                    for (int n = 0; n < 2; ++n) acc[a][b][m][n] = (f32x4){zz1, zz1, zz1, zz1}; }
        cur = nxt; cA = nA; cB = nB; ++ui;
        if constexpr (ALIGN_EPI) { if (wr == 1) PG8_BAR; }
    }
    PG8_WAIT_V(0);
    if constexpr (!ALIGN_EPI) { if (wr == 0) PG8_BAR; }
    PG8_BAR;
    if constexpr (Epi::AFTER_DRAIN) { E.fused(acc, cur, wr, wc, fr, fq, lds, wid, lane); S.done(cur); }
#undef PG8_SA
#undef PG8_SB
#undef PG8_STAGE
#undef PG8_LDA
#undef PG8_LDB
#undef PG8_MMA
#undef PG8_WAIT_V
#undef PG8_WAIT_L
#undef PG8_BAR
#undef PG8_SCHED
#undef At_F
#undef B0_F
#undef B1_F
}
}
#define GAS __attribute__((address_space(1)))
#define LAS __attribute__((address_space(3)))
typedef unsigned short bf16;
typedef unsigned v4u __attribute__((ext_vector_type(4)));
typedef float f32x4 __attribute__((ext_vector_type(4)));
typedef short bf16x8 __attribute__((ext_vector_type(8)));
typedef GAS unsigned gu32;
typedef GAS unsigned long long gu64;
#define RLX_AGENT __ATOMIC_RELAXED, __HIP_MEMORY_SCOPE_AGENT
#define LDS_WAIT() asm volatile("s_waitcnt lgkmcnt(0)" ::: "memory")
#define VM_WAIT() asm volatile("s_waitcnt vmcnt(0)" ::: "memory")
__device__ __forceinline__ unsigned long long rt() { return __builtin_amdgcn_s_memrealtime(); }
typedef float f32x2_t __attribute__((ext_vector_type(2))); typedef __bf16 bf16x2_t __attribute__((ext_vector_type(2)));
__device__ __forceinline__ unsigned pk2(float lo, float hi) { const bf16x2_t b = __builtin_convertvector((f32x2_t){lo, hi}, bf16x2_t); return __builtin_bit_cast(unsigned, b); }
__device__ __forceinline__ unsigned f2bf(float f) { return pk2(f, 0.f) & 0xffffu; }
#define XB_TMO      128
#define XB_XCNT(j)  (256  + 64 * (j))
#define XB_XSUB(j)  (1280 + 64 * (j))
#define XB_XGEN(j)  (2304 + 64 * (j))
#define XB_TOP      3328
#define XB_TOPGEN   3392
#define XCD_BAR_WORDS 3456
#define XB_SPIN_CAP (1u << 18)

__device__ __forceinline__ unsigned xb_ld(unsigned* p)              { return __hip_atomic_load(p, __ATOMIC_RELAXED, __HIP_MEMORY_SCOPE_AGENT); }
__device__ __forceinline__ unsigned xb_add(unsigned* p, unsigned v) { return __hip_atomic_fetch_add(p, v, __ATOMIC_RELAXED, __HIP_MEMORY_SCOPE_AGENT); }
__device__ __forceinline__ unsigned xb_xcc_id() { return (unsigned)__builtin_amdgcn_s_getreg((3 << 11) | 20) & 0xFu; }
#define XB_SPIN(cond, bar) do { unsigned _sp = 0; while (cond) { __builtin_amdgcn_s_sleep(1); \
    if ((++_sp & 255u) == 0u) { if (xb_ld(&(bar)[XB_TMO])) break; if (_sp > XB_SPIN_CAP) { atomicAdd(&(bar)[XB_TMO], 1u); break; } } } } while (0)

struct XcdBarrier {
    unsigned* bar; unsigned x;
    volatile LAS unsigned* st;
};

__device__ __forceinline__ XcdBarrier xcd_barrier_post(unsigned* bar, volatile LAS unsigned* st, int tid) {
    XcdBarrier b; b.bar = bar; b.x = xb_xcc_id(); b.st = st;
    if (tid == 0) (void)xb_add(&bar[XB_XCNT(b.x)], 1u);
    return b;
}
__device__ __forceinline__ void xcd_barrier_complete(unsigned* bar, unsigned x, unsigned& nloc, unsigned& nx) {
    const unsigned G = gridDim.x * gridDim.y * gridDim.z;
    unsigned sum, cnt, mine, sp = 0u;
    for (;;) {
        sum = 0u; cnt = 0u; mine = 0u;
#pragma unroll
        for (unsigned j = 0; j < 16; ++j) { const unsigned c = xb_ld(&bar[XB_XCNT(j)]); sum += c; cnt += (c > 0u) ? 1u : 0u; mine = (j == x) ? c : mine; }
        if (sum == G) break;
        __builtin_amdgcn_s_sleep(1);
        if ((++sp & 255u) == 0u) { if (xb_ld(&bar[XB_TMO])) break; if (sp > XB_SPIN_CAP) { atomicAdd(&bar[XB_TMO], 1u); break; } }
    }
    nloc = mine > 0u ? mine : 1u; nx = cnt > 0u ? cnt : 1u;
}

__device__ __forceinline__ void xcd_barrier(const XcdBarrier& b, int tid) {
    asm volatile("s_waitcnt vmcnt(0)" ::: "memory");
    __syncthreads();
    if (tid == 0) {
        unsigned* bar = b.bar;
        __builtin_amdgcn_s_waitcnt(0);
        unsigned nloc = b.st[0], nx = b.st[1];
        if (nloc == 0u) { xcd_barrier_complete(bar, b.x, nloc, nx); b.st[0] = nloc; b.st[1] = nx; }
        const unsigned old = xb_add(&bar[XB_XSUB(b.x)], 1u);
        const unsigned gen = old / nloc;
        if (old + 1u == (gen + 1u) * nloc) {
            __builtin_amdgcn_fence(__ATOMIC_RELEASE, "agent");
            asm volatile("s_waitcnt vmcnt(0)" ::: "memory");
            const unsigned og = xb_add(&bar[XB_TOP], 1u);
            const unsigned tg = og / nx;
            if (og + 1u == (tg + 1u) * nx) xb_add(&bar[XB_TOPGEN], 1u);
            else XB_SPIN(xb_ld(&bar[XB_TOPGEN]) == tg, bar);
            __builtin_amdgcn_fence(__ATOMIC_ACQUIRE, "agent");
            xb_add(&bar[XB_XGEN(b.x)], 1u);
            asm volatile("s_waitcnt vmcnt(0)" ::: "memory");
        } else {
            XB_SPIN(xb_ld(&bar[XB_XGEN(b.x)]) == gen, bar);
            __builtin_amdgcn_fence(__ATOMIC_ACQUIRE, "agent");
            asm volatile("s_waitcnt vmcnt(0)" ::: "memory");
        }
    }
    __syncthreads();
}

constexpr int NWAVES = 8, NTHR = 512;
constexpr int DM = 2048, FF = 5632, DEPTH = 4;
constexpr int TP = 16384, NSB = 16, TS = 32, M = TP + NSB * TS;
constexpr int RW = 1024, NH = 16, HN = 64, GMW = 1024, GH = 8, GHD = 128;
constexpr int C_W = 3072, C_A = 3136, C_G = 3200, SHIFT = 3360, INC = 5408;
constexpr int PLD = 3584;
constexpr int N3 = 5632;
constexpr int LK = 384;
constexpr int NL = 3072;
constexpr float ALPHA = 1.6817928305074292f;
constexpr float LN_EPS = 1e-5f, GN_EPS = 64e-5f;
constexpr int NPHASE = 15;

constexpr size_t O_YP = 0, O_SP = 34603008, O_SHP = 34865152, O_SS = 34878592, O_SHS = 39072896, O_GV = 39287936, O_END = 41385088;

constexpr size_t MiB = 1u << 20;
constexpr size_t WS_CTL = 0, CTL_ZERO_BYTES = 1 * MiB;
constexpr size_t WS_X = 1 * MiB;
constexpr size_t WS_Z = 133 * MiB;
constexpr size_t WS_XB = 265 * MiB;
constexpr size_t WS_W = 331 * MiB;
constexpr size_t W_1 = WS_W, W_2 = W_1 + 44 * MiB, W_3 = W_2 + 22 * MiB, W_4 = W_3 + 22 * MiB, W_5 = W_4 + 8 * MiB, W_6 = W_5 + 44 * MiB, W_3B = W_6 + 22 * MiB;
constexpr size_t W_1B = 1367 * MiB, W_2B = 1411 * MiB, W_4B = 1433 * MiB;
constexpr size_t W_5B = 67 * MiB, W_3BB = 111 * MiB;
constexpr size_t W_3B2 = 1277 * MiB, W_6B = 1299 * MiB;
constexpr size_t WS_TOP = 1441 * MiB;
__host__ __device__ constexpr size_t wofs(int i, int par) {
    return i == 1 ? (par ? W_1B : W_1) : i == 2 ? (par ? W_2B : W_2) : i == 3 ? (par ? W_3B2 : W_3) : i == 4 ? (par ? W_4B : W_4) : i == 5 ? (par ? W_5B : W_5) : i == 6 ? (par ? W_6B : W_6) : (par ? W_3BB : W_3B); }
constexpr size_t WS_BIG = 496 * MiB;
constexpr size_t B_XB8 = WS_BIG + 96 * MiB;
constexpr size_t B_H = WS_BIG, B_P = WS_BIG, B_U = WS_BIG + 231 * MiB, B_GV = B_U + 33 * MiB, B_A3B = B_GV + 66 * MiB;
constexpr size_t B_MIX = WS_X;
constexpr size_t WS_RW = 839 * MiB;
constexpr size_t RWSZ = 66 * MiB;
constexpr size_t WS_END = WS_RW + 8 * RWSZ;
static_assert(W_3B + (size_t)NL * LK * 2 <= WS_BIG && B_A3B + (size_t)M * LK * 2 <= WS_RW, "ws map");
static_assert(B_MIX + (size_t)M * DM * 2 <= WS_X + (size_t)TP * DM * 4, "MIXB under the sample rows of X");
static_assert((size_t)M * DM * 4 == 132 * MiB && (size_t)M * PLD * 4 == 231 * MiB && (size_t)M * 1024 * 4 == 66 * MiB, "ws sizes");
constexpr int CW_TMO = 0, CW_CODE = 1, CW_BAR = 4096;

constexpr int RING_OFF = 0, RING_BYTES = 135168;
constexpr int LDSCTL_OFF = RING_BYTES, MISC_OFF = LDSCTL_OFF + 320;
constexpr int LDS_BYTES = 147456;

struct Args { const float* in[29]; float* out; unsigned char* ws; int l_lo, l_hi; };
#define KOUT() ((float*)karg_ptr<232>())
#define KWS() ((unsigned char*)karg_ptr<240>())
enum InIdx { I_XP = 0, I_XS, I_SRW, I_SSH, I_F1G, I_F1U, I_F1D, I_WIN, I_MU, I_W0, I_WUP, I_A0, I_AUP, I_GUP, I_KK, I_KA, I_RK, I_GNG, I_GNB, I_GLG, I_GLB, I_GWS, I_GBS, I_WOUT, I_F2G, I_F2U, I_F2D, I_LNG, I_LNB };


template <int OFF> __device__ __forceinline__ const float* karg_ptr() {
    const unsigned long long kp = (unsigned long long)__builtin_amdgcn_kernarg_segment_ptr(); unsigned long long v;
    asm volatile("s_load_dwordx2 %0, %1, %2\n\ts_waitcnt lgkmcnt(0)" : "=s"(v) : "s"(kp), "i"(OFF) : "memory");
    return (const float*)(const GAS float*)v;
}
#define KIN(i) karg_ptr<8 * (i)>()
template <int CTRL> __device__ __forceinline__ float dpp_mov(float x) { return __builtin_bit_cast(float, __builtin_amdgcn_mov_dpp(__builtin_bit_cast(int, x), CTRL, 0xf, 0xf, true)); }
__device__ __forceinline__ float row16_sum(float x) { x += dpp_mov<0x128>(x); x += dpp_mov<0x124>(x); x += dpp_mov<0x122>(x); x += dpp_mov<0x121>(x); return x; }
__device__ __forceinline__ float wave_sum(float v) {
    v = row16_sum(v); const int i = __builtin_bit_cast(int, v);
    const float a = __builtin_bit_cast(float, __builtin_amdgcn_readlane(i, 0)), b = __builtin_bit_cast(float, __builtin_amdgcn_readlane(i, 16)), c = __builtin_bit_cast(float, __builtin_amdgcn_readlane(i, 32)), d = __builtin_bit_cast(float, __builtin_amdgcn_readlane(i, 48));
    return (a + b) + (c + d);
}

template <int MAP> __device__ __forceinline__ void cvt_task(const float* __restrict__ W, int K, int N, bf16* __restrict__ WT, int nb, int k0, int lane) {
    const int n = nb * 256 + 4 * lane; if (n >= N) return;
    const int drow = MAP == 0 ? n : (MAP == 3 ? (n < SHIFT ? n : n + (PLD - SHIFT)) : 256 * (n >> 7) + (n & 127) + (MAP == 2 ? 128 : 0));
    const float* src = W + (size_t)k0 * N + n; bf16* dst = WT + (size_t)drow * K + k0;
#pragma unroll
    for (int kk = 0; kk < 32; kk += 16) { f32x4 v[16];
#pragma unroll
        for (int j = 0; j < 16; ++j) v[j] = *(const f32x4*)(src + (size_t)(kk + j) * N);
#pragma unroll
        for (int i = 0; i < 4; ++i)
#pragma unroll
            for (int hh = 0; hh < 2; ++hh) { v4u o; o.x = pk2(v[8 * hh + 0][i], v[8 * hh + 1][i]); o.y = pk2(v[8 * hh + 2][i], v[8 * hh + 3][i]); o.z = pk2(v[8 * hh + 4][i], v[8 * hh + 5][i]); o.w = pk2(v[8 * hh + 6][i], v[8 * hh + 7][i]);
                *(v4u*)(dst + (size_t)i * K + kk + 8 * hh) = o; } }
}

template <int MAP> __device__ __forceinline__ void cvt_task8(const float* __restrict__ W, int K, int N, unsigned char* __restrict__ WT, int nb, int k0, int lane) {
    const int n = nb * 256 + 4 * lane; if (n >= N) return;
    const int drow = MAP == 0 ? n : 256 * (n >> 7) + (n & 127) + (MAP == 2 ? 128 : 0);
    const float* src = W + (size_t)k0 * N + n; unsigned char* dst = WT + (size_t)drow * K + k0;
#pragma unroll
    for (int kk = 0; kk < 32; kk += 16) { f32x4 v[16];
#pragma unroll
        for (int j = 0; j < 16; ++j) v[j] = *(const f32x4*)(src + (size_t)(kk + j) * N) * 64.0f;
#pragma unroll
        for (int i = 0; i < 4; ++i) { v4u o;
#pragma unroll
            for (int q = 0; q < 4; ++q) { unsigned w = 0u; w = __builtin_amdgcn_cvt_pk_fp8_f32(v[4 * q][i], v[4 * q + 1][i], w, false); w = __builtin_amdgcn_cvt_pk_fp8_f32(v[4 * q + 2][i], v[4 * q + 3][i], w, true); o[q] = w; }
            *(v4u*)(dst + (size_t)i * K + kk) = o; } }
}

constexpr int CV_T_GU = (FF / 256) * (DM / 32), CV_T_D = (DM / 256) * (FF / 32), CV_T_IN = ((INC + 255) / 256) * (DM / 32), CV_T_O = (DM / 256) * (DM / 32), CV_NTASK = 4 * CV_T_GU + 2 * CV_T_D + CV_T_IN + CV_T_O;
__device__ __forceinline__ void phase_convert(int l, int par, int t_lo, int t_hi, bool small, bool inputs, int lane, int idx, int cnt) {
    unsigned char* ws = KWS();
    const size_t so = (size_t)l * DM * FF;
    const float *f1g = KIN(I_F1G) + so, *f1u = KIN(I_F1U) + so, *f1d = KIN(I_F1D) + so, *f2g = KIN(I_F2G) + so, *f2u = KIN(I_F2U) + so, *f2d = KIN(I_F2D) + so;
    const float* win = KIN(I_WIN) + (size_t)l * DM * INC; const float* wout = KIN(I_WOUT) + (size_t)l * DM * DM;
    constexpr int T_GU = CV_T_GU, T_D = CV_T_D, T_IN = CV_T_IN;
    for (int it = t_lo + idx; it < t_hi; it += cnt) {
        int r = it;
        if (r < 4 * T_GU) { const int which = r / T_GU; r -= which * T_GU; const int nb = r % (FF / 256), kb = r / (FF / 256);
            const float* W = which == 0 ? f1g : (which == 1 ? f1u : (which == 2 ? f2g : f2u)); unsigned char* WT = ws + (which < 2 ? wofs(1, par) : wofs(5, par));
            if (which & 1) cvt_task8<2>(W, DM, FF, WT, nb, 32 * kb, lane); else cvt_task8<1>(W, DM, FF, WT, nb, 32 * kb, lane); continue; }
        r -= 4 * T_GU;
        if (r < 2 * T_D) { const int which = r / T_D; r -= which * T_D; const int nb = r % (DM / 256), kb = r / (DM / 256);
            cvt_task8<0>(which == 0 ? f1d : f2d, FF, DM, ws + (which == 0 ? wofs(2, par) : wofs(6, par)), nb, 32 * kb, lane); continue; }
        r -= 2 * T_D;
        if (r < T_IN) { const int nb = r % ((INC + 255) / 256), kb = r / ((INC + 255) / 256); cvt_task<3>(win, DM, INC, (bf16*)(ws + wofs(3, par)), nb, 32 * kb, lane); continue; }
        r -= T_IN;
        { const int nb = r % (DM / 256), kb = r / (DM / 256); cvt_task<0>(wout, DM, DM, (bf16*)(ws + wofs(4, par)), nb, 32 * kb, lane); }
    }
    if (small) {
        { v4u* z = (v4u*)(ws + wofs(3, par) + (size_t)SHIFT * DM * 2); const int nz = (PLD - SHIFT) * DM * 2 / 16;
          unsigned z0; asm volatile("v_mov_b32 %0, 0" : "=v"(z0));
          for (int i = idx * 64 + lane; i < nz; i += cnt * 64) z[i] = (v4u){z0, z0, z0, z0}; }
        { bf16* WT = (bf16*)(ws + wofs(7, par)); const float* wup = KIN(I_WUP) + (size_t)l * 64 * RW; const float* aup = KIN(I_AUP) + (size_t)l * 64 * RW; const float* gup = KIN(I_GUP) + (size_t)l * 160 * RW;
          for (int i = idx * 64 + lane; i < NL * LK; i += cnt * 64) { const int n = i / LK, k = i % LK, kind = n >> 10, c = n & 1023; float v = 0.f;
              if (kind == 0) { if (k < 64) v = wup[(size_t)k * RW + c]; } else if (kind == 1) { if (k >= 64 && k < 128) v = aup[(size_t)(k - 64) * RW + c]; } else { if (k >= 128 && k < 288) v = gup[(size_t)(k - 128) * RW + c]; }
              WT[i] = (bf16)f2bf(v); } }
    }
    if (inputs) {
        float* X = (float*)(ws + WS_X); bf16* XB = (bf16*)(ws + WS_XB); const float* xp = KIN(I_XP); const float* xs = KIN(I_XS);
        for (int m = idx; m < M; m += cnt) { const float* src = m < TP ? xp + (size_t)m * DM : xs + (size_t)(m - TP) * DM;
            const f32x4* s4 = (const f32x4*)src + lane; f32x4* d4 = (f32x4*)(X + (size_t)m * DM) + lane; unsigned long long* o8 = (unsigned long long*)(XB + (size_t)m * DM) + lane; unsigned* q8 = (unsigned*)(ws + B_XB8 + (size_t)m * DM) + lane;
#pragma unroll
            for (int j = 0; j < 8; ++j) { const f32x4 v = s4[64 * j]; if (m >= TP) d4[64 * j] = v; o8[64 * j] = (unsigned long long)pk2(v.x, v.y) | ((unsigned long long)pk2(v.z, v.w) << 32);
                unsigned w = 0u; w = __builtin_amdgcn_cvt_pk_fp8_f32(v.x, v.y, w, false); w = __builtin_amdgcn_cvt_pk_fp8_f32(v.z, v.w, w, true); q8[64 * j] = w; } }
    }
}

__device__ __forceinline__ void phase_ln(const float* Z, const float* Xres, const float* slab, int KS, float sa, float sb, const float* g, const float* b, float* Xo, bf16* XBo, unsigned char* XB8o  , bool all_rows, int lane, int gw, int NGW) {
    const bool deal = NGW == 2048; const int nit = deal ? (gw < 512 ? 3 : 10) : (M - gw + NGW - 1) / NGW;
    for (int it = 0; it < nit; ++it) {
        const int m = !deal ? gw + it * NGW : (gw < 512 ? (it == 0 ? TP + gw : 2 * gw + it - 1) : 1024 + (gw - 512) + it * 1536);
        f32x4 v[8]; float s = 0.f;
        if (m < TP) { const f32x4* zr = (const f32x4*)(Z + (size_t)m * DM) + lane;
#pragma unroll
            for (int j = 0; j < 8; ++j) v[j] = zr[64 * j];
        } else { const f32x4* xr = (const f32x4*)(Xres + (size_t)m * DM) + lane; f32x4 a[8];
#pragma unroll
            for (int j = 0; j < 8; ++j) { v[j] = xr[64 * j]; a[j] = (f32x4){0.f, 0.f, 0.f, 0.f}; }
            for (int ks = 0; ks < KS; ++ks) { const f32x4* sr = (const f32x4*)(slab + ((size_t)ks * 512 + (m - TP)) * DM) + lane;
#pragma unroll
                for (int j = 0; j < 8; ++j) a[j] = a[j] + sr[64 * j]; }
#pragma unroll
            for (int j = 0; j < 8; ++j) v[j] = v[j] * sa + a[j] * sb; }
#pragma unroll
        for (int j = 0; j < 8; ++j) s += (v[j].x + v[j].y) + (v[j].z + v[j].w);
        const float mean = wave_sum(s) * (1.f / DM); float s2 = 0.f;
#pragma unroll
        for (int j = 0; j < 8; ++j) { v[j] = v[j] - mean; s2 += (v[j].x * v[j].x + v[j].y * v[j].y) + (v[j].z * v[j].z + v[j].w * v[j].w); }
        const float rstd = 1.f / sqrtf(wave_sum(s2) * (1.f / DM) + LN_EPS);
        f32x4* xo = (f32x4*)(Xo + (size_t)m * DM) + lane; const bool wx = all_rows || m >= TP;
#pragma unroll
        for (int j = 0; j < 8; ++j) { const f32x4 gg = ((const f32x4*)g)[lane + 64 * j], bb = ((const f32x4*)b)[lane + 64 * j]; const f32x4 o = v[j] * rstd * gg + bb; if (wx) xo[64 * j] = o;
            if (XBo) ((unsigned long long*)(XBo + (size_t)m * DM) + lane)[64 * j] = (unsigned long long)pk2(o.x, o.y) | ((unsigned long long)pk2(o.z, o.w) << 32);
            if (XB8o) { unsigned w = 0u; w = __builtin_amdgcn_cvt_pk_fp8_f32(o.x, o.y, w, false); w = __builtin_amdgcn_cvt_pk_fp8_f32(o.z, o.w, w, true); ((unsigned*)(XB8o + (size_t)m * DM) + lane)[64 * j] = w; } }
    }
}

__device__ __forceinline__ const float* prev_row(const float* ssh, int l, const float* P, int m) {
    if (m < TP) return m == 0 ? nullptr : P + (size_t)(m - 1) * PLD;
    const int b = (m - TP) >> 5, t = (m - TP) & 31;
    return t == 0 ? ssh + (size_t)(l * NSB + b) * SHIFT : P + (size_t)(m - 1) * PLD;
}

__device__ __forceinline__ void phase_prep1(int l, int lane, int gw, int NGW) {
    unsigned char* ws = KWS(); float* outp = KOUT(); const float* P = (const float*)(ws + B_P); float* GV = (float*)(ws + B_GV); bf16* A3B = (bf16*)(ws + B_A3B);
    const float* mu = KIN(I_MU) + (size_t)l * SHIFT; const float* lg = KIN(I_GLG) + (size_t)l * GMW; const float* lb = KIN(I_GLB) + (size_t)l * GMW;
    const float* ssh = KIN(I_SSH);
    for (int m = gw; m < M; m += NGW) {
        const float* pr = P + (size_t)m * PLD; const float* pp = prev_row(ssh, l, P, m);
#pragma unroll
        for (int jj = 0; jj < 6; ++jj) { const int j = jj * 64 + lane; float v = 0.f;
            if (j < 288) { const int c = C_W + j; const float p = pr[c], q = pp ? pp[c] : 0.f; const float xs = p + (q - p) * mu[c];
                if (j < 64) { const float t = __expf(-2.f * fabsf(xs)); const float r = (1.f - t) / (1.f + t); v = xs < 0.f ? -r : r; }
                else if (j < 128) v = xs;
                else v = 1.f / (1.f + __expf(-xs)); }
            A3B[(size_t)m * LK + j] = (bf16)f2bf(v); }
        { f32x4* vr = (f32x4*)(GV + (size_t)m * GMW) + lane; f32x4 v[4]; float s = 0.f;
#pragma unroll
          for (int j = 0; j < 4; ++j) { v[j] = vr[64 * j]; s += (v[j].x + v[j].y) + (v[j].z + v[j].w); }
          const float mean = wave_sum(s) * (1.f / GMW); float s2 = 0.f;
#pragma unroll
          for (int j = 0; j < 4; ++j) { v[j] = v[j] - mean; s2 += (v[j].x * v[j].x + v[j].y * v[j].y) + (v[j].z * v[j].z + v[j].w * v[j].w); }
          const float rstd = 1.f / sqrtf(wave_sum(s2) * (1.f / GMW) + LN_EPS);
          f32x4* go = nullptr; if (m >= TP) go = (f32x4*)(outp + O_GV + ((size_t)l * NSB * TS + (m - TP)) * GMW) + lane;
#pragma unroll
          for (int j = 0; j < 4; ++j) { const f32x4 o = v[j] * rstd * ((const f32x4*)lg)[lane + 64 * j] + ((const f32x4*)lb)[lane + 64 * j]; vr[64 * j] = o; if (go) go[64 * j] = o; } }
        if (m == TP - 1) { float* o = outp + O_SHP + (size_t)l * SHIFT; for (int c = lane; c < SHIFT; c += 64) o[c] = pr[c]; }
        if (m >= TP && ((m - TP) & 31) == 31) { float* o = outp + O_SHS + (size_t)(l * NSB + ((m - TP) >> 5)) * SHIFT; for (int c = lane; c < SHIFT; c += 64) o[c] = pr[c]; }
    }
}

typedef unsigned u32x2g __attribute__((ext_vector_type(2)));
constexpr int GLD = 272, GL_VT = 128 * GLD, GSP = 132;
static_assert(2 * GL_VT <= RING_BYTES && 128 * GSP * 4 <= 2 * GL_VT, "gMLP LDS");
__device__ __forceinline__ void gmlp_unit(int l, LAS unsigned char* lds, int unit, int tid, int wave) {
    unsigned char* ws = KWS(); const float* VN = (const float*)(ws + B_GV); const bf16* U = (const bf16*)(ws + B_U); bf16* MIXB = (bf16*)(ws + B_MIX);
    const int ci = unit >> 3, h = unit & 7; int row0, nr; if (ci < 128) { row0 = 128 * ci; nr = 128; } else { row0 = TP + 32 * (ci - 128); nr = 32; }
    const float* wsm = KIN(I_GWS) + ((size_t)l * GH + h) * 128 * 128; const float* bs = KIN(I_GBS) + ((size_t)l * GH + h) * 128;
    LAS unsigned char* Wb = lds; LAS unsigned char* Vt = lds + GL_VT; LAS float* So = (LAS float*)lds;
    const int lane = tid & 63, g = lane >> 4, lc = lane & 15;
    __syncthreads();
    for (int idx = tid; idx < nr * 32; idx += NTHR) { const int i = idx >> 5, j4 = idx & 31; f32x4 w4 = *(const f32x4*)(wsm + i * 128 + 4 * j4);
        const int j = 4 * j4; if (j > i) w4.x = 0.f; if (j + 1 > i) w4.y = 0.f; if (j + 2 > i) w4.z = 0.f; if (j + 3 > i) w4.w = 0.f;
        *(LAS u32x2g*)(Wb + i * GLD + 8 * j4) = (u32x2g){pk2(w4.x, w4.y), pk2(w4.z, w4.w)}; }
    { const int c = tid & 127, jg = tid >> 7;
      if (32 * jg < nr) { const float* vp = VN + (size_t)(row0 + 32 * jg) * GMW + h * GHD + c; float vv[32];
#pragma unroll
          for (int j = 0; j < 32; ++j) vv[j] = vp[(size_t)j * GMW];
#pragma unroll
          for (int q = 0; q < 4; ++q) *(LAS v4u*)(Vt + c * GLD + (32 * jg + 8 * q) * 2) = (v4u){pk2(vv[8 * q], vv[8 * q + 1]), pk2(vv[8 * q + 2], vv[8 * q + 3]), pk2(vv[8 * q + 4], vv[8 * q + 5]), pk2(vv[8 * q + 6], vv[8 * q + 7])}; } }
    __syncthreads();
    float zf; asm volatile("v_mov_b32 %0, 0" : "=v"(zf));
    f32x4 acc[8];
#pragma unroll
    for (int cb = 0; cb < 8; ++cb) acc[cb] = (f32x4){zf, zf, zf, zf};
    const bool rows_live = 16 * wave < nr;
    if (rows_live) { const int nks = (wave + 2) >> 1;
        for (int ks = 0; ks < nks; ++ks) { const bf16x8 fa = *(const LAS bf16x8*)(Wb + (16 * wave + lc) * GLD + (32 * ks + 8 * g) * 2);
#pragma unroll
            for (int cb = 0; cb < 8; ++cb) acc[cb] = __builtin_amdgcn_mfma_f32_16x16x32_bf16(fa, *(const LAS bf16x8*)(Vt + (16 * cb + lc) * GLD + (32 * ks + 8 * g) * 2), acc[cb], 0, 0, 0); } }
    __syncthreads();
    if (rows_live) {
#pragma unroll
        for (int rg = 0; rg < 4; ++rg) { const int i = 16 * wave + 4 * g + rg; const float b0 = bs[i];
#pragma unroll
            for (int cb = 0; cb < 8; ++cb) So[i * GSP + 16 * cb + lc] = acc[cb][rg] + b0; } }
    __syncthreads();
    const int rq = tid >> 4, cg = tid & 15;
    if (4 * rq < nr) {
#pragma unroll
        for (int r = 0; r < 4; ++r) { const int i = 4 * rq + r; const size_t row = (size_t)(row0 + i); const v4u uu = *(const v4u*)(U + row * GMW + h * GHD + 8 * cg);
            const f32x4 s0 = *(const LAS f32x4*)(So + i * GSP + 8 * cg), s1 = *(const LAS f32x4*)(So + i * GSP + 8 * cg + 4);
            const float u0 = __builtin_bit_cast(float, uu.x << 16), u1 = __builtin_bit_cast(float, uu.x & 0xffff0000u), u2 = __builtin_bit_cast(float, uu.y << 16), u3 = __builtin_bit_cast(float, uu.y & 0xffff0000u);
            const float u4 = __builtin_bit_cast(float, uu.z << 16), u5 = __builtin_bit_cast(float, uu.z & 0xffff0000u), u6 = __builtin_bit_cast(float, uu.w << 16), u7 = __builtin_bit_cast(float, uu.w & 0xffff0000u);
            v4u o; o.x = pk2(u0 * s0.x, u1 * s0.y); o.y = pk2(u2 * s0.z, u3 * s0.w); o.z = pk2(u4 * s1.x, u5 * s1.y); o.w = pk2(u6 * s1.z, u7 * s1.w);
            *(v4u*)(MIXB + row * DM + RW + h * GHD + 8 * cg) = o; }
    }
}


constexpr int NCI = 272, NUNIT = NCI * NH;
constexpr size_t SC_G = WS_RW + 3 * RWSZ;
constexpr size_t SC_HL = SC_G + (size_t)NUNIT * 8192;
constexpr size_t SC_RP = SC_HL + (size_t)NUNIT * 16384;
constexpr size_t SC_YL = SC_RP + (size_t)NUNIT * 8192;
constexpr size_t SC_S0 = SC_YL + (size_t)NUNIT * 16384;
constexpr size_t SC_BON = SC_S0 + (size_t)NUNIT * 8192;
constexpr size_t SC_END = SC_BON + (size_t)NUNIT * 256;
static_assert(SC_END <= WS_END, "scan scratch");
constexpr size_t WS_SLAB = SC_G;
static_assert(WS_SLAB + (size_t)11 * 512 * 2048 * 4 <= WS_END, "slab");
typedef unsigned u32x2 __attribute__((ext_vector_type(2)));
constexpr int BLD = 144;
constexpr int LBUF = 9216;
constexpr int LF0 = 7 * LBUF, F0P = 129;
constexpr int LF1 = LF0 + 64 * F0P * 4, F1P = 68;
constexpr int LF2 = LF1 + 64 * F1P * 4;
constexpr int LTOT = LF2 + 16384;
constexpr int LGC = LTOT + 2048;
constexpr int SCAN_LDS = LGC + 256;
static_assert(SCAN_LDS <= RING_BYTES, "scan LDS");

__device__ __forceinline__ bf16x8 ldfrag(const LAS unsigned char* mat, int blk, int ks, int lane) { return *(const LAS bf16x8*)(mat + (16 * blk + (lane & 15)) * BLD + (32 * ks + 8 * (lane >> 4)) * 2); }
#define MFMA16(a, b, c) __builtin_amdgcn_mfma_f32_16x16x32_bf16((a), (b), (c), 0, 0, 0)

#define LDS_BAR() do { asm volatile("s_waitcnt lgkmcnt(0)" ::: "memory"); __builtin_amdgcn_s_barrier(); asm volatile("" ::: "memory"); } while (0)
__device__ __forceinline__ void scanA_all(int l, LAS unsigned char* lds, int bx, int G, int tid, int wave) {
    unsigned char* ws = KWS();
    const int lane = tid & 63;
    const float* ssh = KIN(I_SSH); const float* mu = KIN(I_MU) + (size_t)l * SHIFT;
    const float *w0p = KIN(I_W0) + (size_t)l * RW, *a0p = KIN(I_A0) + (size_t)l * RW, *kkp = KIN(I_KK) + (size_t)l * RW, *kap = KIN(I_KA) + (size_t)l * RW, *rkp = KIN(I_RK) + (size_t)l * RW;
    float pr_[8], pk_[8], pv_[8], al_[8], wl_[8]; float q_r, q_k, q_v, mu_r, mu_k, mu_v, w0c, a0c, kkc, kac, rkc;
#define SA_LOAD(unit_) do { const int ci_ = (unit_) >> 4, cc_ = 64 * ((unit_) & 15) + lane; const int m0_ = ci_ < 256 ? 64 * ci_ : TP + 32 * (ci_ - 256), n_ = ci_ < 256 ? 64 : 32, t0_ = 8 * wave; \
        const float* P_ = (const float*)(ws + B_P); const float* Wl_ = (const float*)(ws + WS_RW); const float* Al_ = (const float*)(ws + WS_RW + RWSZ); \
        mu_r = mu[cc_]; mu_k = mu[RW + cc_]; mu_v = mu[2 * RW + cc_]; w0c = w0p[cc_]; a0c = a0p[cc_]; kkc = kkp[cc_]; kac = kap[cc_]; rkc = rkp[cc_]; q_r = 0.f; q_k = 0.f; q_v = 0.f; \
        if (t0_ < n_) { const float* pp_ = prev_row(ssh, l, P_, m0_ + t0_); if (pp_) { q_r = pp_[cc_]; q_k = pp_[RW + cc_]; q_v = pp_[2 * RW + cc_]; } } \
        _Pragma("unroll") for (int i = 0; i < 8; ++i) { pr_[i] = 0.f; pk_[i] = 0.f; pv_[i] = 0.f; al_[i] = 0.f; wl_[i] = 0.f; } \
        if (t0_ < n_) { _Pragma("unroll") for (int i = 0; i < 8; ++i) { const size_t m_ = (size_t)(m0_ + t0_ + i); const float* prow_ = P_ + m_ * PLD; pr_[i] = prow_[cc_]; pk_[i] = prow_[RW + cc_]; pv_[i] = prow_[2 * RW + cc_]; al_[i] = Al_[m_ * RW + cc_]; wl_[i] = Wl_[m_ * RW + cc_]; } } } while (0)
    if (bx < NUNIT) SA_LOAD(bx);
    for (int unit = bx; unit < NUNIT; unit += G) {
    const int ci = unit >> 4;
    int m0, n; if (ci < 256) { m0 = 64 * ci; n = 64; } else { m0 = TP + 32 * (ci - 256); n = 32; }
    (void)m0;
    const float* P = (const float*)(ws + B_P); const float* Wl = (const float*)(ws + WS_RW); const float* Al = (const float*)(ws + WS_RW + RWSZ);
    LAS unsigned char* B0 = lds; LAS unsigned char* B1 = lds + LBUF; LAS unsigned char* B2 = lds + 2 * LBUF; LAS unsigned char* B3 = lds + 3 * LBUF;
    LAS unsigned char* B4 = lds + 4 * LBUF; LAS unsigned char* B5 = lds + 5 * LBUF; LAS unsigned char* B6 = lds + 6 * LBUF;
    LAS float* F0 = (LAS float*)(lds + LF0); LAS float* F1 = (LAS float*)(lds + LF1); LAS float* F2 = (LAS float*)(lds + LF2); LAS float* TOT = (LAS float*)(lds + LTOT); LAS float* GC = (LAS float*)(lds + LGC);
    LDS_BAR();
    {
        const int t0 = 8 * wave; const bool live = t0 < n;
        float r[8], kp[8], v[8], kk[8], b[8], lw[8], bsv[8];
        float* bon = (float*)(ws + SC_BON) + (size_t)unit * 64;
#pragma unroll
        for (int i = 0; i < 8; ++i) { r[i] = 0.f; kp[i] = 0.f; v[i] = 0.f; kk[i] = 0.f; b[i] = 0.f; lw[i] = 0.f; bsv[i] = 0.f; }
        if (live) {
#pragma unroll
            for (int i = 0; i < 8; ++i) {
                const float p_r = pr_[i], p_k = pk_[i], p_v = pv_[i];
                const float rr = p_r + (q_r - p_r) * mu_r, kx = p_k + (q_k - p_k) * mu_k, vx = p_v + (q_v - p_v) * mu_v; q_r = p_r; q_k = p_k; q_v = p_v;
                const float av = __builtin_amdgcn_rcpf(1.f + __expf(-(a0c + al_[i])));
                const float sg = __builtin_amdgcn_rcpf(1.f + __expf(-(w0c + wl_[i])));
                const float kkv = kx * kkc; const float n2 = wave_sum(kkv * kkv); const float kn = kkv * __builtin_amdgcn_rsqf(fmaxf(n2, 1e-24f));
                const float kpv = kx * (1.f + (av - 1.f) * kac);
                bsv[i] = wave_sum(rr * kpv * rkc);
                r[i] = rr; kp[i] = kpv; v[i] = vx; kk[i] = kn; b[i] = kn * av; lw[i] = -0.60653065971263342f * sg; }
        }
        if (live && lane < 8) { float bv = bsv[0];
#pragma unroll
            for (int i = 1; i < 8; ++i) bv = lane == i ? bsv[i] : bv;
            bon[t0 + lane] = bv; }
        if (unit + G < NUNIT) SA_LOAD(unit + G);
        float pl[8]; pl[0] = lw[0];
#pragma unroll
        for (int i = 1; i < 8; ++i) pl[i] = pl[i - 1] + lw[i];
        TOT[wave * 64 + lane] = pl[7];
        LDS_BAR();
        float off = 0.f, lamC = 0.f;
#pragma unroll
        for (int s = 0; s < 8; ++s) { const float tv = TOT[s * 64 + lane]; lamC += tv; if (s < wave) off += tv; }
        const float gC = __expf(lamC); if (wave == 0) GC[lane] = gC;
        unsigned vt[4], kb[4], bb[4];
#pragma unroll
        for (int i = 0; i < 8; ++i) { const int t = t0 + i; const float lam = off + pl[i];
            const float g_t = __expf(lam), g_p = __expf(lam - lw[i]), g_i = __expf(-lam), g_c = gC * g_i;
            const float kkt = kk[i] * g_p, rt = r[i] * g_t;
            *(LAS unsigned short*)(B0 + t * BLD + lane * 2) = (unsigned short)f2bf(kkt); F0[t * F0P + lane] = kkt;
            *(LAS unsigned short*)(B1 + t * BLD + lane * 2) = (unsigned short)f2bf(rt); F2[t * 64 + lane] = rt;
            *(LAS unsigned short*)(B2 + t * BLD + lane * 2) = (unsigned short)f2bf(kp[i] * g_i);
            *(LAS unsigned short*)(B3 + t * BLD + lane * 2) = (unsigned short)f2bf(b[i] * g_i);
            const unsigned hv = f2bf(v[i]), hk = f2bf(kp[i] * g_c), hb = f2bf(b[i] * g_c);
            if (i & 1) { vt[i >> 1] |= hv << 16; kb[i >> 1] |= hk << 16; bb[i >> 1] |= hb << 16; } else { vt[i >> 1] = hv; kb[i >> 1] = hk; bb[i >> 1] = hb; } }
        *(LAS v4u*)(B4 + lane * BLD + 16 * wave) = (v4u){vt[0], vt[1], vt[2], vt[3]};
        *(LAS v4u*)(B5 + lane * BLD + 16 * wave) = (v4u){kb[0], kb[1], kb[2], kb[3]};
        *(LAS v4u*)(B6 + lane * BLD + 16 * wave) = (v4u){bb[0], bb[1], bb[2], bb[3]};
    }
    LDS_BAR();
    const int rb = wave >> 1, cb0 = (wave & 1) * 2, g = lane >> 4, lc = lane & 15;
    float zf; asm volatile("v_mov_b32 %0, 0" : "=v"(zf));
    const f32x4 z4 = (f32x4){zf, zf, zf, zf};
    {
        f32x4 aab[2] = {z4, z4}, aak[2] = {z4, z4}, arb[2] = {z4, z4}, ark[2] = {z4, z4};
#pragma unroll
        for (int ks = 0; ks < 2; ++ks) { const bf16x8 fk = ldfrag(B0, rb, ks, lane), fr = ldfrag(B1, rb, ks, lane);
#pragma unroll
            for (int c = 0; c < 2; ++c) { const bf16x8 fkh = ldfrag(B2, cb0 + c, ks, lane), fb = ldfrag(B3, cb0 + c, ks, lane);
                aab[c] = MFMA16(fk, fb, aab[c]); aak[c] = MFMA16(fk, fkh, aak[c]); arb[c] = MFMA16(fr, fb, arb[c]); ark[c] = MFMA16(fr, fkh, ark[c]); } }
        LDS_BAR();
#pragma unroll
        for (int c = 0; c < 2; ++c)
#pragma unroll
            for (int rg = 0; rg < 4; ++rg) { const int t = 16 * rb + 4 * g + rg, s = 16 * (cb0 + c) + lc;
                F1[t * F1P + (s & 3) * 16 + (s >> 2)] = s < t ? aab[c][rg] : 0.f;
                *(LAS unsigned short*)(B0 + t * BLD + s * 2) = (unsigned short)f2bf(s < t ? aak[c][rg] : 0.f);
                *(LAS unsigned short*)(B1 + t * BLD + s * 2) = (unsigned short)f2bf(s <= t ? arb[c][rg] : 0.f);
                *(LAS unsigned short*)(B2 + t * BLD + s * 2) = (unsigned short)f2bf(s <= t ? ark[c][rg] : 0.f); }
    }
    LDS_BAR();
    {
        f32x4 av[2] = {z4, z4};
#pragma unroll
        for (int ks = 0; ks < 2; ++ks) { const bf16x8 fa = ldfrag(B0, rb, ks, lane);
#pragma unroll
            for (int c = 0; c < 2; ++c) av[c] = MFMA16(fa, ldfrag(B4, cb0 + c, ks, lane), av[c]); }
#pragma unroll
        for (int c = 0; c < 2; ++c)
#pragma unroll
            for (int rg = 0; rg < 4; ++rg) F0[(16 * rb + 4 * g + rg) * F0P + 64 + 16 * (cb0 + c) + lc] = av[c][rg];
    }
    LDS_BAR();
    {
        const int j = tid >> 2, p = tid & 3; const LAS float* f1p = F1 + p * 16; const LAS float* f0p = F0 + j;
        float x0 = zf, x1 = zf, x2 = zf, x3 = zf, x4 = zf, x5 = zf, x6 = zf, x7 = zf, x8 = zf, x9 = zf, x10 = zf, x11 = zf, x12 = zf, x13 = zf, x14 = zf, x15 = zf;
        { float part = zf; const float xt = f0p[0*F0P] - part; x0 = (p == 0) ? xt : x0; }
        { const f32x4 a0 = *(const LAS f32x4*)(f1p + 1*F1P + 0); float part = a0.x * x0; part += dpp_mov<0xB1>(part); part += dpp_mov<0x4E>(part); const float xt = f0p[1*F0P] - part; x0 = (p == 1) ? xt : x0; }
        { const f32x4 a0 = *(const LAS f32x4*)(f1p + 2*F1P + 0); float part = a0.x * x0; part += dpp_mov<0xB1>(part); part += dpp_mov<0x4E>(part); const float xt = f0p[2*F0P] - part; x0 = (p == 2) ? xt : x0; }
        { const f32x4 a0 = *(const LAS f32x4*)(f1p + 3*F1P + 0); float part = a0.x * x0; part += dpp_mov<0xB1>(part); part += dpp_mov<0x4E>(part); const float xt = f0p[3*F0P] - part; x0 = (p == 3) ? xt : x0; }
        { const f32x4 a0 = *(const LAS f32x4*)(f1p + 4*F1P + 0); float part = a0.x * x0; part += dpp_mov<0xB1>(part); part += dpp_mov<0x4E>(part); const float xt = f0p[4*F0P] - part; x1 = (p == 0) ? xt : x1; }
        { const f32x4 a0 = *(const LAS f32x4*)(f1p + 5*F1P + 0); float part = (a0.x * x0) + (a0.y * x1); part += dpp_mov<0xB1>(part); part += dpp_mov<0x4E>(part); const float xt = f0p[5*F0P] - part; x1 = (p == 1) ? xt : x1; }
        { const f32x4 a0 = *(const LAS f32x4*)(f1p + 6*F1P + 0); float part = (a0.x * x0) + (a0.y * x1); part += dpp_mov<0xB1>(part); part += dpp_mov<0x4E>(part); const float xt = f0p[6*F0P] - part; x1 = (p == 2) ? xt : x1; }
        { const f32x4 a0 = *(const LAS f32x4*)(f1p + 7*F1P + 0); float part = (a0.x * x0) + (a0.y * x1); part += dpp_mov<0xB1>(part); part += dpp_mov<0x4E>(part); const float xt = f0p[7*F0P] - part; x1 = (p == 3) ? xt : x1; }
        { const f32x4 a0 = *(const LAS f32x4*)(f1p + 8*F1P + 0); float part = (a0.x * x0) + (a0.y * x1); part += dpp_mov<0xB1>(part); part += dpp_mov<0x4E>(part); const float xt = f0p[8*F0P] - part; x2 = (p == 0) ? xt : x2; }
        { const f32x4 a0 = *(const LAS f32x4*)(f1p + 9*F1P + 0); float part = (a0.x * x0 + a0.z * x2) + (a0.y * x1); part += dpp_mov<0xB1>(part); part += dpp_mov<0x4E>(part); const float xt = f0p[9*F0P] - part; x2 = (p == 1) ? xt : x2; }
        { const f32x4 a0 = *(const LAS f32x4*)(f1p + 10*F1P + 0); float part = (a0.x * x0 + a0.z * x2) + (a0.y * x1); part += dpp_mov<0xB1>(part); part += dpp_mov<0x4E>(part); const float xt = f0p[10*F0P] - part; x2 = (p == 2) ? xt : x2; }
        { const f32x4 a0 = *(const LAS f32x4*)(f1p + 11*F1P + 0); float part = (a0.x * x0 + a0.z * x2) + (a0.y * x1); part += dpp_mov<0xB1>(part); part += dpp_mov<0x4E>(part); const float xt = f0p[11*F0P] - part; x2 = (p == 3) ? xt : x2; }
        { const f32x4 a0 = *(const LAS f32x4*)(f1p + 12*F1P + 0); float part = (a0.x * x0 + a0.z * x2) + (a0.y * x1); part += dpp_mov<0xB1>(part); part += dpp_mov<0x4E>(part); const float xt = f0p[12*F0P] - part; x3 = (p == 0) ? xt : x3; }
        { const f32x4 a0 = *(const LAS f32x4*)(f1p + 13*F1P + 0); float part = (a0.x * x0 + a0.z * x2) + (a0.y * x1 + a0.w * x3); part += dpp_mov<0xB1>(part); part += dpp_mov<0x4E>(part); const float xt = f0p[13*F0P] - part; x3 = (p == 1) ? xt : x3; }
        { const f32x4 a0 = *(const LAS f32x4*)(f1p + 14*F1P + 0); float part = (a0.x * x0 + a0.z * x2) + (a0.y * x1 + a0.w * x3); part += dpp_mov<0xB1>(part); part += dpp_mov<0x4E>(part); const float xt = f0p[14*F0P] - part; x3 = (p == 2) ? xt : x3; }
        { const f32x4 a0 = *(const LAS f32x4*)(f1p + 15*F1P + 0); float part = (a0.x * x0 + a0.z * x2) + (a0.y * x1 + a0.w * x3); part += dpp_mov<0xB1>(part); part += dpp_mov<0x4E>(part); const float xt = f0p[15*F0P] - part; x3 = (p == 3) ? xt : x3; }
        { const f32x4 a0 = *(const LAS f32x4*)(f1p + 16*F1P + 0); float part = (a0.x * x0 + a0.z * x2) + (a0.y * x1 + a0.w * x3); part += dpp_mov<0xB1>(part); part += dpp_mov<0x4E>(part); const float xt = f0p[16*F0P] - part; x4 = (p == 0) ? xt : x4; }
        { const f32x4 a0 = *(const LAS f32x4*)(f1p + 17*F1P + 0); const f32x4 a1 = *(const LAS f32x4*)(f1p + 17*F1P + 4); float part = (a0.x * x0 + a0.z * x2 + a1.x * x4) + (a0.y * x1 + a0.w * x3); part += dpp_mov<0xB1>(part); part += dpp_mov<0x4E>(part); const float xt = f0p[17*F0P] - part; x4 = (p == 1) ? xt : x4; }
        { const f32x4 a0 = *(const LAS f32x4*)(f1p + 18*F1P + 0); const f32x4 a1 = *(const LAS f32x4*)(f1p + 18*F1P + 4); float part = (a0.x * x0 + a0.z * x2 + a1.x * x4) + (a0.y * x1 + a0.w * x3); part += dpp_mov<0xB1>(part); part += dpp_mov<0x4E>(part); const float xt = f0p[18*F0P] - part; x4 = (p == 2) ? xt : x4; }
        { const f32x4 a0 = *(const LAS f32x4*)(f1p + 19*F1P + 0); const f32x4 a1 = *(const LAS f32x4*)(f1p + 19*F1P + 4); float part = (a0.x * x0 + a0.z * x2 + a1.x * x4) + (a0.y * x1 + a0.w * x3); part += dpp_mov<0xB1>(part); part += dpp_mov<0x4E>(part); const float xt = f0p[19*F0P] - part; x4 = (p == 3) ? xt : x4; }
        { const f32x4 a0 = *(const LAS f32x4*)(f1p + 20*F1P + 0); const f32x4 a1 = *(const LAS f32x4*)(f1p + 20*F1P + 4); float part = (a0.x * x0 + a0.z * x2 + a1.x * x4) + (a0.y * x1 + a0.w * x3); part += dpp_mov<0xB1>(part); part += dpp_mov<0x4E>(part); const float xt = f0p[20*F0P] - part; x5 = (p == 0) ? xt : x5; }
        { const f32x4 a0 = *(const LAS f32x4*)(f1p + 21*F1P + 0); const f32x4 a1 = *(const LAS f32x4*)(f1p + 21*F1P + 4); float part = (a0.x * x0 + a0.z * x2 + a1.x * x4) + (a0.y * x1 + a0.w * x3 + a1.y * x5); part += dpp_mov<0xB1>(part); part += dpp_mov<0x4E>(part); const float xt = f0p[21*F0P] - part; x5 = (p == 1) ? xt : x5; }
        { const f32x4 a0 = *(const LAS f32x4*)(f1p + 22*F1P + 0); const f32x4 a1 = *(const LAS f32x4*)(f1p + 22*F1P + 4); float part = (a0.x * x0 + a0.z * x2 + a1.x * x4) + (a0.y * x1 + a0.w * x3 + a1.y * x5); part += dpp_mov<0xB1>(part); part += dpp_mov<0x4E>(part); const float xt = f0p[22*F0P] - part; x5 = (p == 2) ? xt : x5; }
        { const f32x4 a0 = *(const LAS f32x4*)(f1p + 23*F1P + 0); const f32x4 a1 = *(const LAS f32x4*)(f1p + 23*F1P + 4); float part = (a0.x * x0 + a0.z * x2 + a1.x * x4) + (a0.y * x1 + a0.w * x3 + a1.y * x5); part += dpp_mov<0xB1>(part); part += dpp_mov<0x4E>(part); const float xt = f0p[23*F0P] - part; x5 = (p == 3) ? xt : x5; }
        { const f32x4 a0 = *(const LAS f32x4*)(f1p + 24*F1P + 0); const f32x4 a1 = *(const LAS f32x4*)(f1p + 24*F1P + 4); float part = (a0.x * x0 + a0.z * x2 + a1.x * x4) + (a0.y * x1 + a0.w * x3 + a1.y * x5); part += dpp_mov<0xB1>(part); part += dpp_mov<0x4E>(part); const float xt = f0p[24*F0P] - part; x6 = (p == 0) ? xt : x6; }
        { const f32x4 a0 = *(const LAS f32x4*)(f1p + 25*F1P + 0); const f32x4 a1 = *(const LAS f32x4*)(f1p + 25*F1P + 4); float part = (a0.x * x0 + a0.z * x2 + a1.x * x4 + a1.z * x6) + (a0.y * x1 + a0.w * x3 + a1.y * x5); part += dpp_mov<0xB1>(part); part += dpp_mov<0x4E>(part); const float xt = f0p[25*F0P] - part; x6 = (p == 1) ? xt : x6; }
        { const f32x4 a0 = *(const LAS f32x4*)(f1p + 26*F1P + 0); const f32x4 a1 = *(const LAS f32x4*)(f1p + 26*F1P + 4); float part = (a0.x * x0 + a0.z * x2 + a1.x * x4 + a1.z * x6) + (a0.y * x1 + a0.w * x3 + a1.y * x5); part += dpp_mov<0xB1>(part); part += dpp_mov<0x4E>(part); const float xt = f0p[26*F0P] - part; x6 = (p == 2) ? xt : x6; }
        { const f32x4 a0 = *(const LAS f32x4*)(f1p + 27*F1P + 0); const f32x4 a1 = *(const LAS f32x4*)(f1p + 27*F1P + 4); float part = (a0.x * x0 + a0.z * x2 + a1.x * x4 + a1.z * x6) + (a0.y * x1 + a0.w * x3 + a1.y * x5); part += dpp_mov<0xB1>(part); part += dpp_mov<0x4E>(part); const float xt = f0p[27*F0P] - part; x6 = (p == 3) ? xt : x6; }
        { const f32x4 a0 = *(const LAS f32x4*)(f1p + 28*F1P + 0); const f32x4 a1 = *(const LAS f32x4*)(f1p + 28*F1P + 4); float part = (a0.x * x0 + a0.z * x2 + a1.x * x4 + a1.z * x6) + (a0.y * x1 + a0.w * x3 + a1.y * x5); part += dpp_mov<0xB1>(part); part += dpp_mov<0x4E>(part); const float xt = f0p[28*F0P] - part; x7 = (p == 0) ? xt : x7; }
        { const f32x4 a0 = *(const LAS f32x4*)(f1p + 29*F1P + 0); const f32x4 a1 = *(const LAS f32x4*)(f1p + 29*F1P + 4); float part = (a0.x * x0 + a0.z * x2 + a1.x * x4 + a1.z * x6) + (a0.y * x1 + a0.w * x3 + a1.y * x5 + a1.w * x7); part += dpp_mov<0xB1>(part); part += dpp_mov<0x4E>(part); const float xt = f0p[29*F0P] - part; x7 = (p == 1) ? xt : x7; }
        { const f32x4 a0 = *(const LAS f32x4*)(f1p + 30*F1P + 0); const f32x4 a1 = *(const LAS f32x4*)(f1p + 30*F1P + 4); float part = (a0.x * x0 + a0.z * x2 + a1.x * x4 + a1.z * x6) + (a0.y * x1 + a0.w * x3 + a1.y * x5 + a1.w * x7); part += dpp_mov<0xB1>(part); part += dpp_mov<0x4E>(part); const float xt = f0p[30*F0P] - part; x7 = (p == 2) ? xt : x7; }
        { const f32x4 a0 = *(const LAS f32x4*)(f1p + 31*F1P + 0); const f32x4 a1 = *(const LAS f32x4*)(f1p + 31*F1P + 4); float part = (a0.x * x0 + a0.z * x2 + a1.x * x4 + a1.z * x6) + (a0.y * x1 + a0.w * x3 + a1.y * x5 + a1.w * x7); part += dpp_mov<0xB1>(part); part += dpp_mov<0x4E>(part); const float xt = f0p[31*F0P] - part; x7 = (p == 3) ? xt : x7; }
        { const f32x4 a0 = *(const LAS f32x4*)(f1p + 32*F1P + 0); const f32x4 a1 = *(const LAS f32x4*)(f1p + 32*F1P + 4); float part = (a0.x * x0 + a0.z * x2 + a1.x * x4 + a1.z * x6) + (a0.y * x1 + a0.w * x3 + a1.y * x5 + a1.w * x7); part += dpp_mov<0xB1>(part); part += dpp_mov<0x4E>(part); const float xt = f0p[32*F0P] - part; x8 = (p == 0) ? xt : x8; }
        { const f32x4 a0 = *(const LAS f32x4*)(f1p + 33*F1P + 0); const f32x4 a1 = *(const LAS f32x4*)(f1p + 33*F1P + 4); const f32x4 a2 = *(const LAS f32x4*)(f1p + 33*F1P + 8); float part = (a0.x * x0 + a0.z * x2 + a1.x * x4 + a1.z * x6 + a2.x * x8) + (a0.y * x1 + a0.w * x3 + a1.y * x5 + a1.w * x7); part += dpp_mov<0xB1>(part); part += dpp_mov<0x4E>(part); const float xt = f0p[33*F0P] - part; x8 = (p == 1) ? xt : x8; }
        { const f32x4 a0 = *(const LAS f32x4*)(f1p + 34*F1P + 0); const f32x4 a1 = *(const LAS f32x4*)(f1p + 34*F1P + 4); const f32x4 a2 = *(const LAS f32x4*)(f1p + 34*F1P + 8); float part = (a0.x * x0 + a0.z * x2 + a1.x * x4 + a1.z * x6 + a2.x * x8) + (a0.y * x1 + a0.w * x3 + a1.y * x5 + a1.w * x7); part += dpp_mov<0xB1>(part); part += dpp_mov<0x4E>(part); const float xt = f0p[34*F0P] - part; x8 = (p == 2) ? xt : x8; }
        { const f32x4 a0 = *(const LAS f32x4*)(f1p + 35*F1P + 0); const f32x4 a1 = *(const LAS f32x4*)(f1p + 35*F1P + 4); const f32x4 a2 = *(const LAS f32x4*)(f1p + 35*F1P + 8); float part = (a0.x * x0 + a0.z * x2 + a1.x * x4 + a1.z * x6 + a2.x * x8) + (a0.y * x1 + a0.w * x3 + a1.y * x5 + a1.w * x7); part += dpp_mov<0xB1>(part); part += dpp_mov<0x4E>(part); const float xt = f0p[35*F0P] - part; x8 = (p == 3) ? xt : x8; }
        { const f32x4 a0 = *(const LAS f32x4*)(f1p + 36*F1P + 0); const f32x4 a1 = *(const LAS f32x4*)(f1p + 36*F1P + 4); const f32x4 a2 = *(const LAS f32x4*)(f1p + 36*F1P + 8); float part = (a0.x * x0 + a0.z * x2 + a1.x * x4 + a1.z * x6 + a2.x * x8) + (a0.y * x1 + a0.w * x3 + a1.y * x5 + a1.w * x7); part += dpp_mov<0xB1>(part); part += dpp_mov<0x4E>(part); const float xt = f0p[36*F0P] - part; x9 = (p == 0) ? xt : x9; }
        { const f32x4 a0 = *(const LAS f32x4*)(f1p + 37*F1P + 0); const f32x4 a1 = *(const LAS f32x4*)(f1p + 37*F1P + 4); const f32x4 a2 = *(const LAS f32x4*)(f1p + 37*F1P + 8); float part = (a0.x * x0 + a0.z * x2 + a1.x * x4 + a1.z * x6 + a2.x * x8) + (a0.y * x1 + a0.w * x3 + a1.y * x5 + a1.w * x7 + a2.y * x9); part += dpp_mov<0xB1>(part); part += dpp_mov<0x4E>(part); const float xt = f0p[37*F0P] - part; x9 = (p == 1) ? xt : x9; }
        { const f32x4 a0 = *(const LAS f32x4*)(f1p + 38*F1P + 0); const f32x4 a1 = *(const LAS f32x4*)(f1p + 38*F1P + 4); const f32x4 a2 = *(const LAS f32x4*)(f1p + 38*F1P + 8); float part = (a0.x * x0 + a0.z * x2 + a1.x * x4 + a1.z * x6 + a2.x * x8) + (a0.y * x1 + a0.w * x3 + a1.y * x5 + a1.w * x7 + a2.y * x9); part += dpp_mov<0xB1>(part); part += dpp_mov<0x4E>(part); const float xt = f0p[38*F0P] - part; x9 = (p == 2) ? xt : x9; }
        { const f32x4 a0 = *(const LAS f32x4*)(f1p + 39*F1P + 0); const f32x4 a1 = *(const LAS f32x4*)(f1p + 39*F1P + 4); const f32x4 a2 = *(const LAS f32x4*)(f1p + 39*F1P + 8); float part = (a0.x * x0 + a0.z * x2 + a1.x * x4 + a1.z * x6 + a2.x * x8) + (a0.y * x1 + a0.w * x3 + a1.y * x5 + a1.w * x7 + a2.y * x9); part += dpp_mov<0xB1>(part); part += dpp_mov<0x4E>(part); const float xt = f0p[39*F0P] - part; x9 = (p == 3) ? xt : x9; }
        { const f32x4 a0 = *(const LAS f32x4*)(f1p + 40*F1P + 0); const f32x4 a1 = *(const LAS f32x4*)(f1p + 40*F1P + 4); const f32x4 a2 = *(const LAS f32x4*)(f1p + 40*F1P + 8); float part = (a0.x * x0 + a0.z * x2 + a1.x * x4 + a1.z * x6 + a2.x * x8) + (a0.y * x1 + a0.w * x3 + a1.y * x5 + a1.w * x7 + a2.y * x9); part += dpp_mov<0xB1>(part); part += dpp_mov<0x4E>(part); const float xt = f0p[40*F0P] - part; x10 = (p == 0) ? xt : x10; }
        { const f32x4 a0 = *(const LAS f32x4*)(f1p + 41*F1P + 0); const f32x4 a1 = *(const LAS f32x4*)(f1p + 41*F1P + 4); const f32x4 a2 = *(const LAS f32x4*)(f1p + 41*F1P + 8); float part = (a0.x * x0 + a0.z * x2 + a1.x * x4 + a1.z * x6 + a2.x * x8 + a2.z * x10) + (a0.y * x1 + a0.w * x3 + a1.y * x5 + a1.w * x7 + a2.y * x9); part += dpp_mov<0xB1>(part); part += dpp_mov<0x4E>(part); const float xt = f0p[41*F0P] - part; x10 = (p == 1) ? xt : x10; }
        { const f32x4 a0 = *(const LAS f32x4*)(f1p + 42*F1P + 0); const f32x4 a1 = *(const LAS f32x4*)(f1p + 42*F1P + 4); const f32x4 a2 = *(const LAS f32x4*)(f1p + 42*F1P + 8); float part = (a0.x * x0 + a0.z * x2 + a1.x * x4 + a1.z * x6 + a2.x * x8 + a2.z * x10) + (a0.y * x1 + a0.w * x3 + a1.y * x5 + a1.w * x7 + a2.y * x9); part += dpp_mov<0xB1>(part); part += dpp_mov<0x4E>(part); const float xt = f0p[42*F0P] - part; x10 = (p == 2) ? xt : x10; }
        { const f32x4 a0 = *(const LAS f32x4*)(f1p + 43*F1P + 0); const f32x4 a1 = *(const LAS f32x4*)(f1p + 43*F1P + 4); const f32x4 a2 = *(const LAS f32x4*)(f1p + 43*F1P + 8); float part = (a0.x * x0 + a0.z * x2 + a1.x * x4 + a1.z * x6 + a2.x * x8 + a2.z * x10) + (a0.y * x1 + a0.w * x3 + a1.y * x5 + a1.w * x7 + a2.y * x9); part += dpp_mov<0xB1>(part); part += dpp_mov<0x4E>(part); const float xt = f0p[43*F0P] - part; x10 = (p == 3) ? xt : x10; }
        { const f32x4 a0 = *(const LAS f32x4*)(f1p + 44*F1P + 0); const f32x4 a1 = *(const LAS f32x4*)(f1p + 44*F1P + 4); const f32x4 a2 = *(const LAS f32x4*)(f1p + 44*F1P + 8); float part = (a0.x * x0 + a0.z * x2 + a1.x * x4 + a1.z * x6 + a2.x * x8 + a2.z * x10) + (a0.y * x1 + a0.w * x3 + a1.y * x5 + a1.w * x7 + a2.y * x9); part += dpp_mov<0xB1>(part); part += dpp_mov<0x4E>(part); const float xt = f0p[44*F0P] - part; x11 = (p == 0) ? xt : x11; }
        { const f32x4 a0 = *(const LAS f32x4*)(f1p + 45*F1P + 0); const f32x4 a1 = *(const LAS f32x4*)(f1p + 45*F1P + 4); const f32x4 a2 = *(const LAS f32x4*)(f1p + 45*F1P + 8); float part = (a0.x * x0 + a0.z * x2 + a1.x * x4 + a1.z * x6 + a2.x * x8 + a2.z * x10) + (a0.y * x1 + a0.w * x3 + a1.y * x5 + a1.w * x7 + a2.y * x9 + a2.w * x11); part += dpp_mov<0xB1>(part); part += dpp_mov<0x4E>(part); const float xt = f0p[45*F0P] - part; x11 = (p == 1) ? xt : x11; }
        { const f32x4 a0 = *(const LAS f32x4*)(f1p + 46*F1P + 0); const f32x4 a1 = *(const LAS f32x4*)(f1p + 46*F1P + 4); const f32x4 a2 = *(const LAS f32x4*)(f1p + 46*F1P + 8); float part = (a0.x * x0 + a0.z * x2 + a1.x * x4 + a1.z * x6 + a2.x * x8 + a2.z * x10) + (a0.y * x1 + a0.w * x3 + a1.y * x5 + a1.w * x7 + a2.y * x9 + a2.w * x11); part += dpp_mov<0xB1>(part); part += dpp_mov<0x4E>(part); const float xt = f0p[46*F0P] - part; x11 = (p == 2) ? xt : x11; }
        { const f32x4 a0 = *(const LAS f32x4*)(f1p + 47*F1P + 0); const f32x4 a1 = *(const LAS f32x4*)(f1p + 47*F1P + 4); const f32x4 a2 = *(const LAS f32x4*)(f1p + 47*F1P + 8); float part = (a0.x * x0 + a0.z * x2 + a1.x * x4 + a1.z * x6 + a2.x * x8 + a2.z * x10) + (a0.y * x1 + a0.w * x3 + a1.y * x5 + a1.w * x7 + a2.y * x9 + a2.w * x11); part += dpp_mov<0xB1>(part); part += dpp_mov<0x4E>(part); const float xt = f0p[47*F0P] - part; x11 = (p == 3) ? xt : x11; }
        { const f32x4 a0 = *(const LAS f32x4*)(f1p + 48*F1P + 0); const f32x4 a1 = *(const LAS f32x4*)(f1p + 48*F1P + 4); const f32x4 a2 = *(const LAS f32x4*)(f1p + 48*F1P + 8); float part = (a0.x * x0 + a0.z * x2 + a1.x * x4 + a1.z * x6 + a2.x * x8 + a2.z * x10) + (a0.y * x1 + a0.w * x3 + a1.y * x5 + a1.w * x7 + a2.y * x9 + a2.w * x11); part += dpp_mov<0xB1>(part); part += dpp_mov<0x4E>(part); const float xt = f0p[48*F0P] - part; x12 = (p == 0) ? xt : x12; }
        { const f32x4 a0 = *(const LAS f32x4*)(f1p + 49*F1P + 0); const f32x4 a1 = *(const LAS f32x4*)(f1p + 49*F1P + 4); const f32x4 a2 = *(const LAS f32x4*)(f1p + 49*F1P + 8); const f32x4 a3 = *(const LAS f32x4*)(f1p + 49*F1P + 12); float part = (a0.x * x0 + a0.z * x2 + a1.x * x4 + a1.z * x6 + a2.x * x8 + a2.z * x10 + a3.x * x12) + (a0.y * x1 + a0.w * x3 + a1.y * x5 + a1.w * x7 + a2.y * x9 + a2.w * x11); part += dpp_mov<0xB1>(part); part += dpp_mov<0x4E>(part); const float xt = f0p[49*F0P] - part; x12 = (p == 1) ? xt : x12; }
        { const f32x4 a0 = *(const LAS f32x4*)(f1p + 50*F1P + 0); const f32x4 a1 = *(const LAS f32x4*)(f1p + 50*F1P + 4); const f32x4 a2 = *(const LAS f32x4*)(f1p + 50*F1P + 8); const f32x4 a3 = *(const LAS f32x4*)(f1p + 50*F1P + 12); float part = (a0.x * x0 + a0.z * x2 + a1.x * x4 + a1.z * x6 + a2.x * x8 + a2.z * x10 + a3.x * x12) + (a0.y * x1 + a0.w * x3 + a1.y * x5 + a1.w * x7 + a2.y * x9 + a2.w * x11); part += dpp_mov<0xB1>(part); part += dpp_mov<0x4E>(part); const float xt = f0p[50*F0P] - part; x12 = (p == 2) ? xt : x12; }
        { const f32x4 a0 = *(const LAS f32x4*)(f1p + 51*F1P + 0); const f32x4 a1 = *(const LAS f32x4*)(f1p + 51*F1P + 4); const f32x4 a2 = *(const LAS f32x4*)(f1p + 51*F1P + 8); const f32x4 a3 = *(const LAS f32x4*)(f1p + 51*F1P + 12); float part = (a0.x * x0 + a0.z * x2 + a1.x * x4 + a1.z * x6 + a2.x * x8 + a2.z * x10 + a3.x * x12) + (a0.y * x1 + a0.w * x3 + a1.y * x5 + a1.w * x7 + a2.y * x9 + a2.w * x11); part += dpp_mov<0xB1>(part); part += dpp_mov<0x4E>(part); const float xt = f0p[51*F0P] - part; x12 = (p == 3) ? xt : x12; }
        { const f32x4 a0 = *(const LAS f32x4*)(f1p + 52*F1P + 0); const f32x4 a1 = *(const LAS f32x4*)(f1p + 52*F1P + 4); const f32x4 a2 = *(const LAS f32x4*)(f1p + 52*F1P + 8); const f32x4 a3 = *(const LAS f32x4*)(f1p + 52*F1P + 12); float part = (a0.x * x0 + a0.z * x2 + a1.x * x4 + a1.z * x6 + a2.x * x8 + a2.z * x10 + a3.x * x12) + (a0.y * x1 + a0.w * x3 + a1.y * x5 + a1.w * x7 + a2.y * x9 + a2.w * x11); part += dpp_mov<0xB1>(part); part += dpp_mov<0x4E>(part); const float xt = f0p[52*F0P] - part; x13 = (p == 0) ? xt : x13; }
        { const f32x4 a0 = *(const LAS f32x4*)(f1p + 53*F1P + 0); const f32x4 a1 = *(const LAS f32x4*)(f1p + 53*F1P + 4); const f32x4 a2 = *(const LAS f32x4*)(f1p + 53*F1P + 8); const f32x4 a3 = *(const LAS f32x4*)(f1p + 53*F1P + 12); float part = (a0.x * x0 + a0.z * x2 + a1.x * x4 + a1.z * x6 + a2.x * x8 + a2.z * x10 + a3.x * x12) + (a0.y * x1 + a0.w * x3 + a1.y * x5 + a1.w * x7 + a2.y * x9 + a2.w * x11 + a3.y * x13); part += dpp_mov<0xB1>(part); part += dpp_mov<0x4E>(part); const float xt = f0p[53*F0P] - part; x13 = (p == 1) ? xt : x13; }
        { const f32x4 a0 = *(const LAS f32x4*)(f1p + 54*F1P + 0); const f32x4 a1 = *(const LAS f32x4*)(f1p + 54*F1P + 4); const f32x4 a2 = *(const LAS f32x4*)(f1p + 54*F1P + 8); const f32x4 a3 = *(const LAS f32x4*)(f1p + 54*F1P + 12); float part = (a0.x * x0 + a0.z * x2 + a1.x * x4 + a1.z * x6 + a2.x * x8 + a2.z * x10 + a3.x * x12) + (a0.y * x1 + a0.w * x3 + a1.y * x5 + a1.w * x7 + a2.y * x9 + a2.w * x11 + a3.y * x13); part += dpp_mov<0xB1>(part); part += dpp_mov<0x4E>(part); const float xt = f0p[54*F0P] - part; x13 = (p == 2) ? xt : x13; }
        { const f32x4 a0 = *(const LAS f32x4*)(f1p + 55*F1P + 0); const f32x4 a1 = *(const LAS f32x4*)(f1p + 55*F1P + 4); const f32x4 a2 = *(const LAS f32x4*)(f1p + 55*F1P + 8); const f32x4 a3 = *(const LAS f32x4*)(f1p + 55*F1P + 12); float part = (a0.x * x0 + a0.z * x2 + a1.x * x4 + a1.z * x6 + a2.x * x8 + a2.z * x10 + a3.x * x12) + (a0.y * x1 + a0.w * x3 + a1.y * x5 + a1.w * x7 + a2.y * x9 + a2.w * x11 + a3.y * x13); part += dpp_mov<0xB1>(part); part += dpp_mov<0x4E>(part); const float xt = f0p[55*F0P] - part; x13 = (p == 3) ? xt : x13; }
        { const f32x4 a0 = *(const LAS f32x4*)(f1p + 56*F1P + 0); const f32x4 a1 = *(const LAS f32x4*)(f1p + 56*F1P + 4); const f32x4 a2 = *(const LAS f32x4*)(f1p + 56*F1P + 8); const f32x4 a3 = *(const LAS f32x4*)(f1p + 56*F1P + 12); float part = (a0.x * x0 + a0.z * x2 + a1.x * x4 + a1.z * x6 + a2.x * x8 + a2.z * x10 + a3.x * x12) + (a0.y * x1 + a0.w * x3 + a1.y * x5 + a1.w * x7 + a2.y * x9 + a2.w * x11 + a3.y * x13); part += dpp_mov<0xB1>(part); part += dpp_mov<0x4E>(part); const float xt = f0p[56*F0P] - part; x14 = (p == 0) ? xt : x14; }
        { const f32x4 a0 = *(const LAS f32x4*)(f1p + 57*F1P + 0); const f32x4 a1 = *(const LAS f32x4*)(f1p + 57*F1P + 4); const f32x4 a2 = *(const LAS f32x4*)(f1p + 57*F1P + 8); const f32x4 a3 = *(const LAS f32x4*)(f1p + 57*F1P + 12); float part = (a0.x * x0 + a0.z * x2 + a1.x * x4 + a1.z * x6 + a2.x * x8 + a2.z * x10 + a3.x * x12 + a3.z * x14) + (a0.y * x1 + a0.w * x3 + a1.y * x5 + a1.w * x7 + a2.y * x9 + a2.w * x11 + a3.y * x13); part += dpp_mov<0xB1>(part); part += dpp_mov<0x4E>(part); const float xt = f0p[57*F0P] - part; x14 = (p == 1) ? xt : x14; }
        { const f32x4 a0 = *(const LAS f32x4*)(f1p + 58*F1P + 0); const f32x4 a1 = *(const LAS f32x4*)(f1p + 58*F1P + 4); const f32x4 a2 = *(const LAS f32x4*)(f1p + 58*F1P + 8); const f32x4 a3 = *(const LAS f32x4*)(f1p + 58*F1P + 12); float part = (a0.x * x0 + a0.z * x2 + a1.x * x4 + a1.z * x6 + a2.x * x8 + a2.z * x10 + a3.x * x12 + a3.z * x14) + (a0.y * x1 + a0.w * x3 + a1.y * x5 + a1.w * x7 + a2.y * x9 + a2.w * x11 + a3.y * x13); part += dpp_mov<0xB1>(part); part += dpp_mov<0x4E>(part); const float xt = f0p[58*F0P] - part; x14 = (p == 2) ? xt : x14; }
        { const f32x4 a0 = *(const LAS f32x4*)(f1p + 59*F1P + 0); const f32x4 a1 = *(const LAS f32x4*)(f1p + 59*F1P + 4); const f32x4 a2 = *(const LAS f32x4*)(f1p + 59*F1P + 8); const f32x4 a3 = *(const LAS f32x4*)(f1p + 59*F1P + 12); float part = (a0.x * x0 + a0.z * x2 + a1.x * x4 + a1.z * x6 + a2.x * x8 + a2.z * x10 + a3.x * x12 + a3.z * x14) + (a0.y * x1 + a0.w * x3 + a1.y * x5 + a1.w * x7 + a2.y * x9 + a2.w * x11 + a3.y * x13); part += dpp_mov<0xB1>(part); part += dpp_mov<0x4E>(part); const float xt = f0p[59*F0P] - part; x14 = (p == 3) ? xt : x14; }
        { const f32x4 a0 = *(const LAS f32x4*)(f1p + 60*F1P + 0); const f32x4 a1 = *(const LAS f32x4*)(f1p + 60*F1P + 4); const f32x4 a2 = *(const LAS f32x4*)(f1p + 60*F1P + 8); const f32x4 a3 = *(const LAS f32x4*)(f1p + 60*F1P + 12); float part = (a0.x * x0 + a0.z * x2 + a1.x * x4 + a1.z * x6 + a2.x * x8 + a2.z * x10 + a3.x * x12 + a3.z * x14) + (a0.y * x1 + a0.w * x3 + a1.y * x5 + a1.w * x7 + a2.y * x9 + a2.w * x11 + a3.y * x13); part += dpp_mov<0xB1>(part); part += dpp_mov<0x4E>(part); const float xt = f0p[60*F0P] - part; x15 = (p == 0) ? xt : x15; }
        { const f32x4 a0 = *(const LAS f32x4*)(f1p + 61*F1P + 0); const f32x4 a1 = *(const LAS f32x4*)(f1p + 61*F1P + 4); const f32x4 a2 = *(const LAS f32x4*)(f1p + 61*F1P + 8); const f32x4 a3 = *(const LAS f32x4*)(f1p + 61*F1P + 12); float part = (a0.x * x0 + a0.z * x2 + a1.x * x4 + a1.z * x6 + a2.x * x8 + a2.z * x10 + a3.x * x12 + a3.z * x14) + (a0.y * x1 + a0.w * x3 + a1.y * x5 + a1.w * x7 + a2.y * x9 + a2.w * x11 + a3.y * x13 + a3.w * x15); part += dpp_mov<0xB1>(part); part += dpp_mov<0x4E>(part); const float xt = f0p[61*F0P] - part; x15 = (p == 1) ? xt : x15; }
        { const f32x4 a0 = *(const LAS f32x4*)(f1p + 62*F1P + 0); const f32x4 a1 = *(const LAS f32x4*)(f1p + 62*F1P + 4); const f32x4 a2 = *(const LAS f32x4*)(f1p + 62*F1P + 8); const f32x4 a3 = *(const LAS f32x4*)(f1p + 62*F1P + 12); float part = (a0.x * x0 + a0.z * x2 + a1.x * x4 + a1.z * x6 + a2.x * x8 + a2.z * x10 + a3.x * x12 + a3.z * x14) + (a0.y * x1 + a0.w * x3 + a1.y * x5 + a1.w * x7 + a2.y * x9 + a2.w * x11 + a3.y * x13 + a3.w * x15); part += dpp_mov<0xB1>(part); part += dpp_mov<0x4E>(part); const float xt = f0p[62*F0P] - part; x15 = (p == 2) ? xt : x15; }
        { const f32x4 a0 = *(const LAS f32x4*)(f1p + 63*F1P + 0); const f32x4 a1 = *(const LAS f32x4*)(f1p + 63*F1P + 4); const f32x4 a2 = *(const LAS f32x4*)(f1p + 63*F1P + 8); const f32x4 a3 = *(const LAS f32x4*)(f1p + 63*F1P + 12); float part = (a0.x * x0 + a0.z * x2 + a1.x * x4 + a1.z * x6 + a2.x * x8 + a2.z * x10 + a3.x * x12 + a3.z * x14) + (a0.y * x1 + a0.w * x3 + a1.y * x5 + a1.w * x7 + a2.y * x9 + a2.w * x11 + a3.y * x13 + a3.w * x15); part += dpp_mov<0xB1>(part); part += dpp_mov<0x4E>(part); const float xt = f0p[63*F0P] - part; x15 = (p == 3) ? xt : x15; }
        LAS unsigned char* dst = (wave < 4 ? B3 : B0) + (j & 63) * BLD + p * 2;
        *(LAS unsigned short*)(dst + 0) = (unsigned short)f2bf(-x0);
        *(LAS unsigned short*)(dst + 8) = (unsigned short)f2bf(-x1);
        *(LAS unsigned short*)(dst + 16) = (unsigned short)f2bf(-x2);
        *(LAS unsigned short*)(dst + 24) = (unsigned short)f2bf(-x3);
        *(LAS unsigned short*)(dst + 32) = (unsigned short)f2bf(-x4);
        *(LAS unsigned short*)(dst + 40) = (unsigned short)f2bf(-x5);
        *(LAS unsigned short*)(dst + 48) = (unsigned short)f2bf(-x6);
        *(LAS unsigned short*)(dst + 56) = (unsigned short)f2bf(-x7);
        *(LAS unsigned short*)(dst + 64) = (unsigned short)f2bf(-x8);
        *(LAS unsigned short*)(dst + 72) = (unsigned short)f2bf(-x9);
        *(LAS unsigned short*)(dst + 80) = (unsigned short)f2bf(-x10);
        *(LAS unsigned short*)(dst + 88) = (unsigned short)f2bf(-x11);
        *(LAS unsigned short*)(dst + 96) = (unsigned short)f2bf(-x12);
        *(LAS unsigned short*)(dst + 104) = (unsigned short)f2bf(-x13);
        *(LAS unsigned short*)(dst + 112) = (unsigned short)f2bf(-x14);
        *(LAS unsigned short*)(dst + 120) = (unsigned short)f2bf(-x15);
    }
    LDS_BAR();
    {
        f32x4 rpT[2], yl[2] = {z4, z4}, gT[2], hl[2] = {z4, z4};
#pragma unroll
        for (int c = 0; c < 2; ++c) { const int colx = 16 * (cb0 + c) + lc; rpT[c] = *(const LAS f32x4*)(F2 + colx * 64 + 16 * rb + 4 * g);
#pragma unroll
            for (int rg = 0; rg < 4; ++rg) { const int row = 16 * rb + 4 * g + rg; gT[c][rg] = row == colx ? GC[row] : 0.f; } }
#pragma unroll
        for (int ks = 0; ks < 2; ++ks) { const bf16x8 fnp = ldfrag(B3, rb, ks, lane), farb = ldfrag(B1, rb, ks, lane), fark = ldfrag(B2, rb, ks, lane), fbb = ldfrag(B6, rb, ks, lane), fkb = ldfrag(B5, rb, ks, lane);
#pragma unroll
            for (int c = 0; c < 2; ++c) { const bf16x8 carb = ldfrag(B1, cb0 + c, ks, lane), cbb = ldfrag(B6, cb0 + c, ks, lane), fq = ldfrag(B0, cb0 + c, ks, lane), fv = ldfrag(B4, cb0 + c, ks, lane);
                rpT[c] = MFMA16(fnp, carb, rpT[c]);
                gT[c] = MFMA16(fnp, cbb, gT[c]);
                yl[c] = MFMA16(fark, fv, yl[c]); yl[c] = MFMA16(farb, fq, yl[c]);
                hl[c] = MFMA16(fkb, fv, hl[c]); hl[c] = MFMA16(fbb, fq, hl[c]); } }
        bf16* RPg = (bf16*)(ws + SC_RP) + (size_t)unit * 4096; float* YLg = (float*)(ws + SC_YL) + (size_t)unit * 4096; bf16* Gg_ = (bf16*)(ws + SC_G) + (size_t)unit * 4096; float* HLg = (float*)(ws + SC_HL) + (size_t)unit * 4096;
#pragma unroll
        for (int c = 0; c < 2; ++c) { const int o = (16 * (cb0 + c) + lc) * 64 + 16 * rb + 4 * g;
            *(u32x2*)(RPg + o) = (u32x2){pk2(rpT[c][0], rpT[c][1]), pk2(rpT[c][2], rpT[c][3])};
            *(u32x2*)(Gg_ + o) = (u32x2){pk2(gT[c][0], gT[c][1]), pk2(gT[c][2], gT[c][3])};
            *(f32x4*)(HLg + o) = hl[c];
            *(f32x4*)(YLg + ((rb * 4 + cb0 + c) * 64 + lane) * 4) = yl[c]; }
    }
    }
#undef SA_LOAD
}

template <int NSTEP> __device__ __forceinline__ void scanB_chain(int l, LAS unsigned char* lds, int ci0, int h, int vs, const float* init, float* outp_state, int tid, int wave) {
    unsigned char* ws = KWS();
    const int lane = tid & 63, half = wave >> 2, jr = wave & 3, g = lane >> 4, lc = lane & 15;
    LAS unsigned char* XH = lds + half * 16384;
    const bf16* Gall = (const bf16*)(ws + SC_G); const float* HLall = (const float*)(ws + SC_HL); bf16* S0all = (bf16*)(ws + SC_S0);
    float zf; asm volatile("v_mov_b32 %0, 0" : "=v"(zf));
    f32x4 acc = (f32x4){zf, zf, zf, zf};
    __syncthreads();
    if (init) acc = *(const f32x4*)(init + (16 * vs + lc) * 64 + 16 * jr + 4 * g);
    constexpr int PF = NSTEP >= 16 ? 8 : 1;
    bf16x8 GA[PF][2], GB[PF][2]; f32x4 LA[PF], LB[PF];
#define SB_ISSUE(Gx, Lx, slot, c) do { const size_t unit_ = (size_t)(ci0 + (c)) * 16 + h; const bf16* Gp = Gall + unit_ * 4096 + (16 * jr + lc) * 64 + 8 * g; const float* Lp = HLall + unit_ * 4096 + (16 * vs + lc) * 64 + 16 * jr + 4 * g; \
        Gx[slot][0] = *(const bf16x8*)Gp; Gx[slot][1] = *(const bf16x8*)(Gp + 32); Lx[slot] = *(const f32x4*)Lp; } while (0)
#define SB_STEP(Gx, Lx, slot, c) do { const size_t unit = (size_t)(ci0 + (c)) * 16 + h; LAS unsigned char* xb = XH + ((c) & 1) * 8192; \
        const unsigned h0 = pk2(acc.x, acc.y), h1 = pk2(acc.z, acc.w); \
        const float l0 = acc.x - __builtin_bit_cast(float, h0 << 16), l1 = acc.y - __builtin_bit_cast(float, h0 & 0xffff0000u), l2 = acc.z - __builtin_bit_cast(float, h1 << 16), l3 = acc.w - __builtin_bit_cast(float, h1 & 0xffff0000u); \
        *(LAS u32x2*)(xb + lc * BLD + (16 * jr + 4 * g) * 2) = (u32x2){h0, h1}; \
        *(LAS u32x2*)(xb + 4096 + lc * BLD + (16 * jr + 4 * g) * 2) = (u32x2){pk2(l0, l1), pk2(l2, l3)}; \
        *(u32x2*)(S0all + unit * 4096 + (16 * vs + lc) * 64 + 16 * jr + 4 * g) = (u32x2){h0, h1};              \
        asm volatile("s_waitcnt lgkmcnt(0)" ::: "memory"); __builtin_amdgcn_s_barrier(); asm volatile("" ::: "memory");     \
        f32x4 a2 = Lx[slot]; \
        _Pragma("unroll") for (int ks = 0; ks < 2; ++ks) { const bf16x8 bh = *(const LAS bf16x8*)(xb + lc * BLD + (32 * ks + 8 * g) * 2), bl = *(const LAS bf16x8*)(xb + 4096 + lc * BLD + (32 * ks + 8 * g) * 2); \
            a2 = MFMA16(Gx[slot][ks], bh, a2); a2 = MFMA16(Gx[slot][ks], bl, a2); } \
        acc = a2; } while (0)
    if constexpr (NSTEP < 16) {
        for (int c = 0; c < NSTEP; ++c) { SB_ISSUE(GA, LA, 0, c); SB_STEP(GA, LA, 0, c); }
    } else {
        static_assert(NSTEP < 16 || NSTEP % 16 == 0, "pass B group structure");
#pragma unroll
        for (int s = 0; s < PF; ++s) SB_ISSUE(GA, LA, s, s);
        for (int c0 = 0; c0 < NSTEP; c0 += 16) {
            SB_STEP(GA, LA, 0, c0);
#pragma unroll
            for (int s = 0; s < PF; ++s) SB_ISSUE(GB, LB, s, c0 + 8 + s);
#pragma unroll
            for (int s = 1; s < PF; ++s) SB_STEP(GA, LA, s, c0 + s);
            SB_STEP(GB, LB, 0, c0 + 8);
            if (c0 + 16 < NSTEP) {
#pragma unroll
                for (int s = 0; s < PF; ++s) SB_ISSUE(GA, LA, s, c0 + 16 + s); }
#pragma unroll
            for (int s = 1; s < PF; ++s) SB_STEP(GB, LB, s, c0 + 8 + s);
        }
    }
    *(f32x4*)(outp_state + (16 * vs + lc) * 64 + 16 * jr + 4 * g) = acc;
#undef SB_ISSUE
#undef SB_STEP
}

template <int NSTEP> __device__ __forceinline__ void scanB_idle() { __syncthreads(); for (int c = 0; c < NSTEP; ++c) { asm volatile("" ::: "memory"); __builtin_amdgcn_s_barrier(); asm volatile("" ::: "memory"); } }

__device__ __forceinline__ void scanC_all(int l, LAS unsigned char* lds, int bx, int G, int tid, int wave) {
    unsigned char* ws = KWS();
    const int lane = tid & 63, rb = wave >> 1, cb0 = (wave & 1) * 2, g = lane >> 4, lc = lane & 15, t0 = 8 * wave;
    const float* ssh = KIN(I_SSH); const float* mu = KIN(I_MU) + (size_t)l * SHIFT; const float* gngp = KIN(I_GNG) + (size_t)l * RW; const float* gnbp = KIN(I_GNB) + (size_t)l * RW;
    const float* P = (const float*)(ws + B_P); const float* Gg = (const float*)(ws + WS_RW + 2 * RWSZ); bf16* MIXB = (bf16*)(ws + B_MIX);
    LAS float* Yl = (LAS float*)lds;
    f32x4 acc[2]; bf16x8 fa[2], fb[2][2]; float pv_[8], gt_[8], bn_[8], q_v, mu_v, gng, gnb;
#define SC_LOAD_A(unit_) do { const bf16* RPg = (const bf16*)(ws + SC_RP) + (size_t)(unit_) * 4096; const float* YLg = (const float*)(ws + SC_YL) + (size_t)(unit_) * 4096; const bf16* S0g = (const bf16*)(ws + SC_S0) + (size_t)(unit_) * 4096; \
        _Pragma("unroll") for (int c = 0; c < 2; ++c) acc[c] = *(const f32x4*)(YLg + ((rb * 4 + cb0 + c) * 64 + lane) * 4); \
        _Pragma("unroll") for (int ks = 0; ks < 2; ++ks) { fa[ks] = *(const bf16x8*)(RPg + (16 * rb + lc) * 64 + 32 * ks + 8 * g); _Pragma("unroll") for (int c = 0; c < 2; ++c) fb[ks][c] = *(const bf16x8*)(S0g + (16 * (cb0 + c) + lc) * 64 + 32 * ks + 8 * g); } } while (0)
#define SC_LOAD_B(unit_) do { const int ci_ = (unit_) >> 4, cc_ = 64 * ((unit_) & 15) + lane; const int m0_ = ci_ < 256 ? 64 * ci_ : TP + 32 * (ci_ - 256), n_ = ci_ < 256 ? 64 : 32; const float* bon_ = (const float*)(ws + SC_BON) + (size_t)(unit_) * 64; \
        mu_v = mu[2 * RW + cc_]; gng = gngp[cc_]; gnb = gnbp[cc_]; q_v = 0.f; \
        _Pragma("unroll") for (int i = 0; i < 8; ++i) { pv_[i] = 0.f; gt_[i] = 0.f; bn_[i] = 0.f; } \
        if (t0 < n_) { const float* pp_ = prev_row(ssh, l, P, m0_ + t0); if (pp_) q_v = pp_[2 * RW + cc_]; \
            _Pragma("unroll") for (int i = 0; i < 8; ++i) { const size_t m_ = (size_t)(m0_ + t0 + i); pv_[i] = P[m_ * PLD + 2 * RW + cc_]; gt_[i] = Gg[m_ * RW + cc_]; bn_[i] = bon_[t0 + i]; } } } while (0)
    if (bx < NUNIT) { SC_LOAD_A(bx); SC_LOAD_B(bx); }
    for (int unit = bx; unit < NUNIT; unit += G) {
        const int ci = unit >> 4, cc = 64 * (unit & 15) + lane; const int m0 = ci < 256 ? 64 * ci : TP + 32 * (ci - 256), n = ci < 256 ? 64 : 32;
        f32x4 y2[2] = {acc[0], acc[1]};
#pragma unroll
        for (int ks = 0; ks < 2; ++ks)
#pragma unroll
            for (int c = 0; c < 2; ++c) y2[c] = MFMA16(fa[ks], fb[ks][c], y2[c]);
        if (unit + G < NUNIT) SC_LOAD_A(unit + G);
        LDS_BAR();
#pragma unroll
        for (int c = 0; c < 2; ++c)
#pragma unroll
            for (int rg = 0; rg < 4; ++rg) Yl[(16 * rb + 4 * g + rg) * 65 + 16 * (cb0 + c) + lc] = y2[c][rg];
        LDS_BAR();
        unsigned short ov[8];
        if (t0 < n) {
            float qv = q_v;
#pragma unroll
            for (int i = 0; i < 8; ++i) { const int t = t0 + i;
                const float y = Yl[t * 65 + lane]; const float ym = wave_sum(y) * (1.f / HN); const float d = y - ym; const float yv = wave_sum(d * d) * (1.f / HN);
                const float yn = d * (1.f / sqrtf(yv + GN_EPS)) * gng + gnb;
                const float p_v = pv_[i]; const float vx = p_v + (qv - p_v) * mu_v; qv = p_v;
                ov[i] = (unsigned short)f2bf((yn + bn_[i] * vx) * gt_[i]); }
        }
        if (unit + G < NUNIT) SC_LOAD_B(unit + G);
        if (t0 < n) {
#pragma unroll
            for (int i = 0; i < 8; ++i) MIXB[(size_t)(m0 + t0 + i) * DM + cc] = (bf16)ov[i];
        }
    }
#undef SC_LOAD_A
#undef SC_LOAD_B
}

template <int PH> __global__ void __launch_bounds__(NTHR, 2) mk_fwd(Args a) {
    extern __shared__ __attribute__((aligned(16))) unsigned char lds_raw[];
    LAS unsigned char* lds = (LAS unsigned char*)lds_raw;
    const int wave_s = __builtin_amdgcn_readfirstlane((int)threadIdx.x >> 6);
    for (int u = threadIdx.x; u < (LDS_BYTES - LDSCTL_OFF) / 4; u += NTHR) ((LAS unsigned*)(lds + LDSCTL_OFF))[u] = 0u;
    __syncthreads();
    if (PH < 0) (void)xcd_barrier_post((unsigned*)KWS() + CW_BAR, (volatile LAS unsigned*)(lds + MISC_OFF) + 8, (int)threadIdx.x);
#define IN(k) (PH < 0 || PH == (k))
#define PHASE_IDS() int tid_; asm volatile("v_mbcnt_lo_u32_b32 %0, -1, 0\n\tv_mbcnt_hi_u32_b32 %0, -1, %0\n\tv_lshl_add_u32 %0, %1, 6, %0" : "=&v"(tid_) : "s"(wave_s)); const int tid = tid_, lane = tid & 63, wave = wave_s; \
    const int G = gridDim.x, bx = blockIdx.x, vcu = (G % 8 == 0) ? (bx % 8) * (G / 8) + bx / 8 : bx, gw = vcu * NWAVES + wave, NGW = G * NWAVES; unsigned char* ws = KWS(); (void)tid; (void)lane; (void)gw; (void)NGW; (void)ws
#define SEAM() do { if (PH < 0) { XcdBarrier bar_; bar_.bar = (unsigned*)KWS() + CW_BAR; bar_.x = xb_xcc_id(); bar_.st = (volatile LAS unsigned*)(lds + MISC_OFF) + 8; xcd_barrier(bar_, tid); } } while (0)

    for (int l = a.l_lo; l < a.l_hi; ++l) {
        const int par = l & 1;
        if (IN(0) && (PH >= 0 || l == a.l_lo)) { PHASE_IDS(); phase_convert(l, par, 0, CV_NTASK, true, l == 0, lane, gw, NGW); SEAM(); }
        if (IN(1)) { PHASE_IDS(); pg8::Gemm g{(const bf16*)(ws + B_XB8), (const bf16*)(ws + wofs(1, par)), M, 2 * FF, DM, DM}; pg8::StaticOrder S; S.init(M, 2 * FF, G, bx); pg8::EpiSwiGLU8 E{ws + B_H, FF};
            pg8::gemm_phase<pg8::EpiSwiGLU8, pg8::StaticOrder, true, true, (121 << 8) | 127>(lds + RING_OFF, g, S, E, tid); SEAM(); }
        if (IN(2)) { PHASE_IDS();
            { pg8::Gemm g{(const bf16*)(ws + B_H), (const bf16*)(ws + wofs(2, par)), TP, DM, FF, FF}; pg8::StaticOrder S; S.init(TP, DM, G, bx); pg8::EpiResid E{(const bf16*)(ws + WS_XB), (float*)(ws + WS_Z), DM, ALPHA, 0.5f};
              pg8::gemm_phase<pg8::EpiResid, pg8::StaticOrder, true, true, (121 << 8) | 125>(lds + RING_OFF, g, S, E, tid); }
            { pg8::Gemm g{(const bf16*)(ws + B_H), (const bf16*)(ws + wofs(2, par)), M, DM, FF, 512}; pg8::SplitOrder S{G, bx, 11, 512}; pg8::EpiSlab E{(float*)(ws + WS_SLAB), 512};
              pg8::gemm_phase<pg8::EpiSlab, pg8::SplitOrder, false, true, (121 << 8) | 125>(lds + RING_OFF, g, S, E, tid); }
            SEAM(); }
        if (IN(3)) { PHASE_IDS(); phase_ln((const float*)(ws + WS_Z), (const float*)(ws + WS_X), (const float*)(ws + WS_SLAB), 11, ALPHA, 0.5f, KIN(I_LNG) + (size_t)l * 3 * DM, KIN(I_LNB) + (size_t)l * 3 * DM, (float*)(ws + WS_X), (bf16*)(ws + WS_XB), (unsigned char*)nullptr, false, lane, gw, NGW); SEAM(); }
        if (IN(4)) { PHASE_IDS(); pg8::Gemm g{(const bf16*)(ws + WS_XB), (const bf16*)(ws + wofs(3, par)), M, N3, DM, DM}; pg8::StaticOrder S; S.init(M, N3, G, bx); pg8::EpiP E{(float*)(ws + B_P), (bf16*)(ws + B_U), (float*)(ws + B_GV)};
            pg8::gemm_phase<pg8::EpiP, pg8::StaticOrder, true, true>(lds + RING_OFF, g, S, E, tid); SEAM(); }
        if (IN(5)) { PHASE_IDS(); phase_prep1(l, lane, gw, NGW); SEAM(); }
        if (IN(6)) { PHASE_IDS(); pg8::Gemm g{(const bf16*)(ws + B_A3B), (const bf16*)(ws + wofs(7, par)), M, NL, LK, LK}; pg8::StaticOrder S; S.init(M, NL, G, bx);
            pg8::EpiLora E{(float*)(ws + WS_RW)};
            pg8::gemm_phase<pg8::EpiLora, pg8::StaticOrder, false, false>(lds + RING_OFF, g, S, E, tid); SEAM(); }
        if (IN(7)) { PHASE_IDS(); scanA_all(l, lds, bx, G, tid, wave); SEAM(); }
        if (IN(8)) { PHASE_IDS();
            if (bx < 64) { const int hh = bx >> 2; if (wave < 4) scanB_chain<256>(l, lds, 0, hh, bx & 3, nullptr, KOUT() + O_SP + ((size_t)l * NH + hh) * 4096, tid, wave); else scanB_idle<256>(); }
            else { const float* srw = KIN(I_SRW); float* outp = KOUT();
                for (int p = bx - 64; p < 512; p += G - 64) { const int task = 2 * p + (wave >> 2), b = task >> 6, hh = (task >> 2) & 15; const size_t so = (((size_t)l * NSB + b) * NH + hh) * 4096;
                    scanB_chain<1>(l, lds, 256 + b, hh, task & 3, srw + so, outp + O_SS + so, tid, wave); }
                for (int u = bx - 64; u < 144 * 8; u += G - 64) gmlp_unit(l, lds, u, tid, wave); }
            SEAM(); }
        if (IN(9)) { PHASE_IDS(); scanC_all(l, lds, bx, G, tid, wave); SEAM(); }
        if (IN(10)) { PHASE_IDS();
            { pg8::Gemm g{(const bf16*)(ws + B_MIX), (const bf16*)(ws + wofs(4, par)), TP, DM, DM, DM}; pg8::StaticOrder S; S.init(TP, DM, G, bx); pg8::EpiResid E{(const bf16*)(ws + WS_XB), (float*)(ws + WS_Z), DM, ALPHA, 1.0f};
              pg8::gemm_phase<pg8::EpiResid, pg8::StaticOrder, true, true>(lds + RING_OFF, g, S, E, tid); }
            { pg8::Gemm g{(const bf16*)(ws + B_MIX), (const bf16*)(ws + wofs(4, par)), M, DM, DM, 256}; pg8::SplitOrder S{G, bx, 8, 256}; pg8::EpiSlab E{(float*)(ws + WS_SLAB), 256};
              pg8::gemm_phase<pg8::EpiSlab, pg8::SplitOrder, false, true>(lds + RING_OFF, g, S, E, tid); }
            SEAM(); }
        if (IN(11)) { PHASE_IDS(); phase_ln((const float*)(ws + WS_Z), (const float*)(ws + WS_X), (const float*)(ws + WS_SLAB), 8, ALPHA, 1.0f, KIN(I_LNG) + (size_t)(l * 3 + 1) * DM, KIN(I_LNB) + (size_t)(l * 3 + 1) * DM, (float*)(ws + WS_X), (bf16*)(ws + WS_XB), ws + B_XB8, false, lane, gw, NGW); SEAM(); }
        if (IN(12)) { PHASE_IDS(); pg8::Gemm g{(const bf16*)(ws + B_XB8), (const bf16*)(ws + wofs(5, par)), M, 2 * FF, DM, DM}; pg8::StaticOrder S; S.init(M, 2 * FF, G, bx); pg8::EpiSwiGLU8 E{ws + B_H, FF};
            pg8::gemm_phase<pg8::EpiSwiGLU8, pg8::StaticOrder, true, true, (121 << 8) | 127>(lds + RING_OFF, g, S, E, tid); SEAM(); }
        if (IN(13)) { PHASE_IDS();
            { pg8::Gemm g{(const bf16*)(ws + B_H), (const bf16*)(ws + wofs(6, par)), TP, DM, FF, FF}; pg8::StaticOrder S; S.init(TP, DM, G, bx); pg8::EpiResid E{(const bf16*)(ws + WS_XB), (float*)(ws + WS_Z), DM, ALPHA, 0.5f};
              pg8::gemm_phase<pg8::EpiResid, pg8::StaticOrder, true, true, (121 << 8) | 125>(lds + RING_OFF, g, S, E, tid); }
            { pg8::Gemm g{(const bf16*)(ws + B_H), (const bf16*)(ws + wofs(6, par)), M, DM, FF, 512}; pg8::SplitOrder S{G, bx, 11, 512}; pg8::EpiSlab E{(float*)(ws + WS_SLAB), 512};
              pg8::gemm_phase<pg8::EpiSlab, pg8::SplitOrder, false, true, (121 << 8) | 125>(lds + RING_OFF, g, S, E, tid); }
            SEAM(); }
        if (IN(14)) { PHASE_IDS(); const bool last = (l == DEPTH - 1);
            phase_ln((const float*)(ws + WS_Z), (const float*)(ws + WS_X), (const float*)(ws + WS_SLAB), 11, ALPHA, 0.5f, KIN(I_LNG) + (size_t)(l * 3 + 2) * DM, KIN(I_LNB) + (size_t)(l * 3 + 2) * DM, last ? KOUT() + O_YP : (float*)(ws + WS_X), last ? (bf16*)nullptr : (bf16*)(ws + WS_XB), last ? (unsigned char*)nullptr : ws + B_XB8, last, lane, gw, NGW);
            if (PH < 0 && l + 1 < a.l_hi) phase_convert(l + 1, par ^ 1, 0, CV_NTASK, true, false, lane, gw, NGW);
            if (!last) SEAM(); }
    }
#undef IN
#undef SEAM
#undef PHASE_IDS
}

template <int PH> static bool prep_kernel() { return hipFuncSetAttribute((const void*)mk_fwd<PH>, hipFuncAttributeMaxDynamicSharedMemorySize, LDS_BYTES) == hipSuccess; }
template <int PH> static void launch_phase(int grid, hipStream_t stream, Args a) { hipLaunchKernelGGL(mk_fwd<PH>, dim3(grid), dim3(NTHR), LDS_BYTES, stream, a); }
extern "C" void kernel_launch(void* const* d_in, const int* in_sizes, int n_in, void* d_out, int out_size, void* d_ws, size_t ws_size, hipStream_t stream) {
    static int grid = 0;
    if (grid == 0) {
        if (n_in != 29 || (size_t)out_size != O_END || ws_size < WS_TOP) { fprintf(stderr, "kernel_launch: unexpected shapes: n_in %d out %d ws %zu (need %zu)\n", n_in, out_size, ws_size, (size_t)WS_TOP); grid = -1; return; }
        int dev = 0, cus = 0, per_cu = 0;
        if (hipGetDevice(&dev) != hipSuccess || hipDeviceGetAttribute(&cus, hipDeviceAttributeMultiprocessorCount, dev) != hipSuccess) { grid = -1; return; }
        bool ok = true;
#if MK_ONE_LAUNCH
        ok = prep_kernel<-1>();
        if (hipOccupancyMaxActiveBlocksPerMultiprocessor(&per_cu, (const void*)mk_fwd<-1>, NTHR, LDS_BYTES) != hipSuccess || per_cu < 1) fprintf(stderr, "kernel_launch: occupancy query says %d\n", per_cu);
#else
        ok = prep_kernel<0>() && prep_kernel<1>() && prep_kernel<2>() && prep_kernel<3>() && prep_kernel<4>() && prep_kernel<5>() && prep_kernel<6>() && prep_kernel<7>() && prep_kernel<8>() && prep_kernel<9>() && prep_kernel<10>() && prep_kernel<11>() && prep_kernel<12>() && prep_kernel<13>() && prep_kernel<14>();
#endif
        if (!ok) { fprintf(stderr, "kernel_launch: hipFuncSetAttribute failed\n"); grid = -1; return; }
        (void)hipGetLastError();
        grid = cus;
        if (grid < 64) { grid = -1; return; }
    }
    if (grid < 0) return;
    (void)hipMemsetAsync((char*)d_ws + WS_CTL, 0, CTL_ZERO_BYTES, stream);
    Args a{};
    for (int i = 0; i < 29; ++i) a.in[i] = (const float*)d_in[i];
    a.out = (float*)d_out; a.ws = (unsigned char*)d_ws;
#if MK_ONE_LAUNCH
    a.l_lo = 0; a.l_hi = DEPTH;
    launch_phase<-1>(grid, stream, a);
#else
    for (int l = 0; l < DEPTH; ++l) { a.l_lo = l; a.l_hi = l + 1;
        launch_phase<0>(grid, stream, a); launch_phase<1>(grid, stream, a); launch_phase<2>(grid, stream, a); launch_phase<3>(grid, stream, a); launch_phase<4>(grid, stream, a);
        launch_phase<5>(grid, stream, a); launch_phase<6>(grid, stream, a); launch_phase<7>(grid, stream, a); launch_phase<8>(grid, stream, a); launch_phase<9>(grid, stream, a);
        launch_phase<10>(grid, stream, a); launch_phase<11>(grid, stream, a); launch_phase<12>(grid, stream, a); launch_phase<13>(grid, stream, a); launch_phase<14>(grid, stream, a); }
#endif
}
```
